# Optimizing an MI355X kernel written in HIP

```python
import math
import jax
import jax.numpy as jnp
from jax import lax
import numpy as np

D_MODEL = 1024
BATCH = 16
SEQ = 4096
DEPTH = 4

CTX_LEN = 256
GRID_W = 64
D_MIX = D_MODEL
GROUP_W = D_MIX // 4
H_A = 4
HKV_A = 2
G_A = H_A // HKV_A
DH_A = GROUP_W // H_A
WINDOW = 128
BLK = 128
HY_W = GROUP_W
HY_ORDER = 2
HY_SHORT = 3
HY_BANDS = 16
HY_EMB = 1 + 2 * HY_BANDS
HY_HID = 64
HY_TARGET = 1e-2
HY_FAST = 0.3
HY_SLOW = 1.5
H_C = 4
DH_C = GROUP_W // H_C
CHUNK_C = 64
H_D = 4
DH_D = GROUP_W // (2 * H_D)
N_EXPERTS = 16
EC_CAPACITY = 2
D_EXPERT = D_MODEL
ROPE_BASE = 10000.0
EPS = 1e-6
NEG = -1e30
IN_SPLITS = (H_A * DH_A, HKV_A * DH_A, HKV_A * DH_A,
             3 * HY_W,
             H_C * DH_C, H_C * DH_C, H_C * DH_C, H_C * DH_C,
             4 * H_C,
             2 * H_D * DH_D, 2 * H_D * DH_D, 2 * H_D * DH_D)
IN_WIDTH = sum(IN_SPLITS)

kernel_name = 'hybrid_diffusion_trunk'


def _rms(x, g):
    xf = x.astype(jnp.float32)
    y = xf * lax.rsqrt(jnp.mean(xf * xf, axis=-1, keepdims=True) + EPS)
    return y.astype(x.dtype) * g.astype(x.dtype)


def _split_cols(p):
    return jnp.split(p, np.cumsum(IN_SPLITS)[:-1].tolist(), axis=-1)


def _axial_tables(T, dh):
    rows = T // GRID_W
    r = jnp.broadcast_to(jnp.arange(rows, dtype=jnp.float32)[:, None], (rows, GRID_W)).reshape(T)
    col = jnp.broadcast_to(jnp.arange(GRID_W, dtype=jnp.float32)[None, :], (rows, GRID_W)).reshape(T)
    nf = dh // 4
    inv = ROPE_BASE ** (-jnp.arange(nf, dtype=jnp.float32) / nf)
    ang = jnp.stack([r[:, None] * inv, col[:, None] * inv], axis=1)
    return jnp.cos(ang), jnp.sin(ang)


def _rope2d(x, cos, sin):
    nf = x.shape[-1] // 4
    xr = x.reshape(*x.shape[:-1], 2, 2, nf)
    bshape = (x.shape[1],) + (1,) * (x.ndim - 3) + (2, nf)
    c = cos.reshape(bshape).astype(x.dtype)
    s = sin.reshape(bshape).astype(x.dtype)
    a, b = xr[..., 0, :], xr[..., 1, :]
    return jnp.stack([a * c - b * s, b * c + a * s], axis=-2).reshape(x.shape)


def _sink_softmax(s, sink):
    m = jnp.maximum(jnp.max(s, axis=-1, keepdims=True), sink)
    p = jnp.exp(s - m)
    return p / (jnp.sum(p, axis=-1, keepdims=True) + jnp.exp(sink - m))


def _window_gqa(qc, kc, vc, ql, kl, vl, q_gain, k_gain, sink, cos, sin, ctx_out):
    B, T = ql.shape[:2]
    S = kc.shape[1]
    nb = T // BLK
    scale = DH_A ** -0.5
    sink_hg = sink.astype(jnp.float32).reshape(HKV_A, G_A, 1, 1)
    kc = _rms(kc.reshape(B, S, HKV_A, DH_A), k_gain)
    vc = vc.reshape(B, S, HKV_A, DH_A)
    ql = _rope2d(_rms(ql.reshape(B, T, H_A, DH_A), q_gain), cos, sin)
    kl = _rope2d(_rms(kl.reshape(B, T, HKV_A, DH_A), k_gain), cos, sin)
    qb = ql.reshape(B, nb, BLK, HKV_A, G_A, DH_A)

    def windows(t):
        tp = jnp.pad(t, ((0, 0), (BLK, BLK), (0, 0), (0, 0))).reshape(B, nb + 2, BLK, HKV_A, DH_A)
        return jnp.concatenate([tp[:, :-2], tp[:, 1:-1], tp[:, 2:]], axis=2)

    kw = windows(kl)
    vw = windows(vl.reshape(B, T, HKV_A, DH_A))
    kpos = jnp.arange(-BLK, T + BLK).reshape(nb + 2, BLK)
    kpos = jnp.concatenate([kpos[:-2], kpos[1:-1], kpos[2:]], axis=1)
    qpos = jnp.arange(T).reshape(nb, BLK)
    valid = ((jnp.abs(qpos[:, :, None] - kpos[:, None, :]) <= WINDOW)
             & (kpos >= 0)[:, None, :] & (kpos < T)[:, None, :])
    s_loc = jnp.einsum('bnqhgd,bnkhd->bnhgqk', qb, kw).astype(jnp.float32) * scale
    s_loc = jnp.where(valid[None, :, None, None], s_loc, NEG)
    s_ctx = jnp.einsum('bnqhgd,bkhd->bnhgqk', qb, kc).astype(jnp.float32) * scale
    p = _sink_softmax(jnp.concatenate([s_loc, s_ctx], axis=-1), sink_hg).astype(vl.dtype)
    nk = 3 * BLK
    ol = (jnp.einsum('bnhgqk,bnkhd->bnqhgd', p[..., :nk], vw)
          + jnp.einsum('bnhgqk,bkhd->bnqhgd', p[..., nk:], vc)).reshape(B, T, H_A * DH_A)
    oc = None
    if ctx_out:
        qcg = _rms(qc.reshape(B, S, H_A, DH_A), q_gain).reshape(B, S, HKV_A, G_A, DH_A)
        sc = jnp.einsum('bqhgd,bkhd->bhgqk', qcg, kc).astype(jnp.float32) * scale
        pc = _sink_softmax(sc, sink_hg).astype(vc.dtype)
        oc = jnp.einsum('bhgqk,bkhd->bqhgd', pc, vc).reshape(B, S, H_A * DH_A)
    return oc, ol


def _hyena_spectra(L, fw1, fb1, freq, fw2, fb2, fw3):
    f32 = jnp.float32
    t = jnp.linspace(0.0, 1.0, L, dtype=f32)[:, None]
    w = 2.0 * math.pi * jnp.arange(L, dtype=f32)[:, None] / L
    bands = jnp.linspace(1e-4, HY_BANDS - 1, HY_BANDS, dtype=f32)
    z = jnp.concatenate([t, jnp.cos(bands * w), -jnp.sin(bands * w)], axis=-1)
    fr = freq.astype(f32)
    h = jnp.sin(fr * (z @ fw1.astype(f32) + fb1.astype(f32)))
    h = jnp.sin(fr * (h @ fw2.astype(f32) + fb2.astype(f32)))
    h = (h @ fw3.astype(f32)).reshape(L, 2, HY_ORDER, HY_W)
    deltas = jnp.abs(jnp.linspace(math.log(HY_TARGET) / HY_SLOW, math.log(HY_TARGET) / HY_FAST, HY_W, dtype=f32))
    h = h * jnp.exp(-t * deltas)[:, None, None, :]
    two_sided = jnp.concatenate([h[:, 0], jnp.zeros((1, HY_ORDER, HY_W), f32), jnp.flip(h[1:, 1], axis=0)], axis=0)
    two_sided = two_sided * lax.rsqrt(jnp.sum(two_sided * two_sided, axis=0, keepdims=True) + EPS)
    return jnp.fft.rfft(two_sided, axis=0)


def _fftconv(z, spec, bias):
    L = z.shape[1]
    zf = z.astype(jnp.float32)
    y = jnp.fft.irfft(jnp.fft.rfft(zf, n=2 * L, axis=1) * spec, n=2 * L, axis=1)[:, :L]
    return (y + zf * bias.astype(jnp.float32)).astype(z.dtype)


def _hyena_mixer(uc, ul, conv_w, fw1, fb1, freq, fw2, fb2, fw3, bias, ctx_out):
    def run(u):
        L = u.shape[1]
        up = jnp.pad(u, ((0, 0), (1, 1), (0, 0)))
        u = conv_w[0] * up[:, 0:L] + conv_w[1] * up[:, 1:L + 1] + conv_w[2] * up[:, 2:L + 2]
        v, x1, x2 = jnp.split(u, 3, axis=-1)
        spec = _hyena_spectra(L, fw1, fb1, freq, fw2, fb2, fw3)
        z = v
        for n, gate in enumerate((x1, x2)):
            z = gate * _fftconv(z, spec[:, n], bias[n])
        return z
    return (run(uc) if ctx_out else None), run(ul)


def _mlstm_scan(q, k, v, ig, lf, state, emit):
    B, H, T, d = q.shape
    nc = T // CHUNK_C

    def chunks(t):
        return jnp.moveaxis(t.reshape(B, H, nc, CHUNK_C, *t.shape[3:]), 2, 0)

    tril = jnp.tril(jnp.ones((CHUNK_C, CHUNK_C), dtype=bool))

    def step(carry, xs):
        C, n, m = carry
        qc, kc, vc, ic, fc = xs
        b = jnp.cumsum(fc, axis=-1)
        g_end = b[..., -1:] - b + ic
        m_new = jnp.maximum(b[..., -1] + m, jnp.max(g_end, axis=-1))
        w_prev = jnp.exp(b[..., -1] + m - m_new)
        w_tok = jnp.exp(g_end - m_new[..., None])
        C_new = w_prev[..., None, None] * C + jnp.einsum('bhs,bhse,bhsk->bhek', w_tok, vc, kc)
        n_new = w_prev[..., None] * n + jnp.einsum('bhs,bhsk->bhk', w_tok, kc)
        if not emit:
            return (C_new, n_new, m_new), None
        logw = jnp.where(tril, b[..., :, None] - b[..., None, :] + ic[..., None, :], NEG)
        inter = b + m[..., None]
        m_t = jnp.maximum(inter, jnp.max(logw, axis=-1))
        w_in = jnp.exp(inter - m_t)
        s = jnp.einsum('bhtk,bhsk->bhts', qc, kc) * jnp.exp(logw - m_t[..., None])
        num = w_in[..., None] * jnp.einsum('bhek,bhtk->bhte', C, qc) + jnp.einsum('bhts,bhse->bhte', s, vc)
        den = w_in * jnp.einsum('bhk,bhtk->bht', n, qc) + jnp.sum(s, axis=-1)
        h = num / jnp.maximum(jnp.abs(den), jnp.exp(-m_t))[..., None]
        return (C_new, n_new, m_new), h

    carry, hs = lax.scan(step, state, tuple(chunks(t) for t in (q, k, v, ig, lf)))
    if not emit:
        return None, carry
    return jnp.moveaxis(hs, 0, 2).reshape(B, H, T, d), carry


def _mlstm_mixer(pc, pl, b_gate, norm_gain, ctx_out):
    f32 = jnp.float32

    def prep(q, k, v, g):
        B, L = q.shape[:2]

        def heads(t):
            return jnp.swapaxes(t.reshape(B, L, H_C, DH_C), 1, 2).astype(f32)

        gates = jnp.moveaxis(g.reshape(B, L, 4, H_C).astype(f32) + b_gate.astype(f32), 1, -1)
        return heads(q), heads(k) * DH_C ** -0.5, heads(v), gates

    qc, kc, vc, oc_pre, gc = pc
    ql, kl, vl, ol_pre, gl = pl
    Qc, Kc, Vc, Gc = prep(qc, kc, vc, gc)
    Ql, Kl, Vl, Gl = prep(ql, kl, vl, gl)
    B = ql.shape[0]
    s0 = (jnp.zeros((B, H_C, DH_C, DH_C), f32), jnp.zeros((B, H_C, DH_C), f32), jnp.zeros((B, H_C), f32))
    lsig = jax.nn.log_sigmoid

    def flip(t):
        return jnp.flip(t, axis=2)

    hcf, sf = _mlstm_scan(Qc, Kc, Vc, Gc[:, 0], lsig(Gc[:, 2]), s0, ctx_out)
    hlf, _ = _mlstm_scan(Ql, Kl, Vl, Gl[:, 0], lsig(Gl[:, 2]), sf, True)
    hcb, sb = _mlstm_scan(flip(Qc), flip(Kc), flip(Vc), flip(Gc[:, 1]), flip(lsig(Gc[:, 3])), s0, ctx_out)
    hlb, _ = _mlstm_scan(flip(Ql), flip(Kl), flip(Vl), flip(Gl[:, 1]), flip(lsig(Gl[:, 3])), sb, True)

    def out(h, o_pre):
        B_, L = o_pre.shape[:2]
        h = jnp.swapaxes(h, 1, 2)
        o = jax.nn.sigmoid(o_pre.reshape(B_, L, H_C, DH_C).astype(f32))
        return (o * _rms(h, norm_gain)).astype(o_pre.dtype).reshape(B_, L, H_C * DH_C)

    yl = out(hlf + flip(hlb), ol_pre)
    yc = out(hcf + flip(hcb), oc_pre) if ctx_out else None
    return yc, yl


def _diff_attn(qc, kc, vc, ql, kl, vl, q_gain, k_gain, lq1, lk1, lq2, lk2, sub_gain, lam_init, cos, sin, ctx_out):
    B, T = ql.shape[:2]
    S = kc.shape[1]
    nb = T // BLK
    scale = DH_D ** -0.5
    f32 = jnp.float32
    lam = (jnp.exp(jnp.sum(lq1.astype(f32) * lk1.astype(f32)))
           - jnp.exp(jnp.sum(lq2.astype(f32) * lk2.astype(f32))) + lam_init)
    kc = _rms(kc.reshape(B, S, H_D, 2, DH_D), k_gain)
    vc = vc.reshape(B, S, H_D, 2 * DH_D)
    ql = _rope2d(_rms(ql.reshape(B, T, H_D, 2, DH_D), q_gain), cos, sin)
    kl = _rope2d(_rms(kl.reshape(B, T, H_D, 2, DH_D), k_gain), cos, sin)
    k_all = jnp.concatenate([kl, kc], axis=1)
    v_all = jnp.concatenate([vl.reshape(B, T, H_D, 2 * DH_D), vc], axis=1)

    def attend(q, k, v):
        s = jnp.einsum('bqhcd,bkhcd->bhcqk', q, k).astype(f32) * scale
        p = jax.nn.softmax(s, axis=-1)
        a = (p[:, :, 0] - lam * p[:, :, 1]).astype(v.dtype)
        return jnp.einsum('bhqk,bkhe->bqhe', a, v)

    def post(o):
        return (_rms(o, sub_gain) * (1.0 - lam_init)).reshape(*o.shape[:2], H_D * 2 * DH_D)

    qb = jnp.moveaxis(ql.reshape(B, nb, BLK, H_D, 2, DH_D), 1, 0)
    ol = lax.map(lambda q: attend(q, k_all, v_all), qb)
    ol = post(jnp.moveaxis(ol, 0, 1).reshape(B, T, H_D, 2 * DH_D))
    oc = post(attend(_rms(qc.reshape(B, S, H_D, 2, DH_D), q_gain), kc, vc)) if ctx_out else None
    return oc, ol


def _expert_choice_ffn(h, w_router, w_g, w_u, w_d):
    B, T, D = h.shape
    cap = (EC_CAPACITY * T) // N_EXPERTS
    aff = jax.nn.softmax((h @ w_router).astype(jnp.float32), axis=-1)
    gate, idx = lax.top_k(jnp.swapaxes(aff, 1, 2), cap)
    bidx = jnp.arange(B)[:, None, None]
    xe = h[bidx, idx]
    a = jnp.einsum('becd,edf->becf', xe, w_g)
    u = jnp.einsum('becd,edf->becf', xe, w_u)
    y = jnp.einsum('becf,efd->becd', jax.nn.silu(a) * u, w_d) * gate[..., None].astype(h.dtype)
    return jnp.zeros_like(h).at[bidx, idx].add(y)


def setup_inputs(seed: int = 0) -> dict:
    key = jax.random.key(seed)
    ks = iter(list(jax.random.split(key, 48)))
    f32 = jnp.float32

    def nrm(shape, s):
        return jax.random.normal(next(ks), shape, f32) * s

    def gain(shape):
        return 1.0 + nrm(shape, 0.05)

    L, D = DEPTH, D_MODEL
    b_gate = jnp.concatenate([nrm((L, 2, H_C), 0.1),
                              jnp.linspace(3.0, 6.0, H_C, dtype=f32) + nrm((L, 2, H_C), 0.1)], axis=1)
    return {
        'x': nrm((BATCH, SEQ, D), 1.0),
        'c': nrm((BATCH, D), 1.0),
        'ctx': nrm((BATCH, CTX_LEN, D), 1.0),
        'c_ctx': nrm((D,), 1.0),
        'w_ada': nrm((L, D, 6 * D), 0.5 * D ** -0.5),
        'b_ada': nrm((L, 6 * D), 0.02),
        'norm1_g': gain((L, D)),
        'norm2_g': gain((L, D)),
        'w_in': nrm((L, D, IN_WIDTH), D ** -0.5),
        'b_gate': b_gate,
        'a_qnorm': gain((L, DH_A)),
        'a_knorm': gain((L, DH_A)),
        'a_sink': nrm((L, H_A), 0.5),
        'hy_conv': nrm((L, HY_SHORT, 3 * HY_W), HY_SHORT ** -0.5),
        'hy_fw1': nrm((L, HY_EMB, HY_HID), HY_EMB ** -0.5),
        'hy_fb1': nrm((L, HY_HID), 0.02),
        'hy_freq': gain((L, HY_HID)),
        'hy_fw2': nrm((L, HY_HID, HY_HID), HY_HID ** -0.5),
        'hy_fb2': nrm((L, HY_HID), 0.02),
        'hy_fw3': nrm((L, HY_HID, 2 * HY_ORDER * HY_W), HY_HID ** -0.5),
        'hy_bias': nrm((L, HY_ORDER, HY_W), 0.5),
        'ml_norm': gain((L, DH_C)),
        'd_qnorm': gain((L, DH_D)),
        'd_knorm': gain((L, DH_D)),
        'd_lq1': nrm((L, DH_D), 0.1),
        'd_lk1': nrm((L, DH_D), 0.1),
        'd_lq2': nrm((L, DH_D), 0.1),
        'd_lk2': nrm((L, DH_D), 0.1),
        'd_subnorm': gain((L, 2 * DH_D)),
        'w_out': nrm((L, D_MIX, D), D_MIX ** -0.5),
        'w_router': nrm((L, D, N_EXPERTS), D ** -0.5),
        'w_e_gate': nrm((L, N_EXPERTS, D, D_EXPERT), D ** -0.5),
        'w_e_up': nrm((L, N_EXPERTS, D, D_EXPERT), D ** -0.5),
        'w_e_down': nrm((L, N_EXPERTS, D_EXPERT, D), D_EXPERT ** -0.5),
    }


def reference(x, c, ctx, c_ctx, w_ada, b_ada, norm1_g, norm2_g, w_in, b_gate,
              a_qnorm, a_knorm, a_sink,
              hy_conv, hy_fw1, hy_fb1, hy_freq, hy_fw2, hy_fb2, hy_fw3, hy_bias,
              ml_norm, d_qnorm, d_knorm, d_lq1, d_lk1, d_lq2, d_lk2, d_subnorm,
              w_out, w_router, w_e_gate, w_e_up, w_e_down):
    T = x.shape[1]
    cos_a, sin_a = _axial_tables(T, DH_A)
    cos_d, sin_d = _axial_tables(T, DH_D)
    silu_c = jax.nn.silu(c)
    silu_cc = jax.nn.silu(c_ctx)
    for l in range(DEPTH):
        last = l == DEPTH - 1
        ctx_out = not last
        lam_init = 0.8 - 0.6 * math.exp(-0.3 * l)
        mod_l = (silu_c @ w_ada[l] + b_ada[l])[:, None, :]
        mod_c = (silu_cc @ w_ada[l] + b_ada[l])[None, None, :]
        sh1l, sc1l, gt1l, sh2l, sc2l, gt2l = jnp.split(mod_l, 6, axis=-1)
        sh1c, sc1c, gt1c, sh2c, sc2c, gt2c = jnp.split(mod_c, 6, axis=-1)

        hl = _rms(x, norm1_g[l]) * (1.0 + sc1l) + sh1l
        hc = _rms(ctx, norm1_g[l]) * (1.0 + sc1c) + sh1c
        pl = _split_cols(hl @ w_in[l])
        pc = _split_cols(hc @ w_in[l])
        ya_c, ya_l = _window_gqa(pc[0], pc[1], pc[2], pl[0], pl[1], pl[2],
                                 a_qnorm[l], a_knorm[l], a_sink[l], cos_a, sin_a, ctx_out)
        yb_c, yb_l = _hyena_mixer(pc[3], pl[3], hy_conv[l], hy_fw1[l], hy_fb1[l], hy_freq[l],
                                  hy_fw2[l], hy_fb2[l], hy_fw3[l], hy_bias[l], ctx_out)
        yc_c, yc_l = _mlstm_mixer(pc[4:9], pl[4:9], b_gate[l], ml_norm[l], ctx_out)
        yd_c, yd_l = _diff_attn(pc[9], pc[10], pc[11], pl[9], pl[10], pl[11],
                                d_qnorm[l], d_knorm[l], d_lq1[l], d_lk1[l], d_lq2[l], d_lk2[l],
                                d_subnorm[l], lam_init, cos_d, sin_d, ctx_out)
        x = x + gt1l * (jnp.concatenate([ya_l, yb_l, yc_l, yd_l], axis=-1) @ w_out[l])

        x = x + gt2l * _expert_choice_ffn(_rms(x, norm2_g[l]) * (1.0 + sc2l) + sh2l,
                                          w_router[l], w_e_gate[l], w_e_up[l], w_e_down[l])
        if ctx_out:
            ctx = ctx + gt1c * (jnp.concatenate([ya_c, yb_c, yc_c, yd_c], axis=-1) @ w_out[l])
            ctx = ctx + gt2c * _expert_choice_ffn(_rms(ctx, norm2_g[l]) * (1.0 + sc2c) + sh2c,
                                                  w_router[l], w_e_gate[l], w_e_up[l], w_e_down[l])
    return x
```

```cpp
#include <hip/hip_runtime.h>
#include <stdint.h>
#include <stdio.h>

typedef unsigned short bf16_t;
typedef short bf16x8 __attribute__((ext_vector_type(8)));
typedef short s16x4 __attribute__((ext_vector_type(4)));
typedef float f32x4 __attribute__((ext_vector_type(4)));
typedef float f32x16 __attribute__((ext_vector_type(16)));
typedef unsigned u32x4 __attribute__((ext_vector_type(4)));
typedef unsigned u32x2 __attribute__((ext_vector_type(2)));
#define LAS __attribute__((address_space(3)))

#define NB 16
#define TL 4096
#define TCX 256
#define DM 1024
#define NROWL 65536
#define NROWC 4096
#define NROW 69632
#define PW 2304
#define INW 3088
#define NEXP 16
#define CAPL 512
#define CAPC 32
#define SLOTS_E 8704
#define NSLOT 139264
#define DEPTH 4
#define NTHR 512
#define LDS_BYTES 155648
#define EPSF 1e-6f
#define LOG2E 1.4426950408889634f

constexpr size_t al256(size_t x) { return (x + 255) & ~size_t(255); }
constexpr size_t WS_BAR   = 0;
constexpr size_t WS_MOD   = al256(WS_BAR + 16384);
constexpr size_t MOD_BYTES = al256((size_t)17 * 6144 * 4);
constexpr size_t WS_HID2L = al256(WS_MOD + 2 * MOD_BYTES);
constexpr size_t WS_HID2C = al256(WS_HID2L + (size_t)4096 * 64 * 4);
constexpr size_t WS_GATES = al256(WS_HID2C + (size_t)256 * 64 * 4);
constexpr size_t WS_AFF   = al256(WS_GATES + (size_t)NROW * 16 * 4);
constexpr size_t WS_SROW  = al256(WS_AFF + (size_t)NROW * 16 * 4);
constexpr size_t WS_SGATE = al256(WS_SROW + (size_t)NSLOT * 4);
constexpr size_t WS_INV   = al256(WS_SGATE + (size_t)NSLOT * 4);
constexpr size_t WS_MLS   = al256(WS_INV + (size_t)NROW * 16 * 4);
constexpr size_t WS_FBUF  = al256(WS_MLS + (size_t)128 * 68 * 4 * 4);
constexpr size_t WS_ROPE  = al256(WS_FBUF + (size_t)256 * 8256 * 2);
constexpr size_t WS_CTX   = al256(WS_ROPE + (size_t)64 * 24 * 8);
constexpr size_t WS_U     = al256(WS_CTX + (size_t)NROWC * DM * 4);
constexpr size_t WS_WOUT  = al256(WS_U + (size_t)(NROW + 3072) * DM * 2);
constexpr size_t WS_WGU   = al256(WS_WOUT + (size_t)DM * DM * 2);
constexpr size_t WS_WD    = al256(WS_WGU + (size_t)NEXP * 2048 * DM * 2);
constexpr size_t WS_P     = al256(WS_WD + (size_t)NEXP * DM * DM * 2);
constexpr size_t WS_UT    = al256(WS_P + (size_t)NROW * PW * 2);
constexpr size_t WS_XE    = al256(WS_UT + (size_t)768 * NROW * 2);
constexpr size_t WS_XB    = al256(WS_XE + (size_t)NSLOT * DM * 2);
constexpr size_t WS_END   = al256(WS_XB + (size_t)NROW * DM * 2);
constexpr size_t WS_HID   = WS_P;
constexpr size_t WS_MLA   = WS_XE;
constexpr size_t WS_MLN   = al256(WS_MLA + (size_t)128 * 68 * 4096 * 2);
constexpr size_t WS_YT    = al256(WS_MLN + (size_t)128 * 68 * 64 * 4);
static_assert(WS_YT + (size_t)256 * NROW * 2 <= WS_XB, "alias overflow");
static_assert((size_t)NSLOT * DM * 2 <= (size_t)NROW * PW * 2, "hid alias overflow");

struct Params {
    const float* in[34];
    float* out;
    unsigned char* ws;
};
enum { I_X = 0, I_C, I_CTX, I_CCTX, I_WADA, I_BADA, I_N1G, I_N2G, I_WIN, I_BGATE, I_AQN, I_AKN, I_ASINK, I_HYCONV, I_FW1, I_FB1, I_FREQ, I_FW2, I_FB2, I_FW3,
       I_HYBIAS, I_MLNORM, I_DQN, I_DKN, I_LQ1, I_LK1, I_LQ2, I_LK2, I_DSUB, I_WOUT, I_WROUTER, I_WEG, I_WEU, I_WED };

__device__ __forceinline__ int my_tid() { int t = threadIdx.x; asm volatile("" : "+v"(t)); return t; }
#define GAS __attribute__((address_space(1)))
__device__ __forceinline__ unsigned char* launder_ws(unsigned char* q) { GAS unsigned char* g = (GAS unsigned char*)q; asm volatile("" : "+s"(g)); return (unsigned char*)g; }
#define CAS __attribute__((address_space(4)))
__device__ __forceinline__ const float* pin_ptr(int i) { const CAS char* ka = (const CAS char*)__builtin_amdgcn_kernarg_segment_ptr(); asm volatile("" : "+s"(ka));
    const GAS float* g = *(const GAS float* const CAS*)(ka + 8 * i); return (const float*)g; }
#define PIN(i) pin_ptr(i)
#define POUT() ((float*)pin_ptr(34))
__device__ __forceinline__ float bf2f(bf16_t v) { return __uint_as_float((unsigned)v << 16); }
__device__ __forceinline__ bf16_t f2bf(float f) { unsigned u = __float_as_uint(f); u += 0x7fffu + ((u >> 16) & 1u); return (bf16_t)(u >> 16); }
__device__ __forceinline__ unsigned pack_bf16(float lo, float hi) { return (unsigned)f2bf(lo) | ((unsigned)f2bf(hi) << 16); }
__device__ __forceinline__ float bflo(unsigned w) { return __uint_as_float(w << 16); }
__device__ __forceinline__ float bfhi(unsigned w) { return __uint_as_float(w & 0xffff0000u); }
template <int CTRL> __device__ __forceinline__ float dpp_get(float v) { return __int_as_float(__builtin_amdgcn_update_dpp(0, __float_as_int(v), CTRL, 0xf, 0xf, true)); }
#define DPP_XOR1 0xB1
#define DPP_XOR2 0x4E
#define DPP_HMIRROR 0x141
#define DPP_MIRROR 0x140
#define DPP_ROR8 0x128
__device__ __forceinline__ float wave_sum(float v) {
    v += dpp_get<DPP_XOR1>(v); v += dpp_get<DPP_XOR2>(v); v += dpp_get<DPP_HMIRROR>(v); v += dpp_get<DPP_MIRROR>(v);
    const int iv = __float_as_int(v);
    return (__int_as_float(__builtin_amdgcn_readlane(iv, 0)) + __int_as_float(__builtin_amdgcn_readlane(iv, 16))) + (__int_as_float(__builtin_amdgcn_readlane(iv, 32)) + __int_as_float(__builtin_amdgcn_readlane(iv, 48)));
}
__device__ __forceinline__ float wave_max(float v) {
    v = fmaxf(v, dpp_get<DPP_XOR1>(v)); v = fmaxf(v, dpp_get<DPP_XOR2>(v)); v = fmaxf(v, dpp_get<DPP_HMIRROR>(v)); v = fmaxf(v, dpp_get<DPP_MIRROR>(v));
    const int iv = __float_as_int(v);
    return fmaxf(fmaxf(__int_as_float(__builtin_amdgcn_readlane(iv, 0)), __int_as_float(__builtin_amdgcn_readlane(iv, 16))), fmaxf(__int_as_float(__builtin_amdgcn_readlane(iv, 32)), __int_as_float(__builtin_amdgcn_readlane(iv, 48))));
}
__device__ __forceinline__ float reduce16_transpose(const float (&part)[16], int lane) {
    float v8[8], v4[4], v2[2], v1;
#pragma unroll
    for (int j = 0; j < 8; ++j) { const auto r = __builtin_amdgcn_permlane32_swap(__float_as_uint(part[j]), __float_as_uint(part[8 + j]), false, false); v8[j] = __uint_as_float(r[0]) + __uint_as_float(r[1]); }
#pragma unroll
    for (int j = 0; j < 4; ++j) { const auto r = __builtin_amdgcn_permlane16_swap(__float_as_uint(v8[j]), __float_as_uint(v8[4 + j]), false, false); v4[j] = __uint_as_float(r[0]) + __uint_as_float(r[1]); }
    { const bool up = (lane & 8) != 0;
#pragma unroll
      for (int j = 0; j < 2; ++j) { const float send = up ? v4[j] : v4[2 + j], keep = up ? v4[2 + j] : v4[j]; v2[j] = keep + dpp_get<DPP_ROR8>(send); } }
    { const bool up = (lane & 4) != 0; const float send = up ? v2[0] : v2[1], keep = up ? v2[1] : v2[0]; v1 = keep + dpp_get<DPP_HMIRROR>(send); }
    v1 += dpp_get<DPP_XOR2>(v1); v1 += dpp_get<DPP_XOR1>(v1);
    return v1;
}
__device__ __forceinline__ float fast_exp2(float x) { return __builtin_amdgcn_exp2f(x); }
__device__ __forceinline__ float log_sigmoid(float x) { return fminf(x, 0.f) - log1pf(expf(-fabsf(x))); }

#define XB_TMO      128
#define XB_XCNT(j)  (256  + 64 * (j))
#define XB_XSUB(j)  (1280 + 64 * (j))
#define XB_XGEN(j)  (2304 + 64 * (j))
#define XB_TOP      3328
#define XB_TOPGEN   3392
#define XCD_BAR_WORDS 3456
#define XB_SPIN_CAP (1u << 22)

__device__ __forceinline__ unsigned xb_ld(unsigned* p)              { return __hip_atomic_load(p, __ATOMIC_RELAXED, __HIP_MEMORY_SCOPE_AGENT); }
__device__ __forceinline__ unsigned xb_add(unsigned* p, unsigned v) { return __hip_atomic_fetch_add(p, v, __ATOMIC_RELAXED, __HIP_MEMORY_SCOPE_AGENT); }
__device__ __forceinline__ unsigned xb_xcc_id() { return (unsigned)__builtin_amdgcn_s_getreg((3 << 11) | 20) & 0xFu; }
#define XB_SPIN(cond, bar) do { unsigned _sp = 0; while (cond) { __builtin_amdgcn_s_sleep(1); \
    if ((++_sp & 255u) == 0u) { if (xb_ld(&(bar)[XB_TMO])) break; if (_sp > XB_SPIN_CAP) { atomicAdd(&(bar)[XB_TMO], 1u); break; } } } } while (0)

struct XcdBarrier { unsigned* bar; unsigned x; volatile LAS unsigned* st; };

__device__ __forceinline__ XcdBarrier xcd_barrier_post(unsigned* bar, volatile LAS unsigned* st) {
    XcdBarrier b; b.bar = bar; b.x = xb_xcc_id(); b.st = st;
    if (threadIdx.x == 0) (void)xb_add(&bar[XB_XCNT(b.x)], 1u);
    return b;
}
__device__ __forceinline__ void xcd_barrier_complete(unsigned* bar, unsigned x, unsigned& nloc, unsigned& nx) {
    const unsigned G = gridDim.x * gridDim.y * gridDim.z;
    unsigned sum, cnt, mine, sp = 0u;
    for (;;) {
        sum = 0u; cnt = 0u; mine = 0u;
#pragma unroll
        for (unsigned j = 0; j < 16; ++j) { const unsigned c = xb_ld(&bar[XB_XCNT(j)]); sum += c; cnt += (c > 0u) ? 1u : 0u; mine = (j == x) ? c : mine; }
        if (sum == G) break;
        __builtin_amdgcn_s_sleep(1);
        if ((++sp & 255u) == 0u) { if (xb_ld(&bar[XB_TMO])) break; if (sp > XB_SPIN_CAP) { atomicAdd(&bar[XB_TMO], 1u); break; } }
    }
    nloc = mine > 0u ? mine : 1u; nx = cnt > 0u ? cnt : 1u;
}
__device__ __forceinline__ void xcd_barrier(const XcdBarrier& b) {
    asm volatile("s_waitcnt vmcnt(0)" ::: "memory");
    __syncthreads();
    if (threadIdx.x == 0) {
        unsigned* bar = b.bar;
        __builtin_amdgcn_s_waitcnt(0);
        unsigned nloc = b.st[0], nx = b.st[1];
        if (nloc == 0u) { xcd_barrier_complete(bar, b.x, nloc, nx); b.st[0] = nloc; b.st[1] = nx; }
        const unsigned old = xb_add(&bar[XB_XSUB(b.x)], 1u);
        const unsigned gen = old / nloc;
        if (old + 1u == (gen + 1u) * nloc) {
            __builtin_amdgcn_fence(__ATOMIC_RELEASE, "agent");
            asm volatile("s_waitcnt vmcnt(0)" ::: "memory");
            const unsigned og = xb_add(&bar[XB_TOP], 1u);
            const unsigned tg = og / nx;
            if (og + 1u == (tg + 1u) * nx) xb_add(&bar[XB_TOPGEN], 1u);
            else XB_SPIN(xb_ld(&bar[XB_TOPGEN]) == tg, bar);
            __builtin_amdgcn_fence(__ATOMIC_ACQUIRE, "agent");
            xb_add(&bar[XB_XGEN(b.x)], 1u);
            asm volatile("s_waitcnt vmcnt(0)" ::: "memory");
        } else {
            XB_SPIN(xb_ld(&bar[XB_XGEN(b.x)]) == gen, bar);
            __builtin_amdgcn_fence(__ATOMIC_ACQUIRE, "agent");
            asm volatile("s_waitcnt vmcnt(0)" ::: "memory");
        }
    }
    __syncthreads();
}

namespace pg8 {
constexpr int BM = 256, BK = 64, HALF = 128, HTB = HALF * BK * 2, STAGE_BYTES = 8 * HTB, NXCD = 8, WGM = 8;
__host__ __device__ __forceinline__ int lds_byte(int r, int c) { const int st = (r >> 4) * 2 + (c >> 5), rr = r & 15, cc = c & 31, ob = rr * 64 + cc * 2; return st * 1024 + (ob ^ (((ob >> 9) & 1) << 5)); }
__host__ __device__ __forceinline__ void stage_rc(int b, int& R, int& C) { const int st = b / 1024, sb = b % 1024, swz = sb ^ (((sb >> 9) & 1) << 5); R = (st >> 1) * 16 + swz / 64; C = (st & 1) * 32 + (swz % 64) / 2; }
__host__ __device__ __forceinline__ int perm32(int rho) { const int n = rho >> 4, i = rho & 15; return 8 * (i >> 2) + 4 * n + (i & 3); }
struct Unit { int pm, pn; };
struct Gemm { const bf16_t* A; const bf16_t* Bt; int M, N, K; };
__device__ __forceinline__ unsigned cvt_pk_bf16(float lo, float hi) { unsigned r; asm volatile("v_cvt_pk_bf16_f32 %0, %1, %2" : "=v"(r) : "v"(lo), "v"(hi)); return r; }

__device__ __forceinline__ void static_unit(int L, int nM, int nN, int& pm, int& pn) {
    const int nwg = nM * nN; int wgid = L;
    { const int q = nwg / NXCD, r = nwg % NXCD, xcd = wgid % NXCD, off = wgid / NXCD; wgid = (xcd < r ? xcd * (q + 1) : r * (q + 1) + (xcd - r) * q) + off; }
    const int nig = WGM * nN, gid = wgid / nig, fm = gid * WGM, gsz = (nM - fm) < WGM ? (nM - fm) : WGM;
    pm = fm + ((wgid % nig) % gsz); pn = (wgid % nig) / gsz;
}

template <class Epi, class Sched>
__device__ __forceinline__ void gemm_phase(LAS unsigned char* lds, const Gemm g, const Sched& S, const Epi& E) {
    const int tid = my_tid(), wid = __builtin_amdgcn_readfirstlane(tid >> 6), lane = tid & 63, wr = wid >> 2, wc = wid & 3, fr = lane & 15, fq = lane >> 4;
    const int K = g.K, nt = K / BK;
    unsigned voffA[2], voffB[2];
#pragma unroll
    for (int i = 0; i < 2; ++i) { int R, C; stage_rc(tid * 16 + i * 8192, R, C); const int Rb = Epi::PERM ? ((R & ~31) + perm32(R & 31)) : R;
        voffA[i] = (unsigned)(R * K + C) * 2u; voffB[i] = (unsigned)(Rb * K + C) * 2u; }
    const size_t kstep = (size_t)(BK * 2);
    const size_t hstep = (size_t)HALF * K * 2;
    const size_t tstep = 2 * hstep;
    const unsigned ldsw = (unsigned)wid * 1024u;
    const int aoff = lds_byte(wr * 64 + fr, fq * 8), boff = lds_byte(wc * 32 + fr, fq * 8);
#define PG8_SA(b, h) (((b) * 2 + (h)) * HTB)
#define PG8_SB(b, h) ((4 + (b) * 2 + (h)) * HTB)
#define PG8_STAGE(bufoff, gbase, voff) do { _Pragma("unroll") for (int _i = 0; _i < 2; ++_i) \
        __builtin_amdgcn_global_load_lds((const unsigned*)((const char*)(gbase) + (voff)[_i]), (LAS unsigned*)(lds + (bufoff) + ldsw + _i * 8192), 16, 0, 0); } while (0)
#define PG8_LDA(dst, b, h) do { _Pragma("unroll") for (int m = 0; m < 4; ++m) _Pragma("unroll") for (int k = 0; k < 2; ++k) dst[m][k] = *(const LAS bf16x8*)(lds + PG8_SA(b, h) + aoff + m * 2048 + k * 1024); } while (0)
#define PG8_LDB(dst, b, h) do { _Pragma("unroll") for (int n = 0; n < 2; ++n) _Pragma("unroll") for (int k = 0; k < 2; ++k) dst[n][k] = *(const LAS bf16x8*)(lds + PG8_SB(b, h) + boff + n * 2048 + k * 1024); } while (0)
#define PG8_MMA(ai, bj, At, Bt) do { __builtin_amdgcn_s_setprio(1); _Pragma("unroll") for (int m = 0; m < 4; ++m) _Pragma("unroll") for (int n = 0; n < 2; ++n) _Pragma("unroll") for (int k = 0; k < 2; ++k) \
        acc[ai][bj][m][n] = __builtin_amdgcn_mfma_f32_16x16x32_bf16(Bt[n][k], At[m][k], acc[ai][bj][m][n], 0, 0, 0); __builtin_amdgcn_s_setprio(0); } while (0)
#define PG8_WAIT_V(n) asm volatile("s_waitcnt vmcnt(" #n ")" ::: "memory")
#define PG8_WAIT_L(n) asm volatile("s_waitcnt lgkmcnt(" #n ")" ::: "memory")
#define PG8_BAR __builtin_amdgcn_s_barrier()
#define PG8_SCHED __builtin_amdgcn_sched_barrier(0)
    Unit cur, nxt; int ui = 0;
    if (!S.next(0, cur)) return;
    f32x4 acc[2][2][4][2];
#pragma unroll
    for (int a = 0; a < 2; ++a)
#pragma unroll
        for (int b = 0; b < 2; ++b)
#pragma unroll
            for (int m = 0; m < 4; ++m)
#pragma unroll
                for (int n = 0; n < 2; ++n) acc[a][b][m][n] = (f32x4){0.f, 0.f, 0.f, 0.f};
    bf16x8 At[4][2], B0[2][2], B1[2][2];
    const char* cA = (const char*)g.A + (size_t)cur.pm * tstep; const char* cB = (const char*)g.Bt + (size_t)cur.pn * tstep;
    PG8_STAGE(PG8_SB(0, 0), cB, voffB); PG8_STAGE(PG8_SA(0, 0), cA, voffA); PG8_STAGE(PG8_SB(0, 1), cB + hstep, voffB); PG8_STAGE(PG8_SA(0, 1), cA + hstep, voffA);
    if (wr == 1) PG8_BAR;
    PG8_WAIT_V(4); PG8_BAR;
    PG8_STAGE(PG8_SB(1, 0), cB + kstep, voffB); PG8_STAGE(PG8_SA(1, 0), cA + kstep, voffA); PG8_STAGE(PG8_SB(1, 1), cB + hstep + kstep, voffB);
    PG8_WAIT_V(6); PG8_BAR;
    for (;;) {
        const bool has_next = S.next(ui + 1, nxt);
        const char* nA = has_next ? (const char*)g.A + (size_t)nxt.pm * tstep : cA; const char* nB = has_next ? (const char*)g.Bt + (size_t)nxt.pn * tstep : cB;
        for (int t = 0; t < nt; t += 2) {
            const bool last = (t == nt - 2);
            const char* a1 = cA + (size_t)(t + 1) * kstep;
            const char* a2 = last ? nA : cA + (size_t)(t + 2) * kstep; const char* b2 = last ? nB : cB + (size_t)(t + 2) * kstep;
            const char* a3 = a2 + kstep; const char* b3 = b2 + kstep;
            PG8_LDB(B0, 0, 0); PG8_SCHED; PG8_LDA(At, 0, 0); PG8_STAGE(PG8_SA(1, 1), a1 + hstep, voffA);
            PG8_WAIT_L(8); PG8_BAR; PG8_WAIT_L(0); PG8_MMA(0, 0, At, B0); PG8_BAR; PG8_SCHED;
            PG8_LDB(B1, 0, 1); PG8_STAGE(PG8_SB(0, 0), b2, voffB);
            PG8_BAR; PG8_WAIT_L(0); PG8_MMA(0, 1, At, B1); PG8_BAR;
            PG8_LDA(At, 0, 1); PG8_STAGE(PG8_SA(0, 0), a2, voffA);
            PG8_BAR; PG8_WAIT_L(0); PG8_MMA(1, 0, At, B0); PG8_BAR; PG8_SCHED;
            PG8_STAGE(PG8_SB(0, 1), b2 + hstep, voffB);
            PG8_WAIT_V(6); PG8_BAR; PG8_MMA(1, 1, At, B1); PG8_BAR;
            PG8_LDB(B0, 1, 0); PG8_SCHED; PG8_LDA(At, 1, 0); PG8_STAGE(PG8_SA(0, 1), a2 + hstep, voffA);
            PG8_WAIT_L(8); PG8_BAR; PG8_WAIT_L(0); PG8_MMA(0, 0, At, B0); PG8_BAR; PG8_SCHED;
            PG8_LDB(B1, 1, 1); PG8_STAGE(PG8_SB(1, 0), b3, voffB);
            PG8_BAR; PG8_WAIT_L(0); PG8_MMA(0, 1, At, B1); PG8_BAR;
            PG8_LDA(At, 1, 1); PG8_STAGE(PG8_SA(1, 0), a3, voffA);
            PG8_BAR; PG8_WAIT_L(0); PG8_MMA(1, 0, At, B0); PG8_BAR; PG8_SCHED;
            PG8_STAGE(PG8_SB(1, 1), b3 + hstep, voffB);
            PG8_WAIT_V(6); PG8_BAR; PG8_MMA(1, 1, At, B1); PG8_BAR;
        }
        E(acc, cur, wr, wc, fr, fq);
        if (!has_next) break;
#pragma unroll
        for (int a = 0; a < 2; ++a)
#pragma unroll
            for (int b = 0; b < 2; ++b)
#pragma unroll
                for (int m = 0; m < 4; ++m)
#pragma unroll
                    for (int n = 0; n < 2; ++n) acc[a][b][m][n] = (f32x4){0.f, 0.f, 0.f, 0.f};
        cur = nxt; cA = nA; cB = nB; ++ui;
    }
    PG8_WAIT_V(0);
    if (wr == 0) PG8_BAR;
    PG8_BAR;
#undef PG8_SA
#undef PG8_SB
#undef PG8_STAGE
#undef PG8_LDA
#undef PG8_LDB
#undef PG8_MMA
#undef PG8_WAIT_V
#undef PG8_WAIT_L
#undef PG8_BAR
#undef PG8_SCHED
}
template <class Epi, class Sched>
__device__ __forceinline__ void gemm_phase_gather(LAS unsigned char* lds, const Gemm g, const Sched& S, const Epi& E, const int* __restrict__ srow) {
    const int tid = my_tid(), wid = __builtin_amdgcn_readfirstlane(tid >> 6), lane = tid & 63, wr = wid >> 2, wc = wid & 3, fr = lane & 15, fq = lane >> 4;
    const int K = g.K, nt = K / BK;
    unsigned voffB[2];
#pragma unroll
    for (int i = 0; i < 2; ++i) { int R, C; stage_rc(tid * 16 + i * 8192, R, C); const int Rb = Epi::PERM ? ((R & ~31) + perm32(R & 31)) : R;
        voffB[i] = (unsigned)(Rb * K + C) * 2u; }
    unsigned gcur[2][2], gnxt[2][2];
#define PG8_LOADG(dst, u) do { const int _t = my_tid(); _Pragma("unroll") for (int _i = 0; _i < 2; ++_i) { int _R, _C; stage_rc(_t * 16 + _i * 8192, _R, _C); _Pragma("unroll") for (int _h = 0; _h < 2; ++_h) \
        dst[_h][_i] = (unsigned)srow[(u).pm * 256 + 128 * _h + _R] * (unsigned)(K * 2) + (unsigned)_C * 2u; } } while (0)
#define PG8_STAGEG(bufoff, gofs, kbyte) do { _Pragma("unroll") for (int _i = 0; _i < 2; ++_i) \
        __builtin_amdgcn_global_load_lds((const unsigned*)((const char*)g.A + (gofs)[_i] + (kbyte)), (LAS unsigned*)(lds + (bufoff) + ldsw + _i * 8192), 16, 0, 0); } while (0)
    const size_t kstep = (size_t)(BK * 2);
    const size_t hstep = (size_t)HALF * K * 2;
    const size_t tstep = 2 * hstep;
    const unsigned ldsw = (unsigned)wid * 1024u;
    const int aoff = lds_byte(wr * 64 + fr, fq * 8), boff = lds_byte(wc * 32 + fr, fq * 8);
#define PG8_SA(b, h) (((b) * 2 + (h)) * HTB)
#define PG8_SB(b, h) ((4 + (b) * 2 + (h)) * HTB)
#define PG8_STAGE(bufoff, gbase, voff) do { _Pragma("unroll") for (int _i = 0; _i < 2; ++_i) \
        __builtin_amdgcn_global_load_lds((const unsigned*)((const char*)(gbase) + (voff)[_i]), (LAS unsigned*)(lds + (bufoff) + ldsw + _i * 8192), 16, 0, 0); } while (0)
#define PG8_LDA(dst, b, h) do { _Pragma("unroll") for (int m = 0; m < 4; ++m) _Pragma("unroll") for (int k = 0; k < 2; ++k) dst[m][k] = *(const LAS bf16x8*)(lds + PG8_SA(b, h) + aoff + m * 2048 + k * 1024); } while (0)
#define PG8_LDB(dst, b, h) do { _Pragma("unroll") for (int n = 0; n < 2; ++n) _Pragma("unroll") for (int k = 0; k < 2; ++k) dst[n][k] = *(const LAS bf16x8*)(lds + PG8_SB(b, h) + boff + n * 2048 + k * 1024); } while (0)
#define PG8_MMA(ai, bj, At, Bt) do { __builtin_amdgcn_s_setprio(1); _Pragma("unroll") for (int m = 0; m < 4; ++m) _Pragma("unroll") for (int n = 0; n < 2; ++n) _Pragma("unroll") for (int k = 0; k < 2; ++k) \
        acc[ai][bj][m][n] = __builtin_amdgcn_mfma_f32_16x16x32_bf16(Bt[n][k], At[m][k], acc[ai][bj][m][n], 0, 0, 0); __builtin_amdgcn_s_setprio(0); } while (0)
#define PG8_WAIT_V(n) asm volatile("s_waitcnt vmcnt(" #n ")" ::: "memory")
#define PG8_WAIT_L(n) asm volatile("s_waitcnt lgkmcnt(" #n ")" ::: "memory")
#define PG8_BAR __builtin_amdgcn_s_barrier()
#define PG8_SCHED __builtin_amdgcn_sched_barrier(0)
    Unit cur, nxt; int ui = 0;
    if (!S.next(0, cur)) return;
    f32x4 acc[2][2][4][2];
#pragma unroll
    for (int a = 0; a < 2; ++a)
#pragma unroll
        for (int b = 0; b < 2; ++b)
#pragma unroll
            for (int m = 0; m < 4; ++m)
#pragma unroll
                for (int n = 0; n < 2; ++n) acc[a][b][m][n] = (f32x4){0.f, 0.f, 0.f, 0.f};
    bf16x8 At[4][2], B0[2][2], B1[2][2];
    const char* cB = (const char*)g.Bt + (size_t)cur.pn * tstep;
    PG8_LOADG(gcur, cur);
    PG8_STAGE(PG8_SB(0, 0), cB, voffB); PG8_STAGEG(PG8_SA(0, 0), gcur[0], 0); PG8_STAGE(PG8_SB(0, 1), cB + hstep, voffB); PG8_STAGEG(PG8_SA(0, 1), gcur[1], 0);
    if (wr == 1) PG8_BAR;
    PG8_WAIT_V(4); PG8_BAR;
    PG8_STAGE(PG8_SB(1, 0), cB + kstep, voffB); PG8_STAGEG(PG8_SA(1, 0), gcur[0], kstep); PG8_STAGE(PG8_SB(1, 1), cB + hstep + kstep, voffB);
    PG8_WAIT_V(6); PG8_BAR;
    for (;;) {
        const bool has_next = S.next(ui + 1, nxt);
        const char* nB = has_next ? (const char*)g.Bt + (size_t)nxt.pn * tstep : cB;
        if (has_next) PG8_LOADG(gnxt, nxt); else { gnxt[0][0] = gcur[0][0]; gnxt[0][1] = gcur[0][1]; gnxt[1][0] = gcur[1][0]; gnxt[1][1] = gcur[1][1]; }
        for (int t = 0; t < nt; t += 2) {
            const bool last = (t == nt - 2);
            const size_t k1 = (size_t)(t + 1) * kstep, k2 = last ? 0 : (size_t)(t + 2) * kstep, k3 = k2 + kstep;
            const char* b2 = last ? nB : cB + (size_t)(t + 2) * kstep; const char* b3 = b2 + kstep;
            unsigned g0[2], g1[2];
            g0[0] = last ? gnxt[0][0] : gcur[0][0]; g0[1] = last ? gnxt[0][1] : gcur[0][1]; g1[0] = last ? gnxt[1][0] : gcur[1][0]; g1[1] = last ? gnxt[1][1] : gcur[1][1];
            PG8_LDB(B0, 0, 0); PG8_SCHED; PG8_LDA(At, 0, 0); PG8_STAGEG(PG8_SA(1, 1), gcur[1], k1);
            PG8_WAIT_L(8); PG8_BAR; PG8_WAIT_L(0); PG8_MMA(0, 0, At, B0); PG8_BAR; PG8_SCHED;
            PG8_LDB(B1, 0, 1); PG8_STAGE(PG8_SB(0, 0), b2, voffB);
            PG8_BAR; PG8_WAIT_L(0); PG8_MMA(0, 1, At, B1); PG8_BAR;
            PG8_LDA(At, 0, 1); PG8_STAGEG(PG8_SA(0, 0), g0, k2);
            PG8_BAR; PG8_WAIT_L(0); PG8_MMA(1, 0, At, B0); PG8_BAR; PG8_SCHED;
            PG8_STAGE(PG8_SB(0, 1), b2 + hstep, voffB);
            PG8_WAIT_V(6); PG8_BAR; PG8_MMA(1, 1, At, B1); PG8_BAR;
            PG8_LDB(B0, 1, 0); PG8_SCHED; PG8_LDA(At, 1, 0); PG8_STAGEG(PG8_SA(0, 1), g1, k2);
            PG8_WAIT_L(8); PG8_BAR; PG8_WAIT_L(0); PG8_MMA(0, 0, At, B0); PG8_BAR; PG8_SCHED;
            PG8_LDB(B1, 1, 1); PG8_STAGE(PG8_SB(1, 0), b3, voffB);
            PG8_BAR; PG8_WAIT_L(0); PG8_MMA(0, 1, At, B1); PG8_BAR;
            PG8_LDA(At, 1, 1); PG8_STAGEG(PG8_SA(1, 0), g0, k3);
            PG8_BAR; PG8_WAIT_L(0); PG8_MMA(1, 0, At, B0); PG8_BAR; PG8_SCHED;
            PG8_STAGE(PG8_SB(1, 1), b3 + hstep, voffB);
            PG8_WAIT_V(6); PG8_BAR; PG8_MMA(1, 1, At, B1); PG8_BAR;
        }
        E(acc, cur, wr, wc, fr, fq);
        if (!has_next) break;
#pragma unroll
        for (int a = 0; a < 2; ++a)
#pragma unroll
            for (int b = 0; b < 2; ++b)
#pragma unroll
                for (int m = 0; m < 4; ++m)
#pragma unroll
                    for (int n = 0; n < 2; ++n) acc[a][b][m][n] = (f32x4){0.f, 0.f, 0.f, 0.f};
        cur = nxt; cB = nB; ++ui;
        gcur[0][0] = gnxt[0][0]; gcur[0][1] = gnxt[0][1]; gcur[1][0] = gnxt[1][0]; gcur[1][1] = gnxt[1][1];
    }
    PG8_WAIT_V(0);
    if (wr == 0) PG8_BAR;
    PG8_BAR;
#undef PG8_LOADG
#undef PG8_STAGEG
#undef PG8_SA
#undef PG8_SB
#undef PG8_STAGE
#undef PG8_LDA
#undef PG8_LDB
#undef PG8_MMA
#undef PG8_WAIT_V
#undef PG8_WAIT_L
#undef PG8_BAR
#undef PG8_SCHED
}
}
using pg8::Unit;
struct InProjOrder { int G, c;
    __device__ __forceinline__ bool next(int i, Unit& u) const {
        const int L = i * G + c; if (L >= 3264) return false;
        int pm, pn;
        if (L < 2448) { pg8::static_unit(L, 272, 9, pm, pn); u.pm = pm; u.pn = 272 + pn; }
        else { pg8::static_unit(L - 2448, 3, 272, pm, pn); u.pm = 281 + pm; u.pn = pn; }
        return true; } };
struct OutProjOrder { int G, c, nM;
    __device__ __forceinline__ bool next(int i, Unit& u) const {
        const int L = i * G + c; if (L >= nM * 4) return false;
        pg8::static_unit(L, nM, 4, u.pm, u.pn); return true; } };
struct GateUpOrder { int G, c, nM;
    __device__ __forceinline__ bool next(int i, Unit& u) const {
        const int per = nM * 8; const int L = i * G + c; if (L >= 16 * per) return false;
        const int e = L / per; int pm, pn; pg8::static_unit(L - e * per, nM, 8, pm, pn); u.pm = e * 34 + pm; u.pn = e * 8 + pn; return true; } };
struct DownOrder { int G, c, nM;
    __device__ __forceinline__ bool next(int i, Unit& u) const {
        const int per = nM * 4; const int L = i * G + c; if (L >= 16 * per) return false;
        const int e = L / per; int pm, pn; pg8::static_unit(L - e * per, nM, 4, pm, pn); u.pm = e * 34 + pm; u.pn = e * 4 + pn; return true; } };

struct EpiInProj { static constexpr bool PERM = true; bf16_t* P; bf16_t* UT; const float* dqn; const float* dkn; const float2* ropeD;
    __device__ __forceinline__ void operator()(const f32x4 (&acc)[2][2][4][2], const Unit& u, int wr, int wc, int fr, int fq) const {
        bf16_t* base; int ldc, rt, ct;
        if (u.pn >= 272) { base = P; ldc = PW; rt = u.pm; ct = u.pn - 272; } else { base = UT; ldc = NROW; rt = u.pm - 281; ct = u.pn; }
        const int row0 = rt * 256 + wr * 64 + fr, col0 = ct * 256 + wc * 32 + 8 * fq;
        if (u.pn >= 272 && (ct == 6 || ct == 7)) {
            const float* gnp = (ct == 6 ? dqn : dkn) + 8 * fq;
            const float4 ga = *(const float4*)gnp, gb = *(const float4*)(gnp + 4);
            const float gn[8] = {ga.x, ga.y, ga.z, ga.w, gb.x, gb.y, gb.z, gb.w};
            const float qs = ct == 6 ? 0.17677669529663687f * LOG2E : 1.0f;
            const bool hi = (fq & 1) != 0;
#pragma unroll
            for (int ai = 0; ai < 2; ++ai)
#pragma unroll
                for (int m = 0; m < 4; ++m) { const int row = row0 + ai * 128 + m * 16; const bool lat = row < NROWL; const int t = row & 4095;
                    const int pos = (fq >> 1) == 0 ? (t >> 6) : (t & 63);
                    const float4* rp = (const float4*)(ropeD + pos * 8);
                    const float4 r0 = rp[0], r1 = rp[1], r2 = rp[2], r3 = rp[3];
                    const float cs[8] = {r0.x, r0.z, r1.x, r1.z, r2.x, r2.z, r3.x, r3.z}, sn[8] = {r0.y, r0.w, r1.y, r1.w, r2.y, r2.w, r3.y, r3.w};
                    bf16_t* rowp = base + (size_t)row * ldc + col0;
#pragma unroll
                    for (int bj = 0; bj < 2; ++bj) { const f32x4 v0 = acc[ai][bj][m][0], v1 = acc[ai][bj][m][1];
                        float x[8] = {v0[0], v0[1], v0[2], v0[3], v1[0], v1[1], v1[2], v1[3]};
                        float ss = 0.f;
#pragma unroll
                        for (int i = 0; i < 8; ++i) ss += x[i] * x[i];
                        ss += __shfl_xor(ss, 16); ss += __shfl_xor(ss, 32);
                        const float inv = rsqrtf(ss * (1.0f / 32.0f) + EPSF);
                        float o[8];
#pragma unroll
                        for (int i = 0; i < 8; ++i) { const float y = x[i] * inv * gn[i]; const float pr = __shfl_xor(y, 16);
                            o[i] = (lat ? (hi ? y * cs[i] + pr * sn[i] : y * cs[i] - pr * sn[i]) : y) * qs; }
                        u32x4 w; w.x = pg8::cvt_pk_bf16(o[0], o[1]); w.y = pg8::cvt_pk_bf16(o[2], o[3]); w.z = pg8::cvt_pk_bf16(o[4], o[5]); w.w = pg8::cvt_pk_bf16(o[6], o[7]);
                        *(u32x4*)(rowp + bj * 128) = w; } }
            return;
        }
#pragma unroll
        for (int ai = 0; ai < 2; ++ai)
#pragma unroll
            for (int m = 0; m < 4; ++m) { bf16_t* rowp = base + (size_t)(row0 + ai * 128 + m * 16) * ldc + col0;
#pragma unroll
                for (int bj = 0; bj < 2; ++bj) { const f32x4 v0 = acc[ai][bj][m][0], v1 = acc[ai][bj][m][1];
                    u32x4 w; w.x = pg8::cvt_pk_bf16(v0[0], v0[1]); w.y = pg8::cvt_pk_bf16(v0[2], v0[3]); w.z = pg8::cvt_pk_bf16(v1[0], v1[1]); w.w = pg8::cvt_pk_bf16(v1[2], v1[3]);
                    *(u32x4*)(rowp + bj * 128) = w; } }
    } };
__device__ __forceinline__ float silu_mul(float g, float u) { return g * u * __builtin_amdgcn_rcpf(1.0f + fast_exp2(-g * LOG2E)); }
struct EpiGU { static constexpr bool PERM = true; bf16_t* HID;
    __device__ __forceinline__ void operator()(const f32x4 (&acc)[2][2][4][2], const Unit& u, int wr, int wc, int fr, int fq) const {
        const int row0 = u.pm * 256 + wr * 64 + fr, col0 = (u.pn & 7) * 128 + wc * 32 + 8 * fq;
#pragma unroll
        for (int ai = 0; ai < 2; ++ai)
#pragma unroll
            for (int m = 0; m < 4; ++m) { bf16_t* rowp = HID + (size_t)(row0 + ai * 128 + m * 16) * DM + col0;
                const f32x4 g0 = acc[ai][0][m][0], g1 = acc[ai][0][m][1], u0 = acc[ai][1][m][0], u1 = acc[ai][1][m][1];
                u32x4 w; w.x = pg8::cvt_pk_bf16(silu_mul(g0[0], u0[0]), silu_mul(g0[1], u0[1])); w.y = pg8::cvt_pk_bf16(silu_mul(g0[2], u0[2]), silu_mul(g0[3], u0[3]));
                w.z = pg8::cvt_pk_bf16(silu_mul(g1[0], u1[0]), silu_mul(g1[1], u1[1])); w.w = pg8::cvt_pk_bf16(silu_mul(g1[2], u1[2]), silu_mul(g1[3], u1[3]));
                *(u32x4*)rowp = w; }
    } };
struct EpiDown { static constexpr bool PERM = true; bf16_t* Y; const float* sgate;
    __device__ __forceinline__ void operator()(const f32x4 (&acc)[2][2][4][2], const Unit& u, int wr, int wc, int fr, int fq) const {
        const int row0 = u.pm * 256 + wr * 64 + fr, col0 = (u.pn & 3) * 256 + wc * 32 + 8 * fq;
#pragma unroll
        for (int ai = 0; ai < 2; ++ai)
#pragma unroll
            for (int m = 0; m < 4; ++m) { const int r = row0 + ai * 128 + m * 16; const float gt = sgate[r]; bf16_t* rowp = Y + (size_t)r * DM + col0;
#pragma unroll
                for (int bj = 0; bj < 2; ++bj) { const f32x4 v0 = acc[ai][bj][m][0] * gt, v1 = acc[ai][bj][m][1] * gt;
                    u32x4 w; w.x = pg8::cvt_pk_bf16(v0[0], v0[1]); w.y = pg8::cvt_pk_bf16(v0[2], v0[3]); w.z = pg8::cvt_pk_bf16(v1[0], v1[1]); w.w = pg8::cvt_pk_bf16(v1[2], v1[3]);
                    *(u32x4*)(rowp + bj * 128) = w; } }
    } };
struct EpiOut { static constexpr bool PERM = true; const float* srcL; const float* srcC; bf16_t* XB; const float* MOD; int first;
    __device__ __forceinline__ void operator()(const f32x4 (&acc)[2][2][4][2], const Unit& u, int wr, int wc, int fr, int fq) const {
        const float* gt = MOD + (size_t)(u.pm < 256 ? (u.pm >> 4) : 16) * 6144 + 2048;
        const int row0 = u.pm * 256 + wr * 64 + fr, col0 = u.pn * 256 + wc * 32 + 8 * fq;
        f32x4 gv[2][2];
#pragma unroll
        for (int bj = 0; bj < 2; ++bj)
#pragma unroll
            for (int n = 0; n < 2; ++n) gv[bj][n] = *(const f32x4*)(gt + col0 + bj * 128 + n * 4);
#pragma unroll
        for (int ai = 0; ai < 2; ++ai)
#pragma unroll
            for (int m = 0; m < 4; ++m) { const int row = row0 + ai * 128 + m * 16;
                bf16_t* xrow = XB + (size_t)row * DM + col0;
                const float* frow = (row < NROWL ? srcL + (size_t)row * DM : srcC + (size_t)(row - NROWL) * DM) + col0;
#pragma unroll
                for (int bj = 0; bj < 2; ++bj) {
                    f32x4 s0, s1;
                    if (first) { s0 = *(const f32x4*)(frow + bj * 128); s1 = *(const f32x4*)(frow + bj * 128 + 4); }
                    else { const u32x4 raw = *(const u32x4*)(xrow + bj * 128);
                        s0 = (f32x4){bflo(raw.x), bfhi(raw.x), bflo(raw.y), bfhi(raw.y)}; s1 = (f32x4){bflo(raw.z), bfhi(raw.z), bflo(raw.w), bfhi(raw.w)}; }
                    const f32x4 v0 = s0 + gv[bj][0] * acc[ai][bj][m][0], v1 = s1 + gv[bj][1] * acc[ai][bj][m][1];
                    u32x4 w; w.x = pg8::cvt_pk_bf16(v0[0], v0[1]); w.y = pg8::cvt_pk_bf16(v0[2], v0[3]); w.z = pg8::cvt_pk_bf16(v1[0], v1[1]); w.w = pg8::cvt_pk_bf16(v1[2], v1[3]);
                    *(u32x4*)(xrow + bj * 128) = w; } }
    } };

__device__ __forceinline__ f32x16 mma32(const bf16_t* A, int lda, const bf16_t* Bt, int ldb, int K, f32x16 acc, int lane) {
    const int r = lane & 31, h = lane >> 5;
    const bf16_t* ap = A + r * lda + 8 * h; const bf16_t* bp = Bt + r * ldb + 8 * h;
    for (int k = 0; k < K; k += 16) {
        const bf16x8 a = *(const bf16x8*)(ap + k); const bf16x8 b = *(const bf16x8*)(bp + k);
        acc = __builtin_amdgcn_mfma_f32_32x32x16_bf16(a, b, acc, 0, 0, 0);
    }
    return acc;
}
#define CROW(reg, lane) (((reg) & 3) + 8 * ((reg) >> 2) + 4 * ((lane) >> 5))
typedef short v4i16_t __attribute__((ext_vector_type(4)));
__device__ __forceinline__ s16x4 tr_read(const LAS unsigned char* ptr) { return __builtin_bit_cast(s16x4, __builtin_amdgcn_ds_read_tr16_b64_v4i16((LAS v4i16_t*)ptr)); }
struct TrDesc { const float* src; bf16_t* dst; int src_ld, src_col0, k0, n0; };
__device__ __forceinline__ void tr_load(const TrDesc& d, int t, float4 (&v)[2]) {
#pragma unroll
    for (int p = 0; p < 2; ++p) { const int j = (t >> 4) + 32 * p; v[p] = *(const float4*)(d.src + (size_t)(d.k0 + j) * d.src_ld + d.src_col0 + (t & 15) * 4); }
}
__device__ __forceinline__ void tr_store(unsigned char* smem, const TrDesc& d, int t, const float4 (&v)[2]) {
    float* tile = (float*)smem;
#pragma unroll
    for (int p = 0; p < 2; ++p) { const int j = (t >> 4) + 32 * p; float* q = tile + j * 65 + (t & 15) * 4; q[0] = v[p].x; q[1] = v[p].y; q[2] = v[p].z; q[3] = v[p].w; }
    __syncthreads();
    { const int i = t >> 3, kc = (t & 7) * 8;
      u32x4 w;
      w.x = pack_bf16(tile[(kc + 0) * 65 + i], tile[(kc + 1) * 65 + i]); w.y = pack_bf16(tile[(kc + 2) * 65 + i], tile[(kc + 3) * 65 + i]);
      w.z = pack_bf16(tile[(kc + 4) * 65 + i], tile[(kc + 5) * 65 + i]); w.w = pack_bf16(tile[(kc + 6) * 65 + i], tile[(kc + 7) * 65 + i]);
      *(u32x4*)(d.dst + (size_t)(d.n0 + i) * DM + d.k0 + kc) = w; }
    __syncthreads();
}

template <int PART>
__device__ __forceinline__ void phase_W(const Params& p, int l, unsigned char* smem) {
    unsigned char* ws = launder_ws(p.ws);
    const int tid = my_tid(), G = gridDim.x, bid = blockIdx.x;
    if (PART == 0 && bid == 0) {
        float2* rA = (float2*)(ws + WS_ROPE); float2* rD = rA + 64 * 16;
        for (int idx = tid; idx < 64 * 16; idx += NTHR) { const int pos = idx >> 4, f = idx & 15; const float inv = powf(10000.0f, -(float)f / 16.0f); float sn, cs; sincosf((float)pos * inv, &sn, &cs); rA[idx] = make_float2(cs, sn); }
        for (int idx = tid; idx < 64 * 8; idx += NTHR) { const int pos = idx >> 3, f = idx & 7; const float inv = powf(10000.0f, -(float)f / 8.0f); float sn, cs; sincosf((float)pos * inv, &sn, &cs); rD[idx] = make_float2(cs, sn); }
    }
    if (PART == 0) { int4* inv4 = (int4*)(ws + WS_INV); const int n4 = NROW * 16 / 4;
      for (int i = bid * NTHR + tid; i < n4; i += G * NTHR) inv4[i] = make_int4(-1, -1, -1, -1); }
    const float* w_in = PIN(I_WIN) + (size_t)l * DM * INW;
    const float* w_out = PIN(I_WOUT) + (size_t)l * DM * DM;
    const float* weg = PIN(I_WEG) + (size_t)l * NEXP * DM * DM;
    const float* weu = PIN(I_WEU) + (size_t)l * NEXP * DM * DM;
    const float* wed = PIN(I_WED) + (size_t)l * NEXP * DM * DM;
    bf16_t* WinT = (bf16_t*)(ws + WS_U) + (size_t)NROW * DM;
    bf16_t* WoutT = (bf16_t*)(ws + WS_WOUT);
    bf16_t* WguT = (bf16_t*)(ws + WS_WGU);
    bf16_t* WdT = (bf16_t*)(ws + WS_WD);
    const int N_IN = 768, N_OUT = 256, N_GU = 8192, N_D = 4096, N_ADA = 96, N_HID = 544;
    const int NCVT = N_IN + N_OUT + N_GU + N_D;
    auto tr_desc = [&](int x, TrDesc& d) {
        if (x < N_IN) { const int nt = x >> 4, kt = x & 15, n0 = nt * 64;
            int sc; if (n0 < 512) sc = n0; else if (n0 < 1536) sc = n0 + 768; else if (n0 < 2304) sc = n0 + 784; else sc = n0 - 1792;
            d.src = w_in; d.src_ld = INW; d.src_col0 = sc; d.k0 = kt * 64; d.dst = WinT; d.n0 = n0; return; }
        x -= N_IN;
        if (x < N_OUT) { const int nt = x >> 4, kt = x & 15; d.src = w_out; d.src_ld = DM; d.src_col0 = nt * 64; d.k0 = kt * 64; d.dst = WoutT; d.n0 = nt * 64; return; }
        x -= N_OUT;
        if (x < N_GU) { const int e = x >> 9, r = x & 511, nt = r >> 4, kt = r & 15, n0 = nt * 64;
            const int j = n0 >> 8, rr = n0 & 255;
            d.src = (rr < 128 ? weg : weu) + (size_t)e * DM * DM; d.src_ld = DM; d.src_col0 = j * 128 + (rr & 127); d.k0 = kt * 64; d.dst = WguT + (size_t)e * 2048 * DM; d.n0 = n0; return; }
        x -= N_GU;
        { const int e = x >> 8, r = x & 255, nt = r >> 4, kt = r & 15;
          d.src = wed + (size_t)e * DM * DM; d.src_ld = DM; d.src_col0 = nt * 64; d.k0 = kt * 64; d.dst = WdT + (size_t)e * DM * DM; d.n0 = nt * 64; }
    };
    if (PART != 2) {
        TrDesc cur, nxt; float4 va[2], vb[2];
        if (bid < NCVT) { tr_desc(bid, cur); tr_load(cur, tid, va); }
        for (int it = bid; it < NCVT; it += G) {
            const bool more = it + G < NCVT;
            if (more) { tr_desc(it + G, nxt); tr_load(nxt, tid, vb); }
            tr_store(smem, cur, tid, va);
            if (more) { cur = nxt; va[0] = vb[0]; va[1] = vb[1]; }
        }
    }
    const int total = (PART == 1) ? 0 : (N_ADA + N_HID);
    for (int it = bid; it < total; it += G) {
        int x = it;
        if (x < N_ADA) {
            const int n0 = x * 64;
            float* sv = (float*)smem;
            float* red = sv + 17 * 1024;
            const float* c = PIN(I_C); const float* cc = PIN(I_CCTX);
            for (int idx = tid; idx < 17 * 1024; idx += NTHR) { const int r = idx >> 10, k = idx & 1023; const float v = r < 16 ? c[r * 1024 + k] : cc[k]; sv[idx] = v / (1.0f + expf(-v)); }
            __syncthreads();
            const int w = tid >> 6, lane = tid & 63;
            float acc[17];
#pragma unroll
            for (int r = 0; r < 17; ++r) acc[r] = 0.f;
            const float* wa = PIN(I_WADA) + (size_t)l * DM * 6144 + n0 + lane;
#pragma unroll 2
            for (int k = 128 * w; k < 128 * w + 128; ++k) { const float wv = wa[(size_t)k * 6144];
#pragma unroll
                for (int r = 0; r < 17; ++r) acc[r] += sv[r * 1024 + k] * wv; }
#pragma unroll
            for (int r = 0; r < 17; ++r) red[(w * 17 + r) * 64 + lane] = acc[r];
            __syncthreads();
            float* MOD = (float*)(ws + WS_MOD + (size_t)(l & 1) * MOD_BYTES); const float* ba = PIN(I_BADA) + (size_t)l * 6144;
            for (int idx = tid; idx < 17 * 64; idx += NTHR) { const int r = idx >> 6, j = idx & 63; float s = ba[n0 + j];
#pragma unroll
                for (int ww = 0; ww < 8; ++ww) s += red[(ww * 17 + r) * 64 + j];
                MOD[(size_t)r * 6144 + n0 + j] = s; }
            __syncthreads();
            continue; }
        x -= N_ADA;
        {
            const bool isc = x >= 512; const int L = isc ? 256 : 4096; const int lagbase = (isc ? x - 512 : x) * 8;
            float* zf = (float*)smem;
            float* h1s = zf + 8 * 36;
            const int li = tid >> 6, j = tid & 63, lag = lagbase + li;
            if (j < 33) { float v;
                if (j == 0) v = (float)lag / (float)(L - 1);
                else { const int bi = (j - 1) & 15; const float band = 1e-4f + (float)bi * ((15.0f - 1e-4f) / 15.0f); const float w = 6.283185307179586f * (float)lag / (float)L; const float a = band * w;
                       v = (j <= 16) ? cosf(a) : -sinf(a); }
                zf[li * 36 + j] = v; }
            __syncthreads();
            const float* fw1 = PIN(I_FW1) + (size_t)l * 33 * 64; const float* fb1 = PIN(I_FB1) + l * 64; const float* fr = PIN(I_FREQ) + l * 64;
            const float* fw2 = PIN(I_FW2) + (size_t)l * 64 * 64; const float* fb2 = PIN(I_FB2) + l * 64;
            float a = fb1[j];
#pragma unroll 3
            for (int i = 0; i < 33; ++i) a += zf[li * 36 + i] * fw1[i * 64 + j];
            h1s[li * 64 + j] = sinf(fr[j] * a);
            __syncthreads();
            float a2 = fb2[j];
#pragma unroll 4
            for (int i = 0; i < 64; ++i) a2 += h1s[li * 64 + i] * fw2[i * 64 + j];
            float* H2 = (float*)(ws + (isc ? WS_HID2C : WS_HID2L));
            H2[(size_t)lag * 64 + j] = sinf(fr[j] * a2);
            __syncthreads();
        }
    }
}

template <int WHICH>
__device__ __forceinline__ void phase_norm(const Params& p, int l, unsigned char* smem) {
    unsigned char* ws = launder_ws(p.ws);
    const int tid = my_tid(), lane = tid & 63, wave = tid >> 6;
    float* Wg = (float*)smem;
    for (int idx = tid; idx < 16384; idx += NTHR) { const int k = idx >> 4, j = idx & 15;
        Wg[j * 1024 + k] = (WHICH == 1) ? PIN(I_WIN)[(size_t)l * DM * INW + (size_t)k * INW + 2304 + j] : PIN(I_WROUTER)[(size_t)l * DM * 16 + k * 16 + j]; }
    __syncthreads();
    const float* gain = PIN(WHICH == 1 ? I_N1G : I_N2G) + (size_t)l * DM;
    const float* MOD = (const float*)(ws + WS_MOD + (size_t)(l & 1) * MOD_BYTES);
    bf16_t* U = (bf16_t*)(ws + WS_U);
    float* outv = (float*)(ws + (WHICH == 1 ? WS_GATES : WS_AFF));
    const float* xl = PIN(I_X); const float* xc = PIN(I_CTX);
    const bf16_t* XB = (const bf16_t*)(ws + WS_XB);
    const int rstride = gridDim.x * 8;
    const int nrows = (WHICH == 2 && l == DEPTH - 1) ? NROWL : NROW;
#define NM_LOAD(dst, r) do { if (WHICH == 1) { const float* s_ = (r) < NROWL ? xl + (size_t)(r) * DM : xc + (size_t)((r) - NROWL) * DM; \
            _Pragma("unroll") for (int i = 0; i < 4; ++i) dst[i] = *(const float4*)(s_ + 256 * i + 4 * lane); } \
        else { const bf16_t* s_ = XB + (size_t)(r) * DM; \
            _Pragma("unroll") for (int i = 0; i < 4; ++i) { const u32x2 w_ = *(const u32x2*)(s_ + 256 * i + 4 * lane); dst[i] = make_float4(bflo(w_.x), bfhi(w_.x), bflo(w_.y), bfhi(w_.y)); } } } while (0)
    float4 cur[4];
    { const int row = blockIdx.x * 8 + wave; NM_LOAD(cur, row); }
    for (int row = blockIdx.x * 8 + wave; row < nrows; row += rstride) {
        float4 nxt[4];
        { const int r2 = row + rstride < nrows ? row + rstride : row; NM_LOAD(nxt, r2); }
        const float* mod = MOD + (size_t)(row < NROWL ? (row >> 12) : 16) * 6144 + (WHICH == 1 ? 0 : 3072);
        float ss = 0.f;
#pragma unroll
        for (int i = 0; i < 4; ++i) ss += cur[i].x * cur[i].x + cur[i].y * cur[i].y + cur[i].z * cur[i].z + cur[i].w * cur[i].w;
        ss = wave_sum(ss);
        const float inv = rsqrtf(ss * (1.0f / 1024.0f) + EPSF);
        float part[16];
#pragma unroll
        for (int j = 0; j < 16; ++j) part[j] = 0.f;
#pragma unroll
        for (int i = 0; i < 4; ++i) { const int k = 256 * i + 4 * lane;
            const float4 v = cur[i];
            const float4 g = *(const float4*)(gain + k), sh = *(const float4*)(mod + k), sc = *(const float4*)(mod + 1024 + k);
            float4 h; h.x = v.x * inv * g.x * (1.f + sc.x) + sh.x; h.y = v.y * inv * g.y * (1.f + sc.y) + sh.y; h.z = v.z * inv * g.z * (1.f + sc.z) + sh.z; h.w = v.w * inv * g.w * (1.f + sc.w) + sh.w;
            u32x2 w; w.x = pack_bf16(h.x, h.y); w.y = pack_bf16(h.z, h.w);
            *(u32x2*)(U + (size_t)row * DM + k) = w;
#pragma unroll
            for (int j = 0; j < 16; ++j) { const float4 wv = *(const float4*)(Wg + j * 1024 + k); part[j] += h.x * wv.x + h.y * wv.y + h.z * wv.z + h.w * wv.w; }
            asm volatile("" ::: "memory"); }
#pragma unroll
        for (int i = 0; i < 4; ++i) cur[i] = nxt[i];
        float v1 = reduce16_transpose(part, lane);
        const int jx = ((lane >> 5) & 1) * 8 + ((lane >> 4) & 1) * 4 + ((lane >> 3) & 1) * 2 + ((lane >> 2) & 1);
        float val = v1;
        if (WHICH == 2) { const float mx = wave_max(v1); const float e = expf(v1 - mx); const float sum = wave_sum(e) * 0.25f; val = e / sum; }
        if ((lane & 3) == 0) outv[(size_t)row * 16 + jx] = val;
    }
    __syncthreads();
}

__device__ __forceinline__ void phase_prep(const Params& p, int l, unsigned char* smem) {
    unsigned char* ws = launder_ws(p.ws);
    const int tid = my_tid(), lane = tid & 63, wave = tid >> 6;
    float2* ropeA = (float2*)smem;
    float2* ropeD = ropeA + 64 * 16;
    for (int idx = tid; idx < 64 * 16; idx += NTHR) { const int pos = idx >> 4, f = idx & 15; const float inv = powf(10000.0f, -(float)f / 16.0f); float s, c; sincosf((float)pos * inv, &s, &c); ropeA[idx] = make_float2(c, s); }
    for (int idx = tid; idx < 64 * 8; idx += NTHR) { const int pos = idx >> 3, f = idx & 7; const float inv = powf(10000.0f, -(float)f / 8.0f); float s, c; sincosf((float)pos * inv, &s, &c); ropeD[idx] = make_float2(c, s); }
    __syncthreads();
    bf16_t* P = (bf16_t*)(ws + WS_P);
    const float* aqn = PIN(I_AQN) + l * 64; const float* akn = PIN(I_AKN) + l * 64;
    const float* dqn = PIN(I_DQN) + l * 32; const float* dkn = PIN(I_DKN) + l * 32;
    const int rstride = gridDim.x * 8;
    const int vecA = min(lane >> 3, 5), chA = lane & 7;
    u32x4 rawA;
    { const int row = blockIdx.x * 8 + wave; const bf16_t* pr = P + (size_t)row * PW; rawA = *(const u32x4*)(pr + vecA * 64 + chA * 8); }
    for (int row = blockIdx.x * 8 + wave; row < NROW; row += rstride) {
        const bool lat = row < NROWL; const int t = row & 4095; const int prow = t >> 6, pcol = t & 63;
        bf16_t* pr = P + (size_t)row * PW;
        u32x4 nxtA;
        { const int r2 = row + rstride < NROW ? row + rstride : row; const bf16_t* p2 = P + (size_t)r2 * PW; nxtA = *(const u32x4*)(p2 + vecA * 64 + chA * 8); }
        {
            const int vec = vecA, ch = chA; const bool act = lane < 48;
            bf16_t* ptr = pr + vec * 64 + ch * 8;
            const u32x4 raw = rawA;
            float x[8]; x[0] = bflo(raw.x); x[1] = bfhi(raw.x); x[2] = bflo(raw.y); x[3] = bfhi(raw.y); x[4] = bflo(raw.z); x[5] = bfhi(raw.z); x[6] = bflo(raw.w); x[7] = bfhi(raw.w);
            float ss = 0.f;
#pragma unroll
            for (int i = 0; i < 8; ++i) ss += x[i] * x[i];
            ss += __shfl_xor(ss, 1); ss += __shfl_xor(ss, 2); ss += __shfl_xor(ss, 4);
            const float inv = rsqrtf(ss * (1.0f / 64.0f) + EPSF);
            const float* gn = (vec < 4 ? aqn : akn) + ch * 8;
            const float qs = vec < 4 ? 0.125f * LOG2E : 1.0f;
            const int axis = ch >> 2, half = (ch >> 1) & 1; const int pos = axis == 0 ? prow : pcol;
            float o[8];
#pragma unroll
            for (int i = 0; i < 8; ++i) { const float y = x[i] * inv * gn[i]; const float pr2 = __shfl_xor(y, 2);
                if (lat) { const float2 cs = ropeA[pos * 16 + 8 * (ch & 1) + i]; o[i] = (half == 0 ? y * cs.x - pr2 * cs.y : y * cs.x + pr2 * cs.y) * qs; } else o[i] = y * qs; }
            if (act) { u32x4 w; w.x = pack_bf16(o[0], o[1]); w.y = pack_bf16(o[2], o[3]); w.z = pack_bf16(o[4], o[5]); w.w = pack_bf16(o[6], o[7]); *(u32x4*)ptr = w; }
        }
        rawA = nxtA;
    }
    __syncthreads();
}
__device__ __forceinline__ int block_excl_scan(int v, int* sbuf  , int& total) {
    const int tid = my_tid(), lane = tid & 63, wave = tid >> 6;
    int inc = v;
#pragma unroll
    for (int o = 1; o < 64; o <<= 1) { const int n = __shfl_up(inc, o); if (lane >= o) inc += n; }
    __syncthreads();
    if (lane == 63) sbuf[wave] = inc;
    __syncthreads();
    int pre = 0, tot = 0;
#pragma unroll
    for (int w = 0; w < 8; ++w) { const int s = sbuf[w]; if (w < wave) pre += s; tot += s; }
    total = tot;
    return pre + inc - v;
}

__device__ __forceinline__ void phase_topk(const Params& p, int l, unsigned char* smem) {
    unsigned char* ws = launder_ws(p.ws);
    const int tid = my_tid();
    unsigned* keys = (unsigned*)smem;
    int* hist = (int*)(keys + 4096);
    int* sb = hist + 256;
    int* ctl = sb + 16;
    const float* AFF = (const float*)(ws + WS_AFF);
    int* SROW = (int*)(ws + WS_SROW); float* SGATE = (float*)(ws + WS_SGATE); int* INV = (int*)(ws + WS_INV);
    const int nlists = (l == DEPTH - 1) ? 256 : 512;
    for (int it = blockIdx.x; it < nlists; it += gridDim.x) {
        const int kind = it >> 8, b = (it >> 4) & 15, e = it & 15;
        const int N = kind ? 256 : 4096, K = kind ? CAPC : CAPL;
        const int rowbase = kind ? NROWL + b * 256 : b * 4096;
        const int slotbase = e * SLOTS_E + (kind ? 8192 + b * CAPC : b * CAPL);
        for (int i = tid; i < N; i += NTHR) keys[i] = __float_as_uint(AFF[(size_t)(rowbase + i) * 16 + e]);
        unsigned prefix = 0, mask = 0; int need = K;
        for (int pass = 3; pass >= 0; --pass) {
            const int shift = 8 * pass;
            if (tid < 256) hist[tid] = 0;
            __syncthreads();
            for (int i = tid; i < N; i += NTHR) { const unsigned k = keys[i]; if ((k & mask) == prefix) atomicAdd(&hist[(k >> shift) & 255], 1); }
            __syncthreads();
            if (tid < 64) {
                const int b0 = 255 - 4 * tid; const int h0 = hist[b0], h1 = hist[b0 - 1], h2 = hist[b0 - 2], h3 = hist[b0 - 3];
                const int tot4 = h0 + h1 + h2 + h3; int inc = tot4;
#pragma unroll
                for (int o = 1; o < 64; o <<= 1) { const int n = __shfl_up(inc, o); if (tid >= o) inc += n; }
                const int exc = inc - tot4;
                const bool hit = (exc < need) && (inc >= need);
                if (hit) { int cum = exc, d = b0;
                    if (cum + h0 >= need) d = b0; else { cum += h0; if (cum + h1 >= need) d = b0 - 1; else { cum += h1; if (cum + h2 >= need) d = b0 - 2; else { cum += h2; d = b0 - 3; } } }
                    ctl[0] = d; ctl[1] = need - cum; } }
            __syncthreads();
            prefix |= (unsigned)ctl[0] << shift; mask |= 255u << shift; need = ctl[1];
            __syncthreads();
        }
        const unsigned T = prefix;
        int cg = 0, ce = 0; unsigned k8[8];
#pragma unroll
        for (int j = 0; j < 8; ++j) { const int i = tid * 8 + j; const unsigned k = (i < N) ? keys[i] : 0u; k8[j] = k; cg += (i < N && k > T) ? 1 : 0; ce += (i < N && k == T) ? 1 : 0; }
        int totg, tote;
        int pg = block_excl_scan(cg, sb, totg);
        int pe = block_excl_scan(ce, sb, tote);
#pragma unroll
        for (int j = 0; j < 8; ++j) { const int i = tid * 8 + j; if (i < N) { const unsigned k = k8[j]; int pos = -1;
                if (k > T) pos = pg++; else if (k == T) { if (pe < need) pos = totg + pe; ++pe; }
                if (pos >= 0) { const int s = slotbase + pos; const int row = rowbase + i; SROW[s] = row; SGATE[s] = __uint_as_float(k); INV[(size_t)row * 16 + e] = s; } } }
        __syncthreads();
    }
}

__device__ __forceinline__ void phase_gather(const Params& p) {
    unsigned char* ws = launder_ws(p.ws);
    const int lane = my_tid() & 63, wave = my_tid() >> 6;
    const int* SROW = (const int*)(ws + WS_SROW);
    const bf16_t* U = (const bf16_t*)(ws + WS_U); bf16_t* XE = (bf16_t*)(ws + WS_XE);
    for (int s = blockIdx.x * 8 + wave; s < NSLOT; s += gridDim.x * 8) {
        const int row = SROW[s];
        const u32x4* src = (const u32x4*)(U + (size_t)row * DM); u32x4* dst = (u32x4*)(XE + (size_t)s * DM);
        const u32x4 a = src[lane], b = src[64 + lane];
        dst[lane] = a; dst[64 + lane] = b;
    }
}

template <bool NEXT>
__device__ __forceinline__ void phase_combine(const Params& p, int l, unsigned char* smem) {
    unsigned char* ws = launder_ws(p.ws);
    const int tid = my_tid(), lane = tid & 63, wave = tid >> 6;
    int* INV = (int*)(ws + WS_INV);
    const bf16_t* YS = (const bf16_t*)(ws + WS_XE);
    const float* MODc = (const float*)(ws + WS_MOD + (size_t)(l & 1) * MOD_BYTES);
    const float* MODn = (const float*)(ws + WS_MOD + (size_t)((l + 1) & 1) * MOD_BYTES);
    float* Wg = (float*)smem;
    bf16_t* U = (bf16_t*)(ws + WS_U); float* GT = (float*)(ws + WS_GATES);
    const float* gain = PIN(I_N1G) + (size_t)(NEXT ? l + 1 : 0) * DM;
    if (NEXT) { for (int idx = tid; idx < 16384; idx += NTHR) { const int k = idx >> 4, j = idx & 15; Wg[j * 1024 + k] = PIN(I_WIN)[(size_t)(l + 1) * DM * INW + (size_t)k * INW + 2304 + j]; }
        __syncthreads(); }
    const int rstride = gridDim.x * 8;
    bf16_t* XB = (bf16_t*)(ws + WS_XB); float* outp = POUT();
    int myinv; u32x2 xc4[4];
    { const int row = blockIdx.x * 8 + wave; myinv = INV[(size_t)row * 16 + (lane & 15)];
#pragma unroll
      for (int i = 0; i < 4; ++i) xc4[i] = *(const u32x2*)(XB + (size_t)row * DM + 256 * i + 4 * lane); }
    const int nrows = NEXT ? NROW : NROWL;
    for (int row = blockIdx.x * 8 + wave; row < nrows; row += rstride) {
        int ninv; u32x2 xn4[4];
        { const int r2 = row + rstride < nrows ? row + rstride : row; ninv = INV[(size_t)r2 * 16 + (lane & 15)];
#pragma unroll
          for (int i = 0; i < 4; ++i) xn4[i] = *(const u32x2*)(XB + (size_t)r2 * DM + 256 * i + 4 * lane); }
        float acc[16];
#pragma unroll
        for (int j = 0; j < 16; ++j) acc[j] = 0.f;
        {
            unsigned msk = (unsigned)(__ballot(myinv >= 0 && lane < 16)) & 0xffffu;
            if (msk) {
                const int e0 = __ffs(msk) - 1; msk &= msk - 1;
                const int s0 = __shfl(myinv, e0);
                const bool two = msk != 0u; int s1 = s0;
                if (two) { const int e1 = __ffs(msk) - 1; msk &= msk - 1; s1 = __shfl(myinv, e1); }
                u32x2 w0[4], w1[4];
#pragma unroll
                for (int i = 0; i < 4; ++i) { w0[i] = *(const u32x2*)(YS + (size_t)s0 * DM + 256 * i + 4 * lane); w1[i] = *(const u32x2*)(YS + (size_t)s1 * DM + 256 * i + 4 * lane); }
                const float f1 = two ? 1.0f : 0.0f;
#pragma unroll
                for (int i = 0; i < 4; ++i) { acc[4 * i + 0] = bflo(w0[i].x) + f1 * bflo(w1[i].x); acc[4 * i + 1] = bfhi(w0[i].x) + f1 * bfhi(w1[i].x);
                    acc[4 * i + 2] = bflo(w0[i].y) + f1 * bflo(w1[i].y); acc[4 * i + 3] = bfhi(w0[i].y) + f1 * bfhi(w1[i].y); }
                while (msk) { const int e = __ffs(msk) - 1; msk &= msk - 1; const int s = __shfl(myinv, e);
#pragma unroll
                    for (int i = 0; i < 4; ++i) { const u32x2 w = *(const u32x2*)(YS + (size_t)s * DM + 256 * i + 4 * lane);
                        acc[4 * i + 0] += bflo(w.x); acc[4 * i + 1] += bfhi(w.x); acc[4 * i + 2] += bflo(w.y); acc[4 * i + 3] += bfhi(w.y); } }
            }
        }
        if (lane < 16) INV[(size_t)row * 16 + lane] = -1;
        const int mrow = row < NROWL ? (row >> 12) : 16;
        const float* gt = MODc + (size_t)mrow * 6144 + 5120;
        float ss = 0.f;
#pragma unroll
        for (int i = 0; i < 4; ++i) { const int k = 256 * i + 4 * lane;
            float4 xv = make_float4(bflo(xc4[i].x), bfhi(xc4[i].x), bflo(xc4[i].y), bfhi(xc4[i].y)); const float4 g = *(const float4*)(gt + k);
            xv.x += g.x * acc[4 * i + 0]; xv.y += g.y * acc[4 * i + 1]; xv.z += g.z * acc[4 * i + 2]; xv.w += g.w * acc[4 * i + 3];
            if (NEXT) { u32x2 w; w.x = pack_bf16(xv.x, xv.y); w.y = pack_bf16(xv.z, xv.w); *(u32x2*)(XB + (size_t)row * DM + k) = w; }
            else *(float4*)(outp + (size_t)row * DM + k) = xv;
            acc[4 * i + 0] = xv.x; acc[4 * i + 1] = xv.y; acc[4 * i + 2] = xv.z; acc[4 * i + 3] = xv.w;
            ss += xv.x * xv.x + xv.y * xv.y + xv.z * xv.z + xv.w * xv.w; }
        myinv = ninv;
#pragma unroll
        for (int i = 0; i < 4; ++i) xc4[i] = xn4[i];
        if (NEXT) {
            ss = wave_sum(ss);
            const float inv = rsqrtf(ss * (1.0f / 1024.0f) + EPSF);
            const float* mod = MODn + (size_t)mrow * 6144;
            float part[16];
#pragma unroll
            for (int j = 0; j < 16; ++j) part[j] = 0.f;
#pragma unroll
            for (int i = 0; i < 4; ++i) { const int k = 256 * i + 4 * lane;
                const float4 g = *(const float4*)(gain + k), sh = *(const float4*)(mod + k), sc = *(const float4*)(mod + 1024 + k);
                float4 h; h.x = acc[4 * i + 0] * inv * g.x * (1.f + sc.x) + sh.x; h.y = acc[4 * i + 1] * inv * g.y * (1.f + sc.y) + sh.y; h.z = acc[4 * i + 2] * inv * g.z * (1.f + sc.z) + sh.z; h.w = acc[4 * i + 3] * inv * g.w * (1.f + sc.w) + sh.w;
                u32x2 w; w.x = pack_bf16(h.x, h.y); w.y = pack_bf16(h.z, h.w);
                *(u32x2*)(U + (size_t)row * DM + k) = w;
#pragma unroll
                for (int j = 0; j < 16; ++j) { const float4 wv = *(const float4*)(Wg + j * 1024 + k); part[j] += h.x * wv.x + h.y * wv.y + h.z * wv.z + h.w * wv.w; }
                asm volatile("" ::: "memory"); }
            const float v1 = reduce16_transpose(part, lane);
            const int jx = ((lane >> 5) & 1) * 8 + ((lane >> 4) & 1) * 4 + ((lane >> 3) & 1) * 2 + ((lane >> 2) & 1);
            if ((lane & 3) == 0) GT[(size_t)row * 16 + jx] = v1;
        }
    }
    __syncthreads();
}
struct AttnItem { int qrow0, qpos0, qcol, kcol, vcol, ycol; int nt0, krow0, kpos0, masked; int nt1, krow1; float M2, sink2, lam, postscale; const float* subgain; };
#define FA_LD 72

template <int NC>
__device__ __forceinline__ void fattn_item(const bf16_t* __restrict__ P, bf16_t* __restrict__ Y, const AttnItem& it, unsigned char* smem) {
    constexpr int KS = (NC == 2) ? 2 : 4;
    const int tid = my_tid(), lane = tid & 63, w = tid >> 6, h = lane >> 5, lq = lane & 31;
    bf16_t* Kb = (bf16_t*)smem;
    bf16_t* Vb = Kb + 2 * 64 * FA_LD;
    const LAS unsigned char* vlds = (const LAS unsigned char*)(smem) + 2 * 64 * FA_LD * 2;
    bf16x8 qf[NC][KS];
    { const bf16_t* qp = P + (size_t)(it.qrow0 + 32 * w + lq) * PW + it.qcol + 8 * h;
#pragma unroll
      for (int c = 0; c < NC; ++c)
#pragma unroll
          for (int s = 0; s < KS; ++s) qf[c][s] = *(const bf16x8*)(qp + 32 * c + 16 * s); }
    f32x16 O[NC][2]; float lsum[NC];
#pragma unroll
    for (int c = 0; c < NC; ++c) { lsum[c] = 0.f;
#pragma unroll
        for (int dt = 0; dt < 2; ++dt)
#pragma unroll
            for (int r = 0; r < 16; ++r) O[c][dt][r] = 0.f; }
    const int ntot = it.nt0 + it.nt1;
    const int ldkey = tid >> 3, ldch = tid & 7;
    const int vlane = ((4 * h + ((lane & 15) >> 2)) * FA_LD + 16 * ((lane >> 4) & 1) + 4 * (lane & 3)) * 2;
    u32x4 kreg, vreg;
    { const int krow = it.nt0 > 0 ? it.krow0 : it.krow1; const bf16_t* kp = P + (size_t)(krow + ldkey) * PW;
      kreg = *(const u32x4*)(kp + it.kcol + ldch * 8); vreg = *(const u32x4*)(kp + it.vcol + ldch * 8); }
    __syncthreads();
    *(u32x4*)(Kb + ldkey * FA_LD + ldch * 8) = kreg; *(u32x4*)(Vb + ldkey * FA_LD + ldch * 8) = vreg;
    __syncthreads();
    const int qpos = it.qpos0 + 32 * w + lq;
    for (int kt = 0; kt < ntot; ++kt) {
        const int buf = kt & 1;
        int kpos = 0; bool msk = false;
        if (kt < it.nt0) { kpos = it.kpos0 + 64 * kt; msk = it.masked != 0; }
        if (kt + 1 < ntot) { const int k2 = kt + 1; const int krow = k2 < it.nt0 ? it.krow0 + 64 * k2 : it.krow1 + 64 * (k2 - it.nt0);
            const bf16_t* kp = P + (size_t)(krow + ldkey) * PW; kreg = *(const u32x4*)(kp + it.kcol + ldch * 8); vreg = *(const u32x4*)(kp + it.vcol + ldch * 8); }
        bool skip = false;
        if (msk) { const int q0 = it.qpos0 + 32 * w; skip = (kpos > q0 + 31 + 128) || (kpos + 63 < q0 - 128); }
        if (!skip) {
            const bf16_t* kb = Kb + buf * 64 * FA_LD; const LAS unsigned char* vb = vlds + buf * 64 * FA_LD * 2 + vlane;
#pragma unroll
            for (int sub = 0; sub < 2; ++sub) {
                unsigned pk[NC][2][4];
#pragma unroll
                for (int c = 0; c < NC; ++c) {
                    f32x16 S;
#pragma unroll
                    for (int r = 0; r < 16; ++r) S[r] = -it.M2;
#pragma unroll
                    for (int s = 0; s < KS; ++s) { const bf16x8 a = *(const bf16x8*)(kb + (32 * sub + lq) * FA_LD + 32 * c + 16 * s + 8 * h);
                        S = __builtin_amdgcn_mfma_f32_32x32x16_bf16(a, qf[c][s], S, 0, 0, 0); }
                    float pv[16];
#pragma unroll
                    for (int r = 0; r < 16; ++r) { pv[r] = fast_exp2(S[r]);
                        if (NC == 1) { if (msk) { const int d = qpos - (kpos + 32 * sub + CROW(r, lane)); if (d > 128 || d < -128) pv[r] = 0.f; } } }
#pragma unroll
                    for (int r = 0; r < 16; ++r) lsum[c] += pv[r];
#pragma unroll
                    for (int s = 0; s < 2; ++s)
#pragma unroll
                        for (int jj = 0; jj < 4; ++jj) pk[c][s][jj] = pg8::cvt_pk_bf16(pv[8 * s + 2 * jj], pv[8 * s + 2 * jj + 1]);
                }
#pragma unroll
                for (int s = 0; s < 2; ++s)
#pragma unroll
                    for (int dt = 0; dt < 2; ++dt) {
                        const s16x4 lo = tr_read(vb + (32 * sub + 16 * s) * FA_LD * 2 + 64 * dt), hi = tr_read(vb + (32 * sub + 16 * s + 8) * FA_LD * 2 + 64 * dt);
                        const bf16x8 a = __builtin_shufflevector(lo, hi, 0, 1, 2, 3, 4, 5, 6, 7);
#pragma unroll
                        for (int c = 0; c < NC; ++c) { u32x4 bw; bw.x = pk[c][s][0]; bw.y = pk[c][s][1]; bw.z = pk[c][s][2]; bw.w = pk[c][s][3];
                            O[c][dt] = __builtin_amdgcn_mfma_f32_32x32x16_bf16(a, __builtin_bit_cast(bf16x8, bw), O[c][dt], 0, 0, 0); }
                    }
            }
        }
        if (kt + 1 < ntot) { bf16_t* kd = Kb + (buf ^ 1) * 64 * FA_LD; bf16_t* vd = Vb + (buf ^ 1) * 64 * FA_LD;
            *(u32x4*)(kd + ldkey * FA_LD + ldch * 8) = kreg; *(u32x4*)(vd + ldkey * FA_LD + ldch * 8) = vreg; }
        __syncthreads();
    }
    float linv[NC];
#pragma unroll
    for (int c = 0; c < NC; ++c) { const float l = lsum[c] + __shfl_xor(lsum[c], 32); linv[c] = (NC == 1) ? 1.0f / (l + fast_exp2(it.sink2 - it.M2)) : 1.0f / l; }
    bf16_t* yp = Y + (size_t)(it.qrow0 + 32 * w + lq) * DM + it.ycol + 4 * h;
    if (NC == 1) {
#pragma unroll
        for (int dt = 0; dt < 2; ++dt)
#pragma unroll
            for (int g = 0; g < 4; ++g) { u32x2 wv; wv.x = pg8::cvt_pk_bf16(O[0][dt][4 * g] * linv[0], O[0][dt][4 * g + 1] * linv[0]); wv.y = pg8::cvt_pk_bf16(O[0][dt][4 * g + 2] * linv[0], O[0][dt][4 * g + 3] * linv[0]);
                *(u32x2*)(yp + 32 * dt + 8 * g) = wv; }
    } else {
        const float a1 = it.lam * linv[NC - 1];
        float ss = 0.f;
#pragma unroll
        for (int dt = 0; dt < 2; ++dt)
#pragma unroll
            for (int r = 0; r < 16; ++r) { const float v = O[0][dt][r] * linv[0] - a1 * O[NC - 1][dt][r]; O[0][dt][r] = v; ss += v * v; }
        ss += __shfl_xor(ss, 32);
        const float rinv = rsqrtf(ss * (1.0f / 64.0f) + EPSF) * it.postscale;
        const float* sg = it.subgain + 4 * h;
#pragma unroll
        for (int dt = 0; dt < 2; ++dt)
#pragma unroll
            for (int g = 0; g < 4; ++g) { const float4 gg = *(const float4*)(sg + 32 * dt + 8 * g);
                u32x2 wv; wv.x = pg8::cvt_pk_bf16(O[0][dt][4 * g] * rinv * gg.x, O[0][dt][4 * g + 1] * rinv * gg.y); wv.y = pg8::cvt_pk_bf16(O[0][dt][4 * g + 2] * rinv * gg.z, O[0][dt][4 * g + 3] * rinv * gg.w);
                *(u32x2*)(yp + 32 * dt + 8 * g) = wv; }
    }
}


#define FD_RING 4
__device__ __forceinline__ void fattn_d_item(const bf16_t* __restrict__ P, bf16_t* __restrict__ Y, const AttnItem& it, unsigned char* smem) {
    const int tid = my_tid(), lane = tid & 63, w = tid >> 6, h = lane >> 5, lq = lane & 31;
    bf16_t* ring = (bf16_t*)smem;
    const LAS unsigned char* rlds = (const LAS unsigned char*)smem;
    constexpr int TB = 64 * FA_LD * 2;
    bf16x8 qf[2][2];
    { const bf16_t* qp = P + (size_t)(it.qrow0 + 32 * w + lq) * PW + it.qcol + 8 * h;
#pragma unroll
      for (int c = 0; c < 2; ++c)
#pragma unroll
          for (int s = 0; s < 2; ++s) qf[c][s] = *(const bf16x8*)(qp + 32 * c + 16 * s); }
    f32x16 O[2][2]; float lsum[2] = {0.f, 0.f};
#pragma unroll
    for (int c = 0; c < 2; ++c)
#pragma unroll
        for (int dt = 0; dt < 2; ++dt)
#pragma unroll
            for (int r = 0; r < 16; ++r) O[c][dt][r] = 0.f;
    const int ntot = it.nt0 + it.nt1;
    const int ldkey = tid >> 3, ldch = tid & 7;
    const int vlane = ((4 * h + ((lane & 15) >> 2)) * FA_LD + 16 * ((lane >> 4) & 1) + 4 * (lane & 3)) * 2;
    const int klane = (lq * FA_LD + 8 * h) * 2;
#define FD_TROW(k) ((k) < it.nt0 ? it.krow0 + 64 * (k) : it.krow1 + 64 * ((k) - it.nt0))
#define FD_GLOAD(k) do { const bf16_t* kp_ = P + (size_t)(FD_TROW(k) + ldkey) * PW; kreg = *(const u32x4*)(kp_ + it.kcol + ldch * 8); vreg = *(const u32x4*)(kp_ + it.vcol + ldch * 8); } while (0)
#define FD_LSTORE(k) do { bf16_t* d_ = ring + (size_t)((k) & (FD_RING - 1)) * 2 * 64 * FA_LD + ldkey * FA_LD + ldch * 8; *(u32x4*)d_ = kreg; *(u32x4*)(d_ + 64 * FA_LD) = vreg; } while (0)
    u32x4 kreg, vreg;
    __syncthreads();
    FD_GLOAD(0); FD_LSTORE(0);
    if (ntot > 1) { FD_GLOAD(1); FD_LSTORE(1); }
    __syncthreads();
    f32x16 zero16;
#pragma unroll
    for (int r = 0; r < 16; ++r) zero16[r] = 0.f;
    f32x16 SS[2];
    { const LAS unsigned char* kb = rlds + klane;
      SS[0] = __builtin_amdgcn_mfma_f32_32x32x16_bf16(*(const LAS bf16x8*)(kb), qf[0][0], zero16, 0, 0, 0);
      SS[0] = __builtin_amdgcn_mfma_f32_32x32x16_bf16(*(const LAS bf16x8*)(kb + 32), qf[0][1], SS[0], 0, 0, 0); }
    unsigned pkp[2][4];
#pragma unroll
    for (int s = 0; s < 2; ++s)
#pragma unroll
        for (int j = 0; j < 4; ++j) pkp[s][j] = 0u;
    for (int kt = 0; kt < ntot; ++kt) {
        if (kt + 2 < ntot) FD_GLOAD(kt + 2);
        const LAS unsigned char* cb = rlds + (size_t)(kt & (FD_RING - 1)) * 2 * TB;
        const LAS unsigned char* nb = rlds + (size_t)((kt + 1) & (FD_RING - 1)) * 2 * TB;
        const LAS unsigned char* pb = rlds + (size_t)((kt + FD_RING - 1) & (FD_RING - 1)) * 2 * TB;
#pragma unroll
        for (int u = 0; u < 4; ++u) {
            const int c = u & 1;
            const int nsub = ((u + 1) & 3) >> 1, nc = (u + 1) & 1;
            const int psub = ((u + 3) & 3) >> 1, pc = (u + 3) & 1;
            const LAS unsigned char* ka = ((u < 3) ? cb : nb) + klane + (32 * nsub) * FA_LD * 2 + 64 * nc;
            const LAS unsigned char* va = ((u > 0) ? cb : pb) + TB + vlane + (32 * psub) * FA_LD * 2;
            const bf16x8 kf0 = *(const LAS bf16x8*)(ka), kf1 = *(const LAS bf16x8*)(ka + 32);
            bf16x8 vf[2][2];
#pragma unroll
            for (int s = 0; s < 2; ++s)
#pragma unroll
                for (int dt = 0; dt < 2; ++dt) { const s16x4 lo = tr_read(va + (16 * s) * FA_LD * 2 + 64 * dt), hi = tr_read(va + (16 * s + 8) * FA_LD * 2 + 64 * dt);
                    vf[s][dt] = __builtin_shufflevector(lo, hi, 0, 1, 2, 3, 4, 5, 6, 7); }
            __builtin_amdgcn_sched_barrier(0);
            f32x16& Sc = SS[u & 1]; f32x16& Sn = SS[(u + 1) & 1];
            unsigned pkc[2][4];
#pragma unroll
            for (int s = 0; s < 2; ++s) {
                float pv[8];
#pragma unroll
                for (int j = 0; j < 8; ++j) pv[j] = fast_exp2(Sc[8 * s + j]);
                lsum[c] += ((pv[0] + pv[1]) + (pv[2] + pv[3])) + ((pv[4] + pv[5]) + (pv[6] + pv[7]));
#pragma unroll
                for (int jj = 0; jj < 4; ++jj) pkc[s][jj] = pg8::cvt_pk_bf16(pv[2 * jj], pv[2 * jj + 1]);
            }
            if ((u < 3) || (kt + 1 < ntot)) {
                Sn = __builtin_amdgcn_mfma_f32_32x32x16_bf16(kf0, qf[nc][0], zero16, 0, 0, 0);
                Sn = __builtin_amdgcn_mfma_f32_32x32x16_bf16(kf1, qf[nc][1], Sn, 0, 0, 0); }
            if ((u > 0) || (kt > 0)) {
#pragma unroll
                for (int s = 0; s < 2; ++s) { u32x4 bw; bw.x = pkp[s][0]; bw.y = pkp[s][1]; bw.z = pkp[s][2]; bw.w = pkp[s][3];
#pragma unroll
                    for (int dt = 0; dt < 2; ++dt) O[pc][dt] = __builtin_amdgcn_mfma_f32_32x32x16_bf16(vf[s][dt], __builtin_bit_cast(bf16x8, bw), O[pc][dt], 0, 0, 0); } }
            __builtin_amdgcn_sched_group_barrier(0x2, 5, 0);
#pragma unroll
            for (int g = 0; g < 6; ++g) { __builtin_amdgcn_sched_group_barrier(0x8, 1, 0); __builtin_amdgcn_sched_group_barrier(0x2, 5, 0); }
            __builtin_amdgcn_sched_barrier(0);
#pragma unroll
            for (int s = 0; s < 2; ++s)
#pragma unroll
                for (int j = 0; j < 4; ++j) pkp[s][j] = pkc[s][j];
        }
        if (kt + 2 < ntot) FD_LSTORE(kt + 2);
        __syncthreads();
    }
    { const LAS unsigned char* va = rlds + (size_t)((ntot - 1) & (FD_RING - 1)) * 2 * TB + TB + vlane + 32 * FA_LD * 2;
#pragma unroll
      for (int s = 0; s < 2; ++s) { u32x4 bw; bw.x = pkp[s][0]; bw.y = pkp[s][1]; bw.z = pkp[s][2]; bw.w = pkp[s][3];
#pragma unroll
          for (int dt = 0; dt < 2; ++dt) {
              const s16x4 lo = tr_read(va + (16 * s) * FA_LD * 2 + 64 * dt), hi = tr_read(va + (16 * s + 8) * FA_LD * 2 + 64 * dt);
              const bf16x8 a = __builtin_shufflevector(lo, hi, 0, 1, 2, 3, 4, 5, 6, 7);
              O[1][dt] = __builtin_amdgcn_mfma_f32_32x32x16_bf16(a, __builtin_bit_cast(bf16x8, bw), O[1][dt], 0, 0, 0); } } }
#undef FD_TROW
#undef FD_GLOAD
#undef FD_LSTORE
    float linv[2];
#pragma unroll
    for (int c = 0; c < 2; ++c) { const float l = lsum[c] + __shfl_xor(lsum[c], 32); linv[c] = 1.0f / l; }
    bf16_t* yp = Y + (size_t)(it.qrow0 + 32 * w + lq) * DM + it.ycol + 4 * h;
    const float a1 = it.lam * linv[1];
    float ss = 0.f;
#pragma unroll
    for (int dt = 0; dt < 2; ++dt)
#pragma unroll
        for (int r = 0; r < 16; ++r) { const float v = O[0][dt][r] * linv[0] - a1 * O[1][dt][r]; O[0][dt][r] = v; ss += v * v; }
    ss += __shfl_xor(ss, 32);
    const float rinv = rsqrtf(ss * (1.0f / 64.0f) + EPSF) * it.postscale;
    const float* sg = it.subgain + 4 * h;
#pragma unroll
    for (int dt = 0; dt < 2; ++dt)
#pragma unroll
        for (int g = 0; g < 4; ++g) { const float4 gg = *(const float4*)(sg + 32 * dt + 8 * g);
            u32x2 wv; wv.x = pg8::cvt_pk_bf16(O[0][dt][4 * g] * rinv * gg.x, O[0][dt][4 * g + 1] * rinv * gg.y); wv.y = pg8::cvt_pk_bf16(O[0][dt][4 * g + 2] * rinv * gg.z, O[0][dt][4 * g + 3] * rinv * gg.w);
            *(u32x2*)(yp + 32 * dt + 8 * g) = wv; }
}

__device__ __forceinline__ float max_abs_vec(const float* g, int n) { float m = 0.f; for (int i = 0; i < n; ++i) m = fmaxf(m, fabsf(g[i])); return m; }

__device__ __forceinline__ int attn_item_remap(int x0, int G) {
    if (G != 256 || x0 >= 1024) return x0;
    const int i = x0 >> 8, bid = x0 & 255, xcd = bid & 7, slot = bid >> 3;
    const int bh = i * 16 + xcd * 2 + (slot >> 4), n = slot & 15;
    return bh * 16 + n;
}
__device__ __forceinline__ void phase_attnA(const Params& p, int l, unsigned char* smem) {
    unsigned char* ws = launder_ws(p.ws);
    const bf16_t* P = (const bf16_t*)(ws + WS_P); bf16_t* Y = (bf16_t*)(ws + WS_U);
    const float bound = 8.0f * LOG2E * 1.02f * max_abs_vec(PIN(I_AQN) + l * 64, 64) * max_abs_vec(PIN(I_AKN) + l * 64, 64);
    const int nitems = (l == DEPTH - 1) ? 1024 : 1088;
    for (int x0 = blockIdx.x; x0 < nitems; x0 += gridDim.x) {
        const int x = attn_item_remap(x0, gridDim.x);
        AttnItem it; it.subgain = nullptr; it.lam = 0.f; it.postscale = 1.f;
        int b, h, n;
        if (x < 1024) { b = x >> 6; h = (x >> 4) & 3; n = x & 15;
            const int lo = max(0, 256 * n - 128), hi = min(TL, 256 * n + 384);
            it.qrow0 = b * TL + 256 * n; it.qpos0 = 256 * n; it.nt0 = (hi - lo) >> 6; it.krow0 = b * TL + lo; it.kpos0 = lo; it.masked = 1; }
        else { const int y = x - 1024; b = y >> 2; h = y & 3;
            it.qrow0 = NROWL + b * TCX; it.qpos0 = 0; it.nt0 = 0; it.krow0 = 0; it.kpos0 = 0; it.masked = 0; }
        it.nt1 = 4; it.krow1 = NROWL + b * TCX;
        it.qcol = h * 64; it.kcol = 256 + (h >> 1) * 64; it.vcol = 384 + (h >> 1) * 64; it.ycol = h * 64;
        it.sink2 = PIN(I_ASINK)[l * 4 + h] * LOG2E; it.M2 = fmaxf(bound, it.sink2);
        fattn_item<1>(P, Y, it, smem);
    }
}
__device__ __forceinline__ void phase_attnD(const Params& p, int l, unsigned char* smem) {
    unsigned char* ws = launder_ws(p.ws);
    const bf16_t* P = (const bf16_t*)(ws + WS_P); bf16_t* Y = (bf16_t*)(ws + WS_U);
    const float bound = 5.656854249f * LOG2E * 1.02f * max_abs_vec(PIN(I_DQN) + l * 32, 32) * max_abs_vec(PIN(I_DKN) + l * 32, 32);
    float d1 = 0.f, d2 = 0.f;
    for (int i = 0; i < 32; ++i) { d1 += PIN(I_LQ1)[l * 32 + i] * PIN(I_LK1)[l * 32 + i]; d2 += PIN(I_LQ2)[l * 32 + i] * PIN(I_LK2)[l * 32 + i]; }
    const float lam_init = 0.8f - 0.6f * expf(-0.3f * (float)l);
    const float lam = expf(d1) - expf(d2) + lam_init;
    const int nitems = (l == DEPTH - 1) ? 1024 : 1088;
    for (int x0 = blockIdx.x; x0 < nitems; x0 += gridDim.x) {
        const int x = attn_item_remap(x0, gridDim.x);
        AttnItem it; it.subgain = PIN(I_DSUB) + l * 64; it.lam = lam; it.postscale = 1.0f - lam_init; it.sink2 = 0.f; it.M2 = bound;
        int b, h, n;
        if (x < 1024) { b = x >> 6; h = (x >> 4) & 3; n = x & 15;
            it.qrow0 = b * TL + 256 * n; it.qpos0 = 0; it.nt0 = 64; it.krow0 = b * TL; it.kpos0 = 0; it.masked = 0; }
        else { const int y = x - 1024; b = y >> 2; h = y & 3;
            it.qrow0 = NROWL + b * TCX; it.qpos0 = 0; it.nt0 = 0; it.krow0 = 0; it.kpos0 = 0; it.masked = 0; }
        it.nt1 = 4; it.krow1 = NROWL + b * TCX;
        it.qcol = 1536 + h * 64; it.kcol = 1792 + h * 64; it.vcol = 2048 + h * 64; it.ycol = 768 + h * 64;
        if (bound < 100.0f) fattn_d_item(P, Y, it, smem); else fattn_item<2>(P, Y, it, smem);
    }
}

#define HY_ZROWS 4160
#define HY_FLEN 8256
#define HY_OFF_F (HY_ZROWS * 32)
#define HY_OFF_MISC (HY_OFF_F + HY_FLEN * 2)

__device__ __forceinline__ void hy_kloop(const LAS unsigned char* zs, const LAS bf16_t* fs, int w, int lane, f32x4 (&acc)[4][8]) {
    const int i = lane & 15, q = lane >> 4, qq = (lane & 15) >> 2, pp = lane & 3;
    const LAS bf16_t* ap = fs + (4096 - 512 * w + 8 * q - 8 * i);
    const LAS unsigned char* bp = zs + (8 * q + qq) * 32 + pp * 8;
    bf16x8 an[4];
#pragma unroll
    for (int m = 0; m < 4; ++m) an[m] = *(const LAS bf16x8*)(ap - 128 * m);
#pragma unroll 1
    for (int ks = 0; ks < 129; ++ks) {
        bf16x8 a[4];
#pragma unroll
        for (int m = 0; m < 4; ++m) a[m] = an[m];
#pragma unroll
        for (int m = 0; m < 4; ++m) an[m] = *(const LAS bf16x8*)(ap + 32 * (ks + 1) - 128 * m);
#pragma unroll
        for (int r = 0; r < 8; ++r) {
            const s16x4 lo = tr_read(bp + (32 * ks + r) * 32), hi = tr_read(bp + (32 * ks + r) * 32 + 128);
            const bf16x8 b = __builtin_shufflevector(lo, hi, 0, 1, 2, 3, 4, 5, 6, 7);
#pragma unroll
            for (int m = 0; m < 4; ++m) acc[m][r] = __builtin_amdgcn_mfma_f32_16x16x32_bf16(a[m], b, acc[m][r], 0, 0, 0);
        }
    }
}
__device__ __forceinline__ float hy_sconv(const bf16_t* u, int t, int T, float c0, float c1, float c2) {
    const int tm = t > 0 ? t - 1 : 0, tp = t < T - 1 ? t + 1 : T - 1;
    const float um = bf2f(u[tm]), u0 = bf2f(u[t]), up = bf2f(u[tp]);
    return (t > 0 ? c0 : 0.f) * um + c1 * u0 + (t < T - 1 ? c2 : 0.f) * up;
}
__device__ __forceinline__ void hy_gate8(const bf16_t* ub  , int t0, float c0, float c1, float c2, float (&g)[8]) {
    const u32x4 raw = *(const u32x4*)ub; const float hl = bf2f(ub[-1]), hr = bf2f(ub[8]);
    float x[10];
    x[0] = t0 > 0 ? hl : 0.f; x[9] = t0 + 8 < 4096 ? hr : 0.f;
    x[1] = bflo(raw.x); x[2] = bfhi(raw.x); x[3] = bflo(raw.y); x[4] = bfhi(raw.y); x[5] = bflo(raw.z); x[6] = bfhi(raw.z); x[7] = bflo(raw.w); x[8] = bfhi(raw.w);
#pragma unroll
    for (int e = 0; e < 8; ++e) g[e] = c0 * x[e] + c1 * x[e + 1] + c2 * x[e + 2];
}
__device__ __forceinline__ float block_sum(float v, float* red  ) {
    v = wave_sum(v);
    __syncthreads();
    if ((my_tid() & 63) == 0) red[my_tid() >> 6] = v;
    __syncthreads();
    float s = 0.f;
#pragma unroll
    for (int w = 0; w < 8; ++w) s += red[w];
    return s;
}

__device__ __forceinline__ void phase_hyena(const Params& p, int l, unsigned char* smem) {
    unsigned char* ws = launder_ws(p.ws);
    LAS unsigned char* lds = (LAS unsigned char*)smem;
    bf16_t* Zs = (bf16_t*)smem; bf16_t* Fs = (bf16_t*)(smem + HY_OFF_F);
    float* fw3c = (float*)(smem + HY_OFF_MISC);
    float* red = fw3c + 256;
    float* HT = (float*)smem;
    const bf16_t* UT = (const bf16_t*)(ws + WS_UT);
    bf16_t* YT = (bf16_t*)(ws + WS_YT);
    const float* H2L = (const float*)(ws + WS_HID2L); const float* H2C = (const float*)(ws + WS_HID2C);
    const float* fw3 = PIN(I_FW3) + (size_t)l * 64 * 1024;
    const float* cw = PIN(I_HYCONV) + (size_t)l * 3 * 768;
    const float da = logf(1e-2f) / 1.5f, db = logf(1e-2f) / 0.3f;
    for (int c = blockIdx.x; c < 256; c += gridDim.x) {
        const int tid = my_tid(), lane = tid & 63, w = tid >> 6;
        bf16_t* FB = (bf16_t*)(ws + WS_FBUF) + (size_t)c * HY_FLEN;
        const float delta = fabsf(da + (float)c * ((db - da) / 255.0f));
        const float bias0 = PIN(I_HYBIAS)[l * 512 + c], bias1 = PIN(I_HYBIAS)[l * 512 + 256 + c];
        __syncthreads();
        if (tid < 256) fw3c[tid] = fw3[(size_t)(tid & 63) * 1024 + (tid >> 6) * 256 + c];
        __syncthreads();
        float ss0 = 0.f, ss1 = 0.f;
#pragma unroll 1
        for (int lag = tid; lag < 4096; lag += NTHR) {
            const float4* hr = (const float4*)(H2L + (size_t)lag * 64);
            float a0 = 0.f, a1 = 0.f, a2 = 0.f, a3 = 0.f;
#pragma unroll
            for (int k4 = 0; k4 < 16; ++k4) { const float4 h = hr[k4];
                a0 += h.x * fw3c[4 * k4] + h.y * fw3c[4 * k4 + 1] + h.z * fw3c[4 * k4 + 2] + h.w * fw3c[4 * k4 + 3];
                a1 += h.x * fw3c[64 + 4 * k4] + h.y * fw3c[64 + 4 * k4 + 1] + h.z * fw3c[64 + 4 * k4 + 2] + h.w * fw3c[64 + 4 * k4 + 3];
                a2 += h.x * fw3c[128 + 4 * k4] + h.y * fw3c[128 + 4 * k4 + 1] + h.z * fw3c[128 + 4 * k4 + 2] + h.w * fw3c[128 + 4 * k4 + 3];
                a3 += h.x * fw3c[192 + 4 * k4] + h.y * fw3c[192 + 4 * k4 + 1] + h.z * fw3c[192 + 4 * k4 + 2] + h.w * fw3c[192 + 4 * k4 + 3]; }
            const float dec = expf(-((float)lag / 4095.0f) * delta);
            a0 *= dec; a1 *= dec; a2 *= dec; a3 *= dec;
            HT[lag] = a0; HT[4096 + lag] = a1; HT[8192 + lag] = a2; HT[12288 + lag] = a3;
            ss0 += a0 * a0 + (lag >= 1 ? a2 * a2 : 0.f); ss1 += a1 * a1 + (lag >= 1 ? a3 * a3 : 0.f);
        }
        ss0 = block_sum(ss0, red); ss1 = block_sum(ss1, red);
        const float n0 = rsqrtf(ss0 + EPSF), n1 = rsqrtf(ss1 + EPSF);
#pragma unroll 1
        for (int x = tid; x < HY_FLEN; x += NTHR) { const int d = 4128 - x; float f0 = 0.f, f1 = 0.f;
            if (d >= 0 && d <= 4095) { f0 = HT[d] * n0; f1 = HT[4096 + d] * n1; } else if (d < 0 && d >= -4095) { f0 = HT[8192 - d] * n0; f1 = HT[12288 - d] * n1; }
            Fs[x] = f2bf(f0); FB[x] = f2bf(f1); }
        __syncthreads();
        for (int idx = tid; idx < 1024; idx += NTHR) { const int rr = idx >> 4; Zs[(rr < 32 ? rr : 4096 + rr) * 16 + (idx & 15)] = 0; }
        { const bf16_t* u = UT + (size_t)c * NROW; const float v0 = cw[c], v1 = cw[768 + c], v2 = cw[1536 + c];
#pragma unroll 2
          for (int idx = tid; idx < 8192; idx += NTHR) { const int b = idx >> 9, t0 = (idx & 511) * 8;
              float g[8]; hy_gate8(u + b * 4096 + t0, t0, v0, v1, v2, g);
#pragma unroll
              for (int i = 0; i < 8; ++i) Zs[(t0 + i + 32) * 16 + b] = f2bf(g[i]); } }
        __syncthreads();
        f32x4 acc[4][8];
#pragma unroll
        for (int m = 0; m < 4; ++m)
#pragma unroll
            for (int r = 0; r < 8; ++r) acc[m][r] = (f32x4){0.f, 0.f, 0.f, 0.f};
        hy_kloop(lds, (const LAS bf16_t*)(lds + HY_OFF_F), w, lane, acc);
        { int lo = lane, wo = w; asm volatile("" : "+v"(lo), "+v"(wo));
          const float g0 = cw[256 + c], g1 = cw[768 + 256 + c], g2 = cw[1536 + 256 + c];
          const int tb0 = 512 * wo + 32 * (lo >> 4);
          const bf16_t* u1 = UT + (size_t)(256 + c) * NROW + (lo & 15) * 4096 + tb0;
          const bf16_t* zp = Zs + (tb0 + 32) * 16 + (lo & 15);
#pragma unroll
          for (int m = 0; m < 4; ++m)
#pragma unroll
              for (int j = 0; j < 4; ++j) { float g[8]; hy_gate8(u1 + 128 * m + 8 * j, tb0 + 128 * m + 8 * j, g0, g1, g2, g);
#pragma unroll
                  for (int r = 0; r < 8; ++r) { const float z = bf2f(zp[(128 * m + r + 8 * j) * 16]); acc[m][r][j] = g[r] * (acc[m][r][j] + bias0 * z); }
                  asm volatile("" ::: "memory"); } }
        __syncthreads();
        { int lo = lane, wo = w; asm volatile("" : "+v"(lo), "+v"(wo));
          bf16_t* zp = Zs + (512 * wo + 32 * (lo >> 4) + 32) * 16 + (lo & 15);
#pragma unroll
          for (int m = 0; m < 4; ++m)
#pragma unroll
              for (int r = 0; r < 8; ++r) {
#pragma unroll
                  for (int j = 0; j < 4; ++j) zp[(128 * m + r + 8 * j) * 16] = f2bf(acc[m][r][j]);
                  asm volatile("" ::: "memory"); } }
        for (int x = tid; x < HY_FLEN / 8; x += NTHR) ((u32x4*)Fs)[x] = ((const u32x4*)FB)[x];
        __syncthreads();
#pragma unroll
        for (int m = 0; m < 4; ++m)
#pragma unroll
            for (int r = 0; r < 8; ++r) acc[m][r] = (f32x4){0.f, 0.f, 0.f, 0.f};
        hy_kloop(lds, (const LAS bf16_t*)(lds + HY_OFF_F), w, lane, acc);
        { int lo = lane, wo = w; asm volatile("" : "+v"(lo), "+v"(wo));
          const float e0 = cw[512 + c], e1 = cw[768 + 512 + c], e2 = cw[1536 + 512 + c];
          const int tb0 = 512 * wo + 32 * (lo >> 4);
          const bf16_t* u2 = UT + (size_t)(512 + c) * NROW + (lo & 15) * 4096 + tb0;
          bf16_t* yo = YT + (size_t)c * NROW + (lo & 15) * 4096 + tb0;
          const bf16_t* zp = Zs + (tb0 + 32) * 16 + (lo & 15);
#pragma unroll
          for (int m = 0; m < 4; ++m)
#pragma unroll
              for (int j = 0; j < 4; ++j) { float g[8]; hy_gate8(u2 + 128 * m + 8 * j, tb0 + 128 * m + 8 * j, e0, e1, e2, g);
#pragma unroll
                  for (int r = 0; r < 8; ++r) { const float z1 = bf2f(zp[(128 * m + r + 8 * j) * 16]); g[r] = g[r] * (acc[m][r][j] + bias1 * z1); }
                  u32x4 o; o.x = pack_bf16(g[0], g[1]); o.y = pack_bf16(g[2], g[3]); o.z = pack_bf16(g[4], g[5]); o.w = pack_bf16(g[6], g[7]);
                  *(u32x4*)(yo + 128 * m + 8 * j) = o;
                  asm volatile("" ::: "memory"); } }
        __syncthreads();
        if (l < DEPTH - 1) {   float* HTc = (float*)smem;
            const float v0 = cw[c], v1 = cw[768 + c], v2 = cw[1536 + c], g0 = cw[256 + c], g1 = cw[768 + 256 + c], g2 = cw[1536 + 256 + c], e0 = cw[512 + c], e1 = cw[768 + 512 + c], e2 = cw[1536 + 512 + c];
            float* Zc = HTc + 1024;
            float* Z1c = Zc + 4096;
            float t0 = 0.f, t1 = 0.f;
            if (tid < 256) { const int lag = tid; const float* hr = H2C + (size_t)lag * 64; float a0 = 0.f, a1 = 0.f, a2 = 0.f, a3 = 0.f;
                for (int k = 0; k < 64; ++k) { const float h = hr[k]; a0 += h * fw3c[k]; a1 += h * fw3c[64 + k]; a2 += h * fw3c[128 + k]; a3 += h * fw3c[192 + k]; }
                const float dec = expf(-((float)lag / 255.0f) * delta);
                a0 *= dec; a1 *= dec; a2 *= dec; a3 *= dec;
                HTc[lag] = a0; HTc[256 + lag] = a1; HTc[512 + lag] = a2; HTc[768 + lag] = a3;
                t0 = a0 * a0 + (lag >= 1 ? a2 * a2 : 0.f); t1 = a1 * a1 + (lag >= 1 ? a3 * a3 : 0.f); }
            t0 = block_sum(t0, red); t1 = block_sum(t1, red);
            const float m0 = rsqrtf(t0 + EPSF), m1 = rsqrtf(t1 + EPSF);
            const bf16_t* uc = UT + (size_t)c * NROW + NROWL;
#pragma unroll 1
            for (int idx = tid; idx < 4096; idx += NTHR) { const int b = idx >> 8, t = idx & 255; Zc[t * 16 + b] = hy_sconv(uc + b * 256, t, 256, v0, v1, v2); }
            __syncthreads();
            const bf16_t* u1c = UT + (size_t)(256 + c) * NROW + NROWL; const bf16_t* u2c = UT + (size_t)(512 + c) * NROW + NROWL;
            const int tq = tid & 255, bh = tid >> 8;
            float y[8];
#pragma unroll
            for (int i = 0; i < 8; ++i) y[i] = 0.f;
#pragma unroll 2
            for (int s2 = 0; s2 < 256; ++s2) { const int d = tq - s2; const float h = d >= 0 ? HTc[d] : HTc[512 - d];
                const float4 za = *(const float4*)(Zc + s2 * 16 + 8 * bh), zb = *(const float4*)(Zc + s2 * 16 + 8 * bh + 4);
                y[0] += h * za.x; y[1] += h * za.y; y[2] += h * za.z; y[3] += h * za.w; y[4] += h * zb.x; y[5] += h * zb.y; y[6] += h * zb.z; y[7] += h * zb.w; }
#pragma unroll
            for (int i = 0; i < 8; ++i) { const int b = 8 * bh + i; const float yy = y[i] * m0 + bias0 * Zc[tq * 16 + b];
                Z1c[tq * 16 + b] = hy_sconv(u1c + b * 256, tq, 256, g0, g1, g2) * yy; y[i] = 0.f; }
            __syncthreads();
#pragma unroll 2
            for (int s2 = 0; s2 < 256; ++s2) { const int d = tq - s2; const float h = d >= 0 ? HTc[256 + d] : HTc[768 - d];
                const float4 za = *(const float4*)(Z1c + s2 * 16 + 8 * bh), zb = *(const float4*)(Z1c + s2 * 16 + 8 * bh + 4);
                y[0] += h * za.x; y[1] += h * za.y; y[2] += h * za.z; y[3] += h * za.w; y[4] += h * zb.x; y[5] += h * zb.y; y[6] += h * zb.z; y[7] += h * zb.w; }
#pragma unroll
            for (int i = 0; i < 8; ++i) { const int b = 8 * bh + i; const float yy = y[i] * m1 + bias1 * Z1c[tq * 16 + b];
                YT[(size_t)c * NROW + NROWL + b * 256 + tq] = f2bf(hy_sconv(u2c + b * 256, tq, 256, e0, e1, e2) * yy); }
            __syncthreads();
        }
    }
}

__device__ __forceinline__ void phase_hy_transpose(const Params& p, int l, unsigned char* smem) {
    unsigned char* ws = launder_ws(p.ws);
    const bf16_t* YT = (const bf16_t*)(ws + WS_YT); bf16_t* Y = (bf16_t*)(ws + WS_U);
    bf16_t* tile = (bf16_t*)smem;
    const int tid = my_tid();
    const int ntile = 4 * ((l == DEPTH - 1 ? NROWL : NROW) / 64);
    for (int it = blockIdx.x; it < ntile; it += gridDim.x) {
        const int ct = it & 3, rt = it >> 2;
        __syncthreads();
        { const int ch = tid >> 3, seg = tid & 7;
          const u32x4 v = *(const u32x4*)(YT + (size_t)(ct * 64 + ch) * NROW + rt * 64 + seg * 8);
          unsigned* d = (unsigned*)(tile + ch * 66 + seg * 8); d[0] = v.x; d[1] = v.y; d[2] = v.z; d[3] = v.w; }
        __syncthreads();
        { const int r = tid >> 3, seg = tid & 7;
          unsigned wv[4];
#pragma unroll
          for (int k = 0; k < 4; ++k) wv[k] = (unsigned)tile[(seg * 8 + 2 * k) * 66 + r] | ((unsigned)tile[(seg * 8 + 2 * k + 1) * 66 + r] << 16);
          u32x4 o; o.x = wv[0]; o.y = wv[1]; o.z = wv[2]; o.w = wv[3];
          *(u32x4*)(Y + (size_t)(rt * 64 + r) * DM + 256 + ct * 64 + seg * 8) = o; }
    }
    __syncthreads();
}
#define ML_ITEMS 4352
__device__ __forceinline__ void ml_decode(int it, int& b, int& head, int& tc, int& tok0, int& jf, int& jb) {
    b = it / 272; const int r = it - b * 272; head = r / 68; tc = r - head * 68;
    tok0 = tc < 4 ? NROWL + b * TCX + 64 * tc : b * TL + 64 * (tc - 4);
    jf = tc; jb = tc < 4 ? 3 - tc : 71 - tc;
}

__device__ __forceinline__ void phase_ml_local(const Params& p, int l, unsigned char* smem) {
    unsigned char* ws = launder_ws(p.ws);
    const int tid = my_tid(), lane = tid & 63, w = tid >> 6;
    bf16_t* Kt = (bf16_t*)smem;
    bf16_t* VwF = Kt + 64 * 72;
    bf16_t* VwB = VwF + 64 * 72;
    float* Vs = (float*)(VwB + 64 * 72);
    float* vec = Vs + 64 * 65;
    float* igf = vec, *igb = vec + 64, *lff = vec + 128, *lfb = vec + 192, *wf = vec + 256, *wb = vec + 320, *scal = vec + 384;
    const bf16_t* P = (const bf16_t*)(ws + WS_P);
    const float* GT = (const float*)(ws + WS_GATES);
    bf16_t* MLA = (bf16_t*)(ws + WS_MLA); float* MLN = (float*)(ws + WS_MLN); float* MLS = (float*)(ws + WS_MLS);
    const float* bg = PIN(I_BGATE) + l * 16;
    for (int it = blockIdx.x; it < ML_ITEMS; it += gridDim.x) {
        int b, head, tc, tok0, jf, jb; ml_decode(it, b, head, tc, tok0, jf, jb);
        __syncthreads();
        { const int s = tid >> 3, ch = tid & 7;
          const bf16_t* pr = P + (size_t)(tok0 + s) * PW + head * 64 + ch * 8;
          const u32x4 kv = *(const u32x4*)(pr + 768), vv = *(const u32x4*)(pr + 1024);
          const unsigned kw[4] = {kv.x, kv.y, kv.z, kv.w}, vw[4] = {vv.x, vv.y, vv.z, vv.w};
#pragma unroll
          for (int i = 0; i < 4; ++i) { Kt[(ch * 8 + 2 * i) * 72 + s] = f2bf(bflo(kw[i]) * 0.125f); Kt[(ch * 8 + 2 * i + 1) * 72 + s] = f2bf(bfhi(kw[i]) * 0.125f);
              Vs[s * 65 + ch * 8 + 2 * i] = bflo(vw[i]); Vs[s * 65 + ch * 8 + 2 * i + 1] = bfhi(vw[i]); } }
        if (tid < 64) { const float* g = GT + (size_t)(tok0 + tid) * 16;
            igf[tid] = g[head] + bg[head]; igb[tid] = g[4 + head] + bg[4 + head]; lff[tid] = log_sigmoid(g[8 + head] + bg[8 + head]); lfb[tid] = log_sigmoid(g[12 + head] + bg[12 + head]); }
        __syncthreads();
        if (tid < 128) {
            const int dirw = tid >> 6, tau = tid & 63, s = dirw ? 63 - tau : tau;
            const float lf = dirw ? lfb[s] : lff[s], ig = dirw ? igb[s] : igf[s];
            float cum = lf;
#pragma unroll
            for (int o = 1; o < 64; o <<= 1) { const float n = __shfl_up(cum, o); if (tau >= o) cum += n; }
            const float B = __shfl(cum, 63);
            const float ge = B - cum + ig;
            const float ml = wave_max(ge);
            (dirw ? wb : wf)[s] = expf(ge - ml);
            if (tau == 0) { scal[2 * dirw] = B; scal[2 * dirw + 1] = ml; } }
        __syncthreads();
        { const int e = tid >> 3, sc = (tid & 7) * 8; u32x4 a, c2; float x[8], y[8];
#pragma unroll
          for (int i = 0; i < 8; ++i) { const float v = Vs[(sc + i) * 65 + e]; x[i] = v * wf[sc + i]; y[i] = v * wb[sc + i]; }
          a.x = pack_bf16(x[0], x[1]); a.y = pack_bf16(x[2], x[3]); a.z = pack_bf16(x[4], x[5]); a.w = pack_bf16(x[6], x[7]);
          c2.x = pack_bf16(y[0], y[1]); c2.y = pack_bf16(y[2], y[3]); c2.z = pack_bf16(y[4], y[5]); c2.w = pack_bf16(y[6], y[7]);
          *(u32x4*)(VwF + e * 72 + sc) = a; *(u32x4*)(VwB + e * 72 + sc) = c2; }
        __syncthreads();
        const int dir = w >> 2, wl = w & 3, te = wl >> 1, tk = wl & 1;
        const int seq = (b * 4 + head) * 2 + dir, j = dir ? jb : jf;
        bf16_t* dst = MLA + ((size_t)seq * 68 + j) * 4096;
        { f32x16 C;
#pragma unroll
          for (int r = 0; r < 16; ++r) C[r] = 0.f;
          C = mma32((dir ? VwB : VwF) + 32 * te * 72, 72, Kt + 32 * tk * 72, 72, 64, C, lane);
#pragma unroll
          for (int r = 0; r < 16; ++r) dst[(32 * te + CROW(r, lane)) * 64 + 32 * tk + (lane & 31)] = f2bf(C[r]); }
        if (wl == 0) {
            const float* wv = dir ? wb : wf; float s = 0.f;
            for (int t = 0; t < 64; ++t) s += wv[t] * bf2f(Kt[lane * 72 + t]);
            MLN[((size_t)seq * 68 + j) * 64 + lane] = s;
            if (lane == 0) { MLS[((size_t)seq * 68 + j) * 4 + 0] = scal[2 * dir]; MLS[((size_t)seq * 68 + j) * 4 + 1] = scal[2 * dir + 1]; }
        }
    }
    __syncthreads();
}

__device__ __forceinline__ void phase_ml_scan(const Params& p) {
    unsigned char* ws = launder_ws(p.ws);
    const int tid = my_tid();
    unsigned* MLA = (unsigned*)(ws + WS_MLA); float* MLN = (float*)(ws + WS_MLN); float* MLS = (float*)(ws + WS_MLS);
    for (int it = blockIdx.x; it < 512; it += gridDim.x) {
        const int seq = it >> 2, part = it & 3;
        unsigned* base = MLA + (size_t)seq * 68 * 2048 + part * 512 + tid;
        float* nb = MLN + (size_t)seq * 68 * 64 + part * 16 + tid;
        float* sc = MLS + (size_t)seq * 68 * 4;
        const bool hasn = tid < 16;
        float m = 0.f, c0 = 0.f, c1 = 0.f, cn = 0.f;
#define ML_SCAN_BATCH(NBATCH, J0) do { unsigned a[NBATCH]; float an[NBATCH], B[NBATCH], ML[NBATCH]; \
            _Pragma("unroll") for (int u = 0; u < NBATCH; ++u) { a[u] = base[(size_t)((J0) + u) * 2048]; an[u] = hasn ? nb[((J0) + u) * 64] : 0.f; B[u] = sc[((J0) + u) * 4]; ML[u] = sc[((J0) + u) * 4 + 1]; } \
            _Pragma("unroll") for (int u = 0; u < NBATCH; ++u) { \
                const float mn = fmaxf(B[u] + m, ML[u]); const float wp = expf(B[u] + m - mn), wa = expf(ML[u] - mn); \
                if (part == 0 && tid == 0) sc[((J0) + u) * 4 + 2] = m; \
                base[(size_t)((J0) + u) * 2048] = pack_bf16(c0, c1); if (hasn) nb[((J0) + u) * 64] = cn; \
                c0 = wp * c0 + wa * bflo(a[u]); c1 = wp * c1 + wa * bfhi(a[u]); cn = wp * cn + wa * an[u]; m = mn; } } while (0)
        for (int j0 = 0; j0 < 64; j0 += 8) ML_SCAN_BATCH(8, j0);
        ML_SCAN_BATCH(4, 64);
#undef ML_SCAN_BATCH
    }
}

__device__ __forceinline__ void phase_ml_out(const Params& p, int l, unsigned char* smem) {
    unsigned char* ws = launder_ws(p.ws);
    const int tid = my_tid(), lane = tid & 63, w = tid >> 6;
    const int DSZ = 71680;
    const bf16_t* P = (const bf16_t*)(ws + WS_P);
    const float* GT = (const float*)(ws + WS_GATES);
    const bf16_t* MLA = (const bf16_t*)(ws + WS_MLA); const float* MLN = (const float*)(ws + WS_MLN); const float* MLS = (const float*)(ws + WS_MLS);
    bf16_t* Y = (bf16_t*)(ws + WS_U);
    const float* bg = PIN(I_BGATE) + l * 16; const float* mln = PIN(I_MLNORM) + l * 64;
    for (int it = blockIdx.x; it < ML_ITEMS; it += gridDim.x) {
        int b, head, tc, tok0, jf, jb; ml_decode(it, b, head, tc, tok0, jf, jb);
        if (l == DEPTH - 1 && tc < 4) continue;
        __syncthreads();
        {   const int s = tid >> 3, ch = tid & 7;
            const bf16_t* pr = P + (size_t)(tok0 + s) * PW + head * 64 + ch * 8;
            const u32x4 qv = *(const u32x4*)(pr + 512), kv = *(const u32x4*)(pr + 768), vv = *(const u32x4*)(pr + 1024);
            u32x4 ks; ks.x = pack_bf16(bflo(kv.x) * 0.125f, bfhi(kv.x) * 0.125f); ks.y = pack_bf16(bflo(kv.y) * 0.125f, bfhi(kv.y) * 0.125f);
            ks.z = pack_bf16(bflo(kv.z) * 0.125f, bfhi(kv.z) * 0.125f); ks.w = pack_bf16(bflo(kv.w) * 0.125f, bfhi(kv.w) * 0.125f);
            const unsigned vw[4] = {vv.x, vv.y, vv.z, vv.w};
#pragma unroll
            for (int d = 0; d < 2; ++d) { unsigned char* D = smem + d * DSZ; const int tau = d ? 63 - s : s;
                bf16_t* Qd = (bf16_t*)D; bf16_t* Kd = Qd + 64 * 72; bf16_t* Bd = Kd + 64 * 72 + 64 * 136;
                *(u32x4*)(Qd + tau * 72 + ch * 8) = qv; *(u32x4*)(Kd + tau * 72 + ch * 8) = ks;
#pragma unroll
                for (int i = 0; i < 4; ++i) { Bd[(ch * 8 + 2 * i) * 136 + tau] = (bf16_t)(vw[i] & 0xffff); Bd[(ch * 8 + 2 * i + 1) * 136 + tau] = (bf16_t)(vw[i] >> 16); } }
#pragma unroll
            for (int d = 0; d < 2; ++d) { unsigned char* D = smem + d * DSZ; bf16_t* Bd = (bf16_t*)D + 2 * 64 * 72 + 64 * 136;
                const int seq = (b * 4 + head) * 2 + d, j = d ? jb : jf;
                const bf16_t* st = MLA + ((size_t)seq * 68 + j) * 4096;
                const int e = tid >> 3, k0 = (tid & 7) * 8;
                *(u32x4*)(Bd + e * 136 + 64 + k0) = *(const u32x4*)(st + e * 64 + k0); }
            if (tid < 128) { const int d = tid >> 6, tau = tid & 63, tk = d ? 63 - tau : tau;
                float* vecs = (float*)(smem + d * DSZ + 53248);
                const int seq = (b * 4 + head) * 2 + d, j = d ? jb : jf;
                vecs[3 * 64 + tau] = MLN[((size_t)seq * 68 + j) * 64 + tau];
                const float* g = GT + (size_t)(tok0 + tk) * 16;
                vecs[4 * 64 + tau] = g[4 * d + head] + bg[4 * d + head];
                vecs[5 * 64 + tau] = log_sigmoid(g[8 + 4 * d + head] + bg[8 + 4 * d + head]); }
        }
        __syncthreads();
        if (tid < 128) { const int d = tid >> 6, tau = tid & 63; float* vecs = (float*)(smem + d * DSZ + 53248);
            const int seq = (b * 4 + head) * 2 + d, j = d ? jb : jf;
            const float m = MLS[((size_t)seq * 68 + j) * 4 + 2];
            float cum = vecs[5 * 64 + tau];
#pragma unroll
            for (int o = 1; o < 64; o <<= 1) { const float n = __shfl_up(cum, o); if (tau >= o) cum += n; }
            float mm = vecs[4 * 64 + tau] - cum;
#pragma unroll
            for (int o = 1; o < 64; o <<= 1) { const float n = __shfl_up(mm, o); if (tau >= o) mm = fmaxf(mm, n); }
            const float mt = cum + fmaxf(m, mm);
            vecs[tau] = cum; vecs[64 + tau] = mt; vecs[128 + tau] = expf(cum + m - mt); }
        __syncthreads();
        const int d = w >> 2, wl = w & 3, tt = wl >> 1, tx = wl & 1;
        unsigned char* D = smem + d * DSZ;
        bf16_t* Qd = (bf16_t*)D; bf16_t* Kd = Qd + 64 * 72; bf16_t* Ad = Kd + 64 * 72; bf16_t* Bd = Ad + 64 * 136;
        float* vecs = (float*)(D + 53248); float* Hd = vecs + 7 * 64;
        {   f32x16 S;
#pragma unroll
            for (int r = 0; r < 16; ++r) S[r] = 0.f;
            S = mma32(Qd + 32 * tt * 72, 72, Kd + 32 * tx * 72, 72, 64, S, lane);
            const int s = 32 * tx + (lane & 31); const float bs = vecs[s], igs = vecs[4 * 64 + s];
#pragma unroll
            for (int r = 0; r < 16; ++r) { const int t = 32 * tt + CROW(r, lane);
                const float val = (s <= t) ? S[r] * expf(vecs[t] - bs + igs - vecs[64 + t]) : 0.f;
                Ad[t * 136 + s] = f2bf(val); }
            const int tl = tid & 255, t = tl >> 2, qd = tl & 3; const float wi = vecs[128 + t];
#pragma unroll
            for (int v = 0; v < 2; ++v) { const u32x4 q = *(const u32x4*)(Qd + t * 72 + 16 * qd + 8 * v); u32x4 o;
                o.x = pack_bf16(bflo(q.x) * wi, bfhi(q.x) * wi); o.y = pack_bf16(bflo(q.y) * wi, bfhi(q.y) * wi); o.z = pack_bf16(bflo(q.z) * wi, bfhi(q.z) * wi); o.w = pack_bf16(bflo(q.w) * wi, bfhi(q.w) * wi);
                *(u32x4*)(Ad + t * 136 + 64 + 16 * qd + 8 * v) = o; }
        }
        __syncthreads();
        {   f32x16 N;
#pragma unroll
            for (int r = 0; r < 16; ++r) N[r] = 0.f;
            N = mma32(Ad + 32 * tt * 136, 136, Bd + 32 * tx * 136, 136, 128, N, lane);
#pragma unroll
            for (int r = 0; r < 16; ++r) Hd[(32 * tt + CROW(r, lane)) * 65 + 32 * tx + (lane & 31)] = N[r];
            const int tl = tid & 255;
            {
                const int t = tl >> 2, qd = tl & 3; float dn = 0.f;
                const u32x4 sa = *(const u32x4*)(Ad + t * 136 + 16 * qd), sb = *(const u32x4*)(Ad + t * 136 + 16 * qd + 8);
                const u32x4 qa = *(const u32x4*)(Ad + t * 136 + 64 + 16 * qd), qb = *(const u32x4*)(Ad + t * 136 + 64 + 16 * qd + 8);
                const float* nv = vecs + 3 * 64 + 16 * qd;
                dn += (bflo(sa.x) + bfhi(sa.x)) + (bflo(sa.y) + bfhi(sa.y)) + (bflo(sa.z) + bfhi(sa.z)) + (bflo(sa.w) + bfhi(sa.w));
                dn += (bflo(sb.x) + bfhi(sb.x)) + (bflo(sb.y) + bfhi(sb.y)) + (bflo(sb.z) + bfhi(sb.z)) + (bflo(sb.w) + bfhi(sb.w));
                dn += bflo(qa.x) * nv[0] + bfhi(qa.x) * nv[1] + bflo(qa.y) * nv[2] + bfhi(qa.y) * nv[3] + bflo(qa.z) * nv[4] + bfhi(qa.z) * nv[5] + bflo(qa.w) * nv[6] + bfhi(qa.w) * nv[7];
                dn += bflo(qb.x) * nv[8] + bfhi(qb.x) * nv[9] + bflo(qb.y) * nv[10] + bfhi(qb.y) * nv[11] + bflo(qb.z) * nv[12] + bfhi(qb.z) * nv[13] + bflo(qb.w) * nv[14] + bfhi(qb.w) * nv[15];
                dn += dpp_get<DPP_XOR1>(dn); dn += dpp_get<DPP_XOR2>(dn);
                if (qd == 0) vecs[6 * 64 + t] = dn; }
        }
        __syncthreads();
        {   const int s = tid >> 3, e0 = (tid & 7) * 8;
            const float* vF = (const float*)(smem + 53248); const float* HF = vF + 7 * 64;
            const float* vB = (const float*)(smem + DSZ + 53248); const float* HB = vB + 7 * 64;
            const int tb = 63 - s;
            const float rf = 1.0f / fmaxf(fabsf(vF[6 * 64 + s]), expf(-vF[64 + s])), rb = 1.0f / fmaxf(fabsf(vB[6 * 64 + tb]), expf(-vB[64 + tb]));
            float y[8], ss = 0.f;
#pragma unroll
            for (int i = 0; i < 8; ++i) { y[i] = HF[s * 65 + e0 + i] * rf + HB[tb * 65 + e0 + i] * rb; ss += y[i] * y[i]; }
            ss += __shfl_xor(ss, 1); ss += __shfl_xor(ss, 2); ss += __shfl_xor(ss, 4);
            const float rinv = rsqrtf(ss * (1.0f / 64.0f) + EPSF);
            const u32x4 ov = *(const u32x4*)(P + (size_t)(tok0 + s) * PW + 1280 + head * 64 + e0);
            const float op[8] = {bflo(ov.x), bfhi(ov.x), bflo(ov.y), bfhi(ov.y), bflo(ov.z), bfhi(ov.z), bflo(ov.w), bfhi(ov.w)};
            float o[8];
#pragma unroll
            for (int i = 0; i < 8; ++i) o[i] = y[i] * rinv * mln[e0 + i] / (1.0f + expf(-op[i]));
            u32x4 wv; wv.x = pack_bf16(o[0], o[1]); wv.y = pack_bf16(o[2], o[3]); wv.z = pack_bf16(o[4], o[5]); wv.w = pack_bf16(o[6], o[7]);
            *(u32x4*)(Y + (size_t)(tok0 + s) * DM + 512 + head * 64 + e0) = wv;
        }
    }
    __syncthreads();
}
#ifndef DUPMASK
#define DUPMASK 0
#endif
#define XBAR() do { XcdBarrier _b; _b.bar = (unsigned*)(launder_ws(p.ws) + WS_BAR); _b.x = xb_xcc_id(); _b.st = xbw; xcd_barrier(_b); if ((DUPMASK >> 13) & 1) xcd_barrier(_b); } while (0)
#define REP(k) for (int _rep = 0; _rep < 1 + ((DUPMASK >> (k)) & 1); ++_rep)
extern __shared__ __attribute__((aligned(16))) unsigned char smem_raw[];

__global__ void __launch_bounds__(NTHR, 2) trunk_fwd(Params p) {
    unsigned char* smem = smem_raw;
    volatile LAS unsigned* xbw = (volatile LAS unsigned*)(smem_raw + LDS_BYTES - 16);
    if (threadIdx.x == 0) { xbw[0] = 0u; xbw[1] = 0u; xbw[2] = 0u; xbw[3] = 0u; }
    __syncthreads();
    (void)xcd_barrier_post((unsigned*)(p.ws + WS_BAR), xbw);
    unsigned char* ws = p.ws;
    LAS unsigned char* lds = (LAS unsigned char*)smem_raw;
    const int G = gridDim.x, c = blockIdx.x;
    phase_W<0>(p, 0, smem);
    XBAR();
    phase_norm<1>(p, 0, smem);
    XBAR();
    for (int l = 0; l < DEPTH; ++l) {
        const bool last = (l == DEPTH - 1);
        REP(10) {   pg8::Gemm g; g.A = (const bf16_t*)(ws + WS_U); g.Bt = (const bf16_t*)(ws + WS_U); g.M = 0; g.N = 0; g.K = DM;
            InProjOrder S{G, c}; EpiInProj E{(bf16_t*)(ws + WS_P), (bf16_t*)(ws + WS_UT), PIN(I_DQN) + l * 32, PIN(I_DKN) + l * 32, (const float2*)(ws + WS_ROPE) + 64 * 16};
            pg8::gemm_phase(lds, g, S, E); }
        XBAR();
        phase_prep(p, l, smem);
        XBAR();
        REP(0) phase_hyena(p, l, smem);
        REP(1) phase_attnD(p, l, smem);
        REP(2) phase_attnA(p, l, smem);
        REP(3) phase_ml_local(p, l, smem);
        XBAR();
        phase_ml_scan(p);
        REP(9) phase_hy_transpose(p, l, smem);
        XBAR();
        REP(4) phase_ml_out(p, l, smem);
        XBAR();
        {   pg8::Gemm g; g.A = (const bf16_t*)(ws + WS_U); g.Bt = (const bf16_t*)(ws + WS_WOUT); g.M = 0; g.N = 0; g.K = DM;
            OutProjOrder S{G, c, last ? 256 : 272};
            EpiOut E{PIN(I_X), PIN(I_CTX), (bf16_t*)(ws + WS_XB), (const float*)(ws + WS_MOD + (size_t)(l & 1) * MOD_BYTES), l == 0 ? 1 : 0};
            pg8::gemm_phase(lds, g, S, E); }
        XBAR();
        REP(6) phase_norm<2>(p, l, smem);
        XBAR();
        REP(7) phase_topk(p, l, smem);
        XBAR();
        REP(11) {   pg8::Gemm g; g.A = (const bf16_t*)(ws + WS_U); g.Bt = (const bf16_t*)(ws + WS_WGU); g.M = 0; g.N = 0; g.K = DM;
            GateUpOrder S{G, c, last ? 32 : 34}; EpiGU E{(bf16_t*)(ws + WS_HID)};
            pg8::gemm_phase_gather(lds, g, S, E, (const int*)(ws + WS_SROW)); }
        XBAR();
        REP(12) {   pg8::Gemm g; g.A = (const bf16_t*)(ws + WS_HID); g.Bt = (const bf16_t*)(ws + WS_WD); g.M = 0; g.N = 0; g.K = DM;
            DownOrder S{G, c, last ? 32 : 34}; EpiDown E{(bf16_t*)(ws + WS_XE), (const float*)(ws + WS_SGATE)};
            pg8::gemm_phase(lds, g, S, E); }
        REP(5) if (l + 1 < DEPTH) phase_W<2>(p, l + 1, smem);
        XBAR();
        if (l + 1 < DEPTH) { REP(14) phase_combine<true>(p, l, smem); REP(5) phase_W<1>(p, l + 1, smem); XBAR(); }
        else phase_combine<false>(p, l, smem);
    }
}

extern "C" void kernel_launch(void* const* d_in, const int* in_sizes, int n_in, void* d_out, int out_size, void* d_ws, size_t ws_size, hipStream_t stream) {
    static int grid = 0;
    if (grid == 0) {
        if (n_in != 34 || out_size != NROWL * DM || ws_size < WS_END) { fprintf(stderr, "kernel_launch: unexpected shapes (n_in %d out %d ws %zu need %zu)\n", n_in, out_size, ws_size, (size_t)WS_END); grid = -1; return; }
        int dev = 0, cus = 0;
        if (hipGetDevice(&dev) != hipSuccess || hipDeviceGetAttribute(&cus, hipDeviceAttributeMultiprocessorCount, dev) != hipSuccess) { grid = -1; return; }
        if (hipFuncSetAttribute((const void*)trunk_fwd, hipFuncAttributeMaxDynamicSharedMemorySize, LDS_BYTES) != hipSuccess) { fprintf(stderr, "kernel_launch: hipFuncSetAttribute failed\n"); grid = -1; return; }
        int per_cu = 0;
        if (hipOccupancyMaxActiveBlocksPerMultiprocessor(&per_cu, (const void*)trunk_fwd, NTHR, LDS_BYTES) != hipSuccess || per_cu < 1) { fprintf(stderr, "kernel_launch: occupancy query says %d\n", per_cu); }
        (void)hipGetLastError();
        grid = cus;
        if (grid > 256) grid = 256;
        grid &= ~7;
    }
    if (grid <= 0) return;
    (void)hipMemsetAsync((char*)d_ws + WS_BAR, 0, 16384, stream);
    Params p{};
    for (int i = 0; i < 34; ++i) p.in[i] = (const float*)d_in[i];
    p.out = (float*)d_out; p.ws = (unsigned char*)d_ws;
    hipLaunchKernelGGL(trunk_fwd, dim3(grid), dim3(NTHR), LDS_BYTES, stream, p);
}
```

```cpp
#include <hip/hip_runtime.h>
#include <stdint.h>
#include <stdio.h>

typedef unsigned short bf16_t;
typedef short bf16x8 __attribute__((ext_vector_type(8)));
typedef short s16x4 __attribute__((ext_vector_type(4)));
typedef float f32x4 __attribute__((ext_vector_type(4)));
typedef float f32x16 __attribute__((ext_vector_type(16)));
typedef unsigned u32x4 __attribute__((ext_vector_type(4)));
typedef unsigned u32x2 __attribute__((ext_vector_type(2)));
#define LAS __attribute__((address_space(3)))

#define NB 16
#define TL 4096
#define TCX 256
#define DM 1024
#define NROWL 65536
#define NROWC 4096
#define NROW 69632
#define PW 2304
#define INW 3088
#define NEXP 16
#define CAPL 512
#define CAPC 32
#define SLOTS_E 8704
#define NSLOT 139264
#define DEPTH 4
#define NTHR 512
#define LDS_BYTES 155648
#define EPSF 1e-6f
#define LOG2E 1.4426950408889634f

constexpr size_t al256(size_t x) { return (x + 255) & ~size_t(255); }
constexpr size_t WS_BAR   = 0;
constexpr size_t WS_MOD   = al256(WS_BAR + 16384);
constexpr size_t MOD_BYTES = al256((size_t)17 * 6144 * 4);
constexpr size_t WS_HID2L = al256(WS_MOD + 2 * MOD_BYTES);
constexpr size_t WS_HID2C = al256(WS_HID2L + (size_t)4096 * 64 * 4);
constexpr size_t WS_GATES = al256(WS_HID2C + (size_t)256 * 64 * 4);
constexpr size_t WS_AFF   = al256(WS_GATES + (size_t)NROW * 16 * 4);
constexpr size_t WS_SROW  = al256(WS_AFF + (size_t)NROW * 16 * 4);
constexpr size_t WS_SGATE = al256(WS_SROW + (size_t)NSLOT * 4);
constexpr size_t WS_INV   = al256(WS_SGATE + (size_t)NSLOT * 4);
constexpr size_t WS_MLS   = al256(WS_INV + (size_t)NROW * 16 * 4);
constexpr size_t WS_FBUF  = al256(WS_MLS + (size_t)128 * 68 * 4 * 4);
constexpr size_t WS_ROPE  = al256(WS_FBUF + (size_t)256 * 8256 * 2);
constexpr size_t WS_CTX   = al256(WS_ROPE + (size_t)64 * 24 * 8);
constexpr size_t WS_U     = al256(WS_CTX + (size_t)NROWC * DM * 4);
constexpr size_t WS_WOUT  = al256(WS_U + (size_t)(NROW + 3072) * DM * 2);
constexpr size_t WS_WGU   = al256(WS_WOUT + (size_t)DM * DM * 2);
constexpr size_t WS_WD    = al256(WS_WGU + (size_t)NEXP * 2048 * DM * 2);
constexpr size_t WS_P     = al256(WS_WD + (size_t)NEXP * DM * DM * 2);
constexpr size_t WS_UT    = al256(WS_P + (size_t)NROW * PW * 2);
constexpr size_t WS_XE    = al256(WS_UT + (size_t)768 * NROW * 2);
constexpr size_t WS_XB    = al256(WS_XE + (size_t)NSLOT * DM * 2);
constexpr size_t WS_END   = al256(WS_XB + (size_t)NROW * DM * 2);
constexpr size_t WS_HID   = WS_P;
constexpr size_t WS_MLA   = WS_XE;
constexpr size_t WS_MLN   = al256(WS_MLA + (size_t)128 * 68 * 4096 * 2);
constexpr size_t WS_YT    = al256(WS_MLN + (size_t)128 * 68 * 64 * 4);
static_assert(WS_YT + (size_t)256 * NROW * 2 <= WS_XB, "alias overflow");
static_assert((size_t)NSLOT * DM * 2 <= (size_t)NROW * PW * 2, "hid alias overflow");

struct Params {
    const float* in[34];
    float* out;
    unsigned char* ws;
};
enum { I_X = 0, I_C, I_CTX, I_CCTX, I_WADA, I_BADA, I_N1G, I_N2G, I_WIN, I_BGATE, I_AQN, I_AKN, I_ASINK, I_HYCONV, I_FW1, I_FB1, I_FREQ, I_FW2, I_FB2, I_FW3,
       I_HYBIAS, I_MLNORM, I_DQN, I_DKN, I_LQ1, I_LK1, I_LQ2, I_LK2, I_DSUB, I_WOUT, I_WROUTER, I_WEG, I_WEU, I_WED };

__device__ __forceinline__ int my_tid() { int t = threadIdx.x; asm volatile("" : "+v"(t)); return t; }
#define GAS __attribute__((address_space(1)))
__device__ __forceinline__ unsigned char* launder_ws(unsigned char* q) { GAS unsigned char* g = (GAS unsigned char*)q; asm volatile("" : "+s"(g)); return (unsigned char*)g; }
#define CAS __attribute__((address_space(4)))
__device__ __forceinline__ const float* pin_ptr(int i) { const CAS char* ka = (const CAS char*)__builtin_amdgcn_kernarg_segment_ptr(); asm volatile("" : "+s"(ka));
    const GAS float* g = *(const GAS float* const CAS*)(ka + 8 * i); return (const float*)g; }
#define PIN(i) pin_ptr(i)
#define POUT() ((float*)pin_ptr(34))
__device__ __forceinline__ float bf2f(bf16_t v) { return __uint_as_float((unsigned)v << 16); }
__device__ __forceinline__ bf16_t f2bf(float f) { unsigned u = __float_as_uint(f); u += 0x7fffu + ((u >> 16) & 1u); return (bf16_t)(u >> 16); }
__device__ __forceinline__ unsigned pack_bf16(float lo, float hi) { return (unsigned)f2bf(lo) | ((unsigned)f2bf(hi) << 16); }
__device__ __forceinline__ float bflo(unsigned w) { return __uint_as_float(w << 16); }
__device__ __forceinline__ float bfhi(unsigned w) { return __uint_as_float(w & 0xffff0000u); }
template <int CTRL> __device__ __forceinline__ float dpp_get(float v) { return __int_as_float(__builtin_amdgcn_update_dpp(0, __float_as_int(v), CTRL, 0xf, 0xf, true)); }
#define DPP_XOR1 0xB1
#define DPP_XOR2 0x4E
#define DPP_HMIRROR 0x141
#define DPP_MIRROR 0x140
#define DPP_ROR8 0x128
__device__ __forceinline__ float wave_sum(float v) {
    v += dpp_get<DPP_XOR1>(v); v += dpp_get<DPP_XOR2>(v); v += dpp_get<DPP_HMIRROR>(v); v += dpp_get<DPP_MIRROR>(v);
    const int iv = __float_as_int(v);
    return (__int_as_float(__builtin_amdgcn_readlane(iv, 0)) + __int_as_float(__builtin_amdgcn_readlane(iv, 16))) + (__int_as_float(__builtin_amdgcn_readlane(iv, 32)) + __int_as_float(__builtin_amdgcn_readlane(iv, 48)));
}
__device__ __forceinline__ float wave_max(float v) {
    v = fmaxf(v, dpp_get<DPP_XOR1>(v)); v = fmaxf(v, dpp_get<DPP_XOR2>(v)); v = fmaxf(v, dpp_get<DPP_HMIRROR>(v)); v = fmaxf(v, dpp_get<DPP_MIRROR>(v));
    const int iv = __float_as_int(v);
    return fmaxf(fmaxf(__int_as_float(__builtin_amdgcn_readlane(iv, 0)), __int_as_float(__builtin_amdgcn_readlane(iv, 16))), fmaxf(__int_as_float(__builtin_amdgcn_readlane(iv, 32)), __int_as_float(__builtin_amdgcn_readlane(iv, 48))));
}
__device__ __forceinline__ float reduce16_transpose(const float (&part)[16], int lane) {
    float v8[8], v4[4], v2[2], v1;
#pragma unroll
    for (int j = 0; j < 8; ++j) { const auto r = __builtin_amdgcn_permlane32_swap(__float_as_uint(part[j]), __float_as_uint(part[8 + j]), false, false); v8[j] = __uint_as_float(r[0]) + __uint_as_float(r[1]); }
#pragma unroll
    for (int j = 0; j < 4; ++j) { const auto r = __builtin_amdgcn_permlane16_swap(__float_as_uint(v8[j]), __float_as_uint(v8[4 + j]), false, false); v4[j] = __uint_as_float(r[0]) + __uint_as_float(r[1]); }
    { const bool up = (lane & 8) != 0;
#pragma unroll
      for (int j = 0; j < 2; ++j) { const float send = up ? v4[j] : v4[2 + j], keep = up ? v4[2 + j] : v4[j]; v2[j] = keep + dpp_get<DPP_ROR8>(send); } }
    { const bool up = (lane & 4) != 0; const float send = up ? v2[0] : v2[1], keep = up ? v2[1] : v2[0]; v1 = keep + dpp_get<DPP_HMIRROR>(send); }
    v1 += dpp_get<DPP_XOR2>(v1); v1 += dpp_get<DPP_XOR1>(v1);
    return v1;
}
__device__ __forceinline__ float fast_exp2(float x) { return __builtin_amdgcn_exp2f(x); }
__device__ __forceinline__ float log_sigmoid(float x) { return fminf(x, 0.f) - log1pf(expf(-fabsf(x))); }

#define XB_TMO      128
#define XB_XCNT(j)  (256  + 64 * (j))
#define XB_XSUB(j)  (1280 + 64 * (j))
#define XB_XGEN(j)  (2304 + 64 * (j))
#define XB_TOP      3328
#define XB_TOPGEN   3392
#define XCD_BAR_WORDS 3456
#define XB_SPIN_CAP (1u << 22)

__device__ __forceinline__ unsigned xb_ld(unsigned* p)              { return __hip_atomic_load(p, __ATOMIC_RELAXED, __HIP_MEMORY_SCOPE_AGENT); }
__device__ __forceinline__ unsigned xb_add(unsigned* p, unsigned v) { return __hip_atomic_fetch_add(p, v, __ATOMIC_RELAXED, __HIP_MEMORY_SCOPE_AGENT); }
__device__ __forceinline__ unsigned xb_xcc_id() { return (unsigned)__builtin_amdgcn_s_getreg((3 << 11) | 20) & 0xFu; }
#define XB_SPIN(cond, bar) do { unsigned _sp = 0; while (cond) { __builtin_amdgcn_s_sleep(1); \
    if ((++_sp & 255u) == 0u) { if (xb_ld(&(bar)[XB_TMO])) break; if (_sp > XB_SPIN_CAP) { atomicAdd(&(bar)[XB_TMO], 1u); break; } } } } while (0)

struct XcdBarrier { unsigned* bar; unsigned x; volatile LAS unsigned* st; };

__device__ __forceinline__ XcdBarrier xcd_barrier_post(unsigned* bar, volatile LAS unsigned* st) {
    XcdBarrier b; b.bar = bar; b.x = xb_xcc_id(); b.st = st;
    if (threadIdx.x == 0) (void)xb_add(&bar[XB_XCNT(b.x)], 1u);
    return b;
}
__device__ __forceinline__ void xcd_barrier_complete(unsigned* bar, unsigned x, unsigned& nloc, unsigned& nx) {
    const unsigned G = gridDim.x * gridDim.y * gridDim.z;
    unsigned sum, cnt, mine, sp = 0u;
    for (;;) {
        sum = 0u; cnt = 0u; mine = 0u;
#pragma unroll
        for (unsigned j = 0; j < 16; ++j) { const unsigned c = xb_ld(&bar[XB_XCNT(j)]); sum += c; cnt += (c > 0u) ? 1u : 0u; mine = (j == x) ? c : mine; }
        if (sum == G) break;
        __builtin_amdgcn_s_sleep(1);
        if ((++sp & 255u) == 0u) { if (xb_ld(&bar[XB_TMO])) break; if (sp > XB_SPIN_CAP) { atomicAdd(&bar[XB_TMO], 1u); break; } }
    }
    nloc = mine > 0u ? mine : 1u; nx = cnt > 0u ? cnt : 1u;
}
__device__ __forceinline__ void xcd_barrier(const XcdBarrier& b) {
    asm volatile("s_waitcnt vmcnt(0)" ::: "memory");
    __syncthreads();
    if (threadIdx.x == 0) {
        unsigned* bar = b.bar;
        __builtin_amdgcn_s_waitcnt(0);
        unsigned nloc = b.st[0], nx = b.st[1];
        if (nloc == 0u) { xcd_barrier_complete(bar, b.x, nloc, nx); b.st[0] = nloc; b.st[1] = nx; }
        const unsigned old = xb_add(&bar[XB_XSUB(b.x)], 1u);
        const unsigned gen = old / nloc;
        if (old + 1u == (gen + 1u) * nloc) {
            __builtin_amdgcn_fence(__ATOMIC_RELEASE, "agent");
            asm volatile("s_waitcnt vmcnt(0)" ::: "memory");
            const unsigned og = xb_add(&bar[XB_TOP], 1u);
            const unsigned tg = og / nx;
            if (og + 1u == (tg + 1u) * nx) xb_add(&bar[XB_TOPGEN], 1u);
            else XB_SPIN(xb_ld(&bar[XB_TOPGEN]) == tg, bar);
            __builtin_amdgcn_fence(__ATOMIC_ACQUIRE, "agent");
            xb_add(&bar[XB_XGEN(b.x)], 1u);
            asm volatile("s_waitcnt vmcnt(0)" ::: "memory");
        } else {
            XB_SPIN(xb_ld(&bar[XB_XGEN(b.x)]) == gen, bar);
            __builtin_amdgcn_fence(__ATOMIC_ACQUIRE, "agent");
            asm volatile("s_waitcnt vmcnt(0)" ::: "memory");
        }
    }
    __syncthreads();
}

namespace pg8 {
constexpr int BM = 256, BK = 64, HALF = 128, HTB = HALF * BK * 2, STAGE_BYTES = 8 * HTB, NXCD = 8, WGM = 8;
__host__ __device__ __forceinline__ int lds_byte(int r, int c) { const int st = (r >> 4) * 2 + (c >> 5), rr = r & 15, cc = c & 31, ob = rr * 64 + cc * 2; return st * 1024 + (ob ^ (((ob >> 9) & 1) << 5)); }
__host__ __device__ __forceinline__ void stage_rc(int b, int& R, int& C) { const int st = b / 1024, sb = b % 1024, swz = sb ^ (((sb >> 9) & 1) << 5); R = (st >> 1) * 16 + swz / 64; C = (st & 1) * 32 + (swz % 64) / 2; }
__host__ __device__ __forceinline__ int perm32(int rho) { const int n = rho >> 4, i = rho & 15; return 8 * (i >> 2) + 4 * n + (i & 3); }
struct Unit { int pm, pn; };
struct Gemm { const bf16_t* A; const bf16_t* Bt; int M, N, K; };
__device__ __forceinline__ unsigned cvt_pk_bf16(float lo, float hi) { unsigned r; asm volatile("v_cvt_pk_bf16_f32 %0, %1, %2" : "=v"(r) : "v"(lo), "v"(hi)); return r; }

__device__ __forceinline__ void static_unit(int L, int nM, int nN, int& pm, int& pn) {
    const int nwg = nM * nN; int wgid = L;
    { const int q = nwg / NXCD, r = nwg % NXCD, xcd = wgid % NXCD, off = wgid / NXCD; wgid = (xcd < r ? xcd * (q + 1) : r * (q + 1) + (xcd - r) * q) + off; }
    const int nig = WGM * nN, gid = wgid / nig, fm = gid * WGM, gsz = (nM - fm) < WGM ? (nM - fm) : WGM;
    pm = fm + ((wgid % nig) % gsz); pn = (wgid % nig) / gsz;
}

template <class Epi, class Sched>
__device__ __forceinline__ void gemm_phase(LAS unsigned char* lds, const Gemm g, const Sched& S, const Epi& E) {
    const int tid = my_tid(), wid = __builtin_amdgcn_readfirstlane(tid >> 6), lane = tid & 63, wr = wid >> 2, wc = wid & 3, fr = lane & 15, fq = lane >> 4;
    const int K = g.K, nt = K / BK;
    unsigned voffA[2], voffB[2];
#pragma unroll
    for (int i = 0; i < 2; ++i) { int R, C; stage_rc(tid * 16 + i * 8192, R, C); const int Rb = Epi::PERM ? ((R & ~31) + perm32(R & 31)) : R;
        voffA[i] = (unsigned)(R * K + C) * 2u; voffB[i] = (unsigned)(Rb * K + C) * 2u; }
    const size_t kstep = (size_t)(BK * 2);
    const size_t hstep = (size_t)HALF * K * 2;
    const size_t tstep = 2 * hstep;
    const unsigned ldsw = (unsigned)wid * 1024u;
    const int aoff = lds_byte(wr * 64 + fr, fq * 8), boff = lds_byte(wc * 32 + fr, fq * 8);
#define PG8_SA(b, h) (((b) * 2 + (h)) * HTB)
#define PG8_SB(b, h) ((4 + (b) * 2 + (h)) * HTB)
#define PG8_STAGE(bufoff, gbase, voff) do { _Pragma("unroll") for (int _i = 0; _i < 2; ++_i) \
        __builtin_amdgcn_global_load_lds((const unsigned*)((const char*)(gbase) + (voff)[_i]), (LAS unsigned*)(lds + (bufoff) + ldsw + _i * 8192), 16, 0, 0); } while (0)
#define PG8_LDA(dst, b, h) do { _Pragma("unroll") for (int m = 0; m < 4; ++m) _Pragma("unroll") for (int k = 0; k < 2; ++k) dst[m][k] = *(const LAS bf16x8*)(lds + PG8_SA(b, h) + aoff + m * 2048 + k * 1024); } while (0)
#define PG8_LDB(dst, b, h) do { _Pragma("unroll") for (int n = 0; n < 2; ++n) _Pragma("unroll") for (int k = 0; k < 2; ++k) dst[n][k] = *(const LAS bf16x8*)(lds + PG8_SB(b, h) + boff + n * 2048 + k * 1024); } while (0)
#define PG8_MMA(ai, bj, At, Bt) do { __builtin_amdgcn_s_setprio(1); _Pragma("unroll") for (int m = 0; m < 4; ++m) _Pragma("unroll") for (int n = 0; n < 2; ++n) _Pragma("unroll") for (int k = 0; k < 2; ++k) \
        acc[ai][bj][m][n] = __builtin_amdgcn_mfma_f32_16x16x32_bf16(Bt[n][k], At[m][k], acc[ai][bj][m][n], 0, 0, 0); __builtin_amdgcn_s_setprio(0); } while (0)
#define PG8_WAIT_V(n) asm volatile("s_waitcnt vmcnt(" #n ")" ::: "memory")
#define PG8_WAIT_L(n) asm volatile("s_waitcnt lgkmcnt(" #n ")" ::: "memory")
#define PG8_BAR __builtin_amdgcn_s_barrier()
#define PG8_SCHED __builtin_amdgcn_sched_barrier(0)
    Unit cur, nxt; int ui = 0;
    if (!S.next(0, cur)) return;
    f32x4 acc[2][2][4][2];
#pragma unroll
    for (int a = 0; a < 2; ++a)
#pragma unroll
        for (int b = 0; b < 2; ++b)
#pragma unroll
            for (int m = 0; m < 4; ++m)
#pragma unroll
                for (int n = 0; n < 2; ++n) acc[a][b][m][n] = (f32x4){0.f, 0.f, 0.f, 0.f};
    bf16x8 At[4][2], B0[2][2], B1[2][2];
    const char* cA = (const char*)g.A + (size_t)cur.pm * tstep; const char* cB = (const char*)g.Bt + (size_t)cur.pn * tstep;
    PG8_STAGE(PG8_SB(0, 0), cB, voffB); PG8_STAGE(PG8_SA(0, 0), cA, voffA); PG8_STAGE(PG8_SB(0, 1), cB + hstep, voffB); PG8_STAGE(PG8_SA(0, 1), cA + hstep, voffA);
    if (wr == 1) PG8_BAR;
    PG8_WAIT_V(4); PG8_BAR;
    PG8_STAGE(PG8_SB(1, 0), cB + kstep, voffB); PG8_STAGE(PG8_SA(1, 0), cA + kstep, voffA); PG8_STAGE(PG8_SB(1, 1), cB + hstep + kstep, voffB);
    PG8_WAIT_V(6); PG8_BAR;
    for (;;) {
        const bool has_next = S.next(ui + 1, nxt);
        const char* nA = has_next ? (const char*)g.A + (size_t)nxt.pm * tstep : cA; const char* nB = has_next ? (const char*)g.Bt + (size_t)nxt.pn * tstep : cB;
        for (int t = 0; t < nt; t += 2) {
            const bool last = (t == nt - 2);
            const char* a1 = cA + (size_t)(t + 1) * kstep;
            const char* a2 = last ? nA : cA + (size_t)(t + 2) * kstep; const char* b2 = last ? nB : cB + (size_t)(t + 2) * kstep;
            const char* a3 = a2 + kstep; const char* b3 = b2 + kstep;
            PG8_LDB(B0, 0, 0); PG8_SCHED; PG8_LDA(At, 0, 0); PG8_STAGE(PG8_SA(1, 1), a1 + hstep, voffA);
            PG8_WAIT_L(8); PG8_BAR; PG8_WAIT_L(0); PG8_MMA(0, 0, At, B0); PG8_BAR; PG8_SCHED;
            PG8_LDB(B1, 0, 1); PG8_STAGE(PG8_SB(0, 0), b2, voffB);
            PG8_BAR; PG8_WAIT_L(0); PG8_MMA(0, 1, At, B1); PG8_BAR;
            PG8_LDA(At, 0, 1); PG8_STAGE(PG8_SA(0, 0), a2, voffA);
            PG8_BAR; PG8_WAIT_L(0); PG8_MMA(1, 0, At, B0); PG8_BAR; PG8_SCHED;
            PG8_STAGE(PG8_SB(0, 1), b2 + hstep, voffB);
            PG8_WAIT_V(6); PG8_BAR; PG8_MMA(1, 1, At, B1); PG8_BAR;
            PG8_LDB(B0, 1, 0); PG8_SCHED; PG8_LDA(At, 1, 0); PG8_STAGE(PG8_SA(0, 1), a2 + hstep, voffA);
            PG8_WAIT_L(8); PG8_BAR; PG8_WAIT_L(0); PG8_MMA(0, 0, At, B0); PG8_BAR; PG8_SCHED;
            PG8_LDB(B1, 1, 1); PG8_STAGE(PG8_SB(1, 0), b3, voffB);
            PG8_BAR; PG8_WAIT_L(0); PG8_MMA(0, 1, At, B1); PG8_BAR;
            PG8_LDA(At, 1, 1); PG8_STAGE(PG8_SA(1, 0), a3, voffA);
            PG8_BAR; PG8_WAIT_L(0); PG8_MMA(1, 0, At, B0); PG8_BAR; PG8_SCHED;
            PG8_STAGE(PG8_SB(1, 1), b3 + hstep, voffB);
            PG8_WAIT_V(6); PG8_BAR; PG8_MMA(1, 1, At, B1); PG8_BAR;
        }
#if defined(PROBE_KIND) && PROBE_KIND == 4
        { unsigned t0_ = 0; if (blockIdx.x == 0 && threadIdx.x == 0) t0_ = (unsigned)wall_clock64();
          E(acc, cur, wr, wc, fr, fq);
          if (blockIdx.x == 0 && threadIdx.x == 0) { asm volatile("s_waitcnt vmcnt(0)" ::: "memory"); volatile LAS unsigned* pw_ = (volatile LAS unsigned*)(lds + LDS_BYTES - 48); pw_[2] += (unsigned)wall_clock64() - t0_; } }
#else
        E(acc, cur, wr, wc, fr, fq);
#endif
        if (!has_next) break;
#pragma unroll
        for (int a = 0; a < 2; ++a)
#pragma unroll
            for (int b = 0; b < 2; ++b)
#pragma unroll
                for (int m = 0; m < 4; ++m)
#pragma unroll
                    for (int n = 0; n < 2; ++n) acc[a][b][m][n] = (f32x4){0.f, 0.f, 0.f, 0.f};
        cur = nxt; cA = nA; cB = nB; ++ui;
    }
    PG8_WAIT_V(0);
    if (wr == 0) PG8_BAR;
    PG8_BAR;
#undef PG8_SA
#undef PG8_SB
#undef PG8_STAGE
#undef PG8_LDA
#undef PG8_LDB
#undef PG8_MMA
#undef PG8_WAIT_V
#undef PG8_WAIT_L
#undef PG8_BAR
#undef PG8_SCHED
}
template <class Epi, class Sched>
__device__ __forceinline__ void gemm_phase_gather(LAS unsigned char* lds, const Gemm g, const Sched& S, const Epi& E, const int* __restrict__ srow) {
    const int tid = my_tid(), wid = __builtin_amdgcn_readfirstlane(tid >> 6), lane = tid & 63, wr = wid >> 2, wc = wid & 3, fr = lane & 15, fq = lane >> 4;
    const int K = g.K, nt = K / BK;
    unsigned voffB[2];
#pragma unroll
    for (int i = 0; i < 2; ++i) { int R, C; stage_rc(tid * 16 + i * 8192, R, C); const int Rb = Epi::PERM ? ((R & ~31) + perm32(R & 31)) : R;
        voffB[i] = (unsigned)(Rb * K + C) * 2u; }
    unsigned gcur[2][2], gnxt[2][2];
#define PG8_LOADG(dst, u) do { const int _t = my_tid(); _Pragma("unroll") for (int _i = 0; _i < 2; ++_i) { int _R, _C; stage_rc(_t * 16 + _i * 8192, _R, _C); _Pragma("unroll") for (int _h = 0; _h < 2; ++_h) \
        dst[_h][_i] = (unsigned)srow[(u).pm * 256 + 128 * _h + _R] * (unsigned)(K * 2) + (unsigned)_C * 2u; } } while (0)
#define PG8_STAGEG(bufoff, gofs, kbyte) do { _Pragma("unroll") for (int _i = 0; _i < 2; ++_i) \
        __builtin_amdgcn_global_load_lds((const unsigned*)((const char*)g.A + (gofs)[_i] + (kbyte)), (LAS unsigned*)(lds + (bufoff) + ldsw + _i * 8192), 16, 0, 0); } while (0)
    const size_t kstep = (size_t)(BK * 2);
    const size_t hstep = (size_t)HALF * K * 2;
    const size_t tstep = 2 * hstep;
    const unsigned ldsw = (unsigned)wid * 1024u;
    const int aoff = lds_byte(wr * 64 + fr, fq * 8), boff = lds_byte(wc * 32 + fr, fq * 8);
#define PG8_SA(b, h) (((b) * 2 + (h)) * HTB)
#define PG8_SB(b, h) ((4 + (b) * 2 + (h)) * HTB)
#define PG8_STAGE(bufoff, gbase, voff) do { _Pragma("unroll") for (int _i = 0; _i < 2; ++_i) \
        __builtin_amdgcn_global_load_lds((const unsigned*)((const char*)(gbase) + (voff)[_i]), (LAS unsigned*)(lds + (bufoff) + ldsw + _i * 8192), 16, 0, 0); } while (0)
#define PG8_LDA(dst, b, h) do { _Pragma("unroll") for (int m = 0; m < 4; ++m) _Pragma("unroll") for (int k = 0; k < 2; ++k) dst[m][k] = *(const LAS bf16x8*)(lds + PG8_SA(b, h) + aoff + m * 2048 + k * 1024); } while (0)
#define PG8_LDB(dst, b, h) do { _Pragma("unroll") for (int n = 0; n < 2; ++n) _Pragma("unroll") for (int k = 0; k < 2; ++k) dst[n][k] = *(const LAS bf16x8*)(lds + PG8_SB(b, h) + boff + n * 2048 + k * 1024); } while (0)
#define PG8_MMA(ai, bj, At, Bt) do { __builtin_amdgcn_s_setprio(1); _Pragma("unroll") for (int m = 0; m < 4; ++m) _Pragma("unroll") for (int n = 0; n < 2; ++n) _Pragma("unroll") for (int k = 0; k < 2; ++k) \
        acc[ai][bj][m][n] = __builtin_amdgcn_mfma_f32_16x16x32_bf16(Bt[n][k], At[m][k], acc[ai][bj][m][n], 0, 0, 0); __builtin_amdgcn_s_setprio(0); } while (0)
#define PG8_WAIT_V(n) asm volatile("s_waitcnt vmcnt(" #n ")" ::: "memory")
#define PG8_WAIT_L(n) asm volatile("s_waitcnt lgkmcnt(" #n ")" ::: "memory")
#define PG8_BAR __builtin_amdgcn_s_barrier()
#define PG8_SCHED __builtin_amdgcn_sched_barrier(0)
    Unit cur, nxt; int ui = 0;
    if (!S.next(0, cur)) return;
    f32x4 acc[2][2][4][2];
#pragma unroll
    for (int a = 0; a < 2; ++a)
#pragma unroll
        for (int b = 0; b < 2; ++b)
#pragma unroll
            for (int m = 0; m < 4; ++m)
#pragma unroll
                for (int n = 0; n < 2; ++n) acc[a][b][m][n] = (f32x4){0.f, 0.f, 0.f, 0.f};
    bf16x8 At[4][2], B0[2][2], B1[2][2];
    const char* cB = (const char*)g.Bt + (size_t)cur.pn * tstep;
    PG8_LOADG(gcur, cur);
    PG8_STAGE(PG8_SB(0, 0), cB, voffB); PG8_STAGEG(PG8_SA(0, 0), gcur[0], 0); PG8_STAGE(PG8_SB(0, 1), cB + hstep, voffB); PG8_STAGEG(PG8_SA(0, 1), gcur[1], 0);
    if (wr == 1) PG8_BAR;
    PG8_WAIT_V(4); PG8_BAR;
    PG8_STAGE(PG8_SB(1, 0), cB + kstep, voffB); PG8_STAGEG(PG8_SA(1, 0), gcur[0], kstep); PG8_STAGE(PG8_SB(1, 1), cB + hstep + kstep, voffB);
    PG8_WAIT_V(6); PG8_BAR;
    for (;;) {
        const bool has_next = S.next(ui + 1, nxt);
        const char* nB = has_next ? (const char*)g.Bt + (size_t)nxt.pn * tstep : cB;
        if (has_next) PG8_LOADG(gnxt, nxt); else { gnxt[0][0] = gcur[0][0]; gnxt[0][1] = gcur[0][1]; gnxt[1][0] = gcur[1][0]; gnxt[1][1] = gcur[1][1]; }
        for (int t = 0; t < nt; t += 2) {
            const bool last = (t == nt - 2);
            const size_t k1 = (size_t)(t + 1) * kstep, k2 = last ? 0 : (size_t)(t + 2) * kstep, k3 = k2 + kstep;
            const char* b2 = last ? nB : cB + (size_t)(t + 2) * kstep; const char* b3 = b2 + kstep;
            unsigned g0[2], g1[2];
            g0[0] = last ? gnxt[0][0] : gcur[0][0]; g0[1] = last ? gnxt[0][1] : gcur[0][1]; g1[0] = last ? gnxt[1][0] : gcur[1][0]; g1[1] = last ? gnxt[1][1] : gcur[1][1];
            PG8_LDB(B0, 0, 0); PG8_SCHED; PG8_LDA(At, 0, 0); PG8_STAGEG(PG8_SA(1, 1), gcur[1], k1);
            PG8_WAIT_L(8); PG8_BAR; PG8_WAIT_L(0); PG8_MMA(0, 0, At, B0); PG8_BAR; PG8_SCHED;
            PG8_LDB(B1, 0, 1); PG8_STAGE(PG8_SB(0, 0), b2, voffB);
            PG8_BAR; PG8_WAIT_L(0); PG8_MMA(0, 1, At, B1); PG8_BAR;
            PG8_LDA(At, 0, 1); PG8_STAGEG(PG8_SA(0, 0), g0, k2);
            PG8_BAR; PG8_WAIT_L(0); PG8_MMA(1, 0, At, B0); PG8_BAR; PG8_SCHED;
            PG8_STAGE(PG8_SB(0, 1), b2 + hstep, voffB);
            PG8_WAIT_V(6); PG8_BAR; PG8_MMA(1, 1, At, B1); PG8_BAR;
            PG8_LDB(B0, 1, 0); PG8_SCHED; PG8_LDA(At, 1, 0); PG8_STAGEG(PG8_SA(0, 1), g1, k2);
            PG8_WAIT_L(8); PG8_BAR; PG8_WAIT_L(0); PG8_MMA(0, 0, At, B0); PG8_BAR; PG8_SCHED;
            PG8_LDB(B1, 1, 1); PG8_STAGE(PG8_SB(1, 0), b3, voffB);
            PG8_BAR; PG8_WAIT_L(0); PG8_MMA(0, 1, At, B1); PG8_BAR;
            PG8_LDA(At, 1, 1); PG8_STAGEG(PG8_SA(1, 0), g0, k3);
            PG8_BAR; PG8_WAIT_L(0); PG8_MMA(1, 0, At, B0); PG8_BAR; PG8_SCHED;
            PG8_STAGE(PG8_SB(1, 1), b3 + hstep, voffB);
            PG8_WAIT_V(6); PG8_BAR; PG8_MMA(1, 1, At, B1); PG8_BAR;
        }
#if defined(PROBE_KIND) && PROBE_KIND == 4
        { unsigned t0_ = 0; if (blockIdx.x == 0 && threadIdx.x == 0) t0_ = (unsigned)wall_clock64();
          E(acc, cur, wr, wc, fr, fq);
          if (blockIdx.x == 0 && threadIdx.x == 0) { asm volatile("s_waitcnt vmcnt(0)" ::: "memory"); volatile LAS unsigned* pw_ = (volatile LAS unsigned*)(lds + LDS_BYTES - 48); pw_[2] += (unsigned)wall_clock64() - t0_; } }
#else
        E(acc, cur, wr, wc, fr, fq);
#endif
        if (!has_next) break;
#pragma unroll
        for (int a = 0; a < 2; ++a)
#pragma unroll
            for (int b = 0; b < 2; ++b)
#pragma unroll
                for (int m = 0; m < 4; ++m)
#pragma unroll
                    for (int n = 0; n < 2; ++n) acc[a][b][m][n] = (f32x4){0.f, 0.f, 0.f, 0.f};
        cur = nxt; cB = nB; ++ui;
        gcur[0][0] = gnxt[0][0]; gcur[0][1] = gnxt[0][1]; gcur[1][0] = gnxt[1][0]; gcur[1][1] = gnxt[1][1];
    }
    PG8_WAIT_V(0);
    if (wr == 0) PG8_BAR;
    PG8_BAR;
#undef PG8_LOADG
#undef PG8_STAGEG
#undef PG8_SA
#undef PG8_SB
#undef PG8_STAGE
#undef PG8_LDA
#undef PG8_LDB
#undef PG8_MMA
#undef PG8_WAIT_V
#undef PG8_WAIT_L
#undef PG8_BAR
#undef PG8_SCHED
}
}
using pg8::Unit;
struct InProjOrder { int G, c;
    __device__ __forceinline__ bool next(int i, Unit& u) const {
        const int L = i * G + c; if (L >= 3264) return false;
        int pm, pn;
        if (L < 2448) { pg8::static_unit(L, 272, 9, pm, pn); u.pm = pm; u.pn = 272 + pn; }
        else { pg8::static_unit(L - 2448, 3, 272, pm, pn); u.pm = 281 + pm; u.pn = pn; }
        return true; } };
struct OutProjOrder { int G, c, nM;
    __device__ __forceinline__ bool next(int i, Unit& u) const {
        const int L = i * G + c; if (L >= nM * 4) return false;
        pg8::static_unit(L, nM, 4, u.pm, u.pn); return true; } };
struct GateUpOrder { int G, c, nM;
    __device__ __forceinline__ bool next(int i, Unit& u) const {
        const int per = nM * 8; const int L = i * G + c; if (L >= 16 * per) return false;
        const int e = L / per; int pm, pn; pg8::static_unit(L - e * per, nM, 8, pm, pn); u.pm = e * 34 + pm; u.pn = e * 8 + pn; return true; } };
struct DownOrder { int G, c, nM;
    __device__ __forceinline__ bool next(int i, Unit& u) const {
        const int per = nM * 4; const int L = i * G + c; if (L >= 16 * per) return false;
        const int e = L / per; int pm, pn; pg8::static_unit(L - e * per, nM, 4, pm, pn); u.pm = e * 34 + pm; u.pn = e * 4 + pn; return true; } };

struct EpiInProj { static constexpr bool PERM = true; bf16_t* P; bf16_t* UT; const float* dqn; const float* dkn; const float2* ropeD;
    __device__ __forceinline__ void operator()(const f32x4 (&acc)[2][2][4][2], const Unit& u, int wr, int wc, int fr, int fq) const {
        bf16_t* base; int ldc, rt, ct;
        if (u.pn >= 272) { base = P; ldc = PW; rt = u.pm; ct = u.pn - 272; } else { base = UT; ldc = NROW; rt = u.pm - 281; ct = u.pn; }
        const int row0 = rt * 256 + wr * 64 + fr, col0 = ct * 256 + wc * 32 + 8 * fq;
        if (u.pn >= 272 && (ct == 6 || ct == 7)) {
            const float* gnp = (ct == 6 ? dqn : dkn) + 8 * fq;
            const float4 ga = *(const float4*)gnp, gb = *(const float4*)(gnp + 4);
            const float gn[8] = {ga.x, ga.y, ga.z, ga.w, gb.x, gb.y, gb.z, gb.w};
            const float qs = ct == 6 ? 0.17677669529663687f * LOG2E : 1.0f;
            const bool hi = (fq & 1) != 0;
#pragma unroll
            for (int ai = 0; ai < 2; ++ai)
#pragma unroll
                for (int m = 0; m < 4; ++m) { const int row = row0 + ai * 128 + m * 16; const bool lat = row < NROWL; const int t = row & 4095;
                    const int pos = (fq >> 1) == 0 ? (t >> 6) : (t & 63);
                    const float4* rp = (const float4*)(ropeD + pos * 8);
                    const float4 r0 = rp[0], r1 = rp[1], r2 = rp[2], r3 = rp[3];
                    const float cs[8] = {r0.x, r0.z, r1.x, r1.z, r2.x, r2.z, r3.x, r3.z}, sn[8] = {r0.y, r0.w, r1.y, r1.w, r2.y, r2.w, r3.y, r3.w};
                    bf16_t* rowp = base + (size_t)row * ldc + col0;
#pragma unroll
                    for (int bj = 0; bj < 2; ++bj) { const f32x4 v0 = acc[ai][bj][m][0], v1 = acc[ai][bj][m][1];
                        float x[8] = {v0[0], v0[1], v0[2], v0[3], v1[0], v1[1], v1[2], v1[3]};
                        float ss = 0.f;
#pragma unroll
                        for (int i = 0; i < 8; ++i) ss += x[i] * x[i];
                        ss += __shfl_xor(ss, 16); ss += __shfl_xor(ss, 32);
                        const float inv = rsqrtf(ss * (1.0f / 32.0f) + EPSF);
                        float o[8];
#pragma unroll
                        for (int i = 0; i < 8; ++i) { const float y = x[i] * inv * gn[i]; const float pr = __shfl_xor(y, 16);
                            o[i] = (lat ? (hi ? y * cs[i] + pr * sn[i] : y * cs[i] - pr * sn[i]) : y) * qs; }
                        u32x4 w; w.x = pg8::cvt_pk_bf16(o[0], o[1]); w.y = pg8::cvt_pk_bf16(o[2], o[3]); w.z = pg8::cvt_pk_bf16(o[4], o[5]); w.w = pg8::cvt_pk_bf16(o[6], o[7]);
                        *(u32x4*)(rowp + bj * 128) = w; } }
            return;
        }
#pragma unroll
        for (int ai = 0; ai < 2; ++ai)
#pragma unroll
            for (int m = 0; m < 4; ++m) { bf16_t* rowp = base + (size_t)(row0 + ai * 128 + m * 16) * ldc + col0;
#pragma unroll
                for (int bj = 0; bj < 2; ++bj) { const f32x4 v0 = acc[ai][bj][m][0], v1 = acc[ai][bj][m][1];
                    u32x4 w; w.x = pg8::cvt_pk_bf16(v0[0], v0[1]); w.y = pg8::cvt_pk_bf16(v0[2], v0[3]); w.z = pg8::cvt_pk_bf16(v1[0], v1[1]); w.w = pg8::cvt_pk_bf16(v1[2], v1[3]);
                    *(u32x4*)(rowp + bj * 128) = w; } }
    } };
__device__ __forceinline__ float silu_mul(float g, float u) { return g * u * __builtin_amdgcn_rcpf(1.0f + fast_exp2(-g * LOG2E)); }
struct EpiGU { static constexpr bool PERM = true; bf16_t* HID;
    __device__ __forceinline__ void operator()(const f32x4 (&acc)[2][2][4][2], const Unit& u, int wr, int wc, int fr, int fq) const {
        const int row0 = u.pm * 256 + wr * 64 + fr, col0 = (u.pn & 7) * 128 + wc * 32 + 8 * fq;
#pragma unroll
        for (int ai = 0; ai < 2; ++ai)
#pragma unroll
            for (int m = 0; m < 4; ++m) { bf16_t* rowp = HID + (size_t)(row0 + ai * 128 + m * 16) * DM + col0;
                const f32x4 g0 = acc[ai][0][m][0], g1 = acc[ai][0][m][1], u0 = acc[ai][1][m][0], u1 = acc[ai][1][m][1];
                u32x4 w; w.x = pg8::cvt_pk_bf16(silu_mul(g0[0], u0[0]), silu_mul(g0[1], u0[1])); w.y = pg8::cvt_pk_bf16(silu_mul(g0[2], u0[2]), silu_mul(g0[3], u0[3]));
                w.z = pg8::cvt_pk_bf16(silu_mul(g1[0], u1[0]), silu_mul(g1[1], u1[1])); w.w = pg8::cvt_pk_bf16(silu_mul(g1[2], u1[2]), silu_mul(g1[3], u1[3]));
                *(u32x4*)rowp = w; }
    } };
struct EpiDown { static constexpr bool PERM = true; bf16_t* Y; const float* sgate;
    __device__ __forceinline__ void operator()(const f32x4 (&acc)[2][2][4][2], const Unit& u, int wr, int wc, int fr, int fq) const {
        const int row0 = u.pm * 256 + wr * 64 + fr, col0 = (u.pn & 3) * 256 + wc * 32 + 8 * fq;
#pragma unroll
        for (int ai = 0; ai < 2; ++ai)
#pragma unroll
            for (int m = 0; m < 4; ++m) { const int r = row0 + ai * 128 + m * 16; const float gt = sgate[r]; bf16_t* rowp = Y + (size_t)r * DM + col0;
#pragma unroll
                for (int bj = 0; bj < 2; ++bj) { const f32x4 v0 = acc[ai][bj][m][0] * gt, v1 = acc[ai][bj][m][1] * gt;
                    u32x4 w; w.x = pg8::cvt_pk_bf16(v0[0], v0[1]); w.y = pg8::cvt_pk_bf16(v0[2], v0[3]); w.z = pg8::cvt_pk_bf16(v1[0], v1[1]); w.w = pg8::cvt_pk_bf16(v1[2], v1[3]);
                    *(u32x4*)(rowp + bj * 128) = w; } }
    } };
struct EpiOut { static constexpr bool PERM = true; const float* srcL; const float* srcC; bf16_t* XB; const float* MOD; int first;
    __device__ __forceinline__ void operator()(const f32x4 (&acc)[2][2][4][2], const Unit& u, int wr, int wc, int fr, int fq) const {
        const float* gt = MOD + (size_t)(u.pm < 256 ? (u.pm >> 4) : 16) * 6144 + 2048;
        const int row0 = u.pm * 256 + wr * 64 + fr, col0 = u.pn * 256 + wc * 32 + 8 * fq;
        f32x4 gv[2][2];
#pragma unroll
        for (int bj = 0; bj < 2; ++bj)
#pragma unroll
            for (int n = 0; n < 2; ++n) gv[bj][n] = *(const f32x4*)(gt + col0 + bj * 128 + n * 4);
#pragma unroll
        for (int ai = 0; ai < 2; ++ai)
#pragma unroll
            for (int m = 0; m < 4; ++m) { const int row = row0 + ai * 128 + m * 16;
                bf16_t* xrow = XB + (size_t)row * DM + col0;
                const float* frow = (row < NROWL ? srcL + (size_t)row * DM : srcC + (size_t)(row - NROWL) * DM) + col0;
#pragma unroll
                for (int bj = 0; bj < 2; ++bj) {
                    f32x4 s0, s1;
                    if (first) { s0 = *(const f32x4*)(frow + bj * 128); s1 = *(const f32x4*)(frow + bj * 128 + 4); }
                    else { const u32x4 raw = *(const u32x4*)(xrow + bj * 128);
                        s0 = (f32x4){bflo(raw.x), bfhi(raw.x), bflo(raw.y), bfhi(raw.y)}; s1 = (f32x4){bflo(raw.z), bfhi(raw.z), bflo(raw.w), bfhi(raw.w)}; }
                    const f32x4 v0 = s0 + gv[bj][0] * acc[ai][bj][m][0], v1 = s1 + gv[bj][1] * acc[ai][bj][m][1];
                    u32x4 w; w.x = pg8::cvt_pk_bf16(v0[0], v0[1]); w.y = pg8::cvt_pk_bf16(v0[2], v0[3]); w.z = pg8::cvt_pk_bf16(v1[0], v1[1]); w.w = pg8::cvt_pk_bf16(v1[2], v1[3]);
                    *(u32x4*)(xrow + bj * 128) = w; } }
    } };

__device__ __forceinline__ f32x16 mma32(const bf16_t* A, int lda, const bf16_t* Bt, int ldb, int K, f32x16 acc, int lane) {
    const int r = lane & 31, h = lane >> 5;
    const bf16_t* ap = A + r * lda + 8 * h; const bf16_t* bp = Bt + r * ldb + 8 * h;
    for (int k = 0; k < K; k += 16) {
        const bf16x8 a = *(const bf16x8*)(ap + k); const bf16x8 b = *(const bf16x8*)(bp + k);
        acc = __builtin_amdgcn_mfma_f32_32x32x16_bf16(a, b, acc, 0, 0, 0);
    }
    return acc;
}
#define CROW(reg, lane) (((reg) & 3) + 8 * ((reg) >> 2) + 4 * ((lane) >> 5))
typedef short v4i16_t __attribute__((ext_vector_type(4)));
__device__ __forceinline__ s16x4 tr_read(const LAS unsigned char* ptr) { return __builtin_bit_cast(s16x4, __builtin_amdgcn_ds_read_tr16_b64_v4i16((LAS v4i16_t*)ptr)); }
struct TrDesc { const float* src; bf16_t* dst; int src_ld, src_col0, k0, n0; };
__device__ __forceinline__ void tr_load(const TrDesc& d, int t, float4 (&v)[2]) {
#pragma unroll
    for (int p = 0; p < 2; ++p) { const int j = (t >> 4) + 32 * p; v[p] = *(const float4*)(d.src + (size_t)(d.k0 + j) * d.src_ld + d.src_col0 + (t & 15) * 4); }
}
__device__ __forceinline__ void tr_store(unsigned char* smem, const TrDesc& d, int t, const float4 (&v)[2]) {
    float* tile = (float*)smem;
#pragma unroll
    for (int p = 0; p < 2; ++p) { const int j = (t >> 4) + 32 * p; float* q = tile + j * 65 + (t & 15) * 4; q[0] = v[p].x; q[1] = v[p].y; q[2] = v[p].z; q[3] = v[p].w; }
    __syncthreads();
    { const int i = t >> 3, kc = (t & 7) * 8;
      u32x4 w;
      w.x = pack_bf16(tile[(kc + 0) * 65 + i], tile[(kc + 1) * 65 + i]); w.y = pack_bf16(tile[(kc + 2) * 65 + i], tile[(kc + 3) * 65 + i]);
      w.z = pack_bf16(tile[(kc + 4) * 65 + i], tile[(kc + 5) * 65 + i]); w.w = pack_bf16(tile[(kc + 6) * 65 + i], tile[(kc + 7) * 65 + i]);
      *(u32x4*)(d.dst + (size_t)(d.n0 + i) * DM + d.k0 + kc) = w; }
    __syncthreads();
}

template <int PART>
__device__ __forceinline__ void phase_W(const Params& p, int l, unsigned char* smem) {
    unsigned char* ws = launder_ws(p.ws);
    const int tid = my_tid(), G = gridDim.x, bid = blockIdx.x;
    if (PART == 0 && bid == 0) {
        float2* rA = (float2*)(ws + WS_ROPE); float2* rD = rA + 64 * 16;
        for (int idx = tid; idx < 64 * 16; idx += NTHR) { const int pos = idx >> 4, f = idx & 15; const float inv = powf(10000.0f, -(float)f / 16.0f); float sn, cs; sincosf((float)pos * inv, &sn, &cs); rA[idx] = make_float2(cs, sn); }
        for (int idx = tid; idx < 64 * 8; idx += NTHR) { const int pos = idx >> 3, f = idx & 7; const float inv = powf(10000.0f, -(float)f / 8.0f); float sn, cs; sincosf((float)pos * inv, &sn, &cs); rD[idx] = make_float2(cs, sn); }
    }
    if (PART == 0) { int4* inv4 = (int4*)(ws + WS_INV); const int n4 = NROW * 16 / 4;
      for (int i = bid * NTHR + tid; i < n4; i += G * NTHR) inv4[i] = make_int4(-1, -1, -1, -1); }
    const float* w_in = PIN(I_WIN) + (size_t)l * DM * INW;
    const float* w_out = PIN(I_WOUT) + (size_t)l * DM * DM;
    const float* weg = PIN(I_WEG) + (size_t)l * NEXP * DM * DM;
    const float* weu = PIN(I_WEU) + (size_t)l * NEXP * DM * DM;
    const float* wed = PIN(I_WED) + (size_t)l * NEXP * DM * DM;
    bf16_t* WinT = (bf16_t*)(ws + WS_U) + (size_t)NROW * DM;
    bf16_t* WoutT = (bf16_t*)(ws + WS_WOUT);
    bf16_t* WguT = (bf16_t*)(ws + WS_WGU);
    bf16_t* WdT = (bf16_t*)(ws + WS_WD);
    const int N_IN = 768, N_OUT = 256, N_GU = 8192, N_D = 4096, N_ADA = 96, N_HID = 544;
    const int NCVT = N_IN + N_OUT + N_GU + N_D;
    auto tr_desc = [&](int x, TrDesc& d) {
        if (x < N_IN) { const int nt = x >> 4, kt = x & 15, n0 = nt * 64;
            int sc; if (n0 < 512) sc = n0; else if (n0 < 1536) sc = n0 + 768; else if (n0 < 2304) sc = n0 + 784; else sc = n0 - 1792;
            d.src = w_in; d.src_ld = INW; d.src_col0 = sc; d.k0 = kt * 64; d.dst = WinT; d.n0 = n0; return; }
        x -= N_IN;
        if (x < N_OUT) { const int nt = x >> 4, kt = x & 15; d.src = w_out; d.src_ld = DM; d.src_col0 = nt * 64; d.k0 = kt * 64; d.dst = WoutT; d.n0 = nt * 64; return; }
        x -= N_OUT;
        if (x < N_GU) { const int e = x >> 9, r = x & 511, nt = r >> 4, kt = r & 15, n0 = nt * 64;
            const int j = n0 >> 8, rr = n0 & 255;
            d.src = (rr < 128 ? weg : weu) + (size_t)e * DM * DM; d.src_ld = DM; d.src_col0 = j * 128 + (rr & 127); d.k0 = kt * 64; d.dst = WguT + (size_t)e * 2048 * DM; d.n0 = n0; return; }
        x -= N_GU;
        { const int e = x >> 8, r = x & 255, nt = r >> 4, kt = r & 15;
          d.src = wed + (size_t)e * DM * DM; d.src_ld = DM; d.src_col0 = nt * 64; d.k0 = kt * 64; d.dst = WdT + (size_t)e * DM * DM; d.n0 = nt * 64; }
    };
    if (PART != 2) {
        TrDesc cur, nxt; float4 va[2], vb[2];
        if (bid < NCVT) { tr_desc(bid, cur); tr_load(cur, tid, va); }
        for (int it = bid; it < NCVT; it += G) {
            const bool more = it + G < NCVT;
            if (more) { tr_desc(it + G, nxt); tr_load(nxt, tid, vb); }
            tr_store(smem, cur, tid, va);
            if (more) { cur = nxt; va[0] = vb[0]; va[1] = vb[1]; }
        }
    }
    const int total = (PART == 1) ? 0 : (N_ADA + N_HID);
    const int it0 = (PART == 2) ? (bid >= G / 2 ? bid - G / 2 : total) : bid, istride = (PART == 2) ? G - G / 2 : G;
    for (int it = it0; it < total; it += istride) {
        int x = it;
        if (x < N_ADA) {
            const int n0 = x * 64;
            float* sv = (float*)smem;
            float* red = sv + 17 * 1024;
            const float* c = PIN(I_C); const float* cc = PIN(I_CCTX);
            for (int idx = tid; idx < 17 * 1024; idx += NTHR) { const int r = idx >> 10, k = idx & 1023; const float v = r < 16 ? c[r * 1024 + k] : cc[k]; sv[idx] = v / (1.0f + expf(-v)); }
            __syncthreads();
            const int w = tid >> 6, lane = tid & 63;
            float acc[17];
#pragma unroll
            for (int r = 0; r < 17; ++r) acc[r] = 0.f;
            const float* wa = PIN(I_WADA) + (size_t)l * DM * 6144 + n0 + lane;
#pragma unroll 2
            for (int k = 128 * w; k < 128 * w + 128; ++k) { const float wv = wa[(size_t)k * 6144];
#pragma unroll
                for (int r = 0; r < 17; ++r) acc[r] += sv[r * 1024 + k] * wv; }
#pragma unroll
            for (int r = 0; r < 17; ++r) red[(w * 17 + r) * 64 + lane] = acc[r];
            __syncthreads();
            float* MOD = (float*)(ws + WS_MOD + (size_t)(l & 1) * MOD_BYTES); const float* ba = PIN(I_BADA) + (size_t)l * 6144;
            for (int idx = tid; idx < 17 * 64; idx += NTHR) { const int r = idx >> 6, j = idx & 63; float s = ba[n0 + j];
#pragma unroll
                for (int ww = 0; ww < 8; ++ww) s += red[(ww * 17 + r) * 64 + j];
                MOD[(size_t)r * 6144 + n0 + j] = s; }
            __syncthreads();
            continue; }
        x -= N_ADA;
        {
            const bool isc = x >= 512; const int L = isc ? 256 : 4096; const int lagbase = (isc ? x - 512 : x) * 8;
            float* zf = (float*)smem;
            float* h1s = zf + 8 * 36;
            const int li = tid >> 6, j = tid & 63, lag = lagbase + li;
            if (j < 33) { float v;
                if (j == 0) v = (float)lag / (float)(L - 1);
                else { const int bi = (j - 1) & 15; const float band = 1e-4f + (float)bi * ((15.0f - 1e-4f) / 15.0f); const float w = 6.283185307179586f * (float)lag / (float)L; const float a = band * w;
                       v = (j <= 16) ? cosf(a) : -sinf(a); }
                zf[li * 36 + j] = v; }
            __syncthreads();
            const float* fw1 = PIN(I_FW1) + (size_t)l * 33 * 64; const float* fb1 = PIN(I_FB1) + l * 64; const float* fr = PIN(I_FREQ) + l * 64;
            const float* fw2 = PIN(I_FW2) + (size_t)l * 64 * 64; const float* fb2 = PIN(I_FB2) + l * 64;
            float a = fb1[j];
#pragma unroll 3
            for (int i = 0; i < 33; ++i) a += zf[li * 36 + i] * fw1[i * 64 + j];
            h1s[li * 64 + j] = sinf(fr[j] * a);
            __syncthreads();
            float a2 = fb2[j];
#pragma unroll 4
            for (int i = 0; i < 64; ++i) a2 += h1s[li * 64 + i] * fw2[i * 64 + j];
            float* H2 = (float*)(ws + (isc ? WS_HID2C : WS_HID2L));
            H2[(size_t)lag * 64 + j] = sinf(fr[j] * a2);
            __syncthreads();
        }
    }
}

template <int WHICH>
__device__ __forceinline__ void phase_norm(const Params& p, int l, unsigned char* smem) {
    unsigned char* ws = launder_ws(p.ws);
    const int tid = my_tid(), lane = tid & 63, wave = tid >> 6;
    float* Wg = (float*)smem;
    for (int idx = tid; idx < 16384; idx += NTHR) { const int k = idx >> 4, j = idx & 15;
        Wg[j * 1024 + k] = (WHICH == 1) ? PIN(I_WIN)[(size_t)l * DM * INW + (size_t)k * INW + 2304 + j] : PIN(I_WROUTER)[(size_t)l * DM * 16 + k * 16 + j]; }
    __syncthreads();
    const float* gain = PIN(WHICH == 1 ? I_N1G : I_N2G) + (size_t)l * DM;
    const float* MOD = (const float*)(ws + WS_MOD + (size_t)(l & 1) * MOD_BYTES);
    bf16_t* U = (bf16_t*)(ws + WS_U);
    float* outv = (float*)(ws + (WHICH == 1 ? WS_GATES : WS_AFF));
    const float* xl = PIN(I_X); const float* xc = PIN(I_CTX);
    const bf16_t* XB = (const bf16_t*)(ws + WS_XB);
    const int rstride = gridDim.x * 8;
    const int nrows = (WHICH == 2 && l == DEPTH - 1) ? NROWL : NROW;
#define NM_LOAD(dst, r) do { if (WHICH == 1) { const float* s_ = (r) < NROWL ? xl + (size_t)(r) * DM : xc + (size_t)((r) - NROWL) * DM; \
            _Pragma("unroll") for (int i = 0; i < 4; ++i) dst[i] = *(const float4*)(s_ + 256 * i + 4 * lane); } \
        else { const bf16_t* s_ = XB + (size_t)(r) * DM; \
            _Pragma("unroll") for (int i = 0; i < 4; ++i) { const u32x2 w_ = *(const u32x2*)(s_ + 256 * i + 4 * lane); dst[i] = make_float4(bflo(w_.x), bfhi(w_.x), bflo(w_.y), bfhi(w_.y)); } } } while (0)
    float4 cur[4];
    { const int row = blockIdx.x * 8 + wave; NM_LOAD(cur, row); }
    for (int row = blockIdx.x * 8 + wave; row < nrows; row += rstride) {
        float4 nxt[4];
        { const int r2 = row + rstride < nrows ? row + rstride : row; NM_LOAD(nxt, r2); }
        const float* mod = MOD + (size_t)(row < NROWL ? (row >> 12) : 16) * 6144 + (WHICH == 1 ? 0 : 3072);
        float ss = 0.f;
#pragma unroll
        for (int i = 0; i < 4; ++i) ss += cur[i].x * cur[i].x + cur[i].y * cur[i].y + cur[i].z * cur[i].z + cur[i].w * cur[i].w;
        ss = wave_sum(ss);
        const float inv = rsqrtf(ss * (1.0f / 1024.0f) + EPSF);
        float part[16];
#pragma unroll
        for (int j = 0; j < 16; ++j) part[j] = 0.f;
#pragma unroll
        for (int i = 0; i < 4; ++i) { const int k = 256 * i + 4 * lane;
            const float4 v = cur[i];
            const float4 g = *(const float4*)(gain + k), sh = *(const float4*)(mod + k), sc = *(const float4*)(mod + 1024 + k);
            float4 h; h.x = v.x * inv * g.x * (1.f + sc.x) + sh.x; h.y = v.y * inv * g.y * (1.f + sc.y) + sh.y; h.z = v.z * inv * g.z * (1.f + sc.z) + sh.z; h.w = v.w * inv * g.w * (1.f + sc.w) + sh.w;
            u32x2 w; w.x = pack_bf16(h.x, h.y); w.y = pack_bf16(h.z, h.w);
            *(u32x2*)(U + (size_t)row * DM + k) = w;
#pragma unroll
            for (int j = 0; j < 16; ++j) { const float4 wv = *(const float4*)(Wg + j * 1024 + k); part[j] += h.x * wv.x + h.y * wv.y + h.z * wv.z + h.w * wv.w; }
            asm volatile("" ::: "memory"); }
#pragma unroll
        for (int i = 0; i < 4; ++i) cur[i] = nxt[i];
        float v1 = reduce16_transpose(part, lane);
        const int jx = ((lane >> 5) & 1) * 8 + ((lane >> 4) & 1) * 4 + ((lane >> 3) & 1) * 2 + ((lane >> 2) & 1);
        float val = v1;
        if (WHICH == 2) { const float mx = wave_max(v1); const float e = expf(v1 - mx); const float sum = wave_sum(e) * 0.25f; val = e / sum; }
        if ((lane & 3) == 0) outv[(size_t)row * 16 + jx] = val;
    }
    __syncthreads();
}

__device__ __forceinline__ void phase_prep(const Params& p, int l, unsigned char* smem) {
    unsigned char* ws = launder_ws(p.ws);
    const int tid = my_tid(), lane = tid & 63, wave = tid >> 6;
    float2* ropeA = (float2*)smem;
    float2* ropeD = ropeA + 64 * 16;
    for (int idx = tid; idx < 64 * 16; idx += NTHR) { const int pos = idx >> 4, f = idx & 15; const float inv = powf(10000.0f, -(float)f / 16.0f); float s, c; sincosf((float)pos * inv, &s, &c); ropeA[idx] = make_float2(c, s); }
    for (int idx = tid; idx < 64 * 8; idx += NTHR) { const int pos = idx >> 3, f = idx & 7; const float inv = powf(10000.0f, -(float)f / 8.0f); float s, c; sincosf((float)pos * inv, &s, &c); ropeD[idx] = make_float2(c, s); }
    __syncthreads();
    bf16_t* P = (bf16_t*)(ws + WS_P);
    const float* aqn = PIN(I_AQN) + l * 64; const float* akn = PIN(I_AKN) + l * 64;
    const float* dqn = PIN(I_DQN) + l * 32; const float* dkn = PIN(I_DKN) + l * 32;
    const int rstride = gridDim.x * 8;
    const int vecA = min(lane >> 3, 5), chA = lane & 7;
    u32x4 rawA;
    { const int row = blockIdx.x * 8 + wave; const bf16_t* pr = P + (size_t)row * PW; rawA = *(const u32x4*)(pr + vecA * 64 + chA * 8); }
    for (int row = blockIdx.x * 8 + wave; row < NROW; row += rstride) {
        const bool lat = row < NROWL; const int t = row & 4095; const int prow = t >> 6, pcol = t & 63;
        bf16_t* pr = P + (size_t)row * PW;
        u32x4 nxtA;
        { const int r2 = row + rstride < NROW ? row + rstride : row; const bf16_t* p2 = P + (size_t)r2 * PW; nxtA = *(const u32x4*)(p2 + vecA * 64 + chA * 8); }
        {
            const int vec = vecA, ch = chA; const bool act = lane < 48;
            bf16_t* ptr = pr + vec * 64 + ch * 8;
            const u32x4 raw = rawA;
            float x[8]; x[0] = bflo(raw.x); x[1] = bfhi(raw.x); x[2] = bflo(raw.y); x[3] = bfhi(raw.y); x[4] = bflo(raw.z); x[5] = bfhi(raw.z); x[6] = bflo(raw.w); x[7] = bfhi(raw.w);
            float ss = 0.f;
#pragma unroll
            for (int i = 0; i < 8; ++i) ss += x[i] * x[i];
            ss += __shfl_xor(ss, 1); ss += __shfl_xor(ss, 2); ss += __shfl_xor(ss, 4);
            const float inv = rsqrtf(ss * (1.0f / 64.0f) + EPSF);
            const float* gn = (vec < 4 ? aqn : akn) + ch * 8;
            const float qs = vec < 4 ? 0.125f * LOG2E : 1.0f;
            const int axis = ch >> 2, half = (ch >> 1) & 1; const int pos = axis == 0 ? prow : pcol;
            float o[8];
#pragma unroll
            for (int i = 0; i < 8; ++i) { const float y = x[i] * inv * gn[i]; const float pr2 = __shfl_xor(y, 2);
                if (lat) { const float2 cs = ropeA[pos * 16 + 8 * (ch & 1) + i]; o[i] = (half == 0 ? y * cs.x - pr2 * cs.y : y * cs.x + pr2 * cs.y) * qs; } else o[i] = y * qs; }
            if (act) { u32x4 w; w.x = pack_bf16(o[0], o[1]); w.y = pack_bf16(o[2], o[3]); w.z = pack_bf16(o[4], o[5]); w.w = pack_bf16(o[6], o[7]); *(u32x4*)ptr = w; }
        }
        rawA = nxtA;
    }
    __syncthreads();
}
__device__ __forceinline__ int block_excl_scan(int v, int* sbuf  , int& total) {
    const int tid = my_tid(), lane = tid & 63, wave = tid >> 6;
    int inc = v;
#pragma unroll
    for (int o = 1; o < 64; o <<= 1) { const int n = __shfl_up(inc, o); if (lane >= o) inc += n; }
    __syncthreads();
    if (lane == 63) sbuf[wave] = inc;
    __syncthreads();
    int pre = 0, tot = 0;
#pragma unroll
    for (int w = 0; w < 8; ++w) { const int s = sbuf[w]; if (w < wave) pre += s; tot += s; }
    total = tot;
    return pre + inc - v;
}

__device__ __forceinline__ void phase_topk(const Params& p, int l, unsigned char* smem) {
    unsigned char* ws = launder_ws(p.ws);
    const int tid = my_tid();
    unsigned* keys = (unsigned*)smem;
    int* hist = (int*)(keys + 4096);
    int* sb = hist + 256;
    int* ctl = sb + 16;
    const float* AFF = (const float*)(ws + WS_AFF);
    int* SROW = (int*)(ws + WS_SROW); float* SGATE = (float*)(ws + WS_SGATE); int* INV = (int*)(ws + WS_INV);
    const int nlists = (l == DEPTH - 1) ? 256 : 512;
    for (int it = blockIdx.x; it < nlists; it += gridDim.x) {
        const int kind = it >> 8, b = (it >> 4) & 15, e = it & 15;
        const int N = kind ? 256 : 4096, K = kind ? CAPC : CAPL;
        const int rowbase = kind ? NROWL + b * 256 : b * 4096;
        const int slotbase = e * SLOTS_E + (kind ? 8192 + b * CAPC : b * CAPL);
        for (int i = tid; i < N; i += NTHR) keys[i] = __float_as_uint(AFF[(size_t)(rowbase + i) * 16 + e]);
        unsigned prefix = 0, mask = 0; int need = K;
        for (int pass = 3; pass >= 0; --pass) {
            const int shift = 8 * pass;
            if (tid < 256) hist[tid] = 0;
            __syncthreads();
            for (int i = tid; i < N; i += NTHR) { const unsigned k = keys[i]; if ((k & mask) == prefix) atomicAdd(&hist[(k >> shift) & 255], 1); }
            __syncthreads();
            if (tid < 64) {
                const int b0 = 255 - 4 * tid; const int h0 = hist[b0], h1 = hist[b0 - 1], h2 = hist[b0 - 2], h3 = hist[b0 - 3];
                const int tot4 = h0 + h1 + h2 + h3; int inc = tot4;
#pragma unroll
                for (int o = 1; o < 64; o <<= 1) { const int n = __shfl_up(inc, o); if (tid >= o) inc += n; }
                const int exc = inc - tot4;
                const bool hit = (exc < need) && (inc >= need);
                if (hit) { int cum = exc, d = b0;
                    if (cum + h0 >= need) d = b0; else { cum += h0; if (cum + h1 >= need) d = b0 - 1; else { cum += h1; if (cum + h2 >= need) d = b0 - 2; else { cum += h2; d = b0 - 3; } } }
                    ctl[0] = d; ctl[1] = need - cum; } }
            __syncthreads();
            prefix |= (unsigned)ctl[0] << shift; mask |= 255u << shift; need = ctl[1];
            __syncthreads();
        }
        const unsigned T = prefix;
        int cg = 0, ce = 0; unsigned k8[8];
#pragma unroll
        for (int j = 0; j < 8; ++j) { const int i = tid * 8 + j; const unsigned k = (i < N) ? keys[i] : 0u; k8[j] = k; cg += (i < N && k > T) ? 1 : 0; ce += (i < N && k == T) ? 1 : 0; }
        int totg, tote;
        int pg = block_excl_scan(cg, sb, totg);
        int pe = block_excl_scan(ce, sb, tote);
#pragma unroll
        for (int j = 0; j < 8; ++j) { const int i = tid * 8 + j; if (i < N) { const unsigned k = k8[j]; int pos = -1;
                if (k > T) pos = pg++; else if (k == T) { if (pe < need) pos = totg + pe; ++pe; }
                if (pos >= 0) { const int s = slotbase + pos; const int row = rowbase + i; SROW[s] = row; SGATE[s] = __uint_as_float(k); INV[(size_t)row * 16 + e] = s; } } }
        __syncthreads();
    }
}

__device__ __forceinline__ void phase_gather(const Params& p) {
    unsigned char* ws = launder_ws(p.ws);
    const int lane = my_tid() & 63, wave = my_tid() >> 6;
    const int* SROW = (const int*)(ws + WS_SROW);
    const bf16_t* U = (const bf16_t*)(ws + WS_U); bf16_t* XE = (bf16_t*)(ws + WS_XE);
    for (int s = blockIdx.x * 8 + wave; s < NSLOT; s += gridDim.x * 8) {
        const int row = SROW[s];
        const u32x4* src = (const u32x4*)(U + (size_t)row * DM); u32x4* dst = (u32x4*)(XE + (size_t)s * DM);
        const u32x4 a = src[lane], b = src[64 + lane];
        dst[lane] = a; dst[64 + lane] = b;
    }
}

template <bool NEXT>
__device__ __forceinline__ void phase_combine(const Params& p, int l, unsigned char* smem) {
    unsigned char* ws = launder_ws(p.ws);
    const int tid = my_tid(), lane = tid & 63, wave = tid >> 6;
    int* INV = (int*)(ws + WS_INV);
    const bf16_t* YS = (const bf16_t*)(ws + WS_XE);
    const float* MODc = (const float*)(ws + WS_MOD + (size_t)(l & 1) * MOD_BYTES);
    const float* MODn = (const float*)(ws + WS_MOD + (size_t)((l + 1) & 1) * MOD_BYTES);
    float* Wg = (float*)smem;
    bf16_t* U = (bf16_t*)(ws + WS_U); float* GT = (float*)(ws + WS_GATES);
    const float* gain = PIN(I_N1G) + (size_t)(NEXT ? l + 1 : 0) * DM;
    if (NEXT) { for (int idx = tid; idx < 16384; idx += NTHR) { const int k = idx >> 4, j = idx & 15; Wg[j * 1024 + k] = PIN(I_WIN)[(size_t)(l + 1) * DM * INW + (size_t)k * INW + 2304 + j]; }
        __syncthreads(); }
    const int rstride = gridDim.x * 8;
    bf16_t* XB = (bf16_t*)(ws + WS_XB); float* outp = POUT();
    int myinv; u32x2 xc4[4];
    { const int row = blockIdx.x * 8 + wave; myinv = INV[(size_t)row * 16 + (lane & 15)];
#pragma unroll
      for (int i = 0; i < 4; ++i) xc4[i] = *(const u32x2*)(XB + (size_t)row * DM + 256 * i + 4 * lane); }
    const int nrows = NEXT ? NROW : NROWL;
    for (int row = blockIdx.x * 8 + wave; row < nrows; row += rstride) {
        int ninv; u32x2 xn4[4];
        { const int r2 = row + rstride < nrows ? row + rstride : row; ninv = INV[(size_t)r2 * 16 + (lane & 15)];
#pragma unroll
          for (int i = 0; i < 4; ++i) xn4[i] = *(const u32x2*)(XB + (size_t)r2 * DM + 256 * i + 4 * lane); }
        float acc[16];
#pragma unroll
        for (int j = 0; j < 16; ++j) acc[j] = 0.f;
        {
            unsigned msk = (unsigned)(__ballot(myinv >= 0 && lane < 16)) & 0xffffu;
            if (msk) {
                const int e0 = __ffs(msk) - 1; msk &= msk - 1;
                const int s0 = __shfl(myinv, e0);
                const bool two = msk != 0u; int s1 = s0;
                if (two) { const int e1 = __ffs(msk) - 1; msk &= msk - 1; s1 = __shfl(myinv, e1); }
                u32x2 w0[4], w1[4];
#pragma unroll
                for (int i = 0; i < 4; ++i) { w0[i] = *(const u32x2*)(YS + (size_t)s0 * DM + 256 * i + 4 * lane); w1[i] = *(const u32x2*)(YS + (size_t)s1 * DM + 256 * i + 4 * lane); }
                const float f1 = two ? 1.0f : 0.0f;
#pragma unroll
                for (int i = 0; i < 4; ++i) { acc[4 * i + 0] = bflo(w0[i].x) + f1 * bflo(w1[i].x); acc[4 * i + 1] = bfhi(w0[i].x) + f1 * bfhi(w1[i].x);
                    acc[4 * i + 2] = bflo(w0[i].y) + f1 * bflo(w1[i].y); acc[4 * i + 3] = bfhi(w0[i].y) + f1 * bfhi(w1[i].y); }
                while (msk) { const int e = __ffs(msk) - 1; msk &= msk - 1; const int s = __shfl(myinv, e);
#pragma unroll
                    for (int i = 0; i < 4; ++i) { const u32x2 w = *(const u32x2*)(YS + (size_t)s * DM + 256 * i + 4 * lane);
                        acc[4 * i + 0] += bflo(w.x); acc[4 * i + 1] += bfhi(w.x); acc[4 * i + 2] += bflo(w.y); acc[4 * i + 3] += bfhi(w.y); } }
            }
        }
        if (lane < 16) INV[(size_t)row * 16 + lane] = -1;
        const int mrow = row < NROWL ? (row >> 12) : 16;
        const float* gt = MODc + (size_t)mrow * 6144 + 5120;
        float ss = 0.f;
#pragma unroll
        for (int i = 0; i < 4; ++i) { const int k = 256 * i + 4 * lane;
            float4 xv = make_float4(bflo(xc4[i].x), bfhi(xc4[i].x), bflo(xc4[i].y), bfhi(xc4[i].y)); const float4 g = *(const float4*)(gt + k);
            xv.x += g.x * acc[4 * i + 0]; xv.y += g.y * acc[4 * i + 1]; xv.z += g.z * acc[4 * i + 2]; xv.w += g.w * acc[4 * i + 3];
            if (NEXT) { u32x2 w; w.x = pack_bf16(xv.x, xv.y); w.y = pack_bf16(xv.z, xv.w); *(u32x2*)(XB + (size_t)row * DM + k) = w; }
            else *(float4*)(outp + (size_t)row * DM + k) = xv;
            acc[4 * i + 0] = xv.x; acc[4 * i + 1] = xv.y; acc[4 * i + 2] = xv.z; acc[4 * i + 3] = xv.w;
            ss += xv.x * xv.x + xv.y * xv.y + xv.z * xv.z + xv.w * xv.w; }
        myinv = ninv;
#pragma unroll
        for (int i = 0; i < 4; ++i) xc4[i] = xn4[i];
        if (NEXT) {
            ss = wave_sum(ss);
            const float inv = rsqrtf(ss * (1.0f / 1024.0f) + EPSF);
            const float* mod = MODn + (size_t)mrow * 6144;
            float part[16];
#pragma unroll
            for (int j = 0; j < 16; ++j) part[j] = 0.f;
#pragma unroll
            for (int i = 0; i < 4; ++i) { const int k = 256 * i + 4 * lane;
                const float4 g = *(const float4*)(gain + k), sh = *(const float4*)(mod + k), sc = *(const float4*)(mod + 1024 + k);
                float4 h; h.x = acc[4 * i + 0] * inv * g.x * (1.f + sc.x) + sh.x; h.y = acc[4 * i + 1] * inv * g.y * (1.f + sc.y) + sh.y; h.z = acc[4 * i + 2] * inv * g.z * (1.f + sc.z) + sh.z; h.w = acc[4 * i + 3] * inv * g.w * (1.f + sc.w) + sh.w;
                u32x2 w; w.x = pack_bf16(h.x, h.y); w.y = pack_bf16(h.z, h.w);
                *(u32x2*)(U + (size_t)row * DM + k) = w;
#pragma unroll
                for (int j = 0; j < 16; ++j) { const float4 wv = *(const float4*)(Wg + j * 1024 + k); part[j] += h.x * wv.x + h.y * wv.y + h.z * wv.z + h.w * wv.w; }
                asm volatile("" ::: "memory"); }
            const float v1 = reduce16_transpose(part, lane);
            const int jx = ((lane >> 5) & 1) * 8 + ((lane >> 4) & 1) * 4 + ((lane >> 3) & 1) * 2 + ((lane >> 2) & 1);
            if ((lane & 3) == 0) GT[(size_t)row * 16 + jx] = v1;
        }
    }
    __syncthreads();
}
struct AttnItem { int qrow0, qpos0, qcol, kcol, vcol, ycol; int nt0, krow0, kpos0, masked; int nt1, krow1; float M2, sink2, lam, postscale; const float* subgain; };
#define FA_LD 72

template <int NC>
__device__ __forceinline__ void fattn_item(const bf16_t* __restrict__ P, bf16_t* __restrict__ Y, const AttnItem& it, unsigned char* smem) {
    constexpr int KS = (NC == 2) ? 2 : 4;
    const int tid = my_tid(), lane = tid & 63, w = tid >> 6, h = lane >> 5, lq = lane & 31;
    bf16_t* Kb = (bf16_t*)smem;
    bf16_t* Vb = Kb + 2 * 64 * FA_LD;
    const LAS unsigned char* vlds = (const LAS unsigned char*)(smem) + 2 * 64 * FA_LD * 2;
    bf16x8 qf[NC][KS];
    { const bf16_t* qp = P + (size_t)(it.qrow0 + 32 * w + lq) * PW + it.qcol + 8 * h;
#pragma unroll
      for (int c = 0; c < NC; ++c)
#pragma unroll
          for (int s = 0; s < KS; ++s) qf[c][s] = *(const bf16x8*)(qp + 32 * c + 16 * s); }
    f32x16 O[NC][2]; float lsum[NC];
#pragma unroll
    for (int c = 0; c < NC; ++c) { lsum[c] = 0.f;
#pragma unroll
        for (int dt = 0; dt < 2; ++dt)
#pragma unroll
            for (int r = 0; r < 16; ++r) O[c][dt][r] = 0.f; }
    const int ntot = it.nt0 + it.nt1;
    const int ldkey = tid >> 3, ldch = tid & 7;
    const int vlane = ((4 * h + ((lane & 15) >> 2)) * FA_LD + 16 * ((lane >> 4) & 1) + 4 * (lane & 3)) * 2;
    u32x4 kreg, vreg;
    { const int krow = it.nt0 > 0 ? it.krow0 : it.krow1; const bf16_t* kp = P + (size_t)(krow + ldkey) * PW;
      kreg = *(const u32x4*)(kp + it.kcol + ldch * 8); vreg = *(const u32x4*)(kp + it.vcol + ldch * 8); }
    __syncthreads();
    *(u32x4*)(Kb + ldkey * FA_LD + ldch * 8) = kreg; *(u32x4*)(Vb + ldkey * FA_LD + ldch * 8) = vreg;
    __syncthreads();
    const int qpos = it.qpos0 + 32 * w + lq;
    for (int kt = 0; kt < ntot; ++kt) {
        const int buf = kt & 1;
        int kpos = 0; bool msk = false;
        if (kt < it.nt0) { kpos = it.kpos0 + 64 * kt; msk = it.masked != 0; }
        if (kt + 1 < ntot) { const int k2 = kt + 1; const int krow = k2 < it.nt0 ? it.krow0 + 64 * k2 : it.krow1 + 64 * (k2 - it.nt0);
            const bf16_t* kp = P + (size_t)(krow + ldkey) * PW; kreg = *(const u32x4*)(kp + it.kcol + ldch * 8); vreg = *(const u32x4*)(kp + it.vcol + ldch * 8); }
        bool skip = false;
        if (msk) { const int q0 = it.qpos0 + 32 * w; skip = (kpos > q0 + 31 + 128) || (kpos + 63 < q0 - 128); }
        if (!skip) {
            const bf16_t* kb = Kb + buf * 64 * FA_LD; const LAS unsigned char* vb = vlds + buf * 64 * FA_LD * 2 + vlane;
#pragma unroll
            for (int sub = 0; sub < 2; ++sub) {
                unsigned pk[NC][2][4];
#pragma unroll
                for (int c = 0; c < NC; ++c) {
                    f32x16 S;
#pragma unroll
                    for (int r = 0; r < 16; ++r) S[r] = -it.M2;
#pragma unroll
                    for (int s = 0; s < KS; ++s) { const bf16x8 a = *(const bf16x8*)(kb + (32 * sub + lq) * FA_LD + 32 * c + 16 * s + 8 * h);
                        S = __builtin_amdgcn_mfma_f32_32x32x16_bf16(a, qf[c][s], S, 0, 0, 0); }
                    float pv[16];
#pragma unroll
                    for (int r = 0; r < 16; ++r) { pv[r] = fast_exp2(S[r]);
                        if (NC == 1) { if (msk) { const int d = qpos - (kpos + 32 * sub + CROW(r, lane)); if (d > 128 || d < -128) pv[r] = 0.f; } } }
#pragma unroll
                    for (int r = 0; r < 16; ++r) lsum[c] += pv[r];
#pragma unroll
                    for (int s = 0; s < 2; ++s)
#pragma unroll
                        for (int jj = 0; jj < 4; ++jj) pk[c][s][jj] = pg8::cvt_pk_bf16(pv[8 * s + 2 * jj], pv[8 * s + 2 * jj + 1]);
                }
#pragma unroll
                for (int s = 0; s < 2; ++s)
#pragma unroll
                    for (int dt = 0; dt < 2; ++dt) {
                        const s16x4 lo = tr_read(vb + (32 * sub + 16 * s) * FA_LD * 2 + 64 * dt), hi = tr_read(vb + (32 * sub + 16 * s + 8) * FA_LD * 2 + 64 * dt);
                        const bf16x8 a = __builtin_shufflevector(lo, hi, 0, 1, 2, 3, 4, 5, 6, 7);
#pragma unroll
                        for (int c = 0; c < NC; ++c) { u32x4 bw; bw.x = pk[c][s][0]; bw.y = pk[c][s][1]; bw.z = pk[c][s][2]; bw.w = pk[c][s][3];
                            O[c][dt] = __builtin_amdgcn_mfma_f32_32x32x16_bf16(a, __builtin_bit_cast(bf16x8, bw), O[c][dt], 0, 0, 0); }
                    }
            }
        }
        if (kt + 1 < ntot) { bf16_t* kd = Kb + (buf ^ 1) * 64 * FA_LD; bf16_t* vd = Vb + (buf ^ 1) * 64 * FA_LD;
            *(u32x4*)(kd + ldkey * FA_LD + ldch * 8) = kreg; *(u32x4*)(vd + ldkey * FA_LD + ldch * 8) = vreg; }
        __syncthreads();
    }
    float linv[NC];
#pragma unroll
    for (int c = 0; c < NC; ++c) { const float l = lsum[c] + __shfl_xor(lsum[c], 32); linv[c] = (NC == 1) ? 1.0f / (l + fast_exp2(it.sink2 - it.M2)) : 1.0f / l; }
    bf16_t* yp = Y + (size_t)(it.qrow0 + 32 * w + lq) * DM + it.ycol + 4 * h;
    if (NC == 1) {
#pragma unroll
        for (int dt = 0; dt < 2; ++dt)
#pragma unroll
            for (int g = 0; g < 4; ++g) { u32x2 wv; wv.x = pg8::cvt_pk_bf16(O[0][dt][4 * g] * linv[0], O[0][dt][4 * g + 1] * linv[0]); wv.y = pg8::cvt_pk_bf16(O[0][dt][4 * g + 2] * linv[0], O[0][dt][4 * g + 3] * linv[0]);
                *(u32x2*)(yp + 32 * dt + 8 * g) = wv; }
    } else {
        const float a1 = it.lam * linv[NC - 1];
        float ss = 0.f;
#pragma unroll
        for (int dt = 0; dt < 2; ++dt)
#pragma unroll
            for (int r = 0; r < 16; ++r) { const float v = O[0][dt][r] * linv[0] - a1 * O[NC - 1][dt][r]; O[0][dt][r] = v; ss += v * v; }
        ss += __shfl_xor(ss, 32);
        const float rinv = rsqrtf(ss * (1.0f / 64.0f) + EPSF) * it.postscale;
        const float* sg = it.subgain + 4 * h;
#pragma unroll
        for (int dt = 0; dt < 2; ++dt)
#pragma unroll
            for (int g = 0; g < 4; ++g) { const float4 gg = *(const float4*)(sg + 32 * dt + 8 * g);
                u32x2 wv; wv.x = pg8::cvt_pk_bf16(O[0][dt][4 * g] * rinv * gg.x, O[0][dt][4 * g + 1] * rinv * gg.y); wv.y = pg8::cvt_pk_bf16(O[0][dt][4 * g + 2] * rinv * gg.z, O[0][dt][4 * g + 3] * rinv * gg.w);
                *(u32x2*)(yp + 32 * dt + 8 * g) = wv; }
    }
}


#define FD_RING 4
__device__ __forceinline__ void fattn_d_item(const bf16_t* __restrict__ P, bf16_t* __restrict__ Y, const AttnItem& it, unsigned char* smem) {
    const int tid = my_tid(), lane = tid & 63, w = tid >> 6, h = lane >> 5, lq = lane & 31;
    bf16_t* ring = (bf16_t*)smem;
    const LAS unsigned char* rlds = (const LAS unsigned char*)smem;
    constexpr int TB = 64 * FA_LD * 2;
    bf16x8 qf[2][2];
    { const bf16_t* qp = P + (size_t)(it.qrow0 + 32 * w + lq) * PW + it.qcol + 8 * h;
#pragma unroll
      for (int c = 0; c < 2; ++c)
#pragma unroll
          for (int s = 0; s < 2; ++s) qf[c][s] = *(const bf16x8*)(qp + 32 * c + 16 * s); }
    f32x16 O[2][2]; float lsum[2] = {0.f, 0.f};
#pragma unroll
    for (int c = 0; c < 2; ++c)
#pragma unroll
        for (int dt = 0; dt < 2; ++dt)
#pragma unroll
            for (int r = 0; r < 16; ++r) O[c][dt][r] = 0.f;
    const int ntot = it.nt0 + it.nt1;
    const int ldkey = tid >> 3, ldch = tid & 7;
    const int vlane = ((4 * h + ((lane & 15) >> 2)) * FA_LD + 16 * ((lane >> 4) & 1) + 4 * (lane & 3)) * 2;
    const int klane = (lq * FA_LD + 8 * h) * 2;
#define FD_TROW(k) ((k) < it.nt0 ? it.krow0 + 64 * (k) : it.krow1 + 64 * ((k) - it.nt0))
#define FD_GLOAD(k) do { const bf16_t* kp_ = P + (size_t)(FD_TROW(k) + ldkey) * PW; kreg = *(const u32x4*)(kp_ + it.kcol + ldch * 8); vreg = *(const u32x4*)(kp_ + it.vcol + ldch * 8); } while (0)
#define FD_LSTORE(k) do { bf16_t* d_ = ring + (size_t)((k) & (FD_RING - 1)) * 2 * 64 * FA_LD + ldkey * FA_LD + ldch * 8; *(u32x4*)d_ = kreg; *(u32x4*)(d_ + 64 * FA_LD) = vreg; } while (0)
    u32x4 kreg, vreg;
    __syncthreads();
    FD_GLOAD(0); FD_LSTORE(0);
    if (ntot > 1) { FD_GLOAD(1); FD_LSTORE(1); }
    __syncthreads();
    f32x16 zero16;
#pragma unroll
    for (int r = 0; r < 16; ++r) zero16[r] = 0.f;
    f32x16 SS[2];
    { const LAS unsigned char* kb = rlds + klane;
      SS[0] = __builtin_amdgcn_mfma_f32_32x32x16_bf16(*(const LAS bf16x8*)(kb), qf[0][0], zero16, 0, 0, 0);
      SS[0] = __builtin_amdgcn_mfma_f32_32x32x16_bf16(*(const LAS bf16x8*)(kb + 32), qf[0][1], SS[0], 0, 0, 0); }
    unsigned pkp[2][4];
#pragma unroll
    for (int s = 0; s < 2; ++s)
#pragma unroll
        for (int j = 0; j < 4; ++j) pkp[s][j] = 0u;
    for (int kt = 0; kt < ntot; ++kt) {
        if (kt + 2 < ntot) FD_GLOAD(kt + 2);
        const LAS unsigned char* cb = rlds + (size_t)(kt & (FD_RING - 1)) * 2 * TB;
        const LAS unsigned char* nb = rlds + (size_t)((kt + 1) & (FD_RING - 1)) * 2 * TB;
        const LAS unsigned char* pb = rlds + (size_t)((kt + FD_RING - 1) & (FD_RING - 1)) * 2 * TB;
#pragma unroll
        for (int u = 0; u < 4; ++u) {
            const int c = u & 1;
            const int nsub = ((u + 1) & 3) >> 1, nc = (u + 1) & 1;
            const int psub = ((u + 3) & 3) >> 1, pc = (u + 3) & 1;
            const LAS unsigned char* ka = ((u < 3) ? cb : nb) + klane + (32 * nsub) * FA_LD * 2 + 64 * nc;
            const LAS unsigned char* va = ((u > 0) ? cb : pb) + TB + vlane + (32 * psub) * FA_LD * 2;
            const bf16x8 kf0 = *(const LAS bf16x8*)(ka), kf1 = *(const LAS bf16x8*)(ka + 32);
            bf16x8 vf[2][2];
#pragma unroll
            for (int s = 0; s < 2; ++s)
#pragma unroll
                for (int dt = 0; dt < 2; ++dt) { const s16x4 lo = tr_read(va + (16 * s) * FA_LD * 2 + 64 * dt), hi = tr_read(va + (16 * s + 8) * FA_LD * 2 + 64 * dt);
                    vf[s][dt] = __builtin_shufflevector(lo, hi, 0, 1, 2, 3, 4, 5, 6, 7); }
            __builtin_amdgcn_sched_barrier(0);
            f32x16& Sc = SS[u & 1]; f32x16& Sn = SS[(u + 1) & 1];
            unsigned pkc[2][4];
#pragma unroll
            for (int s = 0; s < 2; ++s) {
                float pv[8];
#pragma unroll
                for (int j = 0; j < 8; ++j) pv[j] = fast_exp2(Sc[8 * s + j]);
                lsum[c] += ((pv[0] + pv[1]) + (pv[2] + pv[3])) + ((pv[4] + pv[5]) + (pv[6] + pv[7]));
#pragma unroll
                for (int jj = 0; jj < 4; ++jj) pkc[s][jj] = pg8::cvt_pk_bf16(pv[2 * jj], pv[2 * jj + 1]);
            }
            if ((u < 3) || (kt + 1 < ntot)) {
                Sn = __builtin_amdgcn_mfma_f32_32x32x16_bf16(kf0, qf[nc][0], zero16, 0, 0, 0);
                Sn = __builtin_amdgcn_mfma_f32_32x32x16_bf16(kf1, qf[nc][1], Sn, 0, 0, 0); }
            if ((u > 0) || (kt > 0)) {
#pragma unroll
                for (int s = 0; s < 2; ++s) { u32x4 bw; bw.x = pkp[s][0]; bw.y = pkp[s][1]; bw.z = pkp[s][2]; bw.w = pkp[s][3];
#pragma unroll
                    for (int dt = 0; dt < 2; ++dt) O[pc][dt] = __builtin_amdgcn_mfma_f32_32x32x16_bf16(vf[s][dt], __builtin_bit_cast(bf16x8, bw), O[pc][dt], 0, 0, 0); } }
            __builtin_amdgcn_sched_group_barrier(0x2, 5, 0);
#pragma unroll
            for (int g = 0; g < 6; ++g) { __builtin_amdgcn_sched_group_barrier(0x8, 1, 0); __builtin_amdgcn_sched_group_barrier(0x2, 5, 0); }
            __builtin_amdgcn_sched_barrier(0);
#pragma unroll
            for (int s = 0; s < 2; ++s)
#pragma unroll
                for (int j = 0; j < 4; ++j) pkp[s][j] = pkc[s][j];
        }
        if (kt + 2 < ntot) FD_LSTORE(kt + 2);
        __syncthreads();
    }
    { const LAS unsigned char* va = rlds + (size_t)((ntot - 1) & (FD_RING - 1)) * 2 * TB + TB + vlane + 32 * FA_LD * 2;
#pragma unroll
      for (int s = 0; s < 2; ++s) { u32x4 bw; bw.x = pkp[s][0]; bw.y = pkp[s][1]; bw.z = pkp[s][2]; bw.w = pkp[s][3];
#pragma unroll
          for (int dt = 0; dt < 2; ++dt) {
              const s16x4 lo = tr_read(va + (16 * s) * FA_LD * 2 + 64 * dt), hi = tr_read(va + (16 * s + 8) * FA_LD * 2 + 64 * dt);
              const bf16x8 a = __builtin_shufflevector(lo, hi, 0, 1, 2, 3, 4, 5, 6, 7);
              O[1][dt] = __builtin_amdgcn_mfma_f32_32x32x16_bf16(a, __builtin_bit_cast(bf16x8, bw), O[1][dt], 0, 0, 0); } } }
#undef FD_TROW
#undef FD_GLOAD
#undef FD_LSTORE
    float linv[2];
#pragma unroll
    for (int c = 0; c < 2; ++c) { const float l = lsum[c] + __shfl_xor(lsum[c], 32); linv[c] = 1.0f / l; }
    bf16_t* yp = Y + (size_t)(it.qrow0 + 32 * w + lq) * DM + it.ycol + 4 * h;
    const float a1 = it.lam * linv[1];
    float ss = 0.f;
#pragma unroll
    for (int dt = 0; dt < 2; ++dt)
#pragma unroll
        for (int r = 0; r < 16; ++r) { const float v = O[0][dt][r] * linv[0] - a1 * O[1][dt][r]; O[0][dt][r] = v; ss += v * v; }
    ss += __shfl_xor(ss, 32);
    const float rinv = rsqrtf(ss * (1.0f / 64.0f) + EPSF) * it.postscale;
    const float* sg = it.subgain + 4 * h;
#pragma unroll
    for (int dt = 0; dt < 2; ++dt)
#pragma unroll
        for (int g = 0; g < 4; ++g) { const float4 gg = *(const float4*)(sg + 32 * dt + 8 * g);
            u32x2 wv; wv.x = pg8::cvt_pk_bf16(O[0][dt][4 * g] * rinv * gg.x, O[0][dt][4 * g + 1] * rinv * gg.y); wv.y = pg8::cvt_pk_bf16(O[0][dt][4 * g + 2] * rinv * gg.z, O[0][dt][4 * g + 3] * rinv * gg.w);
            *(u32x2*)(yp + 32 * dt + 8 * g) = wv; }
}

__device__ __forceinline__ float max_abs_vec(const float* g, int n) { float m = 0.f; for (int i = 0; i < n; ++i) m = fmaxf(m, fabsf(g[i])); return m; }

__device__ __forceinline__ int attn_item_remap(int x0, int G) {
    if (G != 256 || x0 >= 1024) return x0;
    const int i = x0 >> 8, bid = x0 & 255, xcd = bid & 7, slot = bid >> 3;
    const int bh = i * 16 + xcd * 2 + (slot >> 4), n = slot & 15;
    return bh * 16 + n;
}
__device__ __forceinline__ void phase_attnA(const Params& p, int l, unsigned char* smem) {
    unsigned char* ws = launder_ws(p.ws);
    const bf16_t* P = (const bf16_t*)(ws + WS_P); bf16_t* Y = (bf16_t*)(ws + WS_U);
    const float bound = 8.0f * LOG2E * 1.02f * max_abs_vec(PIN(I_AQN) + l * 64, 64) * max_abs_vec(PIN(I_AKN) + l * 64, 64);
    const int nitems = (l == DEPTH - 1) ? 1024 : 1088;
    const int cshift = (gridDim.x == 256) ? 64 : 0;
    for (int x0 = blockIdx.x; x0 < nitems + cshift; x0 += gridDim.x) {
        if (x0 >= 1024 && x0 < 1024 + cshift) continue;
        const int x = attn_item_remap(x0 >= 1024 ? x0 - cshift : x0, gridDim.x);
        AttnItem it; it.subgain = nullptr; it.lam = 0.f; it.postscale = 1.f;
        int b, h, n;
        if (x < 1024) { b = x >> 6; h = (x >> 4) & 3; n = x & 15;
            const int lo = max(0, 256 * n - 128), hi = min(TL, 256 * n + 384);
            it.qrow0 = b * TL + 256 * n; it.qpos0 = 256 * n; it.nt0 = (hi - lo) >> 6; it.krow0 = b * TL + lo; it.kpos0 = lo; it.masked = 1; }
        else { const int y = x - 1024; b = y >> 2; h = y & 3;
            it.qrow0 = NROWL + b * TCX; it.qpos0 = 0; it.nt0 = 0; it.krow0 = 0; it.kpos0 = 0; it.masked = 0; }
        it.nt1 = 4; it.krow1 = NROWL + b * TCX;
        it.qcol = h * 64; it.kcol = 256 + (h >> 1) * 64; it.vcol = 384 + (h >> 1) * 64; it.ycol = h * 64;
        it.sink2 = PIN(I_ASINK)[l * 4 + h] * LOG2E; it.M2 = fmaxf(bound, it.sink2);
        fattn_item<1>(P, Y, it, smem);
    }
}
__device__ __forceinline__ void phase_attnD(const Params& p, int l, unsigned char* smem) {
    unsigned char* ws = launder_ws(p.ws);
    const bf16_t* P = (const bf16_t*)(ws + WS_P); bf16_t* Y = (bf16_t*)(ws + WS_U);
    const float bound = 5.656854249f * LOG2E * 1.02f * max_abs_vec(PIN(I_DQN) + l * 32, 32) * max_abs_vec(PIN(I_DKN) + l * 32, 32);
    float d1 = 0.f, d2 = 0.f;
    for (int i = 0; i < 32; ++i) { d1 += PIN(I_LQ1)[l * 32 + i] * PIN(I_LK1)[l * 32 + i]; d2 += PIN(I_LQ2)[l * 32 + i] * PIN(I_LK2)[l * 32 + i]; }
    const float lam_init = 0.8f - 0.6f * expf(-0.3f * (float)l);
    const float lam = expf(d1) - expf(d2) + lam_init;
    const int nitems = (l == DEPTH - 1) ? 1024 : 1088;
    for (int x0 = blockIdx.x; x0 < nitems; x0 += gridDim.x) {
        const int x = attn_item_remap(x0, gridDim.x);
        AttnItem it; it.subgain = PIN(I_DSUB) + l * 64; it.lam = lam; it.postscale = 1.0f - lam_init; it.sink2 = 0.f; it.M2 = bound;
        int b, h, n;
        if (x < 1024) { b = x >> 6; h = (x >> 4) & 3; n = x & 15;
            it.qrow0 = b * TL + 256 * n; it.qpos0 = 0; it.nt0 = 64; it.krow0 = b * TL; it.kpos0 = 0; it.masked = 0; }
        else { const int y = x - 1024; b = y >> 2; h = y & 3;
            it.qrow0 = NROWL + b * TCX; it.qpos0 = 0; it.nt0 = 0; it.krow0 = 0; it.kpos0 = 0; it.masked = 0; }
        it.nt1 = 4; it.krow1 = NROWL + b * TCX;
        it.qcol = 1536 + h * 64; it.kcol = 1792 + h * 64; it.vcol = 2048 + h * 64; it.ycol = 768 + h * 64;
        if (bound < 100.0f) fattn_d_item(P, Y, it, smem); else fattn_item<2>(P, Y, it, smem);
    }
}

#define HY_ZROWS 4160
#define HY_FLEN 8256
#define HY_OFF_F (HY_ZROWS * 32)
#define HY_OFF_MISC (HY_OFF_F + HY_FLEN * 2)

__device__ __forceinline__ void hy_kloop(const LAS unsigned char* zs, const LAS bf16_t* fs, int w, int lane, f32x4 (&acc)[4][8]) {
    const int i = lane & 15, q = lane >> 4, qq = (lane & 15) >> 2, pp = lane & 3;
    const LAS bf16_t* ap = fs + (4096 - 512 * w + 8 * q - 8 * i);
    const LAS unsigned char* bp = zs + (8 * q + qq) * 32 + pp * 8;
    bf16x8 an[4];
#pragma unroll
    for (int m = 0; m < 4; ++m) an[m] = *(const LAS bf16x8*)(ap - 128 * m);
#pragma unroll 1
    for (int ks = 0; ks < 129; ++ks) {
        bf16x8 a[4];
#pragma unroll
        for (int m = 0; m < 4; ++m) a[m] = an[m];
#pragma unroll
        for (int m = 0; m < 4; ++m) an[m] = *(const LAS bf16x8*)(ap + 32 * (ks + 1) - 128 * m);
#pragma unroll
        for (int r = 0; r < 8; ++r) {
            const s16x4 lo = tr_read(bp + (32 * ks + r) * 32), hi = tr_read(bp + (32 * ks + r) * 32 + 128);
            const bf16x8 b = __builtin_shufflevector(lo, hi, 0, 1, 2, 3, 4, 5, 6, 7);
#pragma unroll
            for (int m = 0; m < 4; ++m) acc[m][r] = __builtin_amdgcn_mfma_f32_16x16x32_bf16(a[m], b, acc[m][r], 0, 0, 0);
        }
    }
}
__device__ __forceinline__ float hy_sconv(const bf16_t* u, int t, int T, float c0, float c1, float c2) {
    const int tm = t > 0 ? t - 1 : 0, tp = t < T - 1 ? t + 1 : T - 1;
    const float um = bf2f(u[tm]), u0 = bf2f(u[t]), up = bf2f(u[tp]);
    return (t > 0 ? c0 : 0.f) * um + c1 * u0 + (t < T - 1 ? c2 : 0.f) * up;
}
__device__ __forceinline__ void hy_gate8(const bf16_t* ub  , int t0, float c0, float c1, float c2, float (&g)[8]) {
    const u32x4 raw = *(const u32x4*)ub; const float hl = bf2f(ub[-1]), hr = bf2f(ub[8]);
    float x[10];
    x[0] = t0 > 0 ? hl : 0.f; x[9] = t0 + 8 < 4096 ? hr : 0.f;
    x[1] = bflo(raw.x); x[2] = bfhi(raw.x); x[3] = bflo(raw.y); x[4] = bfhi(raw.y); x[5] = bflo(raw.z); x[6] = bfhi(raw.z); x[7] = bflo(raw.w); x[8] = bfhi(raw.w);
#pragma unroll
    for (int e = 0; e < 8; ++e) g[e] = c0 * x[e] + c1 * x[e + 1] + c2 * x[e + 2];
}
__device__ __forceinline__ float block_sum(float v, float* red  ) {
    v = wave_sum(v);
    __syncthreads();
    if ((my_tid() & 63) == 0) red[my_tid() >> 6] = v;
    __syncthreads();
    float s = 0.f;
#pragma unroll
    for (int w = 0; w < 8; ++w) s += red[w];
    return s;
}

__device__ __forceinline__ void phase_hyena(const Params& p, int l, unsigned char* smem) {
    unsigned char* ws = launder_ws(p.ws);
    LAS unsigned char* lds = (LAS unsigned char*)smem;
    bf16_t* Zs = (bf16_t*)smem; bf16_t* Fs = (bf16_t*)(smem + HY_OFF_F);
    float* fw3c = (float*)(smem + HY_OFF_MISC);
    float* red = fw3c + 256;
    float* HT = (float*)smem;
    const bf16_t* UT = (const bf16_t*)(ws + WS_UT);
    bf16_t* YT = (bf16_t*)(ws + WS_YT);
    const float* H2L = (const float*)(ws + WS_HID2L); const float* H2C = (const float*)(ws + WS_HID2C);
    const float* fw3 = PIN(I_FW3) + (size_t)l * 64 * 1024;
    const float* cw = PIN(I_HYCONV) + (size_t)l * 3 * 768;
    const float da = logf(1e-2f) / 1.5f, db = logf(1e-2f) / 0.3f;
    for (int c = blockIdx.x; c < 256; c += gridDim.x) {
        const int tid = my_tid(), lane = tid & 63, w = tid >> 6;
        bf16_t* FB = (bf16_t*)(ws + WS_FBUF) + (size_t)c * HY_FLEN;
        const float delta = fabsf(da + (float)c * ((db - da) / 255.0f));
        const float bias0 = PIN(I_HYBIAS)[l * 512 + c], bias1 = PIN(I_HYBIAS)[l * 512 + 256 + c];
        __syncthreads();
        if (tid < 256) fw3c[tid] = fw3[(size_t)(tid & 63) * 1024 + (tid >> 6) * 256 + c];
        __syncthreads();
        float ss0 = 0.f, ss1 = 0.f;
#pragma unroll 1
        for (int lag = tid; lag < 4096; lag += NTHR) {
            const float4* hr = (const float4*)(H2L + (size_t)lag * 64);
            float a0 = 0.f, a1 = 0.f, a2 = 0.f, a3 = 0.f;
#pragma unroll
            for (int k4 = 0; k4 < 16; ++k4) { const float4 h = hr[k4];
                a0 += h.x * fw3c[4 * k4] + h.y * fw3c[4 * k4 + 1] + h.z * fw3c[4 * k4 + 2] + h.w * fw3c[4 * k4 + 3];
                a1 += h.x * fw3c[64 + 4 * k4] + h.y * fw3c[64 + 4 * k4 + 1] + h.z * fw3c[64 + 4 * k4 + 2] + h.w * fw3c[64 + 4 * k4 + 3];
                a2 += h.x * fw3c[128 + 4 * k4] + h.y * fw3c[128 + 4 * k4 + 1] + h.z * fw3c[128 + 4 * k4 + 2] + h.w * fw3c[128 + 4 * k4 + 3];
                a3 += h.x * fw3c[192 + 4 * k4] + h.y * fw3c[192 + 4 * k4 + 1] + h.z * fw3c[192 + 4 * k4 + 2] + h.w * fw3c[192 + 4 * k4 + 3]; }
            const float dec = expf(-((float)lag / 4095.0f) * delta);
            a0 *= dec; a1 *= dec; a2 *= dec; a3 *= dec;
            HT[lag] = a0; HT[4096 + lag] = a1; HT[8192 + lag] = a2; HT[12288 + lag] = a3;
            ss0 += a0 * a0 + (lag >= 1 ? a2 * a2 : 0.f); ss1 += a1 * a1 + (lag >= 1 ? a3 * a3 : 0.f);
        }
        ss0 = block_sum(ss0, red); ss1 = block_sum(ss1, red);
        const float n0 = rsqrtf(ss0 + EPSF), n1 = rsqrtf(ss1 + EPSF);
#pragma unroll 1
        for (int x = tid; x < HY_FLEN; x += NTHR) { const int d = 4128 - x; float f0 = 0.f, f1 = 0.f;
            if (d >= 0 && d <= 4095) { f0 = HT[d] * n0; f1 = HT[4096 + d] * n1; } else if (d < 0 && d >= -4095) { f0 = HT[8192 - d] * n0; f1 = HT[12288 - d] * n1; }
            Fs[x] = f2bf(f0); FB[x] = f2bf(f1); }
        __syncthreads();
        for (int idx = tid; idx < 1024; idx += NTHR) { const int rr = idx >> 4; Zs[(rr < 32 ? rr : 4096 + rr) * 16 + (idx & 15)] = 0; }
        { const bf16_t* u = UT + (size_t)c * NROW; const float v0 = cw[c], v1 = cw[768 + c], v2 = cw[1536 + c];
#pragma unroll 2
          for (int idx = tid; idx < 8192; idx += NTHR) { const int b = idx >> 9, t0 = (idx & 511) * 8;
              float g[8]; hy_gate8(u + b * 4096 + t0, t0, v0, v1, v2, g);
#pragma unroll
              for (int i = 0; i < 8; ++i) Zs[(t0 + i + 32) * 16 + b] = f2bf(g[i]); } }
        __syncthreads();
        f32x4 acc[4][8];
#pragma unroll
        for (int m = 0; m < 4; ++m)
#pragma unroll
            for (int r = 0; r < 8; ++r) acc[m][r] = (f32x4){0.f, 0.f, 0.f, 0.f};
        hy_kloop(lds, (const LAS bf16_t*)(lds + HY_OFF_F), w, lane, acc);
        { int lo = lane, wo = w; asm volatile("" : "+v"(lo), "+v"(wo));
          const float g0 = cw[256 + c], g1 = cw[768 + 256 + c], g2 = cw[1536 + 256 + c];
          const int tb0 = 512 * wo + 32 * (lo >> 4);
          const bf16_t* u1 = UT + (size_t)(256 + c) * NROW + (lo & 15) * 4096 + tb0;
          const bf16_t* zp = Zs + (tb0 + 32) * 16 + (lo & 15);
#pragma unroll
          for (int m = 0; m < 4; ++m)
#pragma unroll
              for (int j = 0; j < 4; ++j) { float g[8]; hy_gate8(u1 + 128 * m + 8 * j, tb0 + 128 * m + 8 * j, g0, g1, g2, g);
#pragma unroll
                  for (int r = 0; r < 8; ++r) { const float z = bf2f(zp[(128 * m + r + 8 * j) * 16]); acc[m][r][j] = g[r] * (acc[m][r][j] + bias0 * z); }
                  asm volatile("" ::: "memory"); } }
        __syncthreads();
        { int lo = lane, wo = w; asm volatile("" : "+v"(lo), "+v"(wo));
          bf16_t* zp = Zs + (512 * wo + 32 * (lo >> 4) + 32) * 16 + (lo & 15);
#pragma unroll
          for (int m = 0; m < 4; ++m)
#pragma unroll
              for (int r = 0; r < 8; ++r) {
#pragma unroll
                  for (int j = 0; j < 4; ++j) zp[(128 * m + r + 8 * j) * 16] = f2bf(acc[m][r][j]);
                  asm volatile("" ::: "memory"); } }
        for (int x = tid; x < HY_FLEN / 8; x += NTHR) ((u32x4*)Fs)[x] = ((const u32x4*)FB)[x];
        __syncthreads();
#pragma unroll
        for (int m = 0; m < 4; ++m)
#pragma unroll
            for (int r = 0; r < 8; ++r) acc[m][r] = (f32x4){0.f, 0.f, 0.f, 0.f};
        hy_kloop(lds, (const LAS bf16_t*)(lds + HY_OFF_F), w, lane, acc);
        { int lo = lane, wo = w; asm volatile("" : "+v"(lo), "+v"(wo));
          const float e0 = cw[512 + c], e1 = cw[768 + 512 + c], e2 = cw[1536 + 512 + c];
          const int tb0 = 512 * wo + 32 * (lo >> 4);
          const bf16_t* u2 = UT + (size_t)(512 + c) * NROW + (lo & 15) * 4096 + tb0;
          bf16_t* yo = YT + (size_t)c * NROW + (lo & 15) * 4096 + tb0;
          const bf16_t* zp = Zs + (tb0 + 32) * 16 + (lo & 15);
#pragma unroll
          for (int m = 0; m < 4; ++m)
#pragma unroll
              for (int j = 0; j < 4; ++j) { float g[8]; hy_gate8(u2 + 128 * m + 8 * j, tb0 + 128 * m + 8 * j, e0, e1, e2, g);
#pragma unroll
                  for (int r = 0; r < 8; ++r) { const float z1 = bf2f(zp[(128 * m + r + 8 * j) * 16]); g[r] = g[r] * (acc[m][r][j] + bias1 * z1); }
                  u32x4 o; o.x = pack_bf16(g[0], g[1]); o.y = pack_bf16(g[2], g[3]); o.z = pack_bf16(g[4], g[5]); o.w = pack_bf16(g[6], g[7]);
                  *(u32x4*)(yo + 128 * m + 8 * j) = o;
                  asm volatile("" ::: "memory"); } }
        __syncthreads();
        if (l < DEPTH - 1) {   float* HTc = (float*)smem;
            const float v0 = cw[c], v1 = cw[768 + c], v2 = cw[1536 + c], g0 = cw[256 + c], g1 = cw[768 + 256 + c], g2 = cw[1536 + 256 + c], e0 = cw[512 + c], e1 = cw[768 + 512 + c], e2 = cw[1536 + 512 + c];
            float* Zc = HTc + 1024;
            float* Z1c = Zc + 4096;
            float t0 = 0.f, t1 = 0.f;
            if (tid < 256) { const int lag = tid; const float* hr = H2C + (size_t)lag * 64; float a0 = 0.f, a1 = 0.f, a2 = 0.f, a3 = 0.f;
                for (int k = 0; k < 64; ++k) { const float h = hr[k]; a0 += h * fw3c[k]; a1 += h * fw3c[64 + k]; a2 += h * fw3c[128 + k]; a3 += h * fw3c[192 + k]; }
                const float dec = expf(-((float)lag / 255.0f) * delta);
                a0 *= dec; a1 *= dec; a2 *= dec; a3 *= dec;
                HTc[lag] = a0; HTc[256 + lag] = a1; HTc[512 + lag] = a2; HTc[768 + lag] = a3;
                t0 = a0 * a0 + (lag >= 1 ? a2 * a2 : 0.f); t1 = a1 * a1 + (lag >= 1 ? a3 * a3 : 0.f); }
            t0 = block_sum(t0, red); t1 = block_sum(t1, red);
            const float m0 = rsqrtf(t0 + EPSF), m1 = rsqrtf(t1 + EPSF);
            const bf16_t* uc = UT + (size_t)c * NROW + NROWL;
#pragma unroll 1
            for (int idx = tid; idx < 4096; idx += NTHR) { const int b = idx >> 8, t = idx & 255; Zc[t * 16 + b] = hy_sconv(uc + b * 256, t, 256, v0, v1, v2); }
            __syncthreads();
            const bf16_t* u1c = UT + (size_t)(256 + c) * NROW + NROWL; const bf16_t* u2c = UT + (size_t)(512 + c) * NROW + NROWL;
            const int tq = tid & 255, bh = tid >> 8;
            float y[8];
#pragma unroll
            for (int i = 0; i < 8; ++i) y[i] = 0.f;
#pragma unroll 2
            for (int s2 = 0; s2 < 256; ++s2) { const int d = tq - s2; const float h = d >= 0 ? HTc[d] : HTc[512 - d];
                const float4 za = *(const float4*)(Zc + s2 * 16 + 8 * bh), zb = *(const float4*)(Zc + s2 * 16 + 8 * bh + 4);
                y[0] += h * za.x; y[1] += h * za.y; y[2] += h * za.z; y[3] += h * za.w; y[4] += h * zb.x; y[5] += h * zb.y; y[6] += h * zb.z; y[7] += h * zb.w; }
#pragma unroll
            for (int i = 0; i < 8; ++i) { const int b = 8 * bh + i; const float yy = y[i] * m0 + bias0 * Zc[tq * 16 + b];
                Z1c[tq * 16 + b] = hy_sconv(u1c + b * 256, tq, 256, g0, g1, g2) * yy; y[i] = 0.f; }
            __syncthreads();
#pragma unroll 2
            for (int s2 = 0; s2 < 256; ++s2) { const int d = tq - s2; const float h = d >= 0 ? HTc[256 + d] : HTc[768 - d];
                const float4 za = *(const float4*)(Z1c + s2 * 16 + 8 * bh), zb = *(const float4*)(Z1c + s2 * 16 + 8 * bh + 4);
                y[0] += h * za.x; y[1] += h * za.y; y[2] += h * za.z; y[3] += h * za.w; y[4] += h * zb.x; y[5] += h * zb.y; y[6] += h * zb.z; y[7] += h * zb.w; }
#pragma unroll
            for (int i = 0; i < 8; ++i) { const int b = 8 * bh + i; const float yy = y[i] * m1 + bias1 * Z1c[tq * 16 + b];
                YT[(size_t)c * NROW + NROWL + b * 256 + tq] = f2bf(hy_sconv(u2c + b * 256, tq, 256, e0, e1, e2) * yy); }
            __syncthreads();
        }
    }
}

__device__ __forceinline__ void phase_hy_transpose(const Params& p, int l, unsigned char* smem) {
    unsigned char* ws = launder_ws(p.ws);
    const bf16_t* YT = (const bf16_t*)(ws + WS_YT); bf16_t* Y = (bf16_t*)(ws + WS_U);
    bf16_t* tile = (bf16_t*)smem;
    const int tid = my_tid();
    const int ntile = 4 * ((l == DEPTH - 1 ? NROWL : NROW) / 64);
    for (int it = blockIdx.x; it < ntile; it += gridDim.x) {
        const int ct = it & 3, rt = it >> 2;
        __syncthreads();
        { const int ch = tid >> 3, seg = tid & 7;
          const u32x4 v = *(const u32x4*)(YT + (size_t)(ct * 64 + ch) * NROW + rt * 64 + seg * 8);
          unsigned* d = (unsigned*)(tile + ch * 66 + seg * 8); d[0] = v.x; d[1] = v.y; d[2] = v.z; d[3] = v.w; }
        __syncthreads();
        { const int r = tid >> 3, seg = tid & 7;
          unsigned wv[4];
#pragma unroll
          for (int k = 0; k < 4; ++k) wv[k] = (unsigned)tile[(seg * 8 + 2 * k) * 66 + r] | ((unsigned)tile[(seg * 8 + 2 * k + 1) * 66 + r] << 16);
          u32x4 o; o.x = wv[0]; o.y = wv[1]; o.z = wv[2]; o.w = wv[3];
          *(u32x4*)(Y + (size_t)(rt * 64 + r) * DM + 256 + ct * 64 + seg * 8) = o; }
    }
    __syncthreads();
}
#define ML_ITEMS 4352
__device__ __forceinline__ void ml_decode(int it, int& b, int& head, int& tc, int& tok0, int& jf, int& jb) {
    b = it / 272; const int r = it - b * 272; head = r / 68; tc = r - head * 68;
    tok0 = tc < 4 ? NROWL + b * TCX + 64 * tc : b * TL + 64 * (tc - 4);
    jf = tc; jb = tc < 4 ? 3 - tc : 71 - tc;
}

__device__ __forceinline__ void phase_ml_local(const Params& p, int l, unsigned char* smem) {
    unsigned char* ws = launder_ws(p.ws);
    const int tid = my_tid(), lane = tid & 63, w = tid >> 6;
    bf16_t* Kt = (bf16_t*)smem;
    bf16_t* VwF = Kt + 64 * 72;
    bf16_t* VwB = VwF + 64 * 72;
    float* Vs = (float*)(VwB + 64 * 72);
    float* vec = Vs + 64 * 65;
    float* igf = vec, *igb = vec + 64, *lff = vec + 128, *lfb = vec + 192, *wf = vec + 256, *wb = vec + 320, *scal = vec + 384;
    const bf16_t* P = (const bf16_t*)(ws + WS_P);
    const float* GT = (const float*)(ws + WS_GATES);
    bf16_t* MLA = (bf16_t*)(ws + WS_MLA); float* MLN = (float*)(ws + WS_MLN); float* MLS = (float*)(ws + WS_MLS);
    const float* bg = PIN(I_BGATE) + l * 16;
    for (int it = blockIdx.x; it < ML_ITEMS; it += gridDim.x) {
        int b, head, tc, tok0, jf, jb; ml_decode(it, b, head, tc, tok0, jf, jb);
        __syncthreads();
        { const int s = tid >> 3, ch = tid & 7;
          const bf16_t* pr = P + (size_t)(tok0 + s) * PW + head * 64 + ch * 8;
          const u32x4 kv = *(const u32x4*)(pr + 768), vv = *(const u32x4*)(pr + 1024);
          const unsigned kw[4] = {kv.x, kv.y, kv.z, kv.w}, vw[4] = {vv.x, vv.y, vv.z, vv.w};
#pragma unroll
          for (int i = 0; i < 4; ++i) { Kt[(ch * 8 + 2 * i) * 72 + s] = f2bf(bflo(kw[i]) * 0.125f); Kt[(ch * 8 + 2 * i + 1) * 72 + s] = f2bf(bfhi(kw[i]) * 0.125f);
              Vs[s * 65 + ch * 8 + 2 * i] = bflo(vw[i]); Vs[s * 65 + ch * 8 + 2 * i + 1] = bfhi(vw[i]); } }
        if (tid < 64) { const float* g = GT + (size_t)(tok0 + tid) * 16;
            igf[tid] = g[head] + bg[head]; igb[tid] = g[4 + head] + bg[4 + head]; lff[tid] = log_sigmoid(g[8 + head] + bg[8 + head]); lfb[tid] = log_sigmoid(g[12 + head] + bg[12 + head]); }
        __syncthreads();
        if (tid < 128) {
            const int dirw = tid >> 6, tau = tid & 63, s = dirw ? 63 - tau : tau;
            const float lf = dirw ? lfb[s] : lff[s], ig = dirw ? igb[s] : igf[s];
            float cum = lf;
#pragma unroll
            for (int o = 1; o < 64; o <<= 1) { const float n = __shfl_up(cum, o); if (tau >= o) cum += n; }
            const float B = __shfl(cum, 63);
            const float ge = B - cum + ig;
            const float ml = wave_max(ge);
            (dirw ? wb : wf)[s] = expf(ge - ml);
            if (tau == 0) { scal[2 * dirw] = B; scal[2 * dirw + 1] = ml; } }
        __syncthreads();
        { const int e = tid >> 3, sc = (tid & 7) * 8; u32x4 a, c2; float x[8], y[8];
#pragma unroll
          for (int i = 0; i < 8; ++i) { const float v = Vs[(sc + i) * 65 + e]; x[i] = v * wf[sc + i]; y[i] = v * wb[sc + i]; }
          a.x = pack_bf16(x[0], x[1]); a.y = pack_bf16(x[2], x[3]); a.z = pack_bf16(x[4], x[5]); a.w = pack_bf16(x[6], x[7]);
          c2.x = pack_bf16(y[0], y[1]); c2.y = pack_bf16(y[2], y[3]); c2.z = pack_bf16(y[4], y[5]); c2.w = pack_bf16(y[6], y[7]);
          *(u32x4*)(VwF + e * 72 + sc) = a; *(u32x4*)(VwB + e * 72 + sc) = c2; }
        __syncthreads();
        const int dir = w >> 2, wl = w & 3, te = wl >> 1, tk = wl & 1;
        const int seq = (b * 4 + head) * 2 + dir, j = dir ? jb : jf;
        bf16_t* dst = MLA + ((size_t)seq * 68 + j) * 4096;
        { f32x16 C;
#pragma unroll
          for (int r = 0; r < 16; ++r) C[r] = 0.f;
          C = mma32((dir ? VwB : VwF) + 32 * te * 72, 72, Kt + 32 * tk * 72, 72, 64, C, lane);
#pragma unroll
          for (int r = 0; r < 16; ++r) dst[(32 * te + CROW(r, lane)) * 64 + 32 * tk + (lane & 31)] = f2bf(C[r]); }
        if (wl == 0) {
            const float* wv = dir ? wb : wf; float s = 0.f;
            for (int t = 0; t < 64; ++t) s += wv[t] * bf2f(Kt[lane * 72 + t]);
            MLN[((size_t)seq * 68 + j) * 64 + lane] = s;
            if (lane == 0) { MLS[((size_t)seq * 68 + j) * 4 + 0] = scal[2 * dir]; MLS[((size_t)seq * 68 + j) * 4 + 1] = scal[2 * dir + 1]; }
        }
    }
    __syncthreads();
}

__device__ __forceinline__ void phase_ml_scan(const Params& p) {
    unsigned char* ws = launder_ws(p.ws);
    const int tid = my_tid();
    unsigned* MLA = (unsigned*)(ws + WS_MLA); float* MLN = (float*)(ws + WS_MLN); float* MLS = (float*)(ws + WS_MLS);
    for (int it = blockIdx.x; it < 512; it += gridDim.x) {
        const int seq = it >> 2, part = it & 3;
        unsigned* base = MLA + (size_t)seq * 68 * 2048 + part * 512 + tid;
        float* nb = MLN + (size_t)seq * 68 * 64 + part * 16 + tid;
        float* sc = MLS + (size_t)seq * 68 * 4;
        const bool hasn = tid < 16;
        float m = 0.f, c0 = 0.f, c1 = 0.f, cn = 0.f;
#define ML_SCAN_BATCH(NBATCH, J0) do { unsigned a[NBATCH]; float an[NBATCH], B[NBATCH], ML[NBATCH]; \
            _Pragma("unroll") for (int u = 0; u < NBATCH; ++u) { a[u] = base[(size_t)((J0) + u) * 2048]; an[u] = hasn ? nb[((J0) + u) * 64] : 0.f; B[u] = sc[((J0) + u) * 4]; ML[u] = sc[((J0) + u) * 4 + 1]; } \
            _Pragma("unroll") for (int u = 0; u < NBATCH; ++u) { \
                const float mn = fmaxf(B[u] + m, ML[u]); const float wp = expf(B[u] + m - mn), wa = expf(ML[u] - mn); \
                if (part == 0 && tid == 0) sc[((J0) + u) * 4 + 2] = m; \
                base[(size_t)((J0) + u) * 2048] = pack_bf16(c0, c1); if (hasn) nb[((J0) + u) * 64] = cn; \
                c0 = wp * c0 + wa * bflo(a[u]); c1 = wp * c1 + wa * bfhi(a[u]); cn = wp * cn + wa * an[u]; m = mn; } } while (0)
        for (int j0 = 0; j0 < 64; j0 += 8) ML_SCAN_BATCH(8, j0);
        ML_SCAN_BATCH(4, 64);
#undef ML_SCAN_BATCH
    }
}

__device__ __forceinline__ void phase_ml_out(const Params& p, int l, unsigned char* smem) {
    unsigned char* ws = launder_ws(p.ws);
    const int tid = my_tid(), lane = tid & 63, w = tid >> 6;
    const int DSZ = 71680;
    const bf16_t* P = (const bf16_t*)(ws + WS_P);
    const float* GT = (const float*)(ws + WS_GATES);
    const bf16_t* MLA = (const bf16_t*)(ws + WS_MLA); const float* MLN = (const float*)(ws + WS_MLN); const float* MLS = (const float*)(ws + WS_MLS);
    bf16_t* Y = (bf16_t*)(ws + WS_U);
    const float* bg = PIN(I_BGATE) + l * 16; const float* mln = PIN(I_MLNORM) + l * 64;
    u32x4 pq, pk_, pv, pst[2]; float pn = 0.f, pg0 = 0.f, pg1 = 0.f, pm = 0.f;
#define ML_SKIP(it_) ({ int b_, h_, tc_, t0_, jf_, jb_; ml_decode((it_), b_, h_, tc_, t0_, jf_, jb_); (l == DEPTH - 1 && tc_ < 4); })
#define ML_FETCH(it_) do { int b_, h_, tc_, t0_, jf_, jb_; ml_decode((it_), b_, h_, tc_, t0_, jf_, jb_); \
        { const int s_ = tid >> 3, ch_ = tid & 7; const bf16_t* pr_ = P + (size_t)(t0_ + s_) * PW + h_ * 64 + ch_ * 8; \
          pq = *(const u32x4*)(pr_ + 512); pk_ = *(const u32x4*)(pr_ + 768); pv = *(const u32x4*)(pr_ + 1024); } \
        _Pragma("unroll") for (int d_ = 0; d_ < 2; ++d_) { const int seq_ = (b_ * 4 + h_) * 2 + d_, j_ = d_ ? jb_ : jf_; \
          pst[d_] = *(const u32x4*)(MLA + ((size_t)seq_ * 68 + j_) * 4096 + (tid >> 3) * 64 + (tid & 7) * 8); } \
        if (tid < 128) { const int d_ = tid >> 6, tau_ = tid & 63, tk_ = d_ ? 63 - tau_ : tau_; const int seq_ = (b_ * 4 + h_) * 2 + d_, j_ = d_ ? jb_ : jf_; \
          pn = MLN[((size_t)seq_ * 68 + j_) * 64 + tau_]; const float* g_ = GT + (size_t)(t0_ + tk_) * 16; \
          pg0 = g_[4 * d_ + h_]; pg1 = g_[8 + 4 * d_ + h_]; pm = MLS[((size_t)seq_ * 68 + j_) * 4 + 2]; } } while (0)
    int it = blockIdx.x;
    while (it < ML_ITEMS && ML_SKIP(it)) it += gridDim.x;
    if (it < ML_ITEMS) ML_FETCH(it);
    while (it < ML_ITEMS) {
        int b, head, tc, tok0, jf, jb; ml_decode(it, b, head, tc, tok0, jf, jb);
        int nit = it + gridDim.x;
        while (nit < ML_ITEMS && ML_SKIP(nit)) nit += gridDim.x;
        __syncthreads();
        {   const int s = tid >> 3, ch = tid & 7;
            const u32x4 qv = pq, kv = pk_, vv = pv;
            u32x4 ks; ks.x = pack_bf16(bflo(kv.x) * 0.125f, bfhi(kv.x) * 0.125f); ks.y = pack_bf16(bflo(kv.y) * 0.125f, bfhi(kv.y) * 0.125f);
            ks.z = pack_bf16(bflo(kv.z) * 0.125f, bfhi(kv.z) * 0.125f); ks.w = pack_bf16(bflo(kv.w) * 0.125f, bfhi(kv.w) * 0.125f);
            const unsigned vw[4] = {vv.x, vv.y, vv.z, vv.w};
#pragma unroll
            for (int d = 0; d < 2; ++d) { unsigned char* D = smem + d * DSZ; const int tau = d ? 63 - s : s;
                bf16_t* Qd = (bf16_t*)D; bf16_t* Kd = Qd + 64 * 72; bf16_t* Bd = Kd + 64 * 72 + 64 * 136;
                *(u32x4*)(Qd + tau * 72 + ch * 8) = qv; *(u32x4*)(Kd + tau * 72 + ch * 8) = ks;
#pragma unroll
                for (int i = 0; i < 4; ++i) { Bd[(ch * 8 + 2 * i) * 136 + tau] = (bf16_t)(vw[i] & 0xffff); Bd[(ch * 8 + 2 * i + 1) * 136 + tau] = (bf16_t)(vw[i] >> 16); } }
#pragma unroll
            for (int d = 0; d < 2; ++d) { unsigned char* D = smem + d * DSZ; bf16_t* Bd = (bf16_t*)D + 2 * 64 * 72 + 64 * 136;
                const int e = tid >> 3, k0 = (tid & 7) * 8;
                *(u32x4*)(Bd + e * 136 + 64 + k0) = pst[d]; }
            if (tid < 128) { const int d = tid >> 6, tau = tid & 63;
                float* vecs = (float*)(smem + d * DSZ + 53248);
                vecs[3 * 64 + tau] = pn;
                vecs[4 * 64 + tau] = pg0 + bg[4 * d + head];
                vecs[5 * 64 + tau] = log_sigmoid(pg1 + bg[8 + 4 * d + head]); }
        }
        const float mcur = pm;
        if (nit < ML_ITEMS) ML_FETCH(nit);
        __syncthreads();
        if (tid < 128) { const int d = tid >> 6, tau = tid & 63; float* vecs = (float*)(smem + d * DSZ + 53248);
            const int seq = (b * 4 + head) * 2 + d, j = d ? jb : jf;
            const float m = mcur;
            float cum = vecs[5 * 64 + tau];
#pragma unroll
            for (int o = 1; o < 64; o <<= 1) { const float n = __shfl_up(cum, o); if (tau >= o) cum += n; }
            float mm = vecs[4 * 64 + tau] - cum;
#pragma unroll
            for (int o = 1; o < 64; o <<= 1) { const float n = __shfl_up(mm, o); if (tau >= o) mm = fmaxf(mm, n); }
            const float mt = cum + fmaxf(m, mm);
            vecs[tau] = cum; vecs[64 + tau] = mt; vecs[128 + tau] = expf(cum + m - mt); }
        __syncthreads();
        const int d = w >> 2, wl = w & 3, tt = wl >> 1, tx = wl & 1;
        unsigned char* D = smem + d * DSZ;
        bf16_t* Qd = (bf16_t*)D; bf16_t* Kd = Qd + 64 * 72; bf16_t* Ad = Kd + 64 * 72; bf16_t* Bd = Ad + 64 * 136;
        float* vecs = (float*)(D + 53248); float* Hd = vecs + 7 * 64;
        {   f32x16 S;
#pragma unroll
            for (int r = 0; r < 16; ++r) S[r] = 0.f;
            S = mma32(Qd + 32 * tt * 72, 72, Kd + 32 * tx * 72, 72, 64, S, lane);
            const int s = 32 * tx + (lane & 31); const float bs = vecs[s], igs = vecs[4 * 64 + s];
#pragma unroll
            for (int r = 0; r < 16; ++r) { const int t = 32 * tt + CROW(r, lane);
                const float val = (s <= t) ? S[r] * fast_exp2((vecs[t] - bs + igs - vecs[64 + t]) * LOG2E) : 0.f;
                Ad[t * 136 + s] = f2bf(val); }
            const int tl = tid & 255, t = tl >> 2, qd = tl & 3; const float wi = vecs[128 + t];
#pragma unroll
            for (int v = 0; v < 2; ++v) { const u32x4 q = *(const u32x4*)(Qd + t * 72 + 16 * qd + 8 * v); u32x4 o;
                o.x = pack_bf16(bflo(q.x) * wi, bfhi(q.x) * wi); o.y = pack_bf16(bflo(q.y) * wi, bfhi(q.y) * wi); o.z = pack_bf16(bflo(q.z) * wi, bfhi(q.z) * wi); o.w = pack_bf16(bflo(q.w) * wi, bfhi(q.w) * wi);
                *(u32x4*)(Ad + t * 136 + 64 + 16 * qd + 8 * v) = o; }
        }
        __syncthreads();
        {   f32x16 N;
#pragma unroll
            for (int r = 0; r < 16; ++r) N[r] = 0.f;
            N = mma32(Ad + 32 * tt * 136, 136, Bd + 32 * tx * 136, 136, 128, N, lane);
#pragma unroll
            for (int r = 0; r < 16; ++r) Hd[(32 * tt + CROW(r, lane)) * 65 + 32 * tx + (lane & 31)] = N[r];
            const int tl = tid & 255;
            {
                const int t = tl >> 2, qd = tl & 3; float dn = 0.f;
                const u32x4 sa = *(const u32x4*)(Ad + t * 136 + 16 * qd), sb = *(const u32x4*)(Ad + t * 136 + 16 * qd + 8);
                const u32x4 qa = *(const u32x4*)(Ad + t * 136 + 64 + 16 * qd), qb = *(const u32x4*)(Ad + t * 136 + 64 + 16 * qd + 8);
                const float* nv = vecs + 3 * 64 + 16 * qd;
                dn += (bflo(sa.x) + bfhi(sa.x)) + (bflo(sa.y) + bfhi(sa.y)) + (bflo(sa.z) + bfhi(sa.z)) + (bflo(sa.w) + bfhi(sa.w));
                dn += (bflo(sb.x) + bfhi(sb.x)) + (bflo(sb.y) + bfhi(sb.y)) + (bflo(sb.z) + bfhi(sb.z)) + (bflo(sb.w) + bfhi(sb.w));
                dn += bflo(qa.x) * nv[0] + bfhi(qa.x) * nv[1] + bflo(qa.y) * nv[2] + bfhi(qa.y) * nv[3] + bflo(qa.z) * nv[4] + bfhi(qa.z) * nv[5] + bflo(qa.w) * nv[6] + bfhi(qa.w) * nv[7];
                dn += bflo(qb.x) * nv[8] + bfhi(qb.x) * nv[9] + bflo(qb.y) * nv[10] + bfhi(qb.y) * nv[11] + bflo(qb.z) * nv[12] + bfhi(qb.z) * nv[13] + bflo(qb.w) * nv[14] + bfhi(qb.w) * nv[15];
                dn += dpp_get<DPP_XOR1>(dn); dn += dpp_get<DPP_XOR2>(dn);
                if (qd == 0) vecs[6 * 64 + t] = dn; }
        }
        __syncthreads();
        {   const int s = tid >> 3, e0 = (tid & 7) * 8;
            const float* vF = (const float*)(smem + 53248); const float* HF = vF + 7 * 64;
            const float* vB = (const float*)(smem + DSZ + 53248); const float* HB = vB + 7 * 64;
            const int tb = 63 - s;
            const float rf = 1.0f / fmaxf(fabsf(vF[6 * 64 + s]), fast_exp2(-vF[64 + s] * LOG2E)), rb = 1.0f / fmaxf(fabsf(vB[6 * 64 + tb]), fast_exp2(-vB[64 + tb] * LOG2E));
            float y[8], ss = 0.f;
#pragma unroll
            for (int i = 0; i < 8; ++i) { y[i] = HF[s * 65 + e0 + i] * rf + HB[tb * 65 + e0 + i] * rb; ss += y[i] * y[i]; }
            ss += __shfl_xor(ss, 1); ss += __shfl_xor(ss, 2); ss += __shfl_xor(ss, 4);
            const float rinv = rsqrtf(ss * (1.0f / 64.0f) + EPSF);
            const u32x4 ov = *(const u32x4*)(P + (size_t)(tok0 + s) * PW + 1280 + head * 64 + e0);
            const float op[8] = {bflo(ov.x), bfhi(ov.x), bflo(ov.y), bfhi(ov.y), bflo(ov.z), bfhi(ov.z), bflo(ov.w), bfhi(ov.w)};
            float o[8];
#pragma unroll
            for (int i = 0; i < 8; ++i) o[i] = y[i] * rinv * mln[e0 + i] * __builtin_amdgcn_rcpf(1.0f + fast_exp2(-op[i] * LOG2E));
            u32x4 wv; wv.x = pack_bf16(o[0], o[1]); wv.y = pack_bf16(o[2], o[3]); wv.z = pack_bf16(o[4], o[5]); wv.w = pack_bf16(o[6], o[7]);
            *(u32x4*)(Y + (size_t)(tok0 + s) * DM + 512 + head * 64 + e0) = wv;
        }
        it = nit;
    }
#undef ML_SKIP
#undef ML_FETCH
    __syncthreads();
}
#ifndef DUPMASK
#define DUPMASK 0
#endif
#ifndef PROBE_KIND
#define PROBE_KIND 0
#endif
#ifndef PROBE_MASK
#define PROBE_MASK 0
#endif
#ifndef PROBE_MULT
#define PROBE_MULT 1
#endif
#if PROBE_KIND
#define PROBE_PRE() do { if (blockIdx.x == 0 && threadIdx.x == 0) pw[0] = (unsigned)wall_clock64(); } while (0)
#define PROBE_POST(id) do { if (blockIdx.x == 0 && threadIdx.x == 0) { const unsigned t_ = (unsigned)wall_clock64(), c_ = (unsigned)clock64(); \
        if ((PROBE_MASK >> (id)) & 1) { if (PROBE_KIND == 1) pw[2] += t_ - pw[1]; if (PROBE_KIND == 2) pw[2] += t_ - pw[0]; if (PROBE_KIND == 3) { pw[2] += t_ - pw[1]; pw[3] += c_ - pw[4]; } } \
        pw[1] = t_; pw[4] = c_; } } while (0)
#else
#define PROBE_PRE() do {} while (0)
#define PROBE_POST(id) do {} while (0)
#endif
#define XBAR(id) do { PROBE_PRE(); XcdBarrier _b; _b.bar = (unsigned*)(launder_ws(p.ws) + WS_BAR); _b.x = xb_xcc_id(); _b.st = xbw; xcd_barrier(_b); if ((DUPMASK >> 13) & 1) xcd_barrier(_b); PROBE_POST(id); } while (0)
#define REP(k) for (int _rep = 0; _rep < 1 + ((DUPMASK >> (k)) & 1); ++_rep)
extern __shared__ __attribute__((aligned(16))) unsigned char smem_raw[];

__global__ void __launch_bounds__(NTHR, 2) trunk_fwd(Params p) {
    unsigned char* smem = smem_raw;
    volatile LAS unsigned* xbw = (volatile LAS unsigned*)(smem_raw + LDS_BYTES - 16);
    if (threadIdx.x == 0) { xbw[0] = 0u; xbw[1] = 0u; xbw[2] = 0u; xbw[3] = 0u; }
    __syncthreads();
    (void)xcd_barrier_post((unsigned*)(p.ws + WS_BAR), xbw);
#if PROBE_KIND
    volatile LAS unsigned* pw = (volatile LAS unsigned*)(smem_raw + LDS_BYTES - 48);
    if (blockIdx.x == 0 && threadIdx.x == 0) { pw[1] = (unsigned)wall_clock64(); pw[4] = (unsigned)clock64(); pw[2] = 0u; pw[3] = 0u; }
#endif
    unsigned char* ws = p.ws;
    LAS unsigned char* lds = (LAS unsigned char*)smem_raw;
    const int G = gridDim.x, c = blockIdx.x;
    phase_W<0>(p, 0, smem);
    XBAR(0);
    phase_norm<1>(p, 0, smem);
    XBAR(1);
    for (int l = 0; l < DEPTH; ++l) {
        const bool last = (l == DEPTH - 1);
        REP(10) {   pg8::Gemm g; g.A = (const bf16_t*)(ws + WS_U); g.Bt = (const bf16_t*)(ws + WS_U); g.M = 0; g.N = 0; g.K = DM;
            InProjOrder S{G, c}; EpiInProj E{(bf16_t*)(ws + WS_P), (bf16_t*)(ws + WS_UT), PIN(I_DQN) + l * 32, PIN(I_DKN) + l * 32, (const float2*)(ws + WS_ROPE) + 64 * 16};
            pg8::gemm_phase(lds, g, S, E); }
        XBAR(2);
        phase_prep(p, l, smem);
        XBAR(3);
        REP(0) phase_hyena(p, l, smem);
        REP(1) phase_attnD(p, l, smem);
        REP(2) phase_attnA(p, l, smem);
        REP(3) phase_ml_local(p, l, smem);
        XBAR(4);
        phase_ml_scan(p);
        REP(9) phase_hy_transpose(p, l, smem);
        XBAR(5);
        REP(4) phase_ml_out(p, l, smem);
        XBAR(6);
        {   pg8::Gemm g; g.A = (const bf16_t*)(ws + WS_U); g.Bt = (const bf16_t*)(ws + WS_WOUT); g.M = 0; g.N = 0; g.K = DM;
            OutProjOrder S{G, c, last ? 256 : 272};
            EpiOut E{PIN(I_X), PIN(I_CTX), (bf16_t*)(ws + WS_XB), (const float*)(ws + WS_MOD + (size_t)(l & 1) * MOD_BYTES), l == 0 ? 1 : 0};
            pg8::gemm_phase(lds, g, S, E); }
        XBAR(7);
        REP(6) phase_norm<2>(p, l, smem);
        XBAR(8);
        REP(7) phase_topk(p, l, smem);
        XBAR(9);
        REP(11) {   pg8::Gemm g; g.A = (const bf16_t*)(ws + WS_U); g.Bt = (const bf16_t*)(ws + WS_WGU); g.M = 0; g.N = 0; g.K = DM;
            GateUpOrder S{G, c, last ? 32 : 34}; EpiGU E{(bf16_t*)(ws + WS_HID)};
            pg8::gemm_phase_gather(lds, g, S, E, (const int*)(ws + WS_SROW)); }
        XBAR(10);
        REP(12) {   pg8::Gemm g; g.A = (const bf16_t*)(ws + WS_HID); g.Bt = (const bf16_t*)(ws + WS_WD); g.M = 0; g.N = 0; g.K = DM;
            DownOrder S{G, c, last ? 32 : 34}; EpiDown E{(bf16_t*)(ws + WS_XE), (const float*)(ws + WS_SGATE)};
            pg8::gemm_phase(lds, g, S, E); }
        REP(5) if (l + 1 < DEPTH) phase_W<2>(p, l + 1, smem);
        XBAR(11);
        if (l + 1 < DEPTH) { REP(14) phase_combine<true>(p, l, smem); REP(5) phase_W<1>(p, l + 1, smem); XBAR(12); }
        else phase_combine<false>(p, l, smem);
    }
#if PROBE_KIND
    PROBE_POST(12);
    if (blockIdx.x == 0 && threadIdx.x == 0) {
        unsigned long long target = (unsigned long long)pw[2] * PROBE_MULT;
        if (PROBE_KIND == 3) target = pw[2] ? (unsigned long long)pw[3] * 10000ull / pw[2] : 0ull;
        const unsigned long long t0 = wall_clock64();
        while ((unsigned long long)wall_clock64() - t0 < target) __builtin_amdgcn_s_sleep(8);
    }
#endif
}

extern "C" void kernel_launch(void* const* d_in, const int* in_sizes, int n_in, void* d_out, int out_size, void* d_ws, size_t ws_size, hipStream_t stream) {
    static int grid = 0;
    if (grid == 0) {
        if (n_in != 34 || out_size != NROWL * DM || ws_size < WS_END) { fprintf(stderr, "kernel_launch: unexpected shapes (n_in %d out %d ws %zu need %zu)\n", n_in, out_size, ws_size, (size_t)WS_END); grid = -1; return; }
        int dev = 0, cus = 0;
        if (hipGetDevice(&dev) != hipSuccess || hipDeviceGetAttribute(&cus, hipDeviceAttributeMultiprocessorCount, dev) != hipSuccess) { grid = -1; return; }
        if (hipFuncSetAttribute((const void*)trunk_fwd, hipFuncAttributeMaxDynamicSharedMemorySize, LDS_BYTES) != hipSuccess) { fprintf(stderr, "kernel_launch: hipFuncSetAttribute failed\n"); grid = -1; return; }
        int per_cu = 0;
        if (hipOccupancyMaxActiveBlocksPerMultiprocessor(&per_cu, (const void*)trunk_fwd, NTHR, LDS_BYTES) != hipSuccess || per_cu < 1) { fprintf(stderr, "kernel_launch: occupancy query says %d\n", per_cu); }
        (void)hipGetLastError();
        grid = cus;
        if (grid > 256) grid = 256;
        grid &= ~7;
    }
    if (grid <= 0) return;
    (void)hipMemsetAsync((char*)d_ws + WS_BAR, 0, 16384, stream);
    Params p{};
    for (int i = 0; i < 34; ++i) p.in[i] = (const float*)d_in[i];
    p.out = (float*)d_out; p.ws = (unsigned char*)d_ws;
    hipLaunchKernelGGL(trunk_fwd, dim3(grid), dim3(NTHR), LDS_BYTES, stream, p);
}
```

```cpp
#include <hip/hip_runtime.h>
#include <stdint.h>
#include <stdio.h>

typedef unsigned short bf16_t;
typedef short bf16x8 __attribute__((ext_vector_type(8)));
typedef short s16x4 __attribute__((ext_vector_type(4)));
typedef float f32x4 __attribute__((ext_vector_type(4)));
typedef float f32x16 __attribute__((ext_vector_type(16)));
typedef unsigned u32x4 __attribute__((ext_vector_type(4)));
typedef unsigned u32x2 __attribute__((ext_vector_type(2)));
#define LAS __attribute__((address_space(3)))

#define NB 16
#define TL 4096
#define TCX 256
#define DM 1024
#define NROWL 65536
#define NROWC 4096
#define NROW 69632
#define PW 2304
#define INW 3088
#define NEXP 16
#define CAPL 512
#define CAPC 32
#define SLOTS_E 8704
#define NSLOT 139264
#define DEPTH 4
#define NTHR 512
#define LDS_BYTES 155648
#define EPSF 1e-6f
#define LOG2E 1.4426950408889634f

constexpr size_t al256(size_t x) { return (x + 255) & ~size_t(255); }
constexpr size_t WS_BAR   = 0;
constexpr size_t WS_MOD   = al256(WS_BAR + 16384);
constexpr size_t MOD_BYTES = al256((size_t)17 * 6144 * 4);
constexpr size_t WS_HID2L = al256(WS_MOD + 2 * MOD_BYTES);
constexpr size_t WS_HID2C = al256(WS_HID2L + (size_t)4096 * 64 * 4);
constexpr size_t WS_GATES = al256(WS_HID2C + (size_t)256 * 64 * 4);
constexpr size_t WS_AFF   = al256(WS_GATES + (size_t)NROW * 16 * 4);
constexpr size_t WS_SROW  = al256(WS_AFF + (size_t)NROW * 16 * 4);
constexpr size_t WS_SGATE = al256(WS_SROW + (size_t)NSLOT * 4);
constexpr size_t WS_INV   = al256(WS_SGATE + (size_t)NSLOT * 4);
constexpr size_t WS_MLS   = al256(WS_INV + (size_t)NROW * 16 * 4);
constexpr size_t WS_FBUF  = al256(WS_MLS + (size_t)128 * 68 * 4 * 4);
constexpr size_t WS_ROPE  = al256(WS_FBUF + (size_t)256 * 8256 * 2);
constexpr size_t WS_CTX   = al256(WS_ROPE + (size_t)64 * 24 * 8);
constexpr size_t WS_U     = al256(WS_CTX + (size_t)NROWC * DM * 4);
constexpr size_t WS_WOUT  = al256(WS_U + (size_t)(NROW + 3072) * DM * 2);
constexpr size_t WS_WGU   = al256(WS_WOUT + (size_t)DM * DM * 2);
constexpr size_t WS_WD    = al256(WS_WGU + (size_t)NEXP * 2048 * DM * 2);
constexpr size_t WS_P     = al256(WS_WD + (size_t)NEXP * DM * DM * 2);
constexpr size_t WS_UT    = al256(WS_P + (size_t)NROW * PW * 2);
constexpr size_t WS_XE    = al256(WS_UT + (size_t)768 * NROW * 2);
constexpr size_t WS_XB    = al256(WS_XE + (size_t)NSLOT * DM * 2);
constexpr size_t WS_END   = al256(WS_XB + (size_t)NROW * DM * 2);
constexpr size_t WS_HID   = WS_P;
constexpr size_t WS_MLA   = WS_XE;
constexpr size_t WS_MLN   = al256(WS_MLA + (size_t)128 * 68 * 4096 * 2);
constexpr size_t WS_YT    = al256(WS_MLN + (size_t)128 * 68 * 64 * 4);
static_assert(WS_YT + (size_t)256 * NROW * 2 <= WS_XB, "alias overflow");
static_assert((size_t)NSLOT * DM * 2 <= (size_t)NROW * PW * 2, "hid alias overflow");

struct Params {
    const float* in[34];
    float* out;
    unsigned char* ws;
};
enum { I_X = 0, I_C, I_CTX, I_CCTX, I_WADA, I_BADA, I_N1G, I_N2G, I_WIN, I_BGATE, I_AQN, I_AKN, I_ASINK, I_HYCONV, I_FW1, I_FB1, I_FREQ, I_FW2, I_FB2, I_FW3,
       I_HYBIAS, I_MLNORM, I_DQN, I_DKN, I_LQ1, I_LK1, I_LQ2, I_LK2, I_DSUB, I_WOUT, I_WROUTER, I_WEG, I_WEU, I_WED };

__device__ __forceinline__ int my_tid() { int t = threadIdx.x; asm volatile("" : "+v"(t)); return t; }
#define GAS __attribute__((address_space(1)))
__device__ __forceinline__ unsigned char* launder_ws(unsigned char* q) { GAS unsigned char* g = (GAS unsigned char*)q; asm volatile("" : "+s"(g)); return (unsigned char*)g; }
#define CAS __attribute__((address_space(4)))
__device__ __forceinline__ const float* pin_ptr(int i) { const CAS char* ka = (const CAS char*)__builtin_amdgcn_kernarg_segment_ptr(); asm volatile("" : "+s"(ka));
    const GAS float* g = *(const GAS float* const CAS*)(ka + 8 * i); return (const float*)g; }
#define PIN(i) pin_ptr(i)
#define POUT() ((float*)pin_ptr(34))
__device__ __forceinline__ float bf2f(bf16_t v) { return __uint_as_float((unsigned)v << 16); }
__device__ __forceinline__ bf16_t f2bf(float f) { unsigned u = __float_as_uint(f); u += 0x7fffu + ((u >> 16) & 1u); return (bf16_t)(u >> 16); }
__device__ __forceinline__ unsigned pack_bf16(float lo, float hi) { return (unsigned)f2bf(lo) | ((unsigned)f2bf(hi) << 16); }
__device__ __forceinline__ float bflo(unsigned w) { return __uint_as_float(w << 16); }
__device__ __forceinline__ float bfhi(unsigned w) { return __uint_as_float(w & 0xffff0000u); }
template <int CTRL> __device__ __forceinline__ float dpp_get(float v) { return __int_as_float(__builtin_amdgcn_update_dpp(0, __float_as_int(v), CTRL, 0xf, 0xf, true)); }
#define DPP_XOR1 0xB1
#define DPP_XOR2 0x4E
#define DPP_HMIRROR 0x141
#define DPP_MIRROR 0x140
#define DPP_ROR8 0x128
__device__ __forceinline__ float wave_sum(float v) {
    v += dpp_get<DPP_XOR1>(v); v += dpp_get<DPP_XOR2>(v); v += dpp_get<DPP_HMIRROR>(v); v += dpp_get<DPP_MIRROR>(v);
    const int iv = __float_as_int(v);
    return (__int_as_float(__builtin_amdgcn_readlane(iv, 0)) + __int_as_float(__builtin_amdgcn_readlane(iv, 16))) + (__int_as_float(__builtin_amdgcn_readlane(iv, 32)) + __int_as_float(__builtin_amdgcn_readlane(iv, 48)));
}
__device__ __forceinline__ float wave_max(float v) {
    v = fmaxf(v, dpp_get<DPP_XOR1>(v)); v = fmaxf(v, dpp_get<DPP_XOR2>(v)); v = fmaxf(v, dpp_get<DPP_HMIRROR>(v)); v = fmaxf(v, dpp_get<DPP_MIRROR>(v));
    const int iv = __float_as_int(v);
    return fmaxf(fmaxf(__int_as_float(__builtin_amdgcn_readlane(iv, 0)), __int_as_float(__builtin_amdgcn_readlane(iv, 16))), fmaxf(__int_as_float(__builtin_amdgcn_readlane(iv, 32)), __int_as_float(__builtin_amdgcn_readlane(iv, 48))));
}
__device__ __forceinline__ float lane_xor16(float v, int lane) { const auto r = __builtin_amdgcn_permlane16_swap(__float_as_uint(v), __float_as_uint(v), false, false); return __uint_as_float((lane & 16) ? r[0] : r[1]); }
__device__ __forceinline__ float lane_xor32(float v, int lane) { const auto r = __builtin_amdgcn_permlane32_swap(__float_as_uint(v), __float_as_uint(v), false, false); return __uint_as_float((lane & 32) ? r[0] : r[1]); }
__device__ __forceinline__ float reduce16_transpose(const float (&part)[16], int lane) {
    float v8[8], v4[4], v2[2], v1;
#pragma unroll
    for (int j = 0; j < 8; ++j) { const auto r = __builtin_amdgcn_permlane32_swap(__float_as_uint(part[j]), __float_as_uint(part[8 + j]), false, false); v8[j] = __uint_as_float(r[0]) + __uint_as_float(r[1]); }
#pragma unroll
    for (int j = 0; j < 4; ++j) { const auto r = __builtin_amdgcn_permlane16_swap(__float_as_uint(v8[j]), __float_as_uint(v8[4 + j]), false, false); v4[j] = __uint_as_float(r[0]) + __uint_as_float(r[1]); }
    { const bool up = (lane & 8) != 0;
#pragma unroll
      for (int j = 0; j < 2; ++j) { const float send = up ? v4[j] : v4[2 + j], keep = up ? v4[2 + j] : v4[j]; v2[j] = keep + dpp_get<DPP_ROR8>(send); } }
    { const bool up = (lane & 4) != 0; const float send = up ? v2[0] : v2[1], keep = up ? v2[1] : v2[0]; v1 = keep + dpp_get<DPP_HMIRROR>(send); }
    v1 += dpp_get<DPP_XOR2>(v1); v1 += dpp_get<DPP_XOR1>(v1);
    return v1;
}
__device__ __forceinline__ float fast_exp2(float x) { return __builtin_amdgcn_exp2f(x); }
__device__ __forceinline__ float log_sigmoid(float x) { return fminf(x, 0.f) - log1pf(expf(-fabsf(x))); }

#define XB_TMO      128
#define XB_XCNT(j)  (256  + 64 * (j))
#define XB_XSUB(j)  (1280 + 64 * (j))
#define XB_XGEN(j)  (2304 + 64 * (j))
#define XB_TOP      3328
#define XB_TOPGEN   3392
#define XCD_BAR_WORDS 3456
#define XB_SPIN_CAP (1u << 22)

__device__ __forceinline__ unsigned xb_ld(unsigned* p)              { return __hip_atomic_load(p, __ATOMIC_RELAXED, __HIP_MEMORY_SCOPE_AGENT); }
__device__ __forceinline__ unsigned xb_add(unsigned* p, unsigned v) { return __hip_atomic_fetch_add(p, v, __ATOMIC_RELAXED, __HIP_MEMORY_SCOPE_AGENT); }
__device__ __forceinline__ unsigned xb_xcc_id() { return (unsigned)__builtin_amdgcn_s_getreg((3 << 11) | 20) & 0xFu; }
#define XB_SPIN(cond, bar) do { unsigned _sp = 0; while (cond) { __builtin_amdgcn_s_sleep(1); \
    if ((++_sp & 255u) == 0u) { if (xb_ld(&(bar)[XB_TMO])) break; if (_sp > XB_SPIN_CAP) { atomicAdd(&(bar)[XB_TMO], 1u); break; } } } } while (0)

struct XcdBarrier { unsigned* bar; unsigned x; volatile LAS unsigned* st; };

__device__ __forceinline__ XcdBarrier xcd_barrier_post(unsigned* bar, volatile LAS unsigned* st) {
    XcdBarrier b; b.bar = bar; b.x = xb_xcc_id(); b.st = st;
    if (threadIdx.x == 0) (void)xb_add(&bar[XB_XCNT(b.x)], 1u);
    return b;
}
__device__ __forceinline__ void xcd_barrier_complete(unsigned* bar, unsigned x, unsigned& nloc, unsigned& nx) {
    const unsigned G = gridDim.x * gridDim.y * gridDim.z;
    unsigned sum, cnt, mine, sp = 0u;
    for (;;) {
        sum = 0u; cnt = 0u; mine = 0u;
#pragma unroll
        for (unsigned j = 0; j < 16; ++j) { const unsigned c = xb_ld(&bar[XB_XCNT(j)]); sum += c; cnt += (c > 0u) ? 1u : 0u; mine = (j == x) ? c : mine; }
        if (sum == G) break;
        __builtin_amdgcn_s_sleep(1);
        if ((++sp & 255u) == 0u) { if (xb_ld(&bar[XB_TMO])) break; if (sp > XB_SPIN_CAP) { atomicAdd(&bar[XB_TMO], 1u); break; } }
    }
    nloc = mine > 0u ? mine : 1u; nx = cnt > 0u ? cnt : 1u;
}
__device__ __forceinline__ void xcd_barrier(const XcdBarrier& b) {
    asm volatile("s_waitcnt vmcnt(0)" ::: "memory");
    __syncthreads();
    if (threadIdx.x == 0) {
        unsigned* bar = b.bar;
        __builtin_amdgcn_s_waitcnt(0);
        unsigned nloc = b.st[0], nx = b.st[1];
        if (nloc == 0u) { xcd_barrier_complete(bar, b.x, nloc, nx); b.st[0] = nloc; b.st[1] = nx; }
        const unsigned old = xb_add(&bar[XB_XSUB(b.x)], 1u);
        const unsigned gen = old / nloc;
        if (old + 1u == (gen + 1u) * nloc) {
            __builtin_amdgcn_fence(__ATOMIC_RELEASE, "agent");
            asm volatile("s_waitcnt vmcnt(0)" ::: "memory");
            const unsigned og = xb_add(&bar[XB_TOP], 1u);
            const unsigned tg = og / nx;
            if (og + 1u == (tg + 1u) * nx) xb_add(&bar[XB_TOPGEN], 1u);
            else XB_SPIN(xb_ld(&bar[XB_TOPGEN]) == tg, bar);
            __builtin_amdgcn_fence(__ATOMIC_ACQUIRE, "agent");
            xb_add(&bar[XB_XGEN(b.x)], 1u);
            asm volatile("s_waitcnt vmcnt(0)" ::: "memory");
        } else {
            XB_SPIN(xb_ld(&bar[XB_XGEN(b.x)]) == gen, bar);
            __builtin_amdgcn_fence(__ATOMIC_ACQUIRE, "agent");
            asm volatile("s_waitcnt vmcnt(0)" ::: "memory");
        }
    }
    __syncthreads();
}

namespace pg8 {
constexpr int BM = 256, BK = 64, HALF = 128, HTB = HALF * BK * 2, STAGE_BYTES = 8 * HTB, NXCD = 8, WGM = 8;
__host__ __device__ __forceinline__ int lds_byte(int r, int c) { const int st = (r >> 4) * 2 + (c >> 5), rr = r & 15, cc = c & 31, ob = rr * 64 + cc * 2; return st * 1024 + (ob ^ (((ob >> 9) & 1) << 5)); }
__host__ __device__ __forceinline__ void stage_rc(int b, int& R, int& C) { const int st = b / 1024, sb = b % 1024, swz = sb ^ (((sb >> 9) & 1) << 5); R = (st >> 1) * 16 + swz / 64; C = (st & 1) * 32 + (swz % 64) / 2; }
__host__ __device__ __forceinline__ int perm32(int rho) { const int n = rho >> 4, i = rho & 15; return 8 * (i >> 2) + 4 * n + (i & 3); }
struct Unit { int pm, pn; };
struct Gemm { const bf16_t* A; const bf16_t* Bt; int M, N, K; };
__device__ __forceinline__ unsigned cvt_pk_bf16(float lo, float hi) { unsigned r; asm volatile("v_cvt_pk_bf16_f32 %0, %1, %2" : "=v"(r) : "v"(lo), "v"(hi)); return r; }

__device__ __forceinline__ void static_unit(int L, int nM, int nN, int& pm, int& pn) {
    const int nwg = nM * nN; int wgid = L;
    { const int q = nwg / NXCD, r = nwg % NXCD, xcd = wgid % NXCD, off = wgid / NXCD; wgid = (xcd < r ? xcd * (q + 1) : r * (q + 1) + (xcd - r) * q) + off; }
    const int nig = WGM * nN, gid = wgid / nig, fm = gid * WGM, gsz = (nM - fm) < WGM ? (nM - fm) : WGM;
    pm = fm + ((wgid % nig) % gsz); pn = (wgid % nig) / gsz;
}

template <class Epi, class Sched>
__device__ __forceinline__ void gemm_phase(LAS unsigned char* lds, const Gemm g, const Sched& S, const Epi& E) {
    const int tid = my_tid(), wid = __builtin_amdgcn_readfirstlane(tid >> 6), lane = tid & 63, wr = wid >> 2, wc = wid & 3, fr = lane & 15, fq = lane >> 4;
    const int K = g.K, nt = K / BK;
    unsigned voffA[2], voffB[2];
#pragma unroll
    for (int i = 0; i < 2; ++i) { int R, C; stage_rc(tid * 16 + i * 8192, R, C); const int Rb = Epi::PERM ? ((R & ~31) + perm32(R & 31)) : R;
        voffA[i] = (unsigned)(R * K + C) * 2u; voffB[i] = (unsigned)(Rb * K + C) * 2u; }
    const size_t kstep = (size_t)(BK * 2);
    const size_t hstep = (size_t)HALF * K * 2;
    const size_t tstep = 2 * hstep;
    const unsigned ldsw = (unsigned)wid * 1024u;
    const int aoff = lds_byte(wr * 64 + fr, fq * 8), boff = lds_byte(wc * 32 + fr, fq * 8);
#define PG8_SA(b, h) (((b) * 2 + (h)) * HTB)
#define PG8_SB(b, h) ((4 + (b) * 2 + (h)) * HTB)
#define PG8_STAGE(bufoff, gbase, voff) do { _Pragma("unroll") for (int _i = 0; _i < 2; ++_i) \
        __builtin_amdgcn_global_load_lds((const unsigned*)((const char*)(gbase) + (voff)[_i]), (LAS unsigned*)(lds + (bufoff) + ldsw + _i * 8192), 16, 0, 0); } while (0)
#define PG8_LDA(dst, b, h) do { _Pragma("unroll") for (int m = 0; m < 4; ++m) _Pragma("unroll") for (int k = 0; k < 2; ++k) dst[m][k] = *(const LAS bf16x8*)(lds + PG8_SA(b, h) + aoff + m * 2048 + k * 1024); } while (0)
#define PG8_LDB(dst, b, h) do { _Pragma("unroll") for (int n = 0; n < 2; ++n) _Pragma("unroll") for (int k = 0; k < 2; ++k) dst[n][k] = *(const LAS bf16x8*)(lds + PG8_SB(b, h) + boff + n * 2048 + k * 1024); } while (0)
#define PG8_MMA(ai, bj, At, Bt) do { __builtin_amdgcn_s_setprio(1); _Pragma("unroll") for (int m = 0; m < 4; ++m) _Pragma("unroll") for (int n = 0; n < 2; ++n) _Pragma("unroll") for (int k = 0; k < 2; ++k) \
        acc[ai][bj][m][n] = __builtin_amdgcn_mfma_f32_16x16x32_bf16(Bt[n][k], At[m][k], acc[ai][bj][m][n], 0, 0, 0); __builtin_amdgcn_s_setprio(0); } while (0)
#define PG8_WAIT_V(n) asm volatile("s_waitcnt vmcnt(" #n ")" ::: "memory")
#define PG8_WAIT_L(n) asm volatile("s_waitcnt lgkmcnt(" #n ")" ::: "memory")
#define PG8_BAR __builtin_amdgcn_s_barrier()
#define PG8_SCHED __builtin_amdgcn_sched_barrier(0)
    Unit cur, nxt; int ui = 0;
    if (!S.next(0, cur)) return;
    f32x4 acc[2][2][4][2];
#pragma unroll
    for (int a = 0; a < 2; ++a)
#pragma unroll
        for (int b = 0; b < 2; ++b)
#pragma unroll
            for (int m = 0; m < 4; ++m)
#pragma unroll
                for (int n = 0; n < 2; ++n) acc[a][b][m][n] = (f32x4){0.f, 0.f, 0.f, 0.f};
    bf16x8 At[4][2], B0[2][2], B1[2][2];
    const char* cA = (const char*)g.A + (size_t)cur.pm * tstep; const char* cB = (const char*)g.Bt + (size_t)cur.pn * tstep;
    PG8_STAGE(PG8_SB(0, 0), cB, voffB); PG8_STAGE(PG8_SA(0, 0), cA, voffA); PG8_STAGE(PG8_SB(0, 1), cB + hstep, voffB); PG8_STAGE(PG8_SA(0, 1), cA + hstep, voffA);
    if (wr == 1) PG8_BAR;
    PG8_WAIT_V(4); PG8_BAR;
    PG8_STAGE(PG8_SB(1, 0), cB + kstep, voffB); PG8_STAGE(PG8_SA(1, 0), cA + kstep, voffA); PG8_STAGE(PG8_SB(1, 1), cB + hstep + kstep, voffB);
    PG8_WAIT_V(6); PG8_BAR;
    for (;;) {
        const bool has_next = S.next(ui + 1, nxt);
        const char* nA = has_next ? (const char*)g.A + (size_t)nxt.pm * tstep : cA; const char* nB = has_next ? (const char*)g.Bt + (size_t)nxt.pn * tstep : cB;
        for (int t = 0; t < nt; t += 2) {
            const bool last = (t == nt - 2);
            const char* a1 = cA + (size_t)(t + 1) * kstep;
            const char* a2 = last ? nA : cA + (size_t)(t + 2) * kstep; const char* b2 = last ? nB : cB + (size_t)(t + 2) * kstep;
            const char* a3 = a2 + kstep; const char* b3 = b2 + kstep;
            PG8_LDB(B0, 0, 0); PG8_SCHED; PG8_LDA(At, 0, 0); PG8_STAGE(PG8_SA(1, 1), a1 + hstep, voffA);
            PG8_WAIT_L(8); PG8_BAR; PG8_WAIT_L(0); PG8_MMA(0, 0, At, B0); PG8_BAR; PG8_SCHED;
            PG8_LDB(B1, 0, 1); PG8_STAGE(PG8_SB(0, 0), b2, voffB);
            PG8_BAR; PG8_WAIT_L(0); PG8_MMA(0, 1, At, B1); PG8_BAR;
            PG8_LDA(At, 0, 1); PG8_STAGE(PG8_SA(0, 0), a2, voffA);
            PG8_BAR; PG8_WAIT_L(0); PG8_MMA(1, 0, At, B0); PG8_BAR; PG8_SCHED;
            PG8_STAGE(PG8_SB(0, 1), b2 + hstep, voffB);
            PG8_WAIT_V(6); PG8_BAR; PG8_MMA(1, 1, At, B1); PG8_BAR;
            PG8_LDB(B0, 1, 0); PG8_SCHED; PG8_LDA(At, 1, 0); PG8_STAGE(PG8_SA(0, 1), a2 + hstep, voffA);
            PG8_WAIT_L(8); PG8_BAR; PG8_WAIT_L(0); PG8_MMA(0, 0, At, B0); PG8_BAR; PG8_SCHED;
            PG8_LDB(B1, 1, 1); PG8_STAGE(PG8_SB(1, 0), b3, voffB);
            PG8_BAR; PG8_WAIT_L(0); PG8_MMA(0, 1, At, B1); PG8_BAR;
            PG8_LDA(At, 1, 1); PG8_STAGE(PG8_SA(1, 0), a3, voffA);
            PG8_BAR; PG8_WAIT_L(0); PG8_MMA(1, 0, At, B0); PG8_BAR; PG8_SCHED;
            PG8_STAGE(PG8_SB(1, 1), b3 + hstep, voffB);
            PG8_WAIT_V(6); PG8_BAR; PG8_MMA(1, 1, At, B1); PG8_BAR;
        }
#if defined(PROBE_KIND) && PROBE_KIND == 4
        { unsigned t0_ = 0; if (blockIdx.x == 0 && threadIdx.x == 0) t0_ = (unsigned)wall_clock64();
          E(acc, cur, wr, wc, fr, fq);
          if (blockIdx.x == 0 && threadIdx.x == 0) { asm volatile("s_waitcnt vmcnt(0)" ::: "memory"); volatile LAS unsigned* pw_ = (volatile LAS unsigned*)(lds + LDS_BYTES - 48); pw_[2] += (unsigned)wall_clock64() - t0_; } }
#else
        E(acc, cur, wr, wc, fr, fq);
#endif
        if (!has_next) break;
#pragma unroll
        for (int a = 0; a < 2; ++a)
#pragma unroll
            for (int b = 0; b < 2; ++b)
#pragma unroll
                for (int m = 0; m < 4; ++m)
#pragma unroll
                    for (int n = 0; n < 2; ++n) acc[a][b][m][n] = (f32x4){0.f, 0.f, 0.f, 0.f};
        cur = nxt; cA = nA; cB = nB; ++ui;
    }
    PG8_WAIT_V(0);
    if (wr == 0) PG8_BAR;
    PG8_BAR;
#undef PG8_SA
#undef PG8_SB
#undef PG8_STAGE
#undef PG8_LDA
#undef PG8_LDB
#undef PG8_MMA
#undef PG8_WAIT_V
#undef PG8_WAIT_L
#undef PG8_BAR
#undef PG8_SCHED
}
template <class Epi, class Sched>
__device__ __forceinline__ void gemm_phase_gather(LAS unsigned char* lds, const Gemm g, const Sched& S, const Epi& E, const int* __restrict__ srow) {
    const int tid = my_tid(), wid = __builtin_amdgcn_readfirstlane(tid >> 6), lane = tid & 63, wr = wid >> 2, wc = wid & 3, fr = lane & 15, fq = lane >> 4;
    const int K = g.K, nt = K / BK;
    unsigned voffB[2];
#pragma unroll
    for (int i = 0; i < 2; ++i) { int R, C; stage_rc(tid * 16 + i * 8192, R, C); const int Rb = Epi::PERM ? ((R & ~31) + perm32(R & 31)) : R;
        voffB[i] = (unsigned)(Rb * K + C) * 2u; }
    unsigned gcur[2][2], gnxt[2][2];
#define PG8_LOADG(dst, u) do { const int _t = my_tid(); _Pragma("unroll") for (int _i = 0; _i < 2; ++_i) { int _R, _C; stage_rc(_t * 16 + _i * 8192, _R, _C); _Pragma("unroll") for (int _h = 0; _h < 2; ++_h) \
        dst[_h][_i] = (unsigned)srow[(u).pm * 256 + 128 * _h + _R] * (unsigned)(K * 2) + (unsigned)_C * 2u; } } while (0)
#define PG8_STAGEG(bufoff, gofs, kbyte) do { _Pragma("unroll") for (int _i = 0; _i < 2; ++_i) \
        __builtin_amdgcn_global_load_lds((const unsigned*)((const char*)g.A + (gofs)[_i] + (kbyte)), (LAS unsigned*)(lds + (bufoff) + ldsw + _i * 8192), 16, 0, 0); } while (0)
    const size_t kstep = (size_t)(BK * 2);
    const size_t hstep = (size_t)HALF * K * 2;
    const size_t tstep = 2 * hstep;
    const unsigned ldsw = (unsigned)wid * 1024u;
    const int aoff = lds_byte(wr * 64 + fr, fq * 8), boff = lds_byte(wc * 32 + fr, fq * 8);
#define PG8_SA(b, h) (((b) * 2 + (h)) * HTB)
#define PG8_SB(b, h) ((4 + (b) * 2 + (h)) * HTB)
#define PG8_STAGE(bufoff, gbase, voff) do { _Pragma("unroll") for (int _i = 0; _i < 2; ++_i) \
        __builtin_amdgcn_global_load_lds((const unsigned*)((const char*)(gbase) + (voff)[_i]), (LAS unsigned*)(lds + (bufoff) + ldsw + _i * 8192), 16, 0, 0); } while (0)
#define PG8_LDA(dst, b, h) do { _Pragma("unroll") for (int m = 0; m < 4; ++m) _Pragma("unroll") for (int k = 0; k < 2; ++k) dst[m][k] = *(const LAS bf16x8*)(lds + PG8_SA(b, h) + aoff + m * 2048 + k * 1024); } while (0)
#define PG8_LDB(dst, b, h) do { _Pragma("unroll") for (int n = 0; n < 2; ++n) _Pragma("unroll") for (int k = 0; k < 2; ++k) dst[n][k] = *(const LAS bf16x8*)(lds + PG8_SB(b, h) + boff + n * 2048 + k * 1024); } while (0)
#define PG8_MMA(ai, bj, At, Bt) do { __builtin_amdgcn_s_setprio(1); _Pragma("unroll") for (int m = 0; m < 4; ++m) _Pragma("unroll") for (int n = 0; n < 2; ++n) _Pragma("unroll") for (int k = 0; k < 2; ++k) \
        acc[ai][bj][m][n] = __builtin_amdgcn_mfma_f32_16x16x32_bf16(Bt[n][k], At[m][k], acc[ai][bj][m][n], 0, 0, 0); __builtin_amdgcn_s_setprio(0); } while (0)
#define PG8_WAIT_V(n) asm volatile("s_waitcnt vmcnt(" #n ")" ::: "memory")
#define PG8_WAIT_L(n) asm volatile("s_waitcnt lgkmcnt(" #n ")" ::: "memory")
#define PG8_BAR __builtin_amdgcn_s_barrier()
#define PG8_SCHED __builtin_amdgcn_sched_barrier(0)
    Unit cur, nxt; int ui = 0;
    if (!S.next(0, cur)) return;
    f32x4 acc[2][2][4][2];
#pragma unroll
    for (int a = 0; a < 2; ++a)
#pragma unroll
        for (int b = 0; b < 2; ++b)
#pragma unroll
            for (int m = 0; m < 4; ++m)
#pragma unroll
                for (int n = 0; n < 2; ++n) acc[a][b][m][n] = (f32x4){0.f, 0.f, 0.f, 0.f};
    bf16x8 At[4][2], B0[2][2], B1[2][2];
    const char* cB = (const char*)g.Bt + (size_t)cur.pn * tstep;
    PG8_LOADG(gcur, cur);
    PG8_STAGE(PG8_SB(0, 0), cB, voffB); PG8_STAGEG(PG8_SA(0, 0), gcur[0], 0); PG8_STAGE(PG8_SB(0, 1), cB + hstep, voffB); PG8_STAGEG(PG8_SA(0, 1), gcur[1], 0);
    if (wr == 1) PG8_BAR;
    PG8_WAIT_V(4); PG8_BAR;
    PG8_STAGE(PG8_SB(1, 0), cB + kstep, voffB); PG8_STAGEG(PG8_SA(1, 0), gcur[0], kstep); PG8_STAGE(PG8_SB(1, 1), cB + hstep + kstep, voffB);
    PG8_WAIT_V(6); PG8_BAR;
    for (;;) {
        const bool has_next = S.next(ui + 1, nxt);
        const char* nB = has_next ? (const char*)g.Bt + (size_t)nxt.pn * tstep : cB;
        if (has_next) PG8_LOADG(gnxt, nxt); else { gnxt[0][0] = gcur[0][0]; gnxt[0][1] = gcur[0][1]; gnxt[1][0] = gcur[1][0]; gnxt[1][1] = gcur[1][1]; }
        for (int t = 0; t < nt; t += 2) {
            const bool last = (t == nt - 2);
            const size_t k1 = (size_t)(t + 1) * kstep, k2 = last ? 0 : (size_t)(t + 2) * kstep, k3 = k2 + kstep;
            const char* b2 = last ? nB : cB + (size_t)(t + 2) * kstep; const char* b3 = b2 + kstep;
            unsigned g0[2], g1[2];
            g0[0] = last ? gnxt[0][0] : gcur[0][0]; g0[1] = last ? gnxt[0][1] : gcur[0][1]; g1[0] = last ? gnxt[1][0] : gcur[1][0]; g1[1] = last ? gnxt[1][1] : gcur[1][1];
            PG8_LDB(B0, 0, 0); PG8_SCHED; PG8_LDA(At, 0, 0); PG8_STAGEG(PG8_SA(1, 1), gcur[1], k1);
            PG8_WAIT_L(8); PG8_BAR; PG8_WAIT_L(0); PG8_MMA(0, 0, At, B0); PG8_BAR; PG8_SCHED;
            PG8_LDB(B1, 0, 1); PG8_STAGE(PG8_SB(0, 0), b2, voffB);
            PG8_BAR; PG8_WAIT_L(0); PG8_MMA(0, 1, At, B1); PG8_BAR;
            PG8_LDA(At, 0, 1); PG8_STAGEG(PG8_SA(0, 0), g0, k2);
            PG8_BAR; PG8_WAIT_L(0); PG8_MMA(1, 0, At, B0); PG8_BAR; PG8_SCHED;
            PG8_STAGE(PG8_SB(0, 1), b2 + hstep, voffB);
            PG8_WAIT_V(6); PG8_BAR; PG8_MMA(1, 1, At, B1); PG8_BAR;
            PG8_LDB(B0, 1, 0); PG8_SCHED; PG8_LDA(At, 1, 0); PG8_STAGEG(PG8_SA(0, 1), g1, k2);
            PG8_WAIT_L(8); PG8_BAR; PG8_WAIT_L(0); PG8_MMA(0, 0, At, B0); PG8_BAR; PG8_SCHED;
            PG8_LDB(B1, 1, 1); PG8_STAGE(PG8_SB(1, 0), b3, voffB);
            PG8_BAR; PG8_WAIT_L(0); PG8_MMA(0, 1, At, B1); PG8_BAR;
            PG8_LDA(At, 1, 1); PG8_STAGEG(PG8_SA(1, 0), g0, k3);
            PG8_BAR; PG8_WAIT_L(0); PG8_MMA(1, 0, At, B0); PG8_BAR; PG8_SCHED;
            PG8_STAGE(PG8_SB(1, 1), b3 + hstep, voffB);
            PG8_WAIT_V(6); PG8_BAR; PG8_MMA(1, 1, At, B1); PG8_BAR;
        }
#if defined(PROBE_KIND) && PROBE_KIND == 4
        { unsigned t0_ = 0; if (blockIdx.x == 0 && threadIdx.x == 0) t0_ = (unsigned)wall_clock64();
          E(acc, cur, wr, wc, fr, fq);
          if (blockIdx.x == 0 && threadIdx.x == 0) { asm volatile("s_waitcnt vmcnt(0)" ::: "memory"); volatile LAS unsigned* pw_ = (volatile LAS unsigned*)(lds + LDS_BYTES - 48); pw_[2] += (unsigned)wall_clock64() - t0_; } }
#else
        E(acc, cur, wr, wc, fr, fq);
#endif
        if (!has_next) break;
#pragma unroll
        for (int a = 0; a < 2; ++a)
#pragma unroll
            for (int b = 0; b < 2; ++b)
#pragma unroll
                for (int m = 0; m < 4; ++m)
#pragma unroll
                    for (int n = 0; n < 2; ++n) acc[a][b][m][n] = (f32x4){0.f, 0.f, 0.f, 0.f};
        cur = nxt; cB = nB; ++ui;
        gcur[0][0] = gnxt[0][0]; gcur[0][1] = gnxt[0][1]; gcur[1][0] = gnxt[1][0]; gcur[1][1] = gnxt[1][1];
    }
    PG8_WAIT_V(0);
    if (wr == 0) PG8_BAR;
    PG8_BAR;
#undef PG8_LOADG
#undef PG8_STAGEG
#undef PG8_SA
#undef PG8_SB
#undef PG8_STAGE
#undef PG8_LDA
#undef PG8_LDB
#undef PG8_MMA
#undef PG8_WAIT_V
#undef PG8_WAIT_L
#undef PG8_BAR
#undef PG8_SCHED
}
}
using pg8::Unit;
struct InProjOrder { int G, c;
    __device__ __forceinline__ bool next(int i, Unit& u) const {
        const int L = i * G + c; if (L >= 3264) return false;
        int pm, pn;
        if (L < 2448) { pg8::static_unit(L, 272, 9, pm, pn); u.pm = pm; u.pn = 272 + pn; }
        else { pg8::static_unit(L - 2448, 3, 272, pm, pn); u.pm = 281 + pm; u.pn = pn; }
        return true; } };
struct OutProjOrder { int G, c, nM;
    __device__ __forceinline__ bool next(int i, Unit& u) const {
        const int L = i * G + c; if (L >= nM * 4) return false;
        pg8::static_unit(L, nM, 4, u.pm, u.pn); return true; } };
struct GateUpOrder { int G, c, nM;
    __device__ __forceinline__ bool next(int i, Unit& u) const {
        const int per = nM * 8; const int L = i * G + c; if (L >= 16 * per) return false;
        const int e = L / per; int pm, pn; pg8::static_unit(L - e * per, nM, 8, pm, pn); u.pm = e * 34 + pm; u.pn = e * 8 + pn; return true; } };
struct DownOrder { int G, c, nM;
    __device__ __forceinline__ bool next(int i, Unit& u) const {
        const int per = nM * 4; const int L = i * G + c; if (L >= 16 * per) return false;
        const int e = L / per; int pm, pn; pg8::static_unit(L - e * per, nM, 4, pm, pn); u.pm = e * 34 + pm; u.pn = e * 4 + pn; return true; } };

struct EpiInProj { static constexpr bool PERM = true; bf16_t* P; bf16_t* UT; const float* dqn; const float* dkn; const float2* ropeD;
    __device__ __forceinline__ void operator()(const f32x4 (&acc)[2][2][4][2], const Unit& u, int wr, int wc, int fr, int fq) const {
        bf16_t* base; int ldc, rt, ct;
        if (u.pn >= 272) { base = P; ldc = PW; rt = u.pm; ct = u.pn - 272; } else { base = UT; ldc = NROW; rt = u.pm - 281; ct = u.pn; }
        const int row0 = rt * 256 + wr * 64 + fr, col0 = ct * 256 + wc * 32 + 8 * fq;
        if (u.pn >= 272 && (ct == 6 || ct == 7)) {
            const float* gnp = (ct == 6 ? dqn : dkn) + 8 * fq;
            const float4 ga = *(const float4*)gnp, gb = *(const float4*)(gnp + 4);
            const float gn[8] = {ga.x, ga.y, ga.z, ga.w, gb.x, gb.y, gb.z, gb.w};
            const float qs = ct == 6 ? 0.17677669529663687f * LOG2E : 1.0f;
            const bool hi = (fq & 1) != 0; const int lane_ = fr + 16 * fq;
#pragma unroll
            for (int ai = 0; ai < 2; ++ai)
#pragma unroll
                for (int m = 0; m < 4; ++m) { const int row = row0 + ai * 128 + m * 16; const bool lat = row < NROWL; const int t = row & 4095;
                    const int pos = (fq >> 1) == 0 ? (t >> 6) : (t & 63);
                    const float4* rp = (const float4*)(ropeD + pos * 8);
                    const float4 r0 = rp[0], r1 = rp[1], r2 = rp[2], r3 = rp[3];
                    const float cs[8] = {r0.x, r0.z, r1.x, r1.z, r2.x, r2.z, r3.x, r3.z}, sn[8] = {r0.y, r0.w, r1.y, r1.w, r2.y, r2.w, r3.y, r3.w};
                    bf16_t* rowp = base + (size_t)row * ldc + col0;
#pragma unroll
                    for (int bj = 0; bj < 2; ++bj) { const f32x4 v0 = acc[ai][bj][m][0], v1 = acc[ai][bj][m][1];
                        float x[8] = {v0[0], v0[1], v0[2], v0[3], v1[0], v1[1], v1[2], v1[3]};
                        float ss = 0.f;
#pragma unroll
                        for (int i = 0; i < 8; ++i) ss += x[i] * x[i];
                        ss += lane_xor16(ss, lane_); ss += lane_xor32(ss, lane_);
                        const float inv = rsqrtf(ss * (1.0f / 32.0f) + EPSF);
                        float o[8];
#pragma unroll
                        for (int i = 0; i < 8; ++i) { const float y = x[i] * inv * gn[i]; const float pr = lane_xor16(y, lane_);
                            o[i] = (lat ? (hi ? y * cs[i] + pr * sn[i] : y * cs[i] - pr * sn[i]) : y) * qs; }
                        u32x4 w; w.x = pg8::cvt_pk_bf16(o[0], o[1]); w.y = pg8::cvt_pk_bf16(o[2], o[3]); w.z = pg8::cvt_pk_bf16(o[4], o[5]); w.w = pg8::cvt_pk_bf16(o[6], o[7]);
                        *(u32x4*)(rowp + bj * 128) = w; } }
            return;
        }
#pragma unroll
        for (int ai = 0; ai < 2; ++ai)
#pragma unroll
            for (int m = 0; m < 4; ++m) { bf16_t* rowp = base + (size_t)(row0 + ai * 128 + m * 16) * ldc + col0;
#pragma unroll
                for (int bj = 0; bj < 2; ++bj) { const f32x4 v0 = acc[ai][bj][m][0], v1 = acc[ai][bj][m][1];
                    u32x4 w; w.x = pg8::cvt_pk_bf16(v0[0], v0[1]); w.y = pg8::cvt_pk_bf16(v0[2], v0[3]); w.z = pg8::cvt_pk_bf16(v1[0], v1[1]); w.w = pg8::cvt_pk_bf16(v1[2], v1[3]);
                    *(u32x4*)(rowp + bj * 128) = w; } }
    } };
__device__ __forceinline__ float silu_mul(float g, float u) { return g * u * __builtin_amdgcn_rcpf(1.0f + fast_exp2(-g * LOG2E)); }
struct EpiGU { static constexpr bool PERM = true; bf16_t* HID;
    __device__ __forceinline__ void operator()(const f32x4 (&acc)[2][2][4][2], const Unit& u, int wr, int wc, int fr, int fq) const {
        const int row0 = u.pm * 256 + wr * 64 + fr, col0 = (u.pn & 7) * 128 + wc * 32 + 8 * fq;
#pragma unroll
        for (int ai = 0; ai < 2; ++ai)
#pragma unroll
            for (int m = 0; m < 4; ++m) { bf16_t* rowp = HID + (size_t)(row0 + ai * 128 + m * 16) * DM + col0;
                const f32x4 g0 = acc[ai][0][m][0], g1 = acc[ai][0][m][1], u0 = acc[ai][1][m][0], u1 = acc[ai][1][m][1];
                u32x4 w; w.x = pg8::cvt_pk_bf16(silu_mul(g0[0], u0[0]), silu_mul(g0[1], u0[1])); w.y = pg8::cvt_pk_bf16(silu_mul(g0[2], u0[2]), silu_mul(g0[3], u0[3]));
                w.z = pg8::cvt_pk_bf16(silu_mul(g1[0], u1[0]), silu_mul(g1[1], u1[1])); w.w = pg8::cvt_pk_bf16(silu_mul(g1[2], u1[2]), silu_mul(g1[3], u1[3]));
                *(u32x4*)rowp = w; }
    } };
struct EpiDown { static constexpr bool PERM = true; bf16_t* Y; const float* sgate;
    __device__ __forceinline__ void operator()(const f32x4 (&acc)[2][2][4][2], const Unit& u, int wr, int wc, int fr, int fq) const {
        const int row0 = u.pm * 256 + wr * 64 + fr, col0 = (u.pn & 3) * 256 + wc * 32 + 8 * fq;
#pragma unroll
        for (int ai = 0; ai < 2; ++ai)
#pragma unroll
            for (int m = 0; m < 4; ++m) { const int r = row0 + ai * 128 + m * 16; const float gt = sgate[r]; bf16_t* rowp = Y + (size_t)r * DM + col0;
#pragma unroll
                for (int bj = 0; bj < 2; ++bj) { const f32x4 v0 = acc[ai][bj][m][0] * gt, v1 = acc[ai][bj][m][1] * gt;
                    u32x4 w; w.x = pg8::cvt_pk_bf16(v0[0], v0[1]); w.y = pg8::cvt_pk_bf16(v0[2], v0[3]); w.z = pg8::cvt_pk_bf16(v1[0], v1[1]); w.w = pg8::cvt_pk_bf16(v1[2], v1[3]);
                    *(u32x4*)(rowp + bj * 128) = w; } }
    } };
struct EpiOut { static constexpr bool PERM = true; const float* srcL; const float* srcC; bf16_t* XB; const float* MOD; int first;
    __device__ __forceinline__ void operator()(const f32x4 (&acc)[2][2][4][2], const Unit& u, int wr, int wc, int fr, int fq) const {
        const float* gt = MOD + (size_t)(u.pm < 256 ? (u.pm >> 4) : 16) * 6144 + 2048;
        const int row0 = u.pm * 256 + wr * 64 + fr, col0 = u.pn * 256 + wc * 32 + 8 * fq;
        f32x4 gv[2][2];
#pragma unroll
        for (int bj = 0; bj < 2; ++bj)
#pragma unroll
            for (int n = 0; n < 2; ++n) gv[bj][n] = *(const f32x4*)(gt + col0 + bj * 128 + n * 4);
#pragma unroll
        for (int ai = 0; ai < 2; ++ai)
#pragma unroll
            for (int m = 0; m < 4; ++m) { const int row = row0 + ai * 128 + m * 16;
                bf16_t* xrow = XB + (size_t)row * DM + col0;
                const float* frow = (row < NROWL ? srcL + (size_t)row * DM : srcC + (size_t)(row - NROWL) * DM) + col0;
#pragma unroll
                for (int bj = 0; bj < 2; ++bj) {
                    f32x4 s0, s1;
                    if (first) { s0 = *(const f32x4*)(frow + bj * 128); s1 = *(const f32x4*)(frow + bj * 128 + 4); }
                    else { const u32x4 raw = *(const u32x4*)(xrow + bj * 128);
                        s0 = (f32x4){bflo(raw.x), bfhi(raw.x), bflo(raw.y), bfhi(raw.y)}; s1 = (f32x4){bflo(raw.z), bfhi(raw.z), bflo(raw.w), bfhi(raw.w)}; }
                    const f32x4 v0 = s0 + gv[bj][0] * acc[ai][bj][m][0], v1 = s1 + gv[bj][1] * acc[ai][bj][m][1];
                    u32x4 w; w.x = pg8::cvt_pk_bf16(v0[0], v0[1]); w.y = pg8::cvt_pk_bf16(v0[2], v0[3]); w.z = pg8::cvt_pk_bf16(v1[0], v1[1]); w.w = pg8::cvt_pk_bf16(v1[2], v1[3]);
                    *(u32x4*)(xrow + bj * 128) = w; } }
    } };

__device__ __forceinline__ f32x16 mma32(const bf16_t* A, int lda, const bf16_t* Bt, int ldb, int K, f32x16 acc, int lane) {
    const int r = lane & 31, h = lane >> 5;
    const bf16_t* ap = A + r * lda + 8 * h; const bf16_t* bp = Bt + r * ldb + 8 * h;
    for (int k = 0; k < K; k += 16) {
        const bf16x8 a = *(const bf16x8*)(ap + k); const bf16x8 b = *(const bf16x8*)(bp + k);
        acc = __builtin_amdgcn_mfma_f32_32x32x16_bf16(a, b, acc, 0, 0, 0);
    }
    return acc;
}
#define CROW(reg, lane) (((reg) & 3) + 8 * ((reg) >> 2) + 4 * ((lane) >> 5))
typedef short v4i16_t __attribute__((ext_vector_type(4)));
__device__ __forceinline__ s16x4 tr_read(const LAS unsigned char* ptr) { return __builtin_bit_cast(s16x4, __builtin_amdgcn_ds_read_tr16_b64_v4i16((LAS v4i16_t*)ptr)); }
struct TrDesc { const float* src; bf16_t* dst; int src_ld, src_col0, k0, n0; };
__device__ __forceinline__ void tr_load(const TrDesc& d, int t, float4 (&v)[2]) {
#pragma unroll
    for (int p = 0; p < 2; ++p) { const int j = (t >> 4) + 32 * p; v[p] = *(const float4*)(d.src + (size_t)(d.k0 + j) * d.src_ld + d.src_col0 + (t & 15) * 4); }
}
__device__ __forceinline__ void tr_store(unsigned char* smem, const TrDesc& d, int t, const float4 (&v)[2]) {
    float* tile = (float*)smem;
#pragma unroll
    for (int p = 0; p < 2; ++p) { const int j = (t >> 4) + 32 * p; float* q = tile + j * 65 + (t & 15) * 4; q[0] = v[p].x; q[1] = v[p].y; q[2] = v[p].z; q[3] = v[p].w; }
    __syncthreads();
    { const int i = t >> 3, kc = (t & 7) * 8;
      u32x4 w;
      w.x = pack_bf16(tile[(kc + 0) * 65 + i], tile[(kc + 1) * 65 + i]); w.y = pack_bf16(tile[(kc + 2) * 65 + i], tile[(kc + 3) * 65 + i]);
      w.z = pack_bf16(tile[(kc + 4) * 65 + i], tile[(kc + 5) * 65 + i]); w.w = pack_bf16(tile[(kc + 6) * 65 + i], tile[(kc + 7) * 65 + i]);
      *(u32x4*)(d.dst + (size_t)(d.n0 + i) * DM + d.k0 + kc) = w; }
    __syncthreads();
}

template <int PART>
__device__ __forceinline__ void phase_W(const Params& p, int l, unsigned char* smem) {
    unsigned char* ws = launder_ws(p.ws);
    const int tid = my_tid(), G = gridDim.x, bid = blockIdx.x;
    if (PART == 0 && bid == 0) {
        float2* rA = (float2*)(ws + WS_ROPE); float2* rD = rA + 64 * 16;
        for (int idx = tid; idx < 64 * 16; idx += NTHR) { const int pos = idx >> 4, f = idx & 15; const float inv = powf(10000.0f, -(float)f / 16.0f); float sn, cs; sincosf((float)pos * inv, &sn, &cs); rA[idx] = make_float2(cs, sn); }
        for (int idx = tid; idx < 64 * 8; idx += NTHR) { const int pos = idx >> 3, f = idx & 7; const float inv = powf(10000.0f, -(float)f / 8.0f); float sn, cs; sincosf((float)pos * inv, &sn, &cs); rD[idx] = make_float2(cs, sn); }
    }
    if (PART == 0) { int4* inv4 = (int4*)(ws + WS_INV); const int n4 = NROW * 16 / 4;
      for (int i = bid * NTHR + tid; i < n4; i += G * NTHR) inv4[i] = make_int4(-1, -1, -1, -1); }
    const float* w_in = PIN(I_WIN) + (size_t)l * DM * INW;
    const float* w_out = PIN(I_WOUT) + (size_t)l * DM * DM;
    const float* weg = PIN(I_WEG) + (size_t)l * NEXP * DM * DM;
    const float* weu = PIN(I_WEU) + (size_t)l * NEXP * DM * DM;
    const float* wed = PIN(I_WED) + (size_t)l * NEXP * DM * DM;
    bf16_t* WinT = (bf16_t*)(ws + WS_U) + (size_t)NROW * DM;
    bf16_t* WoutT = (bf16_t*)(ws + WS_WOUT);
    bf16_t* WguT = (bf16_t*)(ws + WS_WGU);
    bf16_t* WdT = (bf16_t*)(ws + WS_WD);
    const int N_IN = 768, N_OUT = 256, N_GU = 8192, N_D = 4096, N_ADA = 96, N_HID = 544;
    const int NCVT = N_IN + N_OUT + N_GU + N_D;
    auto tr_desc = [&](int x, TrDesc& d) {
        if (x < N_IN) { const int nt = x >> 4, kt = x & 15, n0 = nt * 64;
            int sc; if (n0 < 512) sc = n0; else if (n0 < 1536) sc = n0 + 768; else if (n0 < 2304) sc = n0 + 784; else sc = n0 - 1792;
            d.src = w_in; d.src_ld = INW; d.src_col0 = sc; d.k0 = kt * 64; d.dst = WinT; d.n0 = n0; return; }
        x -= N_IN;
        if (x < N_OUT) { const int nt = x >> 4, kt = x & 15; d.src = w_out; d.src_ld = DM; d.src_col0 = nt * 64; d.k0 = kt * 64; d.dst = WoutT; d.n0 = nt * 64; return; }
        x -= N_OUT;
        if (x < N_GU) { const int e = x >> 9, r = x & 511, nt = r >> 4, kt = r & 15, n0 = nt * 64;
            const int j = n0 >> 8, rr = n0 & 255;
            d.src = (rr < 128 ? weg : weu) + (size_t)e * DM * DM; d.src_ld = DM; d.src_col0 = j * 128 + (rr & 127); d.k0 = kt * 64; d.dst = WguT + (size_t)e * 2048 * DM; d.n0 = n0; return; }
        x -= N_GU;
        { const int e = x >> 8, r = x & 255, nt = r >> 4, kt = r & 15;
          d.src = wed + (size_t)e * DM * DM; d.src_ld = DM; d.src_col0 = nt * 64; d.k0 = kt * 64; d.dst = WdT + (size_t)e * DM * DM; d.n0 = nt * 64; }
    };
    if (PART < 2) {
        TrDesc cur, nxt; float4 va[2], vb[2];
        if (bid < NCVT) { tr_desc(bid, cur); tr_load(cur, tid, va); }
        for (int it = bid; it < NCVT; it += G) {
            const bool more = it + G < NCVT;
            if (more) { tr_desc(it + G, nxt); tr_load(nxt, tid, vb); }
            tr_store(smem, cur, tid, va);
            if (more) { cur = nxt; va[0] = vb[0]; va[1] = vb[1]; }
        }
    }
    const int ibeg = (PART == 3) ? N_ADA : 0;
    const int total = (PART == 1) ? 0 : (PART == 2 ? N_ADA : N_ADA + N_HID);
    const int nheavy = (PART == 2) ? G / 4 : (PART == 3 ? G / 2 : 0);
    const int it0 = ibeg + (bid >= nheavy ? bid - nheavy : total), istride = G - nheavy;
    for (int it = it0; it < total; it += istride) {
        int x = it;
        if (x < N_ADA) {
            const int n0 = x * 64;
            float* sv = (float*)smem;
            float* red = sv + 17 * 1024;
            const float* c = PIN(I_C); const float* cc = PIN(I_CCTX);
            for (int idx = tid; idx < 17 * 1024; idx += NTHR) { const int r = idx >> 10, k = idx & 1023; const float v = r < 16 ? c[r * 1024 + k] : cc[k]; sv[idx] = v / (1.0f + expf(-v)); }
            __syncthreads();
            const int w = tid >> 6, lane = tid & 63;
            float acc[17];
#pragma unroll
            for (int r = 0; r < 17; ++r) acc[r] = 0.f;
            const float* wa = PIN(I_WADA) + (size_t)l * DM * 6144 + n0 + lane;
            for (int k0 = 128 * w; k0 < 128 * w + 128; k0 += 32) {
                float wv[32];
#pragma unroll
                for (int u = 0; u < 32; ++u) wv[u] = wa[(size_t)(k0 + u) * 6144];
#pragma unroll
                for (int u = 0; u < 32; ++u)
#pragma unroll
                    for (int r = 0; r < 17; ++r) acc[r] += sv[r * 1024 + k0 + u] * wv[u];
            }
#pragma unroll
            for (int r = 0; r < 17; ++r) red[(w * 17 + r) * 64 + lane] = acc[r];
            __syncthreads();
            float* MOD = (float*)(ws + WS_MOD + (size_t)(l & 1) * MOD_BYTES); const float* ba = PIN(I_BADA) + (size_t)l * 6144;
            for (int idx = tid; idx < 17 * 64; idx += NTHR) { const int r = idx >> 6, j = idx & 63; float s = ba[n0 + j];
#pragma unroll
                for (int ww = 0; ww < 8; ++ww) s += red[(ww * 17 + r) * 64 + j];
                MOD[(size_t)r * 6144 + n0 + j] = s; }
            __syncthreads();
            continue; }
        x -= N_ADA;
        {
            const bool isc = x >= 512; const int L = isc ? 256 : 4096; const int lagbase = (isc ? x - 512 : x) * 8;
            float* zf = (float*)smem;
            float* h1s = zf + 8 * 36;
            const int li = tid >> 6, j = tid & 63, lag = lagbase + li;
            if (j < 33) { float v;
                if (j == 0) v = (float)lag / (float)(L - 1);
                else { const int bi = (j - 1) & 15; const float band = 1e-4f + (float)bi * ((15.0f - 1e-4f) / 15.0f); const float w = 6.283185307179586f * (float)lag / (float)L; const float a = band * w;
                       v = (j <= 16) ? cosf(a) : -sinf(a); }
                zf[li * 36 + j] = v; }
            __syncthreads();
            const float* fw1 = PIN(I_FW1) + (size_t)l * 33 * 64; const float* fb1 = PIN(I_FB1) + l * 64; const float* fr = PIN(I_FREQ) + l * 64;
            const float* fw2 = PIN(I_FW2) + (size_t)l * 64 * 64; const float* fb2 = PIN(I_FB2) + l * 64;
            float a = fb1[j];
#pragma unroll 3
            for (int i = 0; i < 33; ++i) a += zf[li * 36 + i] * fw1[i * 64 + j];
            h1s[li * 64 + j] = sinf(fr[j] * a);
            __syncthreads();
            float a2 = fb2[j];
#pragma unroll 4
            for (int i = 0; i < 64; ++i) a2 += h1s[li * 64 + i] * fw2[i * 64 + j];
            float* H2 = (float*)(ws + (isc ? WS_HID2C : WS_HID2L));
            H2[(size_t)lag * 64 + j] = sinf(fr[j] * a2);
            __syncthreads();
        }
    }
}

template <int WHICH>
__device__ __forceinline__ void phase_norm(const Params& p, int l, unsigned char* smem) {
    unsigned char* ws = launder_ws(p.ws);
    const int tid = my_tid(), lane = tid & 63, wave = tid >> 6;
    float* Wg = (float*)smem;
    for (int idx = tid; idx < 16384; idx += NTHR) { const int k = idx >> 4, j = idx & 15;
        Wg[j * 1024 + k] = (WHICH == 1) ? PIN(I_WIN)[(size_t)l * DM * INW + (size_t)k * INW + 2304 + j] : PIN(I_WROUTER)[(size_t)l * DM * 16 + k * 16 + j]; }
    __syncthreads();
    const float* gain = PIN(WHICH == 1 ? I_N1G : I_N2G) + (size_t)l * DM;
    const float* MOD = (const float*)(ws + WS_MOD + (size_t)(l & 1) * MOD_BYTES);
    bf16_t* U = (bf16_t*)(ws + WS_U);
    float* outv = (float*)(ws + (WHICH == 1 ? WS_GATES : WS_AFF));
    const float* xl = PIN(I_X); const float* xc = PIN(I_CTX);
    const bf16_t* XB = (const bf16_t*)(ws + WS_XB);
    const int rstride = gridDim.x * 8;
    const int nrows = (WHICH == 2 && l == DEPTH - 1) ? NROWL : NROW;
#define NM_LOAD(dst, r) do { if (WHICH == 1) { const float* s_ = (r) < NROWL ? xl + (size_t)(r) * DM : xc + (size_t)((r) - NROWL) * DM; \
            _Pragma("unroll") for (int i = 0; i < 4; ++i) dst[i] = *(const float4*)(s_ + 256 * i + 4 * lane); } \
        else { const bf16_t* s_ = XB + (size_t)(r) * DM; \
            _Pragma("unroll") for (int i = 0; i < 4; ++i) { const u32x2 w_ = *(const u32x2*)(s_ + 256 * i + 4 * lane); dst[i] = make_float4(bflo(w_.x), bfhi(w_.x), bflo(w_.y), bfhi(w_.y)); } } } while (0)
    float4 cur[4];
    { const int row = blockIdx.x * 8 + wave; NM_LOAD(cur, row); }
    for (int row = blockIdx.x * 8 + wave; row < nrows; row += rstride) {
        float4 nxt[4];
        { const int r2 = row + rstride < nrows ? row + rstride : row; NM_LOAD(nxt, r2); }
        const float* mod = MOD + (size_t)(row < NROWL ? (row >> 12) : 16) * 6144 + (WHICH == 1 ? 0 : 3072);
        float ss = 0.f;
#pragma unroll
        for (int i = 0; i < 4; ++i) ss += cur[i].x * cur[i].x + cur[i].y * cur[i].y + cur[i].z * cur[i].z + cur[i].w * cur[i].w;
        ss = wave_sum(ss);
        const float inv = rsqrtf(ss * (1.0f / 1024.0f) + EPSF);
        float part[16];
#pragma unroll
        for (int j = 0; j < 16; ++j) part[j] = 0.f;
#pragma unroll
        for (int i = 0; i < 4; ++i) { const int k = 256 * i + 4 * lane;
            const float4 v = cur[i];
            const float4 g = *(const float4*)(gain + k), sh = *(const float4*)(mod + k), sc = *(const float4*)(mod + 1024 + k);
            float4 h; h.x = v.x * inv * g.x * (1.f + sc.x) + sh.x; h.y = v.y * inv * g.y * (1.f + sc.y) + sh.y; h.z = v.z * inv * g.z * (1.f + sc.z) + sh.z; h.w = v.w * inv * g.w * (1.f + sc.w) + sh.w;
            u32x2 w; w.x = pack_bf16(h.x, h.y); w.y = pack_bf16(h.z, h.w);
            *(u32x2*)(U + (size_t)row * DM + k) = w;
#pragma unroll
            for (int j = 0; j < 16; ++j) { const float4 wv = *(const float4*)(Wg + j * 1024 + k); part[j] += h.x * wv.x + h.y * wv.y + h.z * wv.z + h.w * wv.w; }
            asm volatile("" ::: "memory"); }
#pragma unroll
        for (int i = 0; i < 4; ++i) cur[i] = nxt[i];
        float v1 = reduce16_transpose(part, lane);
        const int jx = ((lane >> 5) & 1) * 8 + ((lane >> 4) & 1) * 4 + ((lane >> 3) & 1) * 2 + ((lane >> 2) & 1);
        float val = v1;
        if (WHICH == 2) { const float mx = wave_max(v1); const float e = expf(v1 - mx); const float sum = wave_sum(e) * 0.25f; val = e / sum; }
        if ((lane & 3) == 0) outv[(size_t)row * 16 + jx] = val;
    }
    __syncthreads();
}

__device__ __forceinline__ void phase_prep(const Params& p, int l, unsigned char* smem) {
    unsigned char* ws = launder_ws(p.ws);
    const int tid = my_tid(), lane = tid & 63, wave = tid >> 6;
    float2* ropeA = (float2*)smem;
    float2* ropeD = ropeA + 64 * 16;
    for (int idx = tid; idx < 64 * 16; idx += NTHR) { const int pos = idx >> 4, f = idx & 15; const float inv = powf(10000.0f, -(float)f / 16.0f); float s, c; sincosf((float)pos * inv, &s, &c); ropeA[idx] = make_float2(c, s); }
    for (int idx = tid; idx < 64 * 8; idx += NTHR) { const int pos = idx >> 3, f = idx & 7; const float inv = powf(10000.0f, -(float)f / 8.0f); float s, c; sincosf((float)pos * inv, &s, &c); ropeD[idx] = make_float2(c, s); }
    __syncthreads();
    bf16_t* P = (bf16_t*)(ws + WS_P);
    const float* aqn = PIN(I_AQN) + l * 64; const float* akn = PIN(I_AKN) + l * 64;
    const float* dqn = PIN(I_DQN) + l * 32; const float* dkn = PIN(I_DKN) + l * 32;
    const int rstride = gridDim.x * 8;
    const int vecA = min(lane >> 3, 5), chA = lane & 7;
    u32x4 rawA;
    { const int row = blockIdx.x * 8 + wave; const bf16_t* pr = P + (size_t)row * PW; rawA = *(const u32x4*)(pr + vecA * 64 + chA * 8); }
    for (int row = blockIdx.x * 8 + wave; row < NROW; row += rstride) {
        const bool lat = row < NROWL; const int t = row & 4095; const int prow = t >> 6, pcol = t & 63;
        bf16_t* pr = P + (size_t)row * PW;
        u32x4 nxtA;
        { const int r2 = row + rstride < NROW ? row + rstride : row; const bf16_t* p2 = P + (size_t)r2 * PW; nxtA = *(const u32x4*)(p2 + vecA * 64 + chA * 8); }
        {
            const int vec = vecA, ch = chA; const bool act = lane < 48;
            bf16_t* ptr = pr + vec * 64 + ch * 8;
            const u32x4 raw = rawA;
            float x[8]; x[0] = bflo(raw.x); x[1] = bfhi(raw.x); x[2] = bflo(raw.y); x[3] = bfhi(raw.y); x[4] = bflo(raw.z); x[5] = bfhi(raw.z); x[6] = bflo(raw.w); x[7] = bfhi(raw.w);
            float ss = 0.f;
#pragma unroll
            for (int i = 0; i < 8; ++i) ss += x[i] * x[i];
            ss += __shfl_xor(ss, 1); ss += __shfl_xor(ss, 2); ss += __shfl_xor(ss, 4);
            const float inv = rsqrtf(ss * (1.0f / 64.0f) + EPSF);
            const float* gn = (vec < 4 ? aqn : akn) + ch * 8;
            const float qs = vec < 4 ? 0.125f * LOG2E : 1.0f;
            const int axis = ch >> 2, half = (ch >> 1) & 1; const int pos = axis == 0 ? prow : pcol;
            float o[8];
#pragma unroll
            for (int i = 0; i < 8; ++i) { const float y = x[i] * inv * gn[i]; const float pr2 = __shfl_xor(y, 2);
                if (lat) { const float2 cs = ropeA[pos * 16 + 8 * (ch & 1) + i]; o[i] = (half == 0 ? y * cs.x - pr2 * cs.y : y * cs.x + pr2 * cs.y) * qs; } else o[i] = y * qs; }
            if (act) { u32x4 w; w.x = pack_bf16(o[0], o[1]); w.y = pack_bf16(o[2], o[3]); w.z = pack_bf16(o[4], o[5]); w.w = pack_bf16(o[6], o[7]); *(u32x4*)ptr = w; }
        }
        rawA = nxtA;
    }
    __syncthreads();
}
__device__ __forceinline__ int block_excl_scan(int v, int* sbuf  , int& total) {
    const int tid = my_tid(), lane = tid & 63, wave = tid >> 6;
    int inc = v;
#pragma unroll
    for (int o = 1; o < 64; o <<= 1) { const int n = __shfl_up(inc, o); if (lane >= o) inc += n; }
    __syncthreads();
    if (lane == 63) sbuf[wave] = inc;
    __syncthreads();
    int pre = 0, tot = 0;
#pragma unroll
    for (int w = 0; w < 8; ++w) { const int s = sbuf[w]; if (w < wave) pre += s; tot += s; }
    total = tot;
    return pre + inc - v;
}

__device__ __forceinline__ void phase_topk(const Params& p, int l, unsigned char* smem) {
    unsigned char* ws = launder_ws(p.ws);
    const int tid = my_tid();
    unsigned* keys = (unsigned*)smem;
    int* hist = (int*)(keys + 4096);
    int* sb = hist + 256;
    int* ctl = sb + 16;
    const float* AFF = (const float*)(ws + WS_AFF);
    int* SROW = (int*)(ws + WS_SROW); float* SGATE = (float*)(ws + WS_SGATE); int* INV = (int*)(ws + WS_INV);
    const int nlists = (l == DEPTH - 1) ? 256 : 512;
    for (int it = blockIdx.x; it < nlists; it += gridDim.x) {
        const int kind = it >> 8, b = (it >> 4) & 15, e = it & 15;
        const int N = kind ? 256 : 4096, K = kind ? CAPC : CAPL;
        const int rowbase = kind ? NROWL + b * 256 : b * 4096;
        const int slotbase = e * SLOTS_E + (kind ? 8192 + b * CAPC : b * CAPL);
        for (int i = tid; i < N; i += NTHR) keys[i] = __float_as_uint(AFF[(size_t)(rowbase + i) * 16 + e]);
        unsigned prefix = 0, mask = 0; int need = K;
        for (int pass = 3; pass >= 0; --pass) {
            const int shift = 8 * pass;
            if (tid < 256) hist[tid] = 0;
            __syncthreads();
            for (int i = tid; i < N; i += NTHR) { const unsigned k = keys[i]; if ((k & mask) == prefix) atomicAdd(&hist[(k >> shift) & 255], 1); }
            __syncthreads();
            if (tid < 64) {
                const int b0 = 255 - 4 * tid; const int h0 = hist[b0], h1 = hist[b0 - 1], h2 = hist[b0 - 2], h3 = hist[b0 - 3];
                const int tot4 = h0 + h1 + h2 + h3; int inc = tot4;
#pragma unroll
                for (int o = 1; o < 64; o <<= 1) { const int n = __shfl_up(inc, o); if (tid >= o) inc += n; }
                const int exc = inc - tot4;
                const bool hit = (exc < need) && (inc >= need);
                if (hit) { int cum = exc, d = b0;
                    if (cum + h0 >= need) d = b0; else { cum += h0; if (cum + h1 >= need) d = b0 - 1; else { cum += h1; if (cum + h2 >= need) d = b0 - 2; else { cum += h2; d = b0 - 3; } } }
                    ctl[0] = d; ctl[1] = need - cum; } }
            __syncthreads();
            prefix |= (unsigned)ctl[0] << shift; mask |= 255u << shift; need = ctl[1];
            __syncthreads();
        }
        const unsigned T = prefix;
        int cg = 0, ce = 0; unsigned k8[8];
#pragma unroll
        for (int j = 0; j < 8; ++j) { const int i = tid * 8 + j; const unsigned k = (i < N) ? keys[i] : 0u; k8[j] = k; cg += (i < N && k > T) ? 1 : 0; ce += (i < N && k == T) ? 1 : 0; }
        int totg, tote;
        int pg = block_excl_scan(cg, sb, totg);
        int pe = block_excl_scan(ce, sb, tote);
#pragma unroll
        for (int j = 0; j < 8; ++j) { const int i = tid * 8 + j; if (i < N) { const unsigned k = k8[j]; int pos = -1;
                if (k > T) pos = pg++; else if (k == T) { if (pe < need) pos = totg + pe; ++pe; }
                if (pos >= 0) { const int s = slotbase + pos; const int row = rowbase + i; SROW[s] = row; SGATE[s] = __uint_as_float(k); INV[(size_t)row * 16 + e] = s; } } }
        __syncthreads();
    }
}

__device__ __forceinline__ void phase_gather(const Params& p) {
    unsigned char* ws = launder_ws(p.ws);
    const int lane = my_tid() & 63, wave = my_tid() >> 6;
    const int* SROW = (const int*)(ws + WS_SROW);
    const bf16_t* U = (const bf16_t*)(ws + WS_U); bf16_t* XE = (bf16_t*)(ws + WS_XE);
    for (int s = blockIdx.x * 8 + wave; s < NSLOT; s += gridDim.x * 8) {
        const int row = SROW[s];
        const u32x4* src = (const u32x4*)(U + (size_t)row * DM); u32x4* dst = (u32x4*)(XE + (size_t)s * DM);
        const u32x4 a = src[lane], b = src[64 + lane];
        dst[lane] = a; dst[64 + lane] = b;
    }
}

template <bool NEXT>
__device__ __forceinline__ void phase_combine(const Params& p, int l, unsigned char* smem) {
    unsigned char* ws = launder_ws(p.ws);
    const int tid = my_tid(), lane = tid & 63, wave = tid >> 6;
    int* INV = (int*)(ws + WS_INV);
    const bf16_t* YS = (const bf16_t*)(ws + WS_XE);
    const float* MODc = (const float*)(ws + WS_MOD + (size_t)(l & 1) * MOD_BYTES);
    const float* MODn = (const float*)(ws + WS_MOD + (size_t)((l + 1) & 1) * MOD_BYTES);
    float* Wg = (float*)smem;
    bf16_t* U = (bf16_t*)(ws + WS_U); float* GT = (float*)(ws + WS_GATES);
    const float* gain = PIN(I_N1G) + (size_t)(NEXT ? l + 1 : 0) * DM;
    if (NEXT) { for (int idx = tid; idx < 16384; idx += NTHR) { const int k = idx >> 4, j = idx & 15; Wg[j * 1024 + k] = PIN(I_WIN)[(size_t)(l + 1) * DM * INW + (size_t)k * INW + 2304 + j]; }
        __syncthreads(); }
    const int rstride = gridDim.x * 8;
    bf16_t* XB = (bf16_t*)(ws + WS_XB); float* outp = POUT();
    int myinv; u32x2 xc4[4];
    { const int row = blockIdx.x * 8 + wave; myinv = INV[(size_t)row * 16 + (lane & 15)];
#pragma unroll
      for (int i = 0; i < 4; ++i) xc4[i] = *(const u32x2*)(XB + (size_t)row * DM + 256 * i + 4 * lane); }
    const int nrows = NEXT ? NROW : NROWL;
    for (int row = blockIdx.x * 8 + wave; row < nrows; row += rstride) {
        int ninv; u32x2 xn4[4];
        { const int r2 = row + rstride < nrows ? row + rstride : row; ninv = INV[(size_t)r2 * 16 + (lane & 15)];
#pragma unroll
          for (int i = 0; i < 4; ++i) xn4[i] = *(const u32x2*)(XB + (size_t)r2 * DM + 256 * i + 4 * lane); }
        float acc[16];
#pragma unroll
        for (int j = 0; j < 16; ++j) acc[j] = 0.f;
        {
            unsigned msk = (unsigned)(__ballot(myinv >= 0 && lane < 16)) & 0xffffu;
            if (msk) {
                const int e0 = __ffs(msk) - 1; msk &= msk - 1;
                const int s0 = __shfl(myinv, e0);
                const bool two = msk != 0u; int s1 = s0;
                if (two) { const int e1 = __ffs(msk) - 1; msk &= msk - 1; s1 = __shfl(myinv, e1); }
                u32x2 w0[4], w1[4];
#pragma unroll
                for (int i = 0; i < 4; ++i) { w0[i] = *(const u32x2*)(YS + (size_t)s0 * DM + 256 * i + 4 * lane); w1[i] = *(const u32x2*)(YS + (size_t)s1 * DM + 256 * i + 4 * lane); }
                const float f1 = two ? 1.0f : 0.0f;
#pragma unroll
                for (int i = 0; i < 4; ++i) { acc[4 * i + 0] = bflo(w0[i].x) + f1 * bflo(w1[i].x); acc[4 * i + 1] = bfhi(w0[i].x) + f1 * bfhi(w1[i].x);
                    acc[4 * i + 2] = bflo(w0[i].y) + f1 * bflo(w1[i].y); acc[4 * i + 3] = bfhi(w0[i].y) + f1 * bfhi(w1[i].y); }
                while (msk) { const int e = __ffs(msk) - 1; msk &= msk - 1; const int s = __shfl(myinv, e);
#pragma unroll
                    for (int i = 0; i < 4; ++i) { const u32x2 w = *(const u32x2*)(YS + (size_t)s * DM + 256 * i + 4 * lane);
                        acc[4 * i + 0] += bflo(w.x); acc[4 * i + 1] += bfhi(w.x); acc[4 * i + 2] += bflo(w.y); acc[4 * i + 3] += bfhi(w.y); } }
            }
        }
        if (lane < 16) INV[(size_t)row * 16 + lane] = -1;
        const int mrow = row < NROWL ? (row >> 12) : 16;
        const float* gt = MODc + (size_t)mrow * 6144 + 5120;
        float ss = 0.f;
#pragma unroll
        for (int i = 0; i < 4; ++i) { const int k = 256 * i + 4 * lane;
            float4 xv = make_float4(bflo(xc4[i].x), bfhi(xc4[i].x), bflo(xc4[i].y), bfhi(xc4[i].y)); const float4 g = *(const float4*)(gt + k);
            xv.x += g.x * acc[4 * i + 0]; xv.y += g.y * acc[4 * i + 1]; xv.z += g.z * acc[4 * i + 2]; xv.w += g.w * acc[4 * i + 3];
            if (NEXT) { u32x2 w; w.x = pack_bf16(xv.x, xv.y); w.y = pack_bf16(xv.z, xv.w); *(u32x2*)(XB + (size_t)row * DM + k) = w; }
            else *(float4*)(outp + (size_t)row * DM + k) = xv;
            acc[4 * i + 0] = xv.x; acc[4 * i + 1] = xv.y; acc[4 * i + 2] = xv.z; acc[4 * i + 3] = xv.w;
            ss += xv.x * xv.x + xv.y * xv.y + xv.z * xv.z + xv.w * xv.w; }
        myinv = ninv;
#pragma unroll
        for (int i = 0; i < 4; ++i) xc4[i] = xn4[i];
        if (NEXT) {
            ss = wave_sum(ss);
            const float inv = rsqrtf(ss * (1.0f / 1024.0f) + EPSF);
            const float* mod = MODn + (size_t)mrow * 6144;
            float part[16];
#pragma unroll
            for (int j = 0; j < 16; ++j) part[j] = 0.f;
#pragma unroll
            for (int i = 0; i < 4; ++i) { const int k = 256 * i + 4 * lane;
                const float4 g = *(const float4*)(gain + k), sh = *(const float4*)(mod + k), sc = *(const float4*)(mod + 1024 + k);
                float4 h; h.x = acc[4 * i + 0] * inv * g.x * (1.f + sc.x) + sh.x; h.y = acc[4 * i + 1] * inv * g.y * (1.f + sc.y) + sh.y; h.z = acc[4 * i + 2] * inv * g.z * (1.f + sc.z) + sh.z; h.w = acc[4 * i + 3] * inv * g.w * (1.f + sc.w) + sh.w;
                u32x2 w; w.x = pack_bf16(h.x, h.y); w.y = pack_bf16(h.z, h.w);
                *(u32x2*)(U + (size_t)row * DM + k) = w;
#pragma unroll
                for (int j = 0; j < 16; ++j) { const float4 wv = *(const float4*)(Wg + j * 1024 + k); part[j] += h.x * wv.x + h.y * wv.y + h.z * wv.z + h.w * wv.w; }
                asm volatile("" ::: "memory"); }
            const float v1 = reduce16_transpose(part, lane);
            const int jx = ((lane >> 5) & 1) * 8 + ((lane >> 4) & 1) * 4 + ((lane >> 3) & 1) * 2 + ((lane >> 2) & 1);
            if ((lane & 3) == 0) GT[(size_t)row * 16 + jx] = v1;
        }
    }
    __syncthreads();
}
struct AttnItem { int qrow0, qpos0, qcol, kcol, vcol, ycol; int nt0, krow0, kpos0, masked; int nt1, krow1; float M2, sink2, lam, postscale; const float* subgain; };
#define FA_LD 72

template <int NC>
__device__ __forceinline__ void fattn_item(const bf16_t* __restrict__ P, bf16_t* __restrict__ Y, const AttnItem& it, unsigned char* smem) {
    constexpr int KS = (NC == 2) ? 2 : 4;
    const int tid = my_tid(), lane = tid & 63, w = tid >> 6, h = lane >> 5, lq = lane & 31;
    bf16_t* Kb = (bf16_t*)smem;
    bf16_t* Vb = Kb + 2 * 64 * FA_LD;
    const LAS unsigned char* vlds = (const LAS unsigned char*)(smem) + 2 * 64 * FA_LD * 2;
    bf16x8 qf[NC][KS];
    { const bf16_t* qp = P + (size_t)(it.qrow0 + 32 * w + lq) * PW + it.qcol + 8 * h;
#pragma unroll
      for (int c = 0; c < NC; ++c)
#pragma unroll
          for (int s = 0; s < KS; ++s) qf[c][s] = *(const bf16x8*)(qp + 32 * c + 16 * s); }
    f32x16 O[NC][2]; float lsum[NC];
#pragma unroll
    for (int c = 0; c < NC; ++c) { lsum[c] = 0.f;
#pragma unroll
        for (int dt = 0; dt < 2; ++dt)
#pragma unroll
            for (int r = 0; r < 16; ++r) O[c][dt][r] = 0.f; }
    const int ntot = it.nt0 + it.nt1;
    const int ldkey = tid >> 3, ldch = tid & 7;
    const int vlane = ((4 * h + ((lane & 15) >> 2)) * FA_LD + 16 * ((lane >> 4) & 1) + 4 * (lane & 3)) * 2;
    u32x4 kreg, vreg;
    { const int krow = it.nt0 > 0 ? it.krow0 : it.krow1; const bf16_t* kp = P + (size_t)(krow + ldkey) * PW;
      kreg = *(const u32x4*)(kp + it.kcol + ldch * 8); vreg = *(const u32x4*)(kp + it.vcol + ldch * 8); }
    __syncthreads();
    *(u32x4*)(Kb + ldkey * FA_LD + ldch * 8) = kreg; *(u32x4*)(Vb + ldkey * FA_LD + ldch * 8) = vreg;
    __syncthreads();
    const int qpos = it.qpos0 + 32 * w + lq;
    for (int kt = 0; kt < ntot; ++kt) {
        const int buf = kt & 1;
        int kpos = 0; bool msk = false;
        if (kt < it.nt0) { kpos = it.kpos0 + 64 * kt; msk = it.masked != 0; }
        if (kt + 1 < ntot) { const int k2 = kt + 1; const int krow = k2 < it.nt0 ? it.krow0 + 64 * k2 : it.krow1 + 64 * (k2 - it.nt0);
            const bf16_t* kp = P + (size_t)(krow + ldkey) * PW; kreg = *(const u32x4*)(kp + it.kcol + ldch * 8); vreg = *(const u32x4*)(kp + it.vcol + ldch * 8); }
        bool skip = false;
        if (msk) { const int q0 = it.qpos0 + 32 * w; skip = (kpos > q0 + 31 + 128) || (kpos + 63 < q0 - 128); }
        if (!skip) {
            const bf16_t* kb = Kb + buf * 64 * FA_LD; const LAS unsigned char* vb = vlds + buf * 64 * FA_LD * 2 + vlane;
#pragma unroll
            for (int sub = 0; sub < 2; ++sub) {
                unsigned pk[NC][2][4];
#pragma unroll
                for (int c = 0; c < NC; ++c) {
                    f32x16 S;
#pragma unroll
                    for (int r = 0; r < 16; ++r) S[r] = -it.M2;
#pragma unroll
                    for (int s = 0; s < KS; ++s) { const bf16x8 a = *(const bf16x8*)(kb + (32 * sub + lq) * FA_LD + 32 * c + 16 * s + 8 * h);
                        S = __builtin_amdgcn_mfma_f32_32x32x16_bf16(a, qf[c][s], S, 0, 0, 0); }
                    float pv[16];
#pragma unroll
                    for (int r = 0; r < 16; ++r) { pv[r] = fast_exp2(S[r]);
                        if (NC == 1) { if (msk) { const int d = qpos - (kpos + 32 * sub + CROW(r, lane)); if (d > 128 || d < -128) pv[r] = 0.f; } } }
#pragma unroll
                    for (int r = 0; r < 16; ++r) lsum[c] += pv[r];
#pragma unroll
                    for (int s = 0; s < 2; ++s)
#pragma unroll
                        for (int jj = 0; jj < 4; ++jj) pk[c][s][jj] = pg8::cvt_pk_bf16(pv[8 * s + 2 * jj], pv[8 * s + 2 * jj + 1]);
                }
#pragma unroll
                for (int s = 0; s < 2; ++s)
#pragma unroll
                    for (int dt = 0; dt < 2; ++dt) {
                        const s16x4 lo = tr_read(vb + (32 * sub + 16 * s) * FA_LD * 2 + 64 * dt), hi = tr_read(vb + (32 * sub + 16 * s + 8) * FA_LD * 2 + 64 * dt);
                        const bf16x8 a = __builtin_shufflevector(lo, hi, 0, 1, 2, 3, 4, 5, 6, 7);
#pragma unroll
                        for (int c = 0; c < NC; ++c) { u32x4 bw; bw.x = pk[c][s][0]; bw.y = pk[c][s][1]; bw.z = pk[c][s][2]; bw.w = pk[c][s][3];
                            O[c][dt] = __builtin_amdgcn_mfma_f32_32x32x16_bf16(a, __builtin_bit_cast(bf16x8, bw), O[c][dt], 0, 0, 0); }
                    }
            }
        }
        if (kt + 1 < ntot) { bf16_t* kd = Kb + (buf ^ 1) * 64 * FA_LD; bf16_t* vd = Vb + (buf ^ 1) * 64 * FA_LD;
            *(u32x4*)(kd + ldkey * FA_LD + ldch * 8) = kreg; *(u32x4*)(vd + ldkey * FA_LD + ldch * 8) = vreg; }
        __syncthreads();
    }
    float linv[NC];
#pragma unroll
    for (int c = 0; c < NC; ++c) { const float l = lsum[c] + __shfl_xor(lsum[c], 32); linv[c] = (NC == 1) ? 1.0f / (l + fast_exp2(it.sink2 - it.M2)) : 1.0f / l; }
    bf16_t* yp = Y + (size_t)(it.qrow0 + 32 * w + lq) * DM + it.ycol + 4 * h;
    if (NC == 1) {
#pragma unroll
        for (int dt = 0; dt < 2; ++dt)
#pragma unroll
            for (int g = 0; g < 4; ++g) { u32x2 wv; wv.x = pg8::cvt_pk_bf16(O[0][dt][4 * g] * linv[0], O[0][dt][4 * g + 1] * linv[0]); wv.y = pg8::cvt_pk_bf16(O[0][dt][4 * g + 2] * linv[0], O[0][dt][4 * g + 3] * linv[0]);
                *(u32x2*)(yp + 32 * dt + 8 * g) = wv; }
    } else {
        const float a1 = it.lam * linv[NC - 1];
        float ss = 0.f;
#pragma unroll
        for (int dt = 0; dt < 2; ++dt)
#pragma unroll
            for (int r = 0; r < 16; ++r) { const float v = O[0][dt][r] * linv[0] - a1 * O[NC - 1][dt][r]; O[0][dt][r] = v; ss += v * v; }
        ss += __shfl_xor(ss, 32);
        const float rinv = rsqrtf(ss * (1.0f / 64.0f) + EPSF) * it.postscale;
        const float* sg = it.subgain + 4 * h;
#pragma unroll
        for (int dt = 0; dt < 2; ++dt)
#pragma unroll
            for (int g = 0; g < 4; ++g) { const float4 gg = *(const float4*)(sg + 32 * dt + 8 * g);
                u32x2 wv; wv.x = pg8::cvt_pk_bf16(O[0][dt][4 * g] * rinv * gg.x, O[0][dt][4 * g + 1] * rinv * gg.y); wv.y = pg8::cvt_pk_bf16(O[0][dt][4 * g + 2] * rinv * gg.z, O[0][dt][4 * g + 3] * rinv * gg.w);
                *(u32x2*)(yp + 32 * dt + 8 * g) = wv; }
    }
}


#define FD_RING 4
__device__ __forceinline__ void fattn_d_item(const bf16_t* __restrict__ P, bf16_t* __restrict__ Y, const AttnItem& it, unsigned char* smem) {
    const int tid = my_tid(), lane = tid & 63, w = tid >> 6, h = lane >> 5, lq = lane & 31;
    bf16_t* ring = (bf16_t*)smem;
    const LAS unsigned char* rlds = (const LAS unsigned char*)smem;
    constexpr int TB = 64 * FA_LD * 2;
    bf16x8 qf[2][2];
    { const bf16_t* qp = P + (size_t)(it.qrow0 + 32 * w + lq) * PW + it.qcol + 8 * h;
#pragma unroll
      for (int c = 0; c < 2; ++c)
#pragma unroll
          for (int s = 0; s < 2; ++s) qf[c][s] = *(const bf16x8*)(qp + 32 * c + 16 * s); }
    f32x16 O[2][2]; float lsum[2] = {0.f, 0.f};
#pragma unroll
    for (int c = 0; c < 2; ++c)
#pragma unroll
        for (int dt = 0; dt < 2; ++dt)
#pragma unroll
            for (int r = 0; r < 16; ++r) O[c][dt][r] = 0.f;
    const int ntot = it.nt0 + it.nt1;
    const int ldkey = tid >> 3, ldch = tid & 7;
    const int vlane = ((4 * h + ((lane & 15) >> 2)) * FA_LD + 16 * ((lane >> 4) & 1) + 4 * (lane & 3)) * 2;
    const int klane = (lq * FA_LD + 8 * h) * 2;
#define FD_TROW(k) ((k) < it.nt0 ? it.krow0 + 64 * (k) : it.krow1 + 64 * ((k) - it.nt0))
#define FD_GLOAD(k) do { const bf16_t* kp_ = P + (size_t)(FD_TROW(k) + ldkey) * PW; kreg = *(const u32x4*)(kp_ + it.kcol + ldch * 8); vreg = *(const u32x4*)(kp_ + it.vcol + ldch * 8); } while (0)
#define FD_LSTORE(k) do { bf16_t* d_ = ring + (size_t)((k) & (FD_RING - 1)) * 2 * 64 * FA_LD + ldkey * FA_LD + ldch * 8; *(u32x4*)d_ = kreg; *(u32x4*)(d_ + 64 * FA_LD) = vreg; } while (0)
    u32x4 kreg, vreg;
    __syncthreads();
    FD_GLOAD(0); FD_LSTORE(0);
    if (ntot > 1) { FD_GLOAD(1); FD_LSTORE(1); }
    __syncthreads();
    f32x16 zero16;
#pragma unroll
    for (int r = 0; r < 16; ++r) zero16[r] = 0.f;
    f32x16 SS[2];
    { const LAS unsigned char* kb = rlds + klane;
      SS[0] = __builtin_amdgcn_mfma_f32_32x32x16_bf16(*(const LAS bf16x8*)(kb), qf[0][0], zero16, 0, 0, 0);
      SS[0] = __builtin_amdgcn_mfma_f32_32x32x16_bf16(*(const LAS bf16x8*)(kb + 32), qf[0][1], SS[0], 0, 0, 0); }
    unsigned pkp[2][4];
#pragma unroll
    for (int s = 0; s < 2; ++s)
#pragma unroll
        for (int j = 0; j < 4; ++j) pkp[s][j] = 0u;
    for (int kt = 0; kt < ntot; ++kt) {
        if (kt + 2 < ntot) FD_GLOAD(kt + 2);
        const LAS unsigned char* cb = rlds + (size_t)(kt & (FD_RING - 1)) * 2 * TB;
        const LAS unsigned char* nb = rlds + (size_t)((kt + 1) & (FD_RING - 1)) * 2 * TB;
        const LAS unsigned char* pb = rlds + (size_t)((kt + FD_RING - 1) & (FD_RING - 1)) * 2 * TB;
#pragma unroll
        for (int u = 0; u < 4; ++u) {
            const int c = u & 1;
            const int nsub = ((u + 1) & 3) >> 1, nc = (u + 1) & 1;
            const int psub = ((u + 3) & 3) >> 1, pc = (u + 3) & 1;
            const LAS unsigned char* ka = ((u < 3) ? cb : nb) + klane + (32 * nsub) * FA_LD * 2 + 64 * nc;
            const LAS unsigned char* va = ((u > 0) ? cb : pb) + TB + vlane + (32 * psub) * FA_LD * 2;
            const bf16x8 kf0 = *(const LAS bf16x8*)(ka), kf1 = *(const LAS bf16x8*)(ka + 32);
            bf16x8 vf[2][2];
#pragma unroll
            for (int s = 0; s < 2; ++s)
#pragma unroll
                for (int dt = 0; dt < 2; ++dt) { const s16x4 lo = tr_read(va + (16 * s) * FA_LD * 2 + 64 * dt), hi = tr_read(va + (16 * s + 8) * FA_LD * 2 + 64 * dt);
                    vf[s][dt] = __builtin_shufflevector(lo, hi, 0, 1, 2, 3, 4, 5, 6, 7); }
            __builtin_amdgcn_sched_barrier(0);
            f32x16& Sc = SS[u & 1]; f32x16& Sn = SS[(u + 1) & 1];
            unsigned pkc[2][4];
#pragma unroll
            for (int s = 0; s < 2; ++s) {
                float pv[8];
#pragma unroll
                for (int j = 0; j < 8; ++j) pv[j] = fast_exp2(Sc[8 * s + j]);
                lsum[c] += ((pv[0] + pv[1]) + (pv[2] + pv[3])) + ((pv[4] + pv[5]) + (pv[6] + pv[7]));
#pragma unroll
                for (int jj = 0; jj < 4; ++jj) pkc[s][jj] = pg8::cvt_pk_bf16(pv[2 * jj], pv[2 * jj + 1]);
            }
            if ((u < 3) || (kt + 1 < ntot)) {
                Sn = __builtin_amdgcn_mfma_f32_32x32x16_bf16(kf0, qf[nc][0], zero16, 0, 0, 0);
                Sn = __builtin_amdgcn_mfma_f32_32x32x16_bf16(kf1, qf[nc][1], Sn, 0, 0, 0); }
            if ((u > 0) || (kt > 0)) {
#pragma unroll
                for (int s = 0; s < 2; ++s) { u32x4 bw; bw.x = pkp[s][0]; bw.y = pkp[s][1]; bw.z = pkp[s][2]; bw.w = pkp[s][3];
#pragma unroll
                    for (int dt = 0; dt < 2; ++dt) O[pc][dt] = __builtin_amdgcn_mfma_f32_32x32x16_bf16(vf[s][dt], __builtin_bit_cast(bf16x8, bw), O[pc][dt], 0, 0, 0); } }
            __builtin_amdgcn_sched_group_barrier(0x2, 5, 0);
#pragma unroll
            for (int g = 0; g < 6; ++g) { __builtin_amdgcn_sched_group_barrier(0x8, 1, 0); __builtin_amdgcn_sched_group_barrier(0x2, 5, 0); }
            __builtin_amdgcn_sched_barrier(0);
#pragma unroll
            for (int s = 0; s < 2; ++s)
#pragma unroll
                for (int j = 0; j < 4; ++j) pkp[s][j] = pkc[s][j];
        }
        if (kt + 2 < ntot) FD_LSTORE(kt + 2);
        __syncthreads();
    }
    { const LAS unsigned char* va = rlds + (size_t)((ntot - 1) & (FD_RING - 1)) * 2 * TB + TB + vlane + 32 * FA_LD * 2;
#pragma unroll
      for (int s = 0; s < 2; ++s) { u32x4 bw; bw.x = pkp[s][0]; bw.y = pkp[s][1]; bw.z = pkp[s][2]; bw.w = pkp[s][3];
#pragma unroll
          for (int dt = 0; dt < 2; ++dt) {
              const s16x4 lo = tr_read(va + (16 * s) * FA_LD * 2 + 64 * dt), hi = tr_read(va + (16 * s + 8) * FA_LD * 2 + 64 * dt);
              const bf16x8 a = __builtin_shufflevector(lo, hi, 0, 1, 2, 3, 4, 5, 6, 7);
              O[1][dt] = __builtin_amdgcn_mfma_f32_32x32x16_bf16(a, __builtin_bit_cast(bf16x8, bw), O[1][dt], 0, 0, 0); } } }
#undef FD_TROW
#undef FD_GLOAD
#undef FD_LSTORE
    float linv[2];
#pragma unroll
    for (int c = 0; c < 2; ++c) { const float l = lsum[c] + __shfl_xor(lsum[c], 32); linv[c] = 1.0f / l; }
    bf16_t* yp = Y + (size_t)(it.qrow0 + 32 * w + lq) * DM + it.ycol + 4 * h;
    const float a1 = it.lam * linv[1];
    float ss = 0.f;
#pragma unroll
    for (int dt = 0; dt < 2; ++dt)
#pragma unroll
        for (int r = 0; r < 16; ++r) { const float v = O[0][dt][r] * linv[0] - a1 * O[1][dt][r]; O[0][dt][r] = v; ss += v * v; }
    ss += __shfl_xor(ss, 32);
    const float rinv = rsqrtf(ss * (1.0f / 64.0f) + EPSF) * it.postscale;
    const float* sg = it.subgain + 4 * h;
#pragma unroll
    for (int dt = 0; dt < 2; ++dt)
#pragma unroll
        for (int g = 0; g < 4; ++g) { const float4 gg = *(const float4*)(sg + 32 * dt + 8 * g);
            u32x2 wv; wv.x = pg8::cvt_pk_bf16(O[0][dt][4 * g] * rinv * gg.x, O[0][dt][4 * g + 1] * rinv * gg.y); wv.y = pg8::cvt_pk_bf16(O[0][dt][4 * g + 2] * rinv * gg.z, O[0][dt][4 * g + 3] * rinv * gg.w);
            *(u32x2*)(yp + 32 * dt + 8 * g) = wv; }
}

__device__ __forceinline__ float max_abs_vec(const float* g, int n) { float m = 0.f; for (int i = 0; i < n; ++i) m = fmaxf(m, fabsf(g[i])); return m; }

__device__ __forceinline__ int attn_item_remap(int x0, int G) {
    if (G != 256 || x0 >= 1024) return x0;
    const int i = x0 >> 8, bid = x0 & 255, xcd = bid & 7, slot = bid >> 3;
    const int bh = i * 16 + xcd * 2 + (slot >> 4), n = slot & 15;
    return bh * 16 + n;
}
__device__ __forceinline__ void phase_attnA(const Params& p, int l, unsigned char* smem) {
    unsigned char* ws = launder_ws(p.ws);
    const bf16_t* P = (const bf16_t*)(ws + WS_P); bf16_t* Y = (bf16_t*)(ws + WS_U);
    const float bound = 8.0f * LOG2E * 1.02f * max_abs_vec(PIN(I_AQN) + l * 64, 64) * max_abs_vec(PIN(I_AKN) + l * 64, 64);
    const int nitems = (l == DEPTH - 1) ? 1024 : 1088;
    const int cshift = (gridDim.x == 256) ? 64 : 0;
    for (int x0 = blockIdx.x; x0 < nitems + cshift; x0 += gridDim.x) {
        if (x0 >= 1024 && x0 < 1024 + cshift) continue;
        const int x = attn_item_remap(x0 >= 1024 ? x0 - cshift : x0, gridDim.x);
        AttnItem it; it.subgain = nullptr; it.lam = 0.f; it.postscale = 1.f;
        int b, h, n;
        if (x < 1024) { b = x >> 6; h = (x >> 4) & 3; n = x & 15;
            const int lo = max(0, 256 * n - 128), hi = min(TL, 256 * n + 384);
            it.qrow0 = b * TL + 256 * n; it.qpos0 = 256 * n; it.nt0 = (hi - lo) >> 6; it.krow0 = b * TL + lo; it.kpos0 = lo; it.masked = 1; }
        else { const int y = x - 1024; b = y >> 2; h = y & 3;
            it.qrow0 = NROWL + b * TCX; it.qpos0 = 0; it.nt0 = 0; it.krow0 = 0; it.kpos0 = 0; it.masked = 0; }
        it.nt1 = 4; it.krow1 = NROWL + b * TCX;
        it.qcol = h * 64; it.kcol = 256 + (h >> 1) * 64; it.vcol = 384 + (h >> 1) * 64; it.ycol = h * 64;
        it.sink2 = PIN(I_ASINK)[l * 4 + h] * LOG2E; it.M2 = fmaxf(bound, it.sink2);
        fattn_item<1>(P, Y, it, smem);
    }
}
__device__ __forceinline__ void phase_attnD(const Params& p, int l, unsigned char* smem) {
    unsigned char* ws = launder_ws(p.ws);
    const bf16_t* P = (const bf16_t*)(ws + WS_P); bf16_t* Y = (bf16_t*)(ws + WS_U);
    const float bound = 5.656854249f * LOG2E * 1.02f * max_abs_vec(PIN(I_DQN) + l * 32, 32) * max_abs_vec(PIN(I_DKN) + l * 32, 32);
    float d1 = 0.f, d2 = 0.f;
    for (int i = 0; i < 32; ++i) { d1 += PIN(I_LQ1)[l * 32 + i] * PIN(I_LK1)[l * 32 + i]; d2 += PIN(I_LQ2)[l * 32 + i] * PIN(I_LK2)[l * 32 + i]; }
    const float lam_init = 0.8f - 0.6f * expf(-0.3f * (float)l);
    const float lam = expf(d1) - expf(d2) + lam_init;
    const int nitems = (l == DEPTH - 1) ? 1024 : 1088;
    for (int x0 = blockIdx.x; x0 < nitems; x0 += gridDim.x) {
        const int x = attn_item_remap(x0, gridDim.x);
        AttnItem it; it.subgain = PIN(I_DSUB) + l * 64; it.lam = lam; it.postscale = 1.0f - lam_init; it.sink2 = 0.f; it.M2 = bound;
        int b, h, n;
        if (x < 1024) { b = x >> 6; h = (x >> 4) & 3; n = x & 15;
            it.qrow0 = b * TL + 256 * n; it.qpos0 = 0; it.nt0 = 64; it.krow0 = b * TL; it.kpos0 = 0; it.masked = 0; }
        else { const int y = x - 1024; b = y >> 2; h = y & 3;
            it.qrow0 = NROWL + b * TCX; it.qpos0 = 0; it.nt0 = 0; it.krow0 = 0; it.kpos0 = 0; it.masked = 0; }
        it.nt1 = 4; it.krow1 = NROWL + b * TCX;
        it.qcol = 1536 + h * 64; it.kcol = 1792 + h * 64; it.vcol = 2048 + h * 64; it.ycol = 768 + h * 64;
        if (bound < 100.0f) fattn_d_item(P, Y, it, smem); else fattn_item<2>(P, Y, it, smem);
    }
}

#define HY_ZROWS 4160
#define HY_FLEN 8256
#define HY_OFF_F (HY_ZROWS * 32)
#define HY_OFF_MISC (HY_OFF_F + HY_FLEN * 2)

__device__ __forceinline__ void hy_kloop(const LAS unsigned char* zs, const LAS bf16_t* fs, int w, int lane, f32x4 (&acc)[4][8]) {
    const int i = lane & 15, q = lane >> 4, qq = (lane & 15) >> 2, pp = lane & 3;
    const LAS bf16_t* ap = fs + (4096 - 512 * w + 8 * q - 8 * i);
    const LAS unsigned char* bp = zs + (8 * q + qq) * 32 + pp * 8;
    bf16x8 an[4];
#pragma unroll
    for (int m = 0; m < 4; ++m) an[m] = *(const LAS bf16x8*)(ap - 128 * m);
#pragma unroll 1
    for (int ks = 0; ks < 129; ++ks) {
        bf16x8 a[4];
#pragma unroll
        for (int m = 0; m < 4; ++m) a[m] = an[m];
#pragma unroll
        for (int m = 0; m < 4; ++m) an[m] = *(const LAS bf16x8*)(ap + 32 * (ks + 1) - 128 * m);
#pragma unroll
        for (int r = 0; r < 8; ++r) {
            const s16x4 lo = tr_read(bp + (32 * ks + r) * 32), hi = tr_read(bp + (32 * ks + r) * 32 + 128);
            const bf16x8 b = __builtin_shufflevector(lo, hi, 0, 1, 2, 3, 4, 5, 6, 7);
#pragma unroll
            for (int m = 0; m < 4; ++m) acc[m][r] = __builtin_amdgcn_mfma_f32_16x16x32_bf16(a[m], b, acc[m][r], 0, 0, 0);
        }
    }
}
__device__ __forceinline__ float hy_sconv(const bf16_t* u, int t, int T, float c0, float c1, float c2) {
    const int tm = t > 0 ? t - 1 : 0, tp = t < T - 1 ? t + 1 : T - 1;
    const float um = bf2f(u[tm]), u0 = bf2f(u[t]), up = bf2f(u[tp]);
    return (t > 0 ? c0 : 0.f) * um + c1 * u0 + (t < T - 1 ? c2 : 0.f) * up;
}
__device__ __forceinline__ void hy_gate8(const bf16_t* ub  , int t0, float c0, float c1, float c2, float (&g)[8]) {
    const u32x4 raw = *(const u32x4*)ub; const float hl = bf2f(ub[-1]), hr = bf2f(ub[8]);
    float x[10];
    x[0] = t0 > 0 ? hl : 0.f; x[9] = t0 + 8 < 4096 ? hr : 0.f;
    x[1] = bflo(raw.x); x[2] = bfhi(raw.x); x[3] = bflo(raw.y); x[4] = bfhi(raw.y); x[5] = bflo(raw.z); x[6] = bfhi(raw.z); x[7] = bflo(raw.w); x[8] = bfhi(raw.w);
#pragma unroll
    for (int e = 0; e < 8; ++e) g[e] = c0 * x[e] + c1 * x[e + 1] + c2 * x[e + 2];
}
__device__ __forceinline__ float block_sum(float v, float* red  ) {
    v = wave_sum(v);
    __syncthreads();
    if ((my_tid() & 63) == 0) red[my_tid() >> 6] = v;
    __syncthreads();
    float s = 0.f;
#pragma unroll
    for (int w = 0; w < 8; ++w) s += red[w];
    return s;
}

__device__ __forceinline__ void phase_hyena(const Params& p, int l, unsigned char* smem) {
    unsigned char* ws = launder_ws(p.ws);
    LAS unsigned char* lds = (LAS unsigned char*)smem;
    bf16_t* Zs = (bf16_t*)smem; bf16_t* Fs = (bf16_t*)(smem + HY_OFF_F);
    float* fw3c = (float*)(smem + HY_OFF_MISC);
    float* red = fw3c + 256;
    float* HT = (float*)smem;
    const bf16_t* UT = (const bf16_t*)(ws + WS_UT);
    bf16_t* YT = (bf16_t*)(ws + WS_YT);
    const float* H2L = (const float*)(ws + WS_HID2L); const float* H2C = (const float*)(ws + WS_HID2C);
    const float* fw3 = PIN(I_FW3) + (size_t)l * 64 * 1024;
    const float* cw = PIN(I_HYCONV) + (size_t)l * 3 * 768;
    const float da = logf(1e-2f) / 1.5f, db = logf(1e-2f) / 0.3f;
    for (int c = blockIdx.x; c < 256; c += gridDim.x) {
        const int tid = my_tid(), lane = tid & 63, w = tid >> 6;
        bf16_t* FB = (bf16_t*)(ws + WS_FBUF) + (size_t)c * HY_FLEN;
        const float delta = fabsf(da + (float)c * ((db - da) / 255.0f));
        const float bias0 = PIN(I_HYBIAS)[l * 512 + c], bias1 = PIN(I_HYBIAS)[l * 512 + 256 + c];
        __syncthreads();
        if (tid < 256) fw3c[tid] = fw3[(size_t)(tid & 63) * 1024 + (tid >> 6) * 256 + c];
        __syncthreads();
        float ss0 = 0.f, ss1 = 0.f;
#pragma unroll 1
        for (int lag = tid; lag < 4096; lag += NTHR) {
            const float4* hr = (const float4*)(H2L + (size_t)lag * 64);
            float a0 = 0.f, a1 = 0.f, a2 = 0.f, a3 = 0.f;
#pragma unroll
            for (int k4 = 0; k4 < 16; ++k4) { const float4 h = hr[k4];
                a0 += h.x * fw3c[4 * k4] + h.y * fw3c[4 * k4 + 1] + h.z * fw3c[4 * k4 + 2] + h.w * fw3c[4 * k4 + 3];
                a1 += h.x * fw3c[64 + 4 * k4] + h.y * fw3c[64 + 4 * k4 + 1] + h.z * fw3c[64 + 4 * k4 + 2] + h.w * fw3c[64 + 4 * k4 + 3];
                a2 += h.x * fw3c[128 + 4 * k4] + h.y * fw3c[128 + 4 * k4 + 1] + h.z * fw3c[128 + 4 * k4 + 2] + h.w * fw3c[128 + 4 * k4 + 3];
                a3 += h.x * fw3c[192 + 4 * k4] + h.y * fw3c[192 + 4 * k4 + 1] + h.z * fw3c[192 + 4 * k4 + 2] + h.w * fw3c[192 + 4 * k4 + 3]; }
            const float dec = expf(-((float)lag / 4095.0f) * delta);
            a0 *= dec; a1 *= dec; a2 *= dec; a3 *= dec;
            HT[lag] = a0; HT[4096 + lag] = a1; HT[8192 + lag] = a2; HT[12288 + lag] = a3;
            ss0 += a0 * a0 + (lag >= 1 ? a2 * a2 : 0.f); ss1 += a1 * a1 + (lag >= 1 ? a3 * a3 : 0.f);
        }
        ss0 = block_sum(ss0, red); ss1 = block_sum(ss1, red);
        const float n0 = rsqrtf(ss0 + EPSF), n1 = rsqrtf(ss1 + EPSF);
#pragma unroll 1
        for (int x = tid; x < HY_FLEN; x += NTHR) { const int d = 4128 - x; float f0 = 0.f, f1 = 0.f;
            if (d >= 0 && d <= 4095) { f0 = HT[d] * n0; f1 = HT[4096 + d] * n1; } else if (d < 0 && d >= -4095) { f0 = HT[8192 - d] * n0; f1 = HT[12288 - d] * n1; }
            Fs[x] = f2bf(f0); FB[x] = f2bf(f1); }
        __syncthreads();
        for (int idx = tid; idx < 1024; idx += NTHR) { const int rr = idx >> 4; Zs[(rr < 32 ? rr : 4096 + rr) * 16 + (idx & 15)] = 0; }
        { const bf16_t* u = UT + (size_t)c * NROW; const float v0 = cw[c], v1 = cw[768 + c], v2 = cw[1536 + c];
#pragma unroll 2
          for (int idx = tid; idx < 8192; idx += NTHR) { const int b = idx >> 9, t0 = (idx & 511) * 8;
              float g[8]; hy_gate8(u + b * 4096 + t0, t0, v0, v1, v2, g);
#pragma unroll
              for (int i = 0; i < 8; ++i) Zs[(t0 + i + 32) * 16 + b] = f2bf(g[i]); } }
        __syncthreads();
        f32x4 acc[4][8];
#pragma unroll
        for (int m = 0; m < 4; ++m)
#pragma unroll
            for (int r = 0; r < 8; ++r) acc[m][r] = (f32x4){0.f, 0.f, 0.f, 0.f};
        hy_kloop(lds, (const LAS bf16_t*)(lds + HY_OFF_F), w, lane, acc);
        { int lo = lane, wo = w; asm volatile("" : "+v"(lo), "+v"(wo));
          const float g0 = cw[256 + c], g1 = cw[768 + 256 + c], g2 = cw[1536 + 256 + c];
          const int tb0 = 512 * wo + 32 * (lo >> 4);
          const bf16_t* u1 = UT + (size_t)(256 + c) * NROW + (lo & 15) * 4096 + tb0;
          const bf16_t* zp = Zs + (tb0 + 32) * 16 + (lo & 15);
#pragma unroll
          for (int m = 0; m < 4; ++m)
#pragma unroll
              for (int j = 0; j < 4; ++j) { float g[8]; hy_gate8(u1 + 128 * m + 8 * j, tb0 + 128 * m + 8 * j, g0, g1, g2, g);
#pragma unroll
                  for (int r = 0; r < 8; ++r) { const float z = bf2f(zp[(128 * m + r + 8 * j) * 16]); acc[m][r][j] = g[r] * (acc[m][r][j] + bias0 * z); }
                  asm volatile("" ::: "memory"); } }
        __syncthreads();
        { int lo = lane, wo = w; asm volatile("" : "+v"(lo), "+v"(wo));
          bf16_t* zp = Zs + (512 * wo + 32 * (lo >> 4) + 32) * 16 + (lo & 15);
#pragma unroll
          for (int m = 0; m < 4; ++m)
#pragma unroll
              for (int r = 0; r < 8; ++r) {
#pragma unroll
                  for (int j = 0; j < 4; ++j) zp[(128 * m + r + 8 * j) * 16] = f2bf(acc[m][r][j]);
                  asm volatile("" ::: "memory"); } }
        for (int x = tid; x < HY_FLEN / 8; x += NTHR) ((u32x4*)Fs)[x] = ((const u32x4*)FB)[x];
        __syncthreads();
#pragma unroll
        for (int m = 0; m < 4; ++m)
#pragma unroll
            for (int r = 0; r < 8; ++r) acc[m][r] = (f32x4){0.f, 0.f, 0.f, 0.f};
        hy_kloop(lds, (const LAS bf16_t*)(lds + HY_OFF_F), w, lane, acc);
        { int lo = lane, wo = w; asm volatile("" : "+v"(lo), "+v"(wo));
          const float e0 = cw[512 + c], e1 = cw[768 + 512 + c], e2 = cw[1536 + 512 + c];
          const int tb0 = 512 * wo + 32 * (lo >> 4);
          const bf16_t* u2 = UT + (size_t)(512 + c) * NROW + (lo & 15) * 4096 + tb0;
          bf16_t* yo = YT + (size_t)c * NROW + (lo & 15) * 4096 + tb0;
          const bf16_t* zp = Zs + (tb0 + 32) * 16 + (lo & 15);
#pragma unroll
          for (int m = 0; m < 4; ++m)
#pragma unroll
              for (int j = 0; j < 4; ++j) { float g[8]; hy_gate8(u2 + 128 * m + 8 * j, tb0 + 128 * m + 8 * j, e0, e1, e2, g);
#pragma unroll
                  for (int r = 0; r < 8; ++r) { const float z1 = bf2f(zp[(128 * m + r + 8 * j) * 16]); g[r] = g[r] * (acc[m][r][j] + bias1 * z1); }
                  u32x4 o; o.x = pack_bf16(g[0], g[1]); o.y = pack_bf16(g[2], g[3]); o.z = pack_bf16(g[4], g[5]); o.w = pack_bf16(g[6], g[7]);
                  *(u32x4*)(yo + 128 * m + 8 * j) = o;
                  asm volatile("" ::: "memory"); } }
        __syncthreads();
        if (l < DEPTH - 1) {   float* HTc = (float*)smem;
            const float v0 = cw[c], v1 = cw[768 + c], v2 = cw[1536 + c], g0 = cw[256 + c], g1 = cw[768 + 256 + c], g2 = cw[1536 + 256 + c], e0 = cw[512 + c], e1 = cw[768 + 512 + c], e2 = cw[1536 + 512 + c];
            float* Zc = HTc + 1024;
            float* Z1c = Zc + 4096;
            float t0 = 0.f, t1 = 0.f;
            if (tid < 256) { const int lag = tid; const float* hr = H2C + (size_t)lag * 64; float a0 = 0.f, a1 = 0.f, a2 = 0.f, a3 = 0.f;
                for (int k = 0; k < 64; ++k) { const float h = hr[k]; a0 += h * fw3c[k]; a1 += h * fw3c[64 + k]; a2 += h * fw3c[128 + k]; a3 += h * fw3c[192 + k]; }
                const float dec = expf(-((float)lag / 255.0f) * delta);
                a0 *= dec; a1 *= dec; a2 *= dec; a3 *= dec;
                HTc[lag] = a0; HTc[256 + lag] = a1; HTc[512 + lag] = a2; HTc[768 + lag] = a3;
                t0 = a0 * a0 + (lag >= 1 ? a2 * a2 : 0.f); t1 = a1 * a1 + (lag >= 1 ? a3 * a3 : 0.f); }
            t0 = block_sum(t0, red); t1 = block_sum(t1, red);
            const float m0 = rsqrtf(t0 + EPSF), m1 = rsqrtf(t1 + EPSF);
            const bf16_t* uc = UT + (size_t)c * NROW + NROWL;
#pragma unroll 1
            for (int idx = tid; idx < 4096; idx += NTHR) { const int b = idx >> 8, t = idx & 255; Zc[t * 16 + b] = hy_sconv(uc + b * 256, t, 256, v0, v1, v2); }
            __syncthreads();
            const bf16_t* u1c = UT + (size_t)(256 + c) * NROW + NROWL; const bf16_t* u2c = UT + (size_t)(512 + c) * NROW + NROWL;
            const int tq = tid & 255, bh = tid >> 8;
            float y[8];
#pragma unroll
            for (int i = 0; i < 8; ++i) y[i] = 0.f;
#pragma unroll 2
            for (int s2 = 0; s2 < 256; ++s2) { const int d = tq - s2; const float h = d >= 0 ? HTc[d] : HTc[512 - d];
                const float4 za = *(const float4*)(Zc + s2 * 16 + 8 * bh), zb = *(const float4*)(Zc + s2 * 16 + 8 * bh + 4);
                y[0] += h * za.x; y[1] += h * za.y; y[2] += h * za.z; y[3] += h * za.w; y[4] += h * zb.x; y[5] += h * zb.y; y[6] += h * zb.z; y[7] += h * zb.w; }
#pragma unroll
            for (int i = 0; i < 8; ++i) { const int b = 8 * bh + i; const float yy = y[i] * m0 + bias0 * Zc[tq * 16 + b];
                Z1c[tq * 16 + b] = hy_sconv(u1c + b * 256, tq, 256, g0, g1, g2) * yy; y[i] = 0.f; }
            __syncthreads();
#pragma unroll 2
            for (int s2 = 0; s2 < 256; ++s2) { const int d = tq - s2; const float h = d >= 0 ? HTc[256 + d] : HTc[768 - d];
                const float4 za = *(const float4*)(Z1c + s2 * 16 + 8 * bh), zb = *(const float4*)(Z1c + s2 * 16 + 8 * bh + 4);
                y[0] += h * za.x; y[1] += h * za.y; y[2] += h * za.z; y[3] += h * za.w; y[4] += h * zb.x; y[5] += h * zb.y; y[6] += h * zb.z; y[7] += h * zb.w; }
#pragma unroll
            for (int i = 0; i < 8; ++i) { const int b = 8 * bh + i; const float yy = y[i] * m1 + bias1 * Z1c[tq * 16 + b];
                YT[(size_t)c * NROW + NROWL + b * 256 + tq] = f2bf(hy_sconv(u2c + b * 256, tq, 256, e0, e1, e2) * yy); }
            __syncthreads();
        }
    }
}

__device__ __forceinline__ void phase_hy_transpose(const Params& p, int l, unsigned char* smem) {
    unsigned char* ws = launder_ws(p.ws);
    const bf16_t* YT = (const bf16_t*)(ws + WS_YT); bf16_t* Y = (bf16_t*)(ws + WS_U);
    bf16_t* tile = (bf16_t*)smem;
    const int tid = my_tid();
    const int ntile = 4 * ((l == DEPTH - 1 ? NROWL : NROW) / 64);
    for (int it = blockIdx.x; it < ntile; it += gridDim.x) {
        const int ct = it & 3, rt = it >> 2;
        __syncthreads();
        { const int ch = tid >> 3, seg = tid & 7;
          const u32x4 v = *(const u32x4*)(YT + (size_t)(ct * 64 + ch) * NROW + rt * 64 + seg * 8);
          unsigned* d = (unsigned*)(tile + ch * 66 + seg * 8); d[0] = v.x; d[1] = v.y; d[2] = v.z; d[3] = v.w; }
        __syncthreads();
        { const int r = tid >> 3, seg = tid & 7;
          unsigned wv[4];
#pragma unroll
          for (int k = 0; k < 4; ++k) wv[k] = (unsigned)tile[(seg * 8 + 2 * k) * 66 + r] | ((unsigned)tile[(seg * 8 + 2 * k + 1) * 66 + r] << 16);
          u32x4 o; o.x = wv[0]; o.y = wv[1]; o.z = wv[2]; o.w = wv[3];
          *(u32x4*)(Y + (size_t)(rt * 64 + r) * DM + 256 + ct * 64 + seg * 8) = o; }
    }
    __syncthreads();
}
#define ML_ITEMS 4352
__device__ __forceinline__ void ml_decode(int it, int& b, int& head, int& tc, int& tok0, int& jf, int& jb) {
    b = it / 272; const int r = it - b * 272; head = r / 68; tc = r - head * 68;
    tok0 = tc < 4 ? NROWL + b * TCX + 64 * tc : b * TL + 64 * (tc - 4);
    jf = tc; jb = tc < 4 ? 3 - tc : 71 - tc;
}

__device__ __forceinline__ void phase_ml_local(const Params& p, int l, unsigned char* smem) {
    unsigned char* ws = launder_ws(p.ws);
    const int tid = my_tid(), lane = tid & 63, w = tid >> 6;
    bf16_t* Kt = (bf16_t*)smem;
    bf16_t* VwF = Kt + 64 * 72;
    bf16_t* VwB = VwF + 64 * 72;
    float* Vs = (float*)(VwB + 64 * 72);
    float* vec = Vs + 64 * 65;
    float* igf = vec, *igb = vec + 64, *lff = vec + 128, *lfb = vec + 192, *wf = vec + 256, *wb = vec + 320, *scal = vec + 384;
    const bf16_t* P = (const bf16_t*)(ws + WS_P);
    const float* GT = (const float*)(ws + WS_GATES);
    bf16_t* MLA = (bf16_t*)(ws + WS_MLA); float* MLN = (float*)(ws + WS_MLN); float* MLS = (float*)(ws + WS_MLS);
    const float* bg = PIN(I_BGATE) + l * 16;
    for (int it = blockIdx.x; it < ML_ITEMS; it += gridDim.x) {
        int b, head, tc, tok0, jf, jb; ml_decode(it, b, head, tc, tok0, jf, jb);
        __syncthreads();
        { const int s = tid >> 3, ch = tid & 7;
          const bf16_t* pr = P + (size_t)(tok0 + s) * PW + head * 64 + ch * 8;
          const u32x4 kv = *(const u32x4*)(pr + 768), vv = *(const u32x4*)(pr + 1024);
          const unsigned kw[4] = {kv.x, kv.y, kv.z, kv.w}, vw[4] = {vv.x, vv.y, vv.z, vv.w};
#pragma unroll
          for (int i = 0; i < 4; ++i) { Kt[(ch * 8 + 2 * i) * 72 + s] = f2bf(bflo(kw[i]) * 0.125f); Kt[(ch * 8 + 2 * i + 1) * 72 + s] = f2bf(bfhi(kw[i]) * 0.125f);
              Vs[s * 65 + ch * 8 + 2 * i] = bflo(vw[i]); Vs[s * 65 + ch * 8 + 2 * i + 1] = bfhi(vw[i]); } }
        if (tid < 64) { const float* g = GT + (size_t)(tok0 + tid) * 16;
            igf[tid] = g[head] + bg[head]; igb[tid] = g[4 + head] + bg[4 + head]; lff[tid] = log_sigmoid(g[8 + head] + bg[8 + head]); lfb[tid] = log_sigmoid(g[12 + head] + bg[12 + head]); }
        __syncthreads();
        if (tid < 128) {
            const int dirw = tid >> 6, tau = tid & 63, s = dirw ? 63 - tau : tau;
            const float lf = dirw ? lfb[s] : lff[s], ig = dirw ? igb[s] : igf[s];
            float cum = lf;
#pragma unroll
            for (int o = 1; o < 64; o <<= 1) { const float n = __shfl_up(cum, o); if (tau >= o) cum += n; }
            const float B = __shfl(cum, 63);
            const float ge = B - cum + ig;
            const float ml = wave_max(ge);
            (dirw ? wb : wf)[s] = expf(ge - ml);
            if (tau == 0) { scal[2 * dirw] = B; scal[2 * dirw + 1] = ml; } }
        __syncthreads();
        { const int e = tid >> 3, sc = (tid & 7) * 8; u32x4 a, c2; float x[8], y[8];
#pragma unroll
          for (int i = 0; i < 8; ++i) { const float v = Vs[(sc + i) * 65 + e]; x[i] = v * wf[sc + i]; y[i] = v * wb[sc + i]; }
          a.x = pack_bf16(x[0], x[1]); a.y = pack_bf16(x[2], x[3]); a.z = pack_bf16(x[4], x[5]); a.w = pack_bf16(x[6], x[7]);
          c2.x = pack_bf16(y[0], y[1]); c2.y = pack_bf16(y[2], y[3]); c2.z = pack_bf16(y[4], y[5]); c2.w = pack_bf16(y[6], y[7]);
          *(u32x4*)(VwF + e * 72 + sc) = a; *(u32x4*)(VwB + e * 72 + sc) = c2; }
        __syncthreads();
        const int dir = w >> 2, wl = w & 3, te = wl >> 1, tk = wl & 1;
        const int seq = (b * 4 + head) * 2 + dir, j = dir ? jb : jf;
        bf16_t* dst = MLA + ((size_t)seq * 68 + j) * 4096;
        { f32x16 C;
#pragma unroll
          for (int r = 0; r < 16; ++r) C[r] = 0.f;
          C = mma32((dir ? VwB : VwF) + 32 * te * 72, 72, Kt + 32 * tk * 72, 72, 64, C, lane);
#pragma unroll
          for (int r = 0; r < 16; ++r) dst[(32 * te + CROW(r, lane)) * 64 + 32 * tk + (lane & 31)] = f2bf(C[r]); }
        if (wl == 0) {
            const float* wv = dir ? wb : wf; float s = 0.f;
            for (int t = 0; t < 64; ++t) s += wv[t] * bf2f(Kt[lane * 72 + t]);
            MLN[((size_t)seq * 68 + j) * 64 + lane] = s;
            if (lane == 0) { MLS[((size_t)seq * 68 + j) * 4 + 0] = scal[2 * dir]; MLS[((size_t)seq * 68 + j) * 4 + 1] = scal[2 * dir + 1]; }
        }
    }
    __syncthreads();
}

__device__ __forceinline__ void phase_ml_scan(const Params& p) {
    unsigned char* ws = launder_ws(p.ws);
    const int tid = my_tid();
    unsigned* MLA = (unsigned*)(ws + WS_MLA); float* MLN = (float*)(ws + WS_MLN); float* MLS = (float*)(ws + WS_MLS);
    for (int it = blockIdx.x; it < 512; it += gridDim.x) {
        const int seq = it >> 2, part = it & 3;
        unsigned* base = MLA + (size_t)seq * 68 * 2048 + part * 512 + tid;
        float* nb = MLN + (size_t)seq * 68 * 64 + part * 16 + tid;
        float* sc = MLS + (size_t)seq * 68 * 4;
        const bool hasn = tid < 16;
        float m = 0.f, c0 = 0.f, c1 = 0.f, cn = 0.f;
#define ML_SCAN_BATCH(NBATCH, J0) do { unsigned a[NBATCH]; float an[NBATCH], B[NBATCH], ML[NBATCH]; \
            _Pragma("unroll") for (int u = 0; u < NBATCH; ++u) { a[u] = base[(size_t)((J0) + u) * 2048]; an[u] = hasn ? nb[((J0) + u) * 64] : 0.f; B[u] = sc[((J0) + u) * 4]; ML[u] = sc[((J0) + u) * 4 + 1]; } \
            _Pragma("unroll") for (int u = 0; u < NBATCH; ++u) { \
                const float mn = fmaxf(B[u] + m, ML[u]); const float wp = expf(B[u] + m - mn), wa = expf(ML[u] - mn); \
                if (part == 0 && tid == 0) sc[((J0) + u) * 4 + 2] = m; \
                base[(size_t)((J0) + u) * 2048] = pack_bf16(c0, c1); if (hasn) nb[((J0) + u) * 64] = cn; \
                c0 = wp * c0 + wa * bflo(a[u]); c1 = wp * c1 + wa * bfhi(a[u]); cn = wp * cn + wa * an[u]; m = mn; } } while (0)
        for (int j0 = 0; j0 < 64; j0 += 8) ML_SCAN_BATCH(8, j0);
        ML_SCAN_BATCH(4, 64);
#undef ML_SCAN_BATCH
    }
}

__device__ __forceinline__ void phase_ml_out(const Params& p, int l, unsigned char* smem) {
    unsigned char* ws = launder_ws(p.ws);
    const int tid = my_tid(), lane = tid & 63, w = tid >> 6;
    const int DSZ = 71680;
    const bf16_t* P = (const bf16_t*)(ws + WS_P);
    const float* GT = (const float*)(ws + WS_GATES);
    const bf16_t* MLA = (const bf16_t*)(ws + WS_MLA); const float* MLN = (const float*)(ws + WS_MLN); const float* MLS = (const float*)(ws + WS_MLS);
    bf16_t* Y = (bf16_t*)(ws + WS_U);
    const float* bg = PIN(I_BGATE) + l * 16; const float* mln = PIN(I_MLNORM) + l * 64;
    u32x4 pq, pk_, pv, pst[2]; float pn = 0.f, pg0 = 0.f, pg1 = 0.f, pm = 0.f;
#define ML_SKIP(it_) ({ int b_, h_, tc_, t0_, jf_, jb_; ml_decode((it_), b_, h_, tc_, t0_, jf_, jb_); (l == DEPTH - 1 && tc_ < 4); })
#define ML_FETCH(it_) do { int b_, h_, tc_, t0_, jf_, jb_; ml_decode((it_), b_, h_, tc_, t0_, jf_, jb_); \
        { const int s_ = tid >> 3, ch_ = tid & 7; const bf16_t* pr_ = P + (size_t)(t0_ + s_) * PW + h_ * 64 + ch_ * 8; \
          pq = *(const u32x4*)(pr_ + 512); pk_ = *(const u32x4*)(pr_ + 768); pv = *(const u32x4*)(pr_ + 1024); } \
        _Pragma("unroll") for (int d_ = 0; d_ < 2; ++d_) { const int seq_ = (b_ * 4 + h_) * 2 + d_, j_ = d_ ? jb_ : jf_; \
          pst[d_] = *(const u32x4*)(MLA + ((size_t)seq_ * 68 + j_) * 4096 + (tid >> 3) * 64 + (tid & 7) * 8); } \
        if (tid < 128) { const int d_ = tid >> 6, tau_ = tid & 63, tk_ = d_ ? 63 - tau_ : tau_; const int seq_ = (b_ * 4 + h_) * 2 + d_, j_ = d_ ? jb_ : jf_; \
          pn = MLN[((size_t)seq_ * 68 + j_) * 64 + tau_]; const float* g_ = GT + (size_t)(t0_ + tk_) * 16; \
          pg0 = g_[4 * d_ + h_]; pg1 = g_[8 + 4 * d_ + h_]; pm = MLS[((size_t)seq_ * 68 + j_) * 4 + 2]; } } while (0)
    int it = blockIdx.x;
    while (it < ML_ITEMS && ML_SKIP(it)) it += gridDim.x;
    if (it < ML_ITEMS) ML_FETCH(it);
    while (it < ML_ITEMS) {
        int b, head, tc, tok0, jf, jb; ml_decode(it, b, head, tc, tok0, jf, jb);
        int nit = it + gridDim.x;
        while (nit < ML_ITEMS && ML_SKIP(nit)) nit += gridDim.x;
        __syncthreads();
        {   const int s = tid >> 3, ch = tid & 7;
            const u32x4 qv = pq, kv = pk_, vv = pv;
            u32x4 ks; ks.x = pack_bf16(bflo(kv.x) * 0.125f, bfhi(kv.x) * 0.125f); ks.y = pack_bf16(bflo(kv.y) * 0.125f, bfhi(kv.y) * 0.125f);
            ks.z = pack_bf16(bflo(kv.z) * 0.125f, bfhi(kv.z) * 0.125f); ks.w = pack_bf16(bflo(kv.w) * 0.125f, bfhi(kv.w) * 0.125f);
            const unsigned vw[4] = {vv.x, vv.y, vv.z, vv.w};
#pragma unroll
            for (int d = 0; d < 2; ++d) { unsigned char* D = smem + d * DSZ; const int tau = d ? 63 - s : s;
                bf16_t* Qd = (bf16_t*)D; bf16_t* Kd = Qd + 64 * 72; bf16_t* Bd = Kd + 64 * 72 + 64 * 136;
                *(u32x4*)(Qd + tau * 72 + ch * 8) = qv; *(u32x4*)(Kd + tau * 72 + ch * 8) = ks;
#pragma unroll
                for (int i = 0; i < 4; ++i) { Bd[(ch * 8 + 2 * i) * 136 + tau] = (bf16_t)(vw[i] & 0xffff); Bd[(ch * 8 + 2 * i + 1) * 136 + tau] = (bf16_t)(vw[i] >> 16); } }
#pragma unroll
            for (int d = 0; d < 2; ++d) { unsigned char* D = smem + d * DSZ; bf16_t* Bd = (bf16_t*)D + 2 * 64 * 72 + 64 * 136;
                const int e = tid >> 3, k0 = (tid & 7) * 8;
                *(u32x4*)(Bd + e * 136 + 64 + k0) = pst[d]; }
            if (tid < 128) { const int d = tid >> 6, tau = tid & 63;
                float* vecs = (float*)(smem + d * DSZ + 53248);
                vecs[3 * 64 + tau] = pn;
                vecs[4 * 64 + tau] = pg0 + bg[4 * d + head];
                vecs[5 * 64 + tau] = log_sigmoid(pg1 + bg[8 + 4 * d + head]); }
        }
        const float mcur = pm;
        if (nit < ML_ITEMS) ML_FETCH(nit);
        __syncthreads();
        if (tid < 128) { const int d = tid >> 6, tau = tid & 63; float* vecs = (float*)(smem + d * DSZ + 53248);
            const int seq = (b * 4 + head) * 2 + d, j = d ? jb : jf;
            const float m = mcur;
            float cum = vecs[5 * 64 + tau];
#pragma unroll
            for (int o = 1; o < 64; o <<= 1) { const float n = __shfl_up(cum, o); if (tau >= o) cum += n; }
            float mm = vecs[4 * 64 + tau] - cum;
#pragma unroll
            for (int o = 1; o < 64; o <<= 1) { const float n = __shfl_up(mm, o); if (tau >= o) mm = fmaxf(mm, n); }
            const float mt = cum + fmaxf(m, mm);
            vecs[tau] = cum; vecs[64 + tau] = mt; vecs[128 + tau] = expf(cum + m - mt); }
        __syncthreads();
        const int d = w >> 2, wl = w & 3, tt = wl >> 1, tx = wl & 1;
        unsigned char* D = smem + d * DSZ;
        bf16_t* Qd = (bf16_t*)D; bf16_t* Kd = Qd + 64 * 72; bf16_t* Ad = Kd + 64 * 72; bf16_t* Bd = Ad + 64 * 136;
        float* vecs = (float*)(D + 53248); float* Hd = vecs + 7 * 64;
        {   f32x16 S;
#pragma unroll
            for (int r = 0; r < 16; ++r) S[r] = 0.f;
            S = mma32(Qd + 32 * tt * 72, 72, Kd + 32 * tx * 72, 72, 64, S, lane);
            const int s = 32 * tx + (lane & 31); const float bs = vecs[s], igs = vecs[4 * 64 + s];
#pragma unroll
            for (int r = 0; r < 16; ++r) { const int t = 32 * tt + CROW(r, lane);
                const float val = (s <= t) ? S[r] * fast_exp2((vecs[t] - bs + igs - vecs[64 + t]) * LOG2E) : 0.f;
                Ad[t * 136 + s] = f2bf(val); }
            const int tl = tid & 255, t = tl >> 2, qd = tl & 3; const float wi = vecs[128 + t];
#pragma unroll
            for (int v = 0; v < 2; ++v) { const u32x4 q = *(const u32x4*)(Qd + t * 72 + 16 * qd + 8 * v); u32x4 o;
                o.x = pack_bf16(bflo(q.x) * wi, bfhi(q.x) * wi); o.y = pack_bf16(bflo(q.y) * wi, bfhi(q.y) * wi); o.z = pack_bf16(bflo(q.z) * wi, bfhi(q.z) * wi); o.w = pack_bf16(bflo(q.w) * wi, bfhi(q.w) * wi);
                *(u32x4*)(Ad + t * 136 + 64 + 16 * qd + 8 * v) = o; }
        }
        __syncthreads();
        {   f32x16 N;
#pragma unroll
            for (int r = 0; r < 16; ++r) N[r] = 0.f;
            N = mma32(Ad + 32 * tt * 136, 136, Bd + 32 * tx * 136, 136, 128, N, lane);
#pragma unroll
            for (int r = 0; r < 16; ++r) Hd[(32 * tt + CROW(r, lane)) * 65 + 32 * tx + (lane & 31)] = N[r];
            const int tl = tid & 255;
            {
                const int t = tl >> 2, qd = tl & 3; float dn = 0.f;
                const u32x4 sa = *(const u32x4*)(Ad + t * 136 + 16 * qd), sb = *(const u32x4*)(Ad + t * 136 + 16 * qd + 8);
                const u32x4 qa = *(const u32x4*)(Ad + t * 136 + 64 + 16 * qd), qb = *(const u32x4*)(Ad + t * 136 + 64 + 16 * qd + 8);
                const float* nv = vecs + 3 * 64 + 16 * qd;
                dn += (bflo(sa.x) + bfhi(sa.x)) + (bflo(sa.y) + bfhi(sa.y)) + (bflo(sa.z) + bfhi(sa.z)) + (bflo(sa.w) + bfhi(sa.w));
                dn += (bflo(sb.x) + bfhi(sb.x)) + (bflo(sb.y) + bfhi(sb.y)) + (bflo(sb.z) + bfhi(sb.z)) + (bflo(sb.w) + bfhi(sb.w));
                dn += bflo(qa.x) * nv[0] + bfhi(qa.x) * nv[1] + bflo(qa.y) * nv[2] + bfhi(qa.y) * nv[3] + bflo(qa.z) * nv[4] + bfhi(qa.z) * nv[5] + bflo(qa.w) * nv[6] + bfhi(qa.w) * nv[7];
                dn += bflo(qb.x) * nv[8] + bfhi(qb.x) * nv[9] + bflo(qb.y) * nv[10] + bfhi(qb.y) * nv[11] + bflo(qb.z) * nv[12] + bfhi(qb.z) * nv[13] + bflo(qb.w) * nv[14] + bfhi(qb.w) * nv[15];
                dn += dpp_get<DPP_XOR1>(dn); dn += dpp_get<DPP_XOR2>(dn);
                if (qd == 0) vecs[6 * 64 + t] = dn; }
        }
        __syncthreads();
        {   const int s = tid >> 3, e0 = (tid & 7) * 8;
            const float* vF = (const float*)(smem + 53248); const float* HF = vF + 7 * 64;
            const float* vB = (const float*)(smem + DSZ + 53248); const float* HB = vB + 7 * 64;
            const int tb = 63 - s;
            const float rf = 1.0f / fmaxf(fabsf(vF[6 * 64 + s]), fast_exp2(-vF[64 + s] * LOG2E)), rb = 1.0f / fmaxf(fabsf(vB[6 * 64 + tb]), fast_exp2(-vB[64 + tb] * LOG2E));
            float y[8], ss = 0.f;
#pragma unroll
            for (int i = 0; i < 8; ++i) { y[i] = HF[s * 65 + e0 + i] * rf + HB[tb * 65 + e0 + i] * rb; ss += y[i] * y[i]; }
            ss += __shfl_xor(ss, 1); ss += __shfl_xor(ss, 2); ss += __shfl_xor(ss, 4);
            const float rinv = rsqrtf(ss * (1.0f / 64.0f) + EPSF);
            const u32x4 ov = *(const u32x4*)(P + (size_t)(tok0 + s) * PW + 1280 + head * 64 + e0);
            const float op[8] = {bflo(ov.x), bfhi(ov.x), bflo(ov.y), bfhi(ov.y), bflo(ov.z), bfhi(ov.z), bflo(ov.w), bfhi(ov.w)};
            float o[8];
#pragma unroll
            for (int i = 0; i < 8; ++i) o[i] = y[i] * rinv * mln[e0 + i] * __builtin_amdgcn_rcpf(1.0f + fast_exp2(-op[i] * LOG2E));
            u32x4 wv; wv.x = pack_bf16(o[0], o[1]); wv.y = pack_bf16(o[2], o[3]); wv.z = pack_bf16(o[4], o[5]); wv.w = pack_bf16(o[6], o[7]);
            *(u32x4*)(Y + (size_t)(tok0 + s) * DM + 512 + head * 64 + e0) = wv;
        }
        it = nit;
    }
#undef ML_SKIP
#undef ML_FETCH
    __syncthreads();
}
#ifndef DUPMASK
#define DUPMASK 0
#endif
#ifndef PROBE_KIND
#define PROBE_KIND 0
#endif
#ifndef PROBE_MASK
#define PROBE_MASK 0
#endif
#ifndef PROBE_MULT
#define PROBE_MULT 1
#endif
#if PROBE_KIND
#define PROBE_PRE() do { if (blockIdx.x == 0 && threadIdx.x == 0) pw[0] = (unsigned)wall_clock64(); } while (0)
#define PROBE_POST(id) do { if (blockIdx.x == 0 && threadIdx.x == 0) { const unsigned t_ = (unsigned)wall_clock64(), c_ = (unsigned)clock64(); \
        if ((PROBE_MASK >> (id)) & 1) { if (PROBE_KIND == 1) pw[2] += t_ - pw[1]; if (PROBE_KIND == 2) pw[2] += t_ - pw[0]; if (PROBE_KIND == 3) { pw[2] += t_ - pw[1]; pw[3] += c_ - pw[4]; } } \
        pw[1] = t_; pw[4] = c_; } } while (0)
#else
#define PROBE_PRE() do {} while (0)
#define PROBE_POST(id) do {} while (0)
#endif
#define XBAR(id) do { PROBE_PRE(); XcdBarrier _b; _b.bar = (unsigned*)(launder_ws(p.ws) + WS_BAR); _b.x = xb_xcc_id(); _b.st = xbw; xcd_barrier(_b); if ((DUPMASK >> 13) & 1) xcd_barrier(_b); PROBE_POST(id); } while (0)
#define REP(k) for (int _rep = 0; _rep < 1 + ((DUPMASK >> (k)) & 1); ++_rep)
extern __shared__ __attribute__((aligned(16))) unsigned char smem_raw[];

__global__ void __launch_bounds__(NTHR, 2) trunk_fwd(Params p) {
    unsigned char* smem = smem_raw;
    volatile LAS unsigned* xbw = (volatile LAS unsigned*)(smem_raw + LDS_BYTES - 16);
    if (threadIdx.x == 0) { xbw[0] = 0u; xbw[1] = 0u; xbw[2] = 0u; xbw[3] = 0u; }
    __syncthreads();
    (void)xcd_barrier_post((unsigned*)(p.ws + WS_BAR), xbw);
#if PROBE_KIND
    volatile LAS unsigned* pw = (volatile LAS unsigned*)(smem_raw + LDS_BYTES - 48);
    if (blockIdx.x == 0 && threadIdx.x == 0) { pw[1] = (unsigned)wall_clock64(); pw[4] = (unsigned)clock64(); pw[2] = 0u; pw[3] = 0u; }
#endif
    unsigned char* ws = p.ws;
    LAS unsigned char* lds = (LAS unsigned char*)smem_raw;
    const int G = gridDim.x, c = blockIdx.x;
    phase_W<0>(p, 0, smem);
    XBAR(0);
    phase_norm<1>(p, 0, smem);
    XBAR(1);
    for (int l = 0; l < DEPTH; ++l) {
        const bool last = (l == DEPTH - 1);
        REP(10) {   pg8::Gemm g; g.A = (const bf16_t*)(ws + WS_U); g.Bt = (const bf16_t*)(ws + WS_U); g.M = 0; g.N = 0; g.K = DM;
            InProjOrder S{G, c}; EpiInProj E{(bf16_t*)(ws + WS_P), (bf16_t*)(ws + WS_UT), PIN(I_DQN) + l * 32, PIN(I_DKN) + l * 32, (const float2*)(ws + WS_ROPE) + 64 * 16};
            pg8::gemm_phase(lds, g, S, E); }
        XBAR(2);
        phase_prep(p, l, smem);
        XBAR(3);
        REP(0) phase_hyena(p, l, smem);
        REP(1) phase_attnD(p, l, smem);
        REP(2) phase_attnA(p, l, smem);
        REP(3) phase_ml_local(p, l, smem);
        XBAR(4);
        phase_ml_scan(p);
        REP(9) phase_hy_transpose(p, l, smem);
        XBAR(5);
        REP(4) phase_ml_out(p, l, smem);
        XBAR(6);
        {   pg8::Gemm g; g.A = (const bf16_t*)(ws + WS_U); g.Bt = (const bf16_t*)(ws + WS_WOUT); g.M = 0; g.N = 0; g.K = DM;
            OutProjOrder S{G, c, last ? 256 : 272};
            EpiOut E{PIN(I_X), PIN(I_CTX), (bf16_t*)(ws + WS_XB), (const float*)(ws + WS_MOD + (size_t)(l & 1) * MOD_BYTES), l == 0 ? 1 : 0};
            pg8::gemm_phase(lds, g, S, E); }
        REP(5) if (l + 1 < DEPTH) phase_W<2>(p, l + 1, smem);
        XBAR(7);
        REP(6) phase_norm<2>(p, l, smem);
        XBAR(8);
        REP(7) phase_topk(p, l, smem);
        XBAR(9);
        REP(11) {   pg8::Gemm g; g.A = (const bf16_t*)(ws + WS_U); g.Bt = (const bf16_t*)(ws + WS_WGU); g.M = 0; g.N = 0; g.K = DM;
            GateUpOrder S{G, c, last ? 32 : 34}; EpiGU E{(bf16_t*)(ws + WS_HID)};
            pg8::gemm_phase_gather(lds, g, S, E, (const int*)(ws + WS_SROW)); }
        XBAR(10);
        REP(12) {   pg8::Gemm g; g.A = (const bf16_t*)(ws + WS_HID); g.Bt = (const bf16_t*)(ws + WS_WD); g.M = 0; g.N = 0; g.K = DM;
            DownOrder S{G, c, last ? 32 : 34}; EpiDown E{(bf16_t*)(ws + WS_XE), (const float*)(ws + WS_SGATE)};
            pg8::gemm_phase(lds, g, S, E); }
        if (l + 1 < DEPTH) phase_W<3>(p, l + 1, smem);
        XBAR(11);
        if (l + 1 < DEPTH) { REP(14) phase_combine<true>(p, l, smem); REP(5) phase_W<1>(p, l + 1, smem); XBAR(12); }
        else phase_combine<false>(p, l, smem);
    }
#if PROBE_KIND
    PROBE_POST(12);
    if (blockIdx.x == 0 && threadIdx.x == 0) {
        unsigned long long target = (unsigned long long)pw[2] * PROBE_MULT;
        if (PROBE_KIND == 3) target = pw[2] ? (unsigned long long)pw[3] * 10000ull / pw[2] : 0ull;
        const unsigned long long t0 = wall_clock64();
        while ((unsigned long long)wall_clock64() - t0 < target) __builtin_amdgcn_s_sleep(8);
    }
#endif
}

extern "C" void kernel_launch(void* const* d_in, const int* in_sizes, int n_in, void* d_out, int out_size, void* d_ws, size_t ws_size, hipStream_t stream) {
    static int grid = 0;
    if (grid == 0) {
        if (n_in != 34 || out_size != NROWL * DM || ws_size < WS_END) { fprintf(stderr, "kernel_launch: unexpected shapes (n_in %d out %d ws %zu need %zu)\n", n_in, out_size, ws_size, (size_t)WS_END); grid = -1; return; }
        int dev = 0, cus = 0;
        if (hipGetDevice(&dev) != hipSuccess || hipDeviceGetAttribute(&cus, hipDeviceAttributeMultiprocessorCount, dev) != hipSuccess) { grid = -1; return; }
        if (hipFuncSetAttribute((const void*)trunk_fwd, hipFuncAttributeMaxDynamicSharedMemorySize, LDS_BYTES) != hipSuccess) { fprintf(stderr, "kernel_launch: hipFuncSetAttribute failed\n"); grid = -1; return; }
        int per_cu = 0;
        if (hipOccupancyMaxActiveBlocksPerMultiprocessor(&per_cu, (const void*)trunk_fwd, NTHR, LDS_BYTES) != hipSuccess || per_cu < 1) { fprintf(stderr, "kernel_launch: occupancy query says %d\n", per_cu); }
        (void)hipGetLastError();
        grid = cus;
        if (grid > 256) grid = 256;
        grid &= ~7;
    }
    if (grid <= 0) return;
    (void)hipMemsetAsync((char*)d_ws + WS_BAR, 0, 16384, stream);
    Params p{};
    for (int i = 0; i < 34; ++i) p.in[i] = (const float*)d_in[i];
    p.out = (float*)d_out; p.ws = (unsigned char*)d_ws;
    hipLaunchKernelGGL(trunk_fwd, dim3(grid), dim3(NTHR), LDS_BYTES, stream, p);
}
```

```cpp
#include <hip/hip_runtime.h>
#include <stdint.h>
#include <stdio.h>

typedef unsigned short bf16_t;
typedef short bf16x8 __attribute__((ext_vector_type(8)));
typedef short s16x4 __attribute__((ext_vector_type(4)));
typedef float f32x4 __attribute__((ext_vector_type(4)));
typedef float f32x16 __attribute__((ext_vector_type(16)));
typedef unsigned u32x4 __attribute__((ext_vector_type(4)));
typedef unsigned u32x2 __attribute__((ext_vector_type(2)));
#define LAS __attribute__((address_space(3)))

#define NB 16
#define TL 4096
#define TCX 256
#define DM 1024
#define NROWL 65536
#define NROWC 4096
#define NROW 69632
#define PW 2304
#define INW 3088
#define NEXP 16
#define CAPL 512
#define CAPC 32
#define SLOTS_E 8704
#define NSLOT 139264
#define DEPTH 4
#define NTHR 512
#define LDS_BYTES 155648
#define EPSF 1e-6f
#define LOG2E 1.4426950408889634f

constexpr size_t al256(size_t x) { return (x + 255) & ~size_t(255); }
constexpr size_t WS_BAR   = 0;
constexpr size_t WS_MOD   = al256(WS_BAR + 16384);
constexpr size_t MOD_BYTES = al256((size_t)17 * 6144 * 4);
constexpr size_t WS_HID2L = al256(WS_MOD + 2 * MOD_BYTES);
constexpr size_t WS_HID2C = al256(WS_HID2L + (size_t)4096 * 64 * 4);
constexpr size_t WS_GATES = al256(WS_HID2C + (size_t)256 * 64 * 4);
constexpr size_t WS_AFF   = al256(WS_GATES + (size_t)NROW * 16 * 4);
constexpr size_t WS_SROW  = al256(WS_AFF + (size_t)NROW * 16 * 4);
constexpr size_t WS_SGATE = al256(WS_SROW + (size_t)NSLOT * 4);
constexpr size_t WS_INV   = al256(WS_SGATE + (size_t)NSLOT * 4);
constexpr size_t WS_MLS   = al256(WS_INV + (size_t)NROW * 16 * 4);
constexpr size_t WS_FBUF  = al256(WS_MLS + (size_t)128 * 68 * 4 * 4);
constexpr size_t WS_ROPE  = al256(WS_FBUF + (size_t)256 * 8256 * 2);
constexpr size_t WS_CTX   = al256(WS_ROPE + (size_t)64 * 24 * 8);
constexpr size_t WS_U     = al256(WS_CTX + (size_t)NROWC * DM * 4);
constexpr size_t WS_WOUT  = al256(WS_U + (size_t)(NROW + 3072) * DM * 2);
constexpr size_t WS_WGU   = al256(WS_WOUT + (size_t)DM * DM * 2);
constexpr size_t WS_WD    = al256(WS_WGU + (size_t)NEXP * 2048 * DM * 2);
constexpr size_t WS_P     = al256(WS_WD + (size_t)NEXP * DM * DM * 2);
constexpr size_t WS_UT    = al256(WS_P + (size_t)NROW * PW * 2);
constexpr size_t WS_XE    = al256(WS_UT + (size_t)768 * NROW * 2);
constexpr size_t WS_XB    = al256(WS_XE + (size_t)NSLOT * DM * 2);
constexpr size_t WS_END   = al256(WS_XB + (size_t)NROW * DM * 2);
constexpr size_t WS_HID   = WS_P;
constexpr size_t WS_MLA   = WS_XE;
constexpr size_t WS_MLN   = al256(WS_MLA + (size_t)128 * 68 * 4096 * 2);
constexpr size_t WS_YT    = al256(WS_MLN + (size_t)128 * 68 * 64 * 4);
static_assert(WS_YT + (size_t)256 * NROW * 2 <= WS_XB, "alias overflow");
static_assert((size_t)NSLOT * DM * 2 <= (size_t)NROW * PW * 2, "hid alias overflow");

struct Params {
    const float* in[34];
    float* out;
    unsigned char* ws;
};
enum { I_X = 0, I_C, I_CTX, I_CCTX, I_WADA, I_BADA, I_N1G, I_N2G, I_WIN, I_BGATE, I_AQN, I_AKN, I_ASINK, I_HYCONV, I_FW1, I_FB1, I_FREQ, I_FW2, I_FB2, I_FW3,
       I_HYBIAS, I_MLNORM, I_DQN, I_DKN, I_LQ1, I_LK1, I_LQ2, I_LK2, I_DSUB, I_WOUT, I_WROUTER, I_WEG, I_WEU, I_WED };

__device__ __forceinline__ int my_tid() { int t = threadIdx.x; asm volatile("" : "+v"(t)); return t; }
#define GAS __attribute__((address_space(1)))
__device__ __forceinline__ unsigned char* launder_ws(unsigned char* q) { GAS unsigned char* g = (GAS unsigned char*)q; asm volatile("" : "+s"(g)); return (unsigned char*)g; }
#define CAS __attribute__((address_space(4)))
__device__ __forceinline__ const float* pin_ptr(int i) { const CAS char* ka = (const CAS char*)__builtin_amdgcn_kernarg_segment_ptr(); asm volatile("" : "+s"(ka));
    const GAS float* g = *(const GAS float* const CAS*)(ka + 8 * i); return (const float*)g; }
#define PIN(i) pin_ptr(i)
#define POUT() ((float*)pin_ptr(34))
__device__ __forceinline__ float bf2f(bf16_t v) { return __uint_as_float((unsigned)v << 16); }
__device__ __forceinline__ bf16_t f2bf(float f) { unsigned u = __float_as_uint(f); u += 0x7fffu + ((u >> 16) & 1u); return (bf16_t)(u >> 16); }
__device__ __forceinline__ unsigned pack_bf16(float lo, float hi) { return (unsigned)f2bf(lo) | ((unsigned)f2bf(hi) << 16); }
__device__ __forceinline__ float bflo(unsigned w) { return __uint_as_float(w << 16); }
__device__ __forceinline__ float bfhi(unsigned w) { return __uint_as_float(w & 0xffff0000u); }
template <int CTRL> __device__ __forceinline__ float dpp_get(float v) { return __int_as_float(__builtin_amdgcn_update_dpp(0, __float_as_int(v), CTRL, 0xf, 0xf, true)); }
#define DPP_XOR1 0xB1
#define DPP_XOR2 0x4E
#define DPP_HMIRROR 0x141
#define DPP_MIRROR 0x140
#define DPP_ROR8 0x128
__device__ __forceinline__ float wave_sum(float v) {
    v += dpp_get<DPP_XOR1>(v); v += dpp_get<DPP_XOR2>(v); v += dpp_get<DPP_HMIRROR>(v); v += dpp_get<DPP_MIRROR>(v);
    const int iv = __float_as_int(v);
    return (__int_as_float(__builtin_amdgcn_readlane(iv, 0)) + __int_as_float(__builtin_amdgcn_readlane(iv, 16))) + (__int_as_float(__builtin_amdgcn_readlane(iv, 32)) + __int_as_float(__builtin_amdgcn_readlane(iv, 48)));
}
__device__ __forceinline__ float wave_max(float v) {
    v = fmaxf(v, dpp_get<DPP_XOR1>(v)); v = fmaxf(v, dpp_get<DPP_XOR2>(v)); v = fmaxf(v, dpp_get<DPP_HMIRROR>(v)); v = fmaxf(v, dpp_get<DPP_MIRROR>(v));
    const int iv = __float_as_int(v);
    return fmaxf(fmaxf(__int_as_float(__builtin_amdgcn_readlane(iv, 0)), __int_as_float(__builtin_amdgcn_readlane(iv, 16))), fmaxf(__int_as_float(__builtin_amdgcn_readlane(iv, 32)), __int_as_float(__builtin_amdgcn_readlane(iv, 48))));
}
__device__ __forceinline__ float lane_xor16(float v, int lane) { const auto r = __builtin_amdgcn_permlane16_swap(__float_as_uint(v), __float_as_uint(v), false, false); return __uint_as_float((lane & 16) ? r[0] : r[1]); }
__device__ __forceinline__ float lane_xor32(float v, int lane) { const auto r = __builtin_amdgcn_permlane32_swap(__float_as_uint(v), __float_as_uint(v), false, false); return __uint_as_float((lane & 32) ? r[0] : r[1]); }
__device__ __forceinline__ float reduce16_transpose(const float (&part)[16], int lane) {
    float v8[8], v4[4], v2[2], v1;
#pragma unroll
    for (int j = 0; j < 8; ++j) { const auto r = __builtin_amdgcn_permlane32_swap(__float_as_uint(part[j]), __float_as_uint(part[8 + j]), false, false); v8[j] = __uint_as_float(r[0]) + __uint_as_float(r[1]); }
#pragma unroll
    for (int j = 0; j < 4; ++j) { const auto r = __builtin_amdgcn_permlane16_swap(__float_as_uint(v8[j]), __float_as_uint(v8[4 + j]), false, false); v4[j] = __uint_as_float(r[0]) + __uint_as_float(r[1]); }
    { const bool up = (lane & 8) != 0;
#pragma unroll
      for (int j = 0; j < 2; ++j) { const float send = up ? v4[j] : v4[2 + j], keep = up ? v4[2 + j] : v4[j]; v2[j] = keep + dpp_get<DPP_ROR8>(send); } }
    { const bool up = (lane & 4) != 0; const float send = up ? v2[0] : v2[1], keep = up ? v2[1] : v2[0]; v1 = keep + dpp_get<DPP_HMIRROR>(send); }
    v1 += dpp_get<DPP_XOR2>(v1); v1 += dpp_get<DPP_XOR1>(v1);
    return v1;
}
__device__ __forceinline__ float fast_exp2(float x) { return __builtin_amdgcn_exp2f(x); }
__device__ __forceinline__ float log_sigmoid(float x) { return fminf(x, 0.f) - log1pf(expf(-fabsf(x))); }

#define XB_TMO      128
#define XB_XCNT(j)  (256  + 64 * (j))
#define XB_XSUB(j)  (1280 + 64 * (j))
#define XB_XGEN(j)  (2304 + 64 * (j))
#define XB_TOP      3328
#define XB_TOPGEN   3392
#define XCD_BAR_WORDS 3456
#define XB_SPIN_CAP (1u << 22)

__device__ __forceinline__ unsigned xb_ld(unsigned* p)              { return __hip_atomic_load(p, __ATOMIC_RELAXED, __HIP_MEMORY_SCOPE_AGENT); }
__device__ __forceinline__ unsigned xb_add(unsigned* p, unsigned v) { return __hip_atomic_fetch_add(p, v, __ATOMIC_RELAXED, __HIP_MEMORY_SCOPE_AGENT); }
__device__ __forceinline__ unsigned xb_xcc_id() { return (unsigned)__builtin_amdgcn_s_getreg((3 << 11) | 20) & 0xFu; }
#define XB_SPIN(cond, bar) do { unsigned _sp = 0; while (cond) { __builtin_amdgcn_s_sleep(1); \
    if ((++_sp & 255u) == 0u) { if (xb_ld(&(bar)[XB_TMO])) break; if (_sp > XB_SPIN_CAP) { atomicAdd(&(bar)[XB_TMO], 1u); break; } } } } while (0)

struct XcdBarrier { unsigned* bar; unsigned x; volatile LAS unsigned* st; };

__device__ __forceinline__ XcdBarrier xcd_barrier_post(unsigned* bar, volatile LAS unsigned* st) {
    XcdBarrier b; b.bar = bar; b.x = xb_xcc_id(); b.st = st;
    if (threadIdx.x == 0) (void)xb_add(&bar[XB_XCNT(b.x)], 1u);
    return b;
}
__device__ __forceinline__ void xcd_barrier_complete(unsigned* bar, unsigned x, unsigned& nloc, unsigned& nx) {
    const unsigned G = gridDim.x * gridDim.y * gridDim.z;
    unsigned sum, cnt, mine, sp = 0u;
    for (;;) {
        sum = 0u; cnt = 0u; mine = 0u;
#pragma unroll
        for (unsigned j = 0; j < 16; ++j) { const unsigned c = xb_ld(&bar[XB_XCNT(j)]); sum += c; cnt += (c > 0u) ? 1u : 0u; mine = (j == x) ? c : mine; }
        if (sum == G) break;
        __builtin_amdgcn_s_sleep(1);
        if ((++sp & 255u) == 0u) { if (xb_ld(&bar[XB_TMO])) break; if (sp > XB_SPIN_CAP) { atomicAdd(&bar[XB_TMO], 1u); break; } }
    }
    nloc = mine > 0u ? mine : 1u; nx = cnt > 0u ? cnt : 1u;
}
__device__ __forceinline__ void xcd_barrier(const XcdBarrier& b) {
    asm volatile("s_waitcnt vmcnt(0)" ::: "memory");
    __syncthreads();
    if (threadIdx.x == 0) {
        unsigned* bar = b.bar;
        __builtin_amdgcn_s_waitcnt(0);
        unsigned nloc = b.st[0], nx = b.st[1];
        if (nloc == 0u) { xcd_barrier_complete(bar, b.x, nloc, nx); b.st[0] = nloc; b.st[1] = nx; }
        const unsigned old = xb_add(&bar[XB_XSUB(b.x)], 1u);
        const unsigned gen = old / nloc;
        if (old + 1u == (gen + 1u) * nloc) {
            __builtin_amdgcn_fence(__ATOMIC_RELEASE, "agent");
            asm volatile("s_waitcnt vmcnt(0)" ::: "memory");
            const unsigned og = xb_add(&bar[XB_TOP], 1u);
            const unsigned tg = og / nx;
            if (og + 1u == (tg + 1u) * nx) xb_add(&bar[XB_TOPGEN], 1u);
            else XB_SPIN(xb_ld(&bar[XB_TOPGEN]) == tg, bar);
            __builtin_amdgcn_fence(__ATOMIC_ACQUIRE, "agent");
            xb_add(&bar[XB_XGEN(b.x)], 1u);
            asm volatile("s_waitcnt vmcnt(0)" ::: "memory");
        } else {
            XB_SPIN(xb_ld(&bar[XB_XGEN(b.x)]) == gen, bar);
            __builtin_amdgcn_fence(__ATOMIC_ACQUIRE, "agent");
            asm volatile("s_waitcnt vmcnt(0)" ::: "memory");
        }
    }
    __syncthreads();
}

namespace pg8 {
constexpr int BM = 256, BK = 64, HALF = 128, HTB = HALF * BK * 2, STAGE_BYTES = 8 * HTB, NXCD = 8, WGM = 8;
__host__ __device__ __forceinline__ int lds_byte(int r, int c) { const int st = (r >> 4) * 2 + (c >> 5), rr = r & 15, cc = c & 31, ob = rr * 64 + cc * 2; return st * 1024 + (ob ^ (((ob >> 9) & 1) << 5)); }
__host__ __device__ __forceinline__ void stage_rc(int b, int& R, int& C) { const int st = b / 1024, sb = b % 1024, swz = sb ^ (((sb >> 9) & 1) << 5); R = (st >> 1) * 16 + swz / 64; C = (st & 1) * 32 + (swz % 64) / 2; }
__host__ __device__ __forceinline__ int perm32(int rho) { const int n = rho >> 4, i = rho & 15; return 8 * (i >> 2) + 4 * n + (i & 3); }
struct Unit { int pm, pn; };
struct Gemm { const bf16_t* A; const bf16_t* Bt; int M, N, K; };
__device__ __forceinline__ unsigned cvt_pk_bf16(float lo, float hi) { unsigned r; asm volatile("v_cvt_pk_bf16_f32 %0, %1, %2" : "=v"(r) : "v"(lo), "v"(hi)); return r; }

__device__ __forceinline__ void static_unit(int L, int nM, int nN, int& pm, int& pn) {
    const int nwg = nM * nN; int wgid = L;
    { const int q = nwg / NXCD, r = nwg % NXCD, xcd = wgid % NXCD, off = wgid / NXCD; wgid = (xcd < r ? xcd * (q + 1) : r * (q + 1) + (xcd - r) * q) + off; }
    const int nig = WGM * nN, gid = wgid / nig, fm = gid * WGM, gsz = (nM - fm) < WGM ? (nM - fm) : WGM;
    pm = fm + ((wgid % nig) % gsz); pn = (wgid % nig) / gsz;
}

template <class Epi, class Sched>
__device__ __forceinline__ void gemm_phase(LAS unsigned char* lds, const Gemm g, const Sched& S, const Epi& E) {
    const int tid = my_tid(), wid = __builtin_amdgcn_readfirstlane(tid >> 6), lane = tid & 63, wr = wid >> 2, wc = wid & 3, fr = lane & 15, fq = lane >> 4;
    const int K = g.K, nt = K / BK;
    unsigned voffA[2], voffB[2];
#pragma unroll
    for (int i = 0; i < 2; ++i) { int R, C; stage_rc(tid * 16 + i * 8192, R, C); const int Rb = Epi::PERM ? ((R & ~31) + perm32(R & 31)) : R;
        voffA[i] = (unsigned)(R * K + C) * 2u; voffB[i] = (unsigned)(Rb * K + C) * 2u; }
    const size_t kstep = (size_t)(BK * 2);
    const size_t hstep = (size_t)HALF * K * 2;
    const size_t tstep = 2 * hstep;
    const unsigned ldsw = (unsigned)wid * 1024u;
    const int aoff = lds_byte(wr * 64 + fr, fq * 8), boff = lds_byte(wc * 32 + fr, fq * 8);
#define PG8_SA(b, h) (((b) * 2 + (h)) * HTB)
#define PG8_SB(b, h) ((4 + (b) * 2 + (h)) * HTB)
#define PG8_STAGE(bufoff, gbase, voff) do { _Pragma("unroll") for (int _i = 0; _i < 2; ++_i) \
        __builtin_amdgcn_global_load_lds((const unsigned*)((const char*)(gbase) + (voff)[_i]), (LAS unsigned*)(lds + (bufoff) + ldsw + _i * 8192), 16, 0, 0); } while (0)
#define PG8_LDA(dst, b, h) do { _Pragma("unroll") for (int m = 0; m < 4; ++m) _Pragma("unroll") for (int k = 0; k < 2; ++k) dst[m][k] = *(const LAS bf16x8*)(lds + PG8_SA(b, h) + aoff + m * 2048 + k * 1024); } while (0)
#define PG8_LDB(dst, b, h) do { _Pragma("unroll") for (int n = 0; n < 2; ++n) _Pragma("unroll") for (int k = 0; k < 2; ++k) dst[n][k] = *(const LAS bf16x8*)(lds + PG8_SB(b, h) + boff + n * 2048 + k * 1024); } while (0)
#define PG8_MMA(ai, bj, At, Bt) do { __builtin_amdgcn_s_setprio(1); _Pragma("unroll") for (int m = 0; m < 4; ++m) _Pragma("unroll") for (int n = 0; n < 2; ++n) _Pragma("unroll") for (int k = 0; k < 2; ++k) \
        acc[ai][bj][m][n] = __builtin_amdgcn_mfma_f32_16x16x32_bf16(Bt[n][k], At[m][k], acc[ai][bj][m][n], 0, 0, 0); __builtin_amdgcn_s_setprio(0); } while (0)
#define PG8_WAIT_V(n) asm volatile("s_waitcnt vmcnt(" #n ")" ::: "memory")
#define PG8_WAIT_L(n) asm volatile("s_waitcnt lgkmcnt(" #n ")" ::: "memory")
#define PG8_BAR __builtin_amdgcn_s_barrier()
#define PG8_SCHED __builtin_amdgcn_sched_barrier(0)
    Unit cur, nxt; int ui = 0;
    if (!S.next(0, cur)) return;
    f32x4 acc[2][2][4][2];
#pragma unroll
    for (int a = 0; a < 2; ++a)
#pragma unroll
        for (int b = 0; b < 2; ++b)
#pragma unroll
            for (int m = 0; m < 4; ++m)
#pragma unroll
                for (int n = 0; n < 2; ++n) acc[a][b][m][n] = (f32x4){0.f, 0.f, 0.f, 0.f};
    bf16x8 At[4][2], B0[2][2], B1[2][2];
    const char* cA = (const char*)g.A + (size_t)cur.pm * tstep; const char* cB = (const char*)g.Bt + (size_t)cur.pn * tstep;
    PG8_STAGE(PG8_SB(0, 0), cB, voffB); PG8_STAGE(PG8_SA(0, 0), cA, voffA); PG8_STAGE(PG8_SB(0, 1), cB + hstep, voffB); PG8_STAGE(PG8_SA(0, 1), cA + hstep, voffA);
    if (wr == 1) PG8_BAR;
    PG8_WAIT_V(4); PG8_BAR;
    PG8_STAGE(PG8_SB(1, 0), cB + kstep, voffB); PG8_STAGE(PG8_SA(1, 0), cA + kstep, voffA); PG8_STAGE(PG8_SB(1, 1), cB + hstep + kstep, voffB);
    PG8_WAIT_V(6); PG8_BAR;
    for (;;) {
        const bool has_next = S.next(ui + 1, nxt);
        const char* nA = has_next ? (const char*)g.A + (size_t)nxt.pm * tstep : cA; const char* nB = has_next ? (const char*)g.Bt + (size_t)nxt.pn * tstep : cB;
        for (int t = 0; t < nt; t += 2) {
            const bool last = (t == nt - 2);
            const char* a1 = cA + (size_t)(t + 1) * kstep;
            const char* a2 = last ? nA : cA + (size_t)(t + 2) * kstep; const char* b2 = last ? nB : cB + (size_t)(t + 2) * kstep;
            const char* a3 = a2 + kstep; const char* b3 = b2 + kstep;
            PG8_LDB(B0, 0, 0); PG8_SCHED; PG8_LDA(At, 0, 0); PG8_STAGE(PG8_SA(1, 1), a1 + hstep, voffA);
            PG8_WAIT_L(8); PG8_BAR; PG8_WAIT_L(0); PG8_MMA(0, 0, At, B0); PG8_BAR; PG8_SCHED;
            PG8_LDB(B1, 0, 1); PG8_STAGE(PG8_SB(0, 0), b2, voffB);
            PG8_BAR; PG8_WAIT_L(0); PG8_MMA(0, 1, At, B1); PG8_BAR;
            PG8_LDA(At, 0, 1); PG8_STAGE(PG8_SA(0, 0), a2, voffA);
            PG8_BAR; PG8_WAIT_L(0); PG8_MMA(1, 0, At, B0); PG8_BAR; PG8_SCHED;
            PG8_STAGE(PG8_SB(0, 1), b2 + hstep, voffB);
            PG8_WAIT_V(6); PG8_BAR; PG8_MMA(1, 1, At, B1); PG8_BAR;
            PG8_LDB(B0, 1, 0); PG8_SCHED; PG8_LDA(At, 1, 0); PG8_STAGE(PG8_SA(0, 1), a2 + hstep, voffA);
            PG8_WAIT_L(8); PG8_BAR; PG8_WAIT_L(0); PG8_MMA(0, 0, At, B0); PG8_BAR; PG8_SCHED;
            PG8_LDB(B1, 1, 1); PG8_STAGE(PG8_SB(1, 0), b3, voffB);
            PG8_BAR; PG8_WAIT_L(0); PG8_MMA(0, 1, At, B1); PG8_BAR;
            PG8_LDA(At, 1, 1); PG8_STAGE(PG8_SA(1, 0), a3, voffA);
            PG8_BAR; PG8_WAIT_L(0); PG8_MMA(1, 0, At, B0); PG8_BAR; PG8_SCHED;
            PG8_STAGE(PG8_SB(1, 1), b3 + hstep, voffB);
            PG8_WAIT_V(6); PG8_BAR; PG8_MMA(1, 1, At, B1); PG8_BAR;
        }
#if defined(PROBE_KIND) && PROBE_KIND == 4
        { unsigned t0_ = 0; if (blockIdx.x == 0 && threadIdx.x == 0) t0_ = (unsigned)wall_clock64();
          E(acc, cur, wr, wc, fr, fq);
          if (blockIdx.x == 0 && threadIdx.x == 0) { asm volatile("s_waitcnt vmcnt(0)" ::: "memory"); volatile LAS unsigned* pw_ = (volatile LAS unsigned*)(lds + LDS_BYTES - 48); pw_[2] += (unsigned)wall_clock64() - t0_; } }
#else
        E(acc, cur, wr, wc, fr, fq);
#endif
        if (!has_next) break;
#pragma unroll
        for (int a = 0; a < 2; ++a)
#pragma unroll
            for (int b = 0; b < 2; ++b)
#pragma unroll
                for (int m = 0; m < 4; ++m)
#pragma unroll
                    for (int n = 0; n < 2; ++n) acc[a][b][m][n] = (f32x4){0.f, 0.f, 0.f, 0.f};
        cur = nxt; cA = nA; cB = nB; ++ui;
    }
    PG8_WAIT_V(0);
    if (wr == 0) PG8_BAR;
    PG8_BAR;
#undef PG8_SA
#undef PG8_SB
#undef PG8_STAGE
#undef PG8_LDA
#undef PG8_LDB
#undef PG8_MMA
#undef PG8_WAIT_V
#undef PG8_WAIT_L
#undef PG8_BAR
#undef PG8_SCHED
}
template <class Epi, class Sched>
__device__ __forceinline__ void gemm_phase_gather(LAS unsigned char* lds, const Gemm g, const Sched& S, const Epi& E, const int* __restrict__ srow) {
    const int tid = my_tid(), wid = __builtin_amdgcn_readfirstlane(tid >> 6), lane = tid & 63, wr = wid >> 2, wc = wid & 3, fr = lane & 15, fq = lane >> 4;
    const int K = g.K, nt = K / BK;
    unsigned voffB[2];
#pragma unroll
    for (int i = 0; i < 2; ++i) { int R, C; stage_rc(tid * 16 + i * 8192, R, C); const int Rb = Epi::PERM ? ((R & ~31) + perm32(R & 31)) : R;
        voffB[i] = (unsigned)(Rb * K + C) * 2u; }
    unsigned gcur[2][2], gnxt[2][2];
#define PG8_LOADG(dst, u) do { const int _t = my_tid(); _Pragma("unroll") for (int _i = 0; _i < 2; ++_i) { int _R, _C; stage_rc(_t * 16 + _i * 8192, _R, _C); _Pragma("unroll") for (int _h = 0; _h < 2; ++_h) \
        dst[_h][_i] = (unsigned)srow[(u).pm * 256 + 128 * _h + _R] * (unsigned)(K * 2) + (unsigned)_C * 2u; } } while (0)
#define PG8_STAGEG(bufoff, gofs, kbyte) do { _Pragma("unroll") for (int _i = 0; _i < 2; ++_i) \
        __builtin_amdgcn_global_load_lds((const unsigned*)((const char*)g.A + (gofs)[_i] + (kbyte)), (LAS unsigned*)(lds + (bufoff) + ldsw + _i * 8192), 16, 0, 0); } while (0)
    const size_t kstep = (size_t)(BK * 2);
    const size_t hstep = (size_t)HALF * K * 2;
    const size_t tstep = 2 * hstep;
    const unsigned ldsw = (unsigned)wid * 1024u;
    const int aoff = lds_byte(wr * 64 + fr, fq * 8), boff = lds_byte(wc * 32 + fr, fq * 8);
#define PG8_SA(b, h) (((b) * 2 + (h)) * HTB)
#define PG8_SB(b, h) ((4 + (b) * 2 + (h)) * HTB)
#define PG8_STAGE(bufoff, gbase, voff) do { _Pragma("unroll") for (int _i = 0; _i < 2; ++_i) \
        __builtin_amdgcn_global_load_lds((const unsigned*)((const char*)(gbase) + (voff)[_i]), (LAS unsigned*)(lds + (bufoff) + ldsw + _i * 8192), 16, 0, 0); } while (0)
#define PG8_LDA(dst, b, h) do { _Pragma("unroll") for (int m = 0; m < 4; ++m) _Pragma("unroll") for (int k = 0; k < 2; ++k) dst[m][k] = *(const LAS bf16x8*)(lds + PG8_SA(b, h) + aoff + m * 2048 + k * 1024); } while (0)
#define PG8_LDB(dst, b, h) do { _Pragma("unroll") for (int n = 0; n < 2; ++n) _Pragma("unroll") for (int k = 0; k < 2; ++k) dst[n][k] = *(const LAS bf16x8*)(lds + PG8_SB(b, h) + boff + n * 2048 + k * 1024); } while (0)
#define PG8_MMA(ai, bj, At, Bt) do { __builtin_amdgcn_s_setprio(1); _Pragma("unroll") for (int m = 0; m < 4; ++m) _Pragma("unroll") for (int n = 0; n < 2; ++n) _Pragma("unroll") for (int k = 0; k < 2; ++k) \
        acc[ai][bj][m][n] = __builtin_amdgcn_mfma_f32_16x16x32_bf16(Bt[n][k], At[m][k], acc[ai][bj][m][n], 0, 0, 0); __builtin_amdgcn_s_setprio(0); } while (0)
#define PG8_WAIT_V(n) asm volatile("s_waitcnt vmcnt(" #n ")" ::: "memory")
#define PG8_WAIT_L(n) asm volatile("s_waitcnt lgkmcnt(" #n ")" ::: "memory")
#define PG8_BAR __builtin_amdgcn_s_barrier()
#define PG8_SCHED __builtin_amdgcn_sched_barrier(0)
    Unit cur, nxt; int ui = 0;
    if (!S.next(0, cur)) return;
    f32x4 acc[2][2][4][2];
#pragma unroll
    for (int a = 0; a < 2; ++a)
#pragma unroll
        for (int b = 0; b < 2; ++b)
#pragma unroll
            for (int m = 0; m < 4; ++m)
#pragma unroll
                for (int n = 0; n < 2; ++n) acc[a][b][m][n] = (f32x4){0.f, 0.f, 0.f, 0.f};
    bf16x8 At[4][2], B0[2][2], B1[2][2];
    const char* cB = (const char*)g.Bt + (size_t)cur.pn * tstep;
    PG8_LOADG(gcur, cur);
    PG8_STAGE(PG8_SB(0, 0), cB, voffB); PG8_STAGEG(PG8_SA(0, 0), gcur[0], 0); PG8_STAGE(PG8_SB(0, 1), cB + hstep, voffB); PG8_STAGEG(PG8_SA(0, 1), gcur[1], 0);
    if (wr == 1) PG8_BAR;
    PG8_WAIT_V(4); PG8_BAR;
    PG8_STAGE(PG8_SB(1, 0), cB + kstep, voffB); PG8_STAGEG(PG8_SA(1, 0), gcur[0], kstep); PG8_STAGE(PG8_SB(1, 1), cB + hstep + kstep, voffB);
    PG8_WAIT_V(6); PG8_BAR;
    for (;;) {
        const bool has_next = S.next(ui + 1, nxt);
        const char* nB = has_next ? (const char*)g.Bt + (size_t)nxt.pn * tstep : cB;
        if (has_next) PG8_LOADG(gnxt, nxt); else { gnxt[0][0] = gcur[0][0]; gnxt[0][1] = gcur[0][1]; gnxt[1][0] = gcur[1][0]; gnxt[1][1] = gcur[1][1]; }
        for (int t = 0; t < nt; t += 2) {
            const bool last = (t == nt - 2);
            const size_t k1 = (size_t)(t + 1) * kstep, k2 = last ? 0 : (size_t)(t + 2) * kstep, k3 = k2 + kstep;
            const char* b2 = last ? nB : cB + (size_t)(t + 2) * kstep; const char* b3 = b2 + kstep;
            unsigned g0[2], g1[2];
            g0[0] = last ? gnxt[0][0] : gcur[0][0]; g0[1] = last ? gnxt[0][1] : gcur[0][1]; g1[0] = last ? gnxt[1][0] : gcur[1][0]; g1[1] = last ? gnxt[1][1] : gcur[1][1];
            PG8_LDB(B0, 0, 0); PG8_SCHED; PG8_LDA(At, 0, 0); PG8_STAGEG(PG8_SA(1, 1), gcur[1], k1);
            PG8_WAIT_L(8); PG8_BAR; PG8_WAIT_L(0); PG8_MMA(0, 0, At, B0); PG8_BAR; PG8_SCHED;
            PG8_LDB(B1, 0, 1); PG8_STAGE(PG8_SB(0, 0), b2, voffB);
            PG8_BAR; PG8_WAIT_L(0); PG8_MMA(0, 1, At, B1); PG8_BAR;
            PG8_LDA(At, 0, 1); PG8_STAGEG(PG8_SA(0, 0), g0, k2);
            PG8_BAR; PG8_WAIT_L(0); PG8_MMA(1, 0, At, B0); PG8_BAR; PG8_SCHED;
            PG8_STAGE(PG8_SB(0, 1), b2 + hstep, voffB);
            PG8_WAIT_V(6); PG8_BAR; PG8_MMA(1, 1, At, B1); PG8_BAR;
            PG8_LDB(B0, 1, 0); PG8_SCHED; PG8_LDA(At, 1, 0); PG8_STAGEG(PG8_SA(0, 1), g1, k2);
            PG8_WAIT_L(8); PG8_BAR; PG8_WAIT_L(0); PG8_MMA(0, 0, At, B0); PG8_BAR; PG8_SCHED;
            PG8_LDB(B1, 1, 1); PG8_STAGE(PG8_SB(1, 0), b3, voffB);
            PG8_BAR; PG8_WAIT_L(0); PG8_MMA(0, 1, At, B1); PG8_BAR;
            PG8_LDA(At, 1, 1); PG8_STAGEG(PG8_SA(1, 0), g0, k3);
            PG8_BAR; PG8_WAIT_L(0); PG8_MMA(1, 0, At, B0); PG8_BAR; PG8_SCHED;
            PG8_STAGE(PG8_SB(1, 1), b3 + hstep, voffB);
            PG8_WAIT_V(6); PG8_BAR; PG8_MMA(1, 1, At, B1); PG8_BAR;
        }
#if defined(PROBE_KIND) && PROBE_KIND == 4
        { unsigned t0_ = 0; if (blockIdx.x == 0 && threadIdx.x == 0) t0_ = (unsigned)wall_clock64();
          E(acc, cur, wr, wc, fr, fq);
          if (blockIdx.x == 0 && threadIdx.x == 0) { asm volatile("s_waitcnt vmcnt(0)" ::: "memory"); volatile LAS unsigned* pw_ = (volatile LAS unsigned*)(lds + LDS_BYTES - 48); pw_[2] += (unsigned)wall_clock64() - t0_; } }
#else
        E(acc, cur, wr, wc, fr, fq);
#endif
        if (!has_next) break;
#pragma unroll
        for (int a = 0; a < 2; ++a)
#pragma unroll
            for (int b = 0; b < 2; ++b)
#pragma unroll
                for (int m = 0; m < 4; ++m)
#pragma unroll
                    for (int n = 0; n < 2; ++n) acc[a][b][m][n] = (f32x4){0.f, 0.f, 0.f, 0.f};
        cur = nxt; cB = nB; ++ui;
        gcur[0][0] = gnxt[0][0]; gcur[0][1] = gnxt[0][1]; gcur[1][0] = gnxt[1][0]; gcur[1][1] = gnxt[1][1];
    }
    PG8_WAIT_V(0);
    if (wr == 0) PG8_BAR;
    PG8_BAR;
#undef PG8_LOADG
#undef PG8_STAGEG
#undef PG8_SA
#undef PG8_SB
#undef PG8_STAGE
#undef PG8_LDA
#undef PG8_LDB
#undef PG8_MMA
#undef PG8_WAIT_V
#undef PG8_WAIT_L
#undef PG8_BAR
#undef PG8_SCHED
}
}
using pg8::Unit;
struct InProjOrder { int G, c;
    __device__ __forceinline__ bool next(int i, Unit& u) const {
        const int L = i * G + c; if (L >= 3264) return false;
        int pm, pn;
        if (L < 2448) { pg8::static_unit(L, 272, 9, pm, pn); u.pm = pm; u.pn = 272 + pn; }
        else { pg8::static_unit(L - 2448, 3, 272, pm, pn); u.pm = 281 + pm; u.pn = pn; }
        return true; } };
struct OutProjOrder { int G, c, nM;
    __device__ __forceinline__ bool next(int i, Unit& u) const {
        const int L = i * G + c; if (L >= nM * 4) return false;
        pg8::static_unit(L, nM, 4, u.pm, u.pn); return true; } };
struct GateUpOrder { int G, c, nM;
    __device__ __forceinline__ bool next(int i, Unit& u) const {
        const int per = nM * 8; const int L = i * G + c; if (L >= 16 * per) return false;
        const int e = L / per; int pm, pn; pg8::static_unit(L - e * per, nM, 8, pm, pn); u.pm = e * 34 + pm; u.pn = e * 8 + pn; return true; } };
struct DownOrder { int G, c, nM;
    __device__ __forceinline__ bool next(int i, Unit& u) const {
        const int per = nM * 4; const int L = i * G + c; if (L >= 16 * per) return false;
        const int e = L / per; int pm, pn; pg8::static_unit(L - e * per, nM, 4, pm, pn); u.pm = e * 34 + pm; u.pn = e * 4 + pn; return true; } };

struct EpiInProj { static constexpr bool PERM = true; bf16_t* P; bf16_t* UT; const float* dqn; const float* dkn; const float2* ropeD;
    __device__ __forceinline__ void operator()(const f32x4 (&acc)[2][2][4][2], const Unit& u, int wr, int wc, int fr, int fq) const {
        bf16_t* base; int ldc, rt, ct;
        if (u.pn >= 272) { base = P; ldc = PW; rt = u.pm; ct = u.pn - 272; } else { base = UT; ldc = NROW; rt = u.pm - 281; ct = u.pn; }
        const int row0 = rt * 256 + wr * 64 + fr, col0 = ct * 256 + wc * 32 + 8 * fq;
        if (u.pn >= 272 && (ct == 6 || ct == 7)) {
            const float* gnp = (ct == 6 ? dqn : dkn) + 8 * fq;
            const float4 ga = *(const float4*)gnp, gb = *(const float4*)(gnp + 4);
            const float gn[8] = {ga.x, ga.y, ga.z, ga.w, gb.x, gb.y, gb.z, gb.w};
            const float qs = ct == 6 ? 0.17677669529663687f * LOG2E : 1.0f;
            const bool hi = (fq & 1) != 0; const int lane_ = fr + 16 * fq;
#pragma unroll
            for (int ai = 0; ai < 2; ++ai)
#pragma unroll
                for (int m = 0; m < 4; ++m) { const int row = row0 + ai * 128 + m * 16; const bool lat = row < NROWL; const int t = row & 4095;
                    const int pos = (fq >> 1) == 0 ? (t >> 6) : (t & 63);
                    const float4* rp = (const float4*)(ropeD + pos * 8);
                    const float4 r0 = rp[0], r1 = rp[1], r2 = rp[2], r3 = rp[3];
                    const float cs[8] = {r0.x, r0.z, r1.x, r1.z, r2.x, r2.z, r3.x, r3.z}, sn[8] = {r0.y, r0.w, r1.y, r1.w, r2.y, r2.w, r3.y, r3.w};
                    bf16_t* rowp = base + (size_t)row * ldc + col0;
#pragma unroll
                    for (int bj = 0; bj < 2; ++bj) { const f32x4 v0 = acc[ai][bj][m][0], v1 = acc[ai][bj][m][1];
                        float x[8] = {v0[0], v0[1], v0[2], v0[3], v1[0], v1[1], v1[2], v1[3]};
                        float ss = 0.f;
#pragma unroll
                        for (int i = 0; i < 8; ++i) ss += x[i] * x[i];
                        ss += lane_xor16(ss, lane_); ss += lane_xor32(ss, lane_);
                        const float inv = rsqrtf(ss * (1.0f / 32.0f) + EPSF);
                        float o[8];
#pragma unroll
                        for (int i = 0; i < 8; ++i) { const float y = x[i] * inv * gn[i]; const float pr = lane_xor16(y, lane_);
                            o[i] = (lat ? (hi ? y * cs[i] + pr * sn[i] : y * cs[i] - pr * sn[i]) : y) * qs; }
                        u32x4 w; w.x = pg8::cvt_pk_bf16(o[0], o[1]); w.y = pg8::cvt_pk_bf16(o[2], o[3]); w.z = pg8::cvt_pk_bf16(o[4], o[5]); w.w = pg8::cvt_pk_bf16(o[6], o[7]);
                        *(u32x4*)(rowp + bj * 128) = w; } }
            return;
        }
#pragma unroll
        for (int ai = 0; ai < 2; ++ai)
#pragma unroll
            for (int m = 0; m < 4; ++m) { bf16_t* rowp = base + (size_t)(row0 + ai * 128 + m * 16) * ldc + col0;
#pragma unroll
                for (int bj = 0; bj < 2; ++bj) { const f32x4 v0 = acc[ai][bj][m][0], v1 = acc[ai][bj][m][1];
                    u32x4 w; w.x = pg8::cvt_pk_bf16(v0[0], v0[1]); w.y = pg8::cvt_pk_bf16(v0[2], v0[3]); w.z = pg8::cvt_pk_bf16(v1[0], v1[1]); w.w = pg8::cvt_pk_bf16(v1[2], v1[3]);
                    *(u32x4*)(rowp + bj * 128) = w; } }
    } };
__device__ __forceinline__ float silu_mul(float g, float u) { return g * u * __builtin_amdgcn_rcpf(1.0f + fast_exp2(-g * LOG2E)); }
struct EpiGU { static constexpr bool PERM = true; bf16_t* HID;
    __device__ __forceinline__ void operator()(const f32x4 (&acc)[2][2][4][2], const Unit& u, int wr, int wc, int fr, int fq) const {
        const int row0 = u.pm * 256 + wr * 64 + fr, col0 = (u.pn & 7) * 128 + wc * 32 + 8 * fq;
#pragma unroll
        for (int ai = 0; ai < 2; ++ai)
#pragma unroll
            for (int m = 0; m < 4; ++m) { bf16_t* rowp = HID + (size_t)(row0 + ai * 128 + m * 16) * DM + col0;
                const f32x4 g0 = acc[ai][0][m][0], g1 = acc[ai][0][m][1], u0 = acc[ai][1][m][0], u1 = acc[ai][1][m][1];
                u32x4 w; w.x = pg8::cvt_pk_bf16(silu_mul(g0[0], u0[0]), silu_mul(g0[1], u0[1])); w.y = pg8::cvt_pk_bf16(silu_mul(g0[2], u0[2]), silu_mul(g0[3], u0[3]));
                w.z = pg8::cvt_pk_bf16(silu_mul(g1[0], u1[0]), silu_mul(g1[1], u1[1])); w.w = pg8::cvt_pk_bf16(silu_mul(g1[2], u1[2]), silu_mul(g1[3], u1[3]));
                *(u32x4*)rowp = w; }
    } };
struct EpiDown { static constexpr bool PERM = true; bf16_t* Y; const float* sgate;
    __device__ __forceinline__ void operator()(const f32x4 (&acc)[2][2][4][2], const Unit& u, int wr, int wc, int fr, int fq) const {
        const int row0 = u.pm * 256 + wr * 64 + fr, col0 = (u.pn & 3) * 256 + wc * 32 + 8 * fq;
#pragma unroll
        for (int ai = 0; ai < 2; ++ai)
#pragma unroll
            for (int m = 0; m < 4; ++m) { const int r = row0 + ai * 128 + m * 16; const float gt = sgate[r]; bf16_t* rowp = Y + (size_t)r * DM + col0;
#pragma unroll
                for (int bj = 0; bj < 2; ++bj) { const f32x4 v0 = acc[ai][bj][m][0] * gt, v1 = acc[ai][bj][m][1] * gt;
                    u32x4 w; w.x = pg8::cvt_pk_bf16(v0[0], v0[1]); w.y = pg8::cvt_pk_bf16(v0[2], v0[3]); w.z = pg8::cvt_pk_bf16(v1[0], v1[1]); w.w = pg8::cvt_pk_bf16(v1[2], v1[3]);
                    *(u32x4*)(rowp + bj * 128) = w; } }
    } };
struct EpiOut { static constexpr bool PERM = true; const float* srcL; const float* srcC; bf16_t* XB; const float* MOD; int first;
    __device__ __forceinline__ void operator()(const f32x4 (&acc)[2][2][4][2], const Unit& u, int wr, int wc, int fr, int fq) const {
        const float* gt = MOD + (size_t)(u.pm < 256 ? (u.pm >> 4) : 16) * 6144 + 2048;
        const int row0 = u.pm * 256 + wr * 64 + fr, col0 = u.pn * 256 + wc * 32 + 8 * fq;
        f32x4 gv[2][2];
#pragma unroll
        for (int bj = 0; bj < 2; ++bj)
#pragma unroll
            for (int n = 0; n < 2; ++n) gv[bj][n] = *(const f32x4*)(gt + col0 + bj * 128 + n * 4);
#pragma unroll
        for (int ai = 0; ai < 2; ++ai)
#pragma unroll
            for (int m = 0; m < 4; ++m) { const int row = row0 + ai * 128 + m * 16;
                bf16_t* xrow = XB + (size_t)row * DM + col0;
                const float* frow = (row < NROWL ? srcL + (size_t)row * DM : srcC + (size_t)(row - NROWL) * DM) + col0;
#pragma unroll
                for (int bj = 0; bj < 2; ++bj) {
                    f32x4 s0, s1;
                    if (first) { s0 = *(const f32x4*)(frow + bj * 128); s1 = *(const f32x4*)(frow + bj * 128 + 4); }
                    else { const u32x4 raw = *(const u32x4*)(xrow + bj * 128);
                        s0 = (f32x4){bflo(raw.x), bfhi(raw.x), bflo(raw.y), bfhi(raw.y)}; s1 = (f32x4){bflo(raw.z), bfhi(raw.z), bflo(raw.w), bfhi(raw.w)}; }
                    const f32x4 v0 = s0 + gv[bj][0] * acc[ai][bj][m][0], v1 = s1 + gv[bj][1] * acc[ai][bj][m][1];
                    u32x4 w; w.x = pg8::cvt_pk_bf16(v0[0], v0[1]); w.y = pg8::cvt_pk_bf16(v0[2], v0[3]); w.z = pg8::cvt_pk_bf16(v1[0], v1[1]); w.w = pg8::cvt_pk_bf16(v1[2], v1[3]);
                    *(u32x4*)(xrow + bj * 128) = w; } }
    } };

__device__ __forceinline__ f32x16 mma32(const bf16_t* A, int lda, const bf16_t* Bt, int ldb, int K, f32x16 acc, int lane) {
    const int r = lane & 31, h = lane >> 5;
    const bf16_t* ap = A + r * lda + 8 * h; const bf16_t* bp = Bt + r * ldb + 8 * h;
    for (int k = 0; k < K; k += 16) {
        const bf16x8 a = *(const bf16x8*)(ap + k); const bf16x8 b = *(const bf16x8*)(bp + k);
        acc = __builtin_amdgcn_mfma_f32_32x32x16_bf16(a, b, acc, 0, 0, 0);
    }
    return acc;
}
#define CROW(reg, lane) (((reg) & 3) + 8 * ((reg) >> 2) + 4 * ((lane) >> 5))
typedef short v4i16_t __attribute__((ext_vector_type(4)));
__device__ __forceinline__ s16x4 tr_read(const LAS unsigned char* ptr) { return __builtin_bit_cast(s16x4, __builtin_amdgcn_ds_read_tr16_b64_v4i16((LAS v4i16_t*)ptr)); }
struct TrDesc { const float* src; bf16_t* dst; int src_ld, src_col0, k0, n0; };
__device__ __forceinline__ void tr_load(const TrDesc& d, int t, float4 (&v)[2]) {
#pragma unroll
    for (int p = 0; p < 2; ++p) { const int j = (t >> 4) + 32 * p; v[p] = *(const float4*)(d.src + (size_t)(d.k0 + j) * d.src_ld + d.src_col0 + (t & 15) * 4); }
}
__device__ __forceinline__ void tr_store(unsigned char* smem, const TrDesc& d, int t, const float4 (&v)[2]) {
    float* tile = (float*)smem;
#pragma unroll
    for (int p = 0; p < 2; ++p) { const int j = (t >> 4) + 32 * p; float* q = tile + j * 65 + (t & 15) * 4; q[0] = v[p].x; q[1] = v[p].y; q[2] = v[p].z; q[3] = v[p].w; }
    __syncthreads();
    { const int i = t >> 3, kc = (t & 7) * 8;
      u32x4 w;
      w.x = pack_bf16(tile[(kc + 0) * 65 + i], tile[(kc + 1) * 65 + i]); w.y = pack_bf16(tile[(kc + 2) * 65 + i], tile[(kc + 3) * 65 + i]);
      w.z = pack_bf16(tile[(kc + 4) * 65 + i], tile[(kc + 5) * 65 + i]); w.w = pack_bf16(tile[(kc + 6) * 65 + i], tile[(kc + 7) * 65 + i]);
      *(u32x4*)(d.dst + (size_t)(d.n0 + i) * DM + d.k0 + kc) = w; }
    __syncthreads();
}

template <int PART>
__device__ __forceinline__ void phase_W(const Params& p, int l, unsigned char* smem) {
    unsigned char* ws = launder_ws(p.ws);
    const int tid = my_tid(), G = gridDim.x, bid = blockIdx.x;
    if (PART == 0 && bid == 0) {
        float2* rA = (float2*)(ws + WS_ROPE); float2* rD = rA + 64 * 16;
        for (int idx = tid; idx < 64 * 16; idx += NTHR) { const int pos = idx >> 4, f = idx & 15; const float inv = powf(10000.0f, -(float)f / 16.0f); float sn, cs; sincosf((float)pos * inv, &sn, &cs); rA[idx] = make_float2(cs, sn); }
        for (int idx = tid; idx < 64 * 8; idx += NTHR) { const int pos = idx >> 3, f = idx & 7; const float inv = powf(10000.0f, -(float)f / 8.0f); float sn, cs; sincosf((float)pos * inv, &sn, &cs); rD[idx] = make_float2(cs, sn); }
    }
    if (PART == 0) { int4* inv4 = (int4*)(ws + WS_INV); const int n4 = NROW * 16 / 4;
      for (int i = bid * NTHR + tid; i < n4; i += G * NTHR) inv4[i] = make_int4(-1, -1, -1, -1); }
    const float* w_in = PIN(I_WIN) + (size_t)l * DM * INW;
    const float* w_out = PIN(I_WOUT) + (size_t)l * DM * DM;
    const float* weg = PIN(I_WEG) + (size_t)l * NEXP * DM * DM;
    const float* weu = PIN(I_WEU) + (size_t)l * NEXP * DM * DM;
    const float* wed = PIN(I_WED) + (size_t)l * NEXP * DM * DM;
    bf16_t* WinT = (bf16_t*)(ws + WS_U) + (size_t)NROW * DM;
    bf16_t* WoutT = (bf16_t*)(ws + WS_WOUT);
    bf16_t* WguT = (bf16_t*)(ws + WS_WGU);
    bf16_t* WdT = (bf16_t*)(ws + WS_WD);
    const int N_IN = 768, N_OUT = 256, N_GU = 8192, N_D = 4096, N_ADA = 96, N_HID = 544;
    const int NCVT = N_IN + N_OUT + N_GU + N_D;
    auto tr_desc = [&](int x, TrDesc& d) {
        if (x < N_IN) { const int nt = x >> 4, kt = x & 15, n0 = nt * 64;
            int sc; if (n0 < 512) sc = n0; else if (n0 < 1536) sc = n0 + 768; else if (n0 < 2304) sc = n0 + 784; else sc = n0 - 1792;
            d.src = w_in; d.src_ld = INW; d.src_col0 = sc; d.k0 = kt * 64; d.dst = WinT; d.n0 = n0; return; }
        x -= N_IN;
        if (x < N_OUT) { const int nt = x >> 4, kt = x & 15; d.src = w_out; d.src_ld = DM; d.src_col0 = nt * 64; d.k0 = kt * 64; d.dst = WoutT; d.n0 = nt * 64; return; }
        x -= N_OUT;
        if (x < N_GU) { const int e = x >> 9, r = x & 511, nt = r >> 4, kt = r & 15, n0 = nt * 64;
            const int j = n0 >> 8, rr = n0 & 255;
            d.src = (rr < 128 ? weg : weu) + (size_t)e * DM * DM; d.src_ld = DM; d.src_col0 = j * 128 + (rr & 127); d.k0 = kt * 64; d.dst = WguT + (size_t)e * 2048 * DM; d.n0 = n0; return; }
        x -= N_GU;
        { const int e = x >> 8, r = x & 255, nt = r >> 4, kt = r & 15;
          d.src = wed + (size_t)e * DM * DM; d.src_ld = DM; d.src_col0 = nt * 64; d.k0 = kt * 64; d.dst = WdT + (size_t)e * DM * DM; d.n0 = nt * 64; }
    };
    if (PART < 2) {
        TrDesc cur, nxt; float4 va[2], vb[2];
        if (bid < NCVT) { tr_desc(bid, cur); tr_load(cur, tid, va); }
        for (int it = bid; it < NCVT; it += G) {
            const bool more = it + G < NCVT;
            if (more) { tr_desc(it + G, nxt); tr_load(nxt, tid, vb); }
            tr_store(smem, cur, tid, va);
            if (more) { cur = nxt; va[0] = vb[0]; va[1] = vb[1]; }
        }
    }
    const int ibeg = (PART == 3) ? N_ADA : 0;
    const int total = (PART == 1) ? 0 : (PART == 2 ? N_ADA : N_ADA + N_HID);
    const int nheavy = (PART == 2) ? G / 4 : (PART == 3 ? G / 2 : 0);
    const int it0 = ibeg + (bid >= nheavy ? bid - nheavy : total), istride = G - nheavy;
    for (int it = it0; it < total; it += istride) {
        int x = it;
        if (x < N_ADA) {
            const int n0 = x * 64;
            float* sv = (float*)smem;
            float* red = sv + 17 * 1024;
            const float* c = PIN(I_C); const float* cc = PIN(I_CCTX);
            for (int idx = tid; idx < 17 * 1024; idx += NTHR) { const int r = idx >> 10, k = idx & 1023; const float v = r < 16 ? c[r * 1024 + k] : cc[k]; sv[idx] = v / (1.0f + expf(-v)); }
            __syncthreads();
            const int w = tid >> 6, lane = tid & 63;
            float acc[17];
#pragma unroll
            for (int r = 0; r < 17; ++r) acc[r] = 0.f;
            const float* wa = PIN(I_WADA) + (size_t)l * DM * 6144 + n0 + lane;
            for (int k0 = 128 * w; k0 < 128 * w + 128; k0 += 32) {
                float wv[32];
#pragma unroll
                for (int u = 0; u < 32; ++u) wv[u] = wa[(size_t)(k0 + u) * 6144];
#pragma unroll
                for (int u = 0; u < 32; ++u)
#pragma unroll
                    for (int r = 0; r < 17; ++r) acc[r] += sv[r * 1024 + k0 + u] * wv[u];
            }
#pragma unroll
            for (int r = 0; r < 17; ++r) red[(w * 17 + r) * 64 + lane] = acc[r];
            __syncthreads();
            float* MOD = (float*)(ws + WS_MOD + (size_t)(l & 1) * MOD_BYTES); const float* ba = PIN(I_BADA) + (size_t)l * 6144;
            for (int idx = tid; idx < 17 * 64; idx += NTHR) { const int r = idx >> 6, j = idx & 63; float s = ba[n0 + j];
#pragma unroll
                for (int ww = 0; ww < 8; ++ww) s += red[(ww * 17 + r) * 64 + j];
                MOD[(size_t)r * 6144 + n0 + j] = s; }
            __syncthreads();
            continue; }
        x -= N_ADA;
        {
            const bool isc = x >= 512; const int L = isc ? 256 : 4096; const int lagbase = (isc ? x - 512 : x) * 8;
            float* zf = (float*)smem;
            float* h1s = zf + 8 * 36;
            const int li = tid >> 6, j = tid & 63, lag = lagbase + li;
            if (j < 33) { float v;
                if (j == 0) v = (float)lag / (float)(L - 1);
                else { const int bi = (j - 1) & 15; const float band = 1e-4f + (float)bi * ((15.0f - 1e-4f) / 15.0f); const float w = 6.283185307179586f * (float)lag / (float)L; const float a = band * w;
                       v = (j <= 16) ? cosf(a) : -sinf(a); }
                zf[li * 36 + j] = v; }
            __syncthreads();
            const float* fw1 = PIN(I_FW1) + (size_t)l * 33 * 64; const float* fb1 = PIN(I_FB1) + l * 64; const float* fr = PIN(I_FREQ) + l * 64;
            const float* fw2 = PIN(I_FW2) + (size_t)l * 64 * 64; const float* fb2 = PIN(I_FB2) + l * 64;
            float a = fb1[j];
#pragma unroll 3
            for (int i = 0; i < 33; ++i) a += zf[li * 36 + i] * fw1[i * 64 + j];
            h1s[li * 64 + j] = sinf(fr[j] * a);
            __syncthreads();
            float a2 = fb2[j];
#pragma unroll 4
            for (int i = 0; i < 64; ++i) a2 += h1s[li * 64 + i] * fw2[i * 64 + j];
            float* H2 = (float*)(ws + (isc ? WS_HID2C : WS_HID2L));
            H2[(size_t)j * L + lag] = sinf(fr[j] * a2);
            __syncthreads();
        }
    }
}

template <int WHICH>
__device__ __forceinline__ void phase_norm(const Params& p, int l, unsigned char* smem) {
    unsigned char* ws = launder_ws(p.ws);
    const int tid = my_tid(), lane = tid & 63, wave = tid >> 6;
    float* Wg = (float*)smem;
    for (int idx = tid; idx < 16384; idx += NTHR) { const int k = idx >> 4, j = idx & 15;
        Wg[j * 1024 + k] = (WHICH == 1) ? PIN(I_WIN)[(size_t)l * DM * INW + (size_t)k * INW + 2304 + j] : PIN(I_WROUTER)[(size_t)l * DM * 16 + k * 16 + j]; }
    __syncthreads();
    const float* gain = PIN(WHICH == 1 ? I_N1G : I_N2G) + (size_t)l * DM;
    const float* MOD = (const float*)(ws + WS_MOD + (size_t)(l & 1) * MOD_BYTES);
    bf16_t* U = (bf16_t*)(ws + WS_U);
    float* outv = (float*)(ws + (WHICH == 1 ? WS_GATES : WS_AFF));
    const float* xl = PIN(I_X); const float* xc = PIN(I_CTX);
    const bf16_t* XB = (const bf16_t*)(ws + WS_XB);
    const int rstride = gridDim.x * 8;
    const int nrows = (WHICH == 2 && l == DEPTH - 1) ? NROWL : NROW;
#define NM_LOAD(dst, r) do { if (WHICH == 1) { const float* s_ = (r) < NROWL ? xl + (size_t)(r) * DM : xc + (size_t)((r) - NROWL) * DM; \
            _Pragma("unroll") for (int i = 0; i < 4; ++i) dst[i] = *(const float4*)(s_ + 256 * i + 4 * lane); } \
        else { const bf16_t* s_ = XB + (size_t)(r) * DM; \
            _Pragma("unroll") for (int i = 0; i < 4; ++i) { const u32x2 w_ = *(const u32x2*)(s_ + 256 * i + 4 * lane); dst[i] = make_float4(bflo(w_.x), bfhi(w_.x), bflo(w_.y), bfhi(w_.y)); } } } while (0)
    float4 cur[4];
    { const int row = blockIdx.x * 8 + wave; NM_LOAD(cur, row); }
    for (int row = blockIdx.x * 8 + wave; row < nrows; row += rstride) {
        float4 nxt[4];
        { const int r2 = row + rstride < nrows ? row + rstride : row; NM_LOAD(nxt, r2); }
        const float* mod = MOD + (size_t)(row < NROWL ? (row >> 12) : 16) * 6144 + (WHICH == 1 ? 0 : 3072);
        float ss = 0.f;
#pragma unroll
        for (int i = 0; i < 4; ++i) ss += cur[i].x * cur[i].x + cur[i].y * cur[i].y + cur[i].z * cur[i].z + cur[i].w * cur[i].w;
        ss = wave_sum(ss);
        const float inv = rsqrtf(ss * (1.0f / 1024.0f) + EPSF);
        float part[16];
#pragma unroll
        for (int j = 0; j < 16; ++j) part[j] = 0.f;
#pragma unroll
        for (int i = 0; i < 4; ++i) { const int k = 256 * i + 4 * lane;
            const float4 v = cur[i];
            const float4 g = *(const float4*)(gain + k), sh = *(const float4*)(mod + k), sc = *(const float4*)(mod + 1024 + k);
            float4 h; h.x = v.x * inv * g.x * (1.f + sc.x) + sh.x; h.y = v.y * inv * g.y * (1.f + sc.y) + sh.y; h.z = v.z * inv * g.z * (1.f + sc.z) + sh.z; h.w = v.w * inv * g.w * (1.f + sc.w) + sh.w;
            u32x2 w; w.x = pack_bf16(h.x, h.y); w.y = pack_bf16(h.z, h.w);
            *(u32x2*)(U + (size_t)row * DM + k) = w;
#pragma unroll
            for (int j = 0; j < 16; ++j) { const float4 wv = *(const float4*)(Wg + j * 1024 + k); part[j] += h.x * wv.x + h.y * wv.y + h.z * wv.z + h.w * wv.w; }
            asm volatile("" ::: "memory"); }
#pragma unroll
        for (int i = 0; i < 4; ++i) cur[i] = nxt[i];
        float v1 = reduce16_transpose(part, lane);
        const int jx = ((lane >> 5) & 1) * 8 + ((lane >> 4) & 1) * 4 + ((lane >> 3) & 1) * 2 + ((lane >> 2) & 1);
        float val = v1;
        if (WHICH == 2) { const float mx = wave_max(v1); const float e = expf(v1 - mx); const float sum = wave_sum(e) * 0.25f; val = e / sum; }
        if ((lane & 3) == 0) outv[(size_t)row * 16 + jx] = val;
    }
    __syncthreads();
}

__device__ __forceinline__ void phase_prep(const Params& p, int l, unsigned char* smem) {
    unsigned char* ws = launder_ws(p.ws);
    const int tid = my_tid(), lane = tid & 63, wave = tid >> 6;
    float2* ropeA = (float2*)smem;
    float2* ropeD = ropeA + 64 * 16;
    for (int idx = tid; idx < 64 * 16; idx += NTHR) { const int pos = idx >> 4, f = idx & 15; const float inv = powf(10000.0f, -(float)f / 16.0f); float s, c; sincosf((float)pos * inv, &s, &c); ropeA[idx] = make_float2(c, s); }
    for (int idx = tid; idx < 64 * 8; idx += NTHR) { const int pos = idx >> 3, f = idx & 7; const float inv = powf(10000.0f, -(float)f / 8.0f); float s, c; sincosf((float)pos * inv, &s, &c); ropeD[idx] = make_float2(c, s); }
    __syncthreads();
    bf16_t* P = (bf16_t*)(ws + WS_P);
    const float* aqn = PIN(I_AQN) + l * 64; const float* akn = PIN(I_AKN) + l * 64;
    const float* dqn = PIN(I_DQN) + l * 32; const float* dkn = PIN(I_DKN) + l * 32;
    const int rstride = gridDim.x * 8;
    const int vecA = min(lane >> 3, 5), chA = lane & 7;
    u32x4 rawA;
    { const int row = blockIdx.x * 8 + wave; const bf16_t* pr = P + (size_t)row * PW; rawA = *(const u32x4*)(pr + vecA * 64 + chA * 8); }
    for (int row = blockIdx.x * 8 + wave; row < NROW; row += rstride) {
        const bool lat = row < NROWL; const int t = row & 4095; const int prow = t >> 6, pcol = t & 63;
        bf16_t* pr = P + (size_t)row * PW;
        u32x4 nxtA;
        { const int r2 = row + rstride < NROW ? row + rstride : row; const bf16_t* p2 = P + (size_t)r2 * PW; nxtA = *(const u32x4*)(p2 + vecA * 64 + chA * 8); }
        {
            const int vec = vecA, ch = chA; const bool act = lane < 48;
            bf16_t* ptr = pr + vec * 64 + ch * 8;
            const u32x4 raw = rawA;
            float x[8]; x[0] = bflo(raw.x); x[1] = bfhi(raw.x); x[2] = bflo(raw.y); x[3] = bfhi(raw.y); x[4] = bflo(raw.z); x[5] = bfhi(raw.z); x[6] = bflo(raw.w); x[7] = bfhi(raw.w);
            float ss = 0.f;
#pragma unroll
            for (int i = 0; i < 8; ++i) ss += x[i] * x[i];
            ss += __shfl_xor(ss, 1); ss += __shfl_xor(ss, 2); ss += __shfl_xor(ss, 4);
            const float inv = rsqrtf(ss * (1.0f / 64.0f) + EPSF);
            const float* gn = (vec < 4 ? aqn : akn) + ch * 8;
            const float qs = vec < 4 ? 0.125f * LOG2E : 1.0f;
            const int axis = ch >> 2, half = (ch >> 1) & 1; const int pos = axis == 0 ? prow : pcol;
            float o[8];
#pragma unroll
            for (int i = 0; i < 8; ++i) { const float y = x[i] * inv * gn[i]; const float pr2 = __shfl_xor(y, 2);
                if (lat) { const float2 cs = ropeA[pos * 16 + 8 * (ch & 1) + i]; o[i] = (half == 0 ? y * cs.x - pr2 * cs.y : y * cs.x + pr2 * cs.y) * qs; } else o[i] = y * qs; }
            if (act) { u32x4 w; w.x = pack_bf16(o[0], o[1]); w.y = pack_bf16(o[2], o[3]); w.z = pack_bf16(o[4], o[5]); w.w = pack_bf16(o[6], o[7]); *(u32x4*)ptr = w; }
        }
        rawA = nxtA;
    }
    __syncthreads();
}
__device__ __forceinline__ int block_excl_scan(int v, int* sbuf  , int& total) {
    const int tid = my_tid(), lane = tid & 63, wave = tid >> 6;
    int inc = v;
#pragma unroll
    for (int o = 1; o < 64; o <<= 1) { const int n = __shfl_up(inc, o); if (lane >= o) inc += n; }
    __syncthreads();
    if (lane == 63) sbuf[wave] = inc;
    __syncthreads();
    int pre = 0, tot = 0;
#pragma unroll
    for (int w = 0; w < 8; ++w) { const int s = sbuf[w]; if (w < wave) pre += s; tot += s; }
    total = tot;
    return pre + inc - v;
}

__device__ __forceinline__ void phase_topk(const Params& p, int l, unsigned char* smem) {
    unsigned char* ws = launder_ws(p.ws);
    const int tid = my_tid();
    unsigned* keys = (unsigned*)smem;
    int* hist = (int*)(keys + 4096);
    int* sb = hist + 256;
    int* ctl = sb + 16;
    const float* AFF = (const float*)(ws + WS_AFF);
    int* SROW = (int*)(ws + WS_SROW); float* SGATE = (float*)(ws + WS_SGATE); int* INV = (int*)(ws + WS_INV);
    const int nlists = (l == DEPTH - 1) ? 256 : 512;
    for (int it = blockIdx.x; it < nlists; it += gridDim.x) {
        const int kind = it >> 8, b = (it >> 4) & 15, e = it & 15;
        const int N = kind ? 256 : 4096, K = kind ? CAPC : CAPL;
        const int rowbase = kind ? NROWL + b * 256 : b * 4096;
        const int slotbase = e * SLOTS_E + (kind ? 8192 + b * CAPC : b * CAPL);
        for (int i = tid; i < N; i += NTHR) keys[i] = __float_as_uint(AFF[(size_t)(rowbase + i) * 16 + e]);
        unsigned prefix = 0, mask = 0; int need = K;
        for (int pass = 3; pass >= 0; --pass) {
            const int shift = 8 * pass;
            if (tid < 256) hist[tid] = 0;
            __syncthreads();
            for (int i = tid; i < N; i += NTHR) { const unsigned k = keys[i]; if ((k & mask) == prefix) atomicAdd(&hist[(k >> shift) & 255], 1); }
            __syncthreads();
            if (tid < 64) {
                const int b0 = 255 - 4 * tid; const int h0 = hist[b0], h1 = hist[b0 - 1], h2 = hist[b0 - 2], h3 = hist[b0 - 3];
                const int tot4 = h0 + h1 + h2 + h3; int inc = tot4;
#pragma unroll
                for (int o = 1; o < 64; o <<= 1) { const int n = __shfl_up(inc, o); if (tid >= o) inc += n; }
                const int exc = inc - tot4;
                const bool hit = (exc < need) && (inc >= need);
                if (hit) { int cum = exc, d = b0;
                    if (cum + h0 >= need) d = b0; else { cum += h0; if (cum + h1 >= need) d = b0 - 1; else { cum += h1; if (cum + h2 >= need) d = b0 - 2; else { cum += h2; d = b0 - 3; } } }
                    ctl[0] = d; ctl[1] = need - cum; } }
            __syncthreads();
            prefix |= (unsigned)ctl[0] << shift; mask |= 255u << shift; need = ctl[1];
            __syncthreads();
        }
        const unsigned T = prefix;
        int cg = 0, ce = 0; unsigned k8[8];
#pragma unroll
        for (int j = 0; j < 8; ++j) { const int i = tid * 8 + j; const unsigned k = (i < N) ? keys[i] : 0u; k8[j] = k; cg += (i < N && k > T) ? 1 : 0; ce += (i < N && k == T) ? 1 : 0; }
        int totg, tote;
        int pg = block_excl_scan(cg, sb, totg);
        int pe = block_excl_scan(ce, sb, tote);
#pragma unroll
        for (int j = 0; j < 8; ++j) { const int i = tid * 8 + j; if (i < N) { const unsigned k = k8[j]; int pos = -1;
                if (k > T) pos = pg++; else if (k == T) { if (pe < need) pos = totg + pe; ++pe; }
                if (pos >= 0) { const int s = slotbase + pos; const int row = rowbase + i; SROW[s] = row; SGATE[s] = __uint_as_float(k); INV[(size_t)row * 16 + e] = s; } } }
        __syncthreads();
    }
}

__device__ __forceinline__ void phase_gather(const Params& p) {
    unsigned char* ws = launder_ws(p.ws);
    const int lane = my_tid() & 63, wave = my_tid() >> 6;
    const int* SROW = (const int*)(ws + WS_SROW);
    const bf16_t* U = (const bf16_t*)(ws + WS_U); bf16_t* XE = (bf16_t*)(ws + WS_XE);
    for (int s = blockIdx.x * 8 + wave; s < NSLOT; s += gridDim.x * 8) {
        const int row = SROW[s];
        const u32x4* src = (const u32x4*)(U + (size_t)row * DM); u32x4* dst = (u32x4*)(XE + (size_t)s * DM);
        const u32x4 a = src[lane], b = src[64 + lane];
        dst[lane] = a; dst[64 + lane] = b;
    }
}

template <bool NEXT>
__device__ __forceinline__ void phase_combine(const Params& p, int l, unsigned char* smem) {
    unsigned char* ws = launder_ws(p.ws);
    const int tid = my_tid(), lane = tid & 63, wave = tid >> 6;
    int* INV = (int*)(ws + WS_INV);
    const bf16_t* YS = (const bf16_t*)(ws + WS_XE);
    const float* MODc = (const float*)(ws + WS_MOD + (size_t)(l & 1) * MOD_BYTES);
    const float* MODn = (const float*)(ws + WS_MOD + (size_t)((l + 1) & 1) * MOD_BYTES);
    float* Wg = (float*)smem;
    bf16_t* U = (bf16_t*)(ws + WS_U); float* GT = (float*)(ws + WS_GATES);
    const float* gain = PIN(I_N1G) + (size_t)(NEXT ? l + 1 : 0) * DM;
    if (NEXT) { for (int idx = tid; idx < 16384; idx += NTHR) { const int k = idx >> 4, j = idx & 15; Wg[j * 1024 + k] = PIN(I_WIN)[(size_t)(l + 1) * DM * INW + (size_t)k * INW + 2304 + j]; }
        __syncthreads(); }
    const int rstride = gridDim.x * 8;
    bf16_t* XB = (bf16_t*)(ws + WS_XB); float* outp = POUT();
    int myinv; u32x2 xc4[4];
    { const int row = blockIdx.x * 8 + wave; myinv = INV[(size_t)row * 16 + (lane & 15)];
#pragma unroll
      for (int i = 0; i < 4; ++i) xc4[i] = *(const u32x2*)(XB + (size_t)row * DM + 256 * i + 4 * lane); }
    const int nrows = NEXT ? NROW : NROWL;
    for (int row = blockIdx.x * 8 + wave; row < nrows; row += rstride) {
        int ninv; u32x2 xn4[4];
        { const int r2 = row + rstride < nrows ? row + rstride : row; ninv = INV[(size_t)r2 * 16 + (lane & 15)];
#pragma unroll
          for (int i = 0; i < 4; ++i) xn4[i] = *(const u32x2*)(XB + (size_t)r2 * DM + 256 * i + 4 * lane); }
        float acc[16];
#pragma unroll
        for (int j = 0; j < 16; ++j) acc[j] = 0.f;
        {
            unsigned msk = (unsigned)(__ballot(myinv >= 0 && lane < 16)) & 0xffffu;
            if (msk) {
                const int e0 = __ffs(msk) - 1; msk &= msk - 1;
                const int s0 = __shfl(myinv, e0);
                const bool two = msk != 0u; int s1 = s0;
                if (two) { const int e1 = __ffs(msk) - 1; msk &= msk - 1; s1 = __shfl(myinv, e1); }
                u32x2 w0[4], w1[4];
#pragma unroll
                for (int i = 0; i < 4; ++i) { w0[i] = *(const u32x2*)(YS + (size_t)s0 * DM + 256 * i + 4 * lane); w1[i] = *(const u32x2*)(YS + (size_t)s1 * DM + 256 * i + 4 * lane); }
                const float f1 = two ? 1.0f : 0.0f;
#pragma unroll
                for (int i = 0; i < 4; ++i) { acc[4 * i + 0] = bflo(w0[i].x) + f1 * bflo(w1[i].x); acc[4 * i + 1] = bfhi(w0[i].x) + f1 * bfhi(w1[i].x);
                    acc[4 * i + 2] = bflo(w0[i].y) + f1 * bflo(w1[i].y); acc[4 * i + 3] = bfhi(w0[i].y) + f1 * bfhi(w1[i].y); }
                while (msk) { const int e = __ffs(msk) - 1; msk &= msk - 1; const int s = __shfl(myinv, e);
#pragma unroll
                    for (int i = 0; i < 4; ++i) { const u32x2 w = *(const u32x2*)(YS + (size_t)s * DM + 256 * i + 4 * lane);
                        acc[4 * i + 0] += bflo(w.x); acc[4 * i + 1] += bfhi(w.x); acc[4 * i + 2] += bflo(w.y); acc[4 * i + 3] += bfhi(w.y); } }
            }
        }
        if (lane < 16) INV[(size_t)row * 16 + lane] = -1;
        const int mrow = row < NROWL ? (row >> 12) : 16;
        const float* gt = MODc + (size_t)mrow * 6144 + 5120;
        float ss = 0.f;
#pragma unroll
        for (int i = 0; i < 4; ++i) { const int k = 256 * i + 4 * lane;
            float4 xv = make_float4(bflo(xc4[i].x), bfhi(xc4[i].x), bflo(xc4[i].y), bfhi(xc4[i].y)); const float4 g = *(const float4*)(gt + k);
            xv.x += g.x * acc[4 * i + 0]; xv.y += g.y * acc[4 * i + 1]; xv.z += g.z * acc[4 * i + 2]; xv.w += g.w * acc[4 * i + 3];
            if (NEXT) { u32x2 w; w.x = pack_bf16(xv.x, xv.y); w.y = pack_bf16(xv.z, xv.w); *(u32x2*)(XB + (size_t)row * DM + k) = w; }
            else *(float4*)(outp + (size_t)row * DM + k) = xv;
            acc[4 * i + 0] = xv.x; acc[4 * i + 1] = xv.y; acc[4 * i + 2] = xv.z; acc[4 * i + 3] = xv.w;
            ss += xv.x * xv.x + xv.y * xv.y + xv.z * xv.z + xv.w * xv.w; }
        myinv = ninv;
#pragma unroll
        for (int i = 0; i < 4; ++i) xc4[i] = xn4[i];
        if (NEXT) {
            ss = wave_sum(ss);
            const float inv = rsqrtf(ss * (1.0f / 1024.0f) + EPSF);
            const float* mod = MODn + (size_t)mrow * 6144;
            float part[16];
#pragma unroll
            for (int j = 0; j < 16; ++j) part[j] = 0.f;
#pragma unroll
            for (int i = 0; i < 4; ++i) { const int k = 256 * i + 4 * lane;
                const float4 g = *(const float4*)(gain + k), sh = *(const float4*)(mod + k), sc = *(const float4*)(mod + 1024 + k);
                float4 h; h.x = acc[4 * i + 0] * inv * g.x * (1.f + sc.x) + sh.x; h.y = acc[4 * i + 1] * inv * g.y * (1.f + sc.y) + sh.y; h.z = acc[4 * i + 2] * inv * g.z * (1.f + sc.z) + sh.z; h.w = acc[4 * i + 3] * inv * g.w * (1.f + sc.w) + sh.w;
                u32x2 w; w.x = pack_bf16(h.x, h.y); w.y = pack_bf16(h.z, h.w);
                *(u32x2*)(U + (size_t)row * DM + k) = w;
#pragma unroll
                for (int j = 0; j < 16; ++j) { const float4 wv = *(const float4*)(Wg + j * 1024 + k); part[j] += h.x * wv.x + h.y * wv.y + h.z * wv.z + h.w * wv.w; }
                asm volatile("" ::: "memory"); }
            const float v1 = reduce16_transpose(part, lane);
            const int jx = ((lane >> 5) & 1) * 8 + ((lane >> 4) & 1) * 4 + ((lane >> 3) & 1) * 2 + ((lane >> 2) & 1);
            if ((lane & 3) == 0) GT[(size_t)row * 16 + jx] = v1;
        }
    }
    __syncthreads();
}
struct AttnItem { int qrow0, qpos0, qcol, kcol, vcol, ycol; int nt0, krow0, kpos0, masked; int nt1, krow1; float M2, sink2, lam, postscale; const float* subgain; };
#define FA_LD 72

template <int NC>
__device__ __forceinline__ void fattn_item(const bf16_t* __restrict__ P, bf16_t* __restrict__ Y, const AttnItem& it, unsigned char* smem) {
    constexpr int KS = (NC == 2) ? 2 : 4;
    const int tid = my_tid(), lane = tid & 63, w = tid >> 6, h = lane >> 5, lq = lane & 31;
    bf16_t* Kb = (bf16_t*)smem;
    bf16_t* Vb = Kb + 2 * 64 * FA_LD;
    const LAS unsigned char* vlds = (const LAS unsigned char*)(smem) + 2 * 64 * FA_LD * 2;
    bf16x8 qf[NC][KS];
    { const bf16_t* qp = P + (size_t)(it.qrow0 + 32 * w + lq) * PW + it.qcol + 8 * h;
#pragma unroll
      for (int c = 0; c < NC; ++c)
#pragma unroll
          for (int s = 0; s < KS; ++s) qf[c][s] = *(const bf16x8*)(qp + 32 * c + 16 * s); }
    f32x16 O[NC][2]; float lsum[NC];
#pragma unroll
    for (int c = 0; c < NC; ++c) { lsum[c] = 0.f;
#pragma unroll
        for (int dt = 0; dt < 2; ++dt)
#pragma unroll
            for (int r = 0; r < 16; ++r) O[c][dt][r] = 0.f; }
    const int ntot = it.nt0 + it.nt1;
    const int ldkey = tid >> 3, ldch = tid & 7;
    const int vlane = ((4 * h + ((lane & 15) >> 2)) * FA_LD + 16 * ((lane >> 4) & 1) + 4 * (lane & 3)) * 2;
    u32x4 kreg, vreg;
    { const int krow = it.nt0 > 0 ? it.krow0 : it.krow1; const bf16_t* kp = P + (size_t)(krow + ldkey) * PW;
      kreg = *(const u32x4*)(kp + it.kcol + ldch * 8); vreg = *(const u32x4*)(kp + it.vcol + ldch * 8); }
    __syncthreads();
    *(u32x4*)(Kb + ldkey * FA_LD + ldch * 8) = kreg; *(u32x4*)(Vb + ldkey * FA_LD + ldch * 8) = vreg;
    __syncthreads();
    const int qpos = it.qpos0 + 32 * w + lq;
    for (int kt = 0; kt < ntot; ++kt) {
        const int buf = kt & 1;
        int kpos = 0; bool msk = false;
        if (kt < it.nt0) { kpos = it.kpos0 + 64 * kt; msk = it.masked != 0; }
        if (kt + 1 < ntot) { const int k2 = kt + 1; const int krow = k2 < it.nt0 ? it.krow0 + 64 * k2 : it.krow1 + 64 * (k2 - it.nt0);
            const bf16_t* kp = P + (size_t)(krow + ldkey) * PW; kreg = *(const u32x4*)(kp + it.kcol + ldch * 8); vreg = *(const u32x4*)(kp + it.vcol + ldch * 8); }
        bool skip = false;
        if (msk) { const int q0 = it.qpos0 + 32 * w; skip = (kpos > q0 + 31 + 128) || (kpos + 63 < q0 - 128); }
        if (!skip) {
            const bf16_t* kb = Kb + buf * 64 * FA_LD; const LAS unsigned char* vb = vlds + buf * 64 * FA_LD * 2 + vlane;
#pragma unroll
            for (int sub = 0; sub < 2; ++sub) {
                unsigned pk[NC][2][4];
#pragma unroll
                for (int c = 0; c < NC; ++c) {
                    f32x16 S;
#pragma unroll
                    for (int r = 0; r < 16; ++r) S[r] = -it.M2;
#pragma unroll
                    for (int s = 0; s < KS; ++s) { const bf16x8 a = *(const bf16x8*)(kb + (32 * sub + lq) * FA_LD + 32 * c + 16 * s + 8 * h);
                        S = __builtin_amdgcn_mfma_f32_32x32x16_bf16(a, qf[c][s], S, 0, 0, 0); }
                    float pv[16];
#pragma unroll
                    for (int r = 0; r < 16; ++r) { pv[r] = fast_exp2(S[r]);
                        if (NC == 1) { if (msk) { const int d = qpos - (kpos + 32 * sub + CROW(r, lane)); if (d > 128 || d < -128) pv[r] = 0.f; } } }
#pragma unroll
                    for (int r = 0; r < 16; ++r) lsum[c] += pv[r];
#pragma unroll
                    for (int s = 0; s < 2; ++s)
#pragma unroll
                        for (int jj = 0; jj < 4; ++jj) pk[c][s][jj] = pg8::cvt_pk_bf16(pv[8 * s + 2 * jj], pv[8 * s + 2 * jj + 1]);
                }
#pragma unroll
                for (int s = 0; s < 2; ++s)
#pragma unroll
                    for (int dt = 0; dt < 2; ++dt) {
                        const s16x4 lo = tr_read(vb + (32 * sub + 16 * s) * FA_LD * 2 + 64 * dt), hi = tr_read(vb + (32 * sub + 16 * s + 8) * FA_LD * 2 + 64 * dt);
                        const bf16x8 a = __builtin_shufflevector(lo, hi, 0, 1, 2, 3, 4, 5, 6, 7);
#pragma unroll
                        for (int c = 0; c < NC; ++c) { u32x4 bw; bw.x = pk[c][s][0]; bw.y = pk[c][s][1]; bw.z = pk[c][s][2]; bw.w = pk[c][s][3];
                            O[c][dt] = __builtin_amdgcn_mfma_f32_32x32x16_bf16(a, __builtin_bit_cast(bf16x8, bw), O[c][dt], 0, 0, 0); }
                    }
            }
        }
        if (kt + 1 < ntot) { bf16_t* kd = Kb + (buf ^ 1) * 64 * FA_LD; bf16_t* vd = Vb + (buf ^ 1) * 64 * FA_LD;
            *(u32x4*)(kd + ldkey * FA_LD + ldch * 8) = kreg; *(u32x4*)(vd + ldkey * FA_LD + ldch * 8) = vreg; }
        __syncthreads();
    }
    float linv[NC];
#pragma unroll
    for (int c = 0; c < NC; ++c) { const float l = lsum[c] + __shfl_xor(lsum[c], 32); linv[c] = (NC == 1) ? 1.0f / (l + fast_exp2(it.sink2 - it.M2)) : 1.0f / l; }
    bf16_t* yp = Y + (size_t)(it.qrow0 + 32 * w + lq) * DM + it.ycol + 4 * h;
    if (NC == 1) {
#pragma unroll
        for (int dt = 0; dt < 2; ++dt)
#pragma unroll
            for (int g = 0; g < 4; ++g) { u32x2 wv; wv.x = pg8::cvt_pk_bf16(O[0][dt][4 * g] * linv[0], O[0][dt][4 * g + 1] * linv[0]); wv.y = pg8::cvt_pk_bf16(O[0][dt][4 * g + 2] * linv[0], O[0][dt][4 * g + 3] * linv[0]);
                *(u32x2*)(yp + 32 * dt + 8 * g) = wv; }
    } else {
        const float a1 = it.lam * linv[NC - 1];
        float ss = 0.f;
#pragma unroll
        for (int dt = 0; dt < 2; ++dt)
#pragma unroll
            for (int r = 0; r < 16; ++r) { const float v = O[0][dt][r] * linv[0] - a1 * O[NC - 1][dt][r]; O[0][dt][r] = v; ss += v * v; }
        ss += __shfl_xor(ss, 32);
        const float rinv = rsqrtf(ss * (1.0f / 64.0f) + EPSF) * it.postscale;
        const float* sg = it.subgain + 4 * h;
#pragma unroll
        for (int dt = 0; dt < 2; ++dt)
#pragma unroll
            for (int g = 0; g < 4; ++g) { const float4 gg = *(const float4*)(sg + 32 * dt + 8 * g);
                u32x2 wv; wv.x = pg8::cvt_pk_bf16(O[0][dt][4 * g] * rinv * gg.x, O[0][dt][4 * g + 1] * rinv * gg.y); wv.y = pg8::cvt_pk_bf16(O[0][dt][4 * g + 2] * rinv * gg.z, O[0][dt][4 * g + 3] * rinv * gg.w);
                *(u32x2*)(yp + 32 * dt + 8 * g) = wv; }
    }
}


#define FD_RING 4
__device__ __forceinline__ void fattn_d_item(const bf16_t* __restrict__ P, bf16_t* __restrict__ Y, const AttnItem& it, unsigned char* smem) {
    const int tid = my_tid(), lane = tid & 63, w = tid >> 6, h = lane >> 5, lq = lane & 31;
    bf16_t* ring = (bf16_t*)smem;
    const LAS unsigned char* rlds = (const LAS unsigned char*)smem;
    constexpr int TB = 64 * FA_LD * 2;
    bf16x8 qf[2][2];
    { const bf16_t* qp = P + (size_t)(it.qrow0 + 32 * w + lq) * PW + it.qcol + 8 * h;
#pragma unroll
      for (int c = 0; c < 2; ++c)
#pragma unroll
          for (int s = 0; s < 2; ++s) qf[c][s] = *(const bf16x8*)(qp + 32 * c + 16 * s); }
    f32x16 O[2][2]; float lsum[2] = {0.f, 0.f};
#pragma unroll
    for (int c = 0; c < 2; ++c)
#pragma unroll
        for (int dt = 0; dt < 2; ++dt)
#pragma unroll
            for (int r = 0; r < 16; ++r) O[c][dt][r] = 0.f;
    const int ntot = it.nt0 + it.nt1;
    const int ldkey = tid >> 3, ldch = tid & 7;
    const int vlane = ((4 * h + ((lane & 15) >> 2)) * FA_LD + 16 * ((lane >> 4) & 1) + 4 * (lane & 3)) * 2;
    const int klane = (lq * FA_LD + 8 * h) * 2;
#define FD_TROW(k) ((k) < it.nt0 ? it.krow0 + 64 * (k) : it.krow1 + 64 * ((k) - it.nt0))
#define FD_GLOAD(k) do { const bf16_t* kp_ = P + (size_t)(FD_TROW(k) + ldkey) * PW; kreg = *(const u32x4*)(kp_ + it.kcol + ldch * 8); vreg = *(const u32x4*)(kp_ + it.vcol + ldch * 8); } while (0)
#define FD_LSTORE(k) do { bf16_t* d_ = ring + (size_t)((k) & (FD_RING - 1)) * 2 * 64 * FA_LD + ldkey * FA_LD + ldch * 8; *(u32x4*)d_ = kreg; *(u32x4*)(d_ + 64 * FA_LD) = vreg; } while (0)
    u32x4 kreg, vreg;
    __syncthreads();
    FD_GLOAD(0); FD_LSTORE(0);
    if (ntot > 1) { FD_GLOAD(1); FD_LSTORE(1); }
    __syncthreads();
    f32x16 zero16;
#pragma unroll
    for (int r = 0; r < 16; ++r) zero16[r] = 0.f;
    f32x16 SS[2];
    { const LAS unsigned char* kb = rlds + klane;
      SS[0] = __builtin_amdgcn_mfma_f32_32x32x16_bf16(*(const LAS bf16x8*)(kb), qf[0][0], zero16, 0, 0, 0);
      SS[0] = __builtin_amdgcn_mfma_f32_32x32x16_bf16(*(const LAS bf16x8*)(kb + 32), qf[0][1], SS[0], 0, 0, 0); }
    unsigned pkp[2][4];
#pragma unroll
    for (int s = 0; s < 2; ++s)
#pragma unroll
        for (int j = 0; j < 4; ++j) pkp[s][j] = 0u;
    for (int kt = 0; kt < ntot; ++kt) {
        if (kt + 2 < ntot) FD_GLOAD(kt + 2);
        const LAS unsigned char* cb = rlds + (size_t)(kt & (FD_RING - 1)) * 2 * TB;
        const LAS unsigned char* nb = rlds + (size_t)((kt + 1) & (FD_RING - 1)) * 2 * TB;
        const LAS unsigned char* pb = rlds + (size_t)((kt + FD_RING - 1) & (FD_RING - 1)) * 2 * TB;
#pragma unroll
        for (int u = 0; u < 4; ++u) {
            const int c = u & 1;
            const int nsub = ((u + 1) & 3) >> 1, nc = (u + 1) & 1;
            const int psub = ((u + 3) & 3) >> 1, pc = (u + 3) & 1;
            const LAS unsigned char* ka = ((u < 3) ? cb : nb) + klane + (32 * nsub) * FA_LD * 2 + 64 * nc;
            const LAS unsigned char* va = ((u > 0) ? cb : pb) + TB + vlane + (32 * psub) * FA_LD * 2;
            const bf16x8 kf0 = *(const LAS bf16x8*)(ka), kf1 = *(const LAS bf16x8*)(ka + 32);
            bf16x8 vf[2][2];
#pragma unroll
            for (int s = 0; s < 2; ++s)
#pragma unroll
                for (int dt = 0; dt < 2; ++dt) { const s16x4 lo = tr_read(va + (16 * s) * FA_LD * 2 + 64 * dt), hi = tr_read(va + (16 * s + 8) * FA_LD * 2 + 64 * dt);
                    vf[s][dt] = __builtin_shufflevector(lo, hi, 0, 1, 2, 3, 4, 5, 6, 7); }
            __builtin_amdgcn_sched_barrier(0);
            f32x16& Sc = SS[u & 1]; f32x16& Sn = SS[(u + 1) & 1];
            unsigned pkc[2][4];
#pragma unroll
            for (int s = 0; s < 2; ++s) {
                float pv[8];
#pragma unroll
                for (int j = 0; j < 8; ++j) pv[j] = fast_exp2(Sc[8 * s + j]);
                lsum[c] += ((pv[0] + pv[1]) + (pv[2] + pv[3])) + ((pv[4] + pv[5]) + (pv[6] + pv[7]));
#pragma unroll
                for (int jj = 0; jj < 4; ++jj) pkc[s][jj] = pg8::cvt_pk_bf16(pv[2 * jj], pv[2 * jj + 1]);
            }
            if ((u < 3) || (kt + 1 < ntot)) {
                Sn = __builtin_amdgcn_mfma_f32_32x32x16_bf16(kf0, qf[nc][0], zero16, 0, 0, 0);
                Sn = __builtin_amdgcn_mfma_f32_32x32x16_bf16(kf1, qf[nc][1], Sn, 0, 0, 0); }
            if ((u > 0) || (kt > 0)) {
#pragma unroll
                for (int s = 0; s < 2; ++s) { u32x4 bw; bw.x = pkp[s][0]; bw.y = pkp[s][1]; bw.z = pkp[s][2]; bw.w = pkp[s][3];
#pragma unroll
                    for (int dt = 0; dt < 2; ++dt) O[pc][dt] = __builtin_amdgcn_mfma_f32_32x32x16_bf16(vf[s][dt], __builtin_bit_cast(bf16x8, bw), O[pc][dt], 0, 0, 0); } }
            __builtin_amdgcn_sched_group_barrier(0x2, 5, 0);
#pragma unroll
            for (int g = 0; g < 6; ++g) { __builtin_amdgcn_sched_group_barrier(0x8, 1, 0); __builtin_amdgcn_sched_group_barrier(0x2, 5, 0); }
            __builtin_amdgcn_sched_barrier(0);
#pragma unroll
            for (int s = 0; s < 2; ++s)
#pragma unroll
                for (int j = 0; j < 4; ++j) pkp[s][j] = pkc[s][j];
        }
        if (kt + 2 < ntot) FD_LSTORE(kt + 2);
        __syncthreads();
    }
    { const LAS unsigned char* va = rlds + (size_t)((ntot - 1) & (FD_RING - 1)) * 2 * TB + TB + vlane + 32 * FA_LD * 2;
#pragma unroll
      for (int s = 0; s < 2; ++s) { u32x4 bw; bw.x = pkp[s][0]; bw.y = pkp[s][1]; bw.z = pkp[s][2]; bw.w = pkp[s][3];
#pragma unroll
          for (int dt = 0; dt < 2; ++dt) {
              const s16x4 lo = tr_read(va + (16 * s) * FA_LD * 2 + 64 * dt), hi = tr_read(va + (16 * s + 8) * FA_LD * 2 + 64 * dt);
              const bf16x8 a = __builtin_shufflevector(lo, hi, 0, 1, 2, 3, 4, 5, 6, 7);
              O[1][dt] = __builtin_amdgcn_mfma_f32_32x32x16_bf16(a, __builtin_bit_cast(bf16x8, bw), O[1][dt], 0, 0, 0); } } }
#undef FD_TROW
#undef FD_GLOAD
#undef FD_LSTORE
    float linv[2];
#pragma unroll
    for (int c = 0; c < 2; ++c) { const float l = lsum[c] + __shfl_xor(lsum[c], 32); linv[c] = 1.0f / l; }
    bf16_t* yp = Y + (size_t)(it.qrow0 + 32 * w + lq) * DM + it.ycol + 4 * h;
    const float a1 = it.lam * linv[1];
    float ss = 0.f;
#pragma unroll
    for (int dt = 0; dt < 2; ++dt)
#pragma unroll
        for (int r = 0; r < 16; ++r) { const float v = O[0][dt][r] * linv[0] - a1 * O[1][dt][r]; O[0][dt][r] = v; ss += v * v; }
    ss += __shfl_xor(ss, 32);
    const float rinv = rsqrtf(ss * (1.0f / 64.0f) + EPSF) * it.postscale;
    const float* sg = it.subgain + 4 * h;
#pragma unroll
    for (int dt = 0; dt < 2; ++dt)
#pragma unroll
        for (int g = 0; g < 4; ++g) { const float4 gg = *(const float4*)(sg + 32 * dt + 8 * g);
            u32x2 wv; wv.x = pg8::cvt_pk_bf16(O[0][dt][4 * g] * rinv * gg.x, O[0][dt][4 * g + 1] * rinv * gg.y); wv.y = pg8::cvt_pk_bf16(O[0][dt][4 * g + 2] * rinv * gg.z, O[0][dt][4 * g + 3] * rinv * gg.w);
            *(u32x2*)(yp + 32 * dt + 8 * g) = wv; }
}

__device__ __forceinline__ float max_abs_vec(const float* g, int n) { float m = 0.f; for (int i = 0; i < n; ++i) m = fmaxf(m, fabsf(g[i])); return m; }

__device__ __forceinline__ int attn_item_remap(int x0, int G) {
    if (G != 256 || x0 >= 1024) return x0;
    const int i = x0 >> 8, bid = x0 & 255, xcd = bid & 7, slot = bid >> 3;
    const int bh = i * 16 + xcd * 2 + (slot >> 4), n = slot & 15;
    return bh * 16 + n;
}
__device__ __forceinline__ void phase_attnA(const Params& p, int l, unsigned char* smem) {
    unsigned char* ws = launder_ws(p.ws);
    const bf16_t* P = (const bf16_t*)(ws + WS_P); bf16_t* Y = (bf16_t*)(ws + WS_U);
    const float bound = 8.0f * LOG2E * 1.02f * max_abs_vec(PIN(I_AQN) + l * 64, 64) * max_abs_vec(PIN(I_AKN) + l * 64, 64);
    const int nitems = (l == DEPTH - 1) ? 1024 : 1088;
    const int cshift = (gridDim.x == 256) ? 64 : 0;
    for (int x0 = blockIdx.x; x0 < nitems + cshift; x0 += gridDim.x) {
        if (x0 >= 1024 && x0 < 1024 + cshift) continue;
        const int x = attn_item_remap(x0 >= 1024 ? x0 - cshift : x0, gridDim.x);
        AttnItem it; it.subgain = nullptr; it.lam = 0.f; it.postscale = 1.f;
        int b, h, n;
        if (x < 1024) { b = x >> 6; h = (x >> 4) & 3; n = x & 15;
            const int lo = max(0, 256 * n - 128), hi = min(TL, 256 * n + 384);
            it.qrow0 = b * TL + 256 * n; it.qpos0 = 256 * n; it.nt0 = (hi - lo) >> 6; it.krow0 = b * TL + lo; it.kpos0 = lo; it.masked = 1; }
        else { const int y = x - 1024; b = y >> 2; h = y & 3;
            it.qrow0 = NROWL + b * TCX; it.qpos0 = 0; it.nt0 = 0; it.krow0 = 0; it.kpos0 = 0; it.masked = 0; }
        it.nt1 = 4; it.krow1 = NROWL + b * TCX;
        it.qcol = h * 64; it.kcol = 256 + (h >> 1) * 64; it.vcol = 384 + (h >> 1) * 64; it.ycol = h * 64;
        it.sink2 = PIN(I_ASINK)[l * 4 + h] * LOG2E; it.M2 = fmaxf(bound, it.sink2);
        fattn_item<1>(P, Y, it, smem);
    }
}
__device__ __forceinline__ void phase_attnD(const Params& p, int l, unsigned char* smem) {
    unsigned char* ws = launder_ws(p.ws);
    const bf16_t* P = (const bf16_t*)(ws + WS_P); bf16_t* Y = (bf16_t*)(ws + WS_U);
    const float bound = 5.656854249f * LOG2E * 1.02f * max_abs_vec(PIN(I_DQN) + l * 32, 32) * max_abs_vec(PIN(I_DKN) + l * 32, 32);
    float d1 = 0.f, d2 = 0.f;
    for (int i = 0; i < 32; ++i) { d1 += PIN(I_LQ1)[l * 32 + i] * PIN(I_LK1)[l * 32 + i]; d2 += PIN(I_LQ2)[l * 32 + i] * PIN(I_LK2)[l * 32 + i]; }
    const float lam_init = 0.8f - 0.6f * expf(-0.3f * (float)l);
    const float lam = expf(d1) - expf(d2) + lam_init;
    const int nitems = (l == DEPTH - 1) ? 1024 : 1088;
    for (int x0 = blockIdx.x; x0 < nitems; x0 += gridDim.x) {
        const int x = attn_item_remap(x0, gridDim.x);
        AttnItem it; it.subgain = PIN(I_DSUB) + l * 64; it.lam = lam; it.postscale = 1.0f - lam_init; it.sink2 = 0.f; it.M2 = bound;
        int b, h, n;
        if (x < 1024) { b = x >> 6; h = (x >> 4) & 3; n = x & 15;
            it.qrow0 = b * TL + 256 * n; it.qpos0 = 0; it.nt0 = 64; it.krow0 = b * TL; it.kpos0 = 0; it.masked = 0; }
        else { const int y = x - 1024; b = y >> 2; h = y & 3;
            it.qrow0 = NROWL + b * TCX; it.qpos0 = 0; it.nt0 = 0; it.krow0 = 0; it.kpos0 = 0; it.masked = 0; }
        it.nt1 = 4; it.krow1 = NROWL + b * TCX;
        it.qcol = 1536 + h * 64; it.kcol = 1792 + h * 64; it.vcol = 2048 + h * 64; it.ycol = 768 + h * 64;
        if (bound < 100.0f) fattn_d_item(P, Y, it, smem); else fattn_item<2>(P, Y, it, smem);
    }
}

#define HY_ZROWS 4160
#define HY_FLEN 8256
#define HY_OFF_F (HY_ZROWS * 32)
#define HY_OFF_MISC (HY_OFF_F + HY_FLEN * 2)

__device__ __forceinline__ void hy_kloop(const LAS unsigned char* zs, const LAS bf16_t* fs, int w, int lane, f32x4 (&acc)[4][8]) {
    const int i = lane & 15, q = lane >> 4, qq = (lane & 15) >> 2, pp = lane & 3;
    const LAS bf16_t* ap = fs + (4096 - 512 * w + 8 * q - 8 * i);
    const LAS unsigned char* bp = zs + (8 * q + qq) * 32 + pp * 8;
    bf16x8 an[4];
#pragma unroll
    for (int m = 0; m < 4; ++m) an[m] = *(const LAS bf16x8*)(ap - 128 * m);
#pragma unroll 1
    for (int ks = 0; ks < 129; ++ks) {
        bf16x8 a[4];
#pragma unroll
        for (int m = 0; m < 4; ++m) a[m] = an[m];
#pragma unroll
        for (int m = 0; m < 4; ++m) an[m] = *(const LAS bf16x8*)(ap + 32 * (ks + 1) - 128 * m);
#pragma unroll
        for (int r = 0; r < 8; ++r) {
            const s16x4 lo = tr_read(bp + (32 * ks + r) * 32), hi = tr_read(bp + (32 * ks + r) * 32 + 128);
            const bf16x8 b = __builtin_shufflevector(lo, hi, 0, 1, 2, 3, 4, 5, 6, 7);
#pragma unroll
            for (int m = 0; m < 4; ++m) acc[m][r] = __builtin_amdgcn_mfma_f32_16x16x32_bf16(a[m], b, acc[m][r], 0, 0, 0);
        }
    }
}
#define HYC_OFF_Z 4096
#define HYC_ZROWS 304
#define HYC_OFF_F (HYC_OFF_Z + HYC_ZROWS * 32)
#define HYC_FLEN 576
__device__ __forceinline__ void hy_ckloop(const LAS unsigned char* zs, const LAS bf16_t* fs, int r, int lane, f32x4 (&acc)[2]) {
    const int i = lane & 15, q = lane >> 4, qq = (lane & 15) >> 2, pp = lane & 3;
    const LAS bf16_t* ap = fs + (256 + 8 * q - 8 * i);
    const LAS unsigned char* bp = zs + (8 * q + qq + r) * 32 + pp * 8;
#pragma unroll
    for (int ks = 0; ks < 9; ++ks) {
        const s16x4 lo = tr_read(bp + (32 * ks) * 32), hi = tr_read(bp + (32 * ks) * 32 + 128);
        const bf16x8 b = __builtin_shufflevector(lo, hi, 0, 1, 2, 3, 4, 5, 6, 7);
#pragma unroll
        for (int m = 0; m < 2; ++m) { const bf16x8 a = *(const LAS bf16x8*)(ap + 32 * ks - 128 * m); acc[m] = __builtin_amdgcn_mfma_f32_16x16x32_bf16(a, b, acc[m], 0, 0, 0); }
    }
}
__device__ __forceinline__ float hy_sconv(const bf16_t* u, int t, int T, float c0, float c1, float c2) {
    const int tm = t > 0 ? t - 1 : 0, tp = t < T - 1 ? t + 1 : T - 1;
    const float um = bf2f(u[tm]), u0 = bf2f(u[t]), up = bf2f(u[tp]);
    return (t > 0 ? c0 : 0.f) * um + c1 * u0 + (t < T - 1 ? c2 : 0.f) * up;
}
__device__ __forceinline__ void hy_gate8(const bf16_t* ub  , int t0, float c0, float c1, float c2, float (&g)[8]) {
    const u32x4 raw = *(const u32x4*)ub; const float hl = bf2f(ub[-1]), hr = bf2f(ub[8]);
    float x[10];
    x[0] = t0 > 0 ? hl : 0.f; x[9] = t0 + 8 < 4096 ? hr : 0.f;
    x[1] = bflo(raw.x); x[2] = bfhi(raw.x); x[3] = bflo(raw.y); x[4] = bfhi(raw.y); x[5] = bflo(raw.z); x[6] = bfhi(raw.z); x[7] = bflo(raw.w); x[8] = bfhi(raw.w);
#pragma unroll
    for (int e = 0; e < 8; ++e) g[e] = c0 * x[e] + c1 * x[e + 1] + c2 * x[e + 2];
}
__device__ __forceinline__ float block_sum(float v, float* red  ) {
    v = wave_sum(v);
    __syncthreads();
    if ((my_tid() & 63) == 0) red[my_tid() >> 6] = v;
    __syncthreads();
    float s = 0.f;
#pragma unroll
    for (int w = 0; w < 8; ++w) s += red[w];
    return s;
}

#if defined(PROBE_KIND) && PROBE_KIND == 6
#define HY_STAMP(k) do { if (blockIdx.x == 0 && my_tid() == 0) { volatile unsigned* pw_ = (volatile unsigned*)(smem + LDS_BYTES - 48); const unsigned t_ = (unsigned)wall_clock64(); \
        if ((k) >= 0 && ((PROBE_MASK >> ((k) < 0 ? 0 : (k))) & 1)) pw_[2] += t_ - pw_[5]; pw_[5] = t_; } } while (0)
#else
#define HY_STAMP(k) do {} while (0)
#endif
__device__ __forceinline__ void phase_hyena(const Params& p, int l, unsigned char* smem) {
    unsigned char* ws = launder_ws(p.ws);
    LAS unsigned char* lds = (LAS unsigned char*)smem;
    bf16_t* Zs = (bf16_t*)smem; bf16_t* Fs = (bf16_t*)(smem + HY_OFF_F);
    float* fw3c = (float*)(smem + HY_OFF_MISC);
    float* red = fw3c + 256;
    float* HT = (float*)smem;
    const bf16_t* UT = (const bf16_t*)(ws + WS_UT);
    bf16_t* YT = (bf16_t*)(ws + WS_YT);
    const float* H2L = (const float*)(ws + WS_HID2L); const float* H2C = (const float*)(ws + WS_HID2C);
    const float* fw3 = PIN(I_FW3) + (size_t)l * 64 * 1024;
    const float* cw = PIN(I_HYCONV) + (size_t)l * 3 * 768;
    const float da = logf(1e-2f) / 1.5f, db = logf(1e-2f) / 0.3f;
    for (int c = blockIdx.x; c < 256; c += gridDim.x) {
        const int tid = my_tid(), lane = tid & 63, w = tid >> 6;
        bf16_t* FB = (bf16_t*)(ws + WS_FBUF) + (size_t)c * HY_FLEN;
        const float delta = fabsf(da + (float)c * ((db - da) / 255.0f));
        const float bias0 = PIN(I_HYBIAS)[l * 512 + c], bias1 = PIN(I_HYBIAS)[l * 512 + 256 + c];
        __syncthreads();
        if (tid < 256) fw3c[tid] = fw3[(size_t)(tid & 63) * 1024 + (tid >> 6) * 256 + c];
        __syncthreads();
        HY_STAMP(-1);
        float ss0 = 0.f, ss1 = 0.f;
#pragma unroll 1
        for (int lag = tid; lag < 4096; lag += NTHR) {
            float a0 = 0.f, a1 = 0.f, a2 = 0.f, a3 = 0.f;
            float hv[64];
#pragma unroll
            for (int k = 0; k < 64; ++k) hv[k] = H2L[(size_t)k * 4096 + lag];
#pragma unroll
            for (int k = 0; k < 64; ++k) { const float h = hv[k]; a0 += h * fw3c[k]; a1 += h * fw3c[64 + k]; a2 += h * fw3c[128 + k]; a3 += h * fw3c[192 + k]; }
            const float dec = expf(-((float)lag / 4095.0f) * delta);
            a0 *= dec; a1 *= dec; a2 *= dec; a3 *= dec;
            HT[lag] = a0; HT[4096 + lag] = a1; HT[8192 + lag] = a2; HT[12288 + lag] = a3;
            ss0 += a0 * a0 + (lag >= 1 ? a2 * a2 : 0.f); ss1 += a1 * a1 + (lag >= 1 ? a3 * a3 : 0.f);
        }
        ss0 = block_sum(ss0, red); ss1 = block_sum(ss1, red);
        const float n0 = rsqrtf(ss0 + EPSF), n1 = rsqrtf(ss1 + EPSF);
#pragma unroll 1
        for (int x = tid; x < HY_FLEN; x += NTHR) { const int d = 4128 - x; float f0 = 0.f, f1 = 0.f;
            if (d >= 0 && d <= 4095) { f0 = HT[d] * n0; f1 = HT[4096 + d] * n1; } else if (d < 0 && d >= -4095) { f0 = HT[8192 - d] * n0; f1 = HT[12288 - d] * n1; }
            Fs[x] = f2bf(f0); FB[x] = f2bf(f1); }
        __syncthreads();
        HY_STAMP(0);
        for (int idx = tid; idx < 1024; idx += NTHR) { const int rr = idx >> 4; Zs[(rr < 32 ? rr : 4096 + rr) * 16 + (idx & 15)] = 0; }
        { const bf16_t* u = UT + (size_t)c * NROW; const float v0 = cw[c], v1 = cw[768 + c], v2 = cw[1536 + c];
#pragma unroll 4
          for (int idx = tid; idx < 8192; idx += NTHR) { const int b = idx >> 9, t0 = (idx & 511) * 8;
              float g[8]; hy_gate8(u + b * 4096 + t0, t0, v0, v1, v2, g);
#pragma unroll
              for (int i = 0; i < 8; ++i) Zs[(t0 + i + 32) * 16 + b] = f2bf(g[i]); } }
        __syncthreads();
        HY_STAMP(1);
        f32x4 acc[4][8];
#pragma unroll
        for (int m = 0; m < 4; ++m)
#pragma unroll
            for (int r = 0; r < 8; ++r) acc[m][r] = (f32x4){0.f, 0.f, 0.f, 0.f};
        hy_kloop(lds, (const LAS bf16_t*)(lds + HY_OFF_F), w, lane, acc);
        HY_STAMP(2);
        { int lo = lane, wo = w; asm volatile("" : "+v"(lo), "+v"(wo));
          const float g0 = cw[256 + c], g1 = cw[768 + 256 + c], g2 = cw[1536 + 256 + c];
          const int tb0 = 512 * wo + 32 * (lo >> 4);
          const bf16_t* u1 = UT + (size_t)(256 + c) * NROW + (lo & 15) * 4096 + tb0;
          const bf16_t* zp = Zs + (tb0 + 32) * 16 + (lo & 15);
#pragma unroll
          for (int m = 0; m < 4; ++m)
#pragma unroll
              for (int j = 0; j < 4; ++j) { float g[8]; hy_gate8(u1 + 128 * m + 8 * j, tb0 + 128 * m + 8 * j, g0, g1, g2, g);
#pragma unroll
                  for (int r = 0; r < 8; ++r) { const float z = bf2f(zp[(128 * m + r + 8 * j) * 16]); acc[m][r][j] = g[r] * (acc[m][r][j] + bias0 * z); }
                  asm volatile("" ::: "memory"); } }
        __syncthreads();
        { int lo = lane, wo = w; asm volatile("" : "+v"(lo), "+v"(wo));
          bf16_t* zp = Zs + (512 * wo + 32 * (lo >> 4) + 32) * 16 + (lo & 15);
#pragma unroll
          for (int m = 0; m < 4; ++m)
#pragma unroll
              for (int r = 0; r < 8; ++r) {
#pragma unroll
                  for (int j = 0; j < 4; ++j) zp[(128 * m + r + 8 * j) * 16] = f2bf(acc[m][r][j]);
                  asm volatile("" ::: "memory"); } }
        for (int x = tid; x < HY_FLEN / 8; x += NTHR) ((u32x4*)Fs)[x] = ((const u32x4*)FB)[x];
        __syncthreads();
        HY_STAMP(3);
#pragma unroll
        for (int m = 0; m < 4; ++m)
#pragma unroll
            for (int r = 0; r < 8; ++r) acc[m][r] = (f32x4){0.f, 0.f, 0.f, 0.f};
        hy_kloop(lds, (const LAS bf16_t*)(lds + HY_OFF_F), w, lane, acc);
        HY_STAMP(4);
        { int lo = lane, wo = w; asm volatile("" : "+v"(lo), "+v"(wo));
          const float e0 = cw[512 + c], e1 = cw[768 + 512 + c], e2 = cw[1536 + 512 + c];
          const int tb0 = 512 * wo + 32 * (lo >> 4);
          const bf16_t* u2 = UT + (size_t)(512 + c) * NROW + (lo & 15) * 4096 + tb0;
          bf16_t* yo = YT + (size_t)c * NROW + (lo & 15) * 4096 + tb0;
          const bf16_t* zp = Zs + (tb0 + 32) * 16 + (lo & 15);
#pragma unroll
          for (int m = 0; m < 4; ++m)
#pragma unroll
              for (int j = 0; j < 4; ++j) { float g[8]; hy_gate8(u2 + 128 * m + 8 * j, tb0 + 128 * m + 8 * j, e0, e1, e2, g);
#pragma unroll
                  for (int r = 0; r < 8; ++r) { const float z1 = bf2f(zp[(128 * m + r + 8 * j) * 16]); g[r] = g[r] * (acc[m][r][j] + bias1 * z1); }
                  u32x4 o; o.x = pack_bf16(g[0], g[1]); o.y = pack_bf16(g[2], g[3]); o.z = pack_bf16(g[4], g[5]); o.w = pack_bf16(g[6], g[7]);
                  *(u32x4*)(yo + 128 * m + 8 * j) = o;
                  asm volatile("" ::: "memory"); } }
        __syncthreads();
        HY_STAMP(5);
        if (l < DEPTH - 1) {   float* HTc = (float*)smem;
            bf16_t* Zc = (bf16_t*)(smem + HYC_OFF_Z);
            bf16_t* Fc0 = (bf16_t*)(smem + HYC_OFF_F); bf16_t* Fc1 = Fc0 + HYC_FLEN;
            float* part = (float*)(smem + HYC_OFF_Z);
            float t0 = 0.f, t1 = 0.f;
            { const int lag = tid & 255, kh = tid >> 8; float a0 = 0.f, a1 = 0.f, a2 = 0.f, a3 = 0.f;
              float hv[32];
#pragma unroll
              for (int k = 0; k < 32; ++k) hv[k] = H2C[(size_t)(32 * kh + k) * 256 + lag];
#pragma unroll
              for (int k = 0; k < 32; ++k) { const float h = hv[k]; const int kk = 32 * kh + k; a0 += h * fw3c[kk]; a1 += h * fw3c[64 + kk]; a2 += h * fw3c[128 + kk]; a3 += h * fw3c[192 + kk]; }
              if (kh == 1) { part[lag] = a0; part[256 + lag] = a1; part[512 + lag] = a2; part[768 + lag] = a3; }
              __syncthreads();
              if (kh == 0) { a0 += part[lag]; a1 += part[256 + lag]; a2 += part[512 + lag]; a3 += part[768 + lag];
                const float dec = expf(-((float)lag / 255.0f) * delta);
                a0 *= dec; a1 *= dec; a2 *= dec; a3 *= dec;
                HTc[lag] = a0; HTc[256 + lag] = a1; HTc[512 + lag] = a2; HTc[768 + lag] = a3;
                t0 = a0 * a0 + (lag >= 1 ? a2 * a2 : 0.f); t1 = a1 * a1 + (lag >= 1 ? a3 * a3 : 0.f); } }
            t0 = block_sum(t0, red); t1 = block_sum(t1, red);
            const float m0 = rsqrtf(t0 + EPSF), m1 = rsqrtf(t1 + EPSF);
            for (int x = tid; x < 2 * HYC_FLEN; x += NTHR) { const int o = x >= HYC_FLEN ? 1 : 0, xx = x - o * HYC_FLEN, d = 288 - xx; float f = 0.f;
                if (d >= 0 && d <= 255) f = HTc[256 * o + d]; else if (d < 0 && d >= -255) f = HTc[512 + 256 * o - d];
                Fc0[x] = f2bf(f * (o ? m1 : m0)); }
            { const bf16_t* uc = UT + (size_t)c * NROW + NROWL; const float v0 = cw[c], v1 = cw[768 + c], v2 = cw[1536 + c];
              for (int idx = tid; idx < 768; idx += NTHR) { const int rr = idx >> 4; Zc[(rr < 32 ? rr : 256 + rr) * 16 + (idx & 15)] = 0; }
#pragma unroll 2
              for (int idx = tid; idx < 4096; idx += NTHR) { const int b = idx >> 8, t = idx & 255; Zc[(t + 32) * 16 + b] = f2bf(hy_sconv(uc + b * 256, t, 256, v0, v1, v2)); } }
            __syncthreads();
            f32x4 ca[2];
            ca[0] = (f32x4){0.f, 0.f, 0.f, 0.f}; ca[1] = ca[0];
            hy_ckloop(lds + HYC_OFF_Z, (const LAS bf16_t*)(lds + HYC_OFF_F), w, lane, ca);
            { const float g0 = cw[256 + c], g1 = cw[768 + 256 + c], g2 = cw[1536 + 256 + c];
              const bf16_t* u1c = UT + (size_t)(256 + c) * NROW + NROWL + (lane & 15) * 256;
#pragma unroll
              for (int m = 0; m < 2; ++m)
#pragma unroll
                  for (int j = 0; j < 4; ++j) { const int t = 128 * m + w + 32 * (lane >> 4) + 8 * j;
                      const float z = bf2f(Zc[(t + 32) * 16 + (lane & 15)]);
                      ca[m][j] = hy_sconv(u1c, t, 256, g0, g1, g2) * (ca[m][j] + bias0 * z); } }
            __syncthreads();
#pragma unroll
            for (int m = 0; m < 2; ++m)
#pragma unroll
                for (int j = 0; j < 4; ++j) { const int t = 128 * m + w + 32 * (lane >> 4) + 8 * j; Zc[(t + 32) * 16 + (lane & 15)] = f2bf(ca[m][j]); }
            __syncthreads();
            ca[0] = (f32x4){0.f, 0.f, 0.f, 0.f}; ca[1] = ca[0];
            hy_ckloop(lds + HYC_OFF_Z, (const LAS bf16_t*)(lds + HYC_OFF_F + 2 * HYC_FLEN), w, lane, ca);
            { const float e0 = cw[512 + c], e1 = cw[768 + 512 + c], e2 = cw[1536 + 512 + c];
              const bf16_t* u2c = UT + (size_t)(512 + c) * NROW + NROWL + (lane & 15) * 256;
              bf16_t* yo = YT + (size_t)c * NROW + NROWL + (lane & 15) * 256;
#pragma unroll
              for (int m = 0; m < 2; ++m)
#pragma unroll
                  for (int j = 0; j < 4; ++j) { const int t = 128 * m + w + 32 * (lane >> 4) + 8 * j;
                      const float z1 = bf2f(Zc[(t + 32) * 16 + (lane & 15)]);
                      yo[t] = f2bf(hy_sconv(u2c, t, 256, e0, e1, e2) * (ca[m][j] + bias1 * z1)); } }
            __syncthreads();
        }
        HY_STAMP(6);
    }
}

__device__ __forceinline__ void phase_hy_transpose(const Params& p, int l, unsigned char* smem) {
    unsigned char* ws = launder_ws(p.ws);
    const bf16_t* YT = (const bf16_t*)(ws + WS_YT); bf16_t* Y = (bf16_t*)(ws + WS_U);
    bf16_t* tile = (bf16_t*)smem;
    const int tid = my_tid();
    const int ntile = 4 * ((l == DEPTH - 1 ? NROWL : NROW) / 64);
    for (int it = blockIdx.x; it < ntile; it += gridDim.x) {
        const int ct = it & 3, rt = it >> 2;
        __syncthreads();
        { const int ch = tid >> 3, seg = tid & 7;
          const u32x4 v = *(const u32x4*)(YT + (size_t)(ct * 64 + ch) * NROW + rt * 64 + seg * 8);
          unsigned* d = (unsigned*)(tile + ch * 66 + seg * 8); d[0] = v.x; d[1] = v.y; d[2] = v.z; d[3] = v.w; }
        __syncthreads();
        { const int r = tid >> 3, seg = tid & 7;
          unsigned wv[4];
#pragma unroll
          for (int k = 0; k < 4; ++k) wv[k] = (unsigned)tile[(seg * 8 + 2 * k) * 66 + r] | ((unsigned)tile[(seg * 8 + 2 * k + 1) * 66 + r] << 16);
          u32x4 o; o.x = wv[0]; o.y = wv[1]; o.z = wv[2]; o.w = wv[3];
          *(u32x4*)(Y + (size_t)(rt * 64 + r) * DM + 256 + ct * 64 + seg * 8) = o; }
    }
    __syncthreads();
}
#define ML_ITEMS 4352
__device__ __forceinline__ void ml_decode(int it, int& b, int& head, int& tc, int& tok0, int& jf, int& jb) {
    b = it / 272; const int r = it - b * 272; head = r / 68; tc = r - head * 68;
    tok0 = tc < 4 ? NROWL + b * TCX + 64 * tc : b * TL + 64 * (tc - 4);
    jf = tc; jb = tc < 4 ? 3 - tc : 71 - tc;
}

__device__ __forceinline__ void phase_ml_local(const Params& p, int l, unsigned char* smem) {
    unsigned char* ws = launder_ws(p.ws);
    const int tid = my_tid(), lane = tid & 63, w = tid >> 6;
    bf16_t* Kt = (bf16_t*)smem;
    bf16_t* VwF = Kt + 64 * 72;
    bf16_t* VwB = VwF + 64 * 72;
    float* Vs = (float*)(VwB + 64 * 72);
    float* vec = Vs + 64 * 65;
    float* igf = vec, *igb = vec + 64, *lff = vec + 128, *lfb = vec + 192, *wf = vec + 256, *wb = vec + 320, *scal = vec + 384;
    const bf16_t* P = (const bf16_t*)(ws + WS_P);
    const float* GT = (const float*)(ws + WS_GATES);
    bf16_t* MLA = (bf16_t*)(ws + WS_MLA); float* MLN = (float*)(ws + WS_MLN); float* MLS = (float*)(ws + WS_MLS);
    const float* bg = PIN(I_BGATE) + l * 16;
    for (int it = blockIdx.x; it < ML_ITEMS; it += gridDim.x) {
        int b, head, tc, tok0, jf, jb; ml_decode(it, b, head, tc, tok0, jf, jb);
        __syncthreads();
        { const int s = tid >> 3, ch = tid & 7;
          const bf16_t* pr = P + (size_t)(tok0 + s) * PW + head * 64 + ch * 8;
          const u32x4 kv = *(const u32x4*)(pr + 768), vv = *(const u32x4*)(pr + 1024);
          const unsigned kw[4] = {kv.x, kv.y, kv.z, kv.w}, vw[4] = {vv.x, vv.y, vv.z, vv.w};
#pragma unroll
          for (int i = 0; i < 4; ++i) { Kt[(ch * 8 + 2 * i) * 72 + s] = f2bf(bflo(kw[i]) * 0.125f); Kt[(ch * 8 + 2 * i + 1) * 72 + s] = f2bf(bfhi(kw[i]) * 0.125f);
              Vs[s * 65 + ch * 8 + 2 * i] = bflo(vw[i]); Vs[s * 65 + ch * 8 + 2 * i + 1] = bfhi(vw[i]); } }
        if (tid < 64) { const float* g = GT + (size_t)(tok0 + tid) * 16;
            igf[tid] = g[head] + bg[head]; igb[tid] = g[4 + head] + bg[4 + head]; lff[tid] = log_sigmoid(g[8 + head] + bg[8 + head]); lfb[tid] = log_sigmoid(g[12 + head] + bg[12 + head]); }
        __syncthreads();
        if (tid < 128) {
            const int dirw = tid >> 6, tau = tid & 63, s = dirw ? 63 - tau : tau;
            const float lf = dirw ? lfb[s] : lff[s], ig = dirw ? igb[s] : igf[s];
            float cum = lf;
#pragma unroll
            for (int o = 1; o < 64; o <<= 1) { const float n = __shfl_up(cum, o); if (tau >= o) cum += n; }
            const float B = __shfl(cum, 63);
            const float ge = B - cum + ig;
            const float ml = wave_max(ge);
            (dirw ? wb : wf)[s] = expf(ge - ml);
            if (tau == 0) { scal[2 * dirw] = B; scal[2 * dirw + 1] = ml; } }
        __syncthreads();
        { const int e = tid >> 3, sc = (tid & 7) * 8; u32x4 a, c2; float x[8], y[8];
#pragma unroll
          for (int i = 0; i < 8; ++i) { const float v = Vs[(sc + i) * 65 + e]; x[i] = v * wf[sc + i]; y[i] = v * wb[sc + i]; }
          a.x = pack_bf16(x[0], x[1]); a.y = pack_bf16(x[2], x[3]); a.z = pack_bf16(x[4], x[5]); a.w = pack_bf16(x[6], x[7]);
          c2.x = pack_bf16(y[0], y[1]); c2.y = pack_bf16(y[2], y[3]); c2.z = pack_bf16(y[4], y[5]); c2.w = pack_bf16(y[6], y[7]);
          *(u32x4*)(VwF + e * 72 + sc) = a; *(u32x4*)(VwB + e * 72 + sc) = c2; }
        __syncthreads();
        const int dir = w >> 2, wl = w & 3, te = wl >> 1, tk = wl & 1;
        const int seq = (b * 4 + head) * 2 + dir, j = dir ? jb : jf;
        bf16_t* dst = MLA + ((size_t)seq * 68 + j) * 4096;
        { f32x16 C;
#pragma unroll
          for (int r = 0; r < 16; ++r) C[r] = 0.f;
          C = mma32((dir ? VwB : VwF) + 32 * te * 72, 72, Kt + 32 * tk * 72, 72, 64, C, lane);
#pragma unroll
          for (int r = 0; r < 16; ++r) dst[(32 * te + CROW(r, lane)) * 64 + 32 * tk + (lane & 31)] = f2bf(C[r]); }
        if (wl == 0) {
            const float* wv = dir ? wb : wf; float s = 0.f;
            for (int t = 0; t < 64; ++t) s += wv[t] * bf2f(Kt[lane * 72 + t]);
            MLN[((size_t)seq * 68 + j) * 64 + lane] = s;
            if (lane == 0) { MLS[((size_t)seq * 68 + j) * 4 + 0] = scal[2 * dir]; MLS[((size_t)seq * 68 + j) * 4 + 1] = scal[2 * dir + 1]; }
        }
    }
    __syncthreads();
}

__device__ __forceinline__ void phase_ml_scan(const Params& p) {
    unsigned char* ws = launder_ws(p.ws);
    const int tid = my_tid();
    unsigned* MLA = (unsigned*)(ws + WS_MLA); float* MLN = (float*)(ws + WS_MLN); float* MLS = (float*)(ws + WS_MLS);
    for (int it = blockIdx.x; it < 512; it += gridDim.x) {
        const int seq = it >> 2, part = it & 3;
        unsigned* base = MLA + (size_t)seq * 68 * 2048 + part * 512 + tid;
        float* nb = MLN + (size_t)seq * 68 * 64 + part * 16 + tid;
        float* sc = MLS + (size_t)seq * 68 * 4;
        const bool hasn = tid < 16;
        float m = 0.f, c0 = 0.f, c1 = 0.f, cn = 0.f;
#define ML_SCAN_BATCH(NBATCH, J0) do { unsigned a[NBATCH]; float an[NBATCH], B[NBATCH], ML[NBATCH]; \
            _Pragma("unroll") for (int u = 0; u < NBATCH; ++u) { a[u] = base[(size_t)((J0) + u) * 2048]; an[u] = hasn ? nb[((J0) + u) * 64] : 0.f; B[u] = sc[((J0) + u) * 4]; ML[u] = sc[((J0) + u) * 4 + 1]; } \
            _Pragma("unroll") for (int u = 0; u < NBATCH; ++u) { \
                const float mn = fmaxf(B[u] + m, ML[u]); const float wp = expf(B[u] + m - mn), wa = expf(ML[u] - mn); \
                if (part == 0 && tid == 0) sc[((J0) + u) * 4 + 2] = m; \
                base[(size_t)((J0) + u) * 2048] = pack_bf16(c0, c1); if (hasn) nb[((J0) + u) * 64] = cn; \
                c0 = wp * c0 + wa * bflo(a[u]); c1 = wp * c1 + wa * bfhi(a[u]); cn = wp * cn + wa * an[u]; m = mn; } } while (0)
        for (int j0 = 0; j0 < 64; j0 += 8) ML_SCAN_BATCH(8, j0);
        ML_SCAN_BATCH(4, 64);
#undef ML_SCAN_BATCH
    }
}

__device__ __forceinline__ void phase_ml_out(const Params& p, int l, unsigned char* smem) {
    unsigned char* ws = launder_ws(p.ws);
    const int tid = my_tid(), lane = tid & 63, w = tid >> 6;
    const int DSZ = 71680;
    const bf16_t* P = (const bf16_t*)(ws + WS_P);
    const float* GT = (const float*)(ws + WS_GATES);
    const bf16_t* MLA = (const bf16_t*)(ws + WS_MLA); const float* MLN = (const float*)(ws + WS_MLN); const float* MLS = (const float*)(ws + WS_MLS);
    bf16_t* Y = (bf16_t*)(ws + WS_U);
    const float* bg = PIN(I_BGATE) + l * 16; const float* mln = PIN(I_MLNORM) + l * 64;
    u32x4 pq, pk_, pv, pst[2]; float pn = 0.f, pg0 = 0.f, pg1 = 0.f, pm = 0.f;
#define ML_SKIP(it_) ({ int b_, h_, tc_, t0_, jf_, jb_; ml_decode((it_), b_, h_, tc_, t0_, jf_, jb_); (l == DEPTH - 1 && tc_ < 4); })
#define ML_FETCH(it_) do { int b_, h_, tc_, t0_, jf_, jb_; ml_decode((it_), b_, h_, tc_, t0_, jf_, jb_); \
        { const int s_ = tid >> 3, ch_ = tid & 7; const bf16_t* pr_ = P + (size_t)(t0_ + s_) * PW + h_ * 64 + ch_ * 8; \
          pq = *(const u32x4*)(pr_ + 512); pk_ = *(const u32x4*)(pr_ + 768); pv = *(const u32x4*)(pr_ + 1024); } \
        _Pragma("unroll") for (int d_ = 0; d_ < 2; ++d_) { const int seq_ = (b_ * 4 + h_) * 2 + d_, j_ = d_ ? jb_ : jf_; \
          pst[d_] = *(const u32x4*)(MLA + ((size_t)seq_ * 68 + j_) * 4096 + (tid >> 3) * 64 + (tid & 7) * 8); } \
        if (tid < 128) { const int d_ = tid >> 6, tau_ = tid & 63, tk_ = d_ ? 63 - tau_ : tau_; const int seq_ = (b_ * 4 + h_) * 2 + d_, j_ = d_ ? jb_ : jf_; \
          pn = MLN[((size_t)seq_ * 68 + j_) * 64 + tau_]; const float* g_ = GT + (size_t)(t0_ + tk_) * 16; \
          pg0 = g_[4 * d_ + h_]; pg1 = g_[8 + 4 * d_ + h_]; pm = MLS[((size_t)seq_ * 68 + j_) * 4 + 2]; } } while (0)
    int it = blockIdx.x;
    while (it < ML_ITEMS && ML_SKIP(it)) it += gridDim.x;
    if (it < ML_ITEMS) ML_FETCH(it);
    while (it < ML_ITEMS) {
        int b, head, tc, tok0, jf, jb; ml_decode(it, b, head, tc, tok0, jf, jb);
        int nit = it + gridDim.x;
        while (nit < ML_ITEMS && ML_SKIP(nit)) nit += gridDim.x;
        __syncthreads();
        {   const int s = tid >> 3, ch = tid & 7;
            const u32x4 qv = pq, kv = pk_, vv = pv;
            u32x4 ks; ks.x = pack_bf16(bflo(kv.x) * 0.125f, bfhi(kv.x) * 0.125f); ks.y = pack_bf16(bflo(kv.y) * 0.125f, bfhi(kv.y) * 0.125f);
            ks.z = pack_bf16(bflo(kv.z) * 0.125f, bfhi(kv.z) * 0.125f); ks.w = pack_bf16(bflo(kv.w) * 0.125f, bfhi(kv.w) * 0.125f);
            const unsigned vw[4] = {vv.x, vv.y, vv.z, vv.w};
#pragma unroll
            for (int d = 0; d < 2; ++d) { unsigned char* D = smem + d * DSZ; const int tau = d ? 63 - s : s;
                bf16_t* Qd = (bf16_t*)D; bf16_t* Kd = Qd + 64 * 72; bf16_t* Bd = Kd + 64 * 72 + 64 * 136;
                *(u32x4*)(Qd + tau * 72 + ch * 8) = qv; *(u32x4*)(Kd + tau * 72 + ch * 8) = ks;
#pragma unroll
                for (int i = 0; i < 4; ++i) { Bd[(ch * 8 + 2 * i) * 136 + tau] = (bf16_t)(vw[i] & 0xffff); Bd[(ch * 8 + 2 * i + 1) * 136 + tau] = (bf16_t)(vw[i] >> 16); } }
#pragma unroll
            for (int d = 0; d < 2; ++d) { unsigned char* D = smem + d * DSZ; bf16_t* Bd = (bf16_t*)D + 2 * 64 * 72 + 64 * 136;
                const int e = tid >> 3, k0 = (tid & 7) * 8;
                *(u32x4*)(Bd + e * 136 + 64 + k0) = pst[d]; }
            if (tid < 128) { const int d = tid >> 6, tau = tid & 63;
                float* vecs = (float*)(smem + d * DSZ + 53248);
                vecs[3 * 64 + tau] = pn;
                vecs[4 * 64 + tau] = pg0 + bg[4 * d + head];
                vecs[5 * 64 + tau] = log_sigmoid(pg1 + bg[8 + 4 * d + head]); }
        }
        const float mcur = pm;
        if (nit < ML_ITEMS) ML_FETCH(nit);
        __syncthreads();
        if (tid < 128) { const int d = tid >> 6, tau = tid & 63; float* vecs = (float*)(smem + d * DSZ + 53248);
            const int seq = (b * 4 + head) * 2 + d, j = d ? jb : jf;
            const float m = mcur;
            float cum = vecs[5 * 64 + tau];
#pragma unroll
            for (int o = 1; o < 64; o <<= 1) { const float n = __shfl_up(cum, o); if (tau >= o) cum += n; }
            float mm = vecs[4 * 64 + tau] - cum;
#pragma unroll
            for (int o = 1; o < 64; o <<= 1) { const float n = __shfl_up(mm, o); if (tau >= o) mm = fmaxf(mm, n); }
            const float mt = cum + fmaxf(m, mm);
            vecs[tau] = cum; vecs[64 + tau] = mt; vecs[128 + tau] = expf(cum + m - mt); }
        __syncthreads();
        const int d = w >> 2, wl = w & 3, tt = wl >> 1, tx = wl & 1;
        unsigned char* D = smem + d * DSZ;
        bf16_t* Qd = (bf16_t*)D; bf16_t* Kd = Qd + 64 * 72; bf16_t* Ad = Kd + 64 * 72; bf16_t* Bd = Ad + 64 * 136;
        float* vecs = (float*)(D + 53248); float* Hd = vecs + 7 * 64;
        {   f32x16 S;
#pragma unroll
            for (int r = 0; r < 16; ++r) S[r] = 0.f;
            S = mma32(Qd + 32 * tt * 72, 72, Kd + 32 * tx * 72, 72, 64, S, lane);
            const int s = 32 * tx + (lane & 31); const float bs = vecs[s], igs = vecs[4 * 64 + s];
#pragma unroll
            for (int r = 0; r < 16; ++r) { const int t = 32 * tt + CROW(r, lane);
                const float val = (s <= t) ? S[r] * fast_exp2((vecs[t] - bs + igs - vecs[64 + t]) * LOG2E) : 0.f;
                Ad[t * 136 + s] = f2bf(val); }
            const int tl = tid & 255, t = tl >> 2, qd = tl & 3; const float wi = vecs[128 + t];
#pragma unroll
            for (int v = 0; v < 2; ++v) { const u32x4 q = *(const u32x4*)(Qd + t * 72 + 16 * qd + 8 * v); u32x4 o;
                o.x = pack_bf16(bflo(q.x) * wi, bfhi(q.x) * wi); o.y = pack_bf16(bflo(q.y) * wi, bfhi(q.y) * wi); o.z = pack_bf16(bflo(q.z) * wi, bfhi(q.z) * wi); o.w = pack_bf16(bflo(q.w) * wi, bfhi(q.w) * wi);
                *(u32x4*)(Ad + t * 136 + 64 + 16 * qd + 8 * v) = o; }
        }
        __syncthreads();
        {   f32x16 N;
#pragma unroll
            for (int r = 0; r < 16; ++r) N[r] = 0.f;
            N = mma32(Ad + 32 * tt * 136, 136, Bd + 32 * tx * 136, 136, 128, N, lane);
#pragma unroll
            for (int r = 0; r < 16; ++r) Hd[(32 * tt + CROW(r, lane)) * 65 + 32 * tx + (lane & 31)] = N[r];
            const int tl = tid & 255;
            {
                const int t = tl >> 2, qd = tl & 3; float dn = 0.f;
                const u32x4 sa = *(const u32x4*)(Ad + t * 136 + 16 * qd), sb = *(const u32x4*)(Ad + t * 136 + 16 * qd + 8);
                const u32x4 qa = *(const u32x4*)(Ad + t * 136 + 64 + 16 * qd), qb = *(const u32x4*)(Ad + t * 136 + 64 + 16 * qd + 8);
                const float* nv = vecs + 3 * 64 + 16 * qd;
                dn += (bflo(sa.x) + bfhi(sa.x)) + (bflo(sa.y) + bfhi(sa.y)) + (bflo(sa.z) + bfhi(sa.z)) + (bflo(sa.w) + bfhi(sa.w));
                dn += (bflo(sb.x) + bfhi(sb.x)) + (bflo(sb.y) + bfhi(sb.y)) + (bflo(sb.z) + bfhi(sb.z)) + (bflo(sb.w) + bfhi(sb.w));
                dn += bflo(qa.x) * nv[0] + bfhi(qa.x) * nv[1] + bflo(qa.y) * nv[2] + bfhi(qa.y) * nv[3] + bflo(qa.z) * nv[4] + bfhi(qa.z) * nv[5] + bflo(qa.w) * nv[6] + bfhi(qa.w) * nv[7];
                dn += bflo(qb.x) * nv[8] + bfhi(qb.x) * nv[9] + bflo(qb.y) * nv[10] + bfhi(qb.y) * nv[11] + bflo(qb.z) * nv[12] + bfhi(qb.z) * nv[13] + bflo(qb.w) * nv[14] + bfhi(qb.w) * nv[15];
                dn += dpp_get<DPP_XOR1>(dn); dn += dpp_get<DPP_XOR2>(dn);
                if (qd == 0) vecs[6 * 64 + t] = dn; }
        }
        __syncthreads();
        {   const int s = tid >> 3, e0 = (tid & 7) * 8;
            const float* vF = (const float*)(smem + 53248); const float* HF = vF + 7 * 64;
            const float* vB = (const float*)(smem + DSZ + 53248); const float* HB = vB + 7 * 64;
            const int tb = 63 - s;
            const float rf = 1.0f / fmaxf(fabsf(vF[6 * 64 + s]), fast_exp2(-vF[64 + s] * LOG2E)), rb = 1.0f / fmaxf(fabsf(vB[6 * 64 + tb]), fast_exp2(-vB[64 + tb] * LOG2E));
            float y[8], ss = 0.f;
#pragma unroll
            for (int i = 0; i < 8; ++i) { y[i] = HF[s * 65 + e0 + i] * rf + HB[tb * 65 + e0 + i] * rb; ss += y[i] * y[i]; }
            ss += __shfl_xor(ss, 1); ss += __shfl_xor(ss, 2); ss += __shfl_xor(ss, 4);
            const float rinv = rsqrtf(ss * (1.0f / 64.0f) + EPSF);
            const u32x4 ov = *(const u32x4*)(P + (size_t)(tok0 + s) * PW + 1280 + head * 64 + e0);
            const float op[8] = {bflo(ov.x), bfhi(ov.x), bflo(ov.y), bfhi(ov.y), bflo(ov.z), bfhi(ov.z), bflo(ov.w), bfhi(ov.w)};
            float o[8];
#pragma unroll
            for (int i = 0; i < 8; ++i) o[i] = y[i] * rinv * mln[e0 + i] * __builtin_amdgcn_rcpf(1.0f + fast_exp2(-op[i] * LOG2E));
            u32x4 wv; wv.x = pack_bf16(o[0], o[1]); wv.y = pack_bf16(o[2], o[3]); wv.z = pack_bf16(o[4], o[5]); wv.w = pack_bf16(o[6], o[7]);
            *(u32x4*)(Y + (size_t)(tok0 + s) * DM + 512 + head * 64 + e0) = wv;
        }
        it = nit;
    }
#undef ML_SKIP
#undef ML_FETCH
    __syncthreads();
}
#ifndef DUPMASK
#define DUPMASK 0
#endif
#ifndef PROBE_KIND
#define PROBE_KIND 0
#endif
#ifndef PROBE_MASK
#define PROBE_MASK 0
#endif
#ifndef PROBE_MULT
#define PROBE_MULT 1
#endif
#if PROBE_KIND
#define PROBE_PRE() do { if (blockIdx.x == 0 && threadIdx.x == 0) pw[0] = (unsigned)wall_clock64(); } while (0)
#define PROBE_POST(id) do { if (blockIdx.x == 0 && threadIdx.x == 0) { const unsigned t_ = (unsigned)wall_clock64(), c_ = (unsigned)clock64(); \
        if ((PROBE_MASK >> (id)) & 1) { if (PROBE_KIND == 1) pw[2] += t_ - pw[1]; if (PROBE_KIND == 2) pw[2] += t_ - pw[0]; if (PROBE_KIND == 3) { pw[2] += t_ - pw[1]; pw[3] += c_ - pw[4]; } } \
        pw[1] = t_; pw[4] = c_; } } while (0)
#else
#define PROBE_PRE() do {} while (0)
#define PROBE_POST(id) do {} while (0)
#endif
#if PROBE_KIND == 5
#define PROBE_SEC_BEGIN() do { if (blockIdx.x == 0 && threadIdx.x == 0) pw[5] = (unsigned)wall_clock64(); } while (0)
#define PROBE_SEC_END(k) do { if (blockIdx.x == 0 && threadIdx.x == 0) { const unsigned t_ = (unsigned)wall_clock64(); if ((PROBE_MASK >> (k)) & 1) pw[2] += t_ - pw[5]; pw[5] = t_; } } while (0)
#else
#define PROBE_SEC_BEGIN() do {} while (0)
#define PROBE_SEC_END(k) do {} while (0)
#endif
#define XBAR(id) do { PROBE_PRE(); XcdBarrier _b; _b.bar = (unsigned*)(launder_ws(p.ws) + WS_BAR); _b.x = xb_xcc_id(); _b.st = xbw; xcd_barrier(_b); if ((DUPMASK >> 13) & 1) xcd_barrier(_b); PROBE_POST(id); } while (0)
#define REP(k) for (int _rep = 0; _rep < 1 + ((DUPMASK >> (k)) & 1); ++_rep)
extern __shared__ __attribute__((aligned(16))) unsigned char smem_raw[];

__global__ void __launch_bounds__(NTHR, 2) trunk_fwd(Params p) {
    unsigned char* smem = smem_raw;
    volatile LAS unsigned* xbw = (volatile LAS unsigned*)(smem_raw + LDS_BYTES - 16);
    if (threadIdx.x == 0) { xbw[0] = 0u; xbw[1] = 0u; xbw[2] = 0u; xbw[3] = 0u; }
    __syncthreads();
    (void)xcd_barrier_post((unsigned*)(p.ws + WS_BAR), xbw);
#if PROBE_KIND
    volatile LAS unsigned* pw = (volatile LAS unsigned*)(smem_raw + LDS_BYTES - 48);
    if (blockIdx.x == 0 && threadIdx.x == 0) { pw[1] = (unsigned)wall_clock64(); pw[4] = (unsigned)clock64(); pw[2] = 0u; pw[3] = 0u; }
#endif
    unsigned char* ws = p.ws;
    LAS unsigned char* lds = (LAS unsigned char*)smem_raw;
    const int G = gridDim.x, c = blockIdx.x;
    phase_W<0>(p, 0, smem);
    XBAR(0);
    phase_norm<1>(p, 0, smem);
    XBAR(1);
    for (int l = 0; l < DEPTH; ++l) {
        const bool last = (l == DEPTH - 1);
        REP(10) {   pg8::Gemm g; g.A = (const bf16_t*)(ws + WS_U); g.Bt = (const bf16_t*)(ws + WS_U); g.M = 0; g.N = 0; g.K = DM;
            InProjOrder S{G, c}; EpiInProj E{(bf16_t*)(ws + WS_P), (bf16_t*)(ws + WS_UT), PIN(I_DQN) + l * 32, PIN(I_DKN) + l * 32, (const float2*)(ws + WS_ROPE) + 64 * 16};
            pg8::gemm_phase(lds, g, S, E); }
        XBAR(2);
        phase_prep(p, l, smem);
        XBAR(3);
        PROBE_SEC_BEGIN();
        REP(0) phase_hyena(p, l, smem);
        PROBE_SEC_END(0);
        REP(1) phase_attnD(p, l, smem);
        PROBE_SEC_END(1);
        REP(2) phase_attnA(p, l, smem);
        PROBE_SEC_END(2);
        REP(3) phase_ml_local(p, l, smem);
        PROBE_SEC_END(3);
        XBAR(4);
        phase_ml_scan(p);
        REP(9) phase_hy_transpose(p, l, smem);
        XBAR(5);
        REP(4) phase_ml_out(p, l, smem);
        XBAR(6);
        {   pg8::Gemm g; g.A = (const bf16_t*)(ws + WS_U); g.Bt = (const bf16_t*)(ws + WS_WOUT); g.M = 0; g.N = 0; g.K = DM;
            OutProjOrder S{G, c, last ? 256 : 272};
            EpiOut E{PIN(I_X), PIN(I_CTX), (bf16_t*)(ws + WS_XB), (const float*)(ws + WS_MOD + (size_t)(l & 1) * MOD_BYTES), l == 0 ? 1 : 0};
            pg8::gemm_phase(lds, g, S, E); }
        REP(5) if (l + 1 < DEPTH) phase_W<2>(p, l + 1, smem);
        XBAR(7);
        REP(6) phase_norm<2>(p, l, smem);
        XBAR(8);
        REP(7) phase_topk(p, l, smem);
        XBAR(9);
        REP(11) {   pg8::Gemm g; g.A = (const bf16_t*)(ws + WS_U); g.Bt = (const bf16_t*)(ws + WS_WGU); g.M = 0; g.N = 0; g.K = DM;
            GateUpOrder S{G, c, last ? 32 : 34}; EpiGU E{(bf16_t*)(ws + WS_HID)};
            pg8::gemm_phase_gather(lds, g, S, E, (const int*)(ws + WS_SROW)); }
        XBAR(10);
        REP(12) {   pg8::Gemm g; g.A = (const bf16_t*)(ws + WS_HID); g.Bt = (const bf16_t*)(ws + WS_WD); g.M = 0; g.N = 0; g.K = DM;
            DownOrder S{G, c, last ? 32 : 34}; EpiDown E{(bf16_t*)(ws + WS_XE), (const float*)(ws + WS_SGATE)};
            pg8::gemm_phase(lds, g, S, E); }
        if (l + 1 < DEPTH) phase_W<3>(p, l + 1, smem);
        XBAR(11);
        if (l + 1 < DEPTH) { REP(14) phase_combine<true>(p, l, smem); REP(5) phase_W<1>(p, l + 1, smem); XBAR(12); }
        else phase_combine<false>(p, l, smem);
    }
#if PROBE_KIND
    PROBE_POST(12);
    if (blockIdx.x == 0 && threadIdx.x == 0) {
        unsigned long long target = (unsigned long long)pw[2] * PROBE_MULT;
        if (PROBE_KIND == 3) target = pw[2] ? (unsigned long long)pw[3] * 10000ull / pw[2] : 0ull;
        const unsigned long long t0 = wall_clock64();
        while ((unsigned long long)wall_clock64() - t0 < target) __builtin_amdgcn_s_sleep(8);
    }
#endif
}

extern "C" void kernel_launch(void* const* d_in, const int* in_sizes, int n_in, void* d_out, int out_size, void* d_ws, size_t ws_size, hipStream_t stream) {
    static int grid = 0;
    if (grid == 0) {
        if (n_in != 34 || out_size != NROWL * DM || ws_size < WS_END) { fprintf(stderr, "kernel_launch: unexpected shapes (n_in %d out %d ws %zu need %zu)\n", n_in, out_size, ws_size, (size_t)WS_END); grid = -1; return; }
        int dev = 0, cus = 0;
        if (hipGetDevice(&dev) != hipSuccess || hipDeviceGetAttribute(&cus, hipDeviceAttributeMultiprocessorCount, dev) != hipSuccess) { grid = -1; return; }
        if (hipFuncSetAttribute((const void*)trunk_fwd, hipFuncAttributeMaxDynamicSharedMemorySize, LDS_BYTES) != hipSuccess) { fprintf(stderr, "kernel_launch: hipFuncSetAttribute failed\n"); grid = -1; return; }
        int per_cu = 0;
        if (hipOccupancyMaxActiveBlocksPerMultiprocessor(&per_cu, (const void*)trunk_fwd, NTHR, LDS_BYTES) != hipSuccess || per_cu < 1) { fprintf(stderr, "kernel_launch: occupancy query says %d\n", per_cu); }
        (void)hipGetLastError();
        grid = cus;
        if (grid > 256) grid = 256;
        grid &= ~7;
    }
    if (grid <= 0) return;
    (void)hipMemsetAsync((char*)d_ws + WS_BAR, 0, 16384, stream);
    Params p{};
    for (int i = 0; i < 34; ++i) p.in[i] = (const float*)d_in[i];
    p.out = (float*)d_out; p.ws = (unsigned char*)d_ws;
    hipLaunchKernelGGL(trunk_fwd, dim3(grid), dim3(NTHR), LDS_BYTES, stream, p);
}
```

```cpp
#include <hip/hip_runtime.h>
#include <stdint.h>
#include <stdio.h>

typedef unsigned short bf16_t;
typedef short bf16x8 __attribute__((ext_vector_type(8)));
typedef short s16x4 __attribute__((ext_vector_type(4)));
typedef float f32x4 __attribute__((ext_vector_type(4)));
typedef float f32x16 __attribute__((ext_vector_type(16)));
typedef unsigned u32x4 __attribute__((ext_vector_type(4)));
typedef unsigned u32x2 __attribute__((ext_vector_type(2)));
#define LAS __attribute__((address_space(3)))

#define NB 16
#define TL 4096
#define TCX 256
#define DM 1024
#define NROWL 65536
#define NROWC 4096
#define NROW 69632
#define PW 2304
#define INW 3088
#define NEXP 16
#define CAPL 512
#define CAPC 32
#define SLOTS_E 8704
#define NSLOT 139264
#define DEPTH 4
#define NTHR 512
#define LDS_BYTES 155648
#define EPSF 1e-6f
#define LOG2E 1.4426950408889634f

constexpr size_t al256(size_t x) { return (x + 255) & ~size_t(255); }
constexpr size_t WS_BAR   = 0;
constexpr size_t WS_MOD   = al256(WS_BAR + 16384);
constexpr size_t MOD_BYTES = al256((size_t)17 * 6144 * 4);
constexpr size_t WS_HID2L = al256(WS_MOD + 2 * MOD_BYTES);
constexpr size_t WS_HID2C = al256(WS_HID2L + (size_t)4096 * 64 * 4);
constexpr size_t WS_GATES = al256(WS_HID2C + (size_t)256 * 64 * 4);
constexpr size_t WS_AFF   = al256(WS_GATES + (size_t)NROW * 16 * 4);
constexpr size_t WS_SROW  = al256(WS_AFF + (size_t)NROW * 16 * 4);
constexpr size_t WS_SGATE = al256(WS_SROW + (size_t)NSLOT * 4);
constexpr size_t WS_INV   = al256(WS_SGATE + (size_t)NSLOT * 4);
constexpr size_t WS_MLS   = al256(WS_INV + (size_t)NROW * 16 * 4);
constexpr size_t WS_FBUF  = al256(WS_MLS + (size_t)128 * 68 * 4 * 4);
constexpr size_t WS_ROPE  = al256(WS_FBUF + (size_t)256 * 8256 * 2);
constexpr size_t WS_CTX   = al256(WS_ROPE + (size_t)64 * 24 * 8);
constexpr size_t WS_U     = al256(WS_CTX + (size_t)NROWC * DM * 4);
constexpr size_t WS_WOUT  = al256(WS_U + (size_t)(NROW + 3072) * DM * 2);
constexpr size_t WS_WGU   = al256(WS_WOUT + (size_t)DM * DM * 2);
constexpr size_t WS_WD    = al256(WS_WGU + (size_t)NEXP * 2048 * DM * 2);
constexpr size_t WS_P     = al256(WS_WD + (size_t)NEXP * DM * DM * 2);
constexpr size_t WS_UT    = al256(WS_P + (size_t)NROW * PW * 2);
constexpr size_t WS_XE    = al256(WS_UT + (size_t)768 * NROW * 2);
constexpr size_t WS_XB    = al256(WS_XE + (size_t)NSLOT * DM * 2);
constexpr size_t WS_END   = al256(WS_XB + (size_t)NROW * DM * 2);
constexpr size_t WS_HID   = WS_P;
constexpr size_t WS_MLA   = WS_XE;
constexpr size_t WS_MLN   = al256(WS_MLA + (size_t)128 * 68 * 4096 * 2);
constexpr size_t WS_YT    = al256(WS_MLN + (size_t)128 * 68 * 64 * 4);
static_assert(WS_YT + (size_t)256 * NROW * 2 <= WS_XB, "alias overflow");
static_assert((size_t)NSLOT * DM * 2 <= (size_t)NROW * PW * 2, "hid alias overflow");

struct Params {
    const float* in[34];
    float* out;
    unsigned char* ws;
};
enum { I_X = 0, I_C, I_CTX, I_CCTX, I_WADA, I_BADA, I_N1G, I_N2G, I_WIN, I_BGATE, I_AQN, I_AKN, I_ASINK, I_HYCONV, I_FW1, I_FB1, I_FREQ, I_FW2, I_FB2, I_FW3,
       I_HYBIAS, I_MLNORM, I_DQN, I_DKN, I_LQ1, I_LK1, I_LQ2, I_LK2, I_DSUB, I_WOUT, I_WROUTER, I_WEG, I_WEU, I_WED };

__device__ __forceinline__ int my_tid() { int t = threadIdx.x; asm volatile("" : "+v"(t)); return t; }
#define GAS __attribute__((address_space(1)))
__device__ __forceinline__ unsigned char* launder_ws(unsigned char* q) { GAS unsigned char* g = (GAS unsigned char*)q; asm volatile("" : "+s"(g)); return (unsigned char*)g; }
#define CAS __attribute__((address_space(4)))
__device__ __forceinline__ const float* pin_ptr(int i) { const CAS char* ka = (const CAS char*)__builtin_amdgcn_kernarg_segment_ptr(); asm volatile("" : "+s"(ka));
    const GAS float* g = *(const GAS float* const CAS*)(ka + 8 * i); return (const float*)g; }
#define PIN(i) pin_ptr(i)
#define POUT() ((float*)pin_ptr(34))
__device__ __forceinline__ float bf2f(bf16_t v) { return __uint_as_float((unsigned)v << 16); }
__device__ __forceinline__ bf16_t f2bf(float f) { unsigned u = __float_as_uint(f); u += 0x7fffu + ((u >> 16) & 1u); return (bf16_t)(u >> 16); }
__device__ __forceinline__ unsigned pack_bf16(float lo, float hi) { return (unsigned)f2bf(lo) | ((unsigned)f2bf(hi) << 16); }
__device__ __forceinline__ float bflo(unsigned w) { return __uint_as_float(w << 16); }
__device__ __forceinline__ float bfhi(unsigned w) { return __uint_as_float(w & 0xffff0000u); }
template <int CTRL> __device__ __forceinline__ float dpp_get(float v) { return __int_as_float(__builtin_amdgcn_update_dpp(0, __float_as_int(v), CTRL, 0xf, 0xf, true)); }
#define DPP_XOR1 0xB1
#define DPP_XOR2 0x4E
#define DPP_HMIRROR 0x141
#define DPP_MIRROR 0x140
#define DPP_ROR8 0x128
__device__ __forceinline__ float wave_sum(float v) {
    v += dpp_get<DPP_XOR1>(v); v += dpp_get<DPP_XOR2>(v); v += dpp_get<DPP_HMIRROR>(v); v += dpp_get<DPP_MIRROR>(v);
    const int iv = __float_as_int(v);
    return (__int_as_float(__builtin_amdgcn_readlane(iv, 0)) + __int_as_float(__builtin_amdgcn_readlane(iv, 16))) + (__int_as_float(__builtin_amdgcn_readlane(iv, 32)) + __int_as_float(__builtin_amdgcn_readlane(iv, 48)));
}
__device__ __forceinline__ float wave_max(float v) {
    v = fmaxf(v, dpp_get<DPP_XOR1>(v)); v = fmaxf(v, dpp_get<DPP_XOR2>(v)); v = fmaxf(v, dpp_get<DPP_HMIRROR>(v)); v = fmaxf(v, dpp_get<DPP_MIRROR>(v));
    const int iv = __float_as_int(v);
    return fmaxf(fmaxf(__int_as_float(__builtin_amdgcn_readlane(iv, 0)), __int_as_float(__builtin_amdgcn_readlane(iv, 16))), fmaxf(__int_as_float(__builtin_amdgcn_readlane(iv, 32)), __int_as_float(__builtin_amdgcn_readlane(iv, 48))));
}
__device__ __forceinline__ float lane_xor16(float v, int lane) { const auto r = __builtin_amdgcn_permlane16_swap(__float_as_uint(v), __float_as_uint(v), false, false); return __uint_as_float((lane & 16) ? r[0] : r[1]); }
__device__ __forceinline__ float lane_xor32(float v, int lane) { const auto r = __builtin_amdgcn_permlane32_swap(__float_as_uint(v), __float_as_uint(v), false, false); return __uint_as_float((lane & 32) ? r[0] : r[1]); }
__device__ __forceinline__ float reduce16_transpose(const float (&part)[16], int lane) {
    float v8[8], v4[4], v2[2], v1;
#pragma unroll
    for (int j = 0; j < 8; ++j) { const auto r = __builtin_amdgcn_permlane32_swap(__float_as_uint(part[j]), __float_as_uint(part[8 + j]), false, false); v8[j] = __uint_as_float(r[0]) + __uint_as_float(r[1]); }
#pragma unroll
    for (int j = 0; j < 4; ++j) { const auto r = __builtin_amdgcn_permlane16_swap(__float_as_uint(v8[j]), __float_as_uint(v8[4 + j]), false, false); v4[j] = __uint_as_float(r[0]) + __uint_as_float(r[1]); }
    { const bool up = (lane & 8) != 0;
#pragma unroll
      for (int j = 0; j < 2; ++j) { const float send = up ? v4[j] : v4[2 + j], keep = up ? v4[2 + j] : v4[j]; v2[j] = keep + dpp_get<DPP_ROR8>(send); } }
    { const bool up = (lane & 4) != 0; const float send = up ? v2[0] : v2[1], keep = up ? v2[1] : v2[0]; v1 = keep + dpp_get<DPP_HMIRROR>(send); }
    v1 += dpp_get<DPP_XOR2>(v1); v1 += dpp_get<DPP_XOR1>(v1);
    return v1;
}
__device__ __forceinline__ float fast_exp2(float x) { return __builtin_amdgcn_exp2f(x); }
__device__ __forceinline__ float log_sigmoid(float x) { return fminf(x, 0.f) - log1pf(expf(-fabsf(x))); }

#define XB_TMO      128
#define XB_XCNT(j)  (256  + 64 * (j))
#define XB_XSUB(j)  (1280 + 64 * (j))
#define XB_XGEN(j)  (2304 + 64 * (j))
#define XB_TOP      3328
#define XB_TOPGEN   3392
#define XCD_BAR_WORDS 3456
#define XB_SPIN_CAP (1u << 22)

__device__ __forceinline__ unsigned xb_ld(unsigned* p)              { return __hip_atomic_load(p, __ATOMIC_RELAXED, __HIP_MEMORY_SCOPE_AGENT); }
__device__ __forceinline__ unsigned xb_add(unsigned* p, unsigned v) { return __hip_atomic_fetch_add(p, v, __ATOMIC_RELAXED, __HIP_MEMORY_SCOPE_AGENT); }
__device__ __forceinline__ unsigned xb_xcc_id() { return (unsigned)__builtin_amdgcn_s_getreg((3 << 11) | 20) & 0xFu; }
#define XB_SPIN(cond, bar) do { unsigned _sp = 0; while (cond) { __builtin_amdgcn_s_sleep(1); \
    if ((++_sp & 255u) == 0u) { if (xb_ld(&(bar)[XB_TMO])) break; if (_sp > XB_SPIN_CAP) { atomicAdd(&(bar)[XB_TMO], 1u); break; } } } } while (0)

struct XcdBarrier { unsigned* bar; unsigned x; volatile LAS unsigned* st; };

__device__ __forceinline__ XcdBarrier xcd_barrier_post(unsigned* bar, volatile LAS unsigned* st) {
    XcdBarrier b; b.bar = bar; b.x = xb_xcc_id(); b.st = st;
    if (threadIdx.x == 0) (void)xb_add(&bar[XB_XCNT(b.x)], 1u);
    return b;
}
__device__ __forceinline__ void xcd_barrier_complete(unsigned* bar, unsigned x, unsigned& nloc, unsigned& nx) {
    const unsigned G = gridDim.x * gridDim.y * gridDim.z;
    unsigned sum, cnt, mine, sp = 0u;
    for (;;) {
        sum = 0u; cnt = 0u; mine = 0u;
#pragma unroll
        for (unsigned j = 0; j < 16; ++j) { const unsigned c = xb_ld(&bar[XB_XCNT(j)]); sum += c; cnt += (c > 0u) ? 1u : 0u; mine = (j == x) ? c : mine; }
        if (sum == G) break;
        __builtin_amdgcn_s_sleep(1);
        if ((++sp & 255u) == 0u) { if (xb_ld(&bar[XB_TMO])) break; if (sp > XB_SPIN_CAP) { atomicAdd(&bar[XB_TMO], 1u); break; } }
    }
    nloc = mine > 0u ? mine : 1u; nx = cnt > 0u ? cnt : 1u;
}
__device__ __forceinline__ void xcd_barrier(const XcdBarrier& b) {
    asm volatile("s_waitcnt vmcnt(0)" ::: "memory");
    __syncthreads();
    if (threadIdx.x == 0) {
        unsigned* bar = b.bar;
        __builtin_amdgcn_s_waitcnt(0);
        unsigned nloc = b.st[0], nx = b.st[1];
        if (nloc == 0u) { xcd_barrier_complete(bar, b.x, nloc, nx); b.st[0] = nloc; b.st[1] = nx; }
        const unsigned old = xb_add(&bar[XB_XSUB(b.x)], 1u);
        const unsigned gen = old / nloc;
        if (old + 1u == (gen + 1u) * nloc) {
            __builtin_amdgcn_fence(__ATOMIC_RELEASE, "agent");
            asm volatile("s_waitcnt vmcnt(0)" ::: "memory");
            const unsigned og = xb_add(&bar[XB_TOP], 1u);
            const unsigned tg = og / nx;
            if (og + 1u == (tg + 1u) * nx) xb_add(&bar[XB_TOPGEN], 1u);
            else XB_SPIN(xb_ld(&bar[XB_TOPGEN]) == tg, bar);
            __builtin_amdgcn_fence(__ATOMIC_ACQUIRE, "agent");
            xb_add(&bar[XB_XGEN(b.x)], 1u);
            asm volatile("s_waitcnt vmcnt(0)" ::: "memory");
        } else {
            XB_SPIN(xb_ld(&bar[XB_XGEN(b.x)]) == gen, bar);
            __builtin_amdgcn_fence(__ATOMIC_ACQUIRE, "agent");
            asm volatile("s_waitcnt vmcnt(0)" ::: "memory");
        }
    }
    __syncthreads();
}

namespace pg8 {
constexpr int BM = 256, BK = 64, HALF = 128, HTB = HALF * BK * 2, STAGE_BYTES = 8 * HTB, NXCD = 8, WGM = 8;
__host__ __device__ __forceinline__ int lds_byte(int r, int c) { const int st = (r >> 4) * 2 + (c >> 5), rr = r & 15, cc = c & 31, ob = rr * 64 + cc * 2; return st * 1024 + (ob ^ (((ob >> 9) & 1) << 5)); }
__host__ __device__ __forceinline__ void stage_rc(int b, int& R, int& C) { const int st = b / 1024, sb = b % 1024, swz = sb ^ (((sb >> 9) & 1) << 5); R = (st >> 1) * 16 + swz / 64; C = (st & 1) * 32 + (swz % 64) / 2; }
__host__ __device__ __forceinline__ int perm32(int rho) { const int n = rho >> 4, i = rho & 15; return 8 * (i >> 2) + 4 * n + (i & 3); }
struct Unit { int pm, pn; };
struct Gemm { const bf16_t* A; const bf16_t* Bt; int M, N, K; };
__device__ __forceinline__ unsigned cvt_pk_bf16(float lo, float hi) { unsigned r; asm volatile("v_cvt_pk_bf16_f32 %0, %1, %2" : "=v"(r) : "v"(lo), "v"(hi)); return r; }

__device__ __forceinline__ void static_unit(int L, int nM, int nN, int& pm, int& pn) {
    const int nwg = nM * nN; int wgid = L;
    { const int q = nwg / NXCD, r = nwg % NXCD, xcd = wgid % NXCD, off = wgid / NXCD; wgid = (xcd < r ? xcd * (q + 1) : r * (q + 1) + (xcd - r) * q) + off; }
    const int nig = WGM * nN, gid = wgid / nig, fm = gid * WGM, gsz = (nM - fm) < WGM ? (nM - fm) : WGM;
    pm = fm + ((wgid % nig) % gsz); pn = (wgid % nig) / gsz;
}

template <class Epi, class Sched>
__device__ __forceinline__ void gemm_phase(LAS unsigned char* lds, const Gemm g, const Sched& S, const Epi& E) {
    const int tid = my_tid(), wid = __builtin_amdgcn_readfirstlane(tid >> 6), lane = tid & 63, wr = wid >> 2, wc = wid & 3, fr = lane & 15, fq = lane >> 4;
    const int K = g.K, nt = K / BK;
    unsigned voffA[2], voffB[2];
#pragma unroll
    for (int i = 0; i < 2; ++i) { int R, C; stage_rc(tid * 16 + i * 8192, R, C); const int Rb = Epi::PERM ? ((R & ~31) + perm32(R & 31)) : R;
        voffA[i] = (unsigned)(R * K + C) * 2u; voffB[i] = (unsigned)(Rb * K + C) * 2u; }
    const size_t kstep = (size_t)(BK * 2);
    const size_t hstep = (size_t)HALF * K * 2;
    const size_t tstep = 2 * hstep;
    const unsigned ldsw = (unsigned)wid * 1024u;
    const int aoff = lds_byte(wr * 64 + fr, fq * 8), boff = lds_byte(wc * 32 + fr, fq * 8);
#define PG8_SA(b, h) (((b) * 2 + (h)) * HTB)
#define PG8_SB(b, h) ((4 + (b) * 2 + (h)) * HTB)
#define PG8_STAGE(bufoff, gbase, voff) do { _Pragma("unroll") for (int _i = 0; _i < 2; ++_i) \
        __builtin_amdgcn_global_load_lds((const unsigned*)((const char*)(gbase) + (voff)[_i]), (LAS unsigned*)(lds + (bufoff) + ldsw + _i * 8192), 16, 0, 0); } while (0)
#define PG8_LDA(dst, b, h) do { _Pragma("unroll") for (int m = 0; m < 4; ++m) _Pragma("unroll") for (int k = 0; k < 2; ++k) dst[m][k] = *(const LAS bf16x8*)(lds + PG8_SA(b, h) + aoff + m * 2048 + k * 1024); } while (0)
#define PG8_LDB(dst, b, h) do { _Pragma("unroll") for (int n = 0; n < 2; ++n) _Pragma("unroll") for (int k = 0; k < 2; ++k) dst[n][k] = *(const LAS bf16x8*)(lds + PG8_SB(b, h) + boff + n * 2048 + k * 1024); } while (0)
#define PG8_MMA(ai, bj, At, Bt) do { __builtin_amdgcn_s_setprio(1); _Pragma("unroll") for (int m = 0; m < 4; ++m) _Pragma("unroll") for (int n = 0; n < 2; ++n) _Pragma("unroll") for (int k = 0; k < 2; ++k) \
        acc[ai][bj][m][n] = __builtin_amdgcn_mfma_f32_16x16x32_bf16(Bt[n][k], At[m][k], acc[ai][bj][m][n], 0, 0, 0); __builtin_amdgcn_s_setprio(0); } while (0)
#define PG8_WAIT_V(n) asm volatile("s_waitcnt vmcnt(" #n ")" ::: "memory")
#define PG8_WAIT_L(n) asm volatile("s_waitcnt lgkmcnt(" #n ")" ::: "memory")
#define PG8_BAR __builtin_amdgcn_s_barrier()
#define PG8_SCHED __builtin_amdgcn_sched_barrier(0)
    Unit cur, nxt; int ui = 0;
    if (!S.next(0, cur)) return;
    f32x4 acc[2][2][4][2];
#pragma unroll
    for (int a = 0; a < 2; ++a)
#pragma unroll
        for (int b = 0; b < 2; ++b)
#pragma unroll
            for (int m = 0; m < 4; ++m)
#pragma unroll
                for (int n = 0; n < 2; ++n) acc[a][b][m][n] = (f32x4){0.f, 0.f, 0.f, 0.f};
    bf16x8 At[4][2], B0[2][2], B1[2][2];
    const char* cA = (const char*)g.A + (size_t)cur.pm * tstep; const char* cB = (const char*)g.Bt + (size_t)cur.pn * tstep;
    PG8_STAGE(PG8_SB(0, 0), cB, voffB); PG8_STAGE(PG8_SA(0, 0), cA, voffA); PG8_STAGE(PG8_SB(0, 1), cB + hstep, voffB); PG8_STAGE(PG8_SA(0, 1), cA + hstep, voffA);
    if (wr == 1) PG8_BAR;
    PG8_WAIT_V(4); PG8_BAR;
    PG8_STAGE(PG8_SB(1, 0), cB + kstep, voffB); PG8_STAGE(PG8_SA(1, 0), cA + kstep, voffA); PG8_STAGE(PG8_SB(1, 1), cB + hstep + kstep, voffB);
    PG8_WAIT_V(6); PG8_BAR;
    for (;;) {
        const bool has_next = S.next(ui + 1, nxt);
        const char* nA = has_next ? (const char*)g.A + (size_t)nxt.pm * tstep : cA; const char* nB = has_next ? (const char*)g.Bt + (size_t)nxt.pn * tstep : cB;
        for (int t = 0; t < nt; t += 2) {
            const bool last = (t == nt - 2);
            const char* a1 = cA + (size_t)(t + 1) * kstep;
            const char* a2 = last ? nA : cA + (size_t)(t + 2) * kstep; const char* b2 = last ? nB : cB + (size_t)(t + 2) * kstep;
            const char* a3 = a2 + kstep; const char* b3 = b2 + kstep;
            PG8_LDB(B0, 0, 0); PG8_SCHED; PG8_LDA(At, 0, 0); PG8_STAGE(PG8_SA(1, 1), a1 + hstep, voffA);
            PG8_WAIT_L(8); PG8_BAR; PG8_WAIT_L(0); PG8_MMA(0, 0, At, B0); PG8_BAR; PG8_SCHED;
            PG8_LDB(B1, 0, 1); PG8_STAGE(PG8_SB(0, 0), b2, voffB);
            PG8_BAR; PG8_WAIT_L(0); PG8_MMA(0, 1, At, B1); PG8_BAR;
            PG8_LDA(At, 0, 1); PG8_STAGE(PG8_SA(0, 0), a2, voffA);
            PG8_BAR; PG8_WAIT_L(0); PG8_MMA(1, 0, At, B0); PG8_BAR; PG8_SCHED;
            PG8_STAGE(PG8_SB(0, 1), b2 + hstep, voffB);
            PG8_WAIT_V(6); PG8_BAR; PG8_MMA(1, 1, At, B1); PG8_BAR;
            PG8_LDB(B0, 1, 0); PG8_SCHED; PG8_LDA(At, 1, 0); PG8_STAGE(PG8_SA(0, 1), a2 + hstep, voffA);
            PG8_WAIT_L(8); PG8_BAR; PG8_WAIT_L(0); PG8_MMA(0, 0, At, B0); PG8_BAR; PG8_SCHED;
            PG8_LDB(B1, 1, 1); PG8_STAGE(PG8_SB(1, 0), b3, voffB);
            PG8_BAR; PG8_WAIT_L(0); PG8_MMA(0, 1, At, B1); PG8_BAR;
            PG8_LDA(At, 1, 1); PG8_STAGE(PG8_SA(1, 0), a3, voffA);
            PG8_BAR; PG8_WAIT_L(0); PG8_MMA(1, 0, At, B0); PG8_BAR; PG8_SCHED;
            PG8_STAGE(PG8_SB(1, 1), b3 + hstep, voffB);
            PG8_WAIT_V(6); PG8_BAR; PG8_MMA(1, 1, At, B1); PG8_BAR;
        }
#if defined(PROBE_KIND) && PROBE_KIND == 4
        { unsigned t0_ = 0; if (blockIdx.x == 0 && threadIdx.x == 0) t0_ = (unsigned)wall_clock64();
          E(acc, cur, wr, wc, fr, fq);
          if (blockIdx.x == 0 && threadIdx.x == 0) { asm volatile("s_waitcnt vmcnt(0)" ::: "memory"); volatile LAS unsigned* pw_ = (volatile LAS unsigned*)(lds + LDS_BYTES - 48); pw_[2] += (unsigned)wall_clock64() - t0_; } }
#else
        E(acc, cur, wr, wc, fr, fq);
#endif
        if (!has_next) break;
#pragma unroll
        for (int a = 0; a < 2; ++a)
#pragma unroll
            for (int b = 0; b < 2; ++b)
#pragma unroll
                for (int m = 0; m < 4; ++m)
#pragma unroll
                    for (int n = 0; n < 2; ++n) acc[a][b][m][n] = (f32x4){0.f, 0.f, 0.f, 0.f};
        cur = nxt; cA = nA; cB = nB; ++ui;
    }
    PG8_WAIT_V(0);
    if (wr == 0) PG8_BAR;
    PG8_BAR;
#undef PG8_SA
#undef PG8_SB
#undef PG8_STAGE
#undef PG8_LDA
#undef PG8_LDB
#undef PG8_MMA
#undef PG8_WAIT_V
#undef PG8_WAIT_L
#undef PG8_BAR
#undef PG8_SCHED
}
template <class Epi, class Sched>
__device__ __forceinline__ void gemm_phase_gather(LAS unsigned char* lds, const Gemm g, const Sched& S, const Epi& E, const int* __restrict__ srow) {
    const int tid = my_tid(), wid = __builtin_amdgcn_readfirstlane(tid >> 6), lane = tid & 63, wr = wid >> 2, wc = wid & 3, fr = lane & 15, fq = lane >> 4;
    const int K = g.K, nt = K / BK;
    unsigned voffB[2];
#pragma unroll
    for (int i = 0; i < 2; ++i) { int R, C; stage_rc(tid * 16 + i * 8192, R, C); const int Rb = Epi::PERM ? ((R & ~31) + perm32(R & 31)) : R;
        voffB[i] = (unsigned)(Rb * K + C) * 2u; }
    unsigned gcur[2][2], gnxt[2][2];
#define PG8_LOADG(dst, u) do { const int _t = my_tid(); _Pragma("unroll") for (int _i = 0; _i < 2; ++_i) { int _R, _C; stage_rc(_t * 16 + _i * 8192, _R, _C); _Pragma("unroll") for (int _h = 0; _h < 2; ++_h) \
        dst[_h][_i] = (unsigned)srow[(u).pm * 256 + 128 * _h + _R] * (unsigned)(K * 2) + (unsigned)_C * 2u; } } while (0)
#define PG8_STAGEG(bufoff, gofs, kbyte) do { _Pragma("unroll") for (int _i = 0; _i < 2; ++_i) \
        __builtin_amdgcn_global_load_lds((const unsigned*)((const char*)g.A + (gofs)[_i] + (kbyte)), (LAS unsigned*)(lds + (bufoff) + ldsw + _i * 8192), 16, 0, 0); } while (0)
    const size_t kstep = (size_t)(BK * 2);
    const size_t hstep = (size_t)HALF * K * 2;
    const size_t tstep = 2 * hstep;
    const unsigned ldsw = (unsigned)wid * 1024u;
    const int aoff = lds_byte(wr * 64 + fr, fq * 8), boff = lds_byte(wc * 32 + fr, fq * 8);
#define PG8_SA(b, h) (((b) * 2 + (h)) * HTB)
#define PG8_SB(b, h) ((4 + (b) * 2 + (h)) * HTB)
#define PG8_STAGE(bufoff, gbase, voff) do { _Pragma("unroll") for (int _i = 0; _i < 2; ++_i) \
        __builtin_amdgcn_global_load_lds((const unsigned*)((const char*)(gbase) + (voff)[_i]), (LAS unsigned*)(lds + (bufoff) + ldsw + _i * 8192), 16, 0, 0); } while (0)
#define PG8_LDA(dst, b, h) do { _Pragma("unroll") for (int m = 0; m < 4; ++m) _Pragma("unroll") for (int k = 0; k < 2; ++k) dst[m][k] = *(const LAS bf16x8*)(lds + PG8_SA(b, h) + aoff + m * 2048 + k * 1024); } while (0)
#define PG8_LDB(dst, b, h) do { _Pragma("unroll") for (int n = 0; n < 2; ++n) _Pragma("unroll") for (int k = 0; k < 2; ++k) dst[n][k] = *(const LAS bf16x8*)(lds + PG8_SB(b, h) + boff + n * 2048 + k * 1024); } while (0)
#define PG8_MMA(ai, bj, At, Bt) do { __builtin_amdgcn_s_setprio(1); _Pragma("unroll") for (int m = 0; m < 4; ++m) _Pragma("unroll") for (int n = 0; n < 2; ++n) _Pragma("unroll") for (int k = 0; k < 2; ++k) \
        acc[ai][bj][m][n] = __builtin_amdgcn_mfma_f32_16x16x32_bf16(Bt[n][k], At[m][k], acc[ai][bj][m][n], 0, 0, 0); __builtin_amdgcn_s_setprio(0); } while (0)
#define PG8_WAIT_V(n) asm volatile("s_waitcnt vmcnt(" #n ")" ::: "memory")
#define PG8_WAIT_L(n) asm volatile("s_waitcnt lgkmcnt(" #n ")" ::: "memory")
#define PG8_BAR __builtin_amdgcn_s_barrier()
#define PG8_SCHED __builtin_amdgcn_sched_barrier(0)
    Unit cur, nxt; int ui = 0;
    if (!S.next(0, cur)) return;
    f32x4 acc[2][2][4][2];
#pragma unroll
    for (int a = 0; a < 2; ++a)
#pragma unroll
        for (int b = 0; b < 2; ++b)
#pragma unroll
            for (int m = 0; m < 4; ++m)
#pragma unroll
                for (int n = 0; n < 2; ++n) acc[a][b][m][n] = (f32x4){0.f, 0.f, 0.f, 0.f};
    bf16x8 At[4][2], B0[2][2], B1[2][2];
    const char* cB = (const char*)g.Bt + (size_t)cur.pn * tstep;
    PG8_LOADG(gcur, cur);
    PG8_STAGE(PG8_SB(0, 0), cB, voffB); PG8_STAGEG(PG8_SA(0, 0), gcur[0], 0); PG8_STAGE(PG8_SB(0, 1), cB + hstep, voffB); PG8_STAGEG(PG8_SA(0, 1), gcur[1], 0);
    if (wr == 1) PG8_BAR;
    PG8_WAIT_V(4); PG8_BAR;
    PG8_STAGE(PG8_SB(1, 0), cB + kstep, voffB); PG8_STAGEG(PG8_SA(1, 0), gcur[0], kstep); PG8_STAGE(PG8_SB(1, 1), cB + hstep + kstep, voffB);
    PG8_WAIT_V(6); PG8_BAR;
    for (;;) {
        const bool has_next = S.next(ui + 1, nxt);
        const char* nB = has_next ? (const char*)g.Bt + (size_t)nxt.pn * tstep : cB;
        if (has_next) PG8_LOADG(gnxt, nxt); else { gnxt[0][0] = gcur[0][0]; gnxt[0][1] = gcur[0][1]; gnxt[1][0] = gcur[1][0]; gnxt[1][1] = gcur[1][1]; }
        for (int t = 0; t < nt; t += 2) {
            const bool last = (t == nt - 2);
            const size_t k1 = (size_t)(t + 1) * kstep, k2 = last ? 0 : (size_t)(t + 2) * kstep, k3 = k2 + kstep;
            const char* b2 = last ? nB : cB + (size_t)(t + 2) * kstep; const char* b3 = b2 + kstep;
            unsigned g0[2], g1[2];
            g0[0] = last ? gnxt[0][0] : gcur[0][0]; g0[1] = last ? gnxt[0][1] : gcur[0][1]; g1[0] = last ? gnxt[1][0] : gcur[1][0]; g1[1] = last ? gnxt[1][1] : gcur[1][1];
            PG8_LDB(B0, 0, 0); PG8_SCHED; PG8_LDA(At, 0, 0); PG8_STAGEG(PG8_SA(1, 1), gcur[1], k1);
            PG8_WAIT_L(8); PG8_BAR; PG8_WAIT_L(0); PG8_MMA(0, 0, At, B0); PG8_BAR; PG8_SCHED;
            PG8_LDB(B1, 0, 1); PG8_STAGE(PG8_SB(0, 0), b2, voffB);
            PG8_BAR; PG8_WAIT_L(0); PG8_MMA(0, 1, At, B1); PG8_BAR;
            PG8_LDA(At, 0, 1); PG8_STAGEG(PG8_SA(0, 0), g0, k2);
            PG8_BAR; PG8_WAIT_L(0); PG8_MMA(1, 0, At, B0); PG8_BAR; PG8_SCHED;
            PG8_STAGE(PG8_SB(0, 1), b2 + hstep, voffB);
            PG8_WAIT_V(6); PG8_BAR; PG8_MMA(1, 1, At, B1); PG8_BAR;
            PG8_LDB(B0, 1, 0); PG8_SCHED; PG8_LDA(At, 1, 0); PG8_STAGEG(PG8_SA(0, 1), g1, k2);
            PG8_WAIT_L(8); PG8_BAR; PG8_WAIT_L(0); PG8_MMA(0, 0, At, B0); PG8_BAR; PG8_SCHED;
            PG8_LDB(B1, 1, 1); PG8_STAGE(PG8_SB(1, 0), b3, voffB);
            PG8_BAR; PG8_WAIT_L(0); PG8_MMA(0, 1, At, B1); PG8_BAR;
            PG8_LDA(At, 1, 1); PG8_STAGEG(PG8_SA(1, 0), g0, k3);
            PG8_BAR; PG8_WAIT_L(0); PG8_MMA(1, 0, At, B0); PG8_BAR; PG8_SCHED;
            PG8_STAGE(PG8_SB(1, 1), b3 + hstep, voffB);
            PG8_WAIT_V(6); PG8_BAR; PG8_MMA(1, 1, At, B1); PG8_BAR;
        }
#if defined(PROBE_KIND) && PROBE_KIND == 4
        { unsigned t0_ = 0; if (blockIdx.x == 0 && threadIdx.x == 0) t0_ = (unsigned)wall_clock64();
          E(acc, cur, wr, wc, fr, fq);
          if (blockIdx.x == 0 && threadIdx.x == 0) { asm volatile("s_waitcnt vmcnt(0)" ::: "memory"); volatile LAS unsigned* pw_ = (volatile LAS unsigned*)(lds + LDS_BYTES - 48); pw_[2] += (unsigned)wall_clock64() - t0_; } }
#else
        E(acc, cur, wr, wc, fr, fq);
#endif
        if (!has_next) break;
#pragma unroll
        for (int a = 0; a < 2; ++a)
#pragma unroll
            for (int b = 0; b < 2; ++b)
#pragma unroll
                for (int m = 0; m < 4; ++m)
#pragma unroll
                    for (int n = 0; n < 2; ++n) acc[a][b][m][n] = (f32x4){0.f, 0.f, 0.f, 0.f};
        cur = nxt; cB = nB; ++ui;
        gcur[0][0] = gnxt[0][0]; gcur[0][1] = gnxt[0][1]; gcur[1][0] = gnxt[1][0]; gcur[1][1] = gnxt[1][1];
    }
    PG8_WAIT_V(0);
    if (wr == 0) PG8_BAR;
    PG8_BAR;
#undef PG8_LOADG
#undef PG8_STAGEG
#undef PG8_SA
#undef PG8_SB
#undef PG8_STAGE
#undef PG8_LDA
#undef PG8_LDB
#undef PG8_MMA
#undef PG8_WAIT_V
#undef PG8_WAIT_L
#undef PG8_BAR
#undef PG8_SCHED
}
}
using pg8::Unit;
struct InProjOrder { int G, c;
    __device__ __forceinline__ bool next(int i, Unit& u) const {
        const int L = i * G + c; if (L >= 3264) return false;
        int pm, pn;
        if (L < 2448) { pg8::static_unit(L, 272, 9, pm, pn); u.pm = pm; u.pn = 272 + pn; }
        else { pg8::static_unit(L - 2448, 3, 272, pm, pn); u.pm = 281 + pm; u.pn = pn; }
        return true; } };
struct OutProjOrder { int G, c, nM;
    __device__ __forceinline__ bool next(int i, Unit& u) const {
        const int L = i * G + c; if (L >= nM * 4) return false;
        pg8::static_unit(L, nM, 4, u.pm, u.pn); return true; } };
struct GateUpOrder { int G, c, nM;
    __device__ __forceinline__ bool next(int i, Unit& u) const {
        const int per = nM * 8; const int L = i * G + c; if (L >= 16 * per) return false;
        const int e = L / per; int pm, pn; pg8::static_unit(L - e * per, nM, 8, pm, pn); u.pm = e * 34 + pm; u.pn = e * 8 + pn; return true; } };
struct DownOrder { int G, c, nM;
    __device__ __forceinline__ bool next(int i, Unit& u) const {
        const int per = nM * 4; const int L = i * G + c; if (L >= 16 * per) return false;
        const int e = L / per; int pm, pn; pg8::static_unit(L - e * per, nM, 4, pm, pn); u.pm = e * 34 + pm; u.pn = e * 4 + pn; return true; } };

#define EPI_TAB_OFF 131072
struct EpiInProj { static constexpr bool PERM = true; bf16_t* P; bf16_t* UT; const LAS unsigned char* tab;
    __device__ __forceinline__ void operator()(const f32x4 (&acc)[2][2][4][2], const Unit& u, int wr, int wc, int fr, int fq) const {
        bf16_t* base; int ldc, rt, ct;
        if (u.pn >= 272) { base = P; ldc = PW; rt = u.pm; ct = u.pn - 272; } else { base = UT; ldc = NROW; rt = u.pm - 281; ct = u.pn; }
        const int row0 = rt * 256 + wr * 64 + fr, col0 = ct * 256 + wc * 32 + 8 * fq;
        if (u.pn >= 272 && ct < 2) {
            const bool nrm = ct == 0 || wc < 2;
            const int colA = ct * 256 + wc * 64 + 8 * fq;
            const LAS float* gnp = (const LAS float*)(tab + 12288) + (ct == 0 ? 0 : 64) + 8 * fq;
            const float qs = ct == 0 ? 0.125f * LOG2E : 1.0f;
            const bool hi = (fq >> 1) != 0; const int lane_ = fr + 16 * fq;
#pragma unroll
            for (int ai = 0; ai < 2; ++ai)
#pragma unroll
                for (int m = 0; m < 4; ++m) { const int row = row0 + ai * 128 + m * 16; const bool lat = row < NROWL; const int t = row & 4095;
                    bf16_t* rowp = base + (size_t)row * ldc + colA;
                    float inv = 1.0f;
                    if (nrm) { float ss = 0.f;
#pragma unroll
                        for (int bj = 0; bj < 2; ++bj)
#pragma unroll
                            for (int n = 0; n < 2; ++n)
#pragma unroll
                                for (int e = 0; e < 4; ++e) ss += acc[ai][bj][m][n][e] * acc[ai][bj][m][n][e];
                        ss += lane_xor16(ss, lane_); ss += lane_xor32(ss, lane_);
                        inv = rsqrtf(ss * (1.0f / 64.0f) + EPSF); }
#pragma unroll
                    for (int bj = 0; bj < 2; ++bj) { const f32x4 v0 = acc[ai][bj][m][0], v1 = acc[ai][bj][m][1];
                        float o[8] = {v0[0], v0[1], v0[2], v0[3], v1[0], v1[1], v1[2], v1[3]};
                        if (nrm) {
                            const f32x4 ga = *(const LAS f32x4*)(gnp + bj * 32), gb = *(const LAS f32x4*)(gnp + bj * 32 + 4);
                            const float gn[8] = {ga[0], ga[1], ga[2], ga[3], gb[0], gb[1], gb[2], gb[3]};
                            const int pos = bj == 0 ? (t >> 6) : (t & 63);
                            const LAS f32x4* rp = (const LAS f32x4*)(tab + pos * 128 + 64 * (fq & 1));
                            const f32x4 r0 = rp[0], r1 = rp[1], r2 = rp[2], r3 = rp[3];
                            const float cs[8] = {r0[0], r0[2], r1[0], r1[2], r2[0], r2[2], r3[0], r3[2]}, sn[8] = {r0[1], r0[3], r1[1], r1[3], r2[1], r2[3], r3[1], r3[3]};
#pragma unroll
                            for (int i = 0; i < 8; ++i) { const float y = o[i] * inv * gn[i]; const float pr = lane_xor32(y, lane_);
                                o[i] = (lat ? (hi ? y * cs[i] + pr * sn[i] : y * cs[i] - pr * sn[i]) : y) * qs; } }
                        u32x4 w; w.x = pg8::cvt_pk_bf16(o[0], o[1]); w.y = pg8::cvt_pk_bf16(o[2], o[3]); w.z = pg8::cvt_pk_bf16(o[4], o[5]); w.w = pg8::cvt_pk_bf16(o[6], o[7]);
                        *(u32x4*)(rowp + bj * 32) = w; } }
            return;
        }
        if (u.pn >= 272 && (ct == 6 || ct == 7)) {
            const LAS float* gnp = (const LAS float*)(tab + 12288) + (ct == 6 ? 128 : 160) + 8 * fq;
            const f32x4 ga = *(const LAS f32x4*)gnp, gb = *(const LAS f32x4*)(gnp + 4);
            const float gn[8] = {ga[0], ga[1], ga[2], ga[3], gb[0], gb[1], gb[2], gb[3]};
            const float qs = ct == 6 ? 0.17677669529663687f * LOG2E : 1.0f;
            const bool hi = (fq & 1) != 0; const int lane_ = fr + 16 * fq;
#pragma unroll
            for (int ai = 0; ai < 2; ++ai)
#pragma unroll
                for (int m = 0; m < 4; ++m) { const int row = row0 + ai * 128 + m * 16; const bool lat = row < NROWL; const int t = row & 4095;
                    const int pos = (fq >> 1) == 0 ? (t >> 6) : (t & 63);
                    const LAS f32x4* rp = (const LAS f32x4*)(tab + 8192 + pos * 64);
                    const f32x4 r0 = rp[0], r1 = rp[1], r2 = rp[2], r3 = rp[3];
                    const float cs[8] = {r0[0], r0[2], r1[0], r1[2], r2[0], r2[2], r3[0], r3[2]}, sn[8] = {r0[1], r0[3], r1[1], r1[3], r2[1], r2[3], r3[1], r3[3]};
                    bf16_t* rowp = base + (size_t)row * ldc + col0;
#pragma unroll
                    for (int bj = 0; bj < 2; ++bj) { const f32x4 v0 = acc[ai][bj][m][0], v1 = acc[ai][bj][m][1];
                        float x[8] = {v0[0], v0[1], v0[2], v0[3], v1[0], v1[1], v1[2], v1[3]};
                        float ss = 0.f;
#pragma unroll
                        for (int i = 0; i < 8; ++i) ss += x[i] * x[i];
                        ss += lane_xor16(ss, lane_); ss += lane_xor32(ss, lane_);
                        const float inv = rsqrtf(ss * (1.0f / 32.0f) + EPSF);
                        float o[8];
#pragma unroll
                        for (int i = 0; i < 8; ++i) { const float y = x[i] * inv * gn[i]; const float pr = lane_xor16(y, lane_);
                            o[i] = (lat ? (hi ? y * cs[i] + pr * sn[i] : y * cs[i] - pr * sn[i]) : y) * qs; }
                        u32x4 w; w.x = pg8::cvt_pk_bf16(o[0], o[1]); w.y = pg8::cvt_pk_bf16(o[2], o[3]); w.z = pg8::cvt_pk_bf16(o[4], o[5]); w.w = pg8::cvt_pk_bf16(o[6], o[7]);
                        *(u32x4*)(rowp + bj * 128) = w; } }
            return;
        }
#pragma unroll
        for (int ai = 0; ai < 2; ++ai)
#pragma unroll
            for (int m = 0; m < 4; ++m) { bf16_t* rowp = base + (size_t)(row0 + ai * 128 + m * 16) * ldc + col0;
#pragma unroll
                for (int bj = 0; bj < 2; ++bj) { const f32x4 v0 = acc[ai][bj][m][0], v1 = acc[ai][bj][m][1];
                    u32x4 w; w.x = pg8::cvt_pk_bf16(v0[0], v0[1]); w.y = pg8::cvt_pk_bf16(v0[2], v0[3]); w.z = pg8::cvt_pk_bf16(v1[0], v1[1]); w.w = pg8::cvt_pk_bf16(v1[2], v1[3]);
                    *(u32x4*)(rowp + bj * 128) = w; } }
    } };
__device__ __forceinline__ float silu_mul(float g, float u) { return g * u * __builtin_amdgcn_rcpf(1.0f + fast_exp2(-g * LOG2E)); }
struct EpiGU { static constexpr bool PERM = true; bf16_t* HID;
    __device__ __forceinline__ void operator()(const f32x4 (&acc)[2][2][4][2], const Unit& u, int wr, int wc, int fr, int fq) const {
        const int row0 = u.pm * 256 + wr * 64 + fr, col0 = (u.pn & 7) * 128 + wc * 32 + 8 * fq;
#pragma unroll
        for (int ai = 0; ai < 2; ++ai)
#pragma unroll
            for (int m = 0; m < 4; ++m) { bf16_t* rowp = HID + (size_t)(row0 + ai * 128 + m * 16) * DM + col0;
                const f32x4 g0 = acc[ai][0][m][0], g1 = acc[ai][0][m][1], u0 = acc[ai][1][m][0], u1 = acc[ai][1][m][1];
                u32x4 w; w.x = pg8::cvt_pk_bf16(silu_mul(g0[0], u0[0]), silu_mul(g0[1], u0[1])); w.y = pg8::cvt_pk_bf16(silu_mul(g0[2], u0[2]), silu_mul(g0[3], u0[3]));
                w.z = pg8::cvt_pk_bf16(silu_mul(g1[0], u1[0]), silu_mul(g1[1], u1[1])); w.w = pg8::cvt_pk_bf16(silu_mul(g1[2], u1[2]), silu_mul(g1[3], u1[3]));
                *(u32x4*)rowp = w; }
    } };
struct EpiDown { static constexpr bool PERM = true; bf16_t* Y; const float* sgate;
    __device__ __forceinline__ void operator()(const f32x4 (&acc)[2][2][4][2], const Unit& u, int wr, int wc, int fr, int fq) const {
        const int row0 = u.pm * 256 + wr * 64 + fr, col0 = (u.pn & 3) * 256 + wc * 32 + 8 * fq;
#pragma unroll
        for (int ai = 0; ai < 2; ++ai)
#pragma unroll
            for (int m = 0; m < 4; ++m) { const int r = row0 + ai * 128 + m * 16; const float gt = sgate[r]; bf16_t* rowp = Y + (size_t)r * DM + col0;
#pragma unroll
                for (int bj = 0; bj < 2; ++bj) { const f32x4 v0 = acc[ai][bj][m][0] * gt, v1 = acc[ai][bj][m][1] * gt;
                    u32x4 w; w.x = pg8::cvt_pk_bf16(v0[0], v0[1]); w.y = pg8::cvt_pk_bf16(v0[2], v0[3]); w.z = pg8::cvt_pk_bf16(v1[0], v1[1]); w.w = pg8::cvt_pk_bf16(v1[2], v1[3]);
                    *(u32x4*)(rowp + bj * 128) = w; } }
    } };
struct EpiOut { static constexpr bool PERM = true; const float* srcL; const float* srcC; bf16_t* XB; const float* MOD; int first;
    __device__ __forceinline__ void operator()(const f32x4 (&acc)[2][2][4][2], const Unit& u, int wr, int wc, int fr, int fq) const {
        const float* gt = MOD + (size_t)(u.pm < 256 ? (u.pm >> 4) : 16) * 6144 + 2048;
        const int row0 = u.pm * 256 + wr * 64 + fr, col0 = u.pn * 256 + wc * 32 + 8 * fq;
        f32x4 gv[2][2];
#pragma unroll
        for (int bj = 0; bj < 2; ++bj)
#pragma unroll
            for (int n = 0; n < 2; ++n) gv[bj][n] = *(const f32x4*)(gt + col0 + bj * 128 + n * 4);
#pragma unroll
        for (int ai = 0; ai < 2; ++ai)
#pragma unroll
            for (int m = 0; m < 4; ++m) { const int row = row0 + ai * 128 + m * 16;
                bf16_t* xrow = XB + (size_t)row * DM + col0;
                const float* frow = (row < NROWL ? srcL + (size_t)row * DM : srcC + (size_t)(row - NROWL) * DM) + col0;
#pragma unroll
                for (int bj = 0; bj < 2; ++bj) {
                    f32x4 s0, s1;
                    if (first) { s0 = *(const f32x4*)(frow + bj * 128); s1 = *(const f32x4*)(frow + bj * 128 + 4); }
                    else { const u32x4 raw = *(const u32x4*)(xrow + bj * 128);
                        s0 = (f32x4){bflo(raw.x), bfhi(raw.x), bflo(raw.y), bfhi(raw.y)}; s1 = (f32x4){bflo(raw.z), bfhi(raw.z), bflo(raw.w), bfhi(raw.w)}; }
                    const f32x4 v0 = s0 + gv[bj][0] * acc[ai][bj][m][0], v1 = s1 + gv[bj][1] * acc[ai][bj][m][1];
                    u32x4 w; w.x = pg8::cvt_pk_bf16(v0[0], v0[1]); w.y = pg8::cvt_pk_bf16(v0[2], v0[3]); w.z = pg8::cvt_pk_bf16(v1[0], v1[1]); w.w = pg8::cvt_pk_bf16(v1[2], v1[3]);
                    *(u32x4*)(xrow + bj * 128) = w; } }
    } };

__device__ __forceinline__ f32x16 mma32(const bf16_t* A, int lda, const bf16_t* Bt, int ldb, int K, f32x16 acc, int lane) {
    const int r = lane & 31, h = lane >> 5;
    const bf16_t* ap = A + r * lda + 8 * h; const bf16_t* bp = Bt + r * ldb + 8 * h;
    for (int k = 0; k < K; k += 16) {
        const bf16x8 a = *(const bf16x8*)(ap + k); const bf16x8 b = *(const bf16x8*)(bp + k);
        acc = __builtin_amdgcn_mfma_f32_32x32x16_bf16(a, b, acc, 0, 0, 0);
    }
    return acc;
}
#define CROW(reg, lane) (((reg) & 3) + 8 * ((reg) >> 2) + 4 * ((lane) >> 5))
typedef short v4i16_t __attribute__((ext_vector_type(4)));
__device__ __forceinline__ s16x4 tr_read(const LAS unsigned char* ptr) { return __builtin_bit_cast(s16x4, __builtin_amdgcn_ds_read_tr16_b64_v4i16((LAS v4i16_t*)ptr)); }
struct TrDesc { const float* src; bf16_t* dst; int src_ld, src_col0, k0, n0, hi_off; };
__device__ __forceinline__ void tr_load(const TrDesc& d, int t, float4 (&v)[2]) {
#pragma unroll
    for (int p = 0; p < 2; ++p) { const int j = (t >> 4) + 32 * p; v[p] = *(const float4*)(d.src + (size_t)(d.k0 + j) * d.src_ld + d.src_col0 + (t & 15) * 4 + ((t & 8) ? d.hi_off : 0)); }
}
__device__ __forceinline__ void tr_store(unsigned char* smem, const TrDesc& d, int t, const float4 (&v)[2]) {
    float* tile = (float*)smem;
#pragma unroll
    for (int p = 0; p < 2; ++p) { const int j = (t >> 4) + 32 * p; float* q = tile + j * 65 + (t & 15) * 4; q[0] = v[p].x; q[1] = v[p].y; q[2] = v[p].z; q[3] = v[p].w; }
    __syncthreads();
    { const int i = t >> 3, kc = (t & 7) * 8;
      u32x4 w;
      w.x = pack_bf16(tile[(kc + 0) * 65 + i], tile[(kc + 1) * 65 + i]); w.y = pack_bf16(tile[(kc + 2) * 65 + i], tile[(kc + 3) * 65 + i]);
      w.z = pack_bf16(tile[(kc + 4) * 65 + i], tile[(kc + 5) * 65 + i]); w.w = pack_bf16(tile[(kc + 6) * 65 + i], tile[(kc + 7) * 65 + i]);
      *(u32x4*)(d.dst + (size_t)(d.n0 + i) * DM + d.k0 + kc) = w; }
    __syncthreads();
}

template <int PART>
__device__ __forceinline__ void phase_W(const Params& p, int l, unsigned char* smem) {
    unsigned char* ws = launder_ws(p.ws);
    const int tid = my_tid(), G = gridDim.x, bid = blockIdx.x;
    if (PART == 0 && bid == 0) {
        float2* rA = (float2*)(ws + WS_ROPE); float2* rD = rA + 64 * 16;
        for (int idx = tid; idx < 64 * 16; idx += NTHR) { const int pos = idx >> 4, f = idx & 15; const float inv = powf(10000.0f, -(float)f / 16.0f); float sn, cs; sincosf((float)pos * inv, &sn, &cs); rA[idx] = make_float2(cs, sn); }
        for (int idx = tid; idx < 64 * 8; idx += NTHR) { const int pos = idx >> 3, f = idx & 7; const float inv = powf(10000.0f, -(float)f / 8.0f); float sn, cs; sincosf((float)pos * inv, &sn, &cs); rD[idx] = make_float2(cs, sn); }
    }
    if (PART == 0) { int4* inv4 = (int4*)(ws + WS_INV); const int n4 = NROW * 16 / 4;
      for (int i = bid * NTHR + tid; i < n4; i += G * NTHR) inv4[i] = make_int4(-1, -1, -1, -1); }
    const float* w_in = PIN(I_WIN) + (size_t)l * DM * INW;
    const float* w_out = PIN(I_WOUT) + (size_t)l * DM * DM;
    const float* weg = PIN(I_WEG) + (size_t)l * NEXP * DM * DM;
    const float* weu = PIN(I_WEU) + (size_t)l * NEXP * DM * DM;
    const float* wed = PIN(I_WED) + (size_t)l * NEXP * DM * DM;
    bf16_t* WinT = (bf16_t*)(ws + WS_U) + (size_t)NROW * DM;
    bf16_t* WoutT = (bf16_t*)(ws + WS_WOUT);
    bf16_t* WguT = (bf16_t*)(ws + WS_WGU);
    bf16_t* WdT = (bf16_t*)(ws + WS_WD);
    const int N_IN = 768, N_OUT = 256, N_GU = 8192, N_D = 4096, N_ADA = 96, N_HID = 544;
    const int NCVT = N_IN + N_OUT + N_GU + N_D;
    auto tr_desc = [&](int x, TrDesc& d) {
        if (x < N_IN) { const int nt = x >> 4, kt = x & 15, n0 = nt * 64;
            int sc; d.hi_off = 0; if (n0 < 512) { const int b4 = (n0 >> 6) & 3; sc = (n0 & 256) + (b4 & 1) * 128 + (b4 >> 1) * 32; d.hi_off = 32; } else if (n0 < 1536) sc = n0 + 768; else if (n0 < 2304) sc = n0 + 784; else sc = n0 - 1792;
            d.src = w_in; d.src_ld = INW; d.src_col0 = sc; d.k0 = kt * 64; d.dst = WinT; d.n0 = n0; return; }
        x -= N_IN;
        if (x < N_OUT) { const int nt = x >> 4, kt = x & 15; d.hi_off = 0; d.src = w_out; d.src_ld = DM; d.src_col0 = nt * 64; d.k0 = kt * 64; d.dst = WoutT; d.n0 = nt * 64; return; }
        x -= N_OUT;
        if (x < N_GU) { const int e = x >> 9, r = x & 511, nt = r >> 4, kt = r & 15, n0 = nt * 64;
            const int j = n0 >> 8, rr = n0 & 255;
            d.hi_off = 0; d.src = (rr < 128 ? weg : weu) + (size_t)e * DM * DM; d.src_ld = DM; d.src_col0 = j * 128 + (rr & 127); d.k0 = kt * 64; d.dst = WguT + (size_t)e * 2048 * DM; d.n0 = n0; return; }
        x -= N_GU;
        { const int e = x >> 8, r = x & 255, nt = r >> 4, kt = r & 15;
          d.hi_off = 0; d.src = wed + (size_t)e * DM * DM; d.src_ld = DM; d.src_col0 = nt * 64; d.k0 = kt * 64; d.dst = WdT + (size_t)e * DM * DM; d.n0 = nt * 64; }
    };
    if (PART < 2) {
        TrDesc cur, nxt; float4 va[2], vb[2];
        if (bid < NCVT) { tr_desc(bid, cur); tr_load(cur, tid, va); }
        for (int it = bid; it < NCVT; it += G) {
            const bool more = it + G < NCVT;
            if (more) { tr_desc(it + G, nxt); tr_load(nxt, tid, vb); }
            tr_store(smem, cur, tid, va);
            if (more) { cur = nxt; va[0] = vb[0]; va[1] = vb[1]; }
        }
    }
    const int ibeg = (PART == 3) ? N_ADA : 0;
    const int total = (PART == 1) ? 0 : (PART == 2 ? N_ADA : N_ADA + N_HID);
    const int nheavy = (PART == 2) ? G / 4 : (PART == 3 ? G / 2 : 0);
    const int it0 = ibeg + (bid >= nheavy ? bid - nheavy : total), istride = G - nheavy;
    for (int it = it0; it < total; it += istride) {
        int x = it;
        if (x < N_ADA) {
            const int n0 = x * 64;
            float* sv = (float*)smem;
            float* red = sv + 17 * 1024;
            const float* c = PIN(I_C); const float* cc = PIN(I_CCTX);
            for (int idx = tid; idx < 17 * 1024; idx += NTHR) { const int r = idx >> 10, k = idx & 1023; const float v = r < 16 ? c[r * 1024 + k] : cc[k]; sv[idx] = v / (1.0f + expf(-v)); }
            __syncthreads();
            const int w = tid >> 6, lane = tid & 63;
            float acc[17];
#pragma unroll
            for (int r = 0; r < 17; ++r) acc[r] = 0.f;
            const float* wa = PIN(I_WADA) + (size_t)l * DM * 6144 + n0 + lane;
            for (int k0 = 128 * w; k0 < 128 * w + 128; k0 += 32) {
                float wv[32];
#pragma unroll
                for (int u = 0; u < 32; ++u) wv[u] = wa[(size_t)(k0 + u) * 6144];
#pragma unroll
                for (int u = 0; u < 32; ++u)
#pragma unroll
                    for (int r = 0; r < 17; ++r) acc[r] += sv[r * 1024 + k0 + u] * wv[u];
            }
#pragma unroll
            for (int r = 0; r < 17; ++r) red[(w * 17 + r) * 64 + lane] = acc[r];
            __syncthreads();
            float* MOD = (float*)(ws + WS_MOD + (size_t)(l & 1) * MOD_BYTES); const float* ba = PIN(I_BADA) + (size_t)l * 6144;
            for (int idx = tid; idx < 17 * 64; idx += NTHR) { const int r = idx >> 6, j = idx & 63; float s = ba[n0 + j];
#pragma unroll
                for (int ww = 0; ww < 8; ++ww) s += red[(ww * 17 + r) * 64 + j];
                MOD[(size_t)r * 6144 + n0 + j] = s; }
            __syncthreads();
            continue; }
        x -= N_ADA;
        {
            const bool isc = x >= 512; const int L = isc ? 256 : 4096; const int lagbase = (isc ? x - 512 : x) * 8;
            float* zf = (float*)smem;
            float* h1s = zf + 8 * 36;
            const int li = tid >> 6, j = tid & 63, lag = lagbase + li;
            if (j < 33) { float v;
                if (j == 0) v = (float)lag / (float)(L - 1);
                else { const int bi = (j - 1) & 15; const float band = 1e-4f + (float)bi * ((15.0f - 1e-4f) / 15.0f); const float w = 6.283185307179586f * (float)lag / (float)L; const float a = band * w;
                       v = (j <= 16) ? cosf(a) : -sinf(a); }
                zf[li * 36 + j] = v; }
            __syncthreads();
            const float* fw1 = PIN(I_FW1) + (size_t)l * 33 * 64; const float* fb1 = PIN(I_FB1) + l * 64; const float* fr = PIN(I_FREQ) + l * 64;
            const float* fw2 = PIN(I_FW2) + (size_t)l * 64 * 64; const float* fb2 = PIN(I_FB2) + l * 64;
            float a = fb1[j];
#pragma unroll 3
            for (int i = 0; i < 33; ++i) a += zf[li * 36 + i] * fw1[i * 64 + j];
            h1s[li * 64 + j] = sinf(fr[j] * a);
            __syncthreads();
            float a2 = fb2[j];
#pragma unroll 4
            for (int i = 0; i < 64; ++i) a2 += h1s[li * 64 + i] * fw2[i * 64 + j];
            float* H2 = (float*)(ws + (isc ? WS_HID2C : WS_HID2L));
            H2[(size_t)j * L + lag] = sinf(fr[j] * a2);
            __syncthreads();
        }
    }
}

template <int WHICH>
__device__ __forceinline__ void phase_norm(const Params& p, int l, unsigned char* smem) {
    unsigned char* ws = launder_ws(p.ws);
    const int tid = my_tid(), lane = tid & 63, wave = tid >> 6;
    float* Wg = (float*)smem;
    for (int idx = tid; idx < 16384; idx += NTHR) { const int k = idx >> 4, j = idx & 15;
        Wg[j * 1024 + k] = (WHICH == 1) ? PIN(I_WIN)[(size_t)l * DM * INW + (size_t)k * INW + 2304 + j] : PIN(I_WROUTER)[(size_t)l * DM * 16 + k * 16 + j]; }
    __syncthreads();
    const float* gain = PIN(WHICH == 1 ? I_N1G : I_N2G) + (size_t)l * DM;
    const float* MOD = (const float*)(ws + WS_MOD + (size_t)(l & 1) * MOD_BYTES);
    bf16_t* U = (bf16_t*)(ws + WS_U);
    float* outv = (float*)(ws + (WHICH == 1 ? WS_GATES : WS_AFF));
    const float* xl = PIN(I_X); const float* xc = PIN(I_CTX);
    const bf16_t* XB = (const bf16_t*)(ws + WS_XB);
    const int rstride = gridDim.x * 8;
    const int nrows = (WHICH == 2 && l == DEPTH - 1) ? NROWL : NROW;
#define NM_LOAD(dst, r) do { if (WHICH == 1) { const float* s_ = (r) < NROWL ? xl + (size_t)(r) * DM : xc + (size_t)((r) - NROWL) * DM; \
            _Pragma("unroll") for (int i = 0; i < 4; ++i) dst[i] = *(const float4*)(s_ + 256 * i + 4 * lane); } \
        else { const bf16_t* s_ = XB + (size_t)(r) * DM; \
            _Pragma("unroll") for (int i = 0; i < 4; ++i) { const u32x2 w_ = *(const u32x2*)(s_ + 256 * i + 4 * lane); dst[i] = make_float4(bflo(w_.x), bfhi(w_.x), bflo(w_.y), bfhi(w_.y)); } } } while (0)
    float4 cur[4];
    { const int row = blockIdx.x * 8 + wave; NM_LOAD(cur, row); }
    for (int row = blockIdx.x * 8 + wave; row < nrows; row += rstride) {
        float4 nxt[4];
        { const int r2 = row + rstride < nrows ? row + rstride : row; NM_LOAD(nxt, r2); }
        const float* mod = MOD + (size_t)(row < NROWL ? (row >> 12) : 16) * 6144 + (WHICH == 1 ? 0 : 3072);
        float ss = 0.f;
#pragma unroll
        for (int i = 0; i < 4; ++i) ss += cur[i].x * cur[i].x + cur[i].y * cur[i].y + cur[i].z * cur[i].z + cur[i].w * cur[i].w;
        ss = wave_sum(ss);
        const float inv = rsqrtf(ss * (1.0f / 1024.0f) + EPSF);
        float part[16];
#pragma unroll
        for (int j = 0; j < 16; ++j) part[j] = 0.f;
#pragma unroll
        for (int i = 0; i < 4; ++i) { const int k = 256 * i + 4 * lane;
            const float4 v = cur[i];
            const float4 g = *(const float4*)(gain + k), sh = *(const float4*)(mod + k), sc = *(const float4*)(mod + 1024 + k);
            float4 h; h.x = v.x * inv * g.x * (1.f + sc.x) + sh.x; h.y = v.y * inv * g.y * (1.f + sc.y) + sh.y; h.z = v.z * inv * g.z * (1.f + sc.z) + sh.z; h.w = v.w * inv * g.w * (1.f + sc.w) + sh.w;
            u32x2 w; w.x = pack_bf16(h.x, h.y); w.y = pack_bf16(h.z, h.w);
            *(u32x2*)(U + (size_t)row * DM + k) = w;
#pragma unroll
            for (int j = 0; j < 16; ++j) { const float4 wv = *(const float4*)(Wg + j * 1024 + k); part[j] += h.x * wv.x + h.y * wv.y + h.z * wv.z + h.w * wv.w; }
            asm volatile("" ::: "memory"); }
#pragma unroll
        for (int i = 0; i < 4; ++i) cur[i] = nxt[i];
        float v1 = reduce16_transpose(part, lane);
        const int jx = ((lane >> 5) & 1) * 8 + ((lane >> 4) & 1) * 4 + ((lane >> 3) & 1) * 2 + ((lane >> 2) & 1);
        float val = v1;
        if (WHICH == 2) { const float mx = wave_max(v1); const float e = expf(v1 - mx); const float sum = wave_sum(e) * 0.25f; val = e / sum; }
        if ((lane & 3) == 0) outv[(size_t)row * 16 + jx] = val;
    }
    __syncthreads();
}

__device__ __forceinline__ void phase_prep(const Params& p, int l, unsigned char* smem) {
    unsigned char* ws = launder_ws(p.ws);
    const int tid = my_tid(), lane = tid & 63, wave = tid >> 6;
    float2* ropeA = (float2*)smem;
    float2* ropeD = ropeA + 64 * 16;
    for (int idx = tid; idx < 64 * 16; idx += NTHR) { const int pos = idx >> 4, f = idx & 15; const float inv = powf(10000.0f, -(float)f / 16.0f); float s, c; sincosf((float)pos * inv, &s, &c); ropeA[idx] = make_float2(c, s); }
    for (int idx = tid; idx < 64 * 8; idx += NTHR) { const int pos = idx >> 3, f = idx & 7; const float inv = powf(10000.0f, -(float)f / 8.0f); float s, c; sincosf((float)pos * inv, &s, &c); ropeD[idx] = make_float2(c, s); }
    __syncthreads();
    bf16_t* P = (bf16_t*)(ws + WS_P);
    const float* aqn = PIN(I_AQN) + l * 64; const float* akn = PIN(I_AKN) + l * 64;
    const float* dqn = PIN(I_DQN) + l * 32; const float* dkn = PIN(I_DKN) + l * 32;
    const int rstride = gridDim.x * 8;
    const int vecA = min(lane >> 3, 5), chA = lane & 7;
    u32x4 rawA;
    { const int row = blockIdx.x * 8 + wave; const bf16_t* pr = P + (size_t)row * PW; rawA = *(const u32x4*)(pr + vecA * 64 + chA * 8); }
    for (int row = blockIdx.x * 8 + wave; row < NROW; row += rstride) {
        const bool lat = row < NROWL; const int t = row & 4095; const int prow = t >> 6, pcol = t & 63;
        bf16_t* pr = P + (size_t)row * PW;
        u32x4 nxtA;
        { const int r2 = row + rstride < NROW ? row + rstride : row; const bf16_t* p2 = P + (size_t)r2 * PW; nxtA = *(const u32x4*)(p2 + vecA * 64 + chA * 8); }
        {
            const int vec = vecA, ch = chA; const bool act = lane < 48;
            bf16_t* ptr = pr + vec * 64 + ch * 8;
            const u32x4 raw = rawA;
            float x[8]; x[0] = bflo(raw.x); x[1] = bfhi(raw.x); x[2] = bflo(raw.y); x[3] = bfhi(raw.y); x[4] = bflo(raw.z); x[5] = bfhi(raw.z); x[6] = bflo(raw.w); x[7] = bfhi(raw.w);
            float ss = 0.f;
#pragma unroll
            for (int i = 0; i < 8; ++i) ss += x[i] * x[i];
            ss += __shfl_xor(ss, 1); ss += __shfl_xor(ss, 2); ss += __shfl_xor(ss, 4);
            const float inv = rsqrtf(ss * (1.0f / 64.0f) + EPSF);
            const float* gn = (vec < 4 ? aqn : akn) + ch * 8;
            const float qs = vec < 4 ? 0.125f * LOG2E : 1.0f;
            const int axis = ch >> 2, half = (ch >> 1) & 1; const int pos = axis == 0 ? prow : pcol;
            float o[8];
#pragma unroll
            for (int i = 0; i < 8; ++i) { const float y = x[i] * inv * gn[i]; const float pr2 = __shfl_xor(y, 2);
                if (lat) { const float2 cs = ropeA[pos * 16 + 8 * (ch & 1) + i]; o[i] = (half == 0 ? y * cs.x - pr2 * cs.y : y * cs.x + pr2 * cs.y) * qs; } else o[i] = y * qs; }
            if (act) { u32x4 w; w.x = pack_bf16(o[0], o[1]); w.y = pack_bf16(o[2], o[3]); w.z = pack_bf16(o[4], o[5]); w.w = pack_bf16(o[6], o[7]); *(u32x4*)ptr = w; }
        }
        rawA = nxtA;
    }
    __syncthreads();
}
__device__ __forceinline__ int block_excl_scan(int v, int* sbuf  , int& total) {
    const int tid = my_tid(), lane = tid & 63, wave = tid >> 6;
    int inc = v;
#pragma unroll
    for (int o = 1; o < 64; o <<= 1) { const int n = __shfl_up(inc, o); if (lane >= o) inc += n; }
    __syncthreads();
    if (lane == 63) sbuf[wave] = inc;
    __syncthreads();
    int pre = 0, tot = 0;
#pragma unroll
    for (int w = 0; w < 8; ++w) { const int s = sbuf[w]; if (w < wave) pre += s; tot += s; }
    total = tot;
    return pre + inc - v;
}

__device__ __forceinline__ void phase_topk(const Params& p, int l, unsigned char* smem) {
    unsigned char* ws = launder_ws(p.ws);
    const int tid = my_tid();
    unsigned* keys = (unsigned*)smem;
    int* hist = (int*)(keys + 4096);
    int* sb = hist + 256;
    int* ctl = sb + 16;
    const float* AFF = (const float*)(ws + WS_AFF);
    int* SROW = (int*)(ws + WS_SROW); float* SGATE = (float*)(ws + WS_SGATE); int* INV = (int*)(ws + WS_INV);
    const int nlists = (l == DEPTH - 1) ? 256 : 512;
    for (int it = blockIdx.x; it < nlists; it += gridDim.x) {
        const int kind = it >> 8, b = (it >> 4) & 15, e = it & 15;
        const int N = kind ? 256 : 4096, K = kind ? CAPC : CAPL;
        const int rowbase = kind ? NROWL + b * 256 : b * 4096;
        const int slotbase = e * SLOTS_E + (kind ? 8192 + b * CAPC : b * CAPL);
        for (int i = tid; i < N; i += NTHR) keys[i] = __float_as_uint(AFF[(size_t)(rowbase + i) * 16 + e]);
        unsigned prefix = 0, mask = 0; int need = K;
        for (int pass = 3; pass >= 0; --pass) {
            const int shift = 8 * pass;
            if (tid < 256) hist[tid] = 0;
            __syncthreads();
            for (int i = tid; i < N; i += NTHR) { const unsigned k = keys[i]; if ((k & mask) == prefix) atomicAdd(&hist[(k >> shift) & 255], 1); }
            __syncthreads();
            if (tid < 64) {
                const int b0 = 255 - 4 * tid; const int h0 = hist[b0], h1 = hist[b0 - 1], h2 = hist[b0 - 2], h3 = hist[b0 - 3];
                const int tot4 = h0 + h1 + h2 + h3; int inc = tot4;
#pragma unroll
                for (int o = 1; o < 64; o <<= 1) { const int n = __shfl_up(inc, o); if (tid >= o) inc += n; }
                const int exc = inc - tot4;
                const bool hit = (exc < need) && (inc >= need);
                if (hit) { int cum = exc, d = b0;
                    if (cum + h0 >= need) d = b0; else { cum += h0; if (cum + h1 >= need) d = b0 - 1; else { cum += h1; if (cum + h2 >= need) d = b0 - 2; else { cum += h2; d = b0 - 3; } } }
                    ctl[0] = d; ctl[1] = need - cum; } }
            __syncthreads();
            prefix |= (unsigned)ctl[0] << shift; mask |= 255u << shift; need = ctl[1];
            __syncthreads();
        }
        const unsigned T = prefix;
        int cg = 0, ce = 0; unsigned k8[8];
#pragma unroll
        for (int j = 0; j < 8; ++j) { const int i = tid * 8 + j; const unsigned k = (i < N) ? keys[i] : 0u; k8[j] = k; cg += (i < N && k > T) ? 1 : 0; ce += (i < N && k == T) ? 1 : 0; }
        int totg, tote;
        int pg = block_excl_scan(cg, sb, totg);
        int pe = block_excl_scan(ce, sb, tote);
#pragma unroll
        for (int j = 0; j < 8; ++j) { const int i = tid * 8 + j; if (i < N) { const unsigned k = k8[j]; int pos = -1;
                if (k > T) pos = pg++; else if (k == T) { if (pe < need) pos = totg + pe; ++pe; }
                if (pos >= 0) { const int s = slotbase + pos; const int row = rowbase + i; SROW[s] = row; SGATE[s] = __uint_as_float(k); INV[(size_t)row * 16 + e] = s; } } }
        __syncthreads();
    }
}

__device__ __forceinline__ void phase_gather(const Params& p) {
    unsigned char* ws = launder_ws(p.ws);
    const int lane = my_tid() & 63, wave = my_tid() >> 6;
    const int* SROW = (const int*)(ws + WS_SROW);
    const bf16_t* U = (const bf16_t*)(ws + WS_U); bf16_t* XE = (bf16_t*)(ws + WS_XE);
    for (int s = blockIdx.x * 8 + wave; s < NSLOT; s += gridDim.x * 8) {
        const int row = SROW[s];
        const u32x4* src = (const u32x4*)(U + (size_t)row * DM); u32x4* dst = (u32x4*)(XE + (size_t)s * DM);
        const u32x4 a = src[lane], b = src[64 + lane];
        dst[lane] = a; dst[64 + lane] = b;
    }
}

template <bool NEXT>
__device__ __forceinline__ void phase_combine(const Params& p, int l, unsigned char* smem) {
    unsigned char* ws = launder_ws(p.ws);
    const int tid = my_tid(), lane = tid & 63, wave = tid >> 6;
    int* INV = (int*)(ws + WS_INV);
    const bf16_t* YS = (const bf16_t*)(ws + WS_XE);
    const float* MODc = (const float*)(ws + WS_MOD + (size_t)(l & 1) * MOD_BYTES);
    const float* MODn = (const float*)(ws + WS_MOD + (size_t)((l + 1) & 1) * MOD_BYTES);
    float* Wg = (float*)smem;
    bf16_t* U = (bf16_t*)(ws + WS_U); float* GT = (float*)(ws + WS_GATES);
    const float* gain = PIN(I_N1G) + (size_t)(NEXT ? l + 1 : 0) * DM;
    if (NEXT) { for (int idx = tid; idx < 16384; idx += NTHR) { const int k = idx >> 4, j = idx & 15; Wg[j * 1024 + k] = PIN(I_WIN)[(size_t)(l + 1) * DM * INW + (size_t)k * INW + 2304 + j]; }
        __syncthreads(); }
    const int rstride = gridDim.x * 8;
    bf16_t* XB = (bf16_t*)(ws + WS_XB); float* outp = POUT();
    int myinv; u32x2 xc4[4];
    { const int row = blockIdx.x * 8 + wave; myinv = INV[(size_t)row * 16 + (lane & 15)];
#pragma unroll
      for (int i = 0; i < 4; ++i) xc4[i] = *(const u32x2*)(XB + (size_t)row * DM + 256 * i + 4 * lane); }
    const int nrows = NEXT ? NROW : NROWL;
    for (int row = blockIdx.x * 8 + wave; row < nrows; row += rstride) {
        int ninv; u32x2 xn4[4];
        { const int r2 = row + rstride < nrows ? row + rstride : row; ninv = INV[(size_t)r2 * 16 + (lane & 15)];
#pragma unroll
          for (int i = 0; i < 4; ++i) xn4[i] = *(const u32x2*)(XB + (size_t)r2 * DM + 256 * i + 4 * lane); }
        float acc[16];
#pragma unroll
        for (int j = 0; j < 16; ++j) acc[j] = 0.f;
        {
            unsigned msk = (unsigned)(__ballot(myinv >= 0 && lane < 16)) & 0xffffu;
            if (msk) {
                const int e0 = __ffs(msk) - 1; msk &= msk - 1;
                const int s0 = __shfl(myinv, e0);
                const bool two = msk != 0u; int s1 = s0;
                if (two) { const int e1 = __ffs(msk) - 1; msk &= msk - 1; s1 = __shfl(myinv, e1); }
                u32x2 w0[4], w1[4];
#pragma unroll
                for (int i = 0; i < 4; ++i) { w0[i] = *(const u32x2*)(YS + (size_t)s0 * DM + 256 * i + 4 * lane); w1[i] = *(const u32x2*)(YS + (size_t)s1 * DM + 256 * i + 4 * lane); }
                const float f1 = two ? 1.0f : 0.0f;
#pragma unroll
                for (int i = 0; i < 4; ++i) { acc[4 * i + 0] = bflo(w0[i].x) + f1 * bflo(w1[i].x); acc[4 * i + 1] = bfhi(w0[i].x) + f1 * bfhi(w1[i].x);
                    acc[4 * i + 2] = bflo(w0[i].y) + f1 * bflo(w1[i].y); acc[4 * i + 3] = bfhi(w0[i].y) + f1 * bfhi(w1[i].y); }
                while (msk) { const int e = __ffs(msk) - 1; msk &= msk - 1; const int s = __shfl(myinv, e);
#pragma unroll
                    for (int i = 0; i < 4; ++i) { const u32x2 w = *(const u32x2*)(YS + (size_t)s * DM + 256 * i + 4 * lane);
                        acc[4 * i + 0] += bflo(w.x); acc[4 * i + 1] += bfhi(w.x); acc[4 * i + 2] += bflo(w.y); acc[4 * i + 3] += bfhi(w.y); } }
            }
        }
        if (lane < 16) INV[(size_t)row * 16 + lane] = -1;
        const int mrow = row < NROWL ? (row >> 12) : 16;
        const float* gt = MODc + (size_t)mrow * 6144 + 5120;
        float ss = 0.f;
#pragma unroll
        for (int i = 0; i < 4; ++i) { const int k = 256 * i + 4 * lane;
            float4 xv = make_float4(bflo(xc4[i].x), bfhi(xc4[i].x), bflo(xc4[i].y), bfhi(xc4[i].y)); const float4 g = *(const float4*)(gt + k);
            xv.x += g.x * acc[4 * i + 0]; xv.y += g.y * acc[4 * i + 1]; xv.z += g.z * acc[4 * i + 2]; xv.w += g.w * acc[4 * i + 3];
            if (NEXT) { u32x2 w; w.x = pack_bf16(xv.x, xv.y); w.y = pack_bf16(xv.z, xv.w); *(u32x2*)(XB + (size_t)row * DM + k) = w; }
            else *(float4*)(outp + (size_t)row * DM + k) = xv;
            acc[4 * i + 0] = xv.x; acc[4 * i + 1] = xv.y; acc[4 * i + 2] = xv.z; acc[4 * i + 3] = xv.w;
            ss += xv.x * xv.x + xv.y * xv.y + xv.z * xv.z + xv.w * xv.w; }
        myinv = ninv;
#pragma unroll
        for (int i = 0; i < 4; ++i) xc4[i] = xn4[i];
        if (NEXT) {
            ss = wave_sum(ss);
            const float inv = rsqrtf(ss * (1.0f / 1024.0f) + EPSF);
            const float* mod = MODn + (size_t)mrow * 6144;
            float part[16];
#pragma unroll
            for (int j = 0; j < 16; ++j) part[j] = 0.f;
#pragma unroll
            for (int i = 0; i < 4; ++i) { const int k = 256 * i + 4 * lane;
                const float4 g = *(const float4*)(gain + k), sh = *(const float4*)(mod + k), sc = *(const float4*)(mod + 1024 + k);
                float4 h; h.x = acc[4 * i + 0] * inv * g.x * (1.f + sc.x) + sh.x; h.y = acc[4 * i + 1] * inv * g.y * (1.f + sc.y) + sh.y; h.z = acc[4 * i + 2] * inv * g.z * (1.f + sc.z) + sh.z; h.w = acc[4 * i + 3] * inv * g.w * (1.f + sc.w) + sh.w;
                u32x2 w; w.x = pack_bf16(h.x, h.y); w.y = pack_bf16(h.z, h.w);
                *(u32x2*)(U + (size_t)row * DM + k) = w;
#pragma unroll
                for (int j = 0; j < 16; ++j) { const float4 wv = *(const float4*)(Wg + j * 1024 + k); part[j] += h.x * wv.x + h.y * wv.y + h.z * wv.z + h.w * wv.w; }
                asm volatile("" ::: "memory"); }
            const float v1 = reduce16_transpose(part, lane);
            const int jx = ((lane >> 5) & 1) * 8 + ((lane >> 4) & 1) * 4 + ((lane >> 3) & 1) * 2 + ((lane >> 2) & 1);
            if ((lane & 3) == 0) GT[(size_t)row * 16 + jx] = v1;
        }
    }
    __syncthreads();
}
struct AttnItem { int qrow0, qpos0, qcol, kcol, vcol, ycol; int nt0, krow0, kpos0, masked; int nt1, krow1; float M2, sink2, lam, postscale; const float* subgain; };
#define FA_LD 72

template <int NC>
__device__ __forceinline__ void fattn_item(const bf16_t* __restrict__ P, bf16_t* __restrict__ Y, const AttnItem& it, unsigned char* smem) {
    constexpr int KS = (NC == 2) ? 2 : 4;
    const int tid = my_tid(), lane = tid & 63, w = tid >> 6, h = lane >> 5, lq = lane & 31;
    bf16_t* Kb = (bf16_t*)smem;
    bf16_t* Vb = Kb + 2 * 64 * FA_LD;
    const LAS unsigned char* vlds = (const LAS unsigned char*)(smem) + 2 * 64 * FA_LD * 2;
    bf16x8 qf[NC][KS];
    { const bf16_t* qp = P + (size_t)(it.qrow0 + 32 * w + lq) * PW + it.qcol + 8 * h;
#pragma unroll
      for (int c = 0; c < NC; ++c)
#pragma unroll
          for (int s = 0; s < KS; ++s) qf[c][s] = *(const bf16x8*)(qp + 32 * c + 16 * s); }
    f32x16 O[NC][2]; float lsum[NC];
#pragma unroll
    for (int c = 0; c < NC; ++c) { lsum[c] = 0.f;
#pragma unroll
        for (int dt = 0; dt < 2; ++dt)
#pragma unroll
            for (int r = 0; r < 16; ++r) O[c][dt][r] = 0.f; }
    const int ntot = it.nt0 + it.nt1;
    const int ldkey = tid >> 3, ldch = tid & 7;
    const int vlane = ((4 * h + ((lane & 15) >> 2)) * FA_LD + 16 * ((lane >> 4) & 1) + 4 * (lane & 3)) * 2;
    u32x4 kreg, vreg;
    { const int krow = it.nt0 > 0 ? it.krow0 : it.krow1; const bf16_t* kp = P + (size_t)(krow + ldkey) * PW;
      kreg = *(const u32x4*)(kp + it.kcol + ldch * 8); vreg = *(const u32x4*)(kp + it.vcol + ldch * 8); }
    __syncthreads();
    *(u32x4*)(Kb + ldkey * FA_LD + ldch * 8) = kreg; *(u32x4*)(Vb + ldkey * FA_LD + ldch * 8) = vreg;
    __syncthreads();
    const int qpos = it.qpos0 + 32 * w + lq;
    for (int kt = 0; kt < ntot; ++kt) {
        const int buf = kt & 1;
        int kpos = 0; bool msk = false;
        if (kt < it.nt0) { kpos = it.kpos0 + 64 * kt; msk = it.masked != 0; }
        if (kt + 1 < ntot) { const int k2 = kt + 1; const int krow = k2 < it.nt0 ? it.krow0 + 64 * k2 : it.krow1 + 64 * (k2 - it.nt0);
            const bf16_t* kp = P + (size_t)(krow + ldkey) * PW; kreg = *(const u32x4*)(kp + it.kcol + ldch * 8); vreg = *(const u32x4*)(kp + it.vcol + ldch * 8); }
        bool skip = false;
        if (msk) { const int q0 = it.qpos0 + 32 * w; skip = (kpos > q0 + 31 + 128) || (kpos + 63 < q0 - 128); }
        if (!skip) {
            const bf16_t* kb = Kb + buf * 64 * FA_LD; const LAS unsigned char* vb = vlds + buf * 64 * FA_LD * 2 + vlane;
#pragma unroll
            for (int sub = 0; sub < 2; ++sub) {
                unsigned pk[NC][2][4];
#pragma unroll
                for (int c = 0; c < NC; ++c) {
                    f32x16 S;
#pragma unroll
                    for (int r = 0; r < 16; ++r) S[r] = -it.M2;
#pragma unroll
                    for (int s = 0; s < KS; ++s) { const bf16x8 a = *(const bf16x8*)(kb + (32 * sub + lq) * FA_LD + 32 * c + 16 * s + 8 * h);
                        S = __builtin_amdgcn_mfma_f32_32x32x16_bf16(a, qf[c][s], S, 0, 0, 0); }
                    float pv[16];
#pragma unroll
                    for (int r = 0; r < 16; ++r) { pv[r] = fast_exp2(S[r]);
                        if (NC == 1) { if (msk) { const int d = qpos - (kpos + 32 * sub + CROW(r, lane)); if (d > 128 || d < -128) pv[r] = 0.f; } } }
#pragma unroll
                    for (int r = 0; r < 16; ++r) lsum[c] += pv[r];
#pragma unroll
                    for (int s = 0; s < 2; ++s)
#pragma unroll
                        for (int jj = 0; jj < 4; ++jj) pk[c][s][jj] = pg8::cvt_pk_bf16(pv[8 * s + 2 * jj], pv[8 * s + 2 * jj + 1]);
                }
#pragma unroll
                for (int s = 0; s < 2; ++s)
#pragma unroll
                    for (int dt = 0; dt < 2; ++dt) {
                        const s16x4 lo = tr_read(vb + (32 * sub + 16 * s) * FA_LD * 2 + 64 * dt), hi = tr_read(vb + (32 * sub + 16 * s + 8) * FA_LD * 2 + 64 * dt);
                        const bf16x8 a = __builtin_shufflevector(lo, hi, 0, 1, 2, 3, 4, 5, 6, 7);
#pragma unroll
                        for (int c = 0; c < NC; ++c) { u32x4 bw; bw.x = pk[c][s][0]; bw.y = pk[c][s][1]; bw.z = pk[c][s][2]; bw.w = pk[c][s][3];
                            O[c][dt] = __builtin_amdgcn_mfma_f32_32x32x16_bf16(a, __builtin_bit_cast(bf16x8, bw), O[c][dt], 0, 0, 0); }
                    }
            }
        }
        if (kt + 1 < ntot) { bf16_t* kd = Kb + (buf ^ 1) * 64 * FA_LD; bf16_t* vd = Vb + (buf ^ 1) * 64 * FA_LD;
            *(u32x4*)(kd + ldkey * FA_LD + ldch * 8) = kreg; *(u32x4*)(vd + ldkey * FA_LD + ldch * 8) = vreg; }
        __syncthreads();
    }
    float linv[NC];
#pragma unroll
    for (int c = 0; c < NC; ++c) { const float l = lsum[c] + __shfl_xor(lsum[c], 32); linv[c] = (NC == 1) ? 1.0f / (l + fast_exp2(it.sink2 - it.M2)) : 1.0f / l; }
    bf16_t* yp = Y + (size_t)(it.qrow0 + 32 * w + lq) * DM + it.ycol + 4 * h;
    if (NC == 1) {
#pragma unroll
        for (int dt = 0; dt < 2; ++dt)
#pragma unroll
            for (int g = 0; g < 4; ++g) { u32x2 wv; wv.x = pg8::cvt_pk_bf16(O[0][dt][4 * g] * linv[0], O[0][dt][4 * g + 1] * linv[0]); wv.y = pg8::cvt_pk_bf16(O[0][dt][4 * g + 2] * linv[0], O[0][dt][4 * g + 3] * linv[0]);
                *(u32x2*)(yp + 32 * dt + 8 * g) = wv; }
    } else {
        const float a1 = it.lam * linv[NC - 1];
        float ss = 0.f;
#pragma unroll
        for (int dt = 0; dt < 2; ++dt)
#pragma unroll
            for (int r = 0; r < 16; ++r) { const float v = O[0][dt][r] * linv[0] - a1 * O[NC - 1][dt][r]; O[0][dt][r] = v; ss += v * v; }
        ss += __shfl_xor(ss, 32);
        const float rinv = rsqrtf(ss * (1.0f / 64.0f) + EPSF) * it.postscale;
        const float* sg = it.subgain + 4 * h;
#pragma unroll
        for (int dt = 0; dt < 2; ++dt)
#pragma unroll
            for (int g = 0; g < 4; ++g) { const float4 gg = *(const float4*)(sg + 32 * dt + 8 * g);
                u32x2 wv; wv.x = pg8::cvt_pk_bf16(O[0][dt][4 * g] * rinv * gg.x, O[0][dt][4 * g + 1] * rinv * gg.y); wv.y = pg8::cvt_pk_bf16(O[0][dt][4 * g + 2] * rinv * gg.z, O[0][dt][4 * g + 3] * rinv * gg.w);
                *(u32x2*)(yp + 32 * dt + 8 * g) = wv; }
    }
}


#define FD_RING 4
__device__ __forceinline__ void fattn_d_item(const bf16_t* __restrict__ P, bf16_t* __restrict__ Y, const AttnItem& it, unsigned char* smem) {
    const int tid = my_tid(), lane = tid & 63, w = tid >> 6, h = lane >> 5, lq = lane & 31;
    bf16_t* ring = (bf16_t*)smem;
    const LAS unsigned char* rlds = (const LAS unsigned char*)smem;
    constexpr int TB = 64 * FA_LD * 2;
    bf16x8 qf[2][2];
    { const bf16_t* qp = P + (size_t)(it.qrow0 + 32 * w + lq) * PW + it.qcol + 8 * h;
#pragma unroll
      for (int c = 0; c < 2; ++c)
#pragma unroll
          for (int s = 0; s < 2; ++s) qf[c][s] = *(const bf16x8*)(qp + 32 * c + 16 * s); }
    f32x16 O[2][2]; float lsum[2] = {0.f, 0.f};
#pragma unroll
    for (int c = 0; c < 2; ++c)
#pragma unroll
        for (int dt = 0; dt < 2; ++dt)
#pragma unroll
            for (int r = 0; r < 16; ++r) O[c][dt][r] = 0.f;
    const int ntot = it.nt0 + it.nt1;
    const int ldkey = tid >> 3, ldch = tid & 7;
    const int vlane = ((4 * h + ((lane & 15) >> 2)) * FA_LD + 16 * ((lane >> 4) & 1) + 4 * (lane & 3)) * 2;
    const int klane = (lq * FA_LD + 8 * h) * 2;
#define FD_TROW(k) ((k) < it.nt0 ? it.krow0 + 64 * (k) : it.krow1 + 64 * ((k) - it.nt0))
#define FD_GLOAD(k) do { const bf16_t* kp_ = P + (size_t)(FD_TROW(k) + ldkey) * PW; kreg = *(const u32x4*)(kp_ + it.kcol + ldch * 8); vreg = *(const u32x4*)(kp_ + it.vcol + ldch * 8); } while (0)
#define FD_LSTORE(k) do { bf16_t* d_ = ring + (size_t)((k) & (FD_RING - 1)) * 2 * 64 * FA_LD + ldkey * FA_LD + ldch * 8; *(u32x4*)d_ = kreg; *(u32x4*)(d_ + 64 * FA_LD) = vreg; } while (0)
    u32x4 kreg, vreg;
    __syncthreads();
    FD_GLOAD(0); FD_LSTORE(0);
    if (ntot > 1) { FD_GLOAD(1); FD_LSTORE(1); }
    __syncthreads();
    f32x16 zero16;
#pragma unroll
    for (int r = 0; r < 16; ++r) zero16[r] = 0.f;
    f32x16 SS[2];
    { const LAS unsigned char* kb = rlds + klane;
      SS[0] = __builtin_amdgcn_mfma_f32_32x32x16_bf16(*(const LAS bf16x8*)(kb), qf[0][0], zero16, 0, 0, 0);
      SS[0] = __builtin_amdgcn_mfma_f32_32x32x16_bf16(*(const LAS bf16x8*)(kb + 32), qf[0][1], SS[0], 0, 0, 0); }
    unsigned pkp[2][4];
#pragma unroll
    for (int s = 0; s < 2; ++s)
#pragma unroll
        for (int j = 0; j < 4; ++j) pkp[s][j] = 0u;
    for (int kt = 0; kt < ntot; ++kt) {
        if (kt + 2 < ntot) FD_GLOAD(kt + 2);
        const LAS unsigned char* cb = rlds + (size_t)(kt & (FD_RING - 1)) * 2 * TB;
        const LAS unsigned char* nb = rlds + (size_t)((kt + 1) & (FD_RING - 1)) * 2 * TB;
        const LAS unsigned char* pb = rlds + (size_t)((kt + FD_RING - 1) & (FD_RING - 1)) * 2 * TB;
#pragma unroll
        for (int u = 0; u < 4; ++u) {
            const int c = u & 1;
            const int nsub = ((u + 1) & 3) >> 1, nc = (u + 1) & 1;
            const int psub = ((u + 3) & 3) >> 1, pc = (u + 3) & 1;
            const LAS unsigned char* ka = ((u < 3) ? cb : nb) + klane + (32 * nsub) * FA_LD * 2 + 64 * nc;
            const LAS unsigned char* va = ((u > 0) ? cb : pb) + TB + vlane + (32 * psub) * FA_LD * 2;
            const bf16x8 kf0 = *(const LAS bf16x8*)(ka), kf1 = *(const LAS bf16x8*)(ka + 32);
            bf16x8 vf[2][2];
#pragma unroll
            for (int s = 0; s < 2; ++s)
#pragma unroll
                for (int dt = 0; dt < 2; ++dt) { const s16x4 lo = tr_read(va + (16 * s) * FA_LD * 2 + 64 * dt), hi = tr_read(va + (16 * s + 8) * FA_LD * 2 + 64 * dt);
                    vf[s][dt] = __builtin_shufflevector(lo, hi, 0, 1, 2, 3, 4, 5, 6, 7); }
            __builtin_amdgcn_sched_barrier(0);
            f32x16& Sc = SS[u & 1]; f32x16& Sn = SS[(u + 1) & 1];
            unsigned pkc[2][4];
#pragma unroll
            for (int s = 0; s < 2; ++s) {
                float pv[8];
#pragma unroll
                for (int j = 0; j < 8; ++j) pv[j] = fast_exp2(Sc[8 * s + j]);
                lsum[c] += ((pv[0] + pv[1]) + (pv[2] + pv[3])) + ((pv[4] + pv[5]) + (pv[6] + pv[7]));
#pragma unroll
                for (int jj = 0; jj < 4; ++jj) pkc[s][jj] = pg8::cvt_pk_bf16(pv[2 * jj], pv[2 * jj + 1]);
            }
            if ((u < 3) || (kt + 1 < ntot)) {
                Sn = __builtin_amdgcn_mfma_f32_32x32x16_bf16(kf0, qf[nc][0], zero16, 0, 0, 0);
                Sn = __builtin_amdgcn_mfma_f32_32x32x16_bf16(kf1, qf[nc][1], Sn, 0, 0, 0); }
            if ((u > 0) || (kt > 0)) {
#pragma unroll
                for (int s = 0; s < 2; ++s) { u32x4 bw; bw.x = pkp[s][0]; bw.y = pkp[s][1]; bw.z = pkp[s][2]; bw.w = pkp[s][3];
#pragma unroll
                    for (int dt = 0; dt < 2; ++dt) O[pc][dt] = __builtin_amdgcn_mfma_f32_32x32x16_bf16(vf[s][dt], __builtin_bit_cast(bf16x8, bw), O[pc][dt], 0, 0, 0); } }
            __builtin_amdgcn_sched_group_barrier(0x2, 5, 0);
#pragma unroll
            for (int g = 0; g < 6; ++g) { __builtin_amdgcn_sched_group_barrier(0x8, 1, 0); __builtin_amdgcn_sched_group_barrier(0x2, 5, 0); }
            __builtin_amdgcn_sched_barrier(0);
#pragma unroll
            for (int s = 0; s < 2; ++s)
#pragma unroll
                for (int j = 0; j < 4; ++j) pkp[s][j] = pkc[s][j];
        }
        if (kt + 2 < ntot) FD_LSTORE(kt + 2);
        __syncthreads();
    }
    { const LAS unsigned char* va = rlds + (size_t)((ntot - 1) & (FD_RING - 1)) * 2 * TB + TB + vlane + 32 * FA_LD * 2;
#pragma unroll
      for (int s = 0; s < 2; ++s) { u32x4 bw; bw.x = pkp[s][0]; bw.y = pkp[s][1]; bw.z = pkp[s][2]; bw.w = pkp[s][3];
#pragma unroll
          for (int dt = 0; dt < 2; ++dt) {
              const s16x4 lo = tr_read(va + (16 * s) * FA_LD * 2 + 64 * dt), hi = tr_read(va + (16 * s + 8) * FA_LD * 2 + 64 * dt);
              const bf16x8 a = __builtin_shufflevector(lo, hi, 0, 1, 2, 3, 4, 5, 6, 7);
              O[1][dt] = __builtin_amdgcn_mfma_f32_32x32x16_bf16(a, __builtin_bit_cast(bf16x8, bw), O[1][dt], 0, 0, 0); } } }
#undef FD_TROW
#undef FD_GLOAD
#undef FD_LSTORE
    float linv[2];
#pragma unroll
    for (int c = 0; c < 2; ++c) { const float l = lsum[c] + __shfl_xor(lsum[c], 32); linv[c] = 1.0f / l; }
    bf16_t* yp = Y + (size_t)(it.qrow0 + 32 * w + lq) * DM + it.ycol + 4 * h;
    const float a1 = it.lam * linv[1];
    float ss = 0.f;
#pragma unroll
    for (int dt = 0; dt < 2; ++dt)
#pragma unroll
        for (int r = 0; r < 16; ++r) { const float v = O[0][dt][r] * linv[0] - a1 * O[1][dt][r]; O[0][dt][r] = v; ss += v * v; }
    ss += __shfl_xor(ss, 32);
    const float rinv = rsqrtf(ss * (1.0f / 64.0f) + EPSF) * it.postscale;
    const float* sg = it.subgain + 4 * h;
#pragma unroll
    for (int dt = 0; dt < 2; ++dt)
#pragma unroll
        for (int g = 0; g < 4; ++g) { const float4 gg = *(const float4*)(sg + 32 * dt + 8 * g);
            u32x2 wv; wv.x = pg8::cvt_pk_bf16(O[0][dt][4 * g] * rinv * gg.x, O[0][dt][4 * g + 1] * rinv * gg.y); wv.y = pg8::cvt_pk_bf16(O[0][dt][4 * g + 2] * rinv * gg.z, O[0][dt][4 * g + 3] * rinv * gg.w);
            *(u32x2*)(yp + 32 * dt + 8 * g) = wv; }
}

__device__ __forceinline__ float max_abs_vec(const float* g, int n) { float m = 0.f; for (int i = 0; i < n; ++i) m = fmaxf(m, fabsf(g[i])); return m; }

__device__ __forceinline__ int attn_item_remap(int x0, int G) {
    if (G != 256 || x0 >= 1024) return x0;
    const int i = x0 >> 8, bid = x0 & 255, xcd = bid & 7, slot = bid >> 3;
    const int bh = i * 16 + xcd * 2 + (slot >> 4), n = slot & 15;
    return bh * 16 + n;
}
__device__ __forceinline__ void phase_attnA(const Params& p, int l, unsigned char* smem) {
    unsigned char* ws = launder_ws(p.ws);
    const bf16_t* P = (const bf16_t*)(ws + WS_P); bf16_t* Y = (bf16_t*)(ws + WS_U);
    const float bound = 8.0f * LOG2E * 1.02f * max_abs_vec(PIN(I_AQN) + l * 64, 64) * max_abs_vec(PIN(I_AKN) + l * 64, 64);
    const int nitems = (l == DEPTH - 1) ? 1024 : 1088;
    const int cshift = (gridDim.x == 256) ? 64 : 0;
    for (int x0 = blockIdx.x; x0 < nitems + cshift; x0 += gridDim.x) {
        if (x0 >= 1024 && x0 < 1024 + cshift) continue;
        const int x = attn_item_remap(x0 >= 1024 ? x0 - cshift : x0, gridDim.x);
        AttnItem it; it.subgain = nullptr; it.lam = 0.f; it.postscale = 1.f;
        int b, h, n;
        if (x < 1024) { b = x >> 6; h = (x >> 4) & 3; n = x & 15;
            const int lo = max(0, 256 * n - 128), hi = min(TL, 256 * n + 384);
            it.qrow0 = b * TL + 256 * n; it.qpos0 = 256 * n; it.nt0 = (hi - lo) >> 6; it.krow0 = b * TL + lo; it.kpos0 = lo; it.masked = 1; }
        else { const int y = x - 1024; b = y >> 2; h = y & 3;
            it.qrow0 = NROWL + b * TCX; it.qpos0 = 0; it.nt0 = 0; it.krow0 = 0; it.kpos0 = 0; it.masked = 0; }
        it.nt1 = 4; it.krow1 = NROWL + b * TCX;
        it.qcol = h * 64; it.kcol = 256 + (h >> 1) * 64; it.vcol = 384 + (h >> 1) * 64; it.ycol = h * 64;
        it.sink2 = PIN(I_ASINK)[l * 4 + h] * LOG2E; it.M2 = fmaxf(bound, it.sink2);
        fattn_item<1>(P, Y, it, smem);
    }
}
__device__ __forceinline__ void phase_attnD(const Params& p, int l, unsigned char* smem) {
    unsigned char* ws = launder_ws(p.ws);
    const bf16_t* P = (const bf16_t*)(ws + WS_P); bf16_t* Y = (bf16_t*)(ws + WS_U);
    const float bound = 5.656854249f * LOG2E * 1.02f * max_abs_vec(PIN(I_DQN) + l * 32, 32) * max_abs_vec(PIN(I_DKN) + l * 32, 32);
    float d1 = 0.f, d2 = 0.f;
    for (int i = 0; i < 32; ++i) { d1 += PIN(I_LQ1)[l * 32 + i] * PIN(I_LK1)[l * 32 + i]; d2 += PIN(I_LQ2)[l * 32 + i] * PIN(I_LK2)[l * 32 + i]; }
    const float lam_init = 0.8f - 0.6f * expf(-0.3f * (float)l);
    const float lam = expf(d1) - expf(d2) + lam_init;
    const int nitems = (l == DEPTH - 1) ? 1024 : 1088;
    for (int x0 = blockIdx.x; x0 < nitems; x0 += gridDim.x) {
        const int x = attn_item_remap(x0, gridDim.x);
        AttnItem it; it.subgain = PIN(I_DSUB) + l * 64; it.lam = lam; it.postscale = 1.0f - lam_init; it.sink2 = 0.f; it.M2 = bound;
        int b, h, n;
        if (x < 1024) { b = x >> 6; h = (x >> 4) & 3; n = x & 15;
            it.qrow0 = b * TL + 256 * n; it.qpos0 = 0; it.nt0 = 64; it.krow0 = b * TL; it.kpos0 = 0; it.masked = 0; }
        else { const int y = x - 1024; b = y >> 2; h = y & 3;
            it.qrow0 = NROWL + b * TCX; it.qpos0 = 0; it.nt0 = 0; it.krow0 = 0; it.kpos0 = 0; it.masked = 0; }
        it.nt1 = 4; it.krow1 = NROWL + b * TCX;
        it.qcol = 1536 + h * 64; it.kcol = 1792 + h * 64; it.vcol = 2048 + h * 64; it.ycol = 768 + h * 64;
        if (bound < 100.0f) fattn_d_item(P, Y, it, smem); else fattn_item<2>(P, Y, it, smem);
    }
}

#define HY_ZROWS 4160
#define HY_FLEN 8256
#define HY_OFF_F (HY_ZROWS * 32)
#define HY_OFF_MISC (HY_OFF_F + HY_FLEN * 2)

__device__ __forceinline__ void hy_kloop(const LAS unsigned char* zs, const LAS bf16_t* fs, int w, int lane, f32x4 (&acc)[4][8]) {
    const int i = lane & 15, q = lane >> 4, qq = (lane & 15) >> 2, pp = lane & 3;
    const LAS bf16_t* ap = fs + (4096 - 512 * w + 8 * q - 8 * i);
    const LAS unsigned char* bp = zs + (8 * q + qq) * 32 + pp * 8;
    bf16x8 an[4];
#pragma unroll
    for (int m = 0; m < 4; ++m) an[m] = *(const LAS bf16x8*)(ap - 128 * m);
#pragma unroll 1
    for (int ks = 0; ks < 129; ++ks) {
        bf16x8 a[4];
#pragma unroll
        for (int m = 0; m < 4; ++m) a[m] = an[m];
#pragma unroll
        for (int m = 0; m < 4; ++m) an[m] = *(const LAS bf16x8*)(ap + 32 * (ks + 1) - 128 * m);
#pragma unroll
        for (int r = 0; r < 8; ++r) {
            const s16x4 lo = tr_read(bp + (32 * ks + r) * 32), hi = tr_read(bp + (32 * ks + r) * 32 + 128);
            const bf16x8 b = __builtin_shufflevector(lo, hi, 0, 1, 2, 3, 4, 5, 6, 7);
#pragma unroll
            for (int m = 0; m < 4; ++m) acc[m][r] = __builtin_amdgcn_mfma_f32_16x16x32_bf16(a[m], b, acc[m][r], 0, 0, 0);
        }
    }
}
#define HYC_OFF_Z 4096
#define HYC_ZROWS 304
#define HYC_OFF_F (HYC_OFF_Z + HYC_ZROWS * 32)
#define HYC_FLEN 576
__device__ __forceinline__ void hy_ckloop(const LAS unsigned char* zs, const LAS bf16_t* fs, int r, int lane, f32x4 (&acc)[2]) {
    const int i = lane & 15, q = lane >> 4, qq = (lane & 15) >> 2, pp = lane & 3;
    const LAS bf16_t* ap = fs + (256 + 8 * q - 8 * i);
    const LAS unsigned char* bp = zs + (8 * q + qq + r) * 32 + pp * 8;
#pragma unroll
    for (int ks = 0; ks < 9; ++ks) {
        const s16x4 lo = tr_read(bp + (32 * ks) * 32), hi = tr_read(bp + (32 * ks) * 32 + 128);
        const bf16x8 b = __builtin_shufflevector(lo, hi, 0, 1, 2, 3, 4, 5, 6, 7);
#pragma unroll
        for (int m = 0; m < 2; ++m) { const bf16x8 a = *(const LAS bf16x8*)(ap + 32 * ks - 128 * m); acc[m] = __builtin_amdgcn_mfma_f32_16x16x32_bf16(a, b, acc[m], 0, 0, 0); }
    }
}
__device__ __forceinline__ float hy_sconv(const bf16_t* u, int t, int T, float c0, float c1, float c2) {
    const int tm = t > 0 ? t - 1 : 0, tp = t < T - 1 ? t + 1 : T - 1;
    const float um = bf2f(u[tm]), u0 = bf2f(u[t]), up = bf2f(u[tp]);
    return (t > 0 ? c0 : 0.f) * um + c1 * u0 + (t < T - 1 ? c2 : 0.f) * up;
}
__device__ __forceinline__ void hy_gate8(const bf16_t* ub  , int t0, float c0, float c1, float c2, float (&g)[8]) {
    const u32x4 raw = *(const u32x4*)ub; const float hl = bf2f(ub[-1]), hr = bf2f(ub[8]);
    float x[10];
    x[0] = t0 > 0 ? hl : 0.f; x[9] = t0 + 8 < 4096 ? hr : 0.f;
    x[1] = bflo(raw.x); x[2] = bfhi(raw.x); x[3] = bflo(raw.y); x[4] = bfhi(raw.y); x[5] = bflo(raw.z); x[6] = bfhi(raw.z); x[7] = bflo(raw.w); x[8] = bfhi(raw.w);
#pragma unroll
    for (int e = 0; e < 8; ++e) g[e] = c0 * x[e] + c1 * x[e + 1] + c2 * x[e + 2];
}
__device__ __forceinline__ float block_sum(float v, float* red  ) {
    v = wave_sum(v);
    __syncthreads();
    if ((my_tid() & 63) == 0) red[my_tid() >> 6] = v;
    __syncthreads();
    float s = 0.f;
#pragma unroll
    for (int w = 0; w < 8; ++w) s += red[w];
    return s;
}

#if defined(PROBE_KIND) && PROBE_KIND == 6
#define HY_STAMP(k) do { if (blockIdx.x == 0 && my_tid() == 0) { volatile unsigned* pw_ = (volatile unsigned*)(smem + LDS_BYTES - 48); const unsigned t_ = (unsigned)wall_clock64(); \
        if ((k) >= 0 && ((PROBE_MASK >> ((k) < 0 ? 0 : (k))) & 1)) pw_[2] += t_ - pw_[5]; pw_[5] = t_; } } while (0)
#else
#define HY_STAMP(k) do {} while (0)
#endif
__device__ __forceinline__ void phase_hyena(const Params& p, int l, unsigned char* smem) {
    unsigned char* ws = launder_ws(p.ws);
    LAS unsigned char* lds = (LAS unsigned char*)smem;
    bf16_t* Zs = (bf16_t*)smem; bf16_t* Fs = (bf16_t*)(smem + HY_OFF_F);
    float* fw3c = (float*)(smem + HY_OFF_MISC);
    float* red = fw3c + 256;
    float* HT = (float*)smem;
    const bf16_t* UT = (const bf16_t*)(ws + WS_UT);
    bf16_t* YT = (bf16_t*)(ws + WS_YT);
    const float* H2L = (const float*)(ws + WS_HID2L); const float* H2C = (const float*)(ws + WS_HID2C);
    const float* fw3 = PIN(I_FW3) + (size_t)l * 64 * 1024;
    const float* cw = PIN(I_HYCONV) + (size_t)l * 3 * 768;
    const float da = logf(1e-2f) / 1.5f, db = logf(1e-2f) / 0.3f;
    for (int c = blockIdx.x; c < 256; c += gridDim.x) {
        const int tid = my_tid(), lane = tid & 63, w = tid >> 6;
        bf16_t* FB = (bf16_t*)(ws + WS_FBUF) + (size_t)c * HY_FLEN;
        const float delta = fabsf(da + (float)c * ((db - da) / 255.0f));
        const float bias0 = PIN(I_HYBIAS)[l * 512 + c], bias1 = PIN(I_HYBIAS)[l * 512 + 256 + c];
        __syncthreads();
        if (tid < 256) fw3c[tid] = fw3[(size_t)(tid & 63) * 1024 + (tid >> 6) * 256 + c];
        __syncthreads();
        HY_STAMP(-1);
        float ss0 = 0.f, ss1 = 0.f;
#pragma unroll 1
        for (int lag = tid; lag < 4096; lag += NTHR) {
            float a0 = 0.f, a1 = 0.f, a2 = 0.f, a3 = 0.f;
            float hv[64];
#pragma unroll
            for (int k = 0; k < 64; ++k) hv[k] = H2L[(size_t)k * 4096 + lag];
#pragma unroll
            for (int k = 0; k < 64; ++k) { const float h = hv[k]; a0 += h * fw3c[k]; a1 += h * fw3c[64 + k]; a2 += h * fw3c[128 + k]; a3 += h * fw3c[192 + k]; }
            const float dec = expf(-((float)lag / 4095.0f) * delta);
            a0 *= dec; a1 *= dec; a2 *= dec; a3 *= dec;
            HT[lag] = a0; HT[4096 + lag] = a1; HT[8192 + lag] = a2; HT[12288 + lag] = a3;
            ss0 += a0 * a0 + (lag >= 1 ? a2 * a2 : 0.f); ss1 += a1 * a1 + (lag >= 1 ? a3 * a3 : 0.f);
        }
        ss0 = block_sum(ss0, red); ss1 = block_sum(ss1, red);
        const float n0 = rsqrtf(ss0 + EPSF), n1 = rsqrtf(ss1 + EPSF);
#pragma unroll 1
        for (int x = tid; x < HY_FLEN; x += NTHR) { const int d = 4128 - x; float f0 = 0.f, f1 = 0.f;
            if (d >= 0 && d <= 4095) { f0 = HT[d] * n0; f1 = HT[4096 + d] * n1; } else if (d < 0 && d >= -4095) { f0 = HT[8192 - d] * n0; f1 = HT[12288 - d] * n1; }
            Fs[x] = f2bf(f0); FB[x] = f2bf(f1); }
        __syncthreads();
        HY_STAMP(0);
        for (int idx = tid; idx < 1024; idx += NTHR) { const int rr = idx >> 4; Zs[(rr < 32 ? rr : 4096 + rr) * 16 + (idx & 15)] = 0; }
        { const bf16_t* u = UT + (size_t)c * NROW; const float v0 = cw[c], v1 = cw[768 + c], v2 = cw[1536 + c];
#pragma unroll 4
          for (int idx = tid; idx < 8192; idx += NTHR) { const int b = idx >> 9, t0 = (idx & 511) * 8;
              float g[8]; hy_gate8(u + b * 4096 + t0, t0, v0, v1, v2, g);
#pragma unroll
              for (int i = 0; i < 8; ++i) Zs[(t0 + i + 32) * 16 + b] = f2bf(g[i]); } }
        __syncthreads();
        HY_STAMP(1);
        f32x4 acc[4][8];
#pragma unroll
        for (int m = 0; m < 4; ++m)
#pragma unroll
            for (int r = 0; r < 8; ++r) acc[m][r] = (f32x4){0.f, 0.f, 0.f, 0.f};
        hy_kloop(lds, (const LAS bf16_t*)(lds + HY_OFF_F), w, lane, acc);
        HY_STAMP(2);
        { int lo = lane, wo = w; asm volatile("" : "+v"(lo), "+v"(wo));
          const float g0 = cw[256 + c], g1 = cw[768 + 256 + c], g2 = cw[1536 + 256 + c];
          const int tb0 = 512 * wo + 32 * (lo >> 4);
          const bf16_t* u1 = UT + (size_t)(256 + c) * NROW + (lo & 15) * 4096 + tb0;
          const bf16_t* zp = Zs + (tb0 + 32) * 16 + (lo & 15);
#pragma unroll
          for (int m = 0; m < 4; ++m)
#pragma unroll
              for (int j = 0; j < 4; ++j) { float g[8]; hy_gate8(u1 + 128 * m + 8 * j, tb0 + 128 * m + 8 * j, g0, g1, g2, g);
#pragma unroll
                  for (int r = 0; r < 8; ++r) { const float z = bf2f(zp[(128 * m + r + 8 * j) * 16]); acc[m][r][j] = g[r] * (acc[m][r][j] + bias0 * z); }
                  asm volatile("" ::: "memory"); } }
        __syncthreads();
        { int lo = lane, wo = w; asm volatile("" : "+v"(lo), "+v"(wo));
          bf16_t* zp = Zs + (512 * wo + 32 * (lo >> 4) + 32) * 16 + (lo & 15);
#pragma unroll
          for (int m = 0; m < 4; ++m)
#pragma unroll
              for (int r = 0; r < 8; ++r) {
#pragma unroll
                  for (int j = 0; j < 4; ++j) zp[(128 * m + r + 8 * j) * 16] = f2bf(acc[m][r][j]);
                  asm volatile("" ::: "memory"); } }
        for (int x = tid; x < HY_FLEN / 8; x += NTHR) ((u32x4*)Fs)[x] = ((const u32x4*)FB)[x];
        __syncthreads();
        HY_STAMP(3);
#pragma unroll
        for (int m = 0; m < 4; ++m)
#pragma unroll
            for (int r = 0; r < 8; ++r) acc[m][r] = (f32x4){0.f, 0.f, 0.f, 0.f};
        hy_kloop(lds, (const LAS bf16_t*)(lds + HY_OFF_F), w, lane, acc);
        HY_STAMP(4);
        { int lo = lane, wo = w; asm volatile("" : "+v"(lo), "+v"(wo));
          const float e0 = cw[512 + c], e1 = cw[768 + 512 + c], e2 = cw[1536 + 512 + c];
          const int tb0 = 512 * wo + 32 * (lo >> 4);
          const bf16_t* u2 = UT + (size_t)(512 + c) * NROW + (lo & 15) * 4096 + tb0;
          bf16_t* yo = YT + (size_t)c * NROW + (lo & 15) * 4096 + tb0;
          const bf16_t* zp = Zs + (tb0 + 32) * 16 + (lo & 15);
#pragma unroll
          for (int m = 0; m < 4; ++m)
#pragma unroll
              for (int j = 0; j < 4; ++j) { float g[8]; hy_gate8(u2 + 128 * m + 8 * j, tb0 + 128 * m + 8 * j, e0, e1, e2, g);
#pragma unroll
                  for (int r = 0; r < 8; ++r) { const float z1 = bf2f(zp[(128 * m + r + 8 * j) * 16]); g[r] = g[r] * (acc[m][r][j] + bias1 * z1); }
                  u32x4 o; o.x = pack_bf16(g[0], g[1]); o.y = pack_bf16(g[2], g[3]); o.z = pack_bf16(g[4], g[5]); o.w = pack_bf16(g[6], g[7]);
                  *(u32x4*)(yo + 128 * m + 8 * j) = o;
                  asm volatile("" ::: "memory"); } }
        __syncthreads();
        HY_STAMP(5);
        if (l < DEPTH - 1) {   float* HTc = (float*)smem;
            bf16_t* Zc = (bf16_t*)(smem + HYC_OFF_Z);
            bf16_t* Fc0 = (bf16_t*)(smem + HYC_OFF_F); bf16_t* Fc1 = Fc0 + HYC_FLEN;
            float* part = (float*)(smem + HYC_OFF_Z);
            float t0 = 0.f, t1 = 0.f;
            { const int lag = tid & 255, kh = tid >> 8; float a0 = 0.f, a1 = 0.f, a2 = 0.f, a3 = 0.f;
              float hv[32];
#pragma unroll
              for (int k = 0; k < 32; ++k) hv[k] = H2C[(size_t)(32 * kh + k) * 256 + lag];
#pragma unroll
              for (int k = 0; k < 32; ++k) { const float h = hv[k]; const int kk = 32 * kh + k; a0 += h * fw3c[kk]; a1 += h * fw3c[64 + kk]; a2 += h * fw3c[128 + kk]; a3 += h * fw3c[192 + kk]; }
              if (kh == 1) { part[lag] = a0; part[256 + lag] = a1; part[512 + lag] = a2; part[768 + lag] = a3; }
              __syncthreads();
              if (kh == 0) { a0 += part[lag]; a1 += part[256 + lag]; a2 += part[512 + lag]; a3 += part[768 + lag];
                const float dec = expf(-((float)lag / 255.0f) * delta);
                a0 *= dec; a1 *= dec; a2 *= dec; a3 *= dec;
                HTc[lag] = a0; HTc[256 + lag] = a1; HTc[512 + lag] = a2; HTc[768 + lag] = a3;
                t0 = a0 * a0 + (lag >= 1 ? a2 * a2 : 0.f); t1 = a1 * a1 + (lag >= 1 ? a3 * a3 : 0.f); } }
            t0 = block_sum(t0, red); t1 = block_sum(t1, red);
            const float m0 = rsqrtf(t0 + EPSF), m1 = rsqrtf(t1 + EPSF);
            for (int x = tid; x < 2 * HYC_FLEN; x += NTHR) { const int o = x >= HYC_FLEN ? 1 : 0, xx = x - o * HYC_FLEN, d = 288 - xx; float f = 0.f;
                if (d >= 0 && d <= 255) f = HTc[256 * o + d]; else if (d < 0 && d >= -255) f = HTc[512 + 256 * o - d];
                Fc0[x] = f2bf(f * (o ? m1 : m0)); }
            { const bf16_t* uc = UT + (size_t)c * NROW + NROWL; const float v0 = cw[c], v1 = cw[768 + c], v2 = cw[1536 + c];
              for (int idx = tid; idx < 768; idx += NTHR) { const int rr = idx >> 4; Zc[(rr < 32 ? rr : 256 + rr) * 16 + (idx & 15)] = 0; }
#pragma unroll 2
              for (int idx = tid; idx < 4096; idx += NTHR) { const int b = idx >> 8, t = idx & 255; Zc[(t + 32) * 16 + b] = f2bf(hy_sconv(uc + b * 256, t, 256, v0, v1, v2)); } }
            __syncthreads();
            f32x4 ca[2];
            ca[0] = (f32x4){0.f, 0.f, 0.f, 0.f}; ca[1] = ca[0];
            hy_ckloop(lds + HYC_OFF_Z, (const LAS bf16_t*)(lds + HYC_OFF_F), w, lane, ca);
            { const float g0 = cw[256 + c], g1 = cw[768 + 256 + c], g2 = cw[1536 + 256 + c];
              const bf16_t* u1c = UT + (size_t)(256 + c) * NROW + NROWL + (lane & 15) * 256;
#pragma unroll
              for (int m = 0; m < 2; ++m)
#pragma unroll
                  for (int j = 0; j < 4; ++j) { const int t = 128 * m + w + 32 * (lane >> 4) + 8 * j;
                      const float z = bf2f(Zc[(t + 32) * 16 + (lane & 15)]);
                      ca[m][j] = hy_sconv(u1c, t, 256, g0, g1, g2) * (ca[m][j] + bias0 * z); } }
            __syncthreads();
#pragma unroll
            for (int m = 0; m < 2; ++m)
#pragma unroll
                for (int j = 0; j < 4; ++j) { const int t = 128 * m + w + 32 * (lane >> 4) + 8 * j; Zc[(t + 32) * 16 + (lane & 15)] = f2bf(ca[m][j]); }
            __syncthreads();
            ca[0] = (f32x4){0.f, 0.f, 0.f, 0.f}; ca[1] = ca[0];
            hy_ckloop(lds + HYC_OFF_Z, (const LAS bf16_t*)(lds + HYC_OFF_F + 2 * HYC_FLEN), w, lane, ca);
            { const float e0 = cw[512 + c], e1 = cw[768 + 512 + c], e2 = cw[1536 + 512 + c];
              const bf16_t* u2c = UT + (size_t)(512 + c) * NROW + NROWL + (lane & 15) * 256;
              bf16_t* yo = YT + (size_t)c * NROW + NROWL + (lane & 15) * 256;
#pragma unroll
              for (int m = 0; m < 2; ++m)
#pragma unroll
                  for (int j = 0; j < 4; ++j) { const int t = 128 * m + w + 32 * (lane >> 4) + 8 * j;
                      const float z1 = bf2f(Zc[(t + 32) * 16 + (lane & 15)]);
                      yo[t] = f2bf(hy_sconv(u2c, t, 256, e0, e1, e2) * (ca[m][j] + bias1 * z1)); } }
            __syncthreads();
        }
        HY_STAMP(6);
    }
}

__device__ __forceinline__ void phase_hy_transpose(const Params& p, int l, unsigned char* smem) {
    unsigned char* ws = launder_ws(p.ws);
    const bf16_t* YT = (const bf16_t*)(ws + WS_YT); bf16_t* Y = (bf16_t*)(ws + WS_U);
    bf16_t* tile = (bf16_t*)smem;
    const int tid = my_tid();
    const int ntile = 4 * ((l == DEPTH - 1 ? NROWL : NROW) / 64);
    for (int it = blockIdx.x; it < ntile; it += gridDim.x) {
        const int ct = it & 3, rt = it >> 2;
        __syncthreads();
        { const int ch = tid >> 3, seg = tid & 7;
          const u32x4 v = *(const u32x4*)(YT + (size_t)(ct * 64 + ch) * NROW + rt * 64 + seg * 8);
          unsigned* d = (unsigned*)(tile + ch * 66 + seg * 8); d[0] = v.x; d[1] = v.y; d[2] = v.z; d[3] = v.w; }
        __syncthreads();
        { const int r = tid >> 3, seg = tid & 7;
          unsigned wv[4];
#pragma unroll
          for (int k = 0; k < 4; ++k) wv[k] = (unsigned)tile[(seg * 8 + 2 * k) * 66 + r] | ((unsigned)tile[(seg * 8 + 2 * k + 1) * 66 + r] << 16);
          u32x4 o; o.x = wv[0]; o.y = wv[1]; o.z = wv[2]; o.w = wv[3];
          *(u32x4*)(Y + (size_t)(rt * 64 + r) * DM + 256 + ct * 64 + seg * 8) = o; }
    }
    __syncthreads();
}
#define ML_ITEMS 4352
__device__ __forceinline__ void ml_decode(int it, int& b, int& head, int& tc, int& tok0, int& jf, int& jb) {
    b = it / 272; const int r = it - b * 272; head = r / 68; tc = r - head * 68;
    tok0 = tc < 4 ? NROWL + b * TCX + 64 * tc : b * TL + 64 * (tc - 4);
    jf = tc; jb = tc < 4 ? 3 - tc : 71 - tc;
}

__device__ __forceinline__ void phase_ml_local(const Params& p, int l, unsigned char* smem) {
    unsigned char* ws = launder_ws(p.ws);
    const int tid = my_tid(), lane = tid & 63, w = tid >> 6;
    bf16_t* Kt = (bf16_t*)smem;
    bf16_t* VwF = Kt + 64 * 72;
    bf16_t* VwB = VwF + 64 * 72;
    float* Vs = (float*)(VwB + 64 * 72);
    float* vec = Vs + 64 * 65;
    float* igf = vec, *igb = vec + 64, *lff = vec + 128, *lfb = vec + 192, *wf = vec + 256, *wb = vec + 320, *scal = vec + 384;
    const bf16_t* P = (const bf16_t*)(ws + WS_P);
    const float* GT = (const float*)(ws + WS_GATES);
    bf16_t* MLA = (bf16_t*)(ws + WS_MLA); float* MLN = (float*)(ws + WS_MLN); float* MLS = (float*)(ws + WS_MLS);
    const float* bg = PIN(I_BGATE) + l * 16;
    for (int it = blockIdx.x; it < ML_ITEMS; it += gridDim.x) {
        int b, head, tc, tok0, jf, jb; ml_decode(it, b, head, tc, tok0, jf, jb);
        __syncthreads();
        { const int s = tid >> 3, ch = tid & 7;
          const bf16_t* pr = P + (size_t)(tok0 + s) * PW + head * 64 + ch * 8;
          const u32x4 kv = *(const u32x4*)(pr + 768), vv = *(const u32x4*)(pr + 1024);
          const unsigned kw[4] = {kv.x, kv.y, kv.z, kv.w}, vw[4] = {vv.x, vv.y, vv.z, vv.w};
#pragma unroll
          for (int i = 0; i < 4; ++i) { Kt[(ch * 8 + 2 * i) * 72 + s] = f2bf(bflo(kw[i]) * 0.125f); Kt[(ch * 8 + 2 * i + 1) * 72 + s] = f2bf(bfhi(kw[i]) * 0.125f);
              Vs[s * 65 + ch * 8 + 2 * i] = bflo(vw[i]); Vs[s * 65 + ch * 8 + 2 * i + 1] = bfhi(vw[i]); } }
        if (tid < 64) { const float* g = GT + (size_t)(tok0 + tid) * 16;
            igf[tid] = g[head] + bg[head]; igb[tid] = g[4 + head] + bg[4 + head]; lff[tid] = log_sigmoid(g[8 + head] + bg[8 + head]); lfb[tid] = log_sigmoid(g[12 + head] + bg[12 + head]); }
        __syncthreads();
        if (tid < 128) {
            const int dirw = tid >> 6, tau = tid & 63, s = dirw ? 63 - tau : tau;
            const float lf = dirw ? lfb[s] : lff[s], ig = dirw ? igb[s] : igf[s];
            float cum = lf;
#pragma unroll
            for (int o = 1; o < 64; o <<= 1) { const float n = __shfl_up(cum, o); if (tau >= o) cum += n; }
            const float B = __shfl(cum, 63);
            const float ge = B - cum + ig;
            const float ml = wave_max(ge);
            (dirw ? wb : wf)[s] = expf(ge - ml);
            if (tau == 0) { scal[2 * dirw] = B; scal[2 * dirw + 1] = ml; } }
        __syncthreads();
        { const int e = tid >> 3, sc = (tid & 7) * 8; u32x4 a, c2; float x[8], y[8];
#pragma unroll
          for (int i = 0; i < 8; ++i) { const float v = Vs[(sc + i) * 65 + e]; x[i] = v * wf[sc + i]; y[i] = v * wb[sc + i]; }
          a.x = pack_bf16(x[0], x[1]); a.y = pack_bf16(x[2], x[3]); a.z = pack_bf16(x[4], x[5]); a.w = pack_bf16(x[6], x[7]);
          c2.x = pack_bf16(y[0], y[1]); c2.y = pack_bf16(y[2], y[3]); c2.z = pack_bf16(y[4], y[5]); c2.w = pack_bf16(y[6], y[7]);
          *(u32x4*)(VwF + e * 72 + sc) = a; *(u32x4*)(VwB + e * 72 + sc) = c2; }
        __syncthreads();
        const int dir = w >> 2, wl = w & 3, te = wl >> 1, tk = wl & 1;
        const int seq = (b * 4 + head) * 2 + dir, j = dir ? jb : jf;
        bf16_t* dst = MLA + ((size_t)seq * 68 + j) * 4096;
        { f32x16 C;
#pragma unroll
          for (int r = 0; r < 16; ++r) C[r] = 0.f;
          C = mma32((dir ? VwB : VwF) + 32 * te * 72, 72, Kt + 32 * tk * 72, 72, 64, C, lane);
#pragma unroll
          for (int r = 0; r < 16; ++r) dst[(32 * te + CROW(r, lane)) * 64 + 32 * tk + (lane & 31)] = f2bf(C[r]); }
        if (wl == 0) {
            const float* wv = dir ? wb : wf; float s = 0.f;
            for (int t = 0; t < 64; ++t) s += wv[t] * bf2f(Kt[lane * 72 + t]);
            MLN[((size_t)seq * 68 + j) * 64 + lane] = s;
            if (lane == 0) { MLS[((size_t)seq * 68 + j) * 4 + 0] = scal[2 * dir]; MLS[((size_t)seq * 68 + j) * 4 + 1] = scal[2 * dir + 1]; }
        }
    }
    __syncthreads();
}

__device__ __forceinline__ void phase_ml_scan(const Params& p) {
    unsigned char* ws = launder_ws(p.ws);
    const int tid = my_tid();
    unsigned* MLA = (unsigned*)(ws + WS_MLA); float* MLN = (float*)(ws + WS_MLN); float* MLS = (float*)(ws + WS_MLS);
    for (int it = blockIdx.x; it < 512; it += gridDim.x) {
        const int seq = it >> 2, part = it & 3;
        unsigned* base = MLA + (size_t)seq * 68 * 2048 + part * 512 + tid;
        float* nb = MLN + (size_t)seq * 68 * 64 + part * 16 + tid;
        float* sc = MLS + (size_t)seq * 68 * 4;
        const bool hasn = tid < 16;
        float m = 0.f, c0 = 0.f, c1 = 0.f, cn = 0.f;
#define ML_SCAN_BATCH(NBATCH, J0) do { unsigned a[NBATCH]; float an[NBATCH], B[NBATCH], ML[NBATCH]; \
            _Pragma("unroll") for (int u = 0; u < NBATCH; ++u) { a[u] = base[(size_t)((J0) + u) * 2048]; an[u] = hasn ? nb[((J0) + u) * 64] : 0.f; B[u] = sc[((J0) + u) * 4]; ML[u] = sc[((J0) + u) * 4 + 1]; } \
            _Pragma("unroll") for (int u = 0; u < NBATCH; ++u) { \
                const float mn = fmaxf(B[u] + m, ML[u]); const float wp = expf(B[u] + m - mn), wa = expf(ML[u] - mn); \
                if (part == 0 && tid == 0) sc[((J0) + u) * 4 + 2] = m; \
                base[(size_t)((J0) + u) * 2048] = pack_bf16(c0, c1); if (hasn) nb[((J0) + u) * 64] = cn; \
                c0 = wp * c0 + wa * bflo(a[u]); c1 = wp * c1 + wa * bfhi(a[u]); cn = wp * cn + wa * an[u]; m = mn; } } while (0)
        for (int j0 = 0; j0 < 64; j0 += 8) ML_SCAN_BATCH(8, j0);
        ML_SCAN_BATCH(4, 64);
#undef ML_SCAN_BATCH
    }
}

__device__ __forceinline__ void phase_ml_out(const Params& p, int l, unsigned char* smem) {
    unsigned char* ws = launder_ws(p.ws);
    const int tid = my_tid(), lane = tid & 63, w = tid >> 6;
    const int DSZ = 71680;
    const bf16_t* P = (const bf16_t*)(ws + WS_P);
    const float* GT = (const float*)(ws + WS_GATES);
    const bf16_t* MLA = (const bf16_t*)(ws + WS_MLA); const float* MLN = (const float*)(ws + WS_MLN); const float* MLS = (const float*)(ws + WS_MLS);
    bf16_t* Y = (bf16_t*)(ws + WS_U);
    const float* bg = PIN(I_BGATE) + l * 16; const float* mln = PIN(I_MLNORM) + l * 64;
    u32x4 pq, pk_, pv, pst[2]; float pn = 0.f, pg0 = 0.f, pg1 = 0.f, pm = 0.f;
#define ML_SKIP(it_) ({ int b_, h_, tc_, t0_, jf_, jb_; ml_decode((it_), b_, h_, tc_, t0_, jf_, jb_); (l == DEPTH - 1 && tc_ < 4); })
#define ML_FETCH(it_) do { int b_, h_, tc_, t0_, jf_, jb_; ml_decode((it_), b_, h_, tc_, t0_, jf_, jb_); \
        { const int s_ = tid >> 3, ch_ = tid & 7; const bf16_t* pr_ = P + (size_t)(t0_ + s_) * PW + h_ * 64 + ch_ * 8; \
          pq = *(const u32x4*)(pr_ + 512); pk_ = *(const u32x4*)(pr_ + 768); pv = *(const u32x4*)(pr_ + 1024); } \
        _Pragma("unroll") for (int d_ = 0; d_ < 2; ++d_) { const int seq_ = (b_ * 4 + h_) * 2 + d_, j_ = d_ ? jb_ : jf_; \
          pst[d_] = *(const u32x4*)(MLA + ((size_t)seq_ * 68 + j_) * 4096 + (tid >> 3) * 64 + (tid & 7) * 8); } \
        if (tid < 128) { const int d_ = tid >> 6, tau_ = tid & 63, tk_ = d_ ? 63 - tau_ : tau_; const int seq_ = (b_ * 4 + h_) * 2 + d_, j_ = d_ ? jb_ : jf_; \
          pn = MLN[((size_t)seq_ * 68 + j_) * 64 + tau_]; const float* g_ = GT + (size_t)(t0_ + tk_) * 16; \
          pg0 = g_[4 * d_ + h_]; pg1 = g_[8 + 4 * d_ + h_]; pm = MLS[((size_t)seq_ * 68 + j_) * 4 + 2]; } } while (0)
    int it = blockIdx.x;
    while (it < ML_ITEMS && ML_SKIP(it)) it += gridDim.x;
    if (it < ML_ITEMS) ML_FETCH(it);
    while (it < ML_ITEMS) {
        int b, head, tc, tok0, jf, jb; ml_decode(it, b, head, tc, tok0, jf, jb);
        int nit = it + gridDim.x;
        while (nit < ML_ITEMS && ML_SKIP(nit)) nit += gridDim.x;
        __syncthreads();
        {   const int s = tid >> 3, ch = tid & 7;
            const u32x4 qv = pq, kv = pk_, vv = pv;
            u32x4 ks; ks.x = pack_bf16(bflo(kv.x) * 0.125f, bfhi(kv.x) * 0.125f); ks.y = pack_bf16(bflo(kv.y) * 0.125f, bfhi(kv.y) * 0.125f);
            ks.z = pack_bf16(bflo(kv.z) * 0.125f, bfhi(kv.z) * 0.125f); ks.w = pack_bf16(bflo(kv.w) * 0.125f, bfhi(kv.w) * 0.125f);
            const unsigned vw[4] = {vv.x, vv.y, vv.z, vv.w};
#pragma unroll
            for (int d = 0; d < 2; ++d) { unsigned char* D = smem + d * DSZ; const int tau = d ? 63 - s : s;
                bf16_t* Qd = (bf16_t*)D; bf16_t* Kd = Qd + 64 * 72; bf16_t* Bd = Kd + 64 * 72 + 64 * 136;
                *(u32x4*)(Qd + tau * 72 + ch * 8) = qv; *(u32x4*)(Kd + tau * 72 + ch * 8) = ks;
#pragma unroll
                for (int i = 0; i < 4; ++i) { Bd[(ch * 8 + 2 * i) * 136 + tau] = (bf16_t)(vw[i] & 0xffff); Bd[(ch * 8 + 2 * i + 1) * 136 + tau] = (bf16_t)(vw[i] >> 16); } }
#pragma unroll
            for (int d = 0; d < 2; ++d) { unsigned char* D = smem + d * DSZ; bf16_t* Bd = (bf16_t*)D + 2 * 64 * 72 + 64 * 136;
                const int e = tid >> 3, k0 = (tid & 7) * 8;
                *(u32x4*)(Bd + e * 136 + 64 + k0) = pst[d]; }
            if (tid < 128) { const int d = tid >> 6, tau = tid & 63;
                float* vecs = (float*)(smem + d * DSZ + 53248);
                vecs[3 * 64 + tau] = pn;
                vecs[4 * 64 + tau] = pg0 + bg[4 * d + head];
                vecs[5 * 64 + tau] = log_sigmoid(pg1 + bg[8 + 4 * d + head]); }
        }
        const float mcur = pm;
        if (nit < ML_ITEMS) ML_FETCH(nit);
        __syncthreads();
        if (tid < 128) { const int d = tid >> 6, tau = tid & 63; float* vecs = (float*)(smem + d * DSZ + 53248);
            const int seq = (b * 4 + head) * 2 + d, j = d ? jb : jf;
            const float m = mcur;
            float cum = vecs[5 * 64 + tau];
#pragma unroll
            for (int o = 1; o < 64; o <<= 1) { const float n = __shfl_up(cum, o); if (tau >= o) cum += n; }
            float mm = vecs[4 * 64 + tau] - cum;
#pragma unroll
            for (int o = 1; o < 64; o <<= 1) { const float n = __shfl_up(mm, o); if (tau >= o) mm = fmaxf(mm, n); }
            const float mt = cum + fmaxf(m, mm);
            vecs[tau] = cum; vecs[64 + tau] = mt; vecs[128 + tau] = expf(cum + m - mt); }
        __syncthreads();
        const int d = w >> 2, wl = w & 3, tt = wl >> 1, tx = wl & 1;
        unsigned char* D = smem + d * DSZ;
        bf16_t* Qd = (bf16_t*)D; bf16_t* Kd = Qd + 64 * 72; bf16_t* Ad = Kd + 64 * 72; bf16_t* Bd = Ad + 64 * 136;
        float* vecs = (float*)(D + 53248); float* Hd = vecs + 7 * 64;
        {   f32x16 S;
#pragma unroll
            for (int r = 0; r < 16; ++r) S[r] = 0.f;
            S = mma32(Qd + 32 * tt * 72, 72, Kd + 32 * tx * 72, 72, 64, S, lane);
            const int s = 32 * tx + (lane & 31); const float bs = vecs[s], igs = vecs[4 * 64 + s];
#pragma unroll
            for (int r = 0; r < 16; ++r) { const int t = 32 * tt + CROW(r, lane);
                const float val = (s <= t) ? S[r] * fast_exp2((vecs[t] - bs + igs - vecs[64 + t]) * LOG2E) : 0.f;
                Ad[t * 136 + s] = f2bf(val); }
            const int tl = tid & 255, t = tl >> 2, qd = tl & 3; const float wi = vecs[128 + t];
#pragma unroll
            for (int v = 0; v < 2; ++v) { const u32x4 q = *(const u32x4*)(Qd + t * 72 + 16 * qd + 8 * v); u32x4 o;
                o.x = pack_bf16(bflo(q.x) * wi, bfhi(q.x) * wi); o.y = pack_bf16(bflo(q.y) * wi, bfhi(q.y) * wi); o.z = pack_bf16(bflo(q.z) * wi, bfhi(q.z) * wi); o.w = pack_bf16(bflo(q.w) * wi, bfhi(q.w) * wi);
                *(u32x4*)(Ad + t * 136 + 64 + 16 * qd + 8 * v) = o; }
        }
        __syncthreads();
        {   f32x16 N;
#pragma unroll
            for (int r = 0; r < 16; ++r) N[r] = 0.f;
            N = mma32(Ad + 32 * tt * 136, 136, Bd + 32 * tx * 136, 136, 128, N, lane);
#pragma unroll
            for (int r = 0; r < 16; ++r) Hd[(32 * tt + CROW(r, lane)) * 65 + 32 * tx + (lane & 31)] = N[r];
            const int tl = tid & 255;
            {
                const int t = tl >> 2, qd = tl & 3; float dn = 0.f;
                const u32x4 sa = *(const u32x4*)(Ad + t * 136 + 16 * qd), sb = *(const u32x4*)(Ad + t * 136 + 16 * qd + 8);
                const u32x4 qa = *(const u32x4*)(Ad + t * 136 + 64 + 16 * qd), qb = *(const u32x4*)(Ad + t * 136 + 64 + 16 * qd + 8);
                const float* nv = vecs + 3 * 64 + 16 * qd;
                dn += (bflo(sa.x) + bfhi(sa.x)) + (bflo(sa.y) + bfhi(sa.y)) + (bflo(sa.z) + bfhi(sa.z)) + (bflo(sa.w) + bfhi(sa.w));
                dn += (bflo(sb.x) + bfhi(sb.x)) + (bflo(sb.y) + bfhi(sb.y)) + (bflo(sb.z) + bfhi(sb.z)) + (bflo(sb.w) + bfhi(sb.w));
                dn += bflo(qa.x) * nv[0] + bfhi(qa.x) * nv[1] + bflo(qa.y) * nv[2] + bfhi(qa.y) * nv[3] + bflo(qa.z) * nv[4] + bfhi(qa.z) * nv[5] + bflo(qa.w) * nv[6] + bfhi(qa.w) * nv[7];
                dn += bflo(qb.x) * nv[8] + bfhi(qb.x) * nv[9] + bflo(qb.y) * nv[10] + bfhi(qb.y) * nv[11] + bflo(qb.z) * nv[12] + bfhi(qb.z) * nv[13] + bflo(qb.w) * nv[14] + bfhi(qb.w) * nv[15];
                dn += dpp_get<DPP_XOR1>(dn); dn += dpp_get<DPP_XOR2>(dn);
                if (qd == 0) vecs[6 * 64 + t] = dn; }
        }
        __syncthreads();
        {   const int s = tid >> 3, e0 = (tid & 7) * 8;
            const float* vF = (const float*)(smem + 53248); const float* HF = vF + 7 * 64;
            const float* vB = (const float*)(smem + DSZ + 53248); const float* HB = vB + 7 * 64;
            const int tb = 63 - s;
            const float rf = 1.0f / fmaxf(fabsf(vF[6 * 64 + s]), fast_exp2(-vF[64 + s] * LOG2E)), rb = 1.0f / fmaxf(fabsf(vB[6 * 64 + tb]), fast_exp2(-vB[64 + tb] * LOG2E));
            float y[8], ss = 0.f;
#pragma unroll
            for (int i = 0; i < 8; ++i) { y[i] = HF[s * 65 + e0 + i] * rf + HB[tb * 65 + e0 + i] * rb; ss += y[i] * y[i]; }
            ss += __shfl_xor(ss, 1); ss += __shfl_xor(ss, 2); ss += __shfl_xor(ss, 4);
            const float rinv = rsqrtf(ss * (1.0f / 64.0f) + EPSF);
            const u32x4 ov = *(const u32x4*)(P + (size_t)(tok0 + s) * PW + 1280 + head * 64 + e0);
            const float op[8] = {bflo(ov.x), bfhi(ov.x), bflo(ov.y), bfhi(ov.y), bflo(ov.z), bfhi(ov.z), bflo(ov.w), bfhi(ov.w)};
            float o[8];
#pragma unroll
            for (int i = 0; i < 8; ++i) o[i] = y[i] * rinv * mln[e0 + i] * __builtin_amdgcn_rcpf(1.0f + fast_exp2(-op[i] * LOG2E));
            u32x4 wv; wv.x = pack_bf16(o[0], o[1]); wv.y = pack_bf16(o[2], o[3]); wv.z = pack_bf16(o[4], o[5]); wv.w = pack_bf16(o[6], o[7]);
            *(u32x4*)(Y + (size_t)(tok0 + s) * DM + 512 + head * 64 + e0) = wv;
        }
        it = nit;
    }
#undef ML_SKIP
#undef ML_FETCH
    __syncthreads();
}
#ifndef DUPMASK
#define DUPMASK 0
#endif
#ifndef PROBE_KIND
#define PROBE_KIND 0
#endif
#ifndef PROBE_MASK
#define PROBE_MASK 0
#endif
#ifndef PROBE_MULT
#define PROBE_MULT 1
#endif
#if PROBE_KIND
#define PROBE_PRE() do { if (blockIdx.x == 0 && threadIdx.x == 0) pw[0] = (unsigned)wall_clock64(); } while (0)
#define PROBE_POST(id) do { if (blockIdx.x == 0 && threadIdx.x == 0) { const unsigned t_ = (unsigned)wall_clock64(), c_ = (unsigned)clock64(); \
        if ((PROBE_MASK >> (id)) & 1) { if (PROBE_KIND == 1) pw[2] += t_ - pw[1]; if (PROBE_KIND == 2) pw[2] += t_ - pw[0]; if (PROBE_KIND == 3) { pw[2] += t_ - pw[1]; pw[3] += c_ - pw[4]; } } \
        pw[1] = t_; pw[4] = c_; } } while (0)
#else
#define PROBE_PRE() do {} while (0)
#define PROBE_POST(id) do {} while (0)
#endif
#if PROBE_KIND == 5
#define PROBE_SEC_BEGIN() do { if (blockIdx.x == 0 && threadIdx.x == 0) pw[5] = (unsigned)wall_clock64(); } while (0)
#define PROBE_SEC_END(k) do { if (blockIdx.x == 0 && threadIdx.x == 0) { const unsigned t_ = (unsigned)wall_clock64(); if ((PROBE_MASK >> (k)) & 1) pw[2] += t_ - pw[5]; pw[5] = t_; } } while (0)
#else
#define PROBE_SEC_BEGIN() do {} while (0)
#define PROBE_SEC_END(k) do {} while (0)
#endif
#define XBAR(id) do { PROBE_PRE(); XcdBarrier _b; _b.bar = (unsigned*)(launder_ws(p.ws) + WS_BAR); _b.x = xb_xcc_id(); _b.st = xbw; xcd_barrier(_b); if ((DUPMASK >> 13) & 1) xcd_barrier(_b); PROBE_POST(id); } while (0)
#define REP(k) for (int _rep = 0; _rep < 1 + ((DUPMASK >> (k)) & 1); ++_rep)
extern __shared__ __attribute__((aligned(16))) unsigned char smem_raw[];

__global__ void __launch_bounds__(NTHR, 2) trunk_fwd(Params p) {
    unsigned char* smem = smem_raw;
    volatile LAS unsigned* xbw = (volatile LAS unsigned*)(smem_raw + LDS_BYTES - 16);
    if (threadIdx.x == 0) { xbw[0] = 0u; xbw[1] = 0u; xbw[2] = 0u; xbw[3] = 0u; }
    __syncthreads();
    (void)xcd_barrier_post((unsigned*)(p.ws + WS_BAR), xbw);
#if PROBE_KIND
    volatile LAS unsigned* pw = (volatile LAS unsigned*)(smem_raw + LDS_BYTES - 48);
    if (blockIdx.x == 0 && threadIdx.x == 0) { pw[1] = (unsigned)wall_clock64(); pw[4] = (unsigned)clock64(); pw[2] = 0u; pw[3] = 0u; }
#endif
    unsigned char* ws = p.ws;
    LAS unsigned char* lds = (LAS unsigned char*)smem_raw;
    const int G = gridDim.x, c = blockIdx.x;
    phase_W<0>(p, 0, smem);
    XBAR(0);
    phase_norm<1>(p, 0, smem);
    XBAR(1);
    for (int l = 0; l < DEPTH; ++l) {
        const bool last = (l == DEPTH - 1);
        REP(10) {   pg8::Gemm g; g.A = (const bf16_t*)(ws + WS_U); g.Bt = (const bf16_t*)(ws + WS_U); g.M = 0; g.N = 0; g.K = DM;
            { const int tid = my_tid();
              const float4* src = (const float4*)(ws + WS_ROPE); float4* dst = (float4*)(smem + EPI_TAB_OFF);
              for (int i = tid; i < 768; i += NTHR) dst[i] = src[i];
              float* gl = (float*)(smem + EPI_TAB_OFF + 12288);
              if (tid < 192) gl[tid] = tid < 64 ? PIN(I_AQN)[l * 64 + tid] : tid < 128 ? PIN(I_AKN)[l * 64 + tid - 64] : tid < 160 ? PIN(I_DQN)[l * 32 + tid - 128] : PIN(I_DKN)[l * 32 + tid - 160];
              __syncthreads(); }
            InProjOrder S{G, c}; EpiInProj E{(bf16_t*)(ws + WS_P), (bf16_t*)(ws + WS_UT), (const LAS unsigned char*)(lds + EPI_TAB_OFF)};
            pg8::gemm_phase(lds, g, S, E); }
        XBAR(2);
        PROBE_SEC_BEGIN();
        REP(0) phase_hyena(p, l, smem);
        PROBE_SEC_END(0);
        REP(1) phase_attnD(p, l, smem);
        PROBE_SEC_END(1);
        REP(2) phase_attnA(p, l, smem);
        PROBE_SEC_END(2);
        REP(3) phase_ml_local(p, l, smem);
        PROBE_SEC_END(3);
        XBAR(4);
        phase_ml_scan(p);
        REP(9) phase_hy_transpose(p, l, smem);
        XBAR(5);
        REP(4) phase_ml_out(p, l, smem);
        XBAR(6);
        {   pg8::Gemm g; g.A = (const bf16_t*)(ws + WS_U); g.Bt = (const bf16_t*)(ws + WS_WOUT); g.M = 0; g.N = 0; g.K = DM;
            OutProjOrder S{G, c, last ? 256 : 272};
            EpiOut E{PIN(I_X), PIN(I_CTX), (bf16_t*)(ws + WS_XB), (const float*)(ws + WS_MOD + (size_t)(l & 1) * MOD_BYTES), l == 0 ? 1 : 0};
            pg8::gemm_phase(lds, g, S, E); }
        REP(5) if (l + 1 < DEPTH) phase_W<2>(p, l + 1, smem);
        XBAR(7);
        REP(6) phase_norm<2>(p, l, smem);
        XBAR(8);
        REP(7) phase_topk(p, l, smem);
        XBAR(9);
        REP(11) {   pg8::Gemm g; g.A = (const bf16_t*)(ws + WS_U); g.Bt = (const bf16_t*)(ws + WS_WGU); g.M = 0; g.N = 0; g.K = DM;
            GateUpOrder S{G, c, last ? 32 : 34}; EpiGU E{(bf16_t*)(ws + WS_HID)};
            pg8::gemm_phase_gather(lds, g, S, E, (const int*)(ws + WS_SROW)); }
        XBAR(10);
        REP(12) {   pg8::Gemm g; g.A = (const bf16_t*)(ws + WS_HID); g.Bt = (const bf16_t*)(ws + WS_WD); g.M = 0; g.N = 0; g.K = DM;
            DownOrder S{G, c, last ? 32 : 34}; EpiDown E{(bf16_t*)(ws + WS_XE), (const float*)(ws + WS_SGATE)};
            pg8::gemm_phase(lds, g, S, E); }
        if (l + 1 < DEPTH) phase_W<3>(p, l + 1, smem);
        XBAR(11);
        if (l + 1 < DEPTH) { REP(14) phase_combine<true>(p, l, smem); REP(5) phase_W<1>(p, l + 1, smem); XBAR(12); }
        else phase_combine<false>(p, l, smem);
    }
#if PROBE_KIND
    PROBE_POST(12);
    if (blockIdx.x == 0 && threadIdx.x == 0) {
        unsigned long long target = (unsigned long long)pw[2] * PROBE_MULT;
        if (PROBE_KIND == 3) target = pw[2] ? (unsigned long long)pw[3] * 10000ull / pw[2] : 0ull;
        const unsigned long long t0 = wall_clock64();
        while ((unsigned long long)wall_clock64() - t0 < target) __builtin_amdgcn_s_sleep(8);
    }
#endif
}

extern "C" void kernel_launch(void* const* d_in, const int* in_sizes, int n_in, void* d_out, int out_size, void* d_ws, size_t ws_size, hipStream_t stream) {
    static int grid = 0;
    if (grid == 0) {
        if (n_in != 34 || out_size != NROWL * DM || ws_size < WS_END) { fprintf(stderr, "kernel_launch: unexpected shapes (n_in %d out %d ws %zu need %zu)\n", n_in, out_size, ws_size, (size_t)WS_END); grid = -1; return; }
        int dev = 0, cus = 0;
        if (hipGetDevice(&dev) != hipSuccess || hipDeviceGetAttribute(&cus, hipDeviceAttributeMultiprocessorCount, dev) != hipSuccess) { grid = -1; return; }
        if (hipFuncSetAttribute((const void*)trunk_fwd, hipFuncAttributeMaxDynamicSharedMemorySize, LDS_BYTES) != hipSuccess) { fprintf(stderr, "kernel_launch: hipFuncSetAttribute failed\n"); grid = -1; return; }
        int per_cu = 0;
        if (hipOccupancyMaxActiveBlocksPerMultiprocessor(&per_cu, (const void*)trunk_fwd, NTHR, LDS_BYTES) != hipSuccess || per_cu < 1) { fprintf(stderr, "kernel_launch: occupancy query says %d\n", per_cu); }
        (void)hipGetLastError();
        grid = cus;
        if (grid > 256) grid = 256;
        grid &= ~7;
    }
    if (grid <= 0) return;
    (void)hipMemsetAsync((char*)d_ws + WS_BAR, 0, 16384, stream);
    Params p{};
    for (int i = 0; i < 34; ++i) p.in[i] = (const float*)d_in[i];
    p.out = (float*)d_out; p.ws = (unsigned char*)d_ws;
    hipLaunchKernelGGL(trunk_fwd, dim3(grid), dim3(NTHR), LDS_BYTES, stream, p);
}
```

```cpp
#include <hip/hip_runtime.h>
#include <stdint.h>
#include <stdio.h>

typedef unsigned short bf16_t;
typedef short bf16x8 __attribute__((ext_vector_type(8)));
typedef short s16x4 __attribute__((ext_vector_type(4)));
typedef float f32x4 __attribute__((ext_vector_type(4)));
typedef float f32x16 __attribute__((ext_vector_type(16)));
typedef unsigned u32x4 __attribute__((ext_vector_type(4)));
typedef unsigned u32x2 __attribute__((ext_vector_type(2)));
#define LAS __attribute__((address_space(3)))

#define NB 16
#define TL 4096
#define TCX 256
#define DM 1024
#define NROWL 65536
#define NROWC 4096
#define NROW 69632
#define PW 2304
#define INW 3088
#define NEXP 16
#define CAPL 512
#define CAPC 32
#define SLOTS_E 8704
#define NSLOT 139264
#define DEPTH 4
#define NTHR 512
#define LDS_BYTES 155648
#define EPSF 1e-6f
#define LOG2E 1.4426950408889634f

constexpr size_t al256(size_t x) { return (x + 255) & ~size_t(255); }
constexpr size_t WS_BAR   = 0;
constexpr size_t WS_MOD   = al256(WS_BAR + 16384);
constexpr size_t MOD_BYTES = al256((size_t)17 * 6144 * 4);
constexpr size_t WS_HID2L = al256(WS_MOD + 2 * MOD_BYTES);
constexpr size_t WS_HID2C = al256(WS_HID2L + (size_t)4096 * 64 * 4);
constexpr size_t WS_GATES = al256(WS_HID2C + (size_t)256 * 64 * 4);
constexpr size_t WS_AFF   = al256(WS_GATES + (size_t)NROW * 16 * 4);
constexpr size_t WS_SROW  = al256(WS_AFF + (size_t)NROW * 16 * 4);
constexpr size_t WS_SGATE = al256(WS_SROW + (size_t)NSLOT * 4);
constexpr size_t WS_INV   = al256(WS_SGATE + (size_t)NSLOT * 4);
constexpr size_t WS_MLS   = al256(WS_INV + (size_t)NROW * 16 * 4);
constexpr size_t WS_FBUF  = al256(WS_MLS + (size_t)128 * 68 * 4 * 4);
constexpr size_t WS_ROPE  = al256(WS_FBUF + (size_t)256 * 8256 * 2);
constexpr size_t WS_CTX   = al256(WS_ROPE + (size_t)64 * 24 * 8);
constexpr size_t WS_U     = al256(WS_CTX + (size_t)NROWC * DM * 4);
constexpr size_t WS_WOUT  = al256(WS_U + (size_t)(NROW + 3072) * DM * 2);
constexpr size_t WS_WGU   = al256(WS_WOUT + (size_t)DM * DM * 2);
constexpr size_t WS_WD    = al256(WS_WGU + (size_t)NEXP * 2048 * DM * 2);
constexpr size_t WS_P     = al256(WS_WD + (size_t)NEXP * DM * DM * 2);
constexpr size_t WS_UT    = al256(WS_P + (size_t)NROW * PW * 2);
constexpr size_t WS_XE    = al256(WS_UT + (size_t)768 * NROW * 2);
constexpr size_t WS_XB    = al256(WS_XE + (size_t)NSLOT * DM * 2);
constexpr size_t WS_END   = al256(WS_XB + (size_t)NROW * DM * 2);
constexpr size_t WS_HID   = WS_P;
constexpr size_t WS_MLA   = WS_XE;
constexpr size_t WS_MLN   = al256(WS_MLA + (size_t)128 * 68 * 4096 * 2);
constexpr size_t WS_YT    = al256(WS_MLN + (size_t)128 * 68 * 64 * 4);
static_assert(WS_YT + (size_t)256 * NROW * 2 <= WS_XB, "alias overflow");
static_assert((size_t)NSLOT * DM * 2 <= (size_t)NROW * PW * 2, "hid alias overflow");

struct Params {
    const float* in[34];
    float* out;
    unsigned char* ws;
};
enum { I_X = 0, I_C, I_CTX, I_CCTX, I_WADA, I_BADA, I_N1G, I_N2G, I_WIN, I_BGATE, I_AQN, I_AKN, I_ASINK, I_HYCONV, I_FW1, I_FB1, I_FREQ, I_FW2, I_FB2, I_FW3,
       I_HYBIAS, I_MLNORM, I_DQN, I_DKN, I_LQ1, I_LK1, I_LQ2, I_LK2, I_DSUB, I_WOUT, I_WROUTER, I_WEG, I_WEU, I_WED };

__device__ __forceinline__ int my_tid() { int t = threadIdx.x; asm volatile("" : "+v"(t)); return t; }
#define GAS __attribute__((address_space(1)))
__device__ __forceinline__ unsigned char* launder_ws(unsigned char* q) { GAS unsigned char* g = (GAS unsigned char*)q; asm volatile("" : "+s"(g)); return (unsigned char*)g; }
#define CAS __attribute__((address_space(4)))
__device__ __forceinline__ const float* pin_ptr(int i) { const CAS char* ka = (const CAS char*)__builtin_amdgcn_kernarg_segment_ptr(); asm volatile("" : "+s"(ka));
    const GAS float* g = *(const GAS float* const CAS*)(ka + 8 * i); return (const float*)g; }
#define PIN(i) pin_ptr(i)
#define POUT() ((float*)pin_ptr(34))
__device__ __forceinline__ float bf2f(bf16_t v) { return __uint_as_float((unsigned)v << 16); }
__device__ __forceinline__ bf16_t f2bf(float f) { unsigned u = __float_as_uint(f); u += 0x7fffu + ((u >> 16) & 1u); return (bf16_t)(u >> 16); }
__device__ __forceinline__ unsigned pack_bf16(float lo, float hi) { return (unsigned)f2bf(lo) | ((unsigned)f2bf(hi) << 16); }
__device__ __forceinline__ float bflo(unsigned w) { return __uint_as_float(w << 16); }
__device__ __forceinline__ float bfhi(unsigned w) { return __uint_as_float(w & 0xffff0000u); }
template <int CTRL> __device__ __forceinline__ float dpp_get(float v) { return __int_as_float(__builtin_amdgcn_update_dpp(0, __float_as_int(v), CTRL, 0xf, 0xf, true)); }
#define DPP_XOR1 0xB1
#define DPP_XOR2 0x4E
#define DPP_HMIRROR 0x141
#define DPP_MIRROR 0x140
#define DPP_ROR8 0x128
__device__ __forceinline__ float wave_sum(float v) {
    v += dpp_get<DPP_XOR1>(v); v += dpp_get<DPP_XOR2>(v); v += dpp_get<DPP_HMIRROR>(v); v += dpp_get<DPP_MIRROR>(v);
    const int iv = __float_as_int(v);
    return (__int_as_float(__builtin_amdgcn_readlane(iv, 0)) + __int_as_float(__builtin_amdgcn_readlane(iv, 16))) + (__int_as_float(__builtin_amdgcn_readlane(iv, 32)) + __int_as_float(__builtin_amdgcn_readlane(iv, 48)));
}
__device__ __forceinline__ float wave_max(float v) {
    v = fmaxf(v, dpp_get<DPP_XOR1>(v)); v = fmaxf(v, dpp_get<DPP_XOR2>(v)); v = fmaxf(v, dpp_get<DPP_HMIRROR>(v)); v = fmaxf(v, dpp_get<DPP_MIRROR>(v));
    const int iv = __float_as_int(v);
    return fmaxf(fmaxf(__int_as_float(__builtin_amdgcn_readlane(iv, 0)), __int_as_float(__builtin_amdgcn_readlane(iv, 16))), fmaxf(__int_as_float(__builtin_amdgcn_readlane(iv, 32)), __int_as_float(__builtin_amdgcn_readlane(iv, 48))));
}
__device__ __forceinline__ float lane_xor16(float v, int lane) { const auto r = __builtin_amdgcn_permlane16_swap(__float_as_uint(v), __float_as_uint(v), false, false); return __uint_as_float((lane & 16) ? r[0] : r[1]); }
__device__ __forceinline__ float lane_xor32(float v, int lane) { const auto r = __builtin_amdgcn_permlane32_swap(__float_as_uint(v), __float_as_uint(v), false, false); return __uint_as_float((lane & 32) ? r[0] : r[1]); }
__device__ __forceinline__ float reduce16_transpose(const float (&part)[16], int lane) {
    float v8[8], v4[4], v2[2], v1;
#pragma unroll
    for (int j = 0; j < 8; ++j) { const auto r = __builtin_amdgcn_permlane32_swap(__float_as_uint(part[j]), __float_as_uint(part[8 + j]), false, false); v8[j] = __uint_as_float(r[0]) + __uint_as_float(r[1]); }
#pragma unroll
    for (int j = 0; j < 4; ++j) { const auto r = __builtin_amdgcn_permlane16_swap(__float_as_uint(v8[j]), __float_as_uint(v8[4 + j]), false, false); v4[j] = __uint_as_float(r[0]) + __uint_as_float(r[1]); }
    { const bool up = (lane & 8) != 0;
#pragma unroll
      for (int j = 0; j < 2; ++j) { const float send = up ? v4[j] : v4[2 + j], keep = up ? v4[2 + j] : v4[j]; v2[j] = keep + dpp_get<DPP_ROR8>(send); } }
    { const bool up = (lane & 4) != 0; const float send = up ? v2[0] : v2[1], keep = up ? v2[1] : v2[0]; v1 = keep + dpp_get<DPP_HMIRROR>(send); }
    v1 += dpp_get<DPP_XOR2>(v1); v1 += dpp_get<DPP_XOR1>(v1);
    return v1;
}
__device__ __forceinline__ float fast_exp2(float x) { return __builtin_amdgcn_exp2f(x); }
__device__ __forceinline__ float log_sigmoid(float x) { return fminf(x, 0.f) - log1pf(expf(-fabsf(x))); }

#define XB_TMO      128
#define XB_XCNT(j)  (256  + 64 * (j))
#define XB_XSUB(j)  (1280 + 64 * (j))
#define XB_XGEN(j)  (2304 + 64 * (j))
#define XB_TOP      3328
#define XB_TOPGEN   3392
#define XCD_BAR_WORDS 3456
#define XB_SPIN_CAP (1u << 22)

__device__ __forceinline__ unsigned xb_ld(unsigned* p)              { return __hip_atomic_load(p, __ATOMIC_RELAXED, __HIP_MEMORY_SCOPE_AGENT); }
__device__ __forceinline__ unsigned xb_add(unsigned* p, unsigned v) { return __hip_atomic_fetch_add(p, v, __ATOMIC_RELAXED, __HIP_MEMORY_SCOPE_AGENT); }
__device__ __forceinline__ unsigned xb_xcc_id() { return (unsigned)__builtin_amdgcn_s_getreg((3 << 11) | 20) & 0xFu; }
#define XB_SPIN(cond, bar) do { unsigned _sp = 0; while (cond) { __builtin_amdgcn_s_sleep(1); \
    if ((++_sp & 255u) == 0u) { if (xb_ld(&(bar)[XB_TMO])) break; if (_sp > XB_SPIN_CAP) { atomicAdd(&(bar)[XB_TMO], 1u); break; } } } } while (0)

struct XcdBarrier { unsigned* bar; unsigned x; volatile LAS unsigned* st; };

__device__ __forceinline__ XcdBarrier xcd_barrier_post(unsigned* bar, volatile LAS unsigned* st) {
    XcdBarrier b; b.bar = bar; b.x = xb_xcc_id(); b.st = st;
    if (threadIdx.x == 0) (void)xb_add(&bar[XB_XCNT(b.x)], 1u);
    return b;
}
__device__ __forceinline__ void xcd_barrier_complete(unsigned* bar, unsigned x, unsigned& nloc, unsigned& nx) {
    const unsigned G = gridDim.x * gridDim.y * gridDim.z;
    unsigned sum, cnt, mine, sp = 0u;
    for (;;) {
        sum = 0u; cnt = 0u; mine = 0u;
#pragma unroll
        for (unsigned j = 0; j < 16; ++j) { const unsigned c = xb_ld(&bar[XB_XCNT(j)]); sum += c; cnt += (c > 0u) ? 1u : 0u; mine = (j == x) ? c : mine; }
        if (sum == G) break;
        __builtin_amdgcn_s_sleep(1);
        if ((++sp & 255u) == 0u) { if (xb_ld(&bar[XB_TMO])) break; if (sp > XB_SPIN_CAP) { atomicAdd(&bar[XB_TMO], 1u); break; } }
    }
    nloc = mine > 0u ? mine : 1u; nx = cnt > 0u ? cnt : 1u;
}
__device__ __forceinline__ void xcd_barrier(const XcdBarrier& b) {
    asm volatile("s_waitcnt vmcnt(0)" ::: "memory");
    __syncthreads();
    if (threadIdx.x == 0) {
        unsigned* bar = b.bar;
        __builtin_amdgcn_s_waitcnt(0);
        unsigned nloc = b.st[0], nx = b.st[1];
        if (nloc == 0u) { xcd_barrier_complete(bar, b.x, nloc, nx); b.st[0] = nloc; b.st[1] = nx; }
        const unsigned old = xb_add(&bar[XB_XSUB(b.x)], 1u);
        const unsigned gen = old / nloc;
        if (old + 1u == (gen + 1u) * nloc) {
            __builtin_amdgcn_fence(__ATOMIC_RELEASE, "agent");
            asm volatile("s_waitcnt vmcnt(0)" ::: "memory");
            const unsigned og = xb_add(&bar[XB_TOP], 1u);
            const unsigned tg = og / nx;
            if (og + 1u == (tg + 1u) * nx) xb_add(&bar[XB_TOPGEN], 1u);
            else XB_SPIN(xb_ld(&bar[XB_TOPGEN]) == tg, bar);
            __builtin_amdgcn_fence(__ATOMIC_ACQUIRE, "agent");
            xb_add(&bar[XB_XGEN(b.x)], 1u);
            asm volatile("s_waitcnt vmcnt(0)" ::: "memory");
        } else {
            XB_SPIN(xb_ld(&bar[XB_XGEN(b.x)]) == gen, bar);
            __builtin_amdgcn_fence(__ATOMIC_ACQUIRE, "agent");
            asm volatile("s_waitcnt vmcnt(0)" ::: "memory");
        }
    }
    __syncthreads();
}

namespace pg8 {
constexpr int BM = 256, BK = 64, HALF = 128, HTB = HALF * BK * 2, STAGE_BYTES = 8 * HTB, NXCD = 8, WGM = 8;
__host__ __device__ __forceinline__ int lds_byte(int r, int c) { const int st = (r >> 4) * 2 + (c >> 5), rr = r & 15, cc = c & 31, ob = rr * 64 + cc * 2; return st * 1024 + (ob ^ (((ob >> 9) & 1) << 5)); }
__host__ __device__ __forceinline__ void stage_rc(int b, int& R, int& C) { const int st = b / 1024, sb = b % 1024, swz = sb ^ (((sb >> 9) & 1) << 5); R = (st >> 1) * 16 + swz / 64; C = (st & 1) * 32 + (swz % 64) / 2; }
__host__ __device__ __forceinline__ int perm32(int rho) { const int n = rho >> 4, i = rho & 15; return 8 * (i >> 2) + 4 * n + (i & 3); }
struct Unit { int pm, pn; };
struct Gemm { const bf16_t* A; const bf16_t* Bt; int M, N, K; };
__device__ __forceinline__ unsigned cvt_pk_bf16(float lo, float hi) { unsigned r; asm volatile("v_cvt_pk_bf16_f32 %0, %1, %2" : "=v"(r) : "v"(lo), "v"(hi)); return r; }

__device__ __forceinline__ void static_unit(int L, int nM, int nN, int& pm, int& pn) {
    const int nwg = nM * nN; int wgid = L;
    { const int q = nwg / NXCD, r = nwg % NXCD, xcd = wgid % NXCD, off = wgid / NXCD; wgid = (xcd < r ? xcd * (q + 1) : r * (q + 1) + (xcd - r) * q) + off; }
    const int nig = WGM * nN, gid = wgid / nig, fm = gid * WGM, gsz = (nM - fm) < WGM ? (nM - fm) : WGM;
    pm = fm + ((wgid % nig) % gsz); pn = (wgid % nig) / gsz;
}

template <class Epi, class Sched>
__device__ __forceinline__ void gemm_phase(LAS unsigned char* lds, const Gemm g, const Sched& S, const Epi& E) {
    const int tid = my_tid(), wid = __builtin_amdgcn_readfirstlane(tid >> 6), lane = tid & 63, wr = wid >> 2, wc = wid & 3, fr = lane & 15, fq = lane >> 4;
    const int K = g.K, nt = K / BK;
    unsigned voffA[2], voffB[2];
#pragma unroll
    for (int i = 0; i < 2; ++i) { int R, C; stage_rc(tid * 16 + i * 8192, R, C); const int Rb = Epi::PERM ? ((R & ~31) + perm32(R & 31)) : R;
        voffA[i] = (unsigned)(R * K + C) * 2u; voffB[i] = (unsigned)(Rb * K + C) * 2u; }
    const size_t kstep = (size_t)(BK * 2);
    const size_t hstep = (size_t)HALF * K * 2;
    const size_t tstep = 2 * hstep;
    const unsigned ldsw = (unsigned)wid * 1024u;
    const int aoff = lds_byte(wr * 64 + fr, fq * 8), boff = lds_byte(wc * 32 + fr, fq * 8);
#define PG8_SA(b, h) (((b) * 2 + (h)) * HTB)
#define PG8_SB(b, h) ((4 + (b) * 2 + (h)) * HTB)
#define PG8_STAGE(bufoff, gbase, voff) do { _Pragma("unroll") for (int _i = 0; _i < 2; ++_i) \
        __builtin_amdgcn_global_load_lds((const unsigned*)((const char*)(gbase) + (voff)[_i]), (LAS unsigned*)(lds + (bufoff) + ldsw + _i * 8192), 16, 0, 0); } while (0)
#define PG8_LDA(dst, b, h) do { _Pragma("unroll") for (int m = 0; m < 4; ++m) _Pragma("unroll") for (int k = 0; k < 2; ++k) dst[m][k] = *(const LAS bf16x8*)(lds + PG8_SA(b, h) + aoff + m * 2048 + k * 1024); } while (0)
#define PG8_LDB(dst, b, h) do { _Pragma("unroll") for (int n = 0; n < 2; ++n) _Pragma("unroll") for (int k = 0; k < 2; ++k) dst[n][k] = *(const LAS bf16x8*)(lds + PG8_SB(b, h) + boff + n * 2048 + k * 1024); } while (0)
#define PG8_MMA(ai, bj, At, Bt) do { __builtin_amdgcn_s_setprio(1); _Pragma("unroll") for (int m = 0; m < 4; ++m) _Pragma("unroll") for (int n = 0; n < 2; ++n) _Pragma("unroll") for (int k = 0; k < 2; ++k) \
        acc[ai][bj][m][n] = __builtin_amdgcn_mfma_f32_16x16x32_bf16(Bt[n][k], At[m][k], acc[ai][bj][m][n], 0, 0, 0); __builtin_amdgcn_s_setprio(0); } while (0)
#define PG8_WAIT_V(n) asm volatile("s_waitcnt vmcnt(" #n ")" ::: "memory")
#define PG8_WAIT_L(n) asm volatile("s_waitcnt lgkmcnt(" #n ")" ::: "memory")
#define PG8_BAR __builtin_amdgcn_s_barrier()
#define PG8_SCHED __builtin_amdgcn_sched_barrier(0)
    Unit cur, nxt; int ui = 0;
    if (!S.next(0, cur)) return;
    f32x4 acc[2][2][4][2];
#pragma unroll
    for (int a = 0; a < 2; ++a)
#pragma unroll
        for (int b = 0; b < 2; ++b)
#pragma unroll
            for (int m = 0; m < 4; ++m)
#pragma unroll
                for (int n = 0; n < 2; ++n) acc[a][b][m][n] = (f32x4){0.f, 0.f, 0.f, 0.f};
    bf16x8 At[4][2], B0[2][2], B1[2][2];
    const char* cA = (const char*)g.A + (size_t)cur.pm * tstep; const char* cB = (const char*)g.Bt + (size_t)cur.pn * tstep;
    PG8_STAGE(PG8_SB(0, 0), cB, voffB); PG8_STAGE(PG8_SA(0, 0), cA, voffA); PG8_STAGE(PG8_SB(0, 1), cB + hstep, voffB); PG8_STAGE(PG8_SA(0, 1), cA + hstep, voffA);
    if (wr == 1) PG8_BAR;
    PG8_WAIT_V(4); PG8_BAR;
    PG8_STAGE(PG8_SB(1, 0), cB + kstep, voffB); PG8_STAGE(PG8_SA(1, 0), cA + kstep, voffA); PG8_STAGE(PG8_SB(1, 1), cB + hstep + kstep, voffB);
    PG8_WAIT_V(6); PG8_BAR;
    for (;;) {
        const bool has_next = S.next(ui + 1, nxt);
        const char* nA = has_next ? (const char*)g.A + (size_t)nxt.pm * tstep : cA; const char* nB = has_next ? (const char*)g.Bt + (size_t)nxt.pn * tstep : cB;
        for (int t = 0; t < nt; t += 2) {
            const bool last = (t == nt - 2);
            const char* a1 = cA + (size_t)(t + 1) * kstep;
            const char* a2 = last ? nA : cA + (size_t)(t + 2) * kstep; const char* b2 = last ? nB : cB + (size_t)(t + 2) * kstep;
            const char* a3 = a2 + kstep; const char* b3 = b2 + kstep;
            PG8_LDB(B0, 0, 0); PG8_SCHED; PG8_LDA(At, 0, 0); PG8_STAGE(PG8_SA(1, 1), a1 + hstep, voffA);
            PG8_WAIT_L(8); PG8_BAR; PG8_WAIT_L(0); PG8_MMA(0, 0, At, B0); PG8_BAR; PG8_SCHED;
            PG8_LDB(B1, 0, 1); PG8_STAGE(PG8_SB(0, 0), b2, voffB);
            PG8_BAR; PG8_WAIT_L(0); PG8_MMA(0, 1, At, B1); PG8_BAR;
            PG8_LDA(At, 0, 1); PG8_STAGE(PG8_SA(0, 0), a2, voffA);
            PG8_BAR; PG8_WAIT_L(0); PG8_MMA(1, 0, At, B0); PG8_BAR; PG8_SCHED;
            PG8_STAGE(PG8_SB(0, 1), b2 + hstep, voffB);
            PG8_WAIT_V(6); PG8_BAR; PG8_MMA(1, 1, At, B1); PG8_BAR;
            PG8_LDB(B0, 1, 0); PG8_SCHED; PG8_LDA(At, 1, 0); PG8_STAGE(PG8_SA(0, 1), a2 + hstep, voffA);
            PG8_WAIT_L(8); PG8_BAR; PG8_WAIT_L(0); PG8_MMA(0, 0, At, B0); PG8_BAR; PG8_SCHED;
            PG8_LDB(B1, 1, 1); PG8_STAGE(PG8_SB(1, 0), b3, voffB);
            PG8_BAR; PG8_WAIT_L(0); PG8_MMA(0, 1, At, B1); PG8_BAR;
            PG8_LDA(At, 1, 1); PG8_STAGE(PG8_SA(1, 0), a3, voffA);
            PG8_BAR; PG8_WAIT_L(0); PG8_MMA(1, 0, At, B0); PG8_BAR; PG8_SCHED;
            PG8_STAGE(PG8_SB(1, 1), b3 + hstep, voffB);
            PG8_WAIT_V(6); PG8_BAR; PG8_MMA(1, 1, At, B1); PG8_BAR;
        }
#if defined(PROBE_KIND) && PROBE_KIND == 4
        { unsigned t0_ = 0; if (blockIdx.x == 0 && threadIdx.x == 0) t0_ = (unsigned)wall_clock64();
          E(acc, cur, wr, wc, fr, fq);
          if (blockIdx.x == 0 && threadIdx.x == 0) { asm volatile("s_waitcnt vmcnt(0)" ::: "memory"); volatile LAS unsigned* pw_ = (volatile LAS unsigned*)(lds + LDS_BYTES - 48); pw_[2] += (unsigned)wall_clock64() - t0_; } }
#else
        E(acc, cur, wr, wc, fr, fq);
#endif
        if (!has_next) break;
#pragma unroll
        for (int a = 0; a < 2; ++a)
#pragma unroll
            for (int b = 0; b < 2; ++b)
#pragma unroll
                for (int m = 0; m < 4; ++m)
#pragma unroll
                    for (int n = 0; n < 2; ++n) acc[a][b][m][n] = (f32x4){0.f, 0.f, 0.f, 0.f};
        cur = nxt; cA = nA; cB = nB; ++ui;
    }
    PG8_WAIT_V(0);
    if (wr == 0) PG8_BAR;
    PG8_BAR;
#undef PG8_SA
#undef PG8_SB
#undef PG8_STAGE
#undef PG8_LDA
#undef PG8_LDB
#undef PG8_MMA
#undef PG8_WAIT_V
#undef PG8_WAIT_L
#undef PG8_BAR
#undef PG8_SCHED
}
template <class Epi, class Sched>
__device__ __forceinline__ void gemm_phase_gather(LAS unsigned char* lds, const Gemm g, const Sched& S, const Epi& E, const int* __restrict__ srow) {
    const int tid = my_tid(), wid = __builtin_amdgcn_readfirstlane(tid >> 6), lane = tid & 63, wr = wid >> 2, wc = wid & 3, fr = lane & 15, fq = lane >> 4;
    const int K = g.K, nt = K / BK;
    unsigned voffB[2];
#pragma unroll
    for (int i = 0; i < 2; ++i) { int R, C; stage_rc(tid * 16 + i * 8192, R, C); const int Rb = Epi::PERM ? ((R & ~31) + perm32(R & 31)) : R;
        voffB[i] = (unsigned)(Rb * K + C) * 2u; }
    unsigned gcur[2][2], gnxt[2][2];
#define PG8_LOADG(dst, u) do { const int _t = my_tid(); _Pragma("unroll") for (int _i = 0; _i < 2; ++_i) { int _R, _C; stage_rc(_t * 16 + _i * 8192, _R, _C); _Pragma("unroll") for (int _h = 0; _h < 2; ++_h) \
        dst[_h][_i] = (unsigned)srow[(u).pm * 256 + 128 * _h + _R] * (unsigned)(K * 2) + (unsigned)_C * 2u; } } while (0)
#define PG8_STAGEG(bufoff, gofs, kbyte) do { _Pragma("unroll") for (int _i = 0; _i < 2; ++_i) \
        __builtin_amdgcn_global_load_lds((const unsigned*)((const char*)g.A + (gofs)[_i] + (kbyte)), (LAS unsigned*)(lds + (bufoff) + ldsw + _i * 8192), 16, 0, 0); } while (0)
    const size_t kstep = (size_t)(BK * 2);
    const size_t hstep = (size_t)HALF * K * 2;
    const size_t tstep = 2 * hstep;
    const unsigned ldsw = (unsigned)wid * 1024u;
    const int aoff = lds_byte(wr * 64 + fr, fq * 8), boff = lds_byte(wc * 32 + fr, fq * 8);
#define PG8_SA(b, h) (((b) * 2 + (h)) * HTB)
#define PG8_SB(b, h) ((4 + (b) * 2 + (h)) * HTB)
#define PG8_STAGE(bufoff, gbase, voff) do { _Pragma("unroll") for (int _i = 0; _i < 2; ++_i) \
        __builtin_amdgcn_global_load_lds((const unsigned*)((const char*)(gbase) + (voff)[_i]), (LAS unsigned*)(lds + (bufoff) + ldsw + _i * 8192), 16, 0, 0); } while (0)
#define PG8_LDA(dst, b, h) do { _Pragma("unroll") for (int m = 0; m < 4; ++m) _Pragma("unroll") for (int k = 0; k < 2; ++k) dst[m][k] = *(const LAS bf16x8*)(lds + PG8_SA(b, h) + aoff + m * 2048 + k * 1024); } while (0)
#define PG8_LDB(dst, b, h) do { _Pragma("unroll") for (int n = 0; n < 2; ++n) _Pragma("unroll") for (int k = 0; k < 2; ++k) dst[n][k] = *(const LAS bf16x8*)(lds + PG8_SB(b, h) + boff + n * 2048 + k * 1024); } while (0)
#define PG8_MMA(ai, bj, At, Bt) do { __builtin_amdgcn_s_setprio(1); _Pragma("unroll") for (int m = 0; m < 4; ++m) _Pragma("unroll") for (int n = 0; n < 2; ++n) _Pragma("unroll") for (int k = 0; k < 2; ++k) \
        acc[ai][bj][m][n] = __builtin_amdgcn_mfma_f32_16x16x32_bf16(Bt[n][k], At[m][k], acc[ai][bj][m][n], 0, 0, 0); __builtin_amdgcn_s_setprio(0); } while (0)
#define PG8_WAIT_V(n) asm volatile("s_waitcnt vmcnt(" #n ")" ::: "memory")
#define PG8_WAIT_L(n) asm volatile("s_waitcnt lgkmcnt(" #n ")" ::: "memory")
#define PG8_BAR __builtin_amdgcn_s_barrier()
#define PG8_SCHED __builtin_amdgcn_sched_barrier(0)
    Unit cur, nxt; int ui = 0;
    if (!S.next(0, cur)) return;
    f32x4 acc[2][2][4][2];
#pragma unroll
    for (int a = 0; a < 2; ++a)
#pragma unroll
        for (int b = 0; b < 2; ++b)
#pragma unroll
            for (int m = 0; m < 4; ++m)
#pragma unroll
                for (int n = 0; n < 2; ++n) acc[a][b][m][n] = (f32x4){0.f, 0.f, 0.f, 0.f};
    bf16x8 At[4][2], B0[2][2], B1[2][2];
    const char* cB = (const char*)g.Bt + (size_t)cur.pn * tstep;
    PG8_LOADG(gcur, cur);
    PG8_STAGE(PG8_SB(0, 0), cB, voffB); PG8_STAGEG(PG8_SA(0, 0), gcur[0], 0); PG8_STAGE(PG8_SB(0, 1), cB + hstep, voffB); PG8_STAGEG(PG8_SA(0, 1), gcur[1], 0);
    if (wr == 1) PG8_BAR;
    PG8_WAIT_V(4); PG8_BAR;
    PG8_STAGE(PG8_SB(1, 0), cB + kstep, voffB); PG8_STAGEG(PG8_SA(1, 0), gcur[0], kstep); PG8_STAGE(PG8_SB(1, 1), cB + hstep + kstep, voffB);
    PG8_WAIT_V(6); PG8_BAR;
    for (;;) {
        const bool has_next = S.next(ui + 1, nxt);
        const char* nB = has_next ? (const char*)g.Bt + (size_t)nxt.pn * tstep : cB;
        if (has_next) PG8_LOADG(gnxt, nxt); else { gnxt[0][0] = gcur[0][0]; gnxt[0][1] = gcur[0][1]; gnxt[1][0] = gcur[1][0]; gnxt[1][1] = gcur[1][1]; }
        for (int t = 0; t < nt; t += 2) {
            const bool last = (t == nt - 2);
            const size_t k1 = (size_t)(t + 1) * kstep, k2 = last ? 0 : (size_t)(t + 2) * kstep, k3 = k2 + kstep;
            const char* b2 = last ? nB : cB + (size_t)(t + 2) * kstep; const char* b3 = b2 + kstep;
            unsigned g0[2], g1[2];
            g0[0] = last ? gnxt[0][0] : gcur[0][0]; g0[1] = last ? gnxt[0][1] : gcur[0][1]; g1[0] = last ? gnxt[1][0] : gcur[1][0]; g1[1] = last ? gnxt[1][1] : gcur[1][1];
            PG8_LDB(B0, 0, 0); PG8_SCHED; PG8_LDA(At, 0, 0); PG8_STAGEG(PG8_SA(1, 1), gcur[1], k1);
            PG8_WAIT_L(8); PG8_BAR; PG8_WAIT_L(0); PG8_MMA(0, 0, At, B0); PG8_BAR; PG8_SCHED;
            PG8_LDB(B1, 0, 1); PG8_STAGE(PG8_SB(0, 0), b2, voffB);
            PG8_BAR; PG8_WAIT_L(0); PG8_MMA(0, 1, At, B1); PG8_BAR;
            PG8_LDA(At, 0, 1); PG8_STAGEG(PG8_SA(0, 0), g0, k2);
            PG8_BAR; PG8_WAIT_L(0); PG8_MMA(1, 0, At, B0); PG8_BAR; PG8_SCHED;
            PG8_STAGE(PG8_SB(0, 1), b2 + hstep, voffB);
            PG8_WAIT_V(6); PG8_BAR; PG8_MMA(1, 1, At, B1); PG8_BAR;
            PG8_LDB(B0, 1, 0); PG8_SCHED; PG8_LDA(At, 1, 0); PG8_STAGEG(PG8_SA(0, 1), g1, k2);
            PG8_WAIT_L(8); PG8_BAR; PG8_WAIT_L(0); PG8_MMA(0, 0, At, B0); PG8_BAR; PG8_SCHED;
            PG8_LDB(B1, 1, 1); PG8_STAGE(PG8_SB(1, 0), b3, voffB);
            PG8_BAR; PG8_WAIT_L(0); PG8_MMA(0, 1, At, B1); PG8_BAR;
            PG8_LDA(At, 1, 1); PG8_STAGEG(PG8_SA(1, 0), g0, k3);
            PG8_BAR; PG8_WAIT_L(0); PG8_MMA(1, 0, At, B0); PG8_BAR; PG8_SCHED;
            PG8_STAGE(PG8_SB(1, 1), b3 + hstep, voffB);
            PG8_WAIT_V(6); PG8_BAR; PG8_MMA(1, 1, At, B1); PG8_BAR;
        }
#if defined(PROBE_KIND) && PROBE_KIND == 4
        { unsigned t0_ = 0; if (blockIdx.x == 0 && threadIdx.x == 0) t0_ = (unsigned)wall_clock64();
          E(acc, cur, wr, wc, fr, fq);
          if (blockIdx.x == 0 && threadIdx.x == 0) { asm volatile("s_waitcnt vmcnt(0)" ::: "memory"); volatile LAS unsigned* pw_ = (volatile LAS unsigned*)(lds + LDS_BYTES - 48); pw_[2] += (unsigned)wall_clock64() - t0_; } }
#else
        E(acc, cur, wr, wc, fr, fq);
#endif
        if (!has_next) break;
#pragma unroll
        for (int a = 0; a < 2; ++a)
#pragma unroll
            for (int b = 0; b < 2; ++b)
#pragma unroll
                for (int m = 0; m < 4; ++m)
#pragma unroll
                    for (int n = 0; n < 2; ++n) acc[a][b][m][n] = (f32x4){0.f, 0.f, 0.f, 0.f};
        cur = nxt; cB = nB; ++ui;
        gcur[0][0] = gnxt[0][0]; gcur[0][1] = gnxt[0][1]; gcur[1][0] = gnxt[1][0]; gcur[1][1] = gnxt[1][1];
    }
    PG8_WAIT_V(0);
    if (wr == 0) PG8_BAR;
    PG8_BAR;
#undef PG8_LOADG
#undef PG8_STAGEG
#undef PG8_SA
#undef PG8_SB
#undef PG8_STAGE
#undef PG8_LDA
#undef PG8_LDB
#undef PG8_MMA
#undef PG8_WAIT_V
#undef PG8_WAIT_L
#undef PG8_BAR
#undef PG8_SCHED
}
}
using pg8::Unit;
struct InProjOrder { int G, c;
    __device__ __forceinline__ bool next(int i, Unit& u) const {
        const int L = i * G + c; if (L >= 3264) return false;
        int pm, pn;
        if (L < 2448) { pg8::static_unit(L, 272, 9, pm, pn); u.pm = pm; u.pn = 272 + pn; }
        else { pg8::static_unit(L - 2448, 3, 272, pm, pn); u.pm = 281 + pm; u.pn = pn; }
        return true; } };
struct OutProjOrder { int G, c, nM;
    __device__ __forceinline__ bool next(int i, Unit& u) const {
        const int L = i * G + c; if (L >= nM * 4) return false;
        pg8::static_unit(L, nM, 4, u.pm, u.pn); return true; } };
struct GateUpOrder { int G, c, nM;
    __device__ __forceinline__ bool next(int i, Unit& u) const {
        const int per = nM * 8; const int L = i * G + c; if (L >= 16 * per) return false;
        const int e = L / per; int pm, pn; pg8::static_unit(L - e * per, nM, 8, pm, pn); u.pm = e * 34 + pm; u.pn = e * 8 + pn; return true; } };
struct DownOrder { int G, c, nM;
    __device__ __forceinline__ bool next(int i, Unit& u) const {
        const int per = nM * 4; const int L = i * G + c; if (L >= 16 * per) return false;
        const int e = L / per; int pm, pn; pg8::static_unit(L - e * per, nM, 4, pm, pn); u.pm = e * 34 + pm; u.pn = e * 4 + pn; return true; } };

#define EPI_TAB_OFF 131072
struct EpiInProj { static constexpr bool PERM = true; bf16_t* P; bf16_t* UT; const LAS unsigned char* tab;
    __device__ __forceinline__ void operator()(const f32x4 (&acc)[2][2][4][2], const Unit& u, int wr, int wc, int fr, int fq) const {
        bf16_t* base; int ldc, rt, ct;
        if (u.pn >= 272) { base = P; ldc = PW; rt = u.pm; ct = u.pn - 272; } else { base = UT; ldc = NROW; rt = u.pm - 281; ct = u.pn; }
        const int row0 = rt * 256 + wr * 64 + fr, col0 = ct * 256 + wc * 32 + 8 * fq;
        if (u.pn >= 272 && ct < 2) {
            const bool nrm = ct == 0 || wc < 2;
            const int colA = ct * 256 + wc * 64 + 8 * fq;
            const LAS float* gnp = (const LAS float*)(tab + 12288) + (ct == 0 ? 0 : 64) + 8 * fq;
            const float qs = ct == 0 ? 0.125f * LOG2E : 1.0f;
            const bool hi = (fq >> 1) != 0; const int lane_ = fr + 16 * fq;
#pragma unroll
            for (int ai = 0; ai < 2; ++ai)
#pragma unroll
                for (int m = 0; m < 4; ++m) { const int row = row0 + ai * 128 + m * 16; const bool lat = row < NROWL; const int t = row & 4095;
                    bf16_t* rowp = base + (size_t)row * ldc + colA;
                    float inv = 1.0f;
                    if (nrm) { float ss = 0.f;
#pragma unroll
                        for (int bj = 0; bj < 2; ++bj)
#pragma unroll
                            for (int n = 0; n < 2; ++n)
#pragma unroll
                                for (int e = 0; e < 4; ++e) ss += acc[ai][bj][m][n][e] * acc[ai][bj][m][n][e];
                        ss += lane_xor16(ss, lane_); ss += lane_xor32(ss, lane_);
                        inv = rsqrtf(ss * (1.0f / 64.0f) + EPSF); }
#pragma unroll
                    for (int bj = 0; bj < 2; ++bj) { const f32x4 v0 = acc[ai][bj][m][0], v1 = acc[ai][bj][m][1];
                        float o[8] = {v0[0], v0[1], v0[2], v0[3], v1[0], v1[1], v1[2], v1[3]};
                        if (nrm) {
                            const f32x4 ga = *(const LAS f32x4*)(gnp + bj * 32), gb = *(const LAS f32x4*)(gnp + bj * 32 + 4);
                            const float gn[8] = {ga[0], ga[1], ga[2], ga[3], gb[0], gb[1], gb[2], gb[3]};
                            const int pos = bj == 0 ? (t >> 6) : (t & 63);
                            const LAS f32x4* rp = (const LAS f32x4*)(tab + pos * 128 + 64 * (fq & 1));
                            const f32x4 r0 = rp[0], r1 = rp[1], r2 = rp[2], r3 = rp[3];
                            const float cs[8] = {r0[0], r0[2], r1[0], r1[2], r2[0], r2[2], r3[0], r3[2]}, sn[8] = {r0[1], r0[3], r1[1], r1[3], r2[1], r2[3], r3[1], r3[3]};
#pragma unroll
                            for (int i = 0; i < 8; ++i) { const float y = o[i] * inv * gn[i]; const float pr = lane_xor32(y, lane_);
                                o[i] = (lat ? (hi ? y * cs[i] + pr * sn[i] : y * cs[i] - pr * sn[i]) : y) * qs; } }
                        u32x4 w; w.x = pg8::cvt_pk_bf16(o[0], o[1]); w.y = pg8::cvt_pk_bf16(o[2], o[3]); w.z = pg8::cvt_pk_bf16(o[4], o[5]); w.w = pg8::cvt_pk_bf16(o[6], o[7]);
                        *(u32x4*)(rowp + bj * 32) = w; } }
            return;
        }
        if (u.pn >= 272 && (ct == 6 || ct == 7)) {
            const LAS float* gnp = (const LAS float*)(tab + 12288) + (ct == 6 ? 128 : 160) + 8 * fq;
            const f32x4 ga = *(const LAS f32x4*)gnp, gb = *(const LAS f32x4*)(gnp + 4);
            const float gn[8] = {ga[0], ga[1], ga[2], ga[3], gb[0], gb[1], gb[2], gb[3]};
            const float qs = ct == 6 ? 0.17677669529663687f * LOG2E : 1.0f;
            const bool hi = (fq & 1) != 0; const int lane_ = fr + 16 * fq;
#pragma unroll
            for (int ai = 0; ai < 2; ++ai)
#pragma unroll
                for (int m = 0; m < 4; ++m) { const int row = row0 + ai * 128 + m * 16; const bool lat = row < NROWL; const int t = row & 4095;
                    const int pos = (fq >> 1) == 0 ? (t >> 6) : (t & 63);
                    const LAS f32x4* rp = (const LAS f32x4*)(tab + 8192 + pos * 64);
                    const f32x4 r0 = rp[0], r1 = rp[1], r2 = rp[2], r3 = rp[3];
                    const float cs[8] = {r0[0], r0[2], r1[0], r1[2], r2[0], r2[2], r3[0], r3[2]}, sn[8] = {r0[1], r0[3], r1[1], r1[3], r2[1], r2[3], r3[1], r3[3]};
                    bf16_t* rowp = base + (size_t)row * ldc + col0;
#pragma unroll
                    for (int bj = 0; bj < 2; ++bj) { const f32x4 v0 = acc[ai][bj][m][0], v1 = acc[ai][bj][m][1];
                        float x[8] = {v0[0], v0[1], v0[2], v0[3], v1[0], v1[1], v1[2], v1[3]};
                        float ss = 0.f;
#pragma unroll
                        for (int i = 0; i < 8; ++i) ss += x[i] * x[i];
                        ss += lane_xor16(ss, lane_); ss += lane_xor32(ss, lane_);
                        const float inv = rsqrtf(ss * (1.0f / 32.0f) + EPSF);
                        float o[8];
#pragma unroll
                        for (int i = 0; i < 8; ++i) { const float y = x[i] * inv * gn[i]; const float pr = lane_xor16(y, lane_);
                            o[i] = (lat ? (hi ? y * cs[i] + pr * sn[i] : y * cs[i] - pr * sn[i]) : y) * qs; }
                        u32x4 w; w.x = pg8::cvt_pk_bf16(o[0], o[1]); w.y = pg8::cvt_pk_bf16(o[2], o[3]); w.z = pg8::cvt_pk_bf16(o[4], o[5]); w.w = pg8::cvt_pk_bf16(o[6], o[7]);
                        *(u32x4*)(rowp + bj * 128) = w; } }
            return;
        }
#pragma unroll
        for (int ai = 0; ai < 2; ++ai)
#pragma unroll
            for (int m = 0; m < 4; ++m) { bf16_t* rowp = base + (size_t)(row0 + ai * 128 + m * 16) * ldc + col0;
#pragma unroll
                for (int bj = 0; bj < 2; ++bj) { const f32x4 v0 = acc[ai][bj][m][0], v1 = acc[ai][bj][m][1];
                    u32x4 w; w.x = pg8::cvt_pk_bf16(v0[0], v0[1]); w.y = pg8::cvt_pk_bf16(v0[2], v0[3]); w.z = pg8::cvt_pk_bf16(v1[0], v1[1]); w.w = pg8::cvt_pk_bf16(v1[2], v1[3]);
                    *(u32x4*)(rowp + bj * 128) = w; } }
    } };
__device__ __forceinline__ float silu_mul(float g, float u) { return g * u * __builtin_amdgcn_rcpf(1.0f + fast_exp2(-g * LOG2E)); }
struct EpiGU { static constexpr bool PERM = true; bf16_t* HID;
    __device__ __forceinline__ void operator()(const f32x4 (&acc)[2][2][4][2], const Unit& u, int wr, int wc, int fr, int fq) const {
        const int row0 = u.pm * 256 + wr * 64 + fr, col0 = (u.pn & 7) * 128 + wc * 32 + 8 * fq;
#pragma unroll
        for (int ai = 0; ai < 2; ++ai)
#pragma unroll
            for (int m = 0; m < 4; ++m) { bf16_t* rowp = HID + (size_t)(row0 + ai * 128 + m * 16) * DM + col0;
                const f32x4 g0 = acc[ai][0][m][0], g1 = acc[ai][0][m][1], u0 = acc[ai][1][m][0], u1 = acc[ai][1][m][1];
                u32x4 w; w.x = pg8::cvt_pk_bf16(silu_mul(g0[0], u0[0]), silu_mul(g0[1], u0[1])); w.y = pg8::cvt_pk_bf16(silu_mul(g0[2], u0[2]), silu_mul(g0[3], u0[3]));
                w.z = pg8::cvt_pk_bf16(silu_mul(g1[0], u1[0]), silu_mul(g1[1], u1[1])); w.w = pg8::cvt_pk_bf16(silu_mul(g1[2], u1[2]), silu_mul(g1[3], u1[3]));
                *(u32x4*)rowp = w; }
    } };
struct EpiDown { static constexpr bool PERM = true; bf16_t* Y; const float* sgate;
    __device__ __forceinline__ void operator()(const f32x4 (&acc)[2][2][4][2], const Unit& u, int wr, int wc, int fr, int fq) const {
        const int row0 = u.pm * 256 + wr * 64 + fr, col0 = (u.pn & 3) * 256 + wc * 32 + 8 * fq;
#pragma unroll
        for (int ai = 0; ai < 2; ++ai)
#pragma unroll
            for (int m = 0; m < 4; ++m) { const int r = row0 + ai * 128 + m * 16; const float gt = sgate[r]; bf16_t* rowp = Y + (size_t)r * DM + col0;
#pragma unroll
                for (int bj = 0; bj < 2; ++bj) { const f32x4 v0 = acc[ai][bj][m][0] * gt, v1 = acc[ai][bj][m][1] * gt;
                    u32x4 w; w.x = pg8::cvt_pk_bf16(v0[0], v0[1]); w.y = pg8::cvt_pk_bf16(v0[2], v0[3]); w.z = pg8::cvt_pk_bf16(v1[0], v1[1]); w.w = pg8::cvt_pk_bf16(v1[2], v1[3]);
                    *(u32x4*)(rowp + bj * 128) = w; } }
    } };
struct EpiOut { static constexpr bool PERM = true; const float* srcL; const float* srcC; bf16_t* XB; const float* MOD; int first;
    __device__ __forceinline__ void operator()(const f32x4 (&acc)[2][2][4][2], const Unit& u, int wr, int wc, int fr, int fq) const {
        const float* gt = MOD + (size_t)(u.pm < 256 ? (u.pm >> 4) : 16) * 6144 + 2048;
        const int row0 = u.pm * 256 + wr * 64 + fr, col0 = u.pn * 256 + wc * 32 + 8 * fq;
        f32x4 gv[2][2];
#pragma unroll
        for (int bj = 0; bj < 2; ++bj)
#pragma unroll
            for (int n = 0; n < 2; ++n) gv[bj][n] = *(const f32x4*)(gt + col0 + bj * 128 + n * 4);
#pragma unroll
        for (int ai = 0; ai < 2; ++ai)
#pragma unroll
            for (int m = 0; m < 4; ++m) { const int row = row0 + ai * 128 + m * 16;
                bf16_t* xrow = XB + (size_t)row * DM + col0;
                const float* frow = (row < NROWL ? srcL + (size_t)row * DM : srcC + (size_t)(row - NROWL) * DM) + col0;
#pragma unroll
                for (int bj = 0; bj < 2; ++bj) {
                    f32x4 s0, s1;
                    if (first) { s0 = *(const f32x4*)(frow + bj * 128); s1 = *(const f32x4*)(frow + bj * 128 + 4); }
                    else { const u32x4 raw = *(const u32x4*)(xrow + bj * 128);
                        s0 = (f32x4){bflo(raw.x), bfhi(raw.x), bflo(raw.y), bfhi(raw.y)}; s1 = (f32x4){bflo(raw.z), bfhi(raw.z), bflo(raw.w), bfhi(raw.w)}; }
                    const f32x4 v0 = s0 + gv[bj][0] * acc[ai][bj][m][0], v1 = s1 + gv[bj][1] * acc[ai][bj][m][1];
                    u32x4 w; w.x = pg8::cvt_pk_bf16(v0[0], v0[1]); w.y = pg8::cvt_pk_bf16(v0[2], v0[3]); w.z = pg8::cvt_pk_bf16(v1[0], v1[1]); w.w = pg8::cvt_pk_bf16(v1[2], v1[3]);
                    *(u32x4*)(xrow + bj * 128) = w; } }
    } };

__device__ __forceinline__ f32x16 mma32(const bf16_t* A, int lda, const bf16_t* Bt, int ldb, int K, f32x16 acc, int lane) {
    const int r = lane & 31, h = lane >> 5;
    const bf16_t* ap = A + r * lda + 8 * h; const bf16_t* bp = Bt + r * ldb + 8 * h;
    for (int k = 0; k < K; k += 16) {
        const bf16x8 a = *(const bf16x8*)(ap + k); const bf16x8 b = *(const bf16x8*)(bp + k);
        acc = __builtin_amdgcn_mfma_f32_32x32x16_bf16(a, b, acc, 0, 0, 0);
    }
    return acc;
}
#define CROW(reg, lane) (((reg) & 3) + 8 * ((reg) >> 2) + 4 * ((lane) >> 5))
typedef short v4i16_t __attribute__((ext_vector_type(4)));
__device__ __forceinline__ s16x4 tr_read(const LAS unsigned char* ptr) { return __builtin_bit_cast(s16x4, __builtin_amdgcn_ds_read_tr16_b64_v4i16((LAS v4i16_t*)ptr)); }
struct TrDesc { const float* src; bf16_t* dst; int src_ld, src_col0, k0, n0, hi_off; };
__device__ __forceinline__ void tr_load(const TrDesc& d, int t, float4 (&v)[2]) {
#pragma unroll
    for (int p = 0; p < 2; ++p) { const int j = (t >> 4) + 32 * p; v[p] = *(const float4*)(d.src + (size_t)(d.k0 + j) * d.src_ld + d.src_col0 + (t & 15) * 4 + ((t & 8) ? d.hi_off : 0)); }
}
__device__ __forceinline__ void tr_store(unsigned char* smem, const TrDesc& d, int t, const float4 (&v)[2]) {
    float* tile = (float*)smem;
#pragma unroll
    for (int p = 0; p < 2; ++p) { const int j = (t >> 4) + 32 * p; float* q = tile + j * 65 + (t & 15) * 4; q[0] = v[p].x; q[1] = v[p].y; q[2] = v[p].z; q[3] = v[p].w; }
    __syncthreads();
    { const int i = t >> 3, kc = (t & 7) * 8;
      u32x4 w;
      w.x = pack_bf16(tile[(kc + 0) * 65 + i], tile[(kc + 1) * 65 + i]); w.y = pack_bf16(tile[(kc + 2) * 65 + i], tile[(kc + 3) * 65 + i]);
      w.z = pack_bf16(tile[(kc + 4) * 65 + i], tile[(kc + 5) * 65 + i]); w.w = pack_bf16(tile[(kc + 6) * 65 + i], tile[(kc + 7) * 65 + i]);
      *(u32x4*)(d.dst + (size_t)(d.n0 + i) * DM + d.k0 + kc) = w; }
    __syncthreads();
}

template <int PART>
__device__ __forceinline__ void phase_W(const Params& p, int l, unsigned char* smem) {
    unsigned char* ws = launder_ws(p.ws);
    const int tid = my_tid(), G = gridDim.x, bid = blockIdx.x;
    if (PART == 0 && bid == 0) {
        float2* rA = (float2*)(ws + WS_ROPE); float2* rD = rA + 64 * 16;
        for (int idx = tid; idx < 64 * 16; idx += NTHR) { const int pos = idx >> 4, f = idx & 15; const float inv = powf(10000.0f, -(float)f / 16.0f); float sn, cs; sincosf((float)pos * inv, &sn, &cs); rA[idx] = make_float2(cs, sn); }
        for (int idx = tid; idx < 64 * 8; idx += NTHR) { const int pos = idx >> 3, f = idx & 7; const float inv = powf(10000.0f, -(float)f / 8.0f); float sn, cs; sincosf((float)pos * inv, &sn, &cs); rD[idx] = make_float2(cs, sn); }
    }
    if (PART == 0) { int4* inv4 = (int4*)(ws + WS_INV); const int n4 = NROW * 16 / 4;
      for (int i = bid * NTHR + tid; i < n4; i += G * NTHR) inv4[i] = make_int4(-1, -1, -1, -1); }
    const float* w_in = PIN(I_WIN) + (size_t)l * DM * INW;
    const float* w_out = PIN(I_WOUT) + (size_t)l * DM * DM;
    const float* weg = PIN(I_WEG) + (size_t)l * NEXP * DM * DM;
    const float* weu = PIN(I_WEU) + (size_t)l * NEXP * DM * DM;
    const float* wed = PIN(I_WED) + (size_t)l * NEXP * DM * DM;
    bf16_t* WinT = (bf16_t*)(ws + WS_U) + (size_t)NROW * DM;
    bf16_t* WoutT = (bf16_t*)(ws + WS_WOUT);
    bf16_t* WguT = (bf16_t*)(ws + WS_WGU);
    bf16_t* WdT = (bf16_t*)(ws + WS_WD);
    const int N_IN = 768, N_OUT = 256, N_GU = 8192, N_D = 4096, N_ADA = 96, N_HID = 544;
    const int NCVT = N_IN + N_OUT + N_GU + N_D;
    auto tr_desc = [&](int x, TrDesc& d) {
        if (x < N_IN) { const int nt = x >> 4, kt = x & 15, n0 = nt * 64;
            int sc; d.hi_off = 0; if (n0 < 512) { const int b4 = (n0 >> 6) & 3; sc = (n0 & 256) + (b4 & 1) * 128 + (b4 >> 1) * 32; d.hi_off = 32; } else if (n0 < 1536) sc = n0 + 768; else if (n0 < 2304) sc = n0 + 784; else sc = n0 - 1792;
            d.src = w_in; d.src_ld = INW; d.src_col0 = sc; d.k0 = kt * 64; d.dst = WinT; d.n0 = n0; return; }
        x -= N_IN;
        if (x < N_OUT) { const int nt = x >> 4, kt = x & 15; d.hi_off = 0; d.src = w_out; d.src_ld = DM; d.src_col0 = nt * 64; d.k0 = kt * 64; d.dst = WoutT; d.n0 = nt * 64; return; }
        x -= N_OUT;
        if (x < N_GU) { const int e = x >> 9, r = x & 511, nt = r >> 4, kt = r & 15, n0 = nt * 64;
            const int j = n0 >> 8, rr = n0 & 255;
            d.hi_off = 0; d.src = (rr < 128 ? weg : weu) + (size_t)e * DM * DM; d.src_ld = DM; d.src_col0 = j * 128 + (rr & 127); d.k0 = kt * 64; d.dst = WguT + (size_t)e * 2048 * DM; d.n0 = n0; return; }
        x -= N_GU;
        { const int e = x >> 8, r = x & 255, nt = r >> 4, kt = r & 15;
          d.hi_off = 0; d.src = wed + (size_t)e * DM * DM; d.src_ld = DM; d.src_col0 = nt * 64; d.k0 = kt * 64; d.dst = WdT + (size_t)e * DM * DM; d.n0 = nt * 64; }
    };
    if (PART < 2) {
        TrDesc cur, nxt; float4 va[2], vb[2];
        if (bid < NCVT) { tr_desc(bid, cur); tr_load(cur, tid, va); }
        for (int it = bid; it < NCVT; it += G) {
            const bool more = it + G < NCVT;
            if (more) { tr_desc(it + G, nxt); tr_load(nxt, tid, vb); }
            tr_store(smem, cur, tid, va);
            if (more) { cur = nxt; va[0] = vb[0]; va[1] = vb[1]; }
        }
    }
    const int ibeg = (PART == 3) ? N_ADA : 0;
    const int total = (PART == 1) ? 0 : (PART == 2 ? N_ADA : N_ADA + N_HID);
    const int nheavy = (PART == 2) ? G / 4 : (PART == 3 ? G / 2 : 0);
    const int it0 = ibeg + (bid >= nheavy ? bid - nheavy : total), istride = G - nheavy;
    for (int it = it0; it < total; it += istride) {
        int x = it;
        if (x < N_ADA) {
            const int n0 = x * 64;
            float* sv = (float*)smem;
            float* red = sv + 17 * 1024;
            const float* c = PIN(I_C); const float* cc = PIN(I_CCTX);
            for (int idx = tid; idx < 17 * 1024; idx += NTHR) { const int r = idx >> 10, k = idx & 1023; const float v = r < 16 ? c[r * 1024 + k] : cc[k]; sv[idx] = v / (1.0f + expf(-v)); }
            __syncthreads();
            const int w = tid >> 6, lane = tid & 63;
            float acc[17];
#pragma unroll
            for (int r = 0; r < 17; ++r) acc[r] = 0.f;
            const float* wa = PIN(I_WADA) + (size_t)l * DM * 6144 + n0 + lane;
            for (int k0 = 128 * w; k0 < 128 * w + 128; k0 += 32) {
                float wv[32];
#pragma unroll
                for (int u = 0; u < 32; ++u) wv[u] = wa[(size_t)(k0 + u) * 6144];
#pragma unroll
                for (int u = 0; u < 32; ++u)
#pragma unroll
                    for (int r = 0; r < 17; ++r) acc[r] += sv[r * 1024 + k0 + u] * wv[u];
            }
#pragma unroll
            for (int r = 0; r < 17; ++r) red[(w * 17 + r) * 64 + lane] = acc[r];
            __syncthreads();
            float* MOD = (float*)(ws + WS_MOD + (size_t)(l & 1) * MOD_BYTES); const float* ba = PIN(I_BADA) + (size_t)l * 6144;
            for (int idx = tid; idx < 17 * 64; idx += NTHR) { const int r = idx >> 6, j = idx & 63; float s = ba[n0 + j];
#pragma unroll
                for (int ww = 0; ww < 8; ++ww) s += red[(ww * 17 + r) * 64 + j];
                MOD[(size_t)r * 6144 + n0 + j] = s; }
            __syncthreads();
            continue; }
        x -= N_ADA;
        {
            const bool isc = x >= 512; const int L = isc ? 256 : 4096; const int lagbase = (isc ? x - 512 : x) * 8;
            float* zf = (float*)smem;
            float* h1s = zf + 8 * 36;
            const int li = tid >> 6, j = tid & 63, lag = lagbase + li;
            if (j < 33) { float v;
                if (j == 0) v = (float)lag / (float)(L - 1);
                else { const int bi = (j - 1) & 15; const float band = 1e-4f + (float)bi * ((15.0f - 1e-4f) / 15.0f); const float w = 6.283185307179586f * (float)lag / (float)L; const float a = band * w;
                       v = (j <= 16) ? cosf(a) : -sinf(a); }
                zf[li * 36 + j] = v; }
            __syncthreads();
            const float* fw1 = PIN(I_FW1) + (size_t)l * 33 * 64; const float* fb1 = PIN(I_FB1) + l * 64; const float* fr = PIN(I_FREQ) + l * 64;
            const float* fw2 = PIN(I_FW2) + (size_t)l * 64 * 64; const float* fb2 = PIN(I_FB2) + l * 64;
            float a = fb1[j];
#pragma unroll 3
            for (int i = 0; i < 33; ++i) a += zf[li * 36 + i] * fw1[i * 64 + j];
            h1s[li * 64 + j] = sinf(fr[j] * a);
            __syncthreads();
            float a2 = fb2[j];
#pragma unroll 4
            for (int i = 0; i < 64; ++i) a2 += h1s[li * 64 + i] * fw2[i * 64 + j];
            float* H2 = (float*)(ws + (isc ? WS_HID2C : WS_HID2L));
            H2[(size_t)j * L + lag] = sinf(fr[j] * a2);
            __syncthreads();
        }
    }
}

template <int WHICH> struct NmRaw { typedef float4 T; };
template <> struct NmRaw<2> { typedef u32x2 T; };
__device__ __forceinline__ float4 nm_cvt(const float4& v) { return v; }
__device__ __forceinline__ float4 nm_cvt(const u32x2& w) { return make_float4(bflo(w.x), bfhi(w.x), bflo(w.y), bfhi(w.y)); }
template <int WHICH>
__device__ __forceinline__ void phase_norm(const Params& p, int l, unsigned char* smem) {
    unsigned char* ws = launder_ws(p.ws);
    const int tid = my_tid(), lane = tid & 63, wave = tid >> 6;
    float* Wg = (float*)smem;
    for (int idx = tid; idx < 16384; idx += NTHR) { const int k = idx >> 4, j = idx & 15;
        Wg[j * 1024 + k] = (WHICH == 1) ? PIN(I_WIN)[(size_t)l * DM * INW + (size_t)k * INW + 2304 + j] : PIN(I_WROUTER)[(size_t)l * DM * 16 + k * 16 + j]; }
    __syncthreads();
    const float* gain = PIN(WHICH == 1 ? I_N1G : I_N2G) + (size_t)l * DM;
    const float* MOD = (const float*)(ws + WS_MOD + (size_t)(l & 1) * MOD_BYTES);
    bf16_t* U = (bf16_t*)(ws + WS_U);
    float* outv = (float*)(ws + (WHICH == 1 ? WS_GATES : WS_AFF));
    const float* xl = PIN(I_X); const float* xc = PIN(I_CTX);
    const bf16_t* XB = (const bf16_t*)(ws + WS_XB);
    const int rstride = gridDim.x * 8;
    const int nrows = (WHICH == 2 && l == DEPTH - 1) ? NROWL : NROW;
#define NM_LOAD(dst, r) do { if (WHICH == 1) { const float* s_ = (r) < NROWL ? xl + (size_t)(r) * DM : xc + (size_t)((r) - NROWL) * DM; \
            _Pragma("unroll") for (int i = 0; i < 4; ++i) dst[i] = *(const RawT*)(s_ + 256 * i + 4 * lane); } \
        else { const bf16_t* s_ = XB + (size_t)(r) * DM; \
            _Pragma("unroll") for (int i = 0; i < 4; ++i) dst[i] = *(const RawT*)(s_ + 256 * i + 4 * lane); } } while (0)
    typedef typename NmRaw<WHICH>::T RawT;
    const int rbase = 2 * (blockIdx.x * 8 + wave), rstep = 2 * rstride;
    RawT curA[4], curB[4];
    NM_LOAD(curA, rbase); NM_LOAD(curB, rbase + 1);
#pragma unroll 1
    for (int row0 = rbase; row0 < nrows; row0 += rstep) {
        const int rowB = row0 + 1;
        RawT nxtA[4], nxtB[4];
        { const int r2 = row0 + rstep < nrows ? row0 + rstep : row0; NM_LOAD(nxtA, r2); NM_LOAD(nxtB, r2 + 1); }
        const float* mod = MOD + (size_t)(row0 < NROWL ? (row0 >> 12) : 16) * 6144 + (WHICH == 1 ? 0 : 3072);
        float ssA = 0.f, ssB = 0.f;
#pragma unroll
        for (int i = 0; i < 4; ++i) { const float4 a4 = nm_cvt(curA[i]), b4 = nm_cvt(curB[i]);
            ssA += a4.x * a4.x + a4.y * a4.y + a4.z * a4.z + a4.w * a4.w; ssB += b4.x * b4.x + b4.y * b4.y + b4.z * b4.z + b4.w * b4.w; }
        ssA = wave_sum(ssA); ssB = wave_sum(ssB);
        const float invA = rsqrtf(ssA * (1.0f / 1024.0f) + EPSF), invB = rsqrtf(ssB * (1.0f / 1024.0f) + EPSF);
        float partA[16], partB[16];
#pragma unroll
        for (int j = 0; j < 16; ++j) { partA[j] = 0.f; partB[j] = 0.f; }
#pragma unroll
        for (int i = 0; i < 4; ++i) { const int k = 256 * i + 4 * lane;
            float4 g = *(const float4*)(gain + k); const float4 sh = *(const float4*)(mod + k), sc = *(const float4*)(mod + 1024 + k);
            g.x *= 1.f + sc.x; g.y *= 1.f + sc.y; g.z *= 1.f + sc.z; g.w *= 1.f + sc.w;
            const float4 va = nm_cvt(curA[i]), vb = nm_cvt(curB[i]);
            float4 ha, hb;
            ha.x = va.x * invA * g.x + sh.x; ha.y = va.y * invA * g.y + sh.y; ha.z = va.z * invA * g.z + sh.z; ha.w = va.w * invA * g.w + sh.w;
            hb.x = vb.x * invB * g.x + sh.x; hb.y = vb.y * invB * g.y + sh.y; hb.z = vb.z * invB * g.z + sh.z; hb.w = vb.w * invB * g.w + sh.w;
            { u32x2 w; w.x = pack_bf16(ha.x, ha.y); w.y = pack_bf16(ha.z, ha.w); *(u32x2*)(U + (size_t)row0 * DM + k) = w; }
            { u32x2 w; w.x = pack_bf16(hb.x, hb.y); w.y = pack_bf16(hb.z, hb.w); *(u32x2*)(U + (size_t)rowB * DM + k) = w; }
#pragma unroll
            for (int j = 0; j < 8; ++j) { const float4 wv = *(const float4*)(Wg + j * 1024 + k);
                partA[j] += ha.x * wv.x + ha.y * wv.y + ha.z * wv.z + ha.w * wv.w; partB[j] += hb.x * wv.x + hb.y * wv.y + hb.z * wv.z + hb.w * wv.w; }
            asm volatile("" ::: "memory");
#pragma unroll
            for (int j = 8; j < 16; ++j) { const float4 wv = *(const float4*)(Wg + j * 1024 + k);
                partA[j] += ha.x * wv.x + ha.y * wv.y + ha.z * wv.z + ha.w * wv.w; partB[j] += hb.x * wv.x + hb.y * wv.y + hb.z * wv.z + hb.w * wv.w; }
            asm volatile("" ::: "memory"); }
#pragma unroll
        for (int i = 0; i < 4; ++i) { curA[i] = nxtA[i]; curB[i] = nxtB[i]; }
        const int jx = ((lane >> 5) & 1) * 8 + ((lane >> 4) & 1) * 4 + ((lane >> 3) & 1) * 2 + ((lane >> 2) & 1);
        float vA = reduce16_transpose(partA, lane), vB = reduce16_transpose(partB, lane);
        if (WHICH == 2) { const float mxA = wave_max(vA), mxB = wave_max(vB); const float eA = expf(vA - mxA), eB = expf(vB - mxB);
            const float sA = wave_sum(eA) * 0.25f, sB = wave_sum(eB) * 0.25f; vA = eA / sA; vB = eB / sB; }
        if ((lane & 3) == 0) { outv[(size_t)row0 * 16 + jx] = vA; outv[(size_t)rowB * 16 + jx] = vB; }
    }
    __syncthreads();
}

__device__ __forceinline__ void phase_prep(const Params& p, int l, unsigned char* smem) {
    unsigned char* ws = launder_ws(p.ws);
    const int tid = my_tid(), lane = tid & 63, wave = tid >> 6;
    float2* ropeA = (float2*)smem;
    float2* ropeD = ropeA + 64 * 16;
    for (int idx = tid; idx < 64 * 16; idx += NTHR) { const int pos = idx >> 4, f = idx & 15; const float inv = powf(10000.0f, -(float)f / 16.0f); float s, c; sincosf((float)pos * inv, &s, &c); ropeA[idx] = make_float2(c, s); }
    for (int idx = tid; idx < 64 * 8; idx += NTHR) { const int pos = idx >> 3, f = idx & 7; const float inv = powf(10000.0f, -(float)f / 8.0f); float s, c; sincosf((float)pos * inv, &s, &c); ropeD[idx] = make_float2(c, s); }
    __syncthreads();
    bf16_t* P = (bf16_t*)(ws + WS_P);
    const float* aqn = PIN(I_AQN) + l * 64; const float* akn = PIN(I_AKN) + l * 64;
    const float* dqn = PIN(I_DQN) + l * 32; const float* dkn = PIN(I_DKN) + l * 32;
    const int rstride = gridDim.x * 8;
    const int vecA = min(lane >> 3, 5), chA = lane & 7;
    u32x4 rawA;
    { const int row = blockIdx.x * 8 + wave; const bf16_t* pr = P + (size_t)row * PW; rawA = *(const u32x4*)(pr + vecA * 64 + chA * 8); }
    for (int row = blockIdx.x * 8 + wave; row < NROW; row += rstride) {
        const bool lat = row < NROWL; const int t = row & 4095; const int prow = t >> 6, pcol = t & 63;
        bf16_t* pr = P + (size_t)row * PW;
        u32x4 nxtA;
        { const int r2 = row + rstride < NROW ? row + rstride : row; const bf16_t* p2 = P + (size_t)r2 * PW; nxtA = *(const u32x4*)(p2 + vecA * 64 + chA * 8); }
        {
            const int vec = vecA, ch = chA; const bool act = lane < 48;
            bf16_t* ptr = pr + vec * 64 + ch * 8;
            const u32x4 raw = rawA;
            float x[8]; x[0] = bflo(raw.x); x[1] = bfhi(raw.x); x[2] = bflo(raw.y); x[3] = bfhi(raw.y); x[4] = bflo(raw.z); x[5] = bfhi(raw.z); x[6] = bflo(raw.w); x[7] = bfhi(raw.w);
            float ss = 0.f;
#pragma unroll
            for (int i = 0; i < 8; ++i) ss += x[i] * x[i];
            ss += __shfl_xor(ss, 1); ss += __shfl_xor(ss, 2); ss += __shfl_xor(ss, 4);
            const float inv = rsqrtf(ss * (1.0f / 64.0f) + EPSF);
            const float* gn = (vec < 4 ? aqn : akn) + ch * 8;
            const float qs = vec < 4 ? 0.125f * LOG2E : 1.0f;
            const int axis = ch >> 2, half = (ch >> 1) & 1; const int pos = axis == 0 ? prow : pcol;
            float o[8];
#pragma unroll
            for (int i = 0; i < 8; ++i) { const float y = x[i] * inv * gn[i]; const float pr2 = __shfl_xor(y, 2);
                if (lat) { const float2 cs = ropeA[pos * 16 + 8 * (ch & 1) + i]; o[i] = (half == 0 ? y * cs.x - pr2 * cs.y : y * cs.x + pr2 * cs.y) * qs; } else o[i] = y * qs; }
            if (act) { u32x4 w; w.x = pack_bf16(o[0], o[1]); w.y = pack_bf16(o[2], o[3]); w.z = pack_bf16(o[4], o[5]); w.w = pack_bf16(o[6], o[7]); *(u32x4*)ptr = w; }
        }
        rawA = nxtA;
    }
    __syncthreads();
}
__device__ __forceinline__ int block_excl_scan(int v, int* sbuf  , int& total) {
    const int tid = my_tid(), lane = tid & 63, wave = tid >> 6;
    int inc = v;
#pragma unroll
    for (int o = 1; o < 64; o <<= 1) { const int n = __shfl_up(inc, o); if (lane >= o) inc += n; }
    __syncthreads();
    if (lane == 63) sbuf[wave] = inc;
    __syncthreads();
    int pre = 0, tot = 0;
#pragma unroll
    for (int w = 0; w < 8; ++w) { const int s = sbuf[w]; if (w < wave) pre += s; tot += s; }
    total = tot;
    return pre + inc - v;
}

__device__ __forceinline__ void phase_topk(const Params& p, int l, unsigned char* smem) {
    unsigned char* ws = launder_ws(p.ws);
    const int tid = my_tid();
    unsigned* keys = (unsigned*)smem;
    int* hist = (int*)(keys + 4096);
    int* sb = hist + 256;
    int* ctl = sb + 16;
    const float* AFF = (const float*)(ws + WS_AFF);
    int* SROW = (int*)(ws + WS_SROW); float* SGATE = (float*)(ws + WS_SGATE); int* INV = (int*)(ws + WS_INV);
    const int nlists = (l == DEPTH - 1) ? 256 : 512;
    for (int it = blockIdx.x; it < nlists; it += gridDim.x) {
        const int kind = it >> 8, b = (it >> 4) & 15, e = it & 15;
        const int N = kind ? 256 : 4096, K = kind ? CAPC : CAPL;
        const int rowbase = kind ? NROWL + b * 256 : b * 4096;
        const int slotbase = e * SLOTS_E + (kind ? 8192 + b * CAPC : b * CAPL);
        for (int i = tid; i < N; i += NTHR) keys[i] = __float_as_uint(AFF[(size_t)(rowbase + i) * 16 + e]);
        unsigned prefix = 0, mask = 0; int need = K;
        for (int pass = 3; pass >= 0; --pass) {
            const int shift = 8 * pass;
            if (tid < 256) hist[tid] = 0;
            __syncthreads();
            for (int i = tid; i < N; i += NTHR) { const unsigned k = keys[i]; if ((k & mask) == prefix) atomicAdd(&hist[(k >> shift) & 255], 1); }
            __syncthreads();
            if (tid < 64) {
                const int b0 = 255 - 4 * tid; const int h0 = hist[b0], h1 = hist[b0 - 1], h2 = hist[b0 - 2], h3 = hist[b0 - 3];
                const int tot4 = h0 + h1 + h2 + h3; int inc = tot4;
#pragma unroll
                for (int o = 1; o < 64; o <<= 1) { const int n = __shfl_up(inc, o); if (tid >= o) inc += n; }
                const int exc = inc - tot4;
                const bool hit = (exc < need) && (inc >= need);
                if (hit) { int cum = exc, d = b0;
                    if (cum + h0 >= need) d = b0; else { cum += h0; if (cum + h1 >= need) d = b0 - 1; else { cum += h1; if (cum + h2 >= need) d = b0 - 2; else { cum += h2; d = b0 - 3; } } }
                    ctl[0] = d; ctl[1] = need - cum; } }
            __syncthreads();
            prefix |= (unsigned)ctl[0] << shift; mask |= 255u << shift; need = ctl[1];
            __syncthreads();
        }
        const unsigned T = prefix;
        int cg = 0, ce = 0; unsigned k8[8];
#pragma unroll
        for (int j = 0; j < 8; ++j) { const int i = tid * 8 + j; const unsigned k = (i < N) ? keys[i] : 0u; k8[j] = k; cg += (i < N && k > T) ? 1 : 0; ce += (i < N && k == T) ? 1 : 0; }
        int totg, tote;
        int pg = block_excl_scan(cg, sb, totg);
        int pe = block_excl_scan(ce, sb, tote);
#pragma unroll
        for (int j = 0; j < 8; ++j) { const int i = tid * 8 + j; if (i < N) { const unsigned k = k8[j]; int pos = -1;
                if (k > T) pos = pg++; else if (k == T) { if (pe < need) pos = totg + pe; ++pe; }
                if (pos >= 0) { const int s = slotbase + pos; const int row = rowbase + i; SROW[s] = row; SGATE[s] = __uint_as_float(k); INV[(size_t)row * 16 + e] = s; } } }
        __syncthreads();
    }
}

__device__ __forceinline__ void phase_gather(const Params& p) {
    unsigned char* ws = launder_ws(p.ws);
    const int lane = my_tid() & 63, wave = my_tid() >> 6;
    const int* SROW = (const int*)(ws + WS_SROW);
    const bf16_t* U = (const bf16_t*)(ws + WS_U); bf16_t* XE = (bf16_t*)(ws + WS_XE);
    for (int s = blockIdx.x * 8 + wave; s < NSLOT; s += gridDim.x * 8) {
        const int row = SROW[s];
        const u32x4* src = (const u32x4*)(U + (size_t)row * DM); u32x4* dst = (u32x4*)(XE + (size_t)s * DM);
        const u32x4 a = src[lane], b = src[64 + lane];
        dst[lane] = a; dst[64 + lane] = b;
    }
}

template <bool NEXT>
__device__ __forceinline__ void phase_combine(const Params& p, int l, unsigned char* smem) {
    unsigned char* ws = launder_ws(p.ws);
    const int tid = my_tid(), lane = tid & 63, wave = tid >> 6;
    int* INV = (int*)(ws + WS_INV);
    const bf16_t* YS = (const bf16_t*)(ws + WS_XE);
    const float* MODc = (const float*)(ws + WS_MOD + (size_t)(l & 1) * MOD_BYTES);
    const float* MODn = (const float*)(ws + WS_MOD + (size_t)((l + 1) & 1) * MOD_BYTES);
    float* Wg = (float*)smem;
    bf16_t* U = (bf16_t*)(ws + WS_U); float* GT = (float*)(ws + WS_GATES);
    const float* gain = PIN(I_N1G) + (size_t)(NEXT ? l + 1 : 0) * DM;
    if (NEXT) { for (int idx = tid; idx < 16384; idx += NTHR) { const int k = idx >> 4, j = idx & 15; Wg[j * 1024 + k] = PIN(I_WIN)[(size_t)(l + 1) * DM * INW + (size_t)k * INW + 2304 + j]; }
        __syncthreads(); }
    const int rstride = gridDim.x * 8;
    bf16_t* XB = (bf16_t*)(ws + WS_XB); float* outp = POUT();
    int myinv; u32x2 xc4[4];
    { const int row = blockIdx.x * 8 + wave; myinv = INV[(size_t)row * 16 + (lane & 15)];
#pragma unroll
      for (int i = 0; i < 4; ++i) xc4[i] = *(const u32x2*)(XB + (size_t)row * DM + 256 * i + 4 * lane); }
    const int nrows = NEXT ? NROW : NROWL;
    for (int row = blockIdx.x * 8 + wave; row < nrows; row += rstride) {
        int ninv; u32x2 xn4[4];
        { const int r2 = row + rstride < nrows ? row + rstride : row; ninv = INV[(size_t)r2 * 16 + (lane & 15)];
#pragma unroll
          for (int i = 0; i < 4; ++i) xn4[i] = *(const u32x2*)(XB + (size_t)r2 * DM + 256 * i + 4 * lane); }
        float acc[16];
#pragma unroll
        for (int j = 0; j < 16; ++j) acc[j] = 0.f;
        {
            unsigned msk = (unsigned)(__ballot(myinv >= 0 && lane < 16)) & 0xffffu;
            if (msk) {
                const int e0 = __ffs(msk) - 1; msk &= msk - 1;
                const int s0 = __shfl(myinv, e0);
                const bool two = msk != 0u; int s1 = s0;
                if (two) { const int e1 = __ffs(msk) - 1; msk &= msk - 1; s1 = __shfl(myinv, e1); }
                u32x2 w0[4], w1[4];
#pragma unroll
                for (int i = 0; i < 4; ++i) { w0[i] = *(const u32x2*)(YS + (size_t)s0 * DM + 256 * i + 4 * lane); w1[i] = *(const u32x2*)(YS + (size_t)s1 * DM + 256 * i + 4 * lane); }
                const float f1 = two ? 1.0f : 0.0f;
#pragma unroll
                for (int i = 0; i < 4; ++i) { acc[4 * i + 0] = bflo(w0[i].x) + f1 * bflo(w1[i].x); acc[4 * i + 1] = bfhi(w0[i].x) + f1 * bfhi(w1[i].x);
                    acc[4 * i + 2] = bflo(w0[i].y) + f1 * bflo(w1[i].y); acc[4 * i + 3] = bfhi(w0[i].y) + f1 * bfhi(w1[i].y); }
                while (msk) { const int e = __ffs(msk) - 1; msk &= msk - 1; const int s = __shfl(myinv, e);
#pragma unroll
                    for (int i = 0; i < 4; ++i) { const u32x2 w = *(const u32x2*)(YS + (size_t)s * DM + 256 * i + 4 * lane);
                        acc[4 * i + 0] += bflo(w.x); acc[4 * i + 1] += bfhi(w.x); acc[4 * i + 2] += bflo(w.y); acc[4 * i + 3] += bfhi(w.y); } }
            }
        }
        if (lane < 16) INV[(size_t)row * 16 + lane] = -1;
        const int mrow = row < NROWL ? (row >> 12) : 16;
        const float* gt = MODc + (size_t)mrow * 6144 + 5120;
        float ss = 0.f;
#pragma unroll
        for (int i = 0; i < 4; ++i) { const int k = 256 * i + 4 * lane;
            float4 xv = make_float4(bflo(xc4[i].x), bfhi(xc4[i].x), bflo(xc4[i].y), bfhi(xc4[i].y)); const float4 g = *(const float4*)(gt + k);
            xv.x += g.x * acc[4 * i + 0]; xv.y += g.y * acc[4 * i + 1]; xv.z += g.z * acc[4 * i + 2]; xv.w += g.w * acc[4 * i + 3];
            if (NEXT) { u32x2 w; w.x = pack_bf16(xv.x, xv.y); w.y = pack_bf16(xv.z, xv.w); *(u32x2*)(XB + (size_t)row * DM + k) = w; }
            else *(float4*)(outp + (size_t)row * DM + k) = xv;
            acc[4 * i + 0] = xv.x; acc[4 * i + 1] = xv.y; acc[4 * i + 2] = xv.z; acc[4 * i + 3] = xv.w;
            ss += xv.x * xv.x + xv.y * xv.y + xv.z * xv.z + xv.w * xv.w; }
        myinv = ninv;
#pragma unroll
        for (int i = 0; i < 4; ++i) xc4[i] = xn4[i];
        if (NEXT) {
            ss = wave_sum(ss);
            const float inv = rsqrtf(ss * (1.0f / 1024.0f) + EPSF);
            const float* mod = MODn + (size_t)mrow * 6144;
            float part[16];
#pragma unroll
            for (int j = 0; j < 16; ++j) part[j] = 0.f;
#pragma unroll
            for (int i = 0; i < 4; ++i) { const int k = 256 * i + 4 * lane;
                const float4 g = *(const float4*)(gain + k), sh = *(const float4*)(mod + k), sc = *(const float4*)(mod + 1024 + k);
                float4 h; h.x = acc[4 * i + 0] * inv * g.x * (1.f + sc.x) + sh.x; h.y = acc[4 * i + 1] * inv * g.y * (1.f + sc.y) + sh.y; h.z = acc[4 * i + 2] * inv * g.z * (1.f + sc.z) + sh.z; h.w = acc[4 * i + 3] * inv * g.w * (1.f + sc.w) + sh.w;
                u32x2 w; w.x = pack_bf16(h.x, h.y); w.y = pack_bf16(h.z, h.w);
                *(u32x2*)(U + (size_t)row * DM + k) = w;
#pragma unroll
                for (int j = 0; j < 16; ++j) { const float4 wv = *(const float4*)(Wg + j * 1024 + k); part[j] += h.x * wv.x + h.y * wv.y + h.z * wv.z + h.w * wv.w; }
                asm volatile("" ::: "memory"); }
            const float v1 = reduce16_transpose(part, lane);
            const int jx = ((lane >> 5) & 1) * 8 + ((lane >> 4) & 1) * 4 + ((lane >> 3) & 1) * 2 + ((lane >> 2) & 1);
            if ((lane & 3) == 0) GT[(size_t)row * 16 + jx] = v1;
        }
    }
    __syncthreads();
}
struct AttnItem { int qrow0, qpos0, qcol, kcol, vcol, ycol; int nt0, krow0, kpos0, masked; int nt1, krow1; float M2, sink2, lam, postscale; const float* subgain; };
#define FA_LD 72

template <int NC>
__device__ __forceinline__ void fattn_item(const bf16_t* __restrict__ P, bf16_t* __restrict__ Y, const AttnItem& it, unsigned char* smem) {
    constexpr int KS = (NC == 2) ? 2 : 4;
    const int tid = my_tid(), lane = tid & 63, w = tid >> 6, h = lane >> 5, lq = lane & 31;
    bf16_t* Kb = (bf16_t*)smem;
    bf16_t* Vb = Kb + 2 * 64 * FA_LD;
    const LAS unsigned char* vlds = (const LAS unsigned char*)(smem) + 2 * 64 * FA_LD * 2;
    bf16x8 qf[NC][KS];
    { const bf16_t* qp = P + (size_t)(it.qrow0 + 32 * w + lq) * PW + it.qcol + 8 * h;
#pragma unroll
      for (int c = 0; c < NC; ++c)
#pragma unroll
          for (int s = 0; s < KS; ++s) qf[c][s] = *(const bf16x8*)(qp + 32 * c + 16 * s); }
    f32x16 O[NC][2]; float lsum[NC];
#pragma unroll
    for (int c = 0; c < NC; ++c) { lsum[c] = 0.f;
#pragma unroll
        for (int dt = 0; dt < 2; ++dt)
#pragma unroll
            for (int r = 0; r < 16; ++r) O[c][dt][r] = 0.f; }
    const int ntot = it.nt0 + it.nt1;
    const int ldkey = tid >> 3, ldch = tid & 7;
    const int vlane = ((4 * h + ((lane & 15) >> 2)) * FA_LD + 16 * ((lane >> 4) & 1) + 4 * (lane & 3)) * 2;
    u32x4 kreg, vreg;
    { const int krow = it.nt0 > 0 ? it.krow0 : it.krow1; const bf16_t* kp = P + (size_t)(krow + ldkey) * PW;
      kreg = *(const u32x4*)(kp + it.kcol + ldch * 8); vreg = *(const u32x4*)(kp + it.vcol + ldch * 8); }
    __syncthreads();
    *(u32x4*)(Kb + ldkey * FA_LD + ldch * 8) = kreg; *(u32x4*)(Vb + ldkey * FA_LD + ldch * 8) = vreg;
    __syncthreads();
    const int qpos = it.qpos0 + 32 * w + lq;
    for (int kt = 0; kt < ntot; ++kt) {
        const int buf = kt & 1;
        int kpos = 0; bool msk = false;
        if (kt < it.nt0) { kpos = it.kpos0 + 64 * kt; msk = it.masked != 0; }
        if (kt + 1 < ntot) { const int k2 = kt + 1; const int krow = k2 < it.nt0 ? it.krow0 + 64 * k2 : it.krow1 + 64 * (k2 - it.nt0);
            const bf16_t* kp = P + (size_t)(krow + ldkey) * PW; kreg = *(const u32x4*)(kp + it.kcol + ldch * 8); vreg = *(const u32x4*)(kp + it.vcol + ldch * 8); }
        bool skip = false;
        if (msk) { const int q0 = it.qpos0 + 32 * w; skip = (kpos > q0 + 31 + 128) || (kpos + 63 < q0 - 128); }
        if (!skip) {
            const bf16_t* kb = Kb + buf * 64 * FA_LD; const LAS unsigned char* vb = vlds + buf * 64 * FA_LD * 2 + vlane;
#pragma unroll
            for (int sub = 0; sub < 2; ++sub) {
                unsigned pk[NC][2][4];
#pragma unroll
                for (int c = 0; c < NC; ++c) {
                    f32x16 S;
#pragma unroll
                    for (int r = 0; r < 16; ++r) S[r] = -it.M2;
#pragma unroll
                    for (int s = 0; s < KS; ++s) { const bf16x8 a = *(const bf16x8*)(kb + (32 * sub + lq) * FA_LD + 32 * c + 16 * s + 8 * h);
                        S = __builtin_amdgcn_mfma_f32_32x32x16_bf16(a, qf[c][s], S, 0, 0, 0); }
                    float pv[16];
#pragma unroll
                    for (int r = 0; r < 16; ++r) { pv[r] = fast_exp2(S[r]);
                        if (NC == 1) { if (msk) { const int d = qpos - (kpos + 32 * sub + CROW(r, lane)); if (d > 128 || d < -128) pv[r] = 0.f; } } }
#pragma unroll
                    for (int r = 0; r < 16; ++r) lsum[c] += pv[r];
#pragma unroll
                    for (int s = 0; s < 2; ++s)
#pragma unroll
                        for (int jj = 0; jj < 4; ++jj) pk[c][s][jj] = pg8::cvt_pk_bf16(pv[8 * s + 2 * jj], pv[8 * s + 2 * jj + 1]);
                }
#pragma unroll
                for (int s = 0; s < 2; ++s)
#pragma unroll
                    for (int dt = 0; dt < 2; ++dt) {
                        const s16x4 lo = tr_read(vb + (32 * sub + 16 * s) * FA_LD * 2 + 64 * dt), hi = tr_read(vb + (32 * sub + 16 * s + 8) * FA_LD * 2 + 64 * dt);
                        const bf16x8 a = __builtin_shufflevector(lo, hi, 0, 1, 2, 3, 4, 5, 6, 7);
#pragma unroll
                        for (int c = 0; c < NC; ++c) { u32x4 bw; bw.x = pk[c][s][0]; bw.y = pk[c][s][1]; bw.z = pk[c][s][2]; bw.w = pk[c][s][3];
                            O[c][dt] = __builtin_amdgcn_mfma_f32_32x32x16_bf16(a, __builtin_bit_cast(bf16x8, bw), O[c][dt], 0, 0, 0); }
                    }
            }
        }
        if (kt + 1 < ntot) { bf16_t* kd = Kb + (buf ^ 1) * 64 * FA_LD; bf16_t* vd = Vb + (buf ^ 1) * 64 * FA_LD;
            *(u32x4*)(kd + ldkey * FA_LD + ldch * 8) = kreg; *(u32x4*)(vd + ldkey * FA_LD + ldch * 8) = vreg; }
        __syncthreads();
    }
    float linv[NC];
#pragma unroll
    for (int c = 0; c < NC; ++c) { const float l = lsum[c] + __shfl_xor(lsum[c], 32); linv[c] = (NC == 1) ? 1.0f / (l + fast_exp2(it.sink2 - it.M2)) : 1.0f / l; }
    bf16_t* yp = Y + (size_t)(it.qrow0 + 32 * w + lq) * DM + it.ycol + 4 * h;
    if (NC == 1) {
#pragma unroll
        for (int dt = 0; dt < 2; ++dt)
#pragma unroll
            for (int g = 0; g < 4; ++g) { u32x2 wv; wv.x = pg8::cvt_pk_bf16(O[0][dt][4 * g] * linv[0], O[0][dt][4 * g + 1] * linv[0]); wv.y = pg8::cvt_pk_bf16(O[0][dt][4 * g + 2] * linv[0], O[0][dt][4 * g + 3] * linv[0]);
                *(u32x2*)(yp + 32 * dt + 8 * g) = wv; }
    } else {
        const float a1 = it.lam * linv[NC - 1];
        float ss = 0.f;
#pragma unroll
        for (int dt = 0; dt < 2; ++dt)
#pragma unroll
            for (int r = 0; r < 16; ++r) { const float v = O[0][dt][r] * linv[0] - a1 * O[NC - 1][dt][r]; O[0][dt][r] = v; ss += v * v; }
        ss += __shfl_xor(ss, 32);
        const float rinv = rsqrtf(ss * (1.0f / 64.0f) + EPSF) * it.postscale;
        const float* sg = it.subgain + 4 * h;
#pragma unroll
        for (int dt = 0; dt < 2; ++dt)
#pragma unroll
            for (int g = 0; g < 4; ++g) { const float4 gg = *(const float4*)(sg + 32 * dt + 8 * g);
                u32x2 wv; wv.x = pg8::cvt_pk_bf16(O[0][dt][4 * g] * rinv * gg.x, O[0][dt][4 * g + 1] * rinv * gg.y); wv.y = pg8::cvt_pk_bf16(O[0][dt][4 * g + 2] * rinv * gg.z, O[0][dt][4 * g + 3] * rinv * gg.w);
                *(u32x2*)(yp + 32 * dt + 8 * g) = wv; }
    }
}


#define FD_RING 4
__device__ __forceinline__ void fattn_d_item(const bf16_t* __restrict__ P, bf16_t* __restrict__ Y, const AttnItem& it, unsigned char* smem) {
    const int tid = my_tid(), lane = tid & 63, w = tid >> 6, h = lane >> 5, lq = lane & 31;
    bf16_t* ring = (bf16_t*)smem;
    const LAS unsigned char* rlds = (const LAS unsigned char*)smem;
    constexpr int TB = 64 * FA_LD * 2;
    bf16x8 qf[2][2];
    { const bf16_t* qp = P + (size_t)(it.qrow0 + 32 * w + lq) * PW + it.qcol + 8 * h;
#pragma unroll
      for (int c = 0; c < 2; ++c)
#pragma unroll
          for (int s = 0; s < 2; ++s) qf[c][s] = *(const bf16x8*)(qp + 32 * c + 16 * s); }
    f32x16 O[2][2]; float lsum[2] = {0.f, 0.f};
#pragma unroll
    for (int c = 0; c < 2; ++c)
#pragma unroll
        for (int dt = 0; dt < 2; ++dt)
#pragma unroll
            for (int r = 0; r < 16; ++r) O[c][dt][r] = 0.f;
    const int ntot = it.nt0 + it.nt1;
    const int ldkey = tid >> 3, ldch = tid & 7;
    const int vlane = ((4 * h + ((lane & 15) >> 2)) * FA_LD + 16 * ((lane >> 4) & 1) + 4 * (lane & 3)) * 2;
    const int klane = (lq * FA_LD + 8 * h) * 2;
#define FD_TROW(k) ((k) < it.nt0 ? it.krow0 + 64 * (k) : it.krow1 + 64 * ((k) - it.nt0))
#define FD_GLOAD(k) do { const bf16_t* kp_ = P + (size_t)(FD_TROW(k) + ldkey) * PW; kreg = *(const u32x4*)(kp_ + it.kcol + ldch * 8); vreg = *(const u32x4*)(kp_ + it.vcol + ldch * 8); } while (0)
#define FD_LSTORE(k) do { bf16_t* d_ = ring + (size_t)((k) & (FD_RING - 1)) * 2 * 64 * FA_LD + ldkey * FA_LD + ldch * 8; *(u32x4*)d_ = kreg; *(u32x4*)(d_ + 64 * FA_LD) = vreg; } while (0)
    u32x4 kreg, vreg;
    __syncthreads();
    FD_GLOAD(0); FD_LSTORE(0);
    if (ntot > 1) { FD_GLOAD(1); FD_LSTORE(1); }
    __syncthreads();
    f32x16 zero16;
#pragma unroll
    for (int r = 0; r < 16; ++r) zero16[r] = 0.f;
    f32x16 SS[2];
    { const LAS unsigned char* kb = rlds + klane;
      SS[0] = __builtin_amdgcn_mfma_f32_32x32x16_bf16(*(const LAS bf16x8*)(kb), qf[0][0], zero16, 0, 0, 0);
      SS[0] = __builtin_amdgcn_mfma_f32_32x32x16_bf16(*(const LAS bf16x8*)(kb + 32), qf[0][1], SS[0], 0, 0, 0); }
    unsigned pkp[2][4];
#pragma unroll
    for (int s = 0; s < 2; ++s)
#pragma unroll
        for (int j = 0; j < 4; ++j) pkp[s][j] = 0u;
    for (int kt = 0; kt < ntot; ++kt) {
        if (kt + 2 < ntot) FD_GLOAD(kt + 2);
        const LAS unsigned char* cb = rlds + (size_t)(kt & (FD_RING - 1)) * 2 * TB;
        const LAS unsigned char* nb = rlds + (size_t)((kt + 1) & (FD_RING - 1)) * 2 * TB;
        const LAS unsigned char* pb = rlds + (size_t)((kt + FD_RING - 1) & (FD_RING - 1)) * 2 * TB;
#pragma unroll
        for (int u = 0; u < 4; ++u) {
            const int c = u & 1;
            const int nsub = ((u + 1) & 3) >> 1, nc = (u + 1) & 1;
            const int psub = ((u + 3) & 3) >> 1, pc = (u + 3) & 1;
            const LAS unsigned char* ka = ((u < 3) ? cb : nb) + klane + (32 * nsub) * FA_LD * 2 + 64 * nc;
            const LAS unsigned char* va = ((u > 0) ? cb : pb) + TB + vlane + (32 * psub) * FA_LD * 2;
            const bf16x8 kf0 = *(const LAS bf16x8*)(ka), kf1 = *(const LAS bf16x8*)(ka + 32);
            bf16x8 vf[2][2];
#pragma unroll
            for (int s = 0; s < 2; ++s)
#pragma unroll
                for (int dt = 0; dt < 2; ++dt) { const s16x4 lo = tr_read(va + (16 * s) * FA_LD * 2 + 64 * dt), hi = tr_read(va + (16 * s + 8) * FA_LD * 2 + 64 * dt);
                    vf[s][dt] = __builtin_shufflevector(lo, hi, 0, 1, 2, 3, 4, 5, 6, 7); }
            __builtin_amdgcn_sched_barrier(0);
            f32x16& Sc = SS[u & 1]; f32x16& Sn = SS[(u + 1) & 1];
            unsigned pkc[2][4];
#pragma unroll
            for (int s = 0; s < 2; ++s) {
                float pv[8];
#pragma unroll
                for (int j = 0; j < 8; ++j) pv[j] = fast_exp2(Sc[8 * s + j]);
                lsum[c] += ((pv[0] + pv[1]) + (pv[2] + pv[3])) + ((pv[4] + pv[5]) + (pv[6] + pv[7]));
#pragma unroll
                for (int jj = 0; jj < 4; ++jj) pkc[s][jj] = pg8::cvt_pk_bf16(pv[2 * jj], pv[2 * jj + 1]);
            }
            if ((u < 3) || (kt + 1 < ntot)) {
                Sn = __builtin_amdgcn_mfma_f32_32x32x16_bf16(kf0, qf[nc][0], zero16, 0, 0, 0);
                Sn = __builtin_amdgcn_mfma_f32_32x32x16_bf16(kf1, qf[nc][1], Sn, 0, 0, 0); }
            if ((u > 0) || (kt > 0)) {
#pragma unroll
                for (int s = 0; s < 2; ++s) { u32x4 bw; bw.x = pkp[s][0]; bw.y = pkp[s][1]; bw.z = pkp[s][2]; bw.w = pkp[s][3];
#pragma unroll
                    for (int dt = 0; dt < 2; ++dt) O[pc][dt] = __builtin_amdgcn_mfma_f32_32x32x16_bf16(vf[s][dt], __builtin_bit_cast(bf16x8, bw), O[pc][dt], 0, 0, 0); } }
            __builtin_amdgcn_sched_group_barrier(0x2, 5, 0);
#pragma unroll
            for (int g = 0; g < 6; ++g) { __builtin_amdgcn_sched_group_barrier(0x8, 1, 0); __builtin_amdgcn_sched_group_barrier(0x2, 5, 0); }
            __builtin_amdgcn_sched_barrier(0);
#pragma unroll
            for (int s = 0; s < 2; ++s)
#pragma unroll
                for (int j = 0; j < 4; ++j) pkp[s][j] = pkc[s][j];
        }
        if (kt + 2 < ntot) FD_LSTORE(kt + 2);
        __syncthreads();
    }
    { const LAS unsigned char* va = rlds + (size_t)((ntot - 1) & (FD_RING - 1)) * 2 * TB + TB + vlane + 32 * FA_LD * 2;
#pragma unroll
      for (int s = 0; s < 2; ++s) { u32x4 bw; bw.x = pkp[s][0]; bw.y = pkp[s][1]; bw.z = pkp[s][2]; bw.w = pkp[s][3];
#pragma unroll
          for (int dt = 0; dt < 2; ++dt) {
              const s16x4 lo = tr_read(va + (16 * s) * FA_LD * 2 + 64 * dt), hi = tr_read(va + (16 * s + 8) * FA_LD * 2 + 64 * dt);
              const bf16x8 a = __builtin_shufflevector(lo, hi, 0, 1, 2, 3, 4, 5, 6, 7);
              O[1][dt] = __builtin_amdgcn_mfma_f32_32x32x16_bf16(a, __builtin_bit_cast(bf16x8, bw), O[1][dt], 0, 0, 0); } } }
#undef FD_TROW
#undef FD_GLOAD
#undef FD_LSTORE
    float linv[2];
#pragma unroll
    for (int c = 0; c < 2; ++c) { const float l = lsum[c] + __shfl_xor(lsum[c], 32); linv[c] = 1.0f / l; }
    bf16_t* yp = Y + (size_t)(it.qrow0 + 32 * w + lq) * DM + it.ycol + 4 * h;
    const float a1 = it.lam * linv[1];
    float ss = 0.f;
#pragma unroll
    for (int dt = 0; dt < 2; ++dt)
#pragma unroll
        for (int r = 0; r < 16; ++r) { const float v = O[0][dt][r] * linv[0] - a1 * O[1][dt][r]; O[0][dt][r] = v; ss += v * v; }
    ss += __shfl_xor(ss, 32);
    const float rinv = rsqrtf(ss * (1.0f / 64.0f) + EPSF) * it.postscale;
    const float* sg = it.subgain + 4 * h;
#pragma unroll
    for (int dt = 0; dt < 2; ++dt)
#pragma unroll
        for (int g = 0; g < 4; ++g) { const float4 gg = *(const float4*)(sg + 32 * dt + 8 * g);
            u32x2 wv; wv.x = pg8::cvt_pk_bf16(O[0][dt][4 * g] * rinv * gg.x, O[0][dt][4 * g + 1] * rinv * gg.y); wv.y = pg8::cvt_pk_bf16(O[0][dt][4 * g + 2] * rinv * gg.z, O[0][dt][4 * g + 3] * rinv * gg.w);
            *(u32x2*)(yp + 32 * dt + 8 * g) = wv; }
}

__device__ __forceinline__ float max_abs_vec(const float* g, int n) { float m = 0.f; for (int i = 0; i < n; ++i) m = fmaxf(m, fabsf(g[i])); return m; }

__device__ __forceinline__ int attn_item_remap(int x0, int G) {
    if (G != 256 || x0 >= 1024) return x0;
    const int i = x0 >> 8, bid = x0 & 255, xcd = bid & 7, slot = bid >> 3;
    const int bh = i * 16 + xcd * 2 + (slot >> 4), n = slot & 15;
    return bh * 16 + n;
}
__device__ __forceinline__ void phase_attnA(const Params& p, int l, unsigned char* smem) {
    unsigned char* ws = launder_ws(p.ws);
    const bf16_t* P = (const bf16_t*)(ws + WS_P); bf16_t* Y = (bf16_t*)(ws + WS_U);
    const float bound = 8.0f * LOG2E * 1.02f * max_abs_vec(PIN(I_AQN) + l * 64, 64) * max_abs_vec(PIN(I_AKN) + l * 64, 64);
    const int nitems = (l == DEPTH - 1) ? 1024 : 1088;
    const int cshift = (gridDim.x == 256) ? 64 : 0;
    for (int x0 = blockIdx.x; x0 < nitems + cshift; x0 += gridDim.x) {
        if (x0 >= 1024 && x0 < 1024 + cshift) continue;
        const int x = attn_item_remap(x0 >= 1024 ? x0 - cshift : x0, gridDim.x);
        AttnItem it; it.subgain = nullptr; it.lam = 0.f; it.postscale = 1.f;
        int b, h, n;
        if (x < 1024) { b = x >> 6; h = (x >> 4) & 3; n = x & 15;
            const int lo = max(0, 256 * n - 128), hi = min(TL, 256 * n + 384);
            it.qrow0 = b * TL + 256 * n; it.qpos0 = 256 * n; it.nt0 = (hi - lo) >> 6; it.krow0 = b * TL + lo; it.kpos0 = lo; it.masked = 1; }
        else { const int y = x - 1024; b = y >> 2; h = y & 3;
            it.qrow0 = NROWL + b * TCX; it.qpos0 = 0; it.nt0 = 0; it.krow0 = 0; it.kpos0 = 0; it.masked = 0; }
        it.nt1 = 4; it.krow1 = NROWL + b * TCX;
        it.qcol = h * 64; it.kcol = 256 + (h >> 1) * 64; it.vcol = 384 + (h >> 1) * 64; it.ycol = h * 64;
        it.sink2 = PIN(I_ASINK)[l * 4 + h] * LOG2E; it.M2 = fmaxf(bound, it.sink2);
        fattn_item<1>(P, Y, it, smem);
    }
}
__device__ __forceinline__ void phase_attnD(const Params& p, int l, unsigned char* smem) {
    unsigned char* ws = launder_ws(p.ws);
    const bf16_t* P = (const bf16_t*)(ws + WS_P); bf16_t* Y = (bf16_t*)(ws + WS_U);
    const float bound = 5.656854249f * LOG2E * 1.02f * max_abs_vec(PIN(I_DQN) + l * 32, 32) * max_abs_vec(PIN(I_DKN) + l * 32, 32);
    float d1 = 0.f, d2 = 0.f;
    for (int i = 0; i < 32; ++i) { d1 += PIN(I_LQ1)[l * 32 + i] * PIN(I_LK1)[l * 32 + i]; d2 += PIN(I_LQ2)[l * 32 + i] * PIN(I_LK2)[l * 32 + i]; }
    const float lam_init = 0.8f - 0.6f * expf(-0.3f * (float)l);
    const float lam = expf(d1) - expf(d2) + lam_init;
    const int nitems = (l == DEPTH - 1) ? 1024 : 1088;
    for (int x0 = blockIdx.x; x0 < nitems; x0 += gridDim.x) {
        const int x = attn_item_remap(x0, gridDim.x);
        AttnItem it; it.subgain = PIN(I_DSUB) + l * 64; it.lam = lam; it.postscale = 1.0f - lam_init; it.sink2 = 0.f; it.M2 = bound;
        int b, h, n;
        if (x < 1024) { b = x >> 6; h = (x >> 4) & 3; n = x & 15;
            it.qrow0 = b * TL + 256 * n; it.qpos0 = 0; it.nt0 = 64; it.krow0 = b * TL; it.kpos0 = 0; it.masked = 0; }
        else { const int y = x - 1024; b = y >> 2; h = y & 3;
            it.qrow0 = NROWL + b * TCX; it.qpos0 = 0; it.nt0 = 0; it.krow0 = 0; it.kpos0 = 0; it.masked = 0; }
        it.nt1 = 4; it.krow1 = NROWL + b * TCX;
        it.qcol = 1536 + h * 64; it.kcol = 1792 + h * 64; it.vcol = 2048 + h * 64; it.ycol = 768 + h * 64;
        if (bound < 100.0f) fattn_d_item(P, Y, it, smem); else fattn_item<2>(P, Y, it, smem);
    }
}

#define HY_ZROWS 4160
#define HY_FLEN 8256
#define HY_OFF_F (HY_ZROWS * 32)
#define HY_OFF_MISC (HY_OFF_F + HY_FLEN * 2)

__device__ __forceinline__ void hy_kloop(const LAS unsigned char* zs, const LAS bf16_t* fs, int w, int lane, f32x4 (&acc)[4][8]) {
    const int i = lane & 15, q = lane >> 4, qq = (lane & 15) >> 2, pp = lane & 3;
    const LAS bf16_t* ap = fs + (4096 - 512 * w + 8 * q - 8 * i);
    const LAS unsigned char* bp = zs + (8 * q + qq) * 32 + pp * 8;
    bf16x8 an[4];
#pragma unroll
    for (int m = 0; m < 4; ++m) an[m] = *(const LAS bf16x8*)(ap - 128 * m);
#pragma unroll 1
    for (int ks = 0; ks < 129; ++ks) {
        bf16x8 a[4];
#pragma unroll
        for (int m = 0; m < 4; ++m) a[m] = an[m];
#pragma unroll
        for (int m = 0; m < 4; ++m) an[m] = *(const LAS bf16x8*)(ap + 32 * (ks + 1) - 128 * m);
#pragma unroll
        for (int r = 0; r < 8; ++r) {
            const s16x4 lo = tr_read(bp + (32 * ks + r) * 32), hi = tr_read(bp + (32 * ks + r) * 32 + 128);
            const bf16x8 b = __builtin_shufflevector(lo, hi, 0, 1, 2, 3, 4, 5, 6, 7);
#pragma unroll
            for (int m = 0; m < 4; ++m) acc[m][r] = __builtin_amdgcn_mfma_f32_16x16x32_bf16(a[m], b, acc[m][r], 0, 0, 0);
        }
    }
}
#define HYC_OFF_Z 4096
#define HYC_ZROWS 304
#define HYC_OFF_F (HYC_OFF_Z + HYC_ZROWS * 32)
#define HYC_FLEN 576
__device__ __forceinline__ void hy_ckloop(const LAS unsigned char* zs, const LAS bf16_t* fs, int r, int lane, f32x4 (&acc)[2]) {
    const int i = lane & 15, q = lane >> 4, qq = (lane & 15) >> 2, pp = lane & 3;
    const LAS bf16_t* ap = fs + (256 + 8 * q - 8 * i);
    const LAS unsigned char* bp = zs + (8 * q + qq + r) * 32 + pp * 8;
#pragma unroll
    for (int ks = 0; ks < 9; ++ks) {
        const s16x4 lo = tr_read(bp + (32 * ks) * 32), hi = tr_read(bp + (32 * ks) * 32 + 128);
        const bf16x8 b = __builtin_shufflevector(lo, hi, 0, 1, 2, 3, 4, 5, 6, 7);
#pragma unroll
        for (int m = 0; m < 2; ++m) { const bf16x8 a = *(const LAS bf16x8*)(ap + 32 * ks - 128 * m); acc[m] = __builtin_amdgcn_mfma_f32_16x16x32_bf16(a, b, acc[m], 0, 0, 0); }
    }
}
__device__ __forceinline__ float hy_sconv(const bf16_t* u, int t, int T, float c0, float c1, float c2) {
    const int tm = t > 0 ? t - 1 : 0, tp = t < T - 1 ? t + 1 : T - 1;
    const float um = bf2f(u[tm]), u0 = bf2f(u[t]), up = bf2f(u[tp]);
    return (t > 0 ? c0 : 0.f) * um + c1 * u0 + (t < T - 1 ? c2 : 0.f) * up;
}
__device__ __forceinline__ void hy_gate8(const bf16_t* ub  , int t0, float c0, float c1, float c2, float (&g)[8]) {
    const u32x4 raw = *(const u32x4*)ub; const float hl = bf2f(ub[-1]), hr = bf2f(ub[8]);
    float x[10];
    x[0] = t0 > 0 ? hl : 0.f; x[9] = t0 + 8 < 4096 ? hr : 0.f;
    x[1] = bflo(raw.x); x[2] = bfhi(raw.x); x[3] = bflo(raw.y); x[4] = bfhi(raw.y); x[5] = bflo(raw.z); x[6] = bfhi(raw.z); x[7] = bflo(raw.w); x[8] = bfhi(raw.w);
#pragma unroll
    for (int e = 0; e < 8; ++e) g[e] = c0 * x[e] + c1 * x[e + 1] + c2 * x[e + 2];
}
__device__ __forceinline__ float block_sum(float v, float* red  ) {
    v = wave_sum(v);
    __syncthreads();
    if ((my_tid() & 63) == 0) red[my_tid() >> 6] = v;
    __syncthreads();
    float s = 0.f;
#pragma unroll
    for (int w = 0; w < 8; ++w) s += red[w];
    return s;
}

#if defined(PROBE_KIND) && PROBE_KIND == 6
#define HY_STAMP(k) do { if (blockIdx.x == 0 && my_tid() == 0) { volatile unsigned* pw_ = (volatile unsigned*)(smem + LDS_BYTES - 48); const unsigned t_ = (unsigned)wall_clock64(); \
        if ((k) >= 0 && ((PROBE_MASK >> ((k) < 0 ? 0 : (k))) & 1)) pw_[2] += t_ - pw_[5]; pw_[5] = t_; } } while (0)
#else
#define HY_STAMP(k) do {} while (0)
#endif
__device__ __forceinline__ void phase_hyena(const Params& p, int l, unsigned char* smem) {
    unsigned char* ws = launder_ws(p.ws);
    LAS unsigned char* lds = (LAS unsigned char*)smem;
    bf16_t* Zs = (bf16_t*)smem; bf16_t* Fs = (bf16_t*)(smem + HY_OFF_F);
    float* fw3c = (float*)(smem + HY_OFF_MISC);
    float* red = fw3c + 256;
    float* HT = (float*)smem;
    const bf16_t* UT = (const bf16_t*)(ws + WS_UT);
    bf16_t* YT = (bf16_t*)(ws + WS_YT);
    const float* H2L = (const float*)(ws + WS_HID2L); const float* H2C = (const float*)(ws + WS_HID2C);
    const float* fw3 = PIN(I_FW3) + (size_t)l * 64 * 1024;
    const float* cw = PIN(I_HYCONV) + (size_t)l * 3 * 768;
    const float da = logf(1e-2f) / 1.5f, db = logf(1e-2f) / 0.3f;
    for (int c = blockIdx.x; c < 256; c += gridDim.x) {
        const int tid = my_tid(), lane = tid & 63, w = tid >> 6;
        bf16_t* FB = (bf16_t*)(ws + WS_FBUF) + (size_t)c * HY_FLEN;
        const float delta = fabsf(da + (float)c * ((db - da) / 255.0f));
        const float bias0 = PIN(I_HYBIAS)[l * 512 + c], bias1 = PIN(I_HYBIAS)[l * 512 + 256 + c];
        __syncthreads();
        if (tid < 256) fw3c[tid] = fw3[(size_t)(tid & 63) * 1024 + (tid >> 6) * 256 + c];
        __syncthreads();
        HY_STAMP(-1);
        float ss0 = 0.f, ss1 = 0.f;
#pragma unroll 1
        for (int lag = tid; lag < 4096; lag += NTHR) {
            float a0 = 0.f, a1 = 0.f, a2 = 0.f, a3 = 0.f;
            float hv[64];
#pragma unroll
            for (int k = 0; k < 64; ++k) hv[k] = H2L[(size_t)k * 4096 + lag];
#pragma unroll
            for (int k = 0; k < 64; ++k) { const float h = hv[k]; a0 += h * fw3c[k]; a1 += h * fw3c[64 + k]; a2 += h * fw3c[128 + k]; a3 += h * fw3c[192 + k]; }
            const float dec = expf(-((float)lag / 4095.0f) * delta);
            a0 *= dec; a1 *= dec; a2 *= dec; a3 *= dec;
            HT[lag] = a0; HT[4096 + lag] = a1; HT[8192 + lag] = a2; HT[12288 + lag] = a3;
            ss0 += a0 * a0 + (lag >= 1 ? a2 * a2 : 0.f); ss1 += a1 * a1 + (lag >= 1 ? a3 * a3 : 0.f);
        }
        ss0 = block_sum(ss0, red); ss1 = block_sum(ss1, red);
        const float n0 = rsqrtf(ss0 + EPSF), n1 = rsqrtf(ss1 + EPSF);
#pragma unroll 1
        for (int x = tid; x < HY_FLEN; x += NTHR) { const int d = 4128 - x; float f0 = 0.f, f1 = 0.f;
            if (d >= 0 && d <= 4095) { f0 = HT[d] * n0; f1 = HT[4096 + d] * n1; } else if (d < 0 && d >= -4095) { f0 = HT[8192 - d] * n0; f1 = HT[12288 - d] * n1; }
            Fs[x] = f2bf(f0); FB[x] = f2bf(f1); }
        __syncthreads();
        HY_STAMP(0);
        for (int idx = tid; idx < 1024; idx += NTHR) { const int rr = idx >> 4; Zs[(rr < 32 ? rr : 4096 + rr) * 16 + (idx & 15)] = 0; }
        { const bf16_t* u = UT + (size_t)c * NROW; const float v0 = cw[c], v1 = cw[768 + c], v2 = cw[1536 + c];
#pragma unroll 4
          for (int idx = tid; idx < 8192; idx += NTHR) { const int b = idx >> 9, t0 = (idx & 511) * 8;
              float g[8]; hy_gate8(u + b * 4096 + t0, t0, v0, v1, v2, g);
#pragma unroll
              for (int i = 0; i < 8; ++i) Zs[(t0 + i + 32) * 16 + b] = f2bf(g[i]); } }
        __syncthreads();
        HY_STAMP(1);
        f32x4 acc[4][8];
#pragma unroll
        for (int m = 0; m < 4; ++m)
#pragma unroll
            for (int r = 0; r < 8; ++r) acc[m][r] = (f32x4){0.f, 0.f, 0.f, 0.f};
        hy_kloop(lds, (const LAS bf16_t*)(lds + HY_OFF_F), w, lane, acc);
        HY_STAMP(2);
        { int lo = lane, wo = w; asm volatile("" : "+v"(lo), "+v"(wo));
          const float g0 = cw[256 + c], g1 = cw[768 + 256 + c], g2 = cw[1536 + 256 + c];
          const int tb0 = 512 * wo + 32 * (lo >> 4);
          const bf16_t* u1 = UT + (size_t)(256 + c) * NROW + (lo & 15) * 4096 + tb0;
          const bf16_t* zp = Zs + (tb0 + 32) * 16 + (lo & 15);
#pragma unroll
          for (int m = 0; m < 4; ++m)
#pragma unroll
              for (int j = 0; j < 4; ++j) { float g[8]; hy_gate8(u1 + 128 * m + 8 * j, tb0 + 128 * m + 8 * j, g0, g1, g2, g);
#pragma unroll
                  for (int r = 0; r < 8; ++r) { const float z = bf2f(zp[(128 * m + r + 8 * j) * 16]); acc[m][r][j] = g[r] * (acc[m][r][j] + bias0 * z); }
                  asm volatile("" ::: "memory"); } }
        __syncthreads();
        { int lo = lane, wo = w; asm volatile("" : "+v"(lo), "+v"(wo));
          bf16_t* zp = Zs + (512 * wo + 32 * (lo >> 4) + 32) * 16 + (lo & 15);
#pragma unroll
          for (int m = 0; m < 4; ++m)
#pragma unroll
              for (int r = 0; r < 8; ++r) {
#pragma unroll
                  for (int j = 0; j < 4; ++j) zp[(128 * m + r + 8 * j) * 16] = f2bf(acc[m][r][j]);
                  asm volatile("" ::: "memory"); } }
        for (int x = tid; x < HY_FLEN / 8; x += NTHR) ((u32x4*)Fs)[x] = ((const u32x4*)FB)[x];
        __syncthreads();
        HY_STAMP(3);
#pragma unroll
        for (int m = 0; m < 4; ++m)
#pragma unroll
            for (int r = 0; r < 8; ++r) acc[m][r] = (f32x4){0.f, 0.f, 0.f, 0.f};
        hy_kloop(lds, (const LAS bf16_t*)(lds + HY_OFF_F), w, lane, acc);
        HY_STAMP(4);
        { int lo = lane, wo = w; asm volatile("" : "+v"(lo), "+v"(wo));
          const float e0 = cw[512 + c], e1 = cw[768 + 512 + c], e2 = cw[1536 + 512 + c];
          const int tb0 = 512 * wo + 32 * (lo >> 4);
          const bf16_t* u2 = UT + (size_t)(512 + c) * NROW + (lo & 15) * 4096 + tb0;
          bf16_t* yo = YT + (size_t)c * NROW + (lo & 15) * 4096 + tb0;
          const bf16_t* zp = Zs + (tb0 + 32) * 16 + (lo & 15);
#pragma unroll
          for (int m = 0; m < 4; ++m)
#pragma unroll
              for (int j = 0; j < 4; ++j) { float g[8]; hy_gate8(u2 + 128 * m + 8 * j, tb0 + 128 * m + 8 * j, e0, e1, e2, g);
#pragma unroll
                  for (int r = 0; r < 8; ++r) { const float z1 = bf2f(zp[(128 * m + r + 8 * j) * 16]); g[r] = g[r] * (acc[m][r][j] + bias1 * z1); }
                  u32x4 o; o.x = pack_bf16(g[0], g[1]); o.y = pack_bf16(g[2], g[3]); o.z = pack_bf16(g[4], g[5]); o.w = pack_bf16(g[6], g[7]);
                  *(u32x4*)(yo + 128 * m + 8 * j) = o;
                  asm volatile("" ::: "memory"); } }
        __syncthreads();
        HY_STAMP(5);
        if (l < DEPTH - 1) {   float* HTc = (float*)smem;
            bf16_t* Zc = (bf16_t*)(smem + HYC_OFF_Z);
            bf16_t* Fc0 = (bf16_t*)(smem + HYC_OFF_F); bf16_t* Fc1 = Fc0 + HYC_FLEN;
            float* part = (float*)(smem + HYC_OFF_Z);
            float t0 = 0.f, t1 = 0.f;
            { const int lag = tid & 255, kh = tid >> 8; float a0 = 0.f, a1 = 0.f, a2 = 0.f, a3 = 0.f;
              float hv[32];
#pragma unroll
              for (int k = 0; k < 32; ++k) hv[k] = H2C[(size_t)(32 * kh + k) * 256 + lag];
#pragma unroll
              for (int k = 0; k < 32; ++k) { const float h = hv[k]; const int kk = 32 * kh + k; a0 += h * fw3c[kk]; a1 += h * fw3c[64 + kk]; a2 += h * fw3c[128 + kk]; a3 += h * fw3c[192 + kk]; }
              if (kh == 1) { part[lag] = a0; part[256 + lag] = a1; part[512 + lag] = a2; part[768 + lag] = a3; }
              __syncthreads();
              if (kh == 0) { a0 += part[lag]; a1 += part[256 + lag]; a2 += part[512 + lag]; a3 += part[768 + lag];
                const float dec = expf(-((float)lag / 255.0f) * delta);
                a0 *= dec; a1 *= dec; a2 *= dec; a3 *= dec;
                HTc[lag] = a0; HTc[256 + lag] = a1; HTc[512 + lag] = a2; HTc[768 + lag] = a3;
                t0 = a0 * a0 + (lag >= 1 ? a2 * a2 : 0.f); t1 = a1 * a1 + (lag >= 1 ? a3 * a3 : 0.f); } }
            t0 = block_sum(t0, red); t1 = block_sum(t1, red);
            const float m0 = rsqrtf(t0 + EPSF), m1 = rsqrtf(t1 + EPSF);
            for (int x = tid; x < 2 * HYC_FLEN; x += NTHR) { const int o = x >= HYC_FLEN ? 1 : 0, xx = x - o * HYC_FLEN, d = 288 - xx; float f = 0.f;
                if (d >= 0 && d <= 255) f = HTc[256 * o + d]; else if (d < 0 && d >= -255) f = HTc[512 + 256 * o - d];
                Fc0[x] = f2bf(f * (o ? m1 : m0)); }
            { const bf16_t* uc = UT + (size_t)c * NROW + NROWL; const float v0 = cw[c], v1 = cw[768 + c], v2 = cw[1536 + c];
              for (int idx = tid; idx < 768; idx += NTHR) { const int rr = idx >> 4; Zc[(rr < 32 ? rr : 256 + rr) * 16 + (idx & 15)] = 0; }
#pragma unroll 2
              for (int idx = tid; idx < 4096; idx += NTHR) { const int b = idx >> 8, t = idx & 255; Zc[(t + 32) * 16 + b] = f2bf(hy_sconv(uc + b * 256, t, 256, v0, v1, v2)); } }
            __syncthreads();
            f32x4 ca[2];
            ca[0] = (f32x4){0.f, 0.f, 0.f, 0.f}; ca[1] = ca[0];
            hy_ckloop(lds + HYC_OFF_Z, (const LAS bf16_t*)(lds + HYC_OFF_F), w, lane, ca);
            { const float g0 = cw[256 + c], g1 = cw[768 + 256 + c], g2 = cw[1536 + 256 + c];
              const bf16_t* u1c = UT + (size_t)(256 + c) * NROW + NROWL + (lane & 15) * 256;
#pragma unroll
              for (int m = 0; m < 2; ++m)
#pragma unroll
                  for (int j = 0; j < 4; ++j) { const int t = 128 * m + w + 32 * (lane >> 4) + 8 * j;
                      const float z = bf2f(Zc[(t + 32) * 16 + (lane & 15)]);
                      ca[m][j] = hy_sconv(u1c, t, 256, g0, g1, g2) * (ca[m][j] + bias0 * z); } }
            __syncthreads();
#pragma unroll
            for (int m = 0; m < 2; ++m)
#pragma unroll
                for (int j = 0; j < 4; ++j) { const int t = 128 * m + w + 32 * (lane >> 4) + 8 * j; Zc[(t + 32) * 16 + (lane & 15)] = f2bf(ca[m][j]); }
            __syncthreads();
            ca[0] = (f32x4){0.f, 0.f, 0.f, 0.f}; ca[1] = ca[0];
            hy_ckloop(lds + HYC_OFF_Z, (const LAS bf16_t*)(lds + HYC_OFF_F + 2 * HYC_FLEN), w, lane, ca);
            { const float e0 = cw[512 + c], e1 = cw[768 + 512 + c], e2 = cw[1536 + 512 + c];
              const bf16_t* u2c = UT + (size_t)(512 + c) * NROW + NROWL + (lane & 15) * 256;
              bf16_t* yo = YT + (size_t)c * NROW + NROWL + (lane & 15) * 256;
#pragma unroll
              for (int m = 0; m < 2; ++m)
#pragma unroll
                  for (int j = 0; j < 4; ++j) { const int t = 128 * m + w + 32 * (lane >> 4) + 8 * j;
                      const float z1 = bf2f(Zc[(t + 32) * 16 + (lane & 15)]);
                      yo[t] = f2bf(hy_sconv(u2c, t, 256, e0, e1, e2) * (ca[m][j] + bias1 * z1)); } }
            __syncthreads();
        }
        HY_STAMP(6);
    }
}

__device__ __forceinline__ void phase_hy_transpose(const Params& p, int l, unsigned char* smem) {
    unsigned char* ws = launder_ws(p.ws);
    const bf16_t* YT = (const bf16_t*)(ws + WS_YT); bf16_t* Y = (bf16_t*)(ws + WS_U);
    bf16_t* tile = (bf16_t*)smem;
    const int tid = my_tid();
    const int ntile = 4 * ((l == DEPTH - 1 ? NROWL : NROW) / 64);
    for (int it = blockIdx.x; it < ntile; it += gridDim.x) {
        const int ct = it & 3, rt = it >> 2;
        __syncthreads();
        { const int ch = tid >> 3, seg = tid & 7;
          const u32x4 v = *(const u32x4*)(YT + (size_t)(ct * 64 + ch) * NROW + rt * 64 + seg * 8);
          unsigned* d = (unsigned*)(tile + ch * 66 + seg * 8); d[0] = v.x; d[1] = v.y; d[2] = v.z; d[3] = v.w; }
        __syncthreads();
        { const int r = tid >> 3, seg = tid & 7;
          unsigned wv[4];
#pragma unroll
          for (int k = 0; k < 4; ++k) wv[k] = (unsigned)tile[(seg * 8 + 2 * k) * 66 + r] | ((unsigned)tile[(seg * 8 + 2 * k + 1) * 66 + r] << 16);
          u32x4 o; o.x = wv[0]; o.y = wv[1]; o.z = wv[2]; o.w = wv[3];
          *(u32x4*)(Y + (size_t)(rt * 64 + r) * DM + 256 + ct * 64 + seg * 8) = o; }
    }
    __syncthreads();
}
#define ML_ITEMS 4352
__device__ __forceinline__ void ml_decode(int it, int& b, int& head, int& tc, int& tok0, int& jf, int& jb) {
    b = it / 272; const int r = it - b * 272; head = r / 68; tc = r - head * 68;
    tok0 = tc < 4 ? NROWL + b * TCX + 64 * tc : b * TL + 64 * (tc - 4);
    jf = tc; jb = tc < 4 ? 3 - tc : 71 - tc;
}

__device__ __forceinline__ void phase_ml_local(const Params& p, int l, unsigned char* smem) {
    unsigned char* ws = launder_ws(p.ws);
    const int tid = my_tid(), lane = tid & 63, w = tid >> 6;
    bf16_t* Kt = (bf16_t*)smem;
    bf16_t* VwF = Kt + 64 * 72;
    bf16_t* VwB = VwF + 64 * 72;
    float* Vs = (float*)(VwB + 64 * 72);
    float* vec = Vs + 64 * 65;
    float* igf = vec, *igb = vec + 64, *lff = vec + 128, *lfb = vec + 192, *wf = vec + 256, *wb = vec + 320, *scal = vec + 384;
    const bf16_t* P = (const bf16_t*)(ws + WS_P);
    const float* GT = (const float*)(ws + WS_GATES);
    bf16_t* MLA = (bf16_t*)(ws + WS_MLA); float* MLN = (float*)(ws + WS_MLN); float* MLS = (float*)(ws + WS_MLS);
    const float* bg = PIN(I_BGATE) + l * 16;
    for (int it = blockIdx.x; it < ML_ITEMS; it += gridDim.x) {
        int b, head, tc, tok0, jf, jb; ml_decode(it, b, head, tc, tok0, jf, jb);
        __syncthreads();
        { const int s = tid >> 3, ch = tid & 7;
          const bf16_t* pr = P + (size_t)(tok0 + s) * PW + head * 64 + ch * 8;
          const u32x4 kv = *(const u32x4*)(pr + 768), vv = *(const u32x4*)(pr + 1024);
          const unsigned kw[4] = {kv.x, kv.y, kv.z, kv.w}, vw[4] = {vv.x, vv.y, vv.z, vv.w};
#pragma unroll
          for (int i = 0; i < 4; ++i) { Kt[(ch * 8 + 2 * i) * 72 + s] = f2bf(bflo(kw[i]) * 0.125f); Kt[(ch * 8 + 2 * i + 1) * 72 + s] = f2bf(bfhi(kw[i]) * 0.125f);
              Vs[s * 65 + ch * 8 + 2 * i] = bflo(vw[i]); Vs[s * 65 + ch * 8 + 2 * i + 1] = bfhi(vw[i]); } }
        if (tid < 64) { const float* g = GT + (size_t)(tok0 + tid) * 16;
            igf[tid] = g[head] + bg[head]; igb[tid] = g[4 + head] + bg[4 + head]; lff[tid] = log_sigmoid(g[8 + head] + bg[8 + head]); lfb[tid] = log_sigmoid(g[12 + head] + bg[12 + head]); }
        __syncthreads();
        if (tid < 128) {
            const int dirw = tid >> 6, tau = tid & 63, s = dirw ? 63 - tau : tau;
            const float lf = dirw ? lfb[s] : lff[s], ig = dirw ? igb[s] : igf[s];
            float cum = lf;
#pragma unroll
            for (int o = 1; o < 64; o <<= 1) { const float n = __shfl_up(cum, o); if (tau >= o) cum += n; }
            const float B = __shfl(cum, 63);
            const float ge = B - cum + ig;
            const float ml = wave_max(ge);
            (dirw ? wb : wf)[s] = expf(ge - ml);
            if (tau == 0) { scal[2 * dirw] = B; scal[2 * dirw + 1] = ml; } }
        __syncthreads();
        { const int e = tid >> 3, sc = (tid & 7) * 8; u32x4 a, c2; float x[8], y[8];
#pragma unroll
          for (int i = 0; i < 8; ++i) { const float v = Vs[(sc + i) * 65 + e]; x[i] = v * wf[sc + i]; y[i] = v * wb[sc + i]; }
          a.x = pack_bf16(x[0], x[1]); a.y = pack_bf16(x[2], x[3]); a.z = pack_bf16(x[4], x[5]); a.w = pack_bf16(x[6], x[7]);
          c2.x = pack_bf16(y[0], y[1]); c2.y = pack_bf16(y[2], y[3]); c2.z = pack_bf16(y[4], y[5]); c2.w = pack_bf16(y[6], y[7]);
          *(u32x4*)(VwF + e * 72 + sc) = a; *(u32x4*)(VwB + e * 72 + sc) = c2; }
        __syncthreads();
        const int dir = w >> 2, wl = w & 3, te = wl >> 1, tk = wl & 1;
        const int seq = (b * 4 + head) * 2 + dir, j = dir ? jb : jf;
        bf16_t* dst = MLA + ((size_t)seq * 68 + j) * 4096;
        { f32x16 C;
#pragma unroll
          for (int r = 0; r < 16; ++r) C[r] = 0.f;
          C = mma32((dir ? VwB : VwF) + 32 * te * 72, 72, Kt + 32 * tk * 72, 72, 64, C, lane);
#pragma unroll
          for (int r = 0; r < 16; ++r) dst[(32 * te + CROW(r, lane)) * 64 + 32 * tk + (lane & 31)] = f2bf(C[r]); }
        if (wl == 0) {
            const float* wv = dir ? wb : wf; float s = 0.f;
            for (int t = 0; t < 64; ++t) s += wv[t] * bf2f(Kt[lane * 72 + t]);
            MLN[((size_t)seq * 68 + j) * 64 + lane] = s;
            if (lane == 0) { MLS[((size_t)seq * 68 + j) * 4 + 0] = scal[2 * dir]; MLS[((size_t)seq * 68 + j) * 4 + 1] = scal[2 * dir + 1]; }
        }
    }
    __syncthreads();
}

__device__ __forceinline__ void phase_ml_scan(const Params& p) {
    unsigned char* ws = launder_ws(p.ws);
    const int tid = my_tid();
    unsigned* MLA = (unsigned*)(ws + WS_MLA); float* MLN = (float*)(ws + WS_MLN); float* MLS = (float*)(ws + WS_MLS);
    for (int it = blockIdx.x; it < 512; it += gridDim.x) {
        const int seq = it >> 2, part = it & 3;
        unsigned* base = MLA + (size_t)seq * 68 * 2048 + part * 512 + tid;
        float* nb = MLN + (size_t)seq * 68 * 64 + part * 16 + tid;
        float* sc = MLS + (size_t)seq * 68 * 4;
        const bool hasn = tid < 16;
        float m = 0.f, c0 = 0.f, c1 = 0.f, cn = 0.f;
#define ML_SCAN_BATCH(NBATCH, J0) do { unsigned a[NBATCH]; float an[NBATCH], B[NBATCH], ML[NBATCH]; \
            _Pragma("unroll") for (int u = 0; u < NBATCH; ++u) { a[u] = base[(size_t)((J0) + u) * 2048]; an[u] = hasn ? nb[((J0) + u) * 64] : 0.f; B[u] = sc[((J0) + u) * 4]; ML[u] = sc[((J0) + u) * 4 + 1]; } \
            _Pragma("unroll") for (int u = 0; u < NBATCH; ++u) { \
                const float mn = fmaxf(B[u] + m, ML[u]); const float wp = expf(B[u] + m - mn), wa = expf(ML[u] - mn); \
                if (part == 0 && tid == 0) sc[((J0) + u) * 4 + 2] = m; \
                base[(size_t)((J0) + u) * 2048] = pack_bf16(c0, c1); if (hasn) nb[((J0) + u) * 64] = cn; \
                c0 = wp * c0 + wa * bflo(a[u]); c1 = wp * c1 + wa * bfhi(a[u]); cn = wp * cn + wa * an[u]; m = mn; } } while (0)
        for (int j0 = 0; j0 < 64; j0 += 8) ML_SCAN_BATCH(8, j0);
        ML_SCAN_BATCH(4, 64);
#undef ML_SCAN_BATCH
    }
}

__device__ __forceinline__ void phase_ml_out(const Params& p, int l, unsigned char* smem) {
    unsigned char* ws = launder_ws(p.ws);
    const int tid = my_tid(), lane = tid & 63, w = tid >> 6;
    const int DSZ = 71680;
    const bf16_t* P = (const bf16_t*)(ws + WS_P);
    const float* GT = (const float*)(ws + WS_GATES);
    const bf16_t* MLA = (const bf16_t*)(ws + WS_MLA); const float* MLN = (const float*)(ws + WS_MLN); const float* MLS = (const float*)(ws + WS_MLS);
    bf16_t* Y = (bf16_t*)(ws + WS_U);
    const float* bg = PIN(I_BGATE) + l * 16; const float* mln = PIN(I_MLNORM) + l * 64;
    u32x4 pq, pk_, pv, pst[2]; float pn = 0.f, pg0 = 0.f, pg1 = 0.f, pm = 0.f;
#define ML_SKIP(it_) ({ int b_, h_, tc_, t0_, jf_, jb_; ml_decode((it_), b_, h_, tc_, t0_, jf_, jb_); (l == DEPTH - 1 && tc_ < 4); })
#define ML_FETCH(it_) do { int b_, h_, tc_, t0_, jf_, jb_; ml_decode((it_), b_, h_, tc_, t0_, jf_, jb_); \
        { const int s_ = tid >> 3, ch_ = tid & 7; const bf16_t* pr_ = P + (size_t)(t0_ + s_) * PW + h_ * 64 + ch_ * 8; \
          pq = *(const u32x4*)(pr_ + 512); pk_ = *(const u32x4*)(pr_ + 768); pv = *(const u32x4*)(pr_ + 1024); } \
        _Pragma("unroll") for (int d_ = 0; d_ < 2; ++d_) { const int seq_ = (b_ * 4 + h_) * 2 + d_, j_ = d_ ? jb_ : jf_; \
          pst[d_] = *(const u32x4*)(MLA + ((size_t)seq_ * 68 + j_) * 4096 + (tid >> 3) * 64 + (tid & 7) * 8); } \
        if (tid < 128) { const int d_ = tid >> 6, tau_ = tid & 63, tk_ = d_ ? 63 - tau_ : tau_; const int seq_ = (b_ * 4 + h_) * 2 + d_, j_ = d_ ? jb_ : jf_; \
          pn = MLN[((size_t)seq_ * 68 + j_) * 64 + tau_]; const float* g_ = GT + (size_t)(t0_ + tk_) * 16; \
          pg0 = g_[4 * d_ + h_]; pg1 = g_[8 + 4 * d_ + h_]; pm = MLS[((size_t)seq_ * 68 + j_) * 4 + 2]; } } while (0)
    int it = blockIdx.x;
    while (it < ML_ITEMS && ML_SKIP(it)) it += gridDim.x;
    if (it < ML_ITEMS) ML_FETCH(it);
    while (it < ML_ITEMS) {
        int b, head, tc, tok0, jf, jb; ml_decode(it, b, head, tc, tok0, jf, jb);
        int nit = it + gridDim.x;
        while (nit < ML_ITEMS && ML_SKIP(nit)) nit += gridDim.x;
        __syncthreads();
        {   const int s = tid >> 3, ch = tid & 7;
            const u32x4 qv = pq, kv = pk_, vv = pv;
            u32x4 ks; ks.x = pack_bf16(bflo(kv.x) * 0.125f, bfhi(kv.x) * 0.125f); ks.y = pack_bf16(bflo(kv.y) * 0.125f, bfhi(kv.y) * 0.125f);
            ks.z = pack_bf16(bflo(kv.z) * 0.125f, bfhi(kv.z) * 0.125f); ks.w = pack_bf16(bflo(kv.w) * 0.125f, bfhi(kv.w) * 0.125f);
            const unsigned vw[4] = {vv.x, vv.y, vv.z, vv.w};
#pragma unroll
            for (int d = 0; d < 2; ++d) { unsigned char* D = smem + d * DSZ; const int tau = d ? 63 - s : s;
                bf16_t* Qd = (bf16_t*)D; bf16_t* Kd = Qd + 64 * 72; bf16_t* Bd = Kd + 64 * 72 + 64 * 136;
                *(u32x4*)(Qd + tau * 72 + ch * 8) = qv; *(u32x4*)(Kd + tau * 72 + ch * 8) = ks;
#pragma unroll
                for (int i = 0; i < 4; ++i) { Bd[(ch * 8 + 2 * i) * 136 + tau] = (bf16_t)(vw[i] & 0xffff); Bd[(ch * 8 + 2 * i + 1) * 136 + tau] = (bf16_t)(vw[i] >> 16); } }
#pragma unroll
            for (int d = 0; d < 2; ++d) { unsigned char* D = smem + d * DSZ; bf16_t* Bd = (bf16_t*)D + 2 * 64 * 72 + 64 * 136;
                const int e = tid >> 3, k0 = (tid & 7) * 8;
                *(u32x4*)(Bd + e * 136 + 64 + k0) = pst[d]; }
            if (tid < 128) { const int d = tid >> 6, tau = tid & 63;
                float* vecs = (float*)(smem + d * DSZ + 53248);
                vecs[3 * 64 + tau] = pn;
                vecs[4 * 64 + tau] = pg0 + bg[4 * d + head];
                vecs[5 * 64 + tau] = log_sigmoid(pg1 + bg[8 + 4 * d + head]); }
        }
        const float mcur = pm;
        if (nit < ML_ITEMS) ML_FETCH(nit);
        __syncthreads();
        if (tid < 128) { const int d = tid >> 6, tau = tid & 63; float* vecs = (float*)(smem + d * DSZ + 53248);
            const int seq = (b * 4 + head) * 2 + d, j = d ? jb : jf;
            const float m = mcur;
            float cum = vecs[5 * 64 + tau];
#pragma unroll
            for (int o = 1; o < 64; o <<= 1) { const float n = __shfl_up(cum, o); if (tau >= o) cum += n; }
            float mm = vecs[4 * 64 + tau] - cum;
#pragma unroll
            for (int o = 1; o < 64; o <<= 1) { const float n = __shfl_up(mm, o); if (tau >= o) mm = fmaxf(mm, n); }
            const float mt = cum + fmaxf(m, mm);
            vecs[tau] = cum; vecs[64 + tau] = mt; vecs[128 + tau] = expf(cum + m - mt); }
        __syncthreads();
        const int d = w >> 2, wl = w & 3, tt = wl >> 1, tx = wl & 1;
        unsigned char* D = smem + d * DSZ;
        bf16_t* Qd = (bf16_t*)D; bf16_t* Kd = Qd + 64 * 72; bf16_t* Ad = Kd + 64 * 72; bf16_t* Bd = Ad + 64 * 136;
        float* vecs = (float*)(D + 53248); float* Hd = vecs + 7 * 64;
        {   f32x16 S;
#pragma unroll
            for (int r = 0; r < 16; ++r) S[r] = 0.f;
            S = mma32(Qd + 32 * tt * 72, 72, Kd + 32 * tx * 72, 72, 64, S, lane);
            const int s = 32 * tx + (lane & 31); const float bs = vecs[s], igs = vecs[4 * 64 + s];
#pragma unroll
            for (int r = 0; r < 16; ++r) { const int t = 32 * tt + CROW(r, lane);
                const float val = (s <= t) ? S[r] * fast_exp2((vecs[t] - bs + igs - vecs[64 + t]) * LOG2E) : 0.f;
                Ad[t * 136 + s] = f2bf(val); }
            const int tl = tid & 255, t = tl >> 2, qd = tl & 3; const float wi = vecs[128 + t];
#pragma unroll
            for (int v = 0; v < 2; ++v) { const u32x4 q = *(const u32x4*)(Qd + t * 72 + 16 * qd + 8 * v); u32x4 o;
                o.x = pack_bf16(bflo(q.x) * wi, bfhi(q.x) * wi); o.y = pack_bf16(bflo(q.y) * wi, bfhi(q.y) * wi); o.z = pack_bf16(bflo(q.z) * wi, bfhi(q.z) * wi); o.w = pack_bf16(bflo(q.w) * wi, bfhi(q.w) * wi);
                *(u32x4*)(Ad + t * 136 + 64 + 16 * qd + 8 * v) = o; }
        }
        __syncthreads();
        {   f32x16 N;
#pragma unroll
            for (int r = 0; r < 16; ++r) N[r] = 0.f;
            N = mma32(Ad + 32 * tt * 136, 136, Bd + 32 * tx * 136, 136, 128, N, lane);
#pragma unroll
            for (int r = 0; r < 16; ++r) Hd[(32 * tt + CROW(r, lane)) * 65 + 32 * tx + (lane & 31)] = N[r];
            const int tl = tid & 255;
            {
                const int t = tl >> 2, qd = tl & 3; float dn = 0.f;
                const u32x4 sa = *(const u32x4*)(Ad + t * 136 + 16 * qd), sb = *(const u32x4*)(Ad + t * 136 + 16 * qd + 8);
                const u32x4 qa = *(const u32x4*)(Ad + t * 136 + 64 + 16 * qd), qb = *(const u32x4*)(Ad + t * 136 + 64 + 16 * qd + 8);
                const float* nv = vecs + 3 * 64 + 16 * qd;
                dn += (bflo(sa.x) + bfhi(sa.x)) + (bflo(sa.y) + bfhi(sa.y)) + (bflo(sa.z) + bfhi(sa.z)) + (bflo(sa.w) + bfhi(sa.w));
                dn += (bflo(sb.x) + bfhi(sb.x)) + (bflo(sb.y) + bfhi(sb.y)) + (bflo(sb.z) + bfhi(sb.z)) + (bflo(sb.w) + bfhi(sb.w));
                dn += bflo(qa.x) * nv[0] + bfhi(qa.x) * nv[1] + bflo(qa.y) * nv[2] + bfhi(qa.y) * nv[3] + bflo(qa.z) * nv[4] + bfhi(qa.z) * nv[5] + bflo(qa.w) * nv[6] + bfhi(qa.w) * nv[7];
                dn += bflo(qb.x) * nv[8] + bfhi(qb.x) * nv[9] + bflo(qb.y) * nv[10] + bfhi(qb.y) * nv[11] + bflo(qb.z) * nv[12] + bfhi(qb.z) * nv[13] + bflo(qb.w) * nv[14] + bfhi(qb.w) * nv[15];
                dn += dpp_get<DPP_XOR1>(dn); dn += dpp_get<DPP_XOR2>(dn);
                if (qd == 0) vecs[6 * 64 + t] = dn; }
        }
        __syncthreads();
        {   const int s = tid >> 3, e0 = (tid & 7) * 8;
            const float* vF = (const float*)(smem + 53248); const float* HF = vF + 7 * 64;
            const float* vB = (const float*)(smem + DSZ + 53248); const float* HB = vB + 7 * 64;
            const int tb = 63 - s;
            const float rf = 1.0f / fmaxf(fabsf(vF[6 * 64 + s]), fast_exp2(-vF[64 + s] * LOG2E)), rb = 1.0f / fmaxf(fabsf(vB[6 * 64 + tb]), fast_exp2(-vB[64 + tb] * LOG2E));
            float y[8], ss = 0.f;
#pragma unroll
            for (int i = 0; i < 8; ++i) { y[i] = HF[s * 65 + e0 + i] * rf + HB[tb * 65 + e0 + i] * rb; ss += y[i] * y[i]; }
            ss += __shfl_xor(ss, 1); ss += __shfl_xor(ss, 2); ss += __shfl_xor(ss, 4);
            const float rinv = rsqrtf(ss * (1.0f / 64.0f) + EPSF);
            const u32x4 ov = *(const u32x4*)(P + (size_t)(tok0 + s) * PW + 1280 + head * 64 + e0);
            const float op[8] = {bflo(ov.x), bfhi(ov.x), bflo(ov.y), bfhi(ov.y), bflo(ov.z), bfhi(ov.z), bflo(ov.w), bfhi(ov.w)};
            float o[8];
#pragma unroll
            for (int i = 0; i < 8; ++i) o[i] = y[i] * rinv * mln[e0 + i] * __builtin_amdgcn_rcpf(1.0f + fast_exp2(-op[i] * LOG2E));
            u32x4 wv; wv.x = pack_bf16(o[0], o[1]); wv.y = pack_bf16(o[2], o[3]); wv.z = pack_bf16(o[4], o[5]); wv.w = pack_bf16(o[6], o[7]);
            *(u32x4*)(Y + (size_t)(tok0 + s) * DM + 512 + head * 64 + e0) = wv;
        }
        it = nit;
    }
#undef ML_SKIP
#undef ML_FETCH
    __syncthreads();
}
#ifndef DUPMASK
#define DUPMASK 0
#endif
#ifndef PROBE_KIND
#define PROBE_KIND 0
#endif
#ifndef PROBE_MASK
#define PROBE_MASK 0
#endif
#ifndef PROBE_MULT
#define PROBE_MULT 1
#endif
#if PROBE_KIND
#define PROBE_PRE() do { if (blockIdx.x == 0 && threadIdx.x == 0) pw[0] = (unsigned)wall_clock64(); } while (0)
#define PROBE_POST(id) do { if (blockIdx.x == 0 && threadIdx.x == 0) { const unsigned t_ = (unsigned)wall_clock64(), c_ = (unsigned)clock64(); \
        if ((PROBE_MASK >> (id)) & 1) { if (PROBE_KIND == 1) pw[2] += t_ - pw[1]; if (PROBE_KIND == 2) pw[2] += t_ - pw[0]; if (PROBE_KIND == 3) { pw[2] += t_ - pw[1]; pw[3] += c_ - pw[4]; } } \
        pw[1] = t_; pw[4] = c_; } } while (0)
#else
#define PROBE_PRE() do {} while (0)
#define PROBE_POST(id) do {} while (0)
#endif
#if PROBE_KIND == 5
#define PROBE_SEC_BEGIN() do { if (blockIdx.x == 0 && threadIdx.x == 0) pw[5] = (unsigned)wall_clock64(); } while (0)
#define PROBE_SEC_END(k) do { if (blockIdx.x == 0 && threadIdx.x == 0) { const unsigned t_ = (unsigned)wall_clock64(); if ((PROBE_MASK >> (k)) & 1) pw[2] += t_ - pw[5]; pw[5] = t_; } } while (0)
#else
#define PROBE_SEC_BEGIN() do {} while (0)
#define PROBE_SEC_END(k) do {} while (0)
#endif
#define XBAR(id) do { PROBE_PRE(); XcdBarrier _b; _b.bar = (unsigned*)(launder_ws(p.ws) + WS_BAR); _b.x = xb_xcc_id(); _b.st = xbw; xcd_barrier(_b); if ((DUPMASK >> 13) & 1) xcd_barrier(_b); PROBE_POST(id); } while (0)
#define REP(k) for (int _rep = 0; _rep < 1 + ((DUPMASK >> (k)) & 1); ++_rep)
extern __shared__ __attribute__((aligned(16))) unsigned char smem_raw[];

__global__ void __launch_bounds__(NTHR, 2) trunk_fwd(Params p) {
    unsigned char* smem = smem_raw;
    volatile LAS unsigned* xbw = (volatile LAS unsigned*)(smem_raw + LDS_BYTES - 16);
    if (threadIdx.x == 0) { xbw[0] = 0u; xbw[1] = 0u; xbw[2] = 0u; xbw[3] = 0u; }
    __syncthreads();
    (void)xcd_barrier_post((unsigned*)(p.ws + WS_BAR), xbw);
#if PROBE_KIND
    volatile LAS unsigned* pw = (volatile LAS unsigned*)(smem_raw + LDS_BYTES - 48);
    if (blockIdx.x == 0 && threadIdx.x == 0) { pw[1] = (unsigned)wall_clock64(); pw[4] = (unsigned)clock64(); pw[2] = 0u; pw[3] = 0u; }
#endif
    unsigned char* ws = p.ws;
    LAS unsigned char* lds = (LAS unsigned char*)smem_raw;
    const int G = gridDim.x, c = blockIdx.x;
    phase_W<0>(p, 0, smem);
    XBAR(0);
    phase_norm<1>(p, 0, smem);
    XBAR(1);
    for (int l = 0; l < DEPTH; ++l) {
        const bool last = (l == DEPTH - 1);
        REP(10) {   pg8::Gemm g; g.A = (const bf16_t*)(ws + WS_U); g.Bt = (const bf16_t*)(ws + WS_U); g.M = 0; g.N = 0; g.K = DM;
            { const int tid = my_tid();
              const float4* src = (const float4*)(ws + WS_ROPE); float4* dst = (float4*)(smem + EPI_TAB_OFF);
              for (int i = tid; i < 768; i += NTHR) dst[i] = src[i];
              float* gl = (float*)(smem + EPI_TAB_OFF + 12288);
              if (tid < 192) gl[tid] = tid < 64 ? PIN(I_AQN)[l * 64 + tid] : tid < 128 ? PIN(I_AKN)[l * 64 + tid - 64] : tid < 160 ? PIN(I_DQN)[l * 32 + tid - 128] : PIN(I_DKN)[l * 32 + tid - 160];
              __syncthreads(); }
            InProjOrder S{G, c}; EpiInProj E{(bf16_t*)(ws + WS_P), (bf16_t*)(ws + WS_UT), (const LAS unsigned char*)(lds + EPI_TAB_OFF)};
            pg8::gemm_phase(lds, g, S, E); }
        XBAR(2);
        PROBE_SEC_BEGIN();
        REP(0) phase_hyena(p, l, smem);
        PROBE_SEC_END(0);
        REP(1) phase_attnD(p, l, smem);
        PROBE_SEC_END(1);
        REP(2) phase_attnA(p, l, smem);
        PROBE_SEC_END(2);
        REP(3) phase_ml_local(p, l, smem);
        PROBE_SEC_END(3);
        XBAR(4);
        phase_ml_scan(p);
        REP(9) phase_hy_transpose(p, l, smem);
        XBAR(5);
        REP(4) phase_ml_out(p, l, smem);
        XBAR(6);
        {   pg8::Gemm g; g.A = (const bf16_t*)(ws + WS_U); g.Bt = (const bf16_t*)(ws + WS_WOUT); g.M = 0; g.N = 0; g.K = DM;
            OutProjOrder S{G, c, last ? 256 : 272};
            EpiOut E{PIN(I_X), PIN(I_CTX), (bf16_t*)(ws + WS_XB), (const float*)(ws + WS_MOD + (size_t)(l & 1) * MOD_BYTES), l == 0 ? 1 : 0};
            pg8::gemm_phase(lds, g, S, E); }
        REP(5) if (l + 1 < DEPTH) phase_W<2>(p, l + 1, smem);
        XBAR(7);
        REP(6) phase_norm<2>(p, l, smem);
        XBAR(8);
        REP(7) phase_topk(p, l, smem);
        XBAR(9);
        REP(11) {   pg8::Gemm g; g.A = (const bf16_t*)(ws + WS_U); g.Bt = (const bf16_t*)(ws + WS_WGU); g.M = 0; g.N = 0; g.K = DM;
            GateUpOrder S{G, c, last ? 32 : 34}; EpiGU E{(bf16_t*)(ws + WS_HID)};
            pg8::gemm_phase_gather(lds, g, S, E, (const int*)(ws + WS_SROW)); }
        XBAR(10);
        REP(12) {   pg8::Gemm g; g.A = (const bf16_t*)(ws + WS_HID); g.Bt = (const bf16_t*)(ws + WS_WD); g.M = 0; g.N = 0; g.K = DM;
            DownOrder S{G, c, last ? 32 : 34}; EpiDown E{(bf16_t*)(ws + WS_XE), (const float*)(ws + WS_SGATE)};
            pg8::gemm_phase(lds, g, S, E); }
        if (l + 1 < DEPTH) phase_W<3>(p, l + 1, smem);
        XBAR(11);
        if (l + 1 < DEPTH) { REP(14) phase_combine<true>(p, l, smem); REP(5) phase_W<1>(p, l + 1, smem); XBAR(12); }
        else phase_combine<false>(p, l, smem);
    }
#if PROBE_KIND
    PROBE_POST(12);
    if (blockIdx.x == 0 && threadIdx.x == 0) {
        unsigned long long target = (unsigned long long)pw[2] * PROBE_MULT;
        if (PROBE_KIND == 3) target = pw[2] ? (unsigned long long)pw[3] * 10000ull / pw[2] : 0ull;
        const unsigned long long t0 = wall_clock64();
        while ((unsigned long long)wall_clock64() - t0 < target) __builtin_amdgcn_s_sleep(8);
    }
#endif
}

extern "C" void kernel_launch(void* const* d_in, const int* in_sizes, int n_in, void* d_out, int out_size, void* d_ws, size_t ws_size, hipStream_t stream) {
    static int grid = 0;
    if (grid == 0) {
        if (n_in != 34 || out_size != NROWL * DM || ws_size < WS_END) { fprintf(stderr, "kernel_launch: unexpected shapes (n_in %d out %d ws %zu need %zu)\n", n_in, out_size, ws_size, (size_t)WS_END); grid = -1; return; }
        int dev = 0, cus = 0;
        if (hipGetDevice(&dev) != hipSuccess || hipDeviceGetAttribute(&cus, hipDeviceAttributeMultiprocessorCount, dev) != hipSuccess) { grid = -1; return; }
        if (hipFuncSetAttribute((const void*)trunk_fwd, hipFuncAttributeMaxDynamicSharedMemorySize, LDS_BYTES) != hipSuccess) { fprintf(stderr, "kernel_launch: hipFuncSetAttribute failed\n"); grid = -1; return; }
        int per_cu = 0;
        if (hipOccupancyMaxActiveBlocksPerMultiprocessor(&per_cu, (const void*)trunk_fwd, NTHR, LDS_BYTES) != hipSuccess || per_cu < 1) { fprintf(stderr, "kernel_launch: occupancy query says %d\n", per_cu); }
        (void)hipGetLastError();
        grid = cus;
        if (grid > 256) grid = 256;
        grid &= ~7;
    }
    if (grid <= 0) return;
    (void)hipMemsetAsync((char*)d_ws + WS_BAR, 0, 16384, stream);
    Params p{};
    for (int i = 0; i < 34; ++i) p.in[i] = (const float*)d_in[i];
    p.out = (float*)d_out; p.ws = (unsigned char*)d_ws;
    hipLaunchKernelGGL(trunk_fwd, dim3(grid), dim3(NTHR), LDS_BYTES, stream, p);
}
```

```cpp
#include <hip/hip_runtime.h>
#include <stdint.h>
#include <stdio.h>

typedef unsigned short bf16_t;
typedef short bf16x8 __attribute__((ext_vector_type(8)));
typedef short s16x4 __attribute__((ext_vector_type(4)));
typedef float f32x4 __attribute__((ext_vector_type(4)));
typedef float f32x16 __attribute__((ext_vector_type(16)));
typedef unsigned u32x4 __attribute__((ext_vector_type(4)));
typedef unsigned u32x2 __attribute__((ext_vector_type(2)));
#define LAS __attribute__((address_space(3)))

#define NB 16
#define TL 4096
#define TCX 256
#define DM 1024
#define NROWL 65536
#define NROWC 4096
#define NROW 69632
#define PW 2304
#define INW 3088
#define NEXP 16
#define CAPL 512
#define CAPC 32
#define SLOTS_E 8704
#define NSLOT 139264
#define DEPTH 4
#define NTHR 512
#define LDS_BYTES 155648
#define EPSF 1e-6f
#define LOG2E 1.4426950408889634f

constexpr size_t al256(size_t x) { return (x + 255) & ~size_t(255); }
constexpr size_t WS_BAR   = 0;
constexpr size_t WS_MOD   = al256(WS_BAR + 16384);
constexpr size_t MOD_BYTES = al256((size_t)17 * 6144 * 4);
constexpr size_t WS_HID2L = al256(WS_MOD + 2 * MOD_BYTES);
constexpr size_t WS_HID2C = al256(WS_HID2L + (size_t)4096 * 64 * 4);
constexpr size_t WS_GATES = al256(WS_HID2C + (size_t)256 * 64 * 4);
constexpr size_t WS_AFF   = al256(WS_GATES + (size_t)NROW * 16 * 4);
constexpr size_t WS_SROW  = al256(WS_AFF + (size_t)NROW * 16 * 4);
constexpr size_t WS_SGATE = al256(WS_SROW + (size_t)NSLOT * 4);
constexpr size_t WS_INV   = al256(WS_SGATE + (size_t)NSLOT * 4);
constexpr size_t WS_MLS   = al256(WS_INV + (size_t)NROW * 16 * 4);
constexpr size_t WS_FBUF  = al256(WS_MLS + (size_t)128 * 68 * 4 * 4);
constexpr size_t WS_ROPE  = al256(WS_FBUF + (size_t)256 * 8256 * 2);
constexpr size_t WS_CTX   = al256(WS_ROPE + (size_t)64 * 24 * 8);
constexpr size_t WS_U     = al256(WS_CTX + (size_t)NROWC * DM * 4);
constexpr size_t WS_WOUT  = al256(WS_U + (size_t)(NROW + 3072) * DM * 2);
constexpr size_t WS_WGU   = al256(WS_WOUT + (size_t)DM * DM * 2);
constexpr size_t WS_WD    = al256(WS_WGU + (size_t)NEXP * 2048 * DM * 2);
constexpr size_t WS_P     = al256(WS_WD + (size_t)NEXP * DM * DM * 2);
constexpr size_t WS_UT    = al256(WS_P + (size_t)NROW * PW * 2);
constexpr size_t WS_XE    = al256(WS_UT + (size_t)768 * NROW * 2);
constexpr size_t WS_XB    = al256(WS_XE + (size_t)NSLOT * DM * 2);
constexpr size_t WS_END   = al256(WS_XB + (size_t)NROW * DM * 2);
constexpr size_t WS_HID   = WS_P;
constexpr size_t WS_MLA   = WS_XE;
constexpr size_t WS_MLN   = al256(WS_MLA + (size_t)128 * 68 * 4096 * 2);
constexpr size_t WS_YT    = al256(WS_MLN + (size_t)128 * 68 * 64 * 4);
static_assert(WS_YT + (size_t)256 * NROW * 2 <= WS_XB, "alias overflow");
static_assert((size_t)NSLOT * DM * 2 <= (size_t)NROW * PW * 2, "hid alias overflow");

struct Params {
    const float* in[34];
    float* out;
    unsigned char* ws;
};
enum { I_X = 0, I_C, I_CTX, I_CCTX, I_WADA, I_BADA, I_N1G, I_N2G, I_WIN, I_BGATE, I_AQN, I_AKN, I_ASINK, I_HYCONV, I_FW1, I_FB1, I_FREQ, I_FW2, I_FB2, I_FW3,
       I_HYBIAS, I_MLNORM, I_DQN, I_DKN, I_LQ1, I_LK1, I_LQ2, I_LK2, I_DSUB, I_WOUT, I_WROUTER, I_WEG, I_WEU, I_WED };

__device__ __forceinline__ int my_tid() { int t = threadIdx.x; asm volatile("" : "+v"(t)); return t; }
#define GAS __attribute__((address_space(1)))
__device__ __forceinline__ unsigned char* launder_ws(unsigned char* q) { GAS unsigned char* g = (GAS unsigned char*)q; asm volatile("" : "+s"(g)); return (unsigned char*)g; }
#define CAS __attribute__((address_space(4)))
__device__ __forceinline__ const float* pin_ptr(int i) { const CAS char* ka = (const CAS char*)__builtin_amdgcn_kernarg_segment_ptr(); asm volatile("" : "+s"(ka));
    const GAS float* g = *(const GAS float* const CAS*)(ka + 8 * i); return (const float*)g; }
#define PIN(i) pin_ptr(i)
#define POUT() ((float*)pin_ptr(34))
__device__ __forceinline__ float bf2f(bf16_t v) { return __uint_as_float((unsigned)v << 16); }
__device__ __forceinline__ bf16_t f2bf(float f) { unsigned u = __float_as_uint(f); u += 0x7fffu + ((u >> 16) & 1u); return (bf16_t)(u >> 16); }
__device__ __forceinline__ unsigned pack_bf16(float lo, float hi) { return (unsigned)f2bf(lo) | ((unsigned)f2bf(hi) << 16); }
__device__ __forceinline__ float bflo(unsigned w) { return __uint_as_float(w << 16); }
__device__ __forceinline__ float bfhi(unsigned w) { return __uint_as_float(w & 0xffff0000u); }
template <int CTRL> __device__ __forceinline__ float dpp_get(float v) { return __int_as_float(__builtin_amdgcn_update_dpp(0, __float_as_int(v), CTRL, 0xf, 0xf, true)); }
#define DPP_XOR1 0xB1
#define DPP_XOR2 0x4E
#define DPP_HMIRROR 0x141
#define DPP_MIRROR 0x140
#define DPP_ROR8 0x128
__device__ __forceinline__ float wave_sum(float v) {
    v += dpp_get<DPP_XOR1>(v); v += dpp_get<DPP_XOR2>(v); v += dpp_get<DPP_HMIRROR>(v); v += dpp_get<DPP_MIRROR>(v);
    const int iv = __float_as_int(v);
    return (__int_as_float(__builtin_amdgcn_readlane(iv, 0)) + __int_as_float(__builtin_amdgcn_readlane(iv, 16))) + (__int_as_float(__builtin_amdgcn_readlane(iv, 32)) + __int_as_float(__builtin_amdgcn_readlane(iv, 48)));
}
__device__ __forceinline__ float wave_max(float v) {
    v = fmaxf(v, dpp_get<DPP_XOR1>(v)); v = fmaxf(v, dpp_get<DPP_XOR2>(v)); v = fmaxf(v, dpp_get<DPP_HMIRROR>(v)); v = fmaxf(v, dpp_get<DPP_MIRROR>(v));
    const int iv = __float_as_int(v);
    return fmaxf(fmaxf(__int_as_float(__builtin_amdgcn_readlane(iv, 0)), __int_as_float(__builtin_amdgcn_readlane(iv, 16))), fmaxf(__int_as_float(__builtin_amdgcn_readlane(iv, 32)), __int_as_float(__builtin_amdgcn_readlane(iv, 48))));
}
__device__ __forceinline__ float lane_xor16(float v, int lane) { const auto r = __builtin_amdgcn_permlane16_swap(__float_as_uint(v), __float_as_uint(v), false, false); return __uint_as_float((lane & 16) ? r[0] : r[1]); }
__device__ __forceinline__ float lane_xor32(float v, int lane) { const auto r = __builtin_amdgcn_permlane32_swap(__float_as_uint(v), __float_as_uint(v), false, false); return __uint_as_float((lane & 32) ? r[0] : r[1]); }
__device__ __forceinline__ float reduce16_transpose(const float (&part)[16], int lane) {
    float v8[8], v4[4], v2[2], v1;
#pragma unroll
    for (int j = 0; j < 8; ++j) { const auto r = __builtin_amdgcn_permlane32_swap(__float_as_uint(part[j]), __float_as_uint(part[8 + j]), false, false); v8[j] = __uint_as_float(r[0]) + __uint_as_float(r[1]); }
#pragma unroll
    for (int j = 0; j < 4; ++j) { const auto r = __builtin_amdgcn_permlane16_swap(__float_as_uint(v8[j]), __float_as_uint(v8[4 + j]), false, false); v4[j] = __uint_as_float(r[0]) + __uint_as_float(r[1]); }
    { const bool up = (lane & 8) != 0;
#pragma unroll
      for (int j = 0; j < 2; ++j) { const float send = up ? v4[j] : v4[2 + j], keep = up ? v4[2 + j] : v4[j]; v2[j] = keep + dpp_get<DPP_ROR8>(send); } }
    { const bool up = (lane & 4) != 0; const float send = up ? v2[0] : v2[1], keep = up ? v2[1] : v2[0]; v1 = keep + dpp_get<DPP_HMIRROR>(send); }
    v1 += dpp_get<DPP_XOR2>(v1); v1 += dpp_get<DPP_XOR1>(v1);
    return v1;
}
__device__ __forceinline__ float fast_exp2(float x) { return __builtin_amdgcn_exp2f(x); }
__device__ __forceinline__ float log_sigmoid(float x) { return fminf(x, 0.f) - log1pf(expf(-fabsf(x))); }

#define XB_TMO      128
#define XB_XCNT(j)  (256  + 64 * (j))
#define XB_XSUB(j)  (1280 + 64 * (j))
#define XB_XGEN(j)  (2304 + 64 * (j))
#define XB_TOP      3328
#define XB_TOPGEN   3392
#define XCD_BAR_WORDS 3456
#define XB_SPIN_CAP (1u << 22)

__device__ __forceinline__ unsigned xb_ld(unsigned* p)              { return __hip_atomic_load(p, __ATOMIC_RELAXED, __HIP_MEMORY_SCOPE_AGENT); }
__device__ __forceinline__ unsigned xb_add(unsigned* p, unsigned v) { return __hip_atomic_fetch_add(p, v, __ATOMIC_RELAXED, __HIP_MEMORY_SCOPE_AGENT); }
__device__ __forceinline__ unsigned xb_xcc_id() { return (unsigned)__builtin_amdgcn_s_getreg((3 << 11) | 20) & 0xFu; }
#define XB_SPIN(cond, bar) do { unsigned _sp = 0; while (cond) { __builtin_amdgcn_s_sleep(1); \
    if ((++_sp & 255u) == 0u) { if (xb_ld(&(bar)[XB_TMO])) break; if (_sp > XB_SPIN_CAP) { atomicAdd(&(bar)[XB_TMO], 1u); break; } } } } while (0)

struct XcdBarrier { unsigned* bar; unsigned x; volatile LAS unsigned* st; };

__device__ __forceinline__ XcdBarrier xcd_barrier_post(unsigned* bar, volatile LAS unsigned* st) {
    XcdBarrier b; b.bar = bar; b.x = xb_xcc_id(); b.st = st;
    if (threadIdx.x == 0) (void)xb_add(&bar[XB_XCNT(b.x)], 1u);
    return b;
}
__device__ __forceinline__ void xcd_barrier_complete(unsigned* bar, unsigned x, unsigned& nloc, unsigned& nx) {
    const unsigned G = gridDim.x * gridDim.y * gridDim.z;
    unsigned sum, cnt, mine, sp = 0u;
    for (;;) {
        sum = 0u; cnt = 0u; mine = 0u;
#pragma unroll
        for (unsigned j = 0; j < 16; ++j) { const unsigned c = xb_ld(&bar[XB_XCNT(j)]); sum += c; cnt += (c > 0u) ? 1u : 0u; mine = (j == x) ? c : mine; }
        if (sum == G) break;
        __builtin_amdgcn_s_sleep(1);
        if ((++sp & 255u) == 0u) { if (xb_ld(&bar[XB_TMO])) break; if (sp > XB_SPIN_CAP) { atomicAdd(&bar[XB_TMO], 1u); break; } }
    }
    nloc = mine > 0u ? mine : 1u; nx = cnt > 0u ? cnt : 1u;
}
__device__ __forceinline__ void xcd_barrier(const XcdBarrier& b) {
    asm volatile("s_waitcnt vmcnt(0)" ::: "memory");
    __syncthreads();
    if (threadIdx.x == 0) {
        unsigned* bar = b.bar;
        __builtin_amdgcn_s_waitcnt(0);
        unsigned nloc = b.st[0], nx = b.st[1];
        if (nloc == 0u) { xcd_barrier_complete(bar, b.x, nloc, nx); b.st[0] = nloc; b.st[1] = nx; }
        const unsigned old = xb_add(&bar[XB_XSUB(b.x)], 1u);
        const unsigned gen = old / nloc;
        if (old + 1u == (gen + 1u) * nloc) {
            __builtin_amdgcn_fence(__ATOMIC_RELEASE, "agent");
            asm volatile("s_waitcnt vmcnt(0)" ::: "memory");
            const unsigned og = xb_add(&bar[XB_TOP], 1u);
            const unsigned tg = og / nx;
            if (og + 1u == (tg + 1u) * nx) xb_add(&bar[XB_TOPGEN], 1u);
            else XB_SPIN(xb_ld(&bar[XB_TOPGEN]) == tg, bar);
            __builtin_amdgcn_fence(__ATOMIC_ACQUIRE, "agent");
            xb_add(&bar[XB_XGEN(b.x)], 1u);
            asm volatile("s_waitcnt vmcnt(0)" ::: "memory");
        } else {
            XB_SPIN(xb_ld(&bar[XB_XGEN(b.x)]) == gen, bar);
            __builtin_amdgcn_fence(__ATOMIC_ACQUIRE, "agent");
            asm volatile("s_waitcnt vmcnt(0)" ::: "memory");
        }
    }
    __syncthreads();
}

namespace pg8 {
constexpr int BM = 256, BK = 64, HALF = 128, HTB = HALF * BK * 2, STAGE_BYTES = 8 * HTB, NXCD = 8, WGM = 8;
__host__ __device__ __forceinline__ int lds_byte(int r, int c) { const int st = (r >> 4) * 2 + (c >> 5), rr = r & 15, cc = c & 31, ob = rr * 64 + cc * 2; return st * 1024 + (ob ^ (((ob >> 9) & 1) << 5)); }
__host__ __device__ __forceinline__ void stage_rc(int b, int& R, int& C) { const int st = b / 1024, sb = b % 1024, swz = sb ^ (((sb >> 9) & 1) << 5); R = (st >> 1) * 16 + swz / 64; C = (st & 1) * 32 + (swz % 64) / 2; }
__host__ __device__ __forceinline__ int perm32(int rho) { const int n = rho >> 4, i = rho & 15; return 8 * (i >> 2) + 4 * n + (i & 3); }
struct Unit { int pm, pn; };
struct Gemm { const bf16_t* A; const bf16_t* Bt; int M, N, K; };
__device__ __forceinline__ unsigned cvt_pk_bf16(float lo, float hi) { unsigned r; asm volatile("v_cvt_pk_bf16_f32 %0, %1, %2" : "=v"(r) : "v"(lo), "v"(hi)); return r; }

__device__ __forceinline__ void static_unit(int L, int nM, int nN, int& pm, int& pn) {
    const int nwg = nM * nN; int wgid = L;
    { const int q = nwg / NXCD, r = nwg % NXCD, xcd = wgid % NXCD, off = wgid / NXCD; wgid = (xcd < r ? xcd * (q + 1) : r * (q + 1) + (xcd - r) * q) + off; }
    const int nig = WGM * nN, gid = wgid / nig, fm = gid * WGM, gsz = (nM - fm) < WGM ? (nM - fm) : WGM;
    pm = fm + ((wgid % nig) % gsz); pn = (wgid % nig) / gsz;
}

template <class Epi, class Sched>
__device__ __forceinline__ void gemm_phase(LAS unsigned char* lds, const Gemm g, const Sched& S, const Epi& E) {
    const int tid = my_tid(), wid = __builtin_amdgcn_readfirstlane(tid >> 6), lane = tid & 63, wr = wid >> 2, wc = wid & 3, fr = lane & 15, fq = lane >> 4;
    const int K = g.K, nt = K / BK;
    unsigned voffA[2], voffB[2];
#pragma unroll
    for (int i = 0; i < 2; ++i) { int R, C; stage_rc(tid * 16 + i * 8192, R, C); const int Rb = Epi::PERM ? ((R & ~31) + perm32(R & 31)) : R;
        voffA[i] = (unsigned)(R * K + C) * 2u; voffB[i] = (unsigned)(Rb * K + C) * 2u; }
    const size_t kstep = (size_t)(BK * 2);
    const size_t hstep = (size_t)HALF * K * 2;
    const size_t tstep = 2 * hstep;
    const unsigned ldsw = (unsigned)wid * 1024u;
    const int aoff = lds_byte(wr * 64 + fr, fq * 8), boff = lds_byte(wc * 32 + fr, fq * 8);
#define PG8_SA(b, h) (((b) * 2 + (h)) * HTB)
#define PG8_SB(b, h) ((4 + (b) * 2 + (h)) * HTB)
#define PG8_STAGE(bufoff, gbase, voff) do { _Pragma("unroll") for (int _i = 0; _i < 2; ++_i) \
        __builtin_amdgcn_global_load_lds((const unsigned*)((const char*)(gbase) + (voff)[_i]), (LAS unsigned*)(lds + (bufoff) + ldsw + _i * 8192), 16, 0, 0); } while (0)
#define PG8_LDA(dst, b, h) do { _Pragma("unroll") for (int m = 0; m < 4; ++m) _Pragma("unroll") for (int k = 0; k < 2; ++k) dst[m][k] = *(const LAS bf16x8*)(lds + PG8_SA(b, h) + aoff + m * 2048 + k * 1024); } while (0)
#define PG8_LDB(dst, b, h) do { _Pragma("unroll") for (int n = 0; n < 2; ++n) _Pragma("unroll") for (int k = 0; k < 2; ++k) dst[n][k] = *(const LAS bf16x8*)(lds + PG8_SB(b, h) + boff + n * 2048 + k * 1024); } while (0)
#define PG8_MMA(ai, bj, At, Bt) do { __builtin_amdgcn_s_setprio(1); _Pragma("unroll") for (int m = 0; m < 4; ++m) _Pragma("unroll") for (int n = 0; n < 2; ++n) _Pragma("unroll") for (int k = 0; k < 2; ++k) \
        acc[ai][bj][m][n] = __builtin_amdgcn_mfma_f32_16x16x32_bf16(Bt[n][k], At[m][k], acc[ai][bj][m][n], 0, 0, 0); __builtin_amdgcn_s_setprio(0); } while (0)
#define PG8_WAIT_V(n) asm volatile("s_waitcnt vmcnt(" #n ")" ::: "memory")
#define PG8_WAIT_L(n) asm volatile("s_waitcnt lgkmcnt(" #n ")" ::: "memory")
#define PG8_BAR __builtin_amdgcn_s_barrier()
#define PG8_SCHED __builtin_amdgcn_sched_barrier(0)
    Unit cur, nxt; int ui = 0;
    if (!S.next(0, cur)) return;
    f32x4 acc[2][2][4][2];
#pragma unroll
    for (int a = 0; a < 2; ++a)
#pragma unroll
        for (int b = 0; b < 2; ++b)
#pragma unroll
            for (int m = 0; m < 4; ++m)
#pragma unroll
                for (int n = 0; n < 2; ++n) acc[a][b][m][n] = (f32x4){0.f, 0.f, 0.f, 0.f};
    bf16x8 At[4][2], B0[2][2], B1[2][2];
    const char* cA = (const char*)g.A + (size_t)cur.pm * tstep; const char* cB = (const char*)g.Bt + (size_t)cur.pn * tstep;
    PG8_STAGE(PG8_SB(0, 0), cB, voffB); PG8_STAGE(PG8_SA(0, 0), cA, voffA); PG8_STAGE(PG8_SB(0, 1), cB + hstep, voffB); PG8_STAGE(PG8_SA(0, 1), cA + hstep, voffA);
    if (wr == 1) PG8_BAR;
    PG8_WAIT_V(4); PG8_BAR;
    PG8_STAGE(PG8_SB(1, 0), cB + kstep, voffB); PG8_STAGE(PG8_SA(1, 0), cA + kstep, voffA); PG8_STAGE(PG8_SB(1, 1), cB + hstep + kstep, voffB);
    PG8_WAIT_V(6); PG8_BAR;
    for (;;) {
        const bool has_next = S.next(ui + 1, nxt);
        const char* nA = has_next ? (const char*)g.A + (size_t)nxt.pm * tstep : cA; const char* nB = has_next ? (const char*)g.Bt + (size_t)nxt.pn * tstep : cB;
        for (int t = 0; t < nt; t += 2) {
            const bool last = (t == nt - 2);
            const char* a1 = cA + (size_t)(t + 1) * kstep;
            const char* a2 = last ? nA : cA + (size_t)(t + 2) * kstep; const char* b2 = last ? nB : cB + (size_t)(t + 2) * kstep;
            const char* a3 = a2 + kstep; const char* b3 = b2 + kstep;
            PG8_LDB(B0, 0, 0); PG8_SCHED; PG8_LDA(At, 0, 0); PG8_STAGE(PG8_SA(1, 1), a1 + hstep, voffA);
            PG8_WAIT_L(8); PG8_BAR; PG8_WAIT_L(0); PG8_MMA(0, 0, At, B0); PG8_BAR; PG8_SCHED;
            PG8_LDB(B1, 0, 1); PG8_STAGE(PG8_SB(0, 0), b2, voffB);
            PG8_BAR; PG8_WAIT_L(0); PG8_MMA(0, 1, At, B1); PG8_BAR;
            PG8_LDA(At, 0, 1); PG8_STAGE(PG8_SA(0, 0), a2, voffA);
            PG8_BAR; PG8_WAIT_L(0); PG8_MMA(1, 0, At, B0); PG8_BAR; PG8_SCHED;
            PG8_STAGE(PG8_SB(0, 1), b2 + hstep, voffB);
            PG8_WAIT_V(6); PG8_BAR; PG8_MMA(1, 1, At, B1); PG8_BAR;
            PG8_LDB(B0, 1, 0); PG8_SCHED; PG8_LDA(At, 1, 0); PG8_STAGE(PG8_SA(0, 1), a2 + hstep, voffA);
            PG8_WAIT_L(8); PG8_BAR; PG8_WAIT_L(0); PG8_MMA(0, 0, At, B0); PG8_BAR; PG8_SCHED;
            PG8_LDB(B1, 1, 1); PG8_STAGE(PG8_SB(1, 0), b3, voffB);
            PG8_BAR; PG8_WAIT_L(0); PG8_MMA(0, 1, At, B1); PG8_BAR;
            PG8_LDA(At, 1, 1); PG8_STAGE(PG8_SA(1, 0), a3, voffA);
            PG8_BAR; PG8_WAIT_L(0); PG8_MMA(1, 0, At, B0); PG8_BAR; PG8_SCHED;
            PG8_STAGE(PG8_SB(1, 1), b3 + hstep, voffB);
            PG8_WAIT_V(6); PG8_BAR; PG8_MMA(1, 1, At, B1); PG8_BAR;
        }
#if defined(PROBE_KIND) && PROBE_KIND == 4
        { unsigned t0_ = 0; if (blockIdx.x == 0 && threadIdx.x == 0) t0_ = (unsigned)wall_clock64();
          E(acc, cur, wr, wc, fr, fq);
          if (blockIdx.x == 0 && threadIdx.x == 0) { asm volatile("s_waitcnt vmcnt(0)" ::: "memory"); volatile LAS unsigned* pw_ = (volatile LAS unsigned*)(lds + LDS_BYTES - 48); pw_[2] += (unsigned)wall_clock64() - t0_; } }
#else
        E(acc, cur, wr, wc, fr, fq);
#endif
        if (!has_next) break;
#pragma unroll
        for (int a = 0; a < 2; ++a)
#pragma unroll
            for (int b = 0; b < 2; ++b)
#pragma unroll
                for (int m = 0; m < 4; ++m)
#pragma unroll
                    for (int n = 0; n < 2; ++n) acc[a][b][m][n] = (f32x4){0.f, 0.f, 0.f, 0.f};
        cur = nxt; cA = nA; cB = nB; ++ui;
    }
    PG8_WAIT_V(0);
    if (wr == 0) PG8_BAR;
    PG8_BAR;
#undef PG8_SA
#undef PG8_SB
#undef PG8_STAGE
#undef PG8_LDA
#undef PG8_LDB
#undef PG8_MMA
#undef PG8_WAIT_V
#undef PG8_WAIT_L
#undef PG8_BAR
#undef PG8_SCHED
}
template <class Epi, class Sched>
__device__ __forceinline__ void gemm_phase_gather(LAS unsigned char* lds, const Gemm g, const Sched& S, const Epi& E, const int* __restrict__ srow) {
    const int tid = my_tid(), wid = __builtin_amdgcn_readfirstlane(tid >> 6), lane = tid & 63, wr = wid >> 2, wc = wid & 3, fr = lane & 15, fq = lane >> 4;
    const int K = g.K, nt = K / BK;
    unsigned voffB[2];
#pragma unroll
    for (int i = 0; i < 2; ++i) { int R, C; stage_rc(tid * 16 + i * 8192, R, C); const int Rb = Epi::PERM ? ((R & ~31) + perm32(R & 31)) : R;
        voffB[i] = (unsigned)(Rb * K + C) * 2u; }
    unsigned gcur[2][2], gnxt[2][2];
#define PG8_LOADG(dst, u) do { const int _t = my_tid(); _Pragma("unroll") for (int _i = 0; _i < 2; ++_i) { int _R, _C; stage_rc(_t * 16 + _i * 8192, _R, _C); _Pragma("unroll") for (int _h = 0; _h < 2; ++_h) \
        dst[_h][_i] = (unsigned)srow[(u).pm * 256 + 128 * _h + _R] * (unsigned)(K * 2) + (unsigned)_C * 2u; } } while (0)
#define PG8_STAGEG(bufoff, gofs, kbyte) do { _Pragma("unroll") for (int _i = 0; _i < 2; ++_i) \
        __builtin_amdgcn_global_load_lds((const unsigned*)((const char*)g.A + (gofs)[_i] + (kbyte)), (LAS unsigned*)(lds + (bufoff) + ldsw + _i * 8192), 16, 0, 0); } while (0)
    const size_t kstep = (size_t)(BK * 2);
    const size_t hstep = (size_t)HALF * K * 2;
    const size_t tstep = 2 * hstep;
    const unsigned ldsw = (unsigned)wid * 1024u;
    const int aoff = lds_byte(wr * 64 + fr, fq * 8), boff = lds_byte(wc * 32 + fr, fq * 8);
#define PG8_SA(b, h) (((b) * 2 + (h)) * HTB)
#define PG8_SB(b, h) ((4 + (b) * 2 + (h)) * HTB)
#define PG8_STAGE(bufoff, gbase, voff) do { _Pragma("unroll") for (int _i = 0; _i < 2; ++_i) \
        __builtin_amdgcn_global_load_lds((const unsigned*)((const char*)(gbase) + (voff)[_i]), (LAS unsigned*)(lds + (bufoff) + ldsw + _i * 8192), 16, 0, 0); } while (0)
#define PG8_LDA(dst, b, h) do { _Pragma("unroll") for (int m = 0; m < 4; ++m) _Pragma("unroll") for (int k = 0; k < 2; ++k) dst[m][k] = *(const LAS bf16x8*)(lds + PG8_SA(b, h) + aoff + m * 2048 + k * 1024); } while (0)
#define PG8_LDB(dst, b, h) do { _Pragma("unroll") for (int n = 0; n < 2; ++n) _Pragma("unroll") for (int k = 0; k < 2; ++k) dst[n][k] = *(const LAS bf16x8*)(lds + PG8_SB(b, h) + boff + n * 2048 + k * 1024); } while (0)
#define PG8_MMA(ai, bj, At, Bt) do { __builtin_amdgcn_s_setprio(1); _Pragma("unroll") for (int m = 0; m < 4; ++m) _Pragma("unroll") for (int n = 0; n < 2; ++n) _Pragma("unroll") for (int k = 0; k < 2; ++k) \
        acc[ai][bj][m][n] = __builtin_amdgcn_mfma_f32_16x16x32_bf16(Bt[n][k], At[m][k], acc[ai][bj][m][n], 0, 0, 0); __builtin_amdgcn_s_setprio(0); } while (0)
#define PG8_WAIT_V(n) asm volatile("s_waitcnt vmcnt(" #n ")" ::: "memory")
#define PG8_WAIT_L(n) asm volatile("s_waitcnt lgkmcnt(" #n ")" ::: "memory")
#define PG8_BAR __builtin_amdgcn_s_barrier()
#define PG8_SCHED __builtin_amdgcn_sched_barrier(0)
    Unit cur, nxt; int ui = 0;
    if (!S.next(0, cur)) return;
    f32x4 acc[2][2][4][2];
#pragma unroll
    for (int a = 0; a < 2; ++a)
#pragma unroll
        for (int b = 0; b < 2; ++b)
#pragma unroll
            for (int m = 0; m < 4; ++m)
#pragma unroll
                for (int n = 0; n < 2; ++n) acc[a][b][m][n] = (f32x4){0.f, 0.f, 0.f, 0.f};
    bf16x8 At[4][2], B0[2][2], B1[2][2];
    const char* cB = (const char*)g.Bt + (size_t)cur.pn * tstep;
    PG8_LOADG(gcur, cur);
    PG8_STAGE(PG8_SB(0, 0), cB, voffB); PG8_STAGEG(PG8_SA(0, 0), gcur[0], 0); PG8_STAGE(PG8_SB(0, 1), cB + hstep, voffB); PG8_STAGEG(PG8_SA(0, 1), gcur[1], 0);
    if (wr == 1) PG8_BAR;
    PG8_WAIT_V(4); PG8_BAR;
    PG8_STAGE(PG8_SB(1, 0), cB + kstep, voffB); PG8_STAGEG(PG8_SA(1, 0), gcur[0], kstep); PG8_STAGE(PG8_SB(1, 1), cB + hstep + kstep, voffB);
    PG8_WAIT_V(6); PG8_BAR;
    for (;;) {
        const bool has_next = S.next(ui + 1, nxt);
        const char* nB = has_next ? (const char*)g.Bt + (size_t)nxt.pn * tstep : cB;
        if (has_next) PG8_LOADG(gnxt, nxt); else { gnxt[0][0] = gcur[0][0]; gnxt[0][1] = gcur[0][1]; gnxt[1][0] = gcur[1][0]; gnxt[1][1] = gcur[1][1]; }
        for (int t = 0; t < nt; t += 2) {
            const bool last = (t == nt - 2);
            const size_t k1 = (size_t)(t + 1) * kstep, k2 = last ? 0 : (size_t)(t + 2) * kstep, k3 = k2 + kstep;
            const char* b2 = last ? nB : cB + (size_t)(t + 2) * kstep; const char* b3 = b2 + kstep;
            unsigned g0[2], g1[2];
            g0[0] = last ? gnxt[0][0] : gcur[0][0]; g0[1] = last ? gnxt[0][1] : gcur[0][1]; g1[0] = last ? gnxt[1][0] : gcur[1][0]; g1[1] = last ? gnxt[1][1] : gcur[1][1];
            PG8_LDB(B0, 0, 0); PG8_SCHED; PG8_LDA(At, 0, 0); PG8_STAGEG(PG8_SA(1, 1), gcur[1], k1);
            PG8_WAIT_L(8); PG8_BAR; PG8_WAIT_L(0); PG8_MMA(0, 0, At, B0); PG8_BAR; PG8_SCHED;
            PG8_LDB(B1, 0, 1); PG8_STAGE(PG8_SB(0, 0), b2, voffB);
            PG8_BAR; PG8_WAIT_L(0); PG8_MMA(0, 1, At, B1); PG8_BAR;
            PG8_LDA(At, 0, 1); PG8_STAGEG(PG8_SA(0, 0), g0, k2);
            PG8_BAR; PG8_WAIT_L(0); PG8_MMA(1, 0, At, B0); PG8_BAR; PG8_SCHED;
            PG8_STAGE(PG8_SB(0, 1), b2 + hstep, voffB);
            PG8_WAIT_V(6); PG8_BAR; PG8_MMA(1, 1, At, B1); PG8_BAR;
            PG8_LDB(B0, 1, 0); PG8_SCHED; PG8_LDA(At, 1, 0); PG8_STAGEG(PG8_SA(0, 1), g1, k2);
            PG8_WAIT_L(8); PG8_BAR; PG8_WAIT_L(0); PG8_MMA(0, 0, At, B0); PG8_BAR; PG8_SCHED;
            PG8_LDB(B1, 1, 1); PG8_STAGE(PG8_SB(1, 0), b3, voffB);
            PG8_BAR; PG8_WAIT_L(0); PG8_MMA(0, 1, At, B1); PG8_BAR;
            PG8_LDA(At, 1, 1); PG8_STAGEG(PG8_SA(1, 0), g0, k3);
            PG8_BAR; PG8_WAIT_L(0); PG8_MMA(1, 0, At, B0); PG8_BAR; PG8_SCHED;
            PG8_STAGE(PG8_SB(1, 1), b3 + hstep, voffB);
            PG8_WAIT_V(6); PG8_BAR; PG8_MMA(1, 1, At, B1); PG8_BAR;
        }
#if defined(PROBE_KIND) && PROBE_KIND == 4
        { unsigned t0_ = 0; if (blockIdx.x == 0 && threadIdx.x == 0) t0_ = (unsigned)wall_clock64();
          E(acc, cur, wr, wc, fr, fq);
          if (blockIdx.x == 0 && threadIdx.x == 0) { asm volatile("s_waitcnt vmcnt(0)" ::: "memory"); volatile LAS unsigned* pw_ = (volatile LAS unsigned*)(lds + LDS_BYTES - 48); pw_[2] += (unsigned)wall_clock64() - t0_; } }
#else
        E(acc, cur, wr, wc, fr, fq);
#endif
        if (!has_next) break;
#pragma unroll
        for (int a = 0; a < 2; ++a)
#pragma unroll
            for (int b = 0; b < 2; ++b)
#pragma unroll
                for (int m = 0; m < 4; ++m)
#pragma unroll
                    for (int n = 0; n < 2; ++n) acc[a][b][m][n] = (f32x4){0.f, 0.f, 0.f, 0.f};
        cur = nxt; cB = nB; ++ui;
        gcur[0][0] = gnxt[0][0]; gcur[0][1] = gnxt[0][1]; gcur[1][0] = gnxt[1][0]; gcur[1][1] = gnxt[1][1];
    }
    PG8_WAIT_V(0);
    if (wr == 0) PG8_BAR;
    PG8_BAR;
#undef PG8_LOADG
#undef PG8_STAGEG
#undef PG8_SA
#undef PG8_SB
#undef PG8_STAGE
#undef PG8_LDA
#undef PG8_LDB
#undef PG8_MMA
#undef PG8_WAIT_V
#undef PG8_WAIT_L
#undef PG8_BAR
#undef PG8_SCHED
}
}
using pg8::Unit;
struct InProjOrder { int G, c;
    __device__ __forceinline__ bool next(int i, Unit& u) const {
        const int L = i * G + c; if (L >= 3264) return false;
        int pm, pn;
        if (L < 2448) { pg8::static_unit(L, 272, 9, pm, pn); u.pm = pm; u.pn = 272 + pn; }
        else { pg8::static_unit(L - 2448, 3, 272, pm, pn); u.pm = 281 + pm; u.pn = pn; }
        return true; } };
struct OutProjOrder { int G, c, nM;
    __device__ __forceinline__ bool next(int i, Unit& u) const {
        const int L = i * G + c; if (L >= nM * 4) return false;
        pg8::static_unit(L, nM, 4, u.pm, u.pn); return true; } };
struct GateUpOrder { int G, c, nM;
    __device__ __forceinline__ bool next(int i, Unit& u) const {
        const int per = nM * 8; const int L = i * G + c; if (L >= 16 * per) return false;
        const int e = L / per; int pm, pn; pg8::static_unit(L - e * per, nM, 8, pm, pn); u.pm = e * 34 + pm; u.pn = e * 8 + pn; return true; } };
struct DownOrder { int G, c, nM;
    __device__ __forceinline__ bool next(int i, Unit& u) const {
        const int per = nM * 4; const int L = i * G + c; if (L >= 16 * per) return false;
        const int e = L / per; int pm, pn; pg8::static_unit(L - e * per, nM, 4, pm, pn); u.pm = e * 34 + pm; u.pn = e * 4 + pn; return true; } };

#define EPI_TAB_OFF 131072
struct EpiInProj { static constexpr bool PERM = true; bf16_t* P; bf16_t* UT; const LAS unsigned char* tab;
    __device__ __forceinline__ void operator()(const f32x4 (&acc)[2][2][4][2], const Unit& u, int wr, int wc, int fr, int fq) const {
        bf16_t* base; int ldc, rt, ct;
        if (u.pn >= 272) { base = P; ldc = PW; rt = u.pm; ct = u.pn - 272; } else { base = UT; ldc = NROW; rt = u.pm - 281; ct = u.pn; }
        const int row0 = rt * 256 + wr * 64 + fr, col0 = ct * 256 + wc * 32 + 8 * fq;
        if (u.pn >= 272 && ct < 2) {
            const bool nrm = ct == 0 || wc < 2;
            const int colA = ct * 256 + wc * 64 + 8 * fq;
            const LAS float* gnp = (const LAS float*)(tab + 12288) + (ct == 0 ? 0 : 64) + 8 * fq;
            const float qs = ct == 0 ? 0.125f * LOG2E : 1.0f;
            const bool hi = (fq >> 1) != 0; const int lane_ = fr + 16 * fq;
#pragma unroll
            for (int ai = 0; ai < 2; ++ai)
#pragma unroll
                for (int m = 0; m < 4; ++m) { const int row = row0 + ai * 128 + m * 16; const bool lat = row < NROWL; const int t = row & 4095;
                    bf16_t* rowp = base + (size_t)row * ldc + colA;
                    float inv = 1.0f;
                    if (nrm) { float ss = 0.f;
#pragma unroll
                        for (int bj = 0; bj < 2; ++bj)
#pragma unroll
                            for (int n = 0; n < 2; ++n)
#pragma unroll
                                for (int e = 0; e < 4; ++e) ss += acc[ai][bj][m][n][e] * acc[ai][bj][m][n][e];
                        ss += lane_xor16(ss, lane_); ss += lane_xor32(ss, lane_);
                        inv = rsqrtf(ss * (1.0f / 64.0f) + EPSF); }
#pragma unroll
                    for (int bj = 0; bj < 2; ++bj) { const f32x4 v0 = acc[ai][bj][m][0], v1 = acc[ai][bj][m][1];
                        float o[8] = {v0[0], v0[1], v0[2], v0[3], v1[0], v1[1], v1[2], v1[3]};
                        if (nrm) {
                            const f32x4 ga = *(const LAS f32x4*)(gnp + bj * 32), gb = *(const LAS f32x4*)(gnp + bj * 32 + 4);
                            const float gn[8] = {ga[0], ga[1], ga[2], ga[3], gb[0], gb[1], gb[2], gb[3]};
                            const int pos = bj == 0 ? (t >> 6) : (t & 63);
                            const LAS f32x4* rp = (const LAS f32x4*)(tab + pos * 128 + 64 * (fq & 1));
                            const f32x4 r0 = rp[0], r1 = rp[1], r2 = rp[2], r3 = rp[3];
                            const float cs[8] = {r0[0], r0[2], r1[0], r1[2], r2[0], r2[2], r3[0], r3[2]}, sn[8] = {r0[1], r0[3], r1[1], r1[3], r2[1], r2[3], r3[1], r3[3]};
#pragma unroll
                            for (int i = 0; i < 8; ++i) { const float y = o[i] * inv * gn[i]; const float pr = lane_xor32(y, lane_);
                                o[i] = (lat ? (hi ? y * cs[i] + pr * sn[i] : y * cs[i] - pr * sn[i]) : y) * qs; } }
                        u32x4 w; w.x = pg8::cvt_pk_bf16(o[0], o[1]); w.y = pg8::cvt_pk_bf16(o[2], o[3]); w.z = pg8::cvt_pk_bf16(o[4], o[5]); w.w = pg8::cvt_pk_bf16(o[6], o[7]);
                        *(u32x4*)(rowp + bj * 32) = w; } }
            return;
        }
        if (u.pn >= 272 && (ct == 6 || ct == 7)) {
            const LAS float* gnp = (const LAS float*)(tab + 12288) + (ct == 6 ? 128 : 160) + 8 * fq;
            const f32x4 ga = *(const LAS f32x4*)gnp, gb = *(const LAS f32x4*)(gnp + 4);
            const float gn[8] = {ga[0], ga[1], ga[2], ga[3], gb[0], gb[1], gb[2], gb[3]};
            const float qs = ct == 6 ? 0.17677669529663687f * LOG2E : 1.0f;
            const bool hi = (fq & 1) != 0; const int lane_ = fr + 16 * fq;
#pragma unroll
            for (int ai = 0; ai < 2; ++ai)
#pragma unroll
                for (int m = 0; m < 4; ++m) { const int row = row0 + ai * 128 + m * 16; const bool lat = row < NROWL; const int t = row & 4095;
                    const int pos = (fq >> 1) == 0 ? (t >> 6) : (t & 63);
                    const LAS f32x4* rp = (const LAS f32x4*)(tab + 8192 + pos * 64);
                    const f32x4 r0 = rp[0], r1 = rp[1], r2 = rp[2], r3 = rp[3];
                    const float cs[8] = {r0[0], r0[2], r1[0], r1[2], r2[0], r2[2], r3[0], r3[2]}, sn[8] = {r0[1], r0[3], r1[1], r1[3], r2[1], r2[3], r3[1], r3[3]};
                    bf16_t* rowp = base + (size_t)row * ldc + col0;
#pragma unroll
                    for (int bj = 0; bj < 2; ++bj) { const f32x4 v0 = acc[ai][bj][m][0], v1 = acc[ai][bj][m][1];
                        float x[8] = {v0[0], v0[1], v0[2], v0[3], v1[0], v1[1], v1[2], v1[3]};
                        float ss = 0.f;
#pragma unroll
                        for (int i = 0; i < 8; ++i) ss += x[i] * x[i];
                        ss += lane_xor16(ss, lane_); ss += lane_xor32(ss, lane_);
                        const float inv = rsqrtf(ss * (1.0f / 32.0f) + EPSF);
                        float o[8];
#pragma unroll
                        for (int i = 0; i < 8; ++i) { const float y = x[i] * inv * gn[i]; const float pr = lane_xor16(y, lane_);
                            o[i] = (lat ? (hi ? y * cs[i] + pr * sn[i] : y * cs[i] - pr * sn[i]) : y) * qs; }
                        u32x4 w; w.x = pg8::cvt_pk_bf16(o[0], o[1]); w.y = pg8::cvt_pk_bf16(o[2], o[3]); w.z = pg8::cvt_pk_bf16(o[4], o[5]); w.w = pg8::cvt_pk_bf16(o[6], o[7]);
                        *(u32x4*)(rowp + bj * 128) = w; } }
            return;
        }
#pragma unroll
        for (int ai = 0; ai < 2; ++ai)
#pragma unroll
            for (int m = 0; m < 4; ++m) { bf16_t* rowp = base + (size_t)(row0 + ai * 128 + m * 16) * ldc + col0;
#pragma unroll
                for (int bj = 0; bj < 2; ++bj) { const f32x4 v0 = acc[ai][bj][m][0], v1 = acc[ai][bj][m][1];
                    u32x4 w; w.x = pg8::cvt_pk_bf16(v0[0], v0[1]); w.y = pg8::cvt_pk_bf16(v0[2], v0[3]); w.z = pg8::cvt_pk_bf16(v1[0], v1[1]); w.w = pg8::cvt_pk_bf16(v1[2], v1[3]);
                    *(u32x4*)(rowp + bj * 128) = w; } }
    } };
__device__ __forceinline__ float silu_mul(float g, float u) { return g * u * __builtin_amdgcn_rcpf(1.0f + fast_exp2(-g * LOG2E)); }
struct EpiGU { static constexpr bool PERM = true; bf16_t* HID;
    __device__ __forceinline__ void operator()(const f32x4 (&acc)[2][2][4][2], const Unit& u, int wr, int wc, int fr, int fq) const {
        const int row0 = u.pm * 256 + wr * 64 + fr, col0 = (u.pn & 7) * 128 + wc * 32 + 8 * fq;
#pragma unroll
        for (int ai = 0; ai < 2; ++ai)
#pragma unroll
            for (int m = 0; m < 4; ++m) { bf16_t* rowp = HID + (size_t)(row0 + ai * 128 + m * 16) * DM + col0;
                const f32x4 g0 = acc[ai][0][m][0], g1 = acc[ai][0][m][1], u0 = acc[ai][1][m][0], u1 = acc[ai][1][m][1];
                u32x4 w; w.x = pg8::cvt_pk_bf16(silu_mul(g0[0], u0[0]), silu_mul(g0[1], u0[1])); w.y = pg8::cvt_pk_bf16(silu_mul(g0[2], u0[2]), silu_mul(g0[3], u0[3]));
                w.z = pg8::cvt_pk_bf16(silu_mul(g1[0], u1[0]), silu_mul(g1[1], u1[1])); w.w = pg8::cvt_pk_bf16(silu_mul(g1[2], u1[2]), silu_mul(g1[3], u1[3]));
                *(u32x4*)rowp = w; }
    } };
struct EpiDown { static constexpr bool PERM = true; bf16_t* Y; const float* sgate;
    __device__ __forceinline__ void operator()(const f32x4 (&acc)[2][2][4][2], const Unit& u, int wr, int wc, int fr, int fq) const {
        const int row0 = u.pm * 256 + wr * 64 + fr, col0 = (u.pn & 3) * 256 + wc * 32 + 8 * fq;
#pragma unroll
        for (int ai = 0; ai < 2; ++ai)
#pragma unroll
            for (int m = 0; m < 4; ++m) { const int r = row0 + ai * 128 + m * 16; const float gt = sgate[r]; bf16_t* rowp = Y + (size_t)r * DM + col0;
#pragma unroll
                for (int bj = 0; bj < 2; ++bj) { const f32x4 v0 = acc[ai][bj][m][0] * gt, v1 = acc[ai][bj][m][1] * gt;
                    u32x4 w; w.x = pg8::cvt_pk_bf16(v0[0], v0[1]); w.y = pg8::cvt_pk_bf16(v0[2], v0[3]); w.z = pg8::cvt_pk_bf16(v1[0], v1[1]); w.w = pg8::cvt_pk_bf16(v1[2], v1[3]);
                    *(u32x4*)(rowp + bj * 128) = w; } }
    } };
struct EpiOut { static constexpr bool PERM = true; const float* srcL; const float* srcC; bf16_t* XB; const float* MOD; int first;
    __device__ __forceinline__ void operator()(const f32x4 (&acc)[2][2][4][2], const Unit& u, int wr, int wc, int fr, int fq) const {
        const float* gt = MOD + (size_t)(u.pm < 256 ? (u.pm >> 4) : 16) * 6144 + 2048;
        const int row0 = u.pm * 256 + wr * 64 + fr, col0 = u.pn * 256 + wc * 32 + 8 * fq;
        f32x4 gv[2][2];
#pragma unroll
        for (int bj = 0; bj < 2; ++bj)
#pragma unroll
            for (int n = 0; n < 2; ++n) gv[bj][n] = *(const f32x4*)(gt + col0 + bj * 128 + n * 4);
#pragma unroll
        for (int ai = 0; ai < 2; ++ai)
#pragma unroll
            for (int m = 0; m < 4; ++m) { const int row = row0 + ai * 128 + m * 16;
                bf16_t* xrow = XB + (size_t)row * DM + col0;
                const float* frow = (row < NROWL ? srcL + (size_t)row * DM : srcC + (size_t)(row - NROWL) * DM) + col0;
#pragma unroll
                for (int bj = 0; bj < 2; ++bj) {
                    f32x4 s0, s1;
                    if (first) { s0 = *(const f32x4*)(frow + bj * 128); s1 = *(const f32x4*)(frow + bj * 128 + 4); }
                    else { const u32x4 raw = *(const u32x4*)(xrow + bj * 128);
                        s0 = (f32x4){bflo(raw.x), bfhi(raw.x), bflo(raw.y), bfhi(raw.y)}; s1 = (f32x4){bflo(raw.z), bfhi(raw.z), bflo(raw.w), bfhi(raw.w)}; }
                    const f32x4 v0 = s0 + gv[bj][0] * acc[ai][bj][m][0], v1 = s1 + gv[bj][1] * acc[ai][bj][m][1];
                    u32x4 w; w.x = pg8::cvt_pk_bf16(v0[0], v0[1]); w.y = pg8::cvt_pk_bf16(v0[2], v0[3]); w.z = pg8::cvt_pk_bf16(v1[0], v1[1]); w.w = pg8::cvt_pk_bf16(v1[2], v1[3]);
                    *(u32x4*)(xrow + bj * 128) = w; } }
    } };

__device__ __forceinline__ f32x16 mma32(const bf16_t* A, int lda, const bf16_t* Bt, int ldb, int K, f32x16 acc, int lane) {
    const int r = lane & 31, h = lane >> 5;
    const bf16_t* ap = A + r * lda + 8 * h; const bf16_t* bp = Bt + r * ldb + 8 * h;
    for (int k = 0; k < K; k += 16) {
        const bf16x8 a = *(const bf16x8*)(ap + k); const bf16x8 b = *(const bf16x8*)(bp + k);
        acc = __builtin_amdgcn_mfma_f32_32x32x16_bf16(a, b, acc, 0, 0, 0);
    }
    return acc;
}
#define CROW(reg, lane) (((reg) & 3) + 8 * ((reg) >> 2) + 4 * ((lane) >> 5))
typedef short v4i16_t __attribute__((ext_vector_type(4)));
__device__ __forceinline__ s16x4 tr_read(const LAS unsigned char* ptr) { return __builtin_bit_cast(s16x4, __builtin_amdgcn_ds_read_tr16_b64_v4i16((LAS v4i16_t*)ptr)); }
struct TrDesc { const float* src; bf16_t* dst; int src_ld, src_col0, k0, n0, hi_off; };
__device__ __forceinline__ void tr_load(const TrDesc& d, int t, float4 (&v)[2]) {
#pragma unroll
    for (int p = 0; p < 2; ++p) { const int j = (t >> 4) + 32 * p; v[p] = *(const float4*)(d.src + (size_t)(d.k0 + j) * d.src_ld + d.src_col0 + (t & 15) * 4 + ((t & 8) ? d.hi_off : 0)); }
}
__device__ __forceinline__ void tr_store(unsigned char* smem, const TrDesc& d, int t, const float4 (&v)[2]) {
    float* tile = (float*)smem;
#pragma unroll
    for (int p = 0; p < 2; ++p) { const int j = (t >> 4) + 32 * p; float* q = tile + j * 65 + (t & 15) * 4; q[0] = v[p].x; q[1] = v[p].y; q[2] = v[p].z; q[3] = v[p].w; }
    __syncthreads();
    { const int i = t >> 3, kc = (t & 7) * 8;
      u32x4 w;
      w.x = pack_bf16(tile[(kc + 0) * 65 + i], tile[(kc + 1) * 65 + i]); w.y = pack_bf16(tile[(kc + 2) * 65 + i], tile[(kc + 3) * 65 + i]);
      w.z = pack_bf16(tile[(kc + 4) * 65 + i], tile[(kc + 5) * 65 + i]); w.w = pack_bf16(tile[(kc + 6) * 65 + i], tile[(kc + 7) * 65 + i]);
      *(u32x4*)(d.dst + (size_t)(d.n0 + i) * DM + d.k0 + kc) = w; }
    __syncthreads();
}

template <int PART>
__device__ __forceinline__ void phase_W(const Params& p, int l, unsigned char* smem) {
    unsigned char* ws = launder_ws(p.ws);
    const int tid = my_tid(), G = gridDim.x, bid = blockIdx.x;
    if (PART == 0 && bid == 0) {
        float2* rA = (float2*)(ws + WS_ROPE); float2* rD = rA + 64 * 16;
        for (int idx = tid; idx < 64 * 16; idx += NTHR) { const int pos = idx >> 4, f = idx & 15; const float inv = powf(10000.0f, -(float)f / 16.0f); float sn, cs; sincosf((float)pos * inv, &sn, &cs); rA[idx] = make_float2(cs, sn); }
        for (int idx = tid; idx < 64 * 8; idx += NTHR) { const int pos = idx >> 3, f = idx & 7; const float inv = powf(10000.0f, -(float)f / 8.0f); float sn, cs; sincosf((float)pos * inv, &sn, &cs); rD[idx] = make_float2(cs, sn); }
    }
    if (PART == 0) { int4* inv4 = (int4*)(ws + WS_INV); const int n4 = NROW * 16 / 4;
      for (int i = bid * NTHR + tid; i < n4; i += G * NTHR) inv4[i] = make_int4(-1, -1, -1, -1); }
    const float* w_in = PIN(I_WIN) + (size_t)l * DM * INW;
    const float* w_out = PIN(I_WOUT) + (size_t)l * DM * DM;
    const float* weg = PIN(I_WEG) + (size_t)l * NEXP * DM * DM;
    const float* weu = PIN(I_WEU) + (size_t)l * NEXP * DM * DM;
    const float* wed = PIN(I_WED) + (size_t)l * NEXP * DM * DM;
    bf16_t* WinT = (bf16_t*)(ws + WS_U) + (size_t)NROW * DM;
    bf16_t* WoutT = (bf16_t*)(ws + WS_WOUT);
    bf16_t* WguT = (bf16_t*)(ws + WS_WGU);
    bf16_t* WdT = (bf16_t*)(ws + WS_WD);
    const int N_IN = 768, N_OUT = 256, N_GU = 8192, N_D = 4096, N_ADA = 96, N_HID = 544;
    const int NCVT = N_IN + N_OUT + N_GU + N_D;
    auto tr_desc = [&](int x, TrDesc& d) {
        if (x < N_IN) { const int nt = x >> 4, kt = x & 15, n0 = nt * 64;
            int sc; d.hi_off = 0; if (n0 < 512) { const int b4 = (n0 >> 6) & 3; sc = (n0 & 256) + (b4 & 1) * 128 + (b4 >> 1) * 32; d.hi_off = 32; } else if (n0 < 1536) sc = n0 + 768; else if (n0 < 2304) sc = n0 + 784; else sc = n0 - 1792;
            d.src = w_in; d.src_ld = INW; d.src_col0 = sc; d.k0 = kt * 64; d.dst = WinT; d.n0 = n0; return; }
        x -= N_IN;
        if (x < N_OUT) { const int nt = x >> 4, kt = x & 15; d.hi_off = 0; d.src = w_out; d.src_ld = DM; d.src_col0 = nt * 64; d.k0 = kt * 64; d.dst = WoutT; d.n0 = nt * 64; return; }
        x -= N_OUT;
        if (x < N_GU) { const int e = x >> 9, r = x & 511, nt = r >> 4, kt = r & 15, n0 = nt * 64;
            const int j = n0 >> 8, rr = n0 & 255;
            d.hi_off = 0; d.src = (rr < 128 ? weg : weu) + (size_t)e * DM * DM; d.src_ld = DM; d.src_col0 = j * 128 + (rr & 127); d.k0 = kt * 64; d.dst = WguT + (size_t)e * 2048 * DM; d.n0 = n0; return; }
        x -= N_GU;
        { const int e = x >> 8, r = x & 255, nt = r >> 4, kt = r & 15;
          d.hi_off = 0; d.src = wed + (size_t)e * DM * DM; d.src_ld = DM; d.src_col0 = nt * 64; d.k0 = kt * 64; d.dst = WdT + (size_t)e * DM * DM; d.n0 = nt * 64; }
    };
    if (PART < 2) {
        TrDesc cur, nxt; float4 va[2], vb[2];
        if (bid < NCVT) { tr_desc(bid, cur); tr_load(cur, tid, va); }
        for (int it = bid; it < NCVT; it += G) {
            const bool more = it + G < NCVT;
            if (more) { tr_desc(it + G, nxt); tr_load(nxt, tid, vb); }
            tr_store(smem, cur, tid, va);
            if (more) { cur = nxt; va[0] = vb[0]; va[1] = vb[1]; }
        }
    }
    const int ibeg = (PART == 3) ? N_ADA : 0;
    const int total = (PART == 1) ? 0 : (PART == 2 ? N_ADA : N_ADA + N_HID);
    const int nheavy = (PART == 2) ? G / 4 : (PART == 3 ? G / 2 : 0);
    const int it0 = ibeg + (bid >= nheavy ? bid - nheavy : total), istride = G - nheavy;
    for (int it = it0; it < total; it += istride) {
        int x = it;
        if (x < N_ADA) {
            const int n0 = x * 64;
            float* sv = (float*)smem;
            float* red = sv + 17 * 1024;
            const float* c = PIN(I_C); const float* cc = PIN(I_CCTX);
            for (int idx = tid; idx < 17 * 1024; idx += NTHR) { const int r = idx >> 10, k = idx & 1023; const float v = r < 16 ? c[r * 1024 + k] : cc[k]; sv[idx] = v / (1.0f + expf(-v)); }
            __syncthreads();
            const int w = tid >> 6, lane = tid & 63;
            float acc[17];
#pragma unroll
            for (int r = 0; r < 17; ++r) acc[r] = 0.f;
            const float* wa = PIN(I_WADA) + (size_t)l * DM * 6144 + n0 + lane;
            for (int k0 = 128 * w; k0 < 128 * w + 128; k0 += 32) {
                float wv[32];
#pragma unroll
                for (int u = 0; u < 32; ++u) wv[u] = wa[(size_t)(k0 + u) * 6144];
#pragma unroll
                for (int u = 0; u < 32; ++u)
#pragma unroll
                    for (int r = 0; r < 17; ++r) acc[r] += sv[r * 1024 + k0 + u] * wv[u];
            }
#pragma unroll
            for (int r = 0; r < 17; ++r) red[(w * 17 + r) * 64 + lane] = acc[r];
            __syncthreads();
            float* MOD = (float*)(ws + WS_MOD + (size_t)(l & 1) * MOD_BYTES); const float* ba = PIN(I_BADA) + (size_t)l * 6144;
            for (int idx = tid; idx < 17 * 64; idx += NTHR) { const int r = idx >> 6, j = idx & 63; float s = ba[n0 + j];
#pragma unroll
                for (int ww = 0; ww < 8; ++ww) s += red[(ww * 17 + r) * 64 + j];
                MOD[(size_t)r * 6144 + n0 + j] = s; }
            __syncthreads();
            continue; }
        x -= N_ADA;
        {
            const bool isc = x >= 512; const int L = isc ? 256 : 4096; const int lagbase = (isc ? x - 512 : x) * 8;
            float* zf = (float*)smem;
            float* h1s = zf + 8 * 36;
            const int li = tid >> 6, j = tid & 63, lag = lagbase + li;
            if (j < 33) { float v;
                if (j == 0) v = (float)lag / (float)(L - 1);
                else { const int bi = (j - 1) & 15; const float band = 1e-4f + (float)bi * ((15.0f - 1e-4f) / 15.0f); const float w = 6.283185307179586f * (float)lag / (float)L; const float a = band * w;
                       v = (j <= 16) ? cosf(a) : -sinf(a); }
                zf[li * 36 + j] = v; }
            __syncthreads();
            const float* fw1 = PIN(I_FW1) + (size_t)l * 33 * 64; const float* fb1 = PIN(I_FB1) + l * 64; const float* fr = PIN(I_FREQ) + l * 64;
            const float* fw2 = PIN(I_FW2) + (size_t)l * 64 * 64; const float* fb2 = PIN(I_FB2) + l * 64;
            float a = fb1[j];
#pragma unroll 3
            for (int i = 0; i < 33; ++i) a += zf[li * 36 + i] * fw1[i * 64 + j];
            h1s[li * 64 + j] = sinf(fr[j] * a);
            __syncthreads();
            float a2 = fb2[j];
#pragma unroll 4
            for (int i = 0; i < 64; ++i) a2 += h1s[li * 64 + i] * fw2[i * 64 + j];
            float* H2 = (float*)(ws + (isc ? WS_HID2C : WS_HID2L));
            H2[(size_t)j * L + lag] = sinf(fr[j] * a2);
            __syncthreads();
        }
    }
}

template <int WHICH> struct NmRaw { typedef float4 T; };
template <> struct NmRaw<2> { typedef u32x2 T; };
__device__ __forceinline__ float4 nm_cvt(const float4& v) { return v; }
__device__ __forceinline__ float4 nm_cvt(const u32x2& w) { return make_float4(bflo(w.x), bfhi(w.x), bflo(w.y), bfhi(w.y)); }
template <int WHICH>
__device__ __forceinline__ void phase_norm(const Params& p, int l, unsigned char* smem) {
    unsigned char* ws = launder_ws(p.ws);
    const int tid = my_tid(), lane = tid & 63, wave = tid >> 6;
    float* Wg = (float*)smem;
    for (int idx = tid; idx < 16384; idx += NTHR) { const int k = idx >> 4, j = idx & 15;
        Wg[j * 1024 + k] = (WHICH == 1) ? PIN(I_WIN)[(size_t)l * DM * INW + (size_t)k * INW + 2304 + j] : PIN(I_WROUTER)[(size_t)l * DM * 16 + k * 16 + j]; }
    __syncthreads();
    const float* gain = PIN(WHICH == 1 ? I_N1G : I_N2G) + (size_t)l * DM;
    const float* MOD = (const float*)(ws + WS_MOD + (size_t)(l & 1) * MOD_BYTES);
    bf16_t* U = (bf16_t*)(ws + WS_U);
    float* outv = (float*)(ws + (WHICH == 1 ? WS_GATES : WS_AFF));
    const float* xl = PIN(I_X); const float* xc = PIN(I_CTX);
    const bf16_t* XB = (const bf16_t*)(ws + WS_XB);
    const int rstride = gridDim.x * 8;
    const int nrows = (WHICH == 2 && l == DEPTH - 1) ? NROWL : NROW;
#define NM_LOAD(dst, r) do { if (WHICH == 1) { const float* s_ = (r) < NROWL ? xl + (size_t)(r) * DM : xc + (size_t)((r) - NROWL) * DM; \
            _Pragma("unroll") for (int i = 0; i < 4; ++i) dst[i] = *(const RawT*)(s_ + 256 * i + 4 * lane); } \
        else { const bf16_t* s_ = XB + (size_t)(r) * DM; \
            _Pragma("unroll") for (int i = 0; i < 4; ++i) dst[i] = *(const RawT*)(s_ + 256 * i + 4 * lane); } } while (0)
    typedef typename NmRaw<WHICH>::T RawT;
    const int rbase = 2 * (blockIdx.x * 8 + wave), rstep = 2 * rstride;
    RawT curA[4], curB[4];
    NM_LOAD(curA, rbase); NM_LOAD(curB, rbase + 1);
#pragma unroll 1
    for (int row0 = rbase; row0 < nrows; row0 += rstep) {
        const int rowB = row0 + 1;
        RawT nxtA[4], nxtB[4];
        { const int r2 = row0 + rstep < nrows ? row0 + rstep : row0; NM_LOAD(nxtA, r2); NM_LOAD(nxtB, r2 + 1); }
        const float* mod = MOD + (size_t)(row0 < NROWL ? (row0 >> 12) : 16) * 6144 + (WHICH == 1 ? 0 : 3072);
        float ssA = 0.f, ssB = 0.f;
#pragma unroll
        for (int i = 0; i < 4; ++i) { const float4 a4 = nm_cvt(curA[i]), b4 = nm_cvt(curB[i]);
            ssA += a4.x * a4.x + a4.y * a4.y + a4.z * a4.z + a4.w * a4.w; ssB += b4.x * b4.x + b4.y * b4.y + b4.z * b4.z + b4.w * b4.w; }
        ssA = wave_sum(ssA); ssB = wave_sum(ssB);
        const float invA = rsqrtf(ssA * (1.0f / 1024.0f) + EPSF), invB = rsqrtf(ssB * (1.0f / 1024.0f) + EPSF);
        float partA[16], partB[16];
#pragma unroll
        for (int j = 0; j < 16; ++j) { partA[j] = 0.f; partB[j] = 0.f; }
#pragma unroll
        for (int i = 0; i < 4; ++i) { const int k = 256 * i + 4 * lane;
            float4 g = *(const float4*)(gain + k); const float4 sh = *(const float4*)(mod + k), sc = *(const float4*)(mod + 1024 + k);
            g.x *= 1.f + sc.x; g.y *= 1.f + sc.y; g.z *= 1.f + sc.z; g.w *= 1.f + sc.w;
            const float4 va = nm_cvt(curA[i]), vb = nm_cvt(curB[i]);
            float4 ha, hb;
            ha.x = va.x * invA * g.x + sh.x; ha.y = va.y * invA * g.y + sh.y; ha.z = va.z * invA * g.z + sh.z; ha.w = va.w * invA * g.w + sh.w;
            hb.x = vb.x * invB * g.x + sh.x; hb.y = vb.y * invB * g.y + sh.y; hb.z = vb.z * invB * g.z + sh.z; hb.w = vb.w * invB * g.w + sh.w;
            { u32x2 w; w.x = pack_bf16(ha.x, ha.y); w.y = pack_bf16(ha.z, ha.w); *(u32x2*)(U + (size_t)row0 * DM + k) = w; }
            { u32x2 w; w.x = pack_bf16(hb.x, hb.y); w.y = pack_bf16(hb.z, hb.w); *(u32x2*)(U + (size_t)rowB * DM + k) = w; }
#pragma unroll
            for (int j = 0; j < 8; ++j) { const float4 wv = *(const float4*)(Wg + j * 1024 + k);
                partA[j] += ha.x * wv.x + ha.y * wv.y + ha.z * wv.z + ha.w * wv.w; partB[j] += hb.x * wv.x + hb.y * wv.y + hb.z * wv.z + hb.w * wv.w; }
            asm volatile("" ::: "memory");
#pragma unroll
            for (int j = 8; j < 16; ++j) { const float4 wv = *(const float4*)(Wg + j * 1024 + k);
                partA[j] += ha.x * wv.x + ha.y * wv.y + ha.z * wv.z + ha.w * wv.w; partB[j] += hb.x * wv.x + hb.y * wv.y + hb.z * wv.z + hb.w * wv.w; }
            asm volatile("" ::: "memory"); }
#pragma unroll
        for (int i = 0; i < 4; ++i) { curA[i] = nxtA[i]; curB[i] = nxtB[i]; }
        const int jx = ((lane >> 5) & 1) * 8 + ((lane >> 4) & 1) * 4 + ((lane >> 3) & 1) * 2 + ((lane >> 2) & 1);
        float vA = reduce16_transpose(partA, lane), vB = reduce16_transpose(partB, lane);
        if (WHICH == 2) { const float mxA = wave_max(vA), mxB = wave_max(vB); const float eA = expf(vA - mxA), eB = expf(vB - mxB);
            const float sA = wave_sum(eA) * 0.25f, sB = wave_sum(eB) * 0.25f; vA = eA / sA; vB = eB / sB; }
        if ((lane & 3) == 0) { outv[(size_t)row0 * 16 + jx] = vA; outv[(size_t)rowB * 16 + jx] = vB; }
    }
    __syncthreads();
}

__device__ __forceinline__ void phase_prep(const Params& p, int l, unsigned char* smem) {
    unsigned char* ws = launder_ws(p.ws);
    const int tid = my_tid(), lane = tid & 63, wave = tid >> 6;
    float2* ropeA = (float2*)smem;
    float2* ropeD = ropeA + 64 * 16;
    for (int idx = tid; idx < 64 * 16; idx += NTHR) { const int pos = idx >> 4, f = idx & 15; const float inv = powf(10000.0f, -(float)f / 16.0f); float s, c; sincosf((float)pos * inv, &s, &c); ropeA[idx] = make_float2(c, s); }
    for (int idx = tid; idx < 64 * 8; idx += NTHR) { const int pos = idx >> 3, f = idx & 7; const float inv = powf(10000.0f, -(float)f / 8.0f); float s, c; sincosf((float)pos * inv, &s, &c); ropeD[idx] = make_float2(c, s); }
    __syncthreads();
    bf16_t* P = (bf16_t*)(ws + WS_P);
    const float* aqn = PIN(I_AQN) + l * 64; const float* akn = PIN(I_AKN) + l * 64;
    const float* dqn = PIN(I_DQN) + l * 32; const float* dkn = PIN(I_DKN) + l * 32;
    const int rstride = gridDim.x * 8;
    const int vecA = min(lane >> 3, 5), chA = lane & 7;
    u32x4 rawA;
    { const int row = blockIdx.x * 8 + wave; const bf16_t* pr = P + (size_t)row * PW; rawA = *(const u32x4*)(pr + vecA * 64 + chA * 8); }
    for (int row = blockIdx.x * 8 + wave; row < NROW; row += rstride) {
        const bool lat = row < NROWL; const int t = row & 4095; const int prow = t >> 6, pcol = t & 63;
        bf16_t* pr = P + (size_t)row * PW;
        u32x4 nxtA;
        { const int r2 = row + rstride < NROW ? row + rstride : row; const bf16_t* p2 = P + (size_t)r2 * PW; nxtA = *(const u32x4*)(p2 + vecA * 64 + chA * 8); }
        {
            const int vec = vecA, ch = chA; const bool act = lane < 48;
            bf16_t* ptr = pr + vec * 64 + ch * 8;
            const u32x4 raw = rawA;
            float x[8]; x[0] = bflo(raw.x); x[1] = bfhi(raw.x); x[2] = bflo(raw.y); x[3] = bfhi(raw.y); x[4] = bflo(raw.z); x[5] = bfhi(raw.z); x[6] = bflo(raw.w); x[7] = bfhi(raw.w);
            float ss = 0.f;
#pragma unroll
            for (int i = 0; i < 8; ++i) ss += x[i] * x[i];
            ss += __shfl_xor(ss, 1); ss += __shfl_xor(ss, 2); ss += __shfl_xor(ss, 4);
            const float inv = rsqrtf(ss * (1.0f / 64.0f) + EPSF);
            const float* gn = (vec < 4 ? aqn : akn) + ch * 8;
            const float qs = vec < 4 ? 0.125f * LOG2E : 1.0f;
            const int axis = ch >> 2, half = (ch >> 1) & 1; const int pos = axis == 0 ? prow : pcol;
            float o[8];
#pragma unroll
            for (int i = 0; i < 8; ++i) { const float y = x[i] * inv * gn[i]; const float pr2 = __shfl_xor(y, 2);
                if (lat) { const float2 cs = ropeA[pos * 16 + 8 * (ch & 1) + i]; o[i] = (half == 0 ? y * cs.x - pr2 * cs.y : y * cs.x + pr2 * cs.y) * qs; } else o[i] = y * qs; }
            if (act) { u32x4 w; w.x = pack_bf16(o[0], o[1]); w.y = pack_bf16(o[2], o[3]); w.z = pack_bf16(o[4], o[5]); w.w = pack_bf16(o[6], o[7]); *(u32x4*)ptr = w; }
        }
        rawA = nxtA;
    }
    __syncthreads();
}
__device__ __forceinline__ int block_excl_scan(int v, int* sbuf  , int& total) {
    const int tid = my_tid(), lane = tid & 63, wave = tid >> 6;
    int inc = v;
#pragma unroll
    for (int o = 1; o < 64; o <<= 1) { const int n = __shfl_up(inc, o); if (lane >= o) inc += n; }
    __syncthreads();
    if (lane == 63) sbuf[wave] = inc;
    __syncthreads();
    int pre = 0, tot = 0;
#pragma unroll
    for (int w = 0; w < 8; ++w) { const int s = sbuf[w]; if (w < wave) pre += s; tot += s; }
    total = tot;
    return pre + inc - v;
}

__device__ __forceinline__ void phase_topk(const Params& p, int l, unsigned char* smem) {
    unsigned char* ws = launder_ws(p.ws);
    const int tid = my_tid();
    unsigned* keys = (unsigned*)smem;
    int* hist = (int*)(keys + 4096);
    int* sb = hist + 256;
    int* ctl = sb + 16;
    const float* AFF = (const float*)(ws + WS_AFF);
    int* SROW = (int*)(ws + WS_SROW); float* SGATE = (float*)(ws + WS_SGATE); int* INV = (int*)(ws + WS_INV);
    const int nlists = (l == DEPTH - 1) ? 256 : 512;
    for (int it = blockIdx.x; it < nlists; it += gridDim.x) {
        const int kind = it >> 8, b = (it >> 4) & 15, e = it & 15;
        const int N = kind ? 256 : 4096, K = kind ? CAPC : CAPL;
        const int rowbase = kind ? NROWL + b * 256 : b * 4096;
        const int slotbase = e * SLOTS_E + (kind ? 8192 + b * CAPC : b * CAPL);
        for (int i = tid; i < N; i += NTHR) keys[i] = __float_as_uint(AFF[(size_t)(rowbase + i) * 16 + e]);
        unsigned prefix = 0, mask = 0; int need = K;
        for (int pass = 3; pass >= 0; --pass) {
            const int shift = 8 * pass;
            if (tid < 256) hist[tid] = 0;
            __syncthreads();
            for (int i = tid; i < N; i += NTHR) { const unsigned k = keys[i]; if ((k & mask) == prefix) atomicAdd(&hist[(k >> shift) & 255], 1); }
            __syncthreads();
            if (tid < 64) {
                const int b0 = 255 - 4 * tid; const int h0 = hist[b0], h1 = hist[b0 - 1], h2 = hist[b0 - 2], h3 = hist[b0 - 3];
                const int tot4 = h0 + h1 + h2 + h3; int inc = tot4;
#pragma unroll
                for (int o = 1; o < 64; o <<= 1) { const int n = __shfl_up(inc, o); if (tid >= o) inc += n; }
                const int exc = inc - tot4;
                const bool hit = (exc < need) && (inc >= need);
                if (hit) { int cum = exc, d = b0;
                    if (cum + h0 >= need) d = b0; else { cum += h0; if (cum + h1 >= need) d = b0 - 1; else { cum += h1; if (cum + h2 >= need) d = b0 - 2; else { cum += h2; d = b0 - 3; } } }
                    ctl[0] = d; ctl[1] = need - cum; } }
            __syncthreads();
            prefix |= (unsigned)ctl[0] << shift; mask |= 255u << shift; need = ctl[1];
            __syncthreads();
        }
        const unsigned T = prefix;
        int cg = 0, ce = 0; unsigned k8[8];
#pragma unroll
        for (int j = 0; j < 8; ++j) { const int i = tid * 8 + j; const unsigned k = (i < N) ? keys[i] : 0u; k8[j] = k; cg += (i < N && k > T) ? 1 : 0; ce += (i < N && k == T) ? 1 : 0; }
        int totg, tote;
        int pg = block_excl_scan(cg, sb, totg);
        int pe = block_excl_scan(ce, sb, tote);
#pragma unroll
        for (int j = 0; j < 8; ++j) { const int i = tid * 8 + j; if (i < N) { const unsigned k = k8[j]; int pos = -1;
                if (k > T) pos = pg++; else if (k == T) { if (pe < need) pos = totg + pe; ++pe; }
                if (pos >= 0) { const int s = slotbase + pos; const int row = rowbase + i; SROW[s] = row; SGATE[s] = __uint_as_float(k); INV[(size_t)row * 16 + e] = s; } } }
        __syncthreads();
    }
}

__device__ __forceinline__ void phase_gather(const Params& p) {
    unsigned char* ws = launder_ws(p.ws);
    const int lane = my_tid() & 63, wave = my_tid() >> 6;
    const int* SROW = (const int*)(ws + WS_SROW);
    const bf16_t* U = (const bf16_t*)(ws + WS_U); bf16_t* XE = (bf16_t*)(ws + WS_XE);
    for (int s = blockIdx.x * 8 + wave; s < NSLOT; s += gridDim.x * 8) {
        const int row = SROW[s];
        const u32x4* src = (const u32x4*)(U + (size_t)row * DM); u32x4* dst = (u32x4*)(XE + (size_t)s * DM);
        const u32x4 a = src[lane], b = src[64 + lane];
        dst[lane] = a; dst[64 + lane] = b;
    }
}

template <bool NEXT>
__device__ __forceinline__ void phase_combine(const Params& p, int l, unsigned char* smem) {
    unsigned char* ws = launder_ws(p.ws);
    const int tid = my_tid(), lane = tid & 63, wave = tid >> 6;
    int* INV = (int*)(ws + WS_INV);
    const bf16_t* YS = (const bf16_t*)(ws + WS_XE);
    const float* MODc = (const float*)(ws + WS_MOD + (size_t)(l & 1) * MOD_BYTES);
    const float* MODn = (const float*)(ws + WS_MOD + (size_t)((l + 1) & 1) * MOD_BYTES);
    float* Wg = (float*)smem;
    bf16_t* U = (bf16_t*)(ws + WS_U); float* GT = (float*)(ws + WS_GATES);
    const float* gain = PIN(I_N1G) + (size_t)(NEXT ? l + 1 : 0) * DM;
    if (NEXT) { for (int idx = tid; idx < 16384; idx += NTHR) { const int k = idx >> 4, j = idx & 15; Wg[j * 1024 + k] = PIN(I_WIN)[(size_t)(l + 1) * DM * INW + (size_t)k * INW + 2304 + j]; }
        __syncthreads(); }
    const int rstride = gridDim.x * 8;
    bf16_t* XB = (bf16_t*)(ws + WS_XB); float* outp = POUT();
    const int nrows = NEXT ? NROW : NROWL;
    const int rbase = 2 * (blockIdx.x * 8 + wave), rstep = 2 * rstride;
    int invA, invB; u32x2 xcA[4], xcB[4];
    { invA = INV[(size_t)rbase * 16 + (lane & 15)]; invB = INV[(size_t)(rbase + 1) * 16 + (lane & 15)];
#pragma unroll
      for (int i = 0; i < 4; ++i) { xcA[i] = *(const u32x2*)(XB + (size_t)rbase * DM + 256 * i + 4 * lane); xcB[i] = *(const u32x2*)(XB + (size_t)(rbase + 1) * DM + 256 * i + 4 * lane); } }
#pragma unroll 1
    for (int row0 = rbase; row0 < nrows; row0 += rstep) {
        const int rowB = row0 + 1;
        int ninvA, ninvB; u32x2 xnA[4], xnB[4];
        { const int r2 = row0 + rstep < nrows ? row0 + rstep : row0; ninvA = INV[(size_t)r2 * 16 + (lane & 15)]; ninvB = INV[(size_t)(r2 + 1) * 16 + (lane & 15)];
#pragma unroll
          for (int i = 0; i < 4; ++i) { xnA[i] = *(const u32x2*)(XB + (size_t)r2 * DM + 256 * i + 4 * lane); xnB[i] = *(const u32x2*)(XB + (size_t)(r2 + 1) * DM + 256 * i + 4 * lane); } }
        float accA[16], accB[16];
        unsigned mA = (unsigned)(__ballot(invA >= 0 && lane < 16)) & 0xffffu, mB = (unsigned)(__ballot(invB >= 0 && lane < 16)) & 0xffffu;
        int sA0 = 0, sA1 = 0, sB0 = 0, sB1 = 0; bool hA0 = false, hA1 = false, hB0 = false, hB1 = false;
        if (mA) { const int e0 = __ffs(mA) - 1; mA &= mA - 1; sA0 = __shfl(invA, e0); hA0 = true; if (mA) { const int e1 = __ffs(mA) - 1; mA &= mA - 1; sA1 = __shfl(invA, e1); hA1 = true; } }
        if (mB) { const int e0 = __ffs(mB) - 1; mB &= mB - 1; sB0 = __shfl(invB, e0); hB0 = true; if (mB) { const int e1 = __ffs(mB) - 1; mB &= mB - 1; sB1 = __shfl(invB, e1); hB1 = true; } }
        {   u32x2 wA0[4], wA1[4], wB0[4], wB1[4];
#pragma unroll
            for (int i = 0; i < 4; ++i) { wA0[i] = *(const u32x2*)(YS + (size_t)sA0 * DM + 256 * i + 4 * lane); wA1[i] = *(const u32x2*)(YS + (size_t)sA1 * DM + 256 * i + 4 * lane);
                wB0[i] = *(const u32x2*)(YS + (size_t)sB0 * DM + 256 * i + 4 * lane); wB1[i] = *(const u32x2*)(YS + (size_t)sB1 * DM + 256 * i + 4 * lane); }
#pragma unroll
            for (int i = 0; i < 4; ++i) {
                accA[4 * i + 0] = (hA0 ? bflo(wA0[i].x) : 0.f) + (hA1 ? bflo(wA1[i].x) : 0.f); accA[4 * i + 1] = (hA0 ? bfhi(wA0[i].x) : 0.f) + (hA1 ? bfhi(wA1[i].x) : 0.f);
                accA[4 * i + 2] = (hA0 ? bflo(wA0[i].y) : 0.f) + (hA1 ? bflo(wA1[i].y) : 0.f); accA[4 * i + 3] = (hA0 ? bfhi(wA0[i].y) : 0.f) + (hA1 ? bfhi(wA1[i].y) : 0.f);
                accB[4 * i + 0] = (hB0 ? bflo(wB0[i].x) : 0.f) + (hB1 ? bflo(wB1[i].x) : 0.f); accB[4 * i + 1] = (hB0 ? bfhi(wB0[i].x) : 0.f) + (hB1 ? bfhi(wB1[i].x) : 0.f);
                accB[4 * i + 2] = (hB0 ? bflo(wB0[i].y) : 0.f) + (hB1 ? bflo(wB1[i].y) : 0.f); accB[4 * i + 3] = (hB0 ? bfhi(wB0[i].y) : 0.f) + (hB1 ? bfhi(wB1[i].y) : 0.f); } }
        while (mA) { const int e = __ffs(mA) - 1; mA &= mA - 1; const int s2 = __shfl(invA, e);
#pragma unroll
            for (int i = 0; i < 4; ++i) { const u32x2 w = *(const u32x2*)(YS + (size_t)s2 * DM + 256 * i + 4 * lane);
                accA[4 * i + 0] += bflo(w.x); accA[4 * i + 1] += bfhi(w.x); accA[4 * i + 2] += bflo(w.y); accA[4 * i + 3] += bfhi(w.y); } }
        while (mB) { const int e = __ffs(mB) - 1; mB &= mB - 1; const int s2 = __shfl(invB, e);
#pragma unroll
            for (int i = 0; i < 4; ++i) { const u32x2 w = *(const u32x2*)(YS + (size_t)s2 * DM + 256 * i + 4 * lane);
                accB[4 * i + 0] += bflo(w.x); accB[4 * i + 1] += bfhi(w.x); accB[4 * i + 2] += bflo(w.y); accB[4 * i + 3] += bfhi(w.y); } }
        if (lane < 32) INV[(size_t)row0 * 16 + lane] = -1;
        const int mrow = row0 < NROWL ? (row0 >> 12) : 16;
        const float* gt = MODc + (size_t)mrow * 6144 + 5120;
        float ssA = 0.f, ssB = 0.f;
#pragma unroll
        for (int i = 0; i < 4; ++i) { const int k = 256 * i + 4 * lane;
            const float4 g = *(const float4*)(gt + k);
            float4 xa = make_float4(bflo(xcA[i].x), bfhi(xcA[i].x), bflo(xcA[i].y), bfhi(xcA[i].y)), xb = make_float4(bflo(xcB[i].x), bfhi(xcB[i].x), bflo(xcB[i].y), bfhi(xcB[i].y));
            xa.x += g.x * accA[4 * i + 0]; xa.y += g.y * accA[4 * i + 1]; xa.z += g.z * accA[4 * i + 2]; xa.w += g.w * accA[4 * i + 3];
            xb.x += g.x * accB[4 * i + 0]; xb.y += g.y * accB[4 * i + 1]; xb.z += g.z * accB[4 * i + 2]; xb.w += g.w * accB[4 * i + 3];
            if (NEXT) { u32x2 w; w.x = pack_bf16(xa.x, xa.y); w.y = pack_bf16(xa.z, xa.w); *(u32x2*)(XB + (size_t)row0 * DM + k) = w;
                        u32x2 w2; w2.x = pack_bf16(xb.x, xb.y); w2.y = pack_bf16(xb.z, xb.w); *(u32x2*)(XB + (size_t)rowB * DM + k) = w2; }
            else { *(float4*)(outp + (size_t)row0 * DM + k) = xa; *(float4*)(outp + (size_t)rowB * DM + k) = xb; }
            accA[4 * i + 0] = xa.x; accA[4 * i + 1] = xa.y; accA[4 * i + 2] = xa.z; accA[4 * i + 3] = xa.w;
            accB[4 * i + 0] = xb.x; accB[4 * i + 1] = xb.y; accB[4 * i + 2] = xb.z; accB[4 * i + 3] = xb.w;
            ssA += xa.x * xa.x + xa.y * xa.y + xa.z * xa.z + xa.w * xa.w; ssB += xb.x * xb.x + xb.y * xb.y + xb.z * xb.z + xb.w * xb.w; }
        invA = ninvA; invB = ninvB;
#pragma unroll
        for (int i = 0; i < 4; ++i) { xcA[i] = xnA[i]; xcB[i] = xnB[i]; }
        if (NEXT) {
            ssA = wave_sum(ssA); ssB = wave_sum(ssB);
            const float rA = rsqrtf(ssA * (1.0f / 1024.0f) + EPSF), rB = rsqrtf(ssB * (1.0f / 1024.0f) + EPSF);
            const float* mod = MODn + (size_t)mrow * 6144;
            float partA[16], partB[16];
#pragma unroll
            for (int j = 0; j < 16; ++j) { partA[j] = 0.f; partB[j] = 0.f; }
#pragma unroll
            for (int i = 0; i < 4; ++i) { const int k = 256 * i + 4 * lane;
                float4 g = *(const float4*)(gain + k); const float4 sh = *(const float4*)(mod + k), sc = *(const float4*)(mod + 1024 + k);
                g.x *= 1.f + sc.x; g.y *= 1.f + sc.y; g.z *= 1.f + sc.z; g.w *= 1.f + sc.w;
                float4 ha, hb;
                ha.x = accA[4 * i + 0] * rA * g.x + sh.x; ha.y = accA[4 * i + 1] * rA * g.y + sh.y; ha.z = accA[4 * i + 2] * rA * g.z + sh.z; ha.w = accA[4 * i + 3] * rA * g.w + sh.w;
                hb.x = accB[4 * i + 0] * rB * g.x + sh.x; hb.y = accB[4 * i + 1] * rB * g.y + sh.y; hb.z = accB[4 * i + 2] * rB * g.z + sh.z; hb.w = accB[4 * i + 3] * rB * g.w + sh.w;
                { u32x2 w; w.x = pack_bf16(ha.x, ha.y); w.y = pack_bf16(ha.z, ha.w); *(u32x2*)(U + (size_t)row0 * DM + k) = w; }
                { u32x2 w; w.x = pack_bf16(hb.x, hb.y); w.y = pack_bf16(hb.z, hb.w); *(u32x2*)(U + (size_t)rowB * DM + k) = w; }
#pragma unroll
                for (int j = 0; j < 8; ++j) { const float4 wv = *(const float4*)(Wg + j * 1024 + k);
                    partA[j] += ha.x * wv.x + ha.y * wv.y + ha.z * wv.z + ha.w * wv.w; partB[j] += hb.x * wv.x + hb.y * wv.y + hb.z * wv.z + hb.w * wv.w; }
                asm volatile("" ::: "memory");
#pragma unroll
                for (int j = 8; j < 16; ++j) { const float4 wv = *(const float4*)(Wg + j * 1024 + k);
                    partA[j] += ha.x * wv.x + ha.y * wv.y + ha.z * wv.z + ha.w * wv.w; partB[j] += hb.x * wv.x + hb.y * wv.y + hb.z * wv.z + hb.w * wv.w; }
                asm volatile("" ::: "memory"); }
            const float vA = reduce16_transpose(partA, lane), vB = reduce16_transpose(partB, lane);
            const int jx = ((lane >> 5) & 1) * 8 + ((lane >> 4) & 1) * 4 + ((lane >> 3) & 1) * 2 + ((lane >> 2) & 1);
            if ((lane & 3) == 0) { GT[(size_t)row0 * 16 + jx] = vA; GT[(size_t)rowB * 16 + jx] = vB; }
        }
    }
    __syncthreads();
}
struct AttnItem { int qrow0, qpos0, qcol, kcol, vcol, ycol; int nt0, krow0, kpos0, masked; int nt1, krow1; float M2, sink2, lam, postscale; const float* subgain; };
#define FA_LD 72

template <int NC>
__device__ __forceinline__ void fattn_item(const bf16_t* __restrict__ P, bf16_t* __restrict__ Y, const AttnItem& it, unsigned char* smem) {
    constexpr int KS = (NC == 2) ? 2 : 4;
    const int tid = my_tid(), lane = tid & 63, w = tid >> 6, h = lane >> 5, lq = lane & 31;
    bf16_t* Kb = (bf16_t*)smem;
    bf16_t* Vb = Kb + 2 * 64 * FA_LD;
    const LAS unsigned char* vlds = (const LAS unsigned char*)(smem) + 2 * 64 * FA_LD * 2;
    bf16x8 qf[NC][KS];
    { const bf16_t* qp = P + (size_t)(it.qrow0 + 32 * w + lq) * PW + it.qcol + 8 * h;
#pragma unroll
      for (int c = 0; c < NC; ++c)
#pragma unroll
          for (int s = 0; s < KS; ++s) qf[c][s] = *(const bf16x8*)(qp + 32 * c + 16 * s); }
    f32x16 O[NC][2]; float lsum[NC];
#pragma unroll
    for (int c = 0; c < NC; ++c) { lsum[c] = 0.f;
#pragma unroll
        for (int dt = 0; dt < 2; ++dt)
#pragma unroll
            for (int r = 0; r < 16; ++r) O[c][dt][r] = 0.f; }
    const int ntot = it.nt0 + it.nt1;
    const int ldkey = tid >> 3, ldch = tid & 7;
    const int vlane = ((4 * h + ((lane & 15) >> 2)) * FA_LD + 16 * ((lane >> 4) & 1) + 4 * (lane & 3)) * 2;
    u32x4 kreg, vreg;
    { const int krow = it.nt0 > 0 ? it.krow0 : it.krow1; const bf16_t* kp = P + (size_t)(krow + ldkey) * PW;
      kreg = *(const u32x4*)(kp + it.kcol + ldch * 8); vreg = *(const u32x4*)(kp + it.vcol + ldch * 8); }
    __syncthreads();
    *(u32x4*)(Kb + ldkey * FA_LD + ldch * 8) = kreg; *(u32x4*)(Vb + ldkey * FA_LD + ldch * 8) = vreg;
    __syncthreads();
    const int qpos = it.qpos0 + 32 * w + lq;
    for (int kt = 0; kt < ntot; ++kt) {
        const int buf = kt & 1;
        int kpos = 0; bool msk = false;
        if (kt < it.nt0) { kpos = it.kpos0 + 64 * kt; msk = it.masked != 0; }
        if (kt + 1 < ntot) { const int k2 = kt + 1; const int krow = k2 < it.nt0 ? it.krow0 + 64 * k2 : it.krow1 + 64 * (k2 - it.nt0);
            const bf16_t* kp = P + (size_t)(krow + ldkey) * PW; kreg = *(const u32x4*)(kp + it.kcol + ldch * 8); vreg = *(const u32x4*)(kp + it.vcol + ldch * 8); }
        bool skip = false;
        if (msk) { const int q0 = it.qpos0 + 32 * w; skip = (kpos > q0 + 31 + 128) || (kpos + 63 < q0 - 128); }
        if (!skip) {
            const bf16_t* kb = Kb + buf * 64 * FA_LD; const LAS unsigned char* vb = vlds + buf * 64 * FA_LD * 2 + vlane;
#pragma unroll
            for (int sub = 0; sub < 2; ++sub) {
                unsigned pk[NC][2][4];
#pragma unroll
                for (int c = 0; c < NC; ++c) {
                    f32x16 S;
#pragma unroll
                    for (int r = 0; r < 16; ++r) S[r] = -it.M2;
#pragma unroll
                    for (int s = 0; s < KS; ++s) { const bf16x8 a = *(const bf16x8*)(kb + (32 * sub + lq) * FA_LD + 32 * c + 16 * s + 8 * h);
                        S = __builtin_amdgcn_mfma_f32_32x32x16_bf16(a, qf[c][s], S, 0, 0, 0); }
                    float pv[16];
#pragma unroll
                    for (int r = 0; r < 16; ++r) { pv[r] = fast_exp2(S[r]);
                        if (NC == 1) { if (msk) { const int d = qpos - (kpos + 32 * sub + CROW(r, lane)); if (d > 128 || d < -128) pv[r] = 0.f; } } }
#pragma unroll
                    for (int r = 0; r < 16; ++r) lsum[c] += pv[r];
#pragma unroll
                    for (int s = 0; s < 2; ++s)
#pragma unroll
                        for (int jj = 0; jj < 4; ++jj) pk[c][s][jj] = pg8::cvt_pk_bf16(pv[8 * s + 2 * jj], pv[8 * s + 2 * jj + 1]);
                }
#pragma unroll
                for (int s = 0; s < 2; ++s)
#pragma unroll
                    for (int dt = 0; dt < 2; ++dt) {
                        const s16x4 lo = tr_read(vb + (32 * sub + 16 * s) * FA_LD * 2 + 64 * dt), hi = tr_read(vb + (32 * sub + 16 * s + 8) * FA_LD * 2 + 64 * dt);
                        const bf16x8 a = __builtin_shufflevector(lo, hi, 0, 1, 2, 3, 4, 5, 6, 7);
#pragma unroll
                        for (int c = 0; c < NC; ++c) { u32x4 bw; bw.x = pk[c][s][0]; bw.y = pk[c][s][1]; bw.z = pk[c][s][2]; bw.w = pk[c][s][3];
                            O[c][dt] = __builtin_amdgcn_mfma_f32_32x32x16_bf16(a, __builtin_bit_cast(bf16x8, bw), O[c][dt], 0, 0, 0); }
                    }
            }
        }
        if (kt + 1 < ntot) { bf16_t* kd = Kb + (buf ^ 1) * 64 * FA_LD; bf16_t* vd = Vb + (buf ^ 1) * 64 * FA_LD;
            *(u32x4*)(kd + ldkey * FA_LD + ldch * 8) = kreg; *(u32x4*)(vd + ldkey * FA_LD + ldch * 8) = vreg; }
        __syncthreads();
    }
    float linv[NC];
#pragma unroll
    for (int c = 0; c < NC; ++c) { const float l = lsum[c] + __shfl_xor(lsum[c], 32); linv[c] = (NC == 1) ? 1.0f / (l + fast_exp2(it.sink2 - it.M2)) : 1.0f / l; }
    bf16_t* yp = Y + (size_t)(it.qrow0 + 32 * w + lq) * DM + it.ycol + 4 * h;
    if (NC == 1) {
#pragma unroll
        for (int dt = 0; dt < 2; ++dt)
#pragma unroll
            for (int g = 0; g < 4; ++g) { u32x2 wv; wv.x = pg8::cvt_pk_bf16(O[0][dt][4 * g] * linv[0], O[0][dt][4 * g + 1] * linv[0]); wv.y = pg8::cvt_pk_bf16(O[0][dt][4 * g + 2] * linv[0], O[0][dt][4 * g + 3] * linv[0]);
                *(u32x2*)(yp + 32 * dt + 8 * g) = wv; }
    } else {
        const float a1 = it.lam * linv[NC - 1];
        float ss = 0.f;
#pragma unroll
        for (int dt = 0; dt < 2; ++dt)
#pragma unroll
            for (int r = 0; r < 16; ++r) { const float v = O[0][dt][r] * linv[0] - a1 * O[NC - 1][dt][r]; O[0][dt][r] = v; ss += v * v; }
        ss += __shfl_xor(ss, 32);
        const float rinv = rsqrtf(ss * (1.0f / 64.0f) + EPSF) * it.postscale;
        const float* sg = it.subgain + 4 * h;
#pragma unroll
        for (int dt = 0; dt < 2; ++dt)
#pragma unroll
            for (int g = 0; g < 4; ++g) { const float4 gg = *(const float4*)(sg + 32 * dt + 8 * g);
                u32x2 wv; wv.x = pg8::cvt_pk_bf16(O[0][dt][4 * g] * rinv * gg.x, O[0][dt][4 * g + 1] * rinv * gg.y); wv.y = pg8::cvt_pk_bf16(O[0][dt][4 * g + 2] * rinv * gg.z, O[0][dt][4 * g + 3] * rinv * gg.w);
                *(u32x2*)(yp + 32 * dt + 8 * g) = wv; }
    }
}


#define FD_RING 4
__device__ __forceinline__ void fattn_d_item(const bf16_t* __restrict__ P, bf16_t* __restrict__ Y, const AttnItem& it, unsigned char* smem) {
    const int tid = my_tid(), lane = tid & 63, w = tid >> 6, h = lane >> 5, lq = lane & 31;
    bf16_t* ring = (bf16_t*)smem;
    const LAS unsigned char* rlds = (const LAS unsigned char*)smem;
    constexpr int TB = 64 * FA_LD * 2;
    bf16x8 qf[2][2];
    { const bf16_t* qp = P + (size_t)(it.qrow0 + 32 * w + lq) * PW + it.qcol + 8 * h;
#pragma unroll
      for (int c = 0; c < 2; ++c)
#pragma unroll
          for (int s = 0; s < 2; ++s) qf[c][s] = *(const bf16x8*)(qp + 32 * c + 16 * s); }
    f32x16 O[2][2]; float lsum[2] = {0.f, 0.f};
#pragma unroll
    for (int c = 0; c < 2; ++c)
#pragma unroll
        for (int dt = 0; dt < 2; ++dt)
#pragma unroll
            for (int r = 0; r < 16; ++r) O[c][dt][r] = 0.f;
    const int ntot = it.nt0 + it.nt1;
    const int ldkey = tid >> 3, ldch = tid & 7;
    const int vlane = ((4 * h + ((lane & 15) >> 2)) * FA_LD + 16 * ((lane >> 4) & 1) + 4 * (lane & 3)) * 2;
    const int klane = (lq * FA_LD + 8 * h) * 2;
#define FD_TROW(k) ((k) < it.nt0 ? it.krow0 + 64 * (k) : it.krow1 + 64 * ((k) - it.nt0))
#define FD_GLOAD(k) do { const bf16_t* kp_ = P + (size_t)(FD_TROW(k) + ldkey) * PW; kreg = *(const u32x4*)(kp_ + it.kcol + ldch * 8); vreg = *(const u32x4*)(kp_ + it.vcol + ldch * 8); } while (0)
#define FD_LSTORE(k) do { bf16_t* d_ = ring + (size_t)((k) & (FD_RING - 1)) * 2 * 64 * FA_LD + ldkey * FA_LD + ldch * 8; *(u32x4*)d_ = kreg; *(u32x4*)(d_ + 64 * FA_LD) = vreg; } while (0)
    u32x4 kreg, vreg;
    __syncthreads();
    FD_GLOAD(0); FD_LSTORE(0);
    if (ntot > 1) { FD_GLOAD(1); FD_LSTORE(1); }
    __syncthreads();
    f32x16 zero16;
#pragma unroll
    for (int r = 0; r < 16; ++r) zero16[r] = 0.f;
    f32x16 SS[2];
    { const LAS unsigned char* kb = rlds + klane;
      SS[0] = __builtin_amdgcn_mfma_f32_32x32x16_bf16(*(const LAS bf16x8*)(kb), qf[0][0], zero16, 0, 0, 0);
      SS[0] = __builtin_amdgcn_mfma_f32_32x32x16_bf16(*(const LAS bf16x8*)(kb + 32), qf[0][1], SS[0], 0, 0, 0); }
    unsigned pkp[2][4];
#pragma unroll
    for (int s = 0; s < 2; ++s)
#pragma unroll
        for (int j = 0; j < 4; ++j) pkp[s][j] = 0u;
    for (int kt = 0; kt < ntot; ++kt) {
        if (kt + 2 < ntot) FD_GLOAD(kt + 2);
        const LAS unsigned char* cb = rlds + (size_t)(kt & (FD_RING - 1)) * 2 * TB;
        const LAS unsigned char* nb = rlds + (size_t)((kt + 1) & (FD_RING - 1)) * 2 * TB;
        const LAS unsigned char* pb = rlds + (size_t)((kt + FD_RING - 1) & (FD_RING - 1)) * 2 * TB;
#pragma unroll
        for (int u = 0; u < 4; ++u) {
            const int c = u & 1;
            const int nsub = ((u + 1) & 3) >> 1, nc = (u + 1) & 1;
            const int psub = ((u + 3) & 3) >> 1, pc = (u + 3) & 1;
            const LAS unsigned char* ka = ((u < 3) ? cb : nb) + klane + (32 * nsub) * FA_LD * 2 + 64 * nc;
            const LAS unsigned char* va = ((u > 0) ? cb : pb) + TB + vlane + (32 * psub) * FA_LD * 2;
            const bf16x8 kf0 = *(const LAS bf16x8*)(ka), kf1 = *(const LAS bf16x8*)(ka + 32);
            bf16x8 vf[2][2];
#pragma unroll
            for (int s = 0; s < 2; ++s)
#pragma unroll
                for (int dt = 0; dt < 2; ++dt) { const s16x4 lo = tr_read(va + (16 * s) * FA_LD * 2 + 64 * dt), hi = tr_read(va + (16 * s + 8) * FA_LD * 2 + 64 * dt);
                    vf[s][dt] = __builtin_shufflevector(lo, hi, 0, 1, 2, 3, 4, 5, 6, 7); }
            __builtin_amdgcn_sched_barrier(0);
            f32x16& Sc = SS[u & 1]; f32x16& Sn = SS[(u + 1) & 1];
            unsigned pkc[2][4];
#pragma unroll
            for (int s = 0; s < 2; ++s) {
                float pv[8];
#pragma unroll
                for (int j = 0; j < 8; ++j) pv[j] = fast_exp2(Sc[8 * s + j]);
                lsum[c] += ((pv[0] + pv[1]) + (pv[2] + pv[3])) + ((pv[4] + pv[5]) + (pv[6] + pv[7]));
#pragma unroll
                for (int jj = 0; jj < 4; ++jj) pkc[s][jj] = pg8::cvt_pk_bf16(pv[2 * jj], pv[2 * jj + 1]);
            }
            if ((u < 3) || (kt + 1 < ntot)) {
                Sn = __builtin_amdgcn_mfma_f32_32x32x16_bf16(kf0, qf[nc][0], zero16, 0, 0, 0);
                Sn = __builtin_amdgcn_mfma_f32_32x32x16_bf16(kf1, qf[nc][1], Sn, 0, 0, 0); }
            if ((u > 0) || (kt > 0)) {
#pragma unroll
                for (int s = 0; s < 2; ++s) { u32x4 bw; bw.x = pkp[s][0]; bw.y = pkp[s][1]; bw.z = pkp[s][2]; bw.w = pkp[s][3];
#pragma unroll
                    for (int dt = 0; dt < 2; ++dt) O[pc][dt] = __builtin_amdgcn_mfma_f32_32x32x16_bf16(vf[s][dt], __builtin_bit_cast(bf16x8, bw), O[pc][dt], 0, 0, 0); } }
            __builtin_amdgcn_sched_group_barrier(0x2, 5, 0);
#pragma unroll
            for (int g = 0; g < 6; ++g) { __builtin_amdgcn_sched_group_barrier(0x8, 1, 0); __builtin_amdgcn_sched_group_barrier(0x2, 5, 0); }
            __builtin_amdgcn_sched_barrier(0);
#pragma unroll
            for (int s = 0; s < 2; ++s)
#pragma unroll
                for (int j = 0; j < 4; ++j) pkp[s][j] = pkc[s][j];
        }
        if (kt + 2 < ntot) FD_LSTORE(kt + 2);
        __syncthreads();
    }
    { const LAS unsigned char* va = rlds + (size_t)((ntot - 1) & (FD_RING - 1)) * 2 * TB + TB + vlane + 32 * FA_LD * 2;
#pragma unroll
      for (int s = 0; s < 2; ++s) { u32x4 bw; bw.x = pkp[s][0]; bw.y = pkp[s][1]; bw.z = pkp[s][2]; bw.w = pkp[s][3];
#pragma unroll
          for (int dt = 0; dt < 2; ++dt) {
              const s16x4 lo = tr_read(va + (16 * s) * FA_LD * 2 + 64 * dt), hi = tr_read(va + (16 * s + 8) * FA_LD * 2 + 64 * dt);
              const bf16x8 a = __builtin_shufflevector(lo, hi, 0, 1, 2, 3, 4, 5, 6, 7);
              O[1][dt] = __builtin_amdgcn_mfma_f32_32x32x16_bf16(a, __builtin_bit_cast(bf16x8, bw), O[1][dt], 0, 0, 0); } } }
#undef FD_TROW
#undef FD_GLOAD
#undef FD_LSTORE
    float linv[2];
#pragma unroll
    for (int c = 0; c < 2; ++c) { const float l = lsum[c] + __shfl_xor(lsum[c], 32); linv[c] = 1.0f / l; }
    bf16_t* yp = Y + (size_t)(it.qrow0 + 32 * w + lq) * DM + it.ycol + 4 * h;
    const float a1 = it.lam * linv[1];
    float ss = 0.f;
#pragma unroll
    for (int dt = 0; dt < 2; ++dt)
#pragma unroll
        for (int r = 0; r < 16; ++r) { const float v = O[0][dt][r] * linv[0] - a1 * O[1][dt][r]; O[0][dt][r] = v; ss += v * v; }
    ss += __shfl_xor(ss, 32);
    const float rinv = rsqrtf(ss * (1.0f / 64.0f) + EPSF) * it.postscale;
    const float* sg = it.subgain + 4 * h;
#pragma unroll
    for (int dt = 0; dt < 2; ++dt)
#pragma unroll
        for (int g = 0; g < 4; ++g) { const float4 gg = *(const float4*)(sg + 32 * dt + 8 * g);
            u32x2 wv; wv.x = pg8::cvt_pk_bf16(O[0][dt][4 * g] * rinv * gg.x, O[0][dt][4 * g + 1] * rinv * gg.y); wv.y = pg8::cvt_pk_bf16(O[0][dt][4 * g + 2] * rinv * gg.z, O[0][dt][4 * g + 3] * rinv * gg.w);
            *(u32x2*)(yp + 32 * dt + 8 * g) = wv; }
}

__device__ __forceinline__ float max_abs_vec(const float* g, int n) { float m = 0.f; for (int i = 0; i < n; ++i) m = fmaxf(m, fabsf(g[i])); return m; }

__device__ __forceinline__ int attn_item_remap(int x0, int G) {
    if (G != 256 || x0 >= 1024) return x0;
    const int i = x0 >> 8, bid = x0 & 255, xcd = bid & 7, slot = bid >> 3;
    const int bh = i * 16 + xcd * 2 + (slot >> 4), n = slot & 15;
    return bh * 16 + n;
}
__device__ __forceinline__ void phase_attnA(const Params& p, int l, unsigned char* smem) {
    unsigned char* ws = launder_ws(p.ws);
    const bf16_t* P = (const bf16_t*)(ws + WS_P); bf16_t* Y = (bf16_t*)(ws + WS_U);
    const float bound = 8.0f * LOG2E * 1.02f * max_abs_vec(PIN(I_AQN) + l * 64, 64) * max_abs_vec(PIN(I_AKN) + l * 64, 64);
    const int nitems = (l == DEPTH - 1) ? 1024 : 1088;
    const int cshift = (gridDim.x == 256) ? 64 : 0;
    for (int x0 = blockIdx.x; x0 < nitems + cshift; x0 += gridDim.x) {
        if (x0 >= 1024 && x0 < 1024 + cshift) continue;
        const int x = attn_item_remap(x0 >= 1024 ? x0 - cshift : x0, gridDim.x);
        AttnItem it; it.subgain = nullptr; it.lam = 0.f; it.postscale = 1.f;
        int b, h, n;
        if (x < 1024) { b = x >> 6; h = (x >> 4) & 3; n = x & 15;
            const int lo = max(0, 256 * n - 128), hi = min(TL, 256 * n + 384);
            it.qrow0 = b * TL + 256 * n; it.qpos0 = 256 * n; it.nt0 = (hi - lo) >> 6; it.krow0 = b * TL + lo; it.kpos0 = lo; it.masked = 1; }
        else { const int y = x - 1024; b = y >> 2; h = y & 3;
            it.qrow0 = NROWL + b * TCX; it.qpos0 = 0; it.nt0 = 0; it.krow0 = 0; it.kpos0 = 0; it.masked = 0; }
        it.nt1 = 4; it.krow1 = NROWL + b * TCX;
        it.qcol = h * 64; it.kcol = 256 + (h >> 1) * 64; it.vcol = 384 + (h >> 1) * 64; it.ycol = h * 64;
        it.sink2 = PIN(I_ASINK)[l * 4 + h] * LOG2E; it.M2 = fmaxf(bound, it.sink2);
        fattn_item<1>(P, Y, it, smem);
    }
}
__device__ __forceinline__ void phase_attnD(const Params& p, int l, unsigned char* smem) {
    unsigned char* ws = launder_ws(p.ws);
    const bf16_t* P = (const bf16_t*)(ws + WS_P); bf16_t* Y = (bf16_t*)(ws + WS_U);
    const float bound = 5.656854249f * LOG2E * 1.02f * max_abs_vec(PIN(I_DQN) + l * 32, 32) * max_abs_vec(PIN(I_DKN) + l * 32, 32);
    float d1 = 0.f, d2 = 0.f;
    for (int i = 0; i < 32; ++i) { d1 += PIN(I_LQ1)[l * 32 + i] * PIN(I_LK1)[l * 32 + i]; d2 += PIN(I_LQ2)[l * 32 + i] * PIN(I_LK2)[l * 32 + i]; }
    const float lam_init = 0.8f - 0.6f * expf(-0.3f * (float)l);
    const float lam = expf(d1) - expf(d2) + lam_init;
    const int nitems = (l == DEPTH - 1) ? 1024 : 1088;
    for (int x0 = blockIdx.x; x0 < nitems; x0 += gridDim.x) {
        const int x = attn_item_remap(x0, gridDim.x);
        AttnItem it; it.subgain = PIN(I_DSUB) + l * 64; it.lam = lam; it.postscale = 1.0f - lam_init; it.sink2 = 0.f; it.M2 = bound;
        int b, h, n;
        if (x < 1024) { b = x >> 6; h = (x >> 4) & 3; n = x & 15;
            it.qrow0 = b * TL + 256 * n; it.qpos0 = 0; it.nt0 = 64; it.krow0 = b * TL; it.kpos0 = 0; it.masked = 0; }
        else { const int y = x - 1024; b = y >> 2; h = y & 3;
            it.qrow0 = NROWL + b * TCX; it.qpos0 = 0; it.nt0 = 0; it.krow0 = 0; it.kpos0 = 0; it.masked = 0; }
        it.nt1 = 4; it.krow1 = NROWL + b * TCX;
        it.qcol = 1536 + h * 64; it.kcol = 1792 + h * 64; it.vcol = 2048 + h * 64; it.ycol = 768 + h * 64;
        if (bound < 100.0f) fattn_d_item(P, Y, it, smem); else fattn_item<2>(P, Y, it, smem);
    }
}

#define HY_ZROWS 4160
#define HY_FLEN 8256
#define HY_OFF_F (HY_ZROWS * 32)
#define HY_OFF_MISC (HY_OFF_F + HY_FLEN * 2)

__device__ __forceinline__ void hy_kloop(const LAS unsigned char* zs, const LAS bf16_t* fs, int w, int lane, f32x4 (&acc)[4][8]) {
    const int i = lane & 15, q = lane >> 4, qq = (lane & 15) >> 2, pp = lane & 3;
    const LAS bf16_t* ap = fs + (4096 - 512 * w + 8 * q - 8 * i);
    const LAS unsigned char* bp = zs + (8 * q + qq) * 32 + pp * 8;
    bf16x8 an[4];
#pragma unroll
    for (int m = 0; m < 4; ++m) an[m] = *(const LAS bf16x8*)(ap - 128 * m);
#pragma unroll 1
    for (int ks = 0; ks < 129; ++ks) {
        bf16x8 a[4];
#pragma unroll
        for (int m = 0; m < 4; ++m) a[m] = an[m];
#pragma unroll
        for (int m = 0; m < 4; ++m) an[m] = *(const LAS bf16x8*)(ap + 32 * (ks + 1) - 128 * m);
#pragma unroll
        for (int r = 0; r < 8; ++r) {
            const s16x4 lo = tr_read(bp + (32 * ks + r) * 32), hi = tr_read(bp + (32 * ks + r) * 32 + 128);
            const bf16x8 b = __builtin_shufflevector(lo, hi, 0, 1, 2, 3, 4, 5, 6, 7);
#pragma unroll
            for (int m = 0; m < 4; ++m) acc[m][r] = __builtin_amdgcn_mfma_f32_16x16x32_bf16(a[m], b, acc[m][r], 0, 0, 0);
        }
    }
}
#define HYC_OFF_Z 4096
#define HYC_ZROWS 304
#define HYC_OFF_F (HYC_OFF_Z + HYC_ZROWS * 32)
#define HYC_FLEN 576
__device__ __forceinline__ void hy_ckloop(const LAS unsigned char* zs, const LAS bf16_t* fs, int r, int lane, f32x4 (&acc)[2]) {
    const int i = lane & 15, q = lane >> 4, qq = (lane & 15) >> 2, pp = lane & 3;
    const LAS bf16_t* ap = fs + (256 + 8 * q - 8 * i);
    const LAS unsigned char* bp = zs + (8 * q + qq + r) * 32 + pp * 8;
#pragma unroll
    for (int ks = 0; ks < 9; ++ks) {
        const s16x4 lo = tr_read(bp + (32 * ks) * 32), hi = tr_read(bp + (32 * ks) * 32 + 128);
        const bf16x8 b = __builtin_shufflevector(lo, hi, 0, 1, 2, 3, 4, 5, 6, 7);
#pragma unroll
        for (int m = 0; m < 2; ++m) { const bf16x8 a = *(const LAS bf16x8*)(ap + 32 * ks - 128 * m); acc[m] = __builtin_amdgcn_mfma_f32_16x16x32_bf16(a, b, acc[m], 0, 0, 0); }
    }
}
__device__ __forceinline__ float hy_sconv(const bf16_t* u, int t, int T, float c0, float c1, float c2) {
    const int tm = t > 0 ? t - 1 : 0, tp = t < T - 1 ? t + 1 : T - 1;
    const float um = bf2f(u[tm]), u0 = bf2f(u[t]), up = bf2f(u[tp]);
    return (t > 0 ? c0 : 0.f) * um + c1 * u0 + (t < T - 1 ? c2 : 0.f) * up;
}
__device__ __forceinline__ void hy_gate8(const bf16_t* ub  , int t0, float c0, float c1, float c2, float (&g)[8]) {
    const u32x4 raw = *(const u32x4*)ub; const float hl = bf2f(ub[-1]), hr = bf2f(ub[8]);
    float x[10];
    x[0] = t0 > 0 ? hl : 0.f; x[9] = t0 + 8 < 4096 ? hr : 0.f;
    x[1] = bflo(raw.x); x[2] = bfhi(raw.x); x[3] = bflo(raw.y); x[4] = bfhi(raw.y); x[5] = bflo(raw.z); x[6] = bfhi(raw.z); x[7] = bflo(raw.w); x[8] = bfhi(raw.w);
#pragma unroll
    for (int e = 0; e < 8; ++e) g[e] = c0 * x[e] + c1 * x[e + 1] + c2 * x[e + 2];
}
__device__ __forceinline__ float block_sum(float v, float* red  ) {
    v = wave_sum(v);
    __syncthreads();
    if ((my_tid() & 63) == 0) red[my_tid() >> 6] = v;
    __syncthreads();
    float s = 0.f;
#pragma unroll
    for (int w = 0; w < 8; ++w) s += red[w];
    return s;
}

#if defined(PROBE_KIND) && PROBE_KIND == 6
#define HY_STAMP(k) do { if (blockIdx.x == 0 && my_tid() == 0) { volatile unsigned* pw_ = (volatile unsigned*)(smem + LDS_BYTES - 48); const unsigned t_ = (unsigned)wall_clock64(); \
        if ((k) >= 0 && ((PROBE_MASK >> ((k) < 0 ? 0 : (k))) & 1)) pw_[2] += t_ - pw_[5]; pw_[5] = t_; } } while (0)
#else
#define HY_STAMP(k) do {} while (0)
#endif
__device__ __forceinline__ void phase_hyena(const Params& p, int l, unsigned char* smem) {
    unsigned char* ws = launder_ws(p.ws);
    LAS unsigned char* lds = (LAS unsigned char*)smem;
    bf16_t* Zs = (bf16_t*)smem; bf16_t* Fs = (bf16_t*)(smem + HY_OFF_F);
    float* fw3c = (float*)(smem + HY_OFF_MISC);
    float* red = fw3c + 256;
    float* HT = (float*)smem;
    const bf16_t* UT = (const bf16_t*)(ws + WS_UT);
    bf16_t* YT = (bf16_t*)(ws + WS_YT);
    const float* H2L = (const float*)(ws + WS_HID2L); const float* H2C = (const float*)(ws + WS_HID2C);
    const float* fw3 = PIN(I_FW3) + (size_t)l * 64 * 1024;
    const float* cw = PIN(I_HYCONV) + (size_t)l * 3 * 768;
    const float da = logf(1e-2f) / 1.5f, db = logf(1e-2f) / 0.3f;
    for (int c = blockIdx.x; c < 256; c += gridDim.x) {
        const int tid = my_tid(), lane = tid & 63, w = tid >> 6;
        bf16_t* FB = (bf16_t*)(ws + WS_FBUF) + (size_t)c * HY_FLEN;
        const float delta = fabsf(da + (float)c * ((db - da) / 255.0f));
        const float bias0 = PIN(I_HYBIAS)[l * 512 + c], bias1 = PIN(I_HYBIAS)[l * 512 + 256 + c];
        __syncthreads();
        if (tid < 256) fw3c[tid] = fw3[(size_t)(tid & 63) * 1024 + (tid >> 6) * 256 + c];
        __syncthreads();
        HY_STAMP(-1);
        float ss0 = 0.f, ss1 = 0.f;
#pragma unroll 1
        for (int lag = tid; lag < 4096; lag += NTHR) {
            float a0 = 0.f, a1 = 0.f, a2 = 0.f, a3 = 0.f;
            float hv[64];
#pragma unroll
            for (int k = 0; k < 64; ++k) hv[k] = H2L[(size_t)k * 4096 + lag];
#pragma unroll
            for (int k = 0; k < 64; ++k) { const float h = hv[k]; a0 += h * fw3c[k]; a1 += h * fw3c[64 + k]; a2 += h * fw3c[128 + k]; a3 += h * fw3c[192 + k]; }
            const float dec = expf(-((float)lag / 4095.0f) * delta);
            a0 *= dec; a1 *= dec; a2 *= dec; a3 *= dec;
            HT[lag] = a0; HT[4096 + lag] = a1; HT[8192 + lag] = a2; HT[12288 + lag] = a3;
            ss0 += a0 * a0 + (lag >= 1 ? a2 * a2 : 0.f); ss1 += a1 * a1 + (lag >= 1 ? a3 * a3 : 0.f);
        }
        ss0 = block_sum(ss0, red); ss1 = block_sum(ss1, red);
        const float n0 = rsqrtf(ss0 + EPSF), n1 = rsqrtf(ss1 + EPSF);
#pragma unroll 1
        for (int x = tid; x < HY_FLEN; x += NTHR) { const int d = 4128 - x; float f0 = 0.f, f1 = 0.f;
            if (d >= 0 && d <= 4095) { f0 = HT[d] * n0; f1 = HT[4096 + d] * n1; } else if (d < 0 && d >= -4095) { f0 = HT[8192 - d] * n0; f1 = HT[12288 - d] * n1; }
            Fs[x] = f2bf(f0); FB[x] = f2bf(f1); }
        __syncthreads();
        HY_STAMP(0);
        for (int idx = tid; idx < 1024; idx += NTHR) { const int rr = idx >> 4; Zs[(rr < 32 ? rr : 4096 + rr) * 16 + (idx & 15)] = 0; }
        { const bf16_t* u = UT + (size_t)c * NROW; const float v0 = cw[c], v1 = cw[768 + c], v2 = cw[1536 + c];
#pragma unroll 4
          for (int idx = tid; idx < 8192; idx += NTHR) { const int b = idx >> 9, t0 = (idx & 511) * 8;
              float g[8]; hy_gate8(u + b * 4096 + t0, t0, v0, v1, v2, g);
#pragma unroll
              for (int i = 0; i < 8; ++i) Zs[(t0 + i + 32) * 16 + b] = f2bf(g[i]); } }
        __syncthreads();
        HY_STAMP(1);
        f32x4 acc[4][8];
#pragma unroll
        for (int m = 0; m < 4; ++m)
#pragma unroll
            for (int r = 0; r < 8; ++r) acc[m][r] = (f32x4){0.f, 0.f, 0.f, 0.f};
        hy_kloop(lds, (const LAS bf16_t*)(lds + HY_OFF_F), w, lane, acc);
        HY_STAMP(2);
        { int lo = lane, wo = w; asm volatile("" : "+v"(lo), "+v"(wo));
          const float g0 = cw[256 + c], g1 = cw[768 + 256 + c], g2 = cw[1536 + 256 + c];
          const int tb0 = 512 * wo + 32 * (lo >> 4);
          const bf16_t* u1 = UT + (size_t)(256 + c) * NROW + (lo & 15) * 4096 + tb0;
          const bf16_t* zp = Zs + (tb0 + 32) * 16 + (lo & 15);
#pragma unroll
          for (int m = 0; m < 4; ++m)
#pragma unroll
              for (int j = 0; j < 4; ++j) { float g[8]; hy_gate8(u1 + 128 * m + 8 * j, tb0 + 128 * m + 8 * j, g0, g1, g2, g);
#pragma unroll
                  for (int r = 0; r < 8; ++r) { const float z = bf2f(zp[(128 * m + r + 8 * j) * 16]); acc[m][r][j] = g[r] * (acc[m][r][j] + bias0 * z); }
                  asm volatile("" ::: "memory"); } }
        __syncthreads();
        { int lo = lane, wo = w; asm volatile("" : "+v"(lo), "+v"(wo));
          bf16_t* zp = Zs + (512 * wo + 32 * (lo >> 4) + 32) * 16 + (lo & 15);
#pragma unroll
          for (int m = 0; m < 4; ++m)
#pragma unroll
              for (int r = 0; r < 8; ++r) {
#pragma unroll
                  for (int j = 0; j < 4; ++j) zp[(128 * m + r + 8 * j) * 16] = f2bf(acc[m][r][j]);
                  asm volatile("" ::: "memory"); } }
        for (int x = tid; x < HY_FLEN / 8; x += NTHR) ((u32x4*)Fs)[x] = ((const u32x4*)FB)[x];
        __syncthreads();
        HY_STAMP(3);
#pragma unroll
        for (int m = 0; m < 4; ++m)
#pragma unroll
            for (int r = 0; r < 8; ++r) acc[m][r] = (f32x4){0.f, 0.f, 0.f, 0.f};
        hy_kloop(lds, (const LAS bf16_t*)(lds + HY_OFF_F), w, lane, acc);
        HY_STAMP(4);
        { int lo = lane, wo = w; asm volatile("" : "+v"(lo), "+v"(wo));
          const float e0 = cw[512 + c], e1 = cw[768 + 512 + c], e2 = cw[1536 + 512 + c];
          const int tb0 = 512 * wo + 32 * (lo >> 4);
          const bf16_t* u2 = UT + (size_t)(512 + c) * NROW + (lo & 15) * 4096 + tb0;
          bf16_t* yo = YT + (size_t)c * NROW + (lo & 15) * 4096 + tb0;
          const bf16_t* zp = Zs + (tb0 + 32) * 16 + (lo & 15);
#pragma unroll
          for (int m = 0; m < 4; ++m)
#pragma unroll
              for (int j = 0; j < 4; ++j) { float g[8]; hy_gate8(u2 + 128 * m + 8 * j, tb0 + 128 * m + 8 * j, e0, e1, e2, g);
#pragma unroll
                  for (int r = 0; r < 8; ++r) { const float z1 = bf2f(zp[(128 * m + r + 8 * j) * 16]); g[r] = g[r] * (acc[m][r][j] + bias1 * z1); }
                  u32x4 o; o.x = pack_bf16(g[0], g[1]); o.y = pack_bf16(g[2], g[3]); o.z = pack_bf16(g[4], g[5]); o.w = pack_bf16(g[6], g[7]);
                  *(u32x4*)(yo + 128 * m + 8 * j) = o;
                  asm volatile("" ::: "memory"); } }
        __syncthreads();
        HY_STAMP(5);
        if (l < DEPTH - 1) {   float* HTc = (float*)smem;
            bf16_t* Zc = (bf16_t*)(smem + HYC_OFF_Z);
            bf16_t* Fc0 = (bf16_t*)(smem + HYC_OFF_F); bf16_t* Fc1 = Fc0 + HYC_FLEN;
            float* part = (float*)(smem + HYC_OFF_Z);
            float t0 = 0.f, t1 = 0.f;
            { const int lag = tid & 255, kh = tid >> 8; float a0 = 0.f, a1 = 0.f, a2 = 0.f, a3 = 0.f;
              float hv[32];
#pragma unroll
              for (int k = 0; k < 32; ++k) hv[k] = H2C[(size_t)(32 * kh + k) * 256 + lag];
#pragma unroll
              for (int k = 0; k < 32; ++k) { const float h = hv[k]; const int kk = 32 * kh + k; a0 += h * fw3c[kk]; a1 += h * fw3c[64 + kk]; a2 += h * fw3c[128 + kk]; a3 += h * fw3c[192 + kk]; }
              if (kh == 1) { part[lag] = a0; part[256 + lag] = a1; part[512 + lag] = a2; part[768 + lag] = a3; }
              __syncthreads();
              if (kh == 0) { a0 += part[lag]; a1 += part[256 + lag]; a2 += part[512 + lag]; a3 += part[768 + lag];
                const float dec = expf(-((float)lag / 255.0f) * delta);
                a0 *= dec; a1 *= dec; a2 *= dec; a3 *= dec;
                HTc[lag] = a0; HTc[256 + lag] = a1; HTc[512 + lag] = a2; HTc[768 + lag] = a3;
                t0 = a0 * a0 + (lag >= 1 ? a2 * a2 : 0.f); t1 = a1 * a1 + (lag >= 1 ? a3 * a3 : 0.f); } }
            t0 = block_sum(t0, red); t1 = block_sum(t1, red);
            const float m0 = rsqrtf(t0 + EPSF), m1 = rsqrtf(t1 + EPSF);
            for (int x = tid; x < 2 * HYC_FLEN; x += NTHR) { const int o = x >= HYC_FLEN ? 1 : 0, xx = x - o * HYC_FLEN, d = 288 - xx; float f = 0.f;
                if (d >= 0 && d <= 255) f = HTc[256 * o + d]; else if (d < 0 && d >= -255) f = HTc[512 + 256 * o - d];
                Fc0[x] = f2bf(f * (o ? m1 : m0)); }
            { const bf16_t* uc = UT + (size_t)c * NROW + NROWL; const float v0 = cw[c], v1 = cw[768 + c], v2 = cw[1536 + c];
              for (int idx = tid; idx < 768; idx += NTHR) { const int rr = idx >> 4; Zc[(rr < 32 ? rr : 256 + rr) * 16 + (idx & 15)] = 0; }
#pragma unroll 2
              for (int idx = tid; idx < 4096; idx += NTHR) { const int b = idx >> 8, t = idx & 255; Zc[(t + 32) * 16 + b] = f2bf(hy_sconv(uc + b * 256, t, 256, v0, v1, v2)); } }
            __syncthreads();
            f32x4 ca[2];
            ca[0] = (f32x4){0.f, 0.f, 0.f, 0.f}; ca[1] = ca[0];
            hy_ckloop(lds + HYC_OFF_Z, (const LAS bf16_t*)(lds + HYC_OFF_F), w, lane, ca);
            { const float g0 = cw[256 + c], g1 = cw[768 + 256 + c], g2 = cw[1536 + 256 + c];
              const bf16_t* u1c = UT + (size_t)(256 + c) * NROW + NROWL + (lane & 15) * 256;
#pragma unroll
              for (int m = 0; m < 2; ++m)
#pragma unroll
                  for (int j = 0; j < 4; ++j) { const int t = 128 * m + w + 32 * (lane >> 4) + 8 * j;
                      const float z = bf2f(Zc[(t + 32) * 16 + (lane & 15)]);
                      ca[m][j] = hy_sconv(u1c, t, 256, g0, g1, g2) * (ca[m][j] + bias0 * z); } }
            __syncthreads();
#pragma unroll
            for (int m = 0; m < 2; ++m)
#pragma unroll
                for (int j = 0; j < 4; ++j) { const int t = 128 * m + w + 32 * (lane >> 4) + 8 * j; Zc[(t + 32) * 16 + (lane & 15)] = f2bf(ca[m][j]); }
            __syncthreads();
            ca[0] = (f32x4){0.f, 0.f, 0.f, 0.f}; ca[1] = ca[0];
            hy_ckloop(lds + HYC_OFF_Z, (const LAS bf16_t*)(lds + HYC_OFF_F + 2 * HYC_FLEN), w, lane, ca);
            { const float e0 = cw[512 + c], e1 = cw[768 + 512 + c], e2 = cw[1536 + 512 + c];
              const bf16_t* u2c = UT + (size_t)(512 + c) * NROW + NROWL + (lane & 15) * 256;
              bf16_t* yo = YT + (size_t)c * NROW + NROWL + (lane & 15) * 256;
#pragma unroll
              for (int m = 0; m < 2; ++m)
#pragma unroll
                  for (int j = 0; j < 4; ++j) { const int t = 128 * m + w + 32 * (lane >> 4) + 8 * j;
                      const float z1 = bf2f(Zc[(t + 32) * 16 + (lane & 15)]);
                      yo[t] = f2bf(hy_sconv(u2c, t, 256, e0, e1, e2) * (ca[m][j] + bias1 * z1)); } }
            __syncthreads();
        }
        HY_STAMP(6);
    }
}

__device__ __forceinline__ void phase_hy_transpose(const Params& p, int l, unsigned char* smem) {
    unsigned char* ws = launder_ws(p.ws);
    const bf16_t* YT = (const bf16_t*)(ws + WS_YT); bf16_t* Y = (bf16_t*)(ws + WS_U);
    bf16_t* tile = (bf16_t*)smem;
    const int tid = my_tid();
    const int ntile = 4 * ((l == DEPTH - 1 ? NROWL : NROW) / 64);
    for (int it = blockIdx.x; it < ntile; it += gridDim.x) {
        const int ct = it & 3, rt = it >> 2;
        __syncthreads();
        { const int ch = tid >> 3, seg = tid & 7;
          const u32x4 v = *(const u32x4*)(YT + (size_t)(ct * 64 + ch) * NROW + rt * 64 + seg * 8);
          unsigned* d = (unsigned*)(tile + ch * 66 + seg * 8); d[0] = v.x; d[1] = v.y; d[2] = v.z; d[3] = v.w; }
        __syncthreads();
        { const int r = tid >> 3, seg = tid & 7;
          unsigned wv[4];
#pragma unroll
          for (int k = 0; k < 4; ++k) wv[k] = (unsigned)tile[(seg * 8 + 2 * k) * 66 + r] | ((unsigned)tile[(seg * 8 + 2 * k + 1) * 66 + r] << 16);
          u32x4 o; o.x = wv[0]; o.y = wv[1]; o.z = wv[2]; o.w = wv[3];
          *(u32x4*)(Y + (size_t)(rt * 64 + r) * DM + 256 + ct * 64 + seg * 8) = o; }
    }
    __syncthreads();
}
#define ML_ITEMS 4352
__device__ __forceinline__ void ml_decode(int it, int& b, int& head, int& tc, int& tok0, int& jf, int& jb) {
    b = it / 272; const int r = it - b * 272; head = r / 68; tc = r - head * 68;
    tok0 = tc < 4 ? NROWL + b * TCX + 64 * tc : b * TL + 64 * (tc - 4);
    jf = tc; jb = tc < 4 ? 3 - tc : 71 - tc;
}

__device__ __forceinline__ void phase_ml_local(const Params& p, int l, unsigned char* smem) {
    unsigned char* ws = launder_ws(p.ws);
    const int tid = my_tid(), lane = tid & 63, w = tid >> 6;
    bf16_t* Kt = (bf16_t*)smem;
    bf16_t* VwF = Kt + 64 * 72;
    bf16_t* VwB = VwF + 64 * 72;
    float* Vs = (float*)(VwB + 64 * 72);
    float* vec = Vs + 64 * 65;
    float* igf = vec, *igb = vec + 64, *lff = vec + 128, *lfb = vec + 192, *wf = vec + 256, *wb = vec + 320, *scal = vec + 384;
    const bf16_t* P = (const bf16_t*)(ws + WS_P);
    const float* GT = (const float*)(ws + WS_GATES);
    bf16_t* MLA = (bf16_t*)(ws + WS_MLA); float* MLN = (float*)(ws + WS_MLN); float* MLS = (float*)(ws + WS_MLS);
    const float* bg = PIN(I_BGATE) + l * 16;
    for (int it = blockIdx.x; it < ML_ITEMS; it += gridDim.x) {
        int b, head, tc, tok0, jf, jb; ml_decode(it, b, head, tc, tok0, jf, jb);
        __syncthreads();
        { const int s = tid >> 3, ch = tid & 7;
          const bf16_t* pr = P + (size_t)(tok0 + s) * PW + head * 64 + ch * 8;
          const u32x4 kv = *(const u32x4*)(pr + 768), vv = *(const u32x4*)(pr + 1024);
          const unsigned kw[4] = {kv.x, kv.y, kv.z, kv.w}, vw[4] = {vv.x, vv.y, vv.z, vv.w};
#pragma unroll
          for (int i = 0; i < 4; ++i) { Kt[(ch * 8 + 2 * i) * 72 + s] = f2bf(bflo(kw[i]) * 0.125f); Kt[(ch * 8 + 2 * i + 1) * 72 + s] = f2bf(bfhi(kw[i]) * 0.125f);
              Vs[s * 65 + ch * 8 + 2 * i] = bflo(vw[i]); Vs[s * 65 + ch * 8 + 2 * i + 1] = bfhi(vw[i]); } }
        if (tid < 64) { const float* g = GT + (size_t)(tok0 + tid) * 16;
            igf[tid] = g[head] + bg[head]; igb[tid] = g[4 + head] + bg[4 + head]; lff[tid] = log_sigmoid(g[8 + head] + bg[8 + head]); lfb[tid] = log_sigmoid(g[12 + head] + bg[12 + head]); }
        __syncthreads();
        if (tid < 128) {
            const int dirw = tid >> 6, tau = tid & 63, s = dirw ? 63 - tau : tau;
            const float lf = dirw ? lfb[s] : lff[s], ig = dirw ? igb[s] : igf[s];
            float cum = lf;
#pragma unroll
            for (int o = 1; o < 64; o <<= 1) { const float n = __shfl_up(cum, o); if (tau >= o) cum += n; }
            const float B = __shfl(cum, 63);
            const float ge = B - cum + ig;
            const float ml = wave_max(ge);
            (dirw ? wb : wf)[s] = expf(ge - ml);
            if (tau == 0) { scal[2 * dirw] = B; scal[2 * dirw + 1] = ml; } }
        __syncthreads();
        { const int e = tid >> 3, sc = (tid & 7) * 8; u32x4 a, c2; float x[8], y[8];
#pragma unroll
          for (int i = 0; i < 8; ++i) { const float v = Vs[(sc + i) * 65 + e]; x[i] = v * wf[sc + i]; y[i] = v * wb[sc + i]; }
          a.x = pack_bf16(x[0], x[1]); a.y = pack_bf16(x[2], x[3]); a.z = pack_bf16(x[4], x[5]); a.w = pack_bf16(x[6], x[7]);
          c2.x = pack_bf16(y[0], y[1]); c2.y = pack_bf16(y[2], y[3]); c2.z = pack_bf16(y[4], y[5]); c2.w = pack_bf16(y[6], y[7]);
          *(u32x4*)(VwF + e * 72 + sc) = a; *(u32x4*)(VwB + e * 72 + sc) = c2; }
        __syncthreads();
        const int dir = w >> 2, wl = w & 3, te = wl >> 1, tk = wl & 1;
        const int seq = (b * 4 + head) * 2 + dir, j = dir ? jb : jf;
        bf16_t* dst = MLA + ((size_t)seq * 68 + j) * 4096;
        { f32x16 C;
#pragma unroll
          for (int r = 0; r < 16; ++r) C[r] = 0.f;
          C = mma32((dir ? VwB : VwF) + 32 * te * 72, 72, Kt + 32 * tk * 72, 72, 64, C, lane);
#pragma unroll
          for (int r = 0; r < 16; ++r) dst[(32 * te + CROW(r, lane)) * 64 + 32 * tk + (lane & 31)] = f2bf(C[r]); }
        if (wl == 0) {
            const float* wv = dir ? wb : wf; float s = 0.f;
            for (int t = 0; t < 64; ++t) s += wv[t] * bf2f(Kt[lane * 72 + t]);
            MLN[((size_t)seq * 68 + j) * 64 + lane] = s;
            if (lane == 0) { MLS[((size_t)seq * 68 + j) * 4 + 0] = scal[2 * dir]; MLS[((size_t)seq * 68 + j) * 4 + 1] = scal[2 * dir + 1]; }
        }
    }
    __syncthreads();
}

__device__ __forceinline__ void phase_ml_scan(const Params& p) {
    unsigned char* ws = launder_ws(p.ws);
    const int tid = my_tid();
    unsigned* MLA = (unsigned*)(ws + WS_MLA); float* MLN = (float*)(ws + WS_MLN); float* MLS = (float*)(ws + WS_MLS);
    for (int it = blockIdx.x; it < 512; it += gridDim.x) {
        const int seq = it >> 2, part = it & 3;
        unsigned* base = MLA + (size_t)seq * 68 * 2048 + part * 512 + tid;
        float* nb = MLN + (size_t)seq * 68 * 64 + part * 16 + tid;
        float* sc = MLS + (size_t)seq * 68 * 4;
        const bool hasn = tid < 16;
        float m = 0.f, c0 = 0.f, c1 = 0.f, cn = 0.f;
#define ML_SCAN_BATCH(NBATCH, J0) do { unsigned a[NBATCH]; float an[NBATCH], B[NBATCH], ML[NBATCH]; \
            _Pragma("unroll") for (int u = 0; u < NBATCH; ++u) { a[u] = base[(size_t)((J0) + u) * 2048]; an[u] = hasn ? nb[((J0) + u) * 64] : 0.f; B[u] = sc[((J0) + u) * 4]; ML[u] = sc[((J0) + u) * 4 + 1]; } \
            _Pragma("unroll") for (int u = 0; u < NBATCH; ++u) { \
                const float mn = fmaxf(B[u] + m, ML[u]); const float wp = expf(B[u] + m - mn), wa = expf(ML[u] - mn); \
                if (part == 0 && tid == 0) sc[((J0) + u) * 4 + 2] = m; \
                base[(size_t)((J0) + u) * 2048] = pack_bf16(c0, c1); if (hasn) nb[((J0) + u) * 64] = cn; \
                c0 = wp * c0 + wa * bflo(a[u]); c1 = wp * c1 + wa * bfhi(a[u]); cn = wp * cn + wa * an[u]; m = mn; } } while (0)
        for (int j0 = 0; j0 < 64; j0 += 8) ML_SCAN_BATCH(8, j0);
        ML_SCAN_BATCH(4, 64);
#undef ML_SCAN_BATCH
    }
}

__device__ __forceinline__ void phase_ml_out(const Params& p, int l, unsigned char* smem) {
    unsigned char* ws = launder_ws(p.ws);
    const int tid = my_tid(), lane = tid & 63, w = tid >> 6;
    const int DSZ = 71680;
    const bf16_t* P = (const bf16_t*)(ws + WS_P);
    const float* GT = (const float*)(ws + WS_GATES);
    const bf16_t* MLA = (const bf16_t*)(ws + WS_MLA); const float* MLN = (const float*)(ws + WS_MLN); const float* MLS = (const float*)(ws + WS_MLS);
    bf16_t* Y = (bf16_t*)(ws + WS_U);
    const float* bg = PIN(I_BGATE) + l * 16; const float* mln = PIN(I_MLNORM) + l * 64;
    u32x4 pq, pk_, pv, pst[2]; float pn = 0.f, pg0 = 0.f, pg1 = 0.f, pm = 0.f;
#define ML_SKIP(it_) ({ int b_, h_, tc_, t0_, jf_, jb_; ml_decode((it_), b_, h_, tc_, t0_, jf_, jb_); (l == DEPTH - 1 && tc_ < 4); })
#define ML_FETCH(it_) do { int b_, h_, tc_, t0_, jf_, jb_; ml_decode((it_), b_, h_, tc_, t0_, jf_, jb_); \
        { const int s_ = tid >> 3, ch_ = tid & 7; const bf16_t* pr_ = P + (size_t)(t0_ + s_) * PW + h_ * 64 + ch_ * 8; \
          pq = *(const u32x4*)(pr_ + 512); pk_ = *(const u32x4*)(pr_ + 768); pv = *(const u32x4*)(pr_ + 1024); } \
        _Pragma("unroll") for (int d_ = 0; d_ < 2; ++d_) { const int seq_ = (b_ * 4 + h_) * 2 + d_, j_ = d_ ? jb_ : jf_; \
          pst[d_] = *(const u32x4*)(MLA + ((size_t)seq_ * 68 + j_) * 4096 + (tid >> 3) * 64 + (tid & 7) * 8); } \
        if (tid < 128) { const int d_ = tid >> 6, tau_ = tid & 63, tk_ = d_ ? 63 - tau_ : tau_; const int seq_ = (b_ * 4 + h_) * 2 + d_, j_ = d_ ? jb_ : jf_; \
          pn = MLN[((size_t)seq_ * 68 + j_) * 64 + tau_]; const float* g_ = GT + (size_t)(t0_ + tk_) * 16; \
          pg0 = g_[4 * d_ + h_]; pg1 = g_[8 + 4 * d_ + h_]; pm = MLS[((size_t)seq_ * 68 + j_) * 4 + 2]; } } while (0)
    int it = blockIdx.x;
    while (it < ML_ITEMS && ML_SKIP(it)) it += gridDim.x;
    if (it < ML_ITEMS) ML_FETCH(it);
    while (it < ML_ITEMS) {
        int b, head, tc, tok0, jf, jb; ml_decode(it, b, head, tc, tok0, jf, jb);
        int nit = it + gridDim.x;
        while (nit < ML_ITEMS && ML_SKIP(nit)) nit += gridDim.x;
        __syncthreads();
        {   const int s = tid >> 3, ch = tid & 7;
            const u32x4 qv = pq, kv = pk_, vv = pv;
            u32x4 ks; ks.x = pack_bf16(bflo(kv.x) * 0.125f, bfhi(kv.x) * 0.125f); ks.y = pack_bf16(bflo(kv.y) * 0.125f, bfhi(kv.y) * 0.125f);
            ks.z = pack_bf16(bflo(kv.z) * 0.125f, bfhi(kv.z) * 0.125f); ks.w = pack_bf16(bflo(kv.w) * 0.125f, bfhi(kv.w) * 0.125f);
            const unsigned vw[4] = {vv.x, vv.y, vv.z, vv.w};
#pragma unroll
            for (int d = 0; d < 2; ++d) { unsigned char* D = smem + d * DSZ; const int tau = d ? 63 - s : s;
                bf16_t* Qd = (bf16_t*)D; bf16_t* Kd = Qd + 64 * 72; bf16_t* Bd = Kd + 64 * 72 + 64 * 136;
                *(u32x4*)(Qd + tau * 72 + ch * 8) = qv; *(u32x4*)(Kd + tau * 72 + ch * 8) = ks;
#pragma unroll
                for (int i = 0; i < 4; ++i) { Bd[(ch * 8 + 2 * i) * 136 + tau] = (bf16_t)(vw[i] & 0xffff); Bd[(ch * 8 + 2 * i + 1) * 136 + tau] = (bf16_t)(vw[i] >> 16); } }
#pragma unroll
            for (int d = 0; d < 2; ++d) { unsigned char* D = smem + d * DSZ; bf16_t* Bd = (bf16_t*)D + 2 * 64 * 72 + 64 * 136;
                const int e = tid >> 3, k0 = (tid & 7) * 8;
                *(u32x4*)(Bd + e * 136 + 64 + k0) = pst[d]; }
            if (tid < 128) { const int d = tid >> 6, tau = tid & 63;
                float* vecs = (float*)(smem + d * DSZ + 53248);
                vecs[3 * 64 + tau] = pn;
                vecs[4 * 64 + tau] = pg0 + bg[4 * d + head];
                vecs[5 * 64 + tau] = log_sigmoid(pg1 + bg[8 + 4 * d + head]); }
        }
        const float mcur = pm;
        if (nit < ML_ITEMS) ML_FETCH(nit);
        __syncthreads();
        if (tid < 128) { const int d = tid >> 6, tau = tid & 63; float* vecs = (float*)(smem + d * DSZ + 53248);
            const int seq = (b * 4 + head) * 2 + d, j = d ? jb : jf;
            const float m = mcur;
            float cum = vecs[5 * 64 + tau];
#pragma unroll
            for (int o = 1; o < 64; o <<= 1) { const float n = __shfl_up(cum, o); if (tau >= o) cum += n; }
            float mm = vecs[4 * 64 + tau] - cum;
#pragma unroll
            for (int o = 1; o < 64; o <<= 1) { const float n = __shfl_up(mm, o); if (tau >= o) mm = fmaxf(mm, n); }
            const float mt = cum + fmaxf(m, mm);
            vecs[tau] = cum; vecs[64 + tau] = mt; vecs[128 + tau] = expf(cum + m - mt); }
        __syncthreads();
        const int d = w >> 2, wl = w & 3, tt = wl >> 1, tx = wl & 1;
        unsigned char* D = smem + d * DSZ;
        bf16_t* Qd = (bf16_t*)D; bf16_t* Kd = Qd + 64 * 72; bf16_t* Ad = Kd + 64 * 72; bf16_t* Bd = Ad + 64 * 136;
        float* vecs = (float*)(D + 53248); float* Hd = vecs + 7 * 64;
        {   f32x16 S;
#pragma unroll
            for (int r = 0; r < 16; ++r) S[r] = 0.f;
            S = mma32(Qd + 32 * tt * 72, 72, Kd + 32 * tx * 72, 72, 64, S, lane);
            const int s = 32 * tx + (lane & 31); const float bs = vecs[s], igs = vecs[4 * 64 + s];
#pragma unroll
            for (int r = 0; r < 16; ++r) { const int t = 32 * tt + CROW(r, lane);
                const float val = (s <= t) ? S[r] * fast_exp2((vecs[t] - bs + igs - vecs[64 + t]) * LOG2E) : 0.f;
                Ad[t * 136 + s] = f2bf(val); }
            const int tl = tid & 255, t = tl >> 2, qd = tl & 3; const float wi = vecs[128 + t];
#pragma unroll
            for (int v = 0; v < 2; ++v) { const u32x4 q = *(const u32x4*)(Qd + t * 72 + 16 * qd + 8 * v); u32x4 o;
                o.x = pack_bf16(bflo(q.x) * wi, bfhi(q.x) * wi); o.y = pack_bf16(bflo(q.y) * wi, bfhi(q.y) * wi); o.z = pack_bf16(bflo(q.z) * wi, bfhi(q.z) * wi); o.w = pack_bf16(bflo(q.w) * wi, bfhi(q.w) * wi);
                *(u32x4*)(Ad + t * 136 + 64 + 16 * qd + 8 * v) = o; }
        }
        __syncthreads();
        {   f32x16 N;
#pragma unroll
            for (int r = 0; r < 16; ++r) N[r] = 0.f;
            N = mma32(Ad + 32 * tt * 136, 136, Bd + 32 * tx * 136, 136, 128, N, lane);
#pragma unroll
            for (int r = 0; r < 16; ++r) Hd[(32 * tt + CROW(r, lane)) * 65 + 32 * tx + (lane & 31)] = N[r];
            const int tl = tid & 255;
            {
                const int t = tl >> 2, qd = tl & 3; float dn = 0.f;
                const u32x4 sa = *(const u32x4*)(Ad + t * 136 + 16 * qd), sb = *(const u32x4*)(Ad + t * 136 + 16 * qd + 8);
                const u32x4 qa = *(const u32x4*)(Ad + t * 136 + 64 + 16 * qd), qb = *(const u32x4*)(Ad + t * 136 + 64 + 16 * qd + 8);
                const float* nv = vecs + 3 * 64 + 16 * qd;
                dn += (bflo(sa.x) + bfhi(sa.x)) + (bflo(sa.y) + bfhi(sa.y)) + (bflo(sa.z) + bfhi(sa.z)) + (bflo(sa.w) + bfhi(sa.w));
                dn += (bflo(sb.x) + bfhi(sb.x)) + (bflo(sb.y) + bfhi(sb.y)) + (bflo(sb.z) + bfhi(sb.z)) + (bflo(sb.w) + bfhi(sb.w));
                dn += bflo(qa.x) * nv[0] + bfhi(qa.x) * nv[1] + bflo(qa.y) * nv[2] + bfhi(qa.y) * nv[3] + bflo(qa.z) * nv[4] + bfhi(qa.z) * nv[5] + bflo(qa.w) * nv[6] + bfhi(qa.w) * nv[7];
                dn += bflo(qb.x) * nv[8] + bfhi(qb.x) * nv[9] + bflo(qb.y) * nv[10] + bfhi(qb.y) * nv[11] + bflo(qb.z) * nv[12] + bfhi(qb.z) * nv[13] + bflo(qb.w) * nv[14] + bfhi(qb.w) * nv[15];
                dn += dpp_get<DPP_XOR1>(dn); dn += dpp_get<DPP_XOR2>(dn);
                if (qd == 0) vecs[6 * 64 + t] = dn; }
        }
        __syncthreads();
        {   const int s = tid >> 3, e0 = (tid & 7) * 8;
            const float* vF = (const float*)(smem + 53248); const float* HF = vF + 7 * 64;
            const float* vB = (const float*)(smem + DSZ + 53248); const float* HB = vB + 7 * 64;
            const int tb = 63 - s;
            const float rf = 1.0f / fmaxf(fabsf(vF[6 * 64 + s]), fast_exp2(-vF[64 + s] * LOG2E)), rb = 1.0f / fmaxf(fabsf(vB[6 * 64 + tb]), fast_exp2(-vB[64 + tb] * LOG2E));
            float y[8], ss = 0.f;
#pragma unroll
            for (int i = 0; i < 8; ++i) { y[i] = HF[s * 65 + e0 + i] * rf + HB[tb * 65 + e0 + i] * rb; ss += y[i] * y[i]; }
            ss += __shfl_xor(ss, 1); ss += __shfl_xor(ss, 2); ss += __shfl_xor(ss, 4);
            const float rinv = rsqrtf(ss * (1.0f / 64.0f) + EPSF);
            const u32x4 ov = *(const u32x4*)(P + (size_t)(tok0 + s) * PW + 1280 + head * 64 + e0);
            const float op[8] = {bflo(ov.x), bfhi(ov.x), bflo(ov.y), bfhi(ov.y), bflo(ov.z), bfhi(ov.z), bflo(ov.w), bfhi(ov.w)};
            float o[8];
#pragma unroll
            for (int i = 0; i < 8; ++i) o[i] = y[i] * rinv * mln[e0 + i] * __builtin_amdgcn_rcpf(1.0f + fast_exp2(-op[i] * LOG2E));
            u32x4 wv; wv.x = pack_bf16(o[0], o[1]); wv.y = pack_bf16(o[2], o[3]); wv.z = pack_bf16(o[4], o[5]); wv.w = pack_bf16(o[6], o[7]);
            *(u32x4*)(Y + (size_t)(tok0 + s) * DM + 512 + head * 64 + e0) = wv;
        }
        it = nit;
    }
#undef ML_SKIP
#undef ML_FETCH
    __syncthreads();
}
#ifndef DUPMASK
#define DUPMASK 0
#endif
#ifndef PROBE_KIND
#define PROBE_KIND 0
#endif
#ifndef PROBE_MASK
#define PROBE_MASK 0
#endif
#ifndef PROBE_MULT
#define PROBE_MULT 1
#endif
#if PROBE_KIND
#define PROBE_PRE() do { if (blockIdx.x == 0 && threadIdx.x == 0) pw[0] = (unsigned)wall_clock64(); } while (0)
#define PROBE_POST(id) do { if (blockIdx.x == 0 && threadIdx.x == 0) { const unsigned t_ = (unsigned)wall_clock64(), c_ = (unsigned)clock64(); \
        if ((PROBE_MASK >> (id)) & 1) { if (PROBE_KIND == 1) pw[2] += t_ - pw[1]; if (PROBE_KIND == 2) pw[2] += t_ - pw[0]; if (PROBE_KIND == 3) { pw[2] += t_ - pw[1]; pw[3] += c_ - pw[4]; } } \
        pw[1] = t_; pw[4] = c_; } } while (0)
#else
#define PROBE_PRE() do {} while (0)
#define PROBE_POST(id) do {} while (0)
#endif
#if PROBE_KIND == 5
#define PROBE_SEC_BEGIN() do { if (blockIdx.x == 0 && threadIdx.x == 0) pw[5] = (unsigned)wall_clock64(); } while (0)
#define PROBE_SEC_END(k) do { if (blockIdx.x == 0 && threadIdx.x == 0) { const unsigned t_ = (unsigned)wall_clock64(); if ((PROBE_MASK >> (k)) & 1) pw[2] += t_ - pw[5]; pw[5] = t_; } } while (0)
#else
#define PROBE_SEC_BEGIN() do {} while (0)
#define PROBE_SEC_END(k) do {} while (0)
#endif
#define XBAR(id) do { PROBE_PRE(); XcdBarrier _b; _b.bar = (unsigned*)(launder_ws(p.ws) + WS_BAR); _b.x = xb_xcc_id(); _b.st = xbw; xcd_barrier(_b); if ((DUPMASK >> 13) & 1) xcd_barrier(_b); PROBE_POST(id); } while (0)
#define REP(k) for (int _rep = 0; _rep < 1 + ((DUPMASK >> (k)) & 1); ++_rep)
extern __shared__ __attribute__((aligned(16))) unsigned char smem_raw[];

__global__ void __launch_bounds__(NTHR, 2) trunk_fwd(Params p) {
    unsigned char* smem = smem_raw;
    volatile LAS unsigned* xbw = (volatile LAS unsigned*)(smem_raw + LDS_BYTES - 16);
    if (threadIdx.x == 0) { xbw[0] = 0u; xbw[1] = 0u; xbw[2] = 0u; xbw[3] = 0u; }
    __syncthreads();
    (void)xcd_barrier_post((unsigned*)(p.ws + WS_BAR), xbw);
#if PROBE_KIND
    volatile LAS unsigned* pw = (volatile LAS unsigned*)(smem_raw + LDS_BYTES - 48);
    if (blockIdx.x == 0 && threadIdx.x == 0) { pw[1] = (unsigned)wall_clock64(); pw[4] = (unsigned)clock64(); pw[2] = 0u; pw[3] = 0u; }
#endif
    unsigned char* ws = p.ws;
    LAS unsigned char* lds = (LAS unsigned char*)smem_raw;
    const int G = gridDim.x, c = blockIdx.x;
    phase_W<0>(p, 0, smem);
    XBAR(0);
    phase_norm<1>(p, 0, smem);
    XBAR(1);
    for (int l = 0; l < DEPTH; ++l) {
        const bool last = (l == DEPTH - 1);
        REP(10) {   pg8::Gemm g; g.A = (const bf16_t*)(ws + WS_U); g.Bt = (const bf16_t*)(ws + WS_U); g.M = 0; g.N = 0; g.K = DM;
            { const int tid = my_tid();
              const float4* src = (const float4*)(ws + WS_ROPE); float4* dst = (float4*)(smem + EPI_TAB_OFF);
              for (int i = tid; i < 768; i += NTHR) dst[i] = src[i];
              float* gl = (float*)(smem + EPI_TAB_OFF + 12288);
              if (tid < 192) gl[tid] = tid < 64 ? PIN(I_AQN)[l * 64 + tid] : tid < 128 ? PIN(I_AKN)[l * 64 + tid - 64] : tid < 160 ? PIN(I_DQN)[l * 32 + tid - 128] : PIN(I_DKN)[l * 32 + tid - 160];
              __syncthreads(); }
            InProjOrder S{G, c}; EpiInProj E{(bf16_t*)(ws + WS_P), (bf16_t*)(ws + WS_UT), (const LAS unsigned char*)(lds + EPI_TAB_OFF)};
            pg8::gemm_phase(lds, g, S, E); }
        XBAR(2);
        PROBE_SEC_BEGIN();
        REP(0) phase_hyena(p, l, smem);
        PROBE_SEC_END(0);
        REP(1) phase_attnD(p, l, smem);
        PROBE_SEC_END(1);
        REP(2) phase_attnA(p, l, smem);
        PROBE_SEC_END(2);
        REP(3) phase_ml_local(p, l, smem);
        PROBE_SEC_END(3);
        XBAR(4);
        phase_ml_scan(p);
        REP(9) phase_hy_transpose(p, l, smem);
        XBAR(5);
        REP(4) phase_ml_out(p, l, smem);
        XBAR(6);
        {   pg8::Gemm g; g.A = (const bf16_t*)(ws + WS_U); g.Bt = (const bf16_t*)(ws + WS_WOUT); g.M = 0; g.N = 0; g.K = DM;
            OutProjOrder S{G, c, last ? 256 : 272};
            EpiOut E{PIN(I_X), PIN(I_CTX), (bf16_t*)(ws + WS_XB), (const float*)(ws + WS_MOD + (size_t)(l & 1) * MOD_BYTES), l == 0 ? 1 : 0};
            pg8::gemm_phase(lds, g, S, E); }
        REP(5) if (l + 1 < DEPTH) phase_W<2>(p, l + 1, smem);
        XBAR(7);
        REP(6) phase_norm<2>(p, l, smem);
        XBAR(8);
        REP(7) phase_topk(p, l, smem);
        XBAR(9);
        REP(11) {   pg8::Gemm g; g.A = (const bf16_t*)(ws + WS_U); g.Bt = (const bf16_t*)(ws + WS_WGU); g.M = 0; g.N = 0; g.K = DM;
            GateUpOrder S{G, c, last ? 32 : 34}; EpiGU E{(bf16_t*)(ws + WS_HID)};
            pg8::gemm_phase_gather(lds, g, S, E, (const int*)(ws + WS_SROW)); }
        XBAR(10);
        REP(12) {   pg8::Gemm g; g.A = (const bf16_t*)(ws + WS_HID); g.Bt = (const bf16_t*)(ws + WS_WD); g.M = 0; g.N = 0; g.K = DM;
            DownOrder S{G, c, last ? 32 : 34}; EpiDown E{(bf16_t*)(ws + WS_XE), (const float*)(ws + WS_SGATE)};
            pg8::gemm_phase(lds, g, S, E); }
        if (l + 1 < DEPTH) phase_W<3>(p, l + 1, smem);
        XBAR(11);
        if (l + 1 < DEPTH) { REP(14) phase_combine<true>(p, l, smem); REP(5) phase_W<1>(p, l + 1, smem); XBAR(12); }
        else phase_combine<false>(p, l, smem);
    }
#if PROBE_KIND
    PROBE_POST(12);
    if (blockIdx.x == 0 && threadIdx.x == 0) {
        unsigned long long target = (unsigned long long)pw[2] * PROBE_MULT;
        if (PROBE_KIND == 3) target = pw[2] ? (unsigned long long)pw[3] * 10000ull / pw[2] : 0ull;
        const unsigned long long t0 = wall_clock64();
        while ((unsigned long long)wall_clock64() - t0 < target) __builtin_amdgcn_s_sleep(8);
    }
#endif
}

extern "C" void kernel_launch(void* const* d_in, const int* in_sizes, int n_in, void* d_out, int out_size, void* d_ws, size_t ws_size, hipStream_t stream) {
    static int grid = 0;
    if (grid == 0) {
        if (n_in != 34 || out_size != NROWL * DM || ws_size < WS_END) { fprintf(stderr, "kernel_launch: unexpected shapes (n_in %d out %d ws %zu need %zu)\n", n_in, out_size, ws_size, (size_t)WS_END); grid = -1; return; }
        int dev = 0, cus = 0;
        if (hipGetDevice(&dev) != hipSuccess || hipDeviceGetAttribute(&cus, hipDeviceAttributeMultiprocessorCount, dev) != hipSuccess) { grid = -1; return; }
        if (hipFuncSetAttribute((const void*)trunk_fwd, hipFuncAttributeMaxDynamicSharedMemorySize, LDS_BYTES) != hipSuccess) { fprintf(stderr, "kernel_launch: hipFuncSetAttribute failed\n"); grid = -1; return; }
        int per_cu = 0;
        if (hipOccupancyMaxActiveBlocksPerMultiprocessor(&per_cu, (const void*)trunk_fwd, NTHR, LDS_BYTES) != hipSuccess || per_cu < 1) { fprintf(stderr, "kernel_launch: occupancy query says %d\n", per_cu); }
        (void)hipGetLastError();
        grid = cus;
        if (grid > 256) grid = 256;
        grid &= ~7;
    }
    if (grid <= 0) return;
    (void)hipMemsetAsync((char*)d_ws + WS_BAR, 0, 16384, stream);
    Params p{};
    for (int i = 0; i < 34; ++i) p.in[i] = (const float*)d_in[i];
    p.out = (float*)d_out; p.ws = (unsigned char*)d_ws;
    hipLaunchKernelGGL(trunk_fwd, dim3(grid), dim3(NTHR), LDS_BYTES, stream, p);
}
```

```cpp
#include <hip/hip_runtime.h>
#include <stdint.h>
#include <stdio.h>

typedef unsigned short bf16_t;
typedef short bf16x8 __attribute__((ext_vector_type(8)));
typedef short s16x4 __attribute__((ext_vector_type(4)));
typedef float f32x4 __attribute__((ext_vector_type(4)));
typedef float f32x2 __attribute__((ext_vector_type(2)));
typedef float f32x16 __attribute__((ext_vector_type(16)));
typedef unsigned u32x4 __attribute__((ext_vector_type(4)));
typedef unsigned u32x2 __attribute__((ext_vector_type(2)));
#define LAS __attribute__((address_space(3)))

#define NB 16
#define TL 4096
#define TCX 256
#define DM 1024
#define NROWL 65536
#define NROWC 4096
#define NROW 69632
#define PW 2304
#define INW 3088
#define NEXP 16
#define CAPL 512
#define CAPC 32
#define SLOTS_E 8704
#define NSLOT 139264
#define DEPTH 4
#define NTHR 512
#define LDS_BYTES 155648
#define EPSF 1e-6f
#define LOG2E 1.4426950408889634f

constexpr size_t al256(size_t x) { return (x + 255) & ~size_t(255); }
constexpr size_t WS_BAR   = 0;
constexpr size_t WS_MOD   = al256(WS_BAR + 16384);
constexpr size_t MOD_BYTES = al256((size_t)17 * 6144 * 4);
constexpr size_t WS_HID2L = al256(WS_MOD + 2 * MOD_BYTES);
constexpr size_t WS_HID2C = al256(WS_HID2L + (size_t)4096 * 64 * 4);
constexpr size_t WS_GATES = al256(WS_HID2C + (size_t)256 * 64 * 4);
constexpr size_t WS_AFF   = al256(WS_GATES + (size_t)NROW * 16 * 4);
constexpr size_t WS_SROW  = al256(WS_AFF + (size_t)NROW * 16 * 4);
constexpr size_t WS_SGATE = al256(WS_SROW + (size_t)NSLOT * 4);
constexpr size_t WS_INV   = al256(WS_SGATE + (size_t)NSLOT * 4);
constexpr size_t WS_MLS   = al256(WS_INV + (size_t)NROW * 16 * 4);
constexpr size_t WS_FBUF  = al256(WS_MLS + (size_t)128 * 68 * 4 * 4);
constexpr size_t WS_ROPE  = al256(WS_FBUF + (size_t)256 * 8256 * 2);
constexpr size_t WS_CTX   = al256(WS_ROPE + (size_t)64 * 24 * 8);
constexpr size_t WS_U     = al256(WS_CTX + (size_t)NROWC * DM * 4);
constexpr size_t WS_WOUT  = al256(WS_U + (size_t)(NROW + 3072) * DM * 2);
constexpr size_t WS_WGU   = al256(WS_WOUT + (size_t)DM * DM * 2);
constexpr size_t WS_WD    = al256(WS_WGU + (size_t)NEXP * 2048 * DM * 2);
constexpr size_t WS_P     = al256(WS_WD + (size_t)NEXP * DM * DM * 2);
constexpr size_t WS_UT    = al256(WS_P + (size_t)NROW * PW * 2);
constexpr size_t WS_XE    = al256(WS_UT + (size_t)768 * NROW * 2);
constexpr size_t WS_XB    = al256(WS_XE + (size_t)NSLOT * DM * 2);
constexpr size_t WS_END   = al256(WS_XB + (size_t)NROW * DM * 2);
constexpr size_t WS_HID   = WS_P;
constexpr size_t WS_MLA   = WS_XE;
constexpr size_t WS_MLN   = al256(WS_MLA + (size_t)128 * 68 * 4096 * 2);
constexpr size_t WS_YT    = al256(WS_MLN + (size_t)128 * 68 * 64 * 4);
static_assert(WS_YT + (size_t)256 * NROW * 2 <= WS_XB, "alias overflow");
static_assert((size_t)NSLOT * DM * 2 <= (size_t)NROW * PW * 2, "hid alias overflow");

struct Params {
    const float* in[34];
    float* out;
    unsigned char* ws;
};
enum { I_X = 0, I_C, I_CTX, I_CCTX, I_WADA, I_BADA, I_N1G, I_N2G, I_WIN, I_BGATE, I_AQN, I_AKN, I_ASINK, I_HYCONV, I_FW1, I_FB1, I_FREQ, I_FW2, I_FB2, I_FW3,
       I_HYBIAS, I_MLNORM, I_DQN, I_DKN, I_LQ1, I_LK1, I_LQ2, I_LK2, I_DSUB, I_WOUT, I_WROUTER, I_WEG, I_WEU, I_WED };

__device__ __forceinline__ int my_tid() { int t = threadIdx.x; asm volatile("" : "+v"(t)); return t; }
#define GAS __attribute__((address_space(1)))
__device__ __forceinline__ unsigned char* launder_ws(unsigned char* q) { GAS unsigned char* g = (GAS unsigned char*)q; asm volatile("" : "+s"(g)); return (unsigned char*)g; }
#define CAS __attribute__((address_space(4)))
__device__ __forceinline__ const float* pin_ptr(int i) { const CAS char* ka = (const CAS char*)__builtin_amdgcn_kernarg_segment_ptr(); asm volatile("" : "+s"(ka));
    const GAS float* g = *(const GAS float* const CAS*)(ka + 8 * i); return (const float*)g; }
#define PIN(i) pin_ptr(i)
#define POUT() ((float*)pin_ptr(34))
__device__ __forceinline__ float bf2f(bf16_t v) { return __uint_as_float((unsigned)v << 16); }
__device__ __forceinline__ bf16_t f2bf(float f) { unsigned u = __float_as_uint(f); u += 0x7fffu + ((u >> 16) & 1u); return (bf16_t)(u >> 16); }
__device__ __forceinline__ unsigned pack_bf16(float lo, float hi) { return (unsigned)f2bf(lo) | ((unsigned)f2bf(hi) << 16); }
__device__ __forceinline__ float bflo(unsigned w) { return __uint_as_float(w << 16); }
__device__ __forceinline__ float bfhi(unsigned w) { return __uint_as_float(w & 0xffff0000u); }
template <int CTRL> __device__ __forceinline__ float dpp_get(float v) { return __int_as_float(__builtin_amdgcn_update_dpp(0, __float_as_int(v), CTRL, 0xf, 0xf, true)); }
#define DPP_XOR1 0xB1
#define DPP_XOR2 0x4E
#define DPP_HMIRROR 0x141
#define DPP_MIRROR 0x140
#define DPP_ROR8 0x128
__device__ __forceinline__ float wave_sum(float v) {
    v += dpp_get<DPP_XOR1>(v); v += dpp_get<DPP_XOR2>(v); v += dpp_get<DPP_HMIRROR>(v); v += dpp_get<DPP_MIRROR>(v);
    const int iv = __float_as_int(v);
    return (__int_as_float(__builtin_amdgcn_readlane(iv, 0)) + __int_as_float(__builtin_amdgcn_readlane(iv, 16))) + (__int_as_float(__builtin_amdgcn_readlane(iv, 32)) + __int_as_float(__builtin_amdgcn_readlane(iv, 48)));
}
__device__ __forceinline__ float wave_max(float v) {
    v = fmaxf(v, dpp_get<DPP_XOR1>(v)); v = fmaxf(v, dpp_get<DPP_XOR2>(v)); v = fmaxf(v, dpp_get<DPP_HMIRROR>(v)); v = fmaxf(v, dpp_get<DPP_MIRROR>(v));
    const int iv = __float_as_int(v);
    return fmaxf(fmaxf(__int_as_float(__builtin_amdgcn_readlane(iv, 0)), __int_as_float(__builtin_amdgcn_readlane(iv, 16))), fmaxf(__int_as_float(__builtin_amdgcn_readlane(iv, 32)), __int_as_float(__builtin_amdgcn_readlane(iv, 48))));
}
__device__ __forceinline__ float lane_xor16(float v, int lane) { const auto r = __builtin_amdgcn_permlane16_swap(__float_as_uint(v), __float_as_uint(v), false, false); return __uint_as_float((lane & 16) ? r[0] : r[1]); }
__device__ __forceinline__ float lane_xor32(float v, int lane) { const auto r = __builtin_amdgcn_permlane32_swap(__float_as_uint(v), __float_as_uint(v), false, false); return __uint_as_float((lane & 32) ? r[0] : r[1]); }
__device__ __forceinline__ float reduce16_transpose(const float (&part)[16], int lane) {
    float v8[8], v4[4], v2[2], v1;
#pragma unroll
    for (int j = 0; j < 8; ++j) { const auto r = __builtin_amdgcn_permlane32_swap(__float_as_uint(part[j]), __float_as_uint(part[8 + j]), false, false); v8[j] = __uint_as_float(r[0]) + __uint_as_float(r[1]); }
#pragma unroll
    for (int j = 0; j < 4; ++j) { const auto r = __builtin_amdgcn_permlane16_swap(__float_as_uint(v8[j]), __float_as_uint(v8[4 + j]), false, false); v4[j] = __uint_as_float(r[0]) + __uint_as_float(r[1]); }
    { const bool up = (lane & 8) != 0;
#pragma unroll
      for (int j = 0; j < 2; ++j) { const float send = up ? v4[j] : v4[2 + j], keep = up ? v4[2 + j] : v4[j]; v2[j] = keep + dpp_get<DPP_ROR8>(send); } }
    { const bool up = (lane & 4) != 0; const float send = up ? v2[0] : v2[1], keep = up ? v2[1] : v2[0]; v1 = keep + dpp_get<DPP_HMIRROR>(send); }
    v1 += dpp_get<DPP_XOR2>(v1); v1 += dpp_get<DPP_XOR1>(v1);
    return v1;
}
__device__ __forceinline__ float fast_exp2(float x) { return __builtin_amdgcn_exp2f(x); }
__device__ __forceinline__ float log_sigmoid(float x) { return fminf(x, 0.f) - log1pf(expf(-fabsf(x))); }

#define XB_TMO      128
#define XB_XCNT(j)  (256  + 64 * (j))
#define XB_XSUB(j)  (1280 + 64 * (j))
#define XB_XGEN(j)  (2304 + 64 * (j))
#define XB_TOP      3328
#define XB_TOPGEN   3392
#define XCD_BAR_WORDS 3456
#define XB_SPIN_CAP (1u << 22)

__device__ __forceinline__ unsigned xb_ld(unsigned* p)              { return __hip_atomic_load(p, __ATOMIC_RELAXED, __HIP_MEMORY_SCOPE_AGENT); }
__device__ __forceinline__ unsigned xb_add(unsigned* p, unsigned v) { return __hip_atomic_fetch_add(p, v, __ATOMIC_RELAXED, __HIP_MEMORY_SCOPE_AGENT); }
__device__ __forceinline__ unsigned xb_xcc_id() { return (unsigned)__builtin_amdgcn_s_getreg((3 << 11) | 20) & 0xFu; }
#define XB_SPIN(cond, bar) do { unsigned _sp = 0; while (cond) { __builtin_amdgcn_s_sleep(1); \
    if ((++_sp & 255u) == 0u) { if (xb_ld(&(bar)[XB_TMO])) break; if (_sp > XB_SPIN_CAP) { atomicAdd(&(bar)[XB_TMO], 1u); break; } } } } while (0)

struct XcdBarrier { unsigned* bar; unsigned x; volatile LAS unsigned* st; };

__device__ __forceinline__ XcdBarrier xcd_barrier_post(unsigned* bar, volatile LAS unsigned* st) {
    XcdBarrier b; b.bar = bar; b.x = xb_xcc_id(); b.st = st;
    if (threadIdx.x == 0) (void)xb_add(&bar[XB_XCNT(b.x)], 1u);
    return b;
}
__device__ __forceinline__ void xcd_barrier_complete(unsigned* bar, unsigned x, unsigned& nloc, unsigned& nx) {
    const unsigned G = gridDim.x * gridDim.y * gridDim.z;
    unsigned sum, cnt, mine, sp = 0u;
    for (;;) {
        sum = 0u; cnt = 0u; mine = 0u;
#pragma unroll
        for (unsigned j = 0; j < 16; ++j) { const unsigned c = xb_ld(&bar[XB_XCNT(j)]); sum += c; cnt += (c > 0u) ? 1u : 0u; mine = (j == x) ? c : mine; }
        if (sum == G) break;
        __builtin_amdgcn_s_sleep(1);
        if ((++sp & 255u) == 0u) { if (xb_ld(&bar[XB_TMO])) break; if (sp > XB_SPIN_CAP) { atomicAdd(&bar[XB_TMO], 1u); break; } }
    }
    nloc = mine > 0u ? mine : 1u; nx = cnt > 0u ? cnt : 1u;
}
__device__ __forceinline__ void xcd_barrier(const XcdBarrier& b) {
    asm volatile("s_waitcnt vmcnt(0)" ::: "memory");
    __syncthreads();
    if (threadIdx.x == 0) {
        unsigned* bar = b.bar;
        __builtin_amdgcn_s_waitcnt(0);
        unsigned nloc = b.st[0], nx = b.st[1];
        if (nloc == 0u) { xcd_barrier_complete(bar, b.x, nloc, nx); b.st[0] = nloc; b.st[1] = nx; }
        const unsigned old = xb_add(&bar[XB_XSUB(b.x)], 1u);
        const unsigned gen = old / nloc;
        if (old + 1u == (gen + 1u) * nloc) {
            __builtin_amdgcn_fence(__ATOMIC_RELEASE, "agent");
            asm volatile("s_waitcnt vmcnt(0)" ::: "memory");
            const unsigned og = xb_add(&bar[XB_TOP], 1u);
            const unsigned tg = og / nx;
            if (og + 1u == (tg + 1u) * nx) xb_add(&bar[XB_TOPGEN], 1u);
            else XB_SPIN(xb_ld(&bar[XB_TOPGEN]) == tg, bar);
            __builtin_amdgcn_fence(__ATOMIC_ACQUIRE, "agent");
            xb_add(&bar[XB_XGEN(b.x)], 1u);
            asm volatile("s_waitcnt vmcnt(0)" ::: "memory");
        } else {
            XB_SPIN(xb_ld(&bar[XB_XGEN(b.x)]) == gen, bar);
            __builtin_amdgcn_fence(__ATOMIC_ACQUIRE, "agent");
            asm volatile("s_waitcnt vmcnt(0)" ::: "memory");
        }
    }
    __syncthreads();
}

namespace pg8 {
constexpr int BM = 256, BK = 64, HALF = 128, HTB = HALF * BK * 2, STAGE_BYTES = 8 * HTB, NXCD = 8, WGM = 8;
__host__ __device__ __forceinline__ int lds_byte(int r, int c) { const int st = (r >> 4) * 2 + (c >> 5), rr = r & 15, cc = c & 31, ob = rr * 64 + cc * 2; return st * 1024 + (ob ^ (((ob >> 9) & 1) << 5)); }
__host__ __device__ __forceinline__ void stage_rc(int b, int& R, int& C) { const int st = b / 1024, sb = b % 1024, swz = sb ^ (((sb >> 9) & 1) << 5); R = (st >> 1) * 16 + swz / 64; C = (st & 1) * 32 + (swz % 64) / 2; }
__host__ __device__ __forceinline__ int perm32(int rho) { const int n = rho >> 4, i = rho & 15; return 8 * (i >> 2) + 4 * n + (i & 3); }
struct Unit { int pm, pn; };
struct Gemm { const bf16_t* A; const bf16_t* Bt; int M, N, K; };
__device__ __forceinline__ unsigned cvt_pk_bf16(float lo, float hi) { unsigned r; asm volatile("v_cvt_pk_bf16_f32 %0, %1, %2" : "=v"(r) : "v"(lo), "v"(hi)); return r; }

__device__ __forceinline__ void static_unit(int L, int nM, int nN, int& pm, int& pn) {
    const int nwg = nM * nN; int wgid = L;
    { const int q = nwg / NXCD, r = nwg % NXCD, xcd = wgid % NXCD, off = wgid / NXCD; wgid = (xcd < r ? xcd * (q + 1) : r * (q + 1) + (xcd - r) * q) + off; }
    const int nig = WGM * nN, gid = wgid / nig, fm = gid * WGM, gsz = (nM - fm) < WGM ? (nM - fm) : WGM;
    pm = fm + ((wgid % nig) % gsz); pn = (wgid % nig) / gsz;
}

template <class Epi, class Sched>
__device__ __forceinline__ void gemm_phase(LAS unsigned char* lds, const Gemm g, const Sched& S, const Epi& E) {
    const int tid = my_tid(), wid = __builtin_amdgcn_readfirstlane(tid >> 6), lane = tid & 63, wr = wid >> 2, wc = wid & 3, fr = lane & 15, fq = lane >> 4;
    const int K = g.K, nt = K / BK;
    unsigned voffA[2], voffB[2];
#pragma unroll
    for (int i = 0; i < 2; ++i) { int R, C; stage_rc(tid * 16 + i * 8192, R, C); const int Rb = Epi::PERM ? ((R & ~31) + perm32(R & 31)) : R;
        voffA[i] = (unsigned)(R * K + C) * 2u; voffB[i] = (unsigned)(Rb * K + C) * 2u; }
    const size_t kstep = (size_t)(BK * 2);
    const size_t hstep = (size_t)HALF * K * 2;
    const size_t tstep = 2 * hstep;
    const unsigned ldsw = (unsigned)wid * 1024u;
    const int aoff = lds_byte(wr * 64 + fr, fq * 8), boff = lds_byte(wc * 32 + fr, fq * 8);
#define PG8_SA(b, h) (((b) * 2 + (h)) * HTB)
#define PG8_SB(b, h) ((4 + (b) * 2 + (h)) * HTB)
#define PG8_STAGE(bufoff, gbase, voff) do { _Pragma("unroll") for (int _i = 0; _i < 2; ++_i) \
        __builtin_amdgcn_global_load_lds((const unsigned*)((const char*)(gbase) + (voff)[_i]), (LAS unsigned*)(lds + (bufoff) + ldsw + _i * 8192), 16, 0, 0); } while (0)
#define PG8_LDA(dst, b, h) do { _Pragma("unroll") for (int m = 0; m < 4; ++m) _Pragma("unroll") for (int k = 0; k < 2; ++k) dst[m][k] = *(const LAS bf16x8*)(lds + PG8_SA(b, h) + aoff + m * 2048 + k * 1024); } while (0)
#define PG8_LDB(dst, b, h) do { _Pragma("unroll") for (int n = 0; n < 2; ++n) _Pragma("unroll") for (int k = 0; k < 2; ++k) dst[n][k] = *(const LAS bf16x8*)(lds + PG8_SB(b, h) + boff + n * 2048 + k * 1024); } while (0)
#define PG8_MMA(ai, bj, At, Bt) do { __builtin_amdgcn_s_setprio(1); _Pragma("unroll") for (int m = 0; m < 4; ++m) _Pragma("unroll") for (int n = 0; n < 2; ++n) _Pragma("unroll") for (int k = 0; k < 2; ++k) \
        acc[ai][bj][m][n] = __builtin_amdgcn_mfma_f32_16x16x32_bf16(Bt[n][k], At[m][k], acc[ai][bj][m][n], 0, 0, 0); __builtin_amdgcn_s_setprio(0); } while (0)
#define PG8_WAIT_V(n) asm volatile("s_waitcnt vmcnt(" #n ")" ::: "memory")
#define PG8_WAIT_L(n) asm volatile("s_waitcnt lgkmcnt(" #n ")" ::: "memory")
#define PG8_BAR __builtin_amdgcn_s_barrier()
#define PG8_SCHED __builtin_amdgcn_sched_barrier(0)
    Unit cur, nxt; int ui = 0;
    if (!S.next(0, cur)) return;
    f32x4 acc[2][2][4][2];
#pragma unroll
    for (int a = 0; a < 2; ++a)
#pragma unroll
        for (int b = 0; b < 2; ++b)
#pragma unroll
            for (int m = 0; m < 4; ++m)
#pragma unroll
                for (int n = 0; n < 2; ++n) acc[a][b][m][n] = (f32x4){0.f, 0.f, 0.f, 0.f};
    bf16x8 At[4][2], B0[2][2], B1[2][2];
    const char* cA = (const char*)g.A + (size_t)cur.pm * tstep; const char* cB = (const char*)g.Bt + (size_t)cur.pn * tstep;
    PG8_STAGE(PG8_SB(0, 0), cB, voffB); PG8_STAGE(PG8_SA(0, 0), cA, voffA); PG8_STAGE(PG8_SB(0, 1), cB + hstep, voffB); PG8_STAGE(PG8_SA(0, 1), cA + hstep, voffA);
    if (wr == 1) PG8_BAR;
    PG8_WAIT_V(4); PG8_BAR;
    PG8_STAGE(PG8_SB(1, 0), cB + kstep, voffB); PG8_STAGE(PG8_SA(1, 0), cA + kstep, voffA); PG8_STAGE(PG8_SB(1, 1), cB + hstep + kstep, voffB);
    PG8_WAIT_V(6); PG8_BAR;
    for (;;) {
        const bool has_next = S.next(ui + 1, nxt);
        const char* nA = has_next ? (const char*)g.A + (size_t)nxt.pm * tstep : cA; const char* nB = has_next ? (const char*)g.Bt + (size_t)nxt.pn * tstep : cB;
        for (int t = 0; t < nt; t += 2) {
            const bool last = (t == nt - 2);
            const char* a1 = cA + (size_t)(t + 1) * kstep;
            const char* a2 = last ? nA : cA + (size_t)(t + 2) * kstep; const char* b2 = last ? nB : cB + (size_t)(t + 2) * kstep;
            const char* a3 = a2 + kstep; const char* b3 = b2 + kstep;
            PG8_LDB(B0, 0, 0); PG8_SCHED; PG8_LDA(At, 0, 0); PG8_STAGE(PG8_SA(1, 1), a1 + hstep, voffA);
            PG8_WAIT_L(8); PG8_BAR; PG8_WAIT_L(0); PG8_MMA(0, 0, At, B0); PG8_BAR; PG8_SCHED;
            PG8_LDB(B1, 0, 1); PG8_STAGE(PG8_SB(0, 0), b2, voffB);
            PG8_BAR; PG8_WAIT_L(0); PG8_MMA(0, 1, At, B1); PG8_BAR;
            PG8_LDA(At, 0, 1); PG8_STAGE(PG8_SA(0, 0), a2, voffA);
            PG8_BAR; PG8_WAIT_L(0); PG8_MMA(1, 0, At, B0); PG8_BAR; PG8_SCHED;
            PG8_STAGE(PG8_SB(0, 1), b2 + hstep, voffB);
            PG8_WAIT_V(6); PG8_BAR; PG8_MMA(1, 1, At, B1); PG8_BAR;
            PG8_LDB(B0, 1, 0); PG8_SCHED; PG8_LDA(At, 1, 0); PG8_STAGE(PG8_SA(0, 1), a2 + hstep, voffA);
            PG8_WAIT_L(8); PG8_BAR; PG8_WAIT_L(0); PG8_MMA(0, 0, At, B0); PG8_BAR; PG8_SCHED;
            PG8_LDB(B1, 1, 1); PG8_STAGE(PG8_SB(1, 0), b3, voffB);
            PG8_BAR; PG8_WAIT_L(0); PG8_MMA(0, 1, At, B1); PG8_BAR;
            PG8_LDA(At, 1, 1); PG8_STAGE(PG8_SA(1, 0), a3, voffA);
            PG8_BAR; PG8_WAIT_L(0); PG8_MMA(1, 0, At, B0); PG8_BAR; PG8_SCHED;
            PG8_STAGE(PG8_SB(1, 1), b3 + hstep, voffB);
            PG8_WAIT_V(6); PG8_BAR; PG8_MMA(1, 1, At, B1); PG8_BAR;
        }
#if defined(PROBE_KIND) && PROBE_KIND == 4
        { unsigned t0_ = 0; if (blockIdx.x == 0 && threadIdx.x == 0) t0_ = (unsigned)wall_clock64();
          E(acc, cur, wr, wc, fr, fq);
          if (blockIdx.x == 0 && threadIdx.x == 0) { asm volatile("s_waitcnt vmcnt(0)" ::: "memory"); volatile LAS unsigned* pw_ = (volatile LAS unsigned*)(lds + LDS_BYTES - 48); pw_[2] += (unsigned)wall_clock64() - t0_; } }
#else
        E(acc, cur, wr, wc, fr, fq);
#endif
        if (!has_next) break;
#pragma unroll
        for (int a = 0; a < 2; ++a)
#pragma unroll
            for (int b = 0; b < 2; ++b)
#pragma unroll
                for (int m = 0; m < 4; ++m)
#pragma unroll
                    for (int n = 0; n < 2; ++n) acc[a][b][m][n] = (f32x4){0.f, 0.f, 0.f, 0.f};
        cur = nxt; cA = nA; cB = nB; ++ui;
    }
    PG8_WAIT_V(0);
    if (wr == 0) PG8_BAR;
    PG8_BAR;
#undef PG8_SA
#undef PG8_SB
#undef PG8_STAGE
#undef PG8_LDA
#undef PG8_LDB
#undef PG8_MMA
#undef PG8_WAIT_V
#undef PG8_WAIT_L
#undef PG8_BAR
#undef PG8_SCHED
}
template <class Epi, class Sched>
__device__ __forceinline__ void gemm_phase_gather(LAS unsigned char* lds, const Gemm g, const Sched& S, const Epi& E, const int* __restrict__ srow) {
    const int tid = my_tid(), wid = __builtin_amdgcn_readfirstlane(tid >> 6), lane = tid & 63, wr = wid >> 2, wc = wid & 3, fr = lane & 15, fq = lane >> 4;
    const int K = g.K, nt = K / BK;
    unsigned voffB[2];
#pragma unroll
    for (int i = 0; i < 2; ++i) { int R, C; stage_rc(tid * 16 + i * 8192, R, C); const int Rb = Epi::PERM ? ((R & ~31) + perm32(R & 31)) : R;
        voffB[i] = (unsigned)(Rb * K + C) * 2u; }
    unsigned gcur[2][2], gnxt[2][2];
#define PG8_LOADG(dst, u) do { const int _t = my_tid(); _Pragma("unroll") for (int _i = 0; _i < 2; ++_i) { int _R, _C; stage_rc(_t * 16 + _i * 8192, _R, _C); _Pragma("unroll") for (int _h = 0; _h < 2; ++_h) \
        dst[_h][_i] = (unsigned)srow[(u).pm * 256 + 128 * _h + _R] * (unsigned)(K * 2) + (unsigned)_C * 2u; } } while (0)
#define PG8_STAGEG(bufoff, gofs, kbyte) do { _Pragma("unroll") for (int _i = 0; _i < 2; ++_i) \
        __builtin_amdgcn_global_load_lds((const unsigned*)((const char*)g.A + (gofs)[_i] + (kbyte)), (LAS unsigned*)(lds + (bufoff) + ldsw + _i * 8192), 16, 0, 0); } while (0)
    const size_t kstep = (size_t)(BK * 2);
    const size_t hstep = (size_t)HALF * K * 2;
    const size_t tstep = 2 * hstep;
    const unsigned ldsw = (unsigned)wid * 1024u;
    const int aoff = lds_byte(wr * 64 + fr, fq * 8), boff = lds_byte(wc * 32 + fr, fq * 8);
#define PG8_SA(b, h) (((b) * 2 + (h)) * HTB)
#define PG8_SB(b, h) ((4 + (b) * 2 + (h)) * HTB)
#define PG8_STAGE(bufoff, gbase, voff) do { _Pragma("unroll") for (int _i = 0; _i < 2; ++_i) \
        __builtin_amdgcn_global_load_lds((const unsigned*)((const char*)(gbase) + (voff)[_i]), (LAS unsigned*)(lds + (bufoff) + ldsw + _i * 8192), 16, 0, 0); } while (0)
#define PG8_LDA(dst, b, h) do { _Pragma("unroll") for (int m = 0; m < 4; ++m) _Pragma("unroll") for (int k = 0; k < 2; ++k) dst[m][k] = *(const LAS bf16x8*)(lds + PG8_SA(b, h) + aoff + m * 2048 + k * 1024); } while (0)
#define PG8_LDB(dst, b, h) do { _Pragma("unroll") for (int n = 0; n < 2; ++n) _Pragma("unroll") for (int k = 0; k < 2; ++k) dst[n][k] = *(const LAS bf16x8*)(lds + PG8_SB(b, h) + boff + n * 2048 + k * 1024); } while (0)
#define PG8_MMA(ai, bj, At, Bt) do { __builtin_amdgcn_s_setprio(1); _Pragma("unroll") for (int m = 0; m < 4; ++m) _Pragma("unroll") for (int n = 0; n < 2; ++n) _Pragma("unroll") for (int k = 0; k < 2; ++k) \
        acc[ai][bj][m][n] = __builtin_amdgcn_mfma_f32_16x16x32_bf16(Bt[n][k], At[m][k], acc[ai][bj][m][n], 0, 0, 0); __builtin_amdgcn_s_setprio(0); } while (0)
#define PG8_WAIT_V(n) asm volatile("s_waitcnt vmcnt(" #n ")" ::: "memory")
#define PG8_WAIT_L(n) asm volatile("s_waitcnt lgkmcnt(" #n ")" ::: "memory")
#define PG8_BAR __builtin_amdgcn_s_barrier()
#define PG8_SCHED __builtin_amdgcn_sched_barrier(0)
    Unit cur, nxt; int ui = 0;
    if (!S.next(0, cur)) return;
    f32x4 acc[2][2][4][2];
#pragma unroll
    for (int a = 0; a < 2; ++a)
#pragma unroll
        for (int b = 0; b < 2; ++b)
#pragma unroll
            for (int m = 0; m < 4; ++m)
#pragma unroll
                for (int n = 0; n < 2; ++n) acc[a][b][m][n] = (f32x4){0.f, 0.f, 0.f, 0.f};
    bf16x8 At[4][2], B0[2][2], B1[2][2];
    const char* cB = (const char*)g.Bt + (size_t)cur.pn * tstep;
    PG8_LOADG(gcur, cur);
    PG8_STAGE(PG8_SB(0, 0), cB, voffB); PG8_STAGEG(PG8_SA(0, 0), gcur[0], 0); PG8_STAGE(PG8_SB(0, 1), cB + hstep, voffB); PG8_STAGEG(PG8_SA(0, 1), gcur[1], 0);
    if (wr == 1) PG8_BAR;
    PG8_WAIT_V(4); PG8_BAR;
    PG8_STAGE(PG8_SB(1, 0), cB + kstep, voffB); PG8_STAGEG(PG8_SA(1, 0), gcur[0], kstep); PG8_STAGE(PG8_SB(1, 1), cB + hstep + kstep, voffB);
    PG8_WAIT_V(6); PG8_BAR;
    for (;;) {
        const bool has_next = S.next(ui + 1, nxt);
        const char* nB = has_next ? (const char*)g.Bt + (size_t)nxt.pn * tstep : cB;
        if (has_next) PG8_LOADG(gnxt, nxt); else { gnxt[0][0] = gcur[0][0]; gnxt[0][1] = gcur[0][1]; gnxt[1][0] = gcur[1][0]; gnxt[1][1] = gcur[1][1]; }
        for (int t = 0; t < nt; t += 2) {
            const bool last = (t == nt - 2);
            const size_t k1 = (size_t)(t + 1) * kstep, k2 = last ? 0 : (size_t)(t + 2) * kstep, k3 = k2 + kstep;
            const char* b2 = last ? nB : cB + (size_t)(t + 2) * kstep; const char* b3 = b2 + kstep;
            unsigned g0[2], g1[2];
            g0[0] = last ? gnxt[0][0] : gcur[0][0]; g0[1] = last ? gnxt[0][1] : gcur[0][1]; g1[0] = last ? gnxt[1][0] : gcur[1][0]; g1[1] = last ? gnxt[1][1] : gcur[1][1];
            PG8_LDB(B0, 0, 0); PG8_SCHED; PG8_LDA(At, 0, 0); PG8_STAGEG(PG8_SA(1, 1), gcur[1], k1);
            PG8_WAIT_L(8); PG8_BAR; PG8_WAIT_L(0); PG8_MMA(0, 0, At, B0); PG8_BAR; PG8_SCHED;
            PG8_LDB(B1, 0, 1); PG8_STAGE(PG8_SB(0, 0), b2, voffB);
            PG8_BAR; PG8_WAIT_L(0); PG8_MMA(0, 1, At, B1); PG8_BAR;
            PG8_LDA(At, 0, 1); PG8_STAGEG(PG8_SA(0, 0), g0, k2);
            PG8_BAR; PG8_WAIT_L(0); PG8_MMA(1, 0, At, B0); PG8_BAR; PG8_SCHED;
            PG8_STAGE(PG8_SB(0, 1), b2 + hstep, voffB);
            PG8_WAIT_V(6); PG8_BAR; PG8_MMA(1, 1, At, B1); PG8_BAR;
            PG8_LDB(B0, 1, 0); PG8_SCHED; PG8_LDA(At, 1, 0); PG8_STAGEG(PG8_SA(0, 1), g1, k2);
            PG8_WAIT_L(8); PG8_BAR; PG8_WAIT_L(0); PG8_MMA(0, 0, At, B0); PG8_BAR; PG8_SCHED;
            PG8_LDB(B1, 1, 1); PG8_STAGE(PG8_SB(1, 0), b3, voffB);
            PG8_BAR; PG8_WAIT_L(0); PG8_MMA(0, 1, At, B1); PG8_BAR;
            PG8_LDA(At, 1, 1); PG8_STAGEG(PG8_SA(1, 0), g0, k3);
            PG8_BAR; PG8_WAIT_L(0); PG8_MMA(1, 0, At, B0); PG8_BAR; PG8_SCHED;
            PG8_STAGE(PG8_SB(1, 1), b3 + hstep, voffB);
            PG8_WAIT_V(6); PG8_BAR; PG8_MMA(1, 1, At, B1); PG8_BAR;
        }
#if defined(PROBE_KIND) && PROBE_KIND == 4
        { unsigned t0_ = 0; if (blockIdx.x == 0 && threadIdx.x == 0) t0_ = (unsigned)wall_clock64();
          E(acc, cur, wr, wc, fr, fq);
          if (blockIdx.x == 0 && threadIdx.x == 0) { asm volatile("s_waitcnt vmcnt(0)" ::: "memory"); volatile LAS unsigned* pw_ = (volatile LAS unsigned*)(lds + LDS_BYTES - 48); pw_[2] += (unsigned)wall_clock64() - t0_; } }
#else
        E(acc, cur, wr, wc, fr, fq);
#endif
        if (!has_next) break;
#pragma unroll
        for (int a = 0; a < 2; ++a)
#pragma unroll
            for (int b = 0; b < 2; ++b)
#pragma unroll
                for (int m = 0; m < 4; ++m)
#pragma unroll
                    for (int n = 0; n < 2; ++n) acc[a][b][m][n] = (f32x4){0.f, 0.f, 0.f, 0.f};
        cur = nxt; cB = nB; ++ui;
        gcur[0][0] = gnxt[0][0]; gcur[0][1] = gnxt[0][1]; gcur[1][0] = gnxt[1][0]; gcur[1][1] = gnxt[1][1];
    }
    PG8_WAIT_V(0);
    if (wr == 0) PG8_BAR;
    PG8_BAR;
#undef PG8_LOADG
#undef PG8_STAGEG
#undef PG8_SA
#undef PG8_SB
#undef PG8_STAGE
#undef PG8_LDA
#undef PG8_LDB
#undef PG8_MMA
#undef PG8_WAIT_V
#undef PG8_WAIT_L
#undef PG8_BAR
#undef PG8_SCHED
}
}
using pg8::Unit;
struct InProjOrder { int G, c;
    __device__ __forceinline__ bool next(int i, Unit& u) const {
        const int L = i * G + c; if (L >= 3264) return false;
        int pm, pn;
        if (L < 2448) { pg8::static_unit(L, 272, 9, pm, pn); u.pm = pm; u.pn = 272 + pn; }
        else { pg8::static_unit(L - 2448, 3, 272, pm, pn); u.pm = 281 + pm; u.pn = pn; }
        return true; } };
struct OutProjOrder { int G, c, nM;
    __device__ __forceinline__ bool next(int i, Unit& u) const {
        const int L = i * G + c; if (L >= nM * 4) return false;
        pg8::static_unit(L, nM, 4, u.pm, u.pn); return true; } };
struct GateUpOrder { int G, c, nM;
    __device__ __forceinline__ bool next(int i, Unit& u) const {
        const int per = nM * 8; const int L = i * G + c; if (L >= 16 * per) return false;
        const int e = L / per; int pm, pn; pg8::static_unit(L - e * per, nM, 8, pm, pn); u.pm = e * 34 + pm; u.pn = e * 8 + pn; return true; } };
struct DownOrder { int G, c, nM;
    __device__ __forceinline__ bool next(int i, Unit& u) const {
        const int per = nM * 4; const int L = i * G + c; if (L >= 16 * per) return false;
        const int e = L / per; int pm, pn; pg8::static_unit(L - e * per, nM, 4, pm, pn); u.pm = e * 34 + pm; u.pn = e * 4 + pn; return true; } };

#define EPI_TAB_OFF 131072
struct EpiInProj { static constexpr bool PERM = true; bf16_t* P; bf16_t* UT; const LAS unsigned char* tab;
    __device__ __forceinline__ void operator()(const f32x4 (&acc)[2][2][4][2], const Unit& u, int wr, int wc, int fr, int fq) const {
        bf16_t* base; int ldc, rt, ct;
        if (u.pn >= 272) { base = P; ldc = PW; rt = u.pm; ct = u.pn - 272; } else { base = UT; ldc = NROW; rt = u.pm - 281; ct = u.pn; }
        const int row0 = rt * 256 + wr * 64 + fr, col0 = ct * 256 + wc * 32 + 8 * fq;
        if (u.pn >= 272 && ct < 2) {
            const bool nrm = ct == 0 || wc < 2;
            const int colA = ct * 256 + wc * 64 + 8 * fq;
            const LAS float* gnp = (const LAS float*)(tab + 12288) + (ct == 0 ? 0 : 64) + 8 * fq;
            const float qs = ct == 0 ? 0.125f * LOG2E : 1.0f;
            const bool hi = (fq >> 1) != 0; const int lane_ = fr + 16 * fq;
#pragma unroll
            for (int ai = 0; ai < 2; ++ai)
#pragma unroll
                for (int m = 0; m < 4; ++m) { const int row = row0 + ai * 128 + m * 16; const bool lat = row < NROWL; const int t = row & 4095;
                    bf16_t* rowp = base + (size_t)row * ldc + colA;
                    float inv = 1.0f;
                    if (nrm) { float ss = 0.f;
#pragma unroll
                        for (int bj = 0; bj < 2; ++bj)
#pragma unroll
                            for (int n = 0; n < 2; ++n)
#pragma unroll
                                for (int e = 0; e < 4; ++e) ss += acc[ai][bj][m][n][e] * acc[ai][bj][m][n][e];
                        ss += lane_xor16(ss, lane_); ss += lane_xor32(ss, lane_);
                        inv = rsqrtf(ss * (1.0f / 64.0f) + EPSF); }
#pragma unroll
                    for (int bj = 0; bj < 2; ++bj) { const f32x4 v0 = acc[ai][bj][m][0], v1 = acc[ai][bj][m][1];
                        float o[8] = {v0[0], v0[1], v0[2], v0[3], v1[0], v1[1], v1[2], v1[3]};
                        if (nrm) {
                            const f32x4 ga = *(const LAS f32x4*)(gnp + bj * 32), gb = *(const LAS f32x4*)(gnp + bj * 32 + 4);
                            const float gn[8] = {ga[0], ga[1], ga[2], ga[3], gb[0], gb[1], gb[2], gb[3]};
                            const int pos = bj == 0 ? (t >> 6) : (t & 63);
                            const LAS f32x4* rp = (const LAS f32x4*)(tab + pos * 128 + 64 * (fq & 1));
                            const f32x4 r0 = rp[0], r1 = rp[1], r2 = rp[2], r3 = rp[3];
                            const float cs[8] = {r0[0], r0[2], r1[0], r1[2], r2[0], r2[2], r3[0], r3[2]}, sn[8] = {r0[1], r0[3], r1[1], r1[3], r2[1], r2[3], r3[1], r3[3]};
#pragma unroll
                            for (int i = 0; i < 8; ++i) { const float y = o[i] * inv * gn[i]; const float pr = lane_xor32(y, lane_);
                                o[i] = (lat ? (hi ? y * cs[i] + pr * sn[i] : y * cs[i] - pr * sn[i]) : y) * qs; } }
                        u32x4 w; w.x = pg8::cvt_pk_bf16(o[0], o[1]); w.y = pg8::cvt_pk_bf16(o[2], o[3]); w.z = pg8::cvt_pk_bf16(o[4], o[5]); w.w = pg8::cvt_pk_bf16(o[6], o[7]);
                        *(u32x4*)(rowp + bj * 32) = w; } }
            return;
        }
        if (u.pn >= 272 && (ct == 6 || ct == 7)) {
            const LAS float* gnp = (const LAS float*)(tab + 12288) + (ct == 6 ? 128 : 160) + 8 * fq;
            const f32x4 ga = *(const LAS f32x4*)gnp, gb = *(const LAS f32x4*)(gnp + 4);
            const float gn[8] = {ga[0], ga[1], ga[2], ga[3], gb[0], gb[1], gb[2], gb[3]};
            const float qs = ct == 6 ? 0.17677669529663687f * LOG2E : 1.0f;
            const bool hi = (fq & 1) != 0; const int lane_ = fr + 16 * fq;
#pragma unroll
            for (int ai = 0; ai < 2; ++ai)
#pragma unroll
                for (int m = 0; m < 4; ++m) { const int row = row0 + ai * 128 + m * 16; const bool lat = row < NROWL; const int t = row & 4095;
                    const int pos = (fq >> 1) == 0 ? (t >> 6) : (t & 63);
                    const LAS f32x4* rp = (const LAS f32x4*)(tab + 8192 + pos * 64);
                    const f32x4 r0 = rp[0], r1 = rp[1], r2 = rp[2], r3 = rp[3];
                    const float cs[8] = {r0[0], r0[2], r1[0], r1[2], r2[0], r2[2], r3[0], r3[2]}, sn[8] = {r0[1], r0[3], r1[1], r1[3], r2[1], r2[3], r3[1], r3[3]};
                    bf16_t* rowp = base + (size_t)row * ldc + col0;
#pragma unroll
                    for (int bj = 0; bj < 2; ++bj) { const f32x4 v0 = acc[ai][bj][m][0], v1 = acc[ai][bj][m][1];
                        float x[8] = {v0[0], v0[1], v0[2], v0[3], v1[0], v1[1], v1[2], v1[3]};
                        float ss = 0.f;
#pragma unroll
                        for (int i = 0; i < 8; ++i) ss += x[i] * x[i];
                        ss += lane_xor16(ss, lane_); ss += lane_xor32(ss, lane_);
                        const float inv = rsqrtf(ss * (1.0f / 32.0f) + EPSF);
                        float o[8];
#pragma unroll
                        for (int i = 0; i < 8; ++i) { const float y = x[i] * inv * gn[i]; const float pr = lane_xor16(y, lane_);
                            o[i] = (lat ? (hi ? y * cs[i] + pr * sn[i] : y * cs[i] - pr * sn[i]) : y) * qs; }
                        u32x4 w; w.x = pg8::cvt_pk_bf16(o[0], o[1]); w.y = pg8::cvt_pk_bf16(o[2], o[3]); w.z = pg8::cvt_pk_bf16(o[4], o[5]); w.w = pg8::cvt_pk_bf16(o[6], o[7]);
                        *(u32x4*)(rowp + bj * 128) = w; } }
            return;
        }
#pragma unroll
        for (int ai = 0; ai < 2; ++ai)
#pragma unroll
            for (int m = 0; m < 4; ++m) { bf16_t* rowp = base + (size_t)(row0 + ai * 128 + m * 16) * ldc + col0;
#pragma unroll
                for (int bj = 0; bj < 2; ++bj) { const f32x4 v0 = acc[ai][bj][m][0], v1 = acc[ai][bj][m][1];
                    u32x4 w; w.x = pg8::cvt_pk_bf16(v0[0], v0[1]); w.y = pg8::cvt_pk_bf16(v0[2], v0[3]); w.z = pg8::cvt_pk_bf16(v1[0], v1[1]); w.w = pg8::cvt_pk_bf16(v1[2], v1[3]);
                    *(u32x4*)(rowp + bj * 128) = w; } }
    } };
__device__ __forceinline__ float silu_mul(float g, float u) { return g * u * __builtin_amdgcn_rcpf(1.0f + fast_exp2(-g * LOG2E)); }
struct EpiGU { static constexpr bool PERM = true; bf16_t* HID;
    __device__ __forceinline__ void operator()(const f32x4 (&acc)[2][2][4][2], const Unit& u, int wr, int wc, int fr, int fq) const {
        const int row0 = u.pm * 256 + wr * 64 + fr, col0 = (u.pn & 7) * 128 + wc * 32 + 8 * fq;
#pragma unroll
        for (int ai = 0; ai < 2; ++ai)
#pragma unroll
            for (int m = 0; m < 4; ++m) { bf16_t* rowp = HID + (size_t)(row0 + ai * 128 + m * 16) * DM + col0;
                const f32x4 g0 = acc[ai][0][m][0], g1 = acc[ai][0][m][1], u0 = acc[ai][1][m][0], u1 = acc[ai][1][m][1];
                u32x4 w; w.x = pg8::cvt_pk_bf16(silu_mul(g0[0], u0[0]), silu_mul(g0[1], u0[1])); w.y = pg8::cvt_pk_bf16(silu_mul(g0[2], u0[2]), silu_mul(g0[3], u0[3]));
                w.z = pg8::cvt_pk_bf16(silu_mul(g1[0], u1[0]), silu_mul(g1[1], u1[1])); w.w = pg8::cvt_pk_bf16(silu_mul(g1[2], u1[2]), silu_mul(g1[3], u1[3]));
                *(u32x4*)rowp = w; }
    } };
struct EpiDown { static constexpr bool PERM = true; bf16_t* Y; const float* sgate;
    __device__ __forceinline__ void operator()(const f32x4 (&acc)[2][2][4][2], const Unit& u, int wr, int wc, int fr, int fq) const {
        const int row0 = u.pm * 256 + wr * 64 + fr, col0 = (u.pn & 3) * 256 + wc * 32 + 8 * fq;
#pragma unroll
        for (int ai = 0; ai < 2; ++ai)
#pragma unroll
            for (int m = 0; m < 4; ++m) { const int r = row0 + ai * 128 + m * 16; const float gt = sgate[r]; bf16_t* rowp = Y + (size_t)r * DM + col0;
#pragma unroll
                for (int bj = 0; bj < 2; ++bj) { const f32x4 v0 = acc[ai][bj][m][0] * gt, v1 = acc[ai][bj][m][1] * gt;
                    u32x4 w; w.x = pg8::cvt_pk_bf16(v0[0], v0[1]); w.y = pg8::cvt_pk_bf16(v0[2], v0[3]); w.z = pg8::cvt_pk_bf16(v1[0], v1[1]); w.w = pg8::cvt_pk_bf16(v1[2], v1[3]);
                    *(u32x4*)(rowp + bj * 128) = w; } }
    } };
struct EpiOut { static constexpr bool PERM = true; const float* srcL; const float* srcC; bf16_t* XB; const float* MOD; int first;
    __device__ __forceinline__ void operator()(const f32x4 (&acc)[2][2][4][2], const Unit& u, int wr, int wc, int fr, int fq) const {
        const float* gt = MOD + (size_t)(u.pm < 256 ? (u.pm >> 4) : 16) * 6144 + 2048;
        const int row0 = u.pm * 256 + wr * 64 + fr, col0 = u.pn * 256 + wc * 32 + 8 * fq;
        f32x4 gv[2][2];
#pragma unroll
        for (int bj = 0; bj < 2; ++bj)
#pragma unroll
            for (int n = 0; n < 2; ++n) gv[bj][n] = *(const f32x4*)(gt + col0 + bj * 128 + n * 4);
#pragma unroll
        for (int ai = 0; ai < 2; ++ai)
#pragma unroll
            for (int m = 0; m < 4; ++m) { const int row = row0 + ai * 128 + m * 16;
                bf16_t* xrow = XB + (size_t)row * DM + col0;
                const float* frow = (row < NROWL ? srcL + (size_t)row * DM : srcC + (size_t)(row - NROWL) * DM) + col0;
#pragma unroll
                for (int bj = 0; bj < 2; ++bj) {
                    f32x4 s0, s1;
                    if (first) { s0 = *(const f32x4*)(frow + bj * 128); s1 = *(const f32x4*)(frow + bj * 128 + 4); }
                    else { const u32x4 raw = *(const u32x4*)(xrow + bj * 128);
                        s0 = (f32x4){bflo(raw.x), bfhi(raw.x), bflo(raw.y), bfhi(raw.y)}; s1 = (f32x4){bflo(raw.z), bfhi(raw.z), bflo(raw.w), bfhi(raw.w)}; }
                    const f32x4 v0 = s0 + gv[bj][0] * acc[ai][bj][m][0], v1 = s1 + gv[bj][1] * acc[ai][bj][m][1];
                    u32x4 w; w.x = pg8::cvt_pk_bf16(v0[0], v0[1]); w.y = pg8::cvt_pk_bf16(v0[2], v0[3]); w.z = pg8::cvt_pk_bf16(v1[0], v1[1]); w.w = pg8::cvt_pk_bf16(v1[2], v1[3]);
                    *(u32x4*)(xrow + bj * 128) = w; } }
    } };

__device__ __forceinline__ f32x16 mma32(const bf16_t* A, int lda, const bf16_t* Bt, int ldb, int K, f32x16 acc, int lane) {
    const int r = lane & 31, h = lane >> 5;
    const bf16_t* ap = A + r * lda + 8 * h; const bf16_t* bp = Bt + r * ldb + 8 * h;
    for (int k = 0; k < K; k += 16) {
        const bf16x8 a = *(const bf16x8*)(ap + k); const bf16x8 b = *(const bf16x8*)(bp + k);
        acc = __builtin_amdgcn_mfma_f32_32x32x16_bf16(a, b, acc, 0, 0, 0);
    }
    return acc;
}
#define CROW(reg, lane) (((reg) & 3) + 8 * ((reg) >> 2) + 4 * ((lane) >> 5))
typedef short v4i16_t __attribute__((ext_vector_type(4)));
__device__ __forceinline__ s16x4 tr_read(const LAS unsigned char* ptr) { return __builtin_bit_cast(s16x4, __builtin_amdgcn_ds_read_tr16_b64_v4i16((LAS v4i16_t*)ptr)); }
struct TrDesc { const float* src; bf16_t* dst; int src_ld, src_col0, k0, n0, hi_off; };
__device__ __forceinline__ void tr_load(const TrDesc& d, int t, float4 (&v)[2]) {
#pragma unroll
    for (int p = 0; p < 2; ++p) { const int j = (t >> 4) + 32 * p; v[p] = *(const float4*)(d.src + (size_t)(d.k0 + j) * d.src_ld + d.src_col0 + (t & 15) * 4 + ((t & 8) ? d.hi_off : 0)); }
}
__device__ __forceinline__ void tr_store(unsigned char* smem, const TrDesc& d, int t, const float4 (&v)[2]) {
    float* tile = (float*)smem;
#pragma unroll
    for (int p = 0; p < 2; ++p) { const int j = (t >> 4) + 32 * p; float* q = tile + j * 65 + (t & 15) * 4; q[0] = v[p].x; q[1] = v[p].y; q[2] = v[p].z; q[3] = v[p].w; }
    __syncthreads();
    { const int i = t >> 3, kc = (t & 7) * 8;
      u32x4 w;
      w.x = pack_bf16(tile[(kc + 0) * 65 + i], tile[(kc + 1) * 65 + i]); w.y = pack_bf16(tile[(kc + 2) * 65 + i], tile[(kc + 3) * 65 + i]);
      w.z = pack_bf16(tile[(kc + 4) * 65 + i], tile[(kc + 5) * 65 + i]); w.w = pack_bf16(tile[(kc + 6) * 65 + i], tile[(kc + 7) * 65 + i]);
      *(u32x4*)(d.dst + (size_t)(d.n0 + i) * DM + d.k0 + kc) = w; }
    __syncthreads();
}

template <int PART>
__device__ __forceinline__ void phase_W(const Params& p, int l, unsigned char* smem) {
    unsigned char* ws = launder_ws(p.ws);
    const int tid = my_tid(), G = gridDim.x, bid = blockIdx.x;
    if (PART == 0 && bid == 0) {
        float2* rA = (float2*)(ws + WS_ROPE); float2* rD = rA + 64 * 16;
        for (int idx = tid; idx < 64 * 16; idx += NTHR) { const int pos = idx >> 4, f = idx & 15; const float inv = powf(10000.0f, -(float)f / 16.0f); float sn, cs; sincosf((float)pos * inv, &sn, &cs); rA[idx] = make_float2(cs, sn); }
        for (int idx = tid; idx < 64 * 8; idx += NTHR) { const int pos = idx >> 3, f = idx & 7; const float inv = powf(10000.0f, -(float)f / 8.0f); float sn, cs; sincosf((float)pos * inv, &sn, &cs); rD[idx] = make_float2(cs, sn); }
    }
    if (PART == 0) { int4* inv4 = (int4*)(ws + WS_INV); const int n4 = NROW * 16 / 4;
      for (int i = bid * NTHR + tid; i < n4; i += G * NTHR) inv4[i] = make_int4(-1, -1, -1, -1); }
    const float* w_in = PIN(I_WIN) + (size_t)l * DM * INW;
    const float* w_out = PIN(I_WOUT) + (size_t)l * DM * DM;
    const float* weg = PIN(I_WEG) + (size_t)l * NEXP * DM * DM;
    const float* weu = PIN(I_WEU) + (size_t)l * NEXP * DM * DM;
    const float* wed = PIN(I_WED) + (size_t)l * NEXP * DM * DM;
    bf16_t* WinT = (bf16_t*)(ws + WS_U) + (size_t)NROW * DM;
    bf16_t* WoutT = (bf16_t*)(ws + WS_WOUT);
    bf16_t* WguT = (bf16_t*)(ws + WS_WGU);
    bf16_t* WdT = (bf16_t*)(ws + WS_WD);
    const int N_IN = 768, N_OUT = 256, N_GU = 8192, N_D = 4096, N_ADA = 96, N_HID = 544;
    const int NCVT = N_IN + N_OUT + N_GU + N_D;
    auto tr_desc = [&](int x, TrDesc& d) {
        if (x < N_IN) { const int nt = x >> 4, kt = x & 15, n0 = nt * 64;
            int sc; d.hi_off = 0; if (n0 < 512) { const int b4 = (n0 >> 6) & 3; sc = (n0 & 256) + (b4 & 1) * 128 + (b4 >> 1) * 32; d.hi_off = 32; } else if (n0 < 1536) sc = n0 + 768; else if (n0 < 2304) sc = n0 + 784; else sc = n0 - 1792;
            d.src = w_in; d.src_ld = INW; d.src_col0 = sc; d.k0 = kt * 64; d.dst = WinT; d.n0 = n0; return; }
        x -= N_IN;
        if (x < N_OUT) { const int nt = x >> 4, kt = x & 15; d.hi_off = 0; d.src = w_out; d.src_ld = DM; d.src_col0 = nt * 64; d.k0 = kt * 64; d.dst = WoutT; d.n0 = nt * 64; return; }
        x -= N_OUT;
        if (x < N_GU) { const int e = x >> 9, r = x & 511, nt = r >> 4, kt = r & 15, n0 = nt * 64;
            const int j = n0 >> 8, rr = n0 & 255;
            d.hi_off = 0; d.src = (rr < 128 ? weg : weu) + (size_t)e * DM * DM; d.src_ld = DM; d.src_col0 = j * 128 + (rr & 127); d.k0 = kt * 64; d.dst = WguT + (size_t)e * 2048 * DM; d.n0 = n0; return; }
        x -= N_GU;
        { const int e = x >> 8, r = x & 255, nt = r >> 4, kt = r & 15;
          d.hi_off = 0; d.src = wed + (size_t)e * DM * DM; d.src_ld = DM; d.src_col0 = nt * 64; d.k0 = kt * 64; d.dst = WdT + (size_t)e * DM * DM; d.n0 = nt * 64; }
    };
    if (PART < 2) {
        TrDesc cur, nxt; float4 va[2], vb[2];
        if (bid < NCVT) { tr_desc(bid, cur); tr_load(cur, tid, va); }
        for (int it = bid; it < NCVT; it += G) {
            const bool more = it + G < NCVT;
            if (more) { tr_desc(it + G, nxt); tr_load(nxt, tid, vb); }
            tr_store(smem, cur, tid, va);
            if (more) { cur = nxt; va[0] = vb[0]; va[1] = vb[1]; }
        }
    }
    const int ibeg = (PART == 3) ? N_ADA : 0;
    const int total = (PART == 1) ? 0 : (PART == 2 ? N_ADA : N_ADA + N_HID);
    const int nheavy = (PART == 2) ? G / 4 : (PART == 3 ? G / 2 : 0);
    const int it0 = ibeg + (bid >= nheavy ? bid - nheavy : total), istride = G - nheavy;
    for (int it = it0; it < total; it += istride) {
        int x = it;
        if (x < N_ADA) {
            const int n0 = x * 64;
            float* sv = (float*)smem;
            float* red = sv + 17 * 1024;
            const float* c = PIN(I_C); const float* cc = PIN(I_CCTX);
            for (int idx = tid; idx < 17 * 1024; idx += NTHR) { const int r = idx >> 10, k = idx & 1023; const float v = r < 16 ? c[r * 1024 + k] : cc[k]; sv[idx] = v / (1.0f + expf(-v)); }
            __syncthreads();
            const int w = tid >> 6, lane = tid & 63;
            float acc[17];
#pragma unroll
            for (int r = 0; r < 17; ++r) acc[r] = 0.f;
            const float* wa = PIN(I_WADA) + (size_t)l * DM * 6144 + n0 + lane;
            for (int k0 = 128 * w; k0 < 128 * w + 128; k0 += 32) {
                float wv[32];
#pragma unroll
                for (int u = 0; u < 32; ++u) wv[u] = wa[(size_t)(k0 + u) * 6144];
#pragma unroll
                for (int u = 0; u < 32; ++u)
#pragma unroll
                    for (int r = 0; r < 17; ++r) acc[r] += sv[r * 1024 + k0 + u] * wv[u];
            }
#pragma unroll
            for (int r = 0; r < 17; ++r) red[(w * 17 + r) * 64 + lane] = acc[r];
            __syncthreads();
            float* MOD = (float*)(ws + WS_MOD + (size_t)(l & 1) * MOD_BYTES); const float* ba = PIN(I_BADA) + (size_t)l * 6144;
            for (int idx = tid; idx < 17 * 64; idx += NTHR) { const int r = idx >> 6, j = idx & 63; float s = ba[n0 + j];
#pragma unroll
                for (int ww = 0; ww < 8; ++ww) s += red[(ww * 17 + r) * 64 + j];
                MOD[(size_t)r * 6144 + n0 + j] = s; }
            __syncthreads();
            continue; }
        x -= N_ADA;
        {
            const bool isc = x >= 512; const int L = isc ? 256 : 4096; const int lagbase = (isc ? x - 512 : x) * 8;
            float* zf = (float*)smem;
            float* h1s = zf + 8 * 36;
            const int li = tid >> 6, j = tid & 63, lag = lagbase + li;
            if (j < 33) { float v;
                if (j == 0) v = (float)lag / (float)(L - 1);
                else { const int bi = (j - 1) & 15; const float band = 1e-4f + (float)bi * ((15.0f - 1e-4f) / 15.0f); const float w = 6.283185307179586f * (float)lag / (float)L; const float a = band * w;
                       v = (j <= 16) ? cosf(a) : -sinf(a); }
                zf[li * 36 + j] = v; }
            __syncthreads();
            const float* fw1 = PIN(I_FW1) + (size_t)l * 33 * 64; const float* fb1 = PIN(I_FB1) + l * 64; const float* fr = PIN(I_FREQ) + l * 64;
            const float* fw2 = PIN(I_FW2) + (size_t)l * 64 * 64; const float* fb2 = PIN(I_FB2) + l * 64;
            float a = fb1[j];
#pragma unroll 3
            for (int i = 0; i < 33; ++i) a += zf[li * 36 + i] * fw1[i * 64 + j];
            h1s[li * 64 + j] = sinf(fr[j] * a);
            __syncthreads();
            float a2 = fb2[j];
#pragma unroll 4
            for (int i = 0; i < 64; ++i) a2 += h1s[li * 64 + i] * fw2[i * 64 + j];
            float* H2 = (float*)(ws + (isc ? WS_HID2C : WS_HID2L));
            H2[(size_t)j * L + lag] = sinf(fr[j] * a2);
            __syncthreads();
        }
    }
}

template <int WHICH> struct NmRaw { typedef float4 T; };
template <> struct NmRaw<2> { typedef u32x2 T; };
__device__ __forceinline__ float4 nm_cvt(const float4& v) { return v; }
__device__ __forceinline__ float4 nm_cvt(const u32x2& w) { return make_float4(bflo(w.x), bfhi(w.x), bflo(w.y), bfhi(w.y)); }
template <int WHICH>
__device__ __forceinline__ void phase_norm(const Params& p, int l, unsigned char* smem) {
    unsigned char* ws = launder_ws(p.ws);
    const int tid = my_tid(), lane = tid & 63, wave = tid >> 6;
    float* Wg = (float*)smem;
    for (int idx = tid; idx < 16384; idx += NTHR) { const int k = idx >> 4, j = idx & 15;
        Wg[j * 1024 + k] = (WHICH == 1) ? PIN(I_WIN)[(size_t)l * DM * INW + (size_t)k * INW + 2304 + j] : PIN(I_WROUTER)[(size_t)l * DM * 16 + k * 16 + j]; }
    __syncthreads();
    const float* gain = PIN(WHICH == 1 ? I_N1G : I_N2G) + (size_t)l * DM;
    const float* MOD = (const float*)(ws + WS_MOD + (size_t)(l & 1) * MOD_BYTES);
    bf16_t* U = (bf16_t*)(ws + WS_U);
    float* outv = (float*)(ws + (WHICH == 1 ? WS_GATES : WS_AFF));
    const float* xl = PIN(I_X); const float* xc = PIN(I_CTX);
    const bf16_t* XB = (const bf16_t*)(ws + WS_XB);
    const int rstride = gridDim.x * 8;
    const int nrows = (WHICH == 2 && l == DEPTH - 1) ? NROWL : NROW;
#define NM_LOAD(dst, r) do { if (WHICH == 1) { const float* s_ = (r) < NROWL ? xl + (size_t)(r) * DM : xc + (size_t)((r) - NROWL) * DM; \
            _Pragma("unroll") for (int i = 0; i < 4; ++i) dst[i] = *(const RawT*)(s_ + 256 * i + 4 * lane); } \
        else { const bf16_t* s_ = XB + (size_t)(r) * DM; \
            _Pragma("unroll") for (int i = 0; i < 4; ++i) dst[i] = *(const RawT*)(s_ + 256 * i + 4 * lane); } } while (0)
    typedef typename NmRaw<WHICH>::T RawT;
    const int rbase = 2 * (blockIdx.x * 8 + wave), rstep = 2 * rstride;
    RawT curA[4], curB[4];
    NM_LOAD(curA, rbase); NM_LOAD(curB, rbase + 1);
#pragma unroll 1
    for (int row0 = rbase; row0 < nrows; row0 += rstep) {
        const int rowB = row0 + 1;
        RawT nxtA[4], nxtB[4];
        { const int r2 = row0 + rstep < nrows ? row0 + rstep : row0; NM_LOAD(nxtA, r2); NM_LOAD(nxtB, r2 + 1); }
        const float* mod = MOD + (size_t)(row0 < NROWL ? (row0 >> 12) : 16) * 6144 + (WHICH == 1 ? 0 : 3072);
        float ssA = 0.f, ssB = 0.f;
#pragma unroll
        for (int i = 0; i < 4; ++i) { const float4 a4 = nm_cvt(curA[i]), b4 = nm_cvt(curB[i]);
            ssA += a4.x * a4.x + a4.y * a4.y + a4.z * a4.z + a4.w * a4.w; ssB += b4.x * b4.x + b4.y * b4.y + b4.z * b4.z + b4.w * b4.w; }
        ssA = wave_sum(ssA); ssB = wave_sum(ssB);
        const float invA = rsqrtf(ssA * (1.0f / 1024.0f) + EPSF), invB = rsqrtf(ssB * (1.0f / 1024.0f) + EPSF);
        float partA[16], partB[16];
#pragma unroll
        for (int j = 0; j < 16; ++j) { partA[j] = 0.f; partB[j] = 0.f; }
#pragma unroll
        for (int i = 0; i < 4; ++i) { const int k = 256 * i + 4 * lane;
            float4 g = *(const float4*)(gain + k); const float4 sh = *(const float4*)(mod + k), sc = *(const float4*)(mod + 1024 + k);
            g.x *= 1.f + sc.x; g.y *= 1.f + sc.y; g.z *= 1.f + sc.z; g.w *= 1.f + sc.w;
            const float4 va = nm_cvt(curA[i]), vb = nm_cvt(curB[i]);
            float4 ha, hb;
            ha.x = va.x * invA * g.x + sh.x; ha.y = va.y * invA * g.y + sh.y; ha.z = va.z * invA * g.z + sh.z; ha.w = va.w * invA * g.w + sh.w;
            hb.x = vb.x * invB * g.x + sh.x; hb.y = vb.y * invB * g.y + sh.y; hb.z = vb.z * invB * g.z + sh.z; hb.w = vb.w * invB * g.w + sh.w;
            { u32x2 w; w.x = pack_bf16(ha.x, ha.y); w.y = pack_bf16(ha.z, ha.w); *(u32x2*)(U + (size_t)row0 * DM + k) = w; }
            { u32x2 w; w.x = pack_bf16(hb.x, hb.y); w.y = pack_bf16(hb.z, hb.w); *(u32x2*)(U + (size_t)rowB * DM + k) = w; }
#pragma unroll
            for (int j = 0; j < 8; ++j) { const float4 wv = *(const float4*)(Wg + j * 1024 + k);
                partA[j] += ha.x * wv.x + ha.y * wv.y + ha.z * wv.z + ha.w * wv.w; partB[j] += hb.x * wv.x + hb.y * wv.y + hb.z * wv.z + hb.w * wv.w; }
            asm volatile("" ::: "memory");
#pragma unroll
            for (int j = 8; j < 16; ++j) { const float4 wv = *(const float4*)(Wg + j * 1024 + k);
                partA[j] += ha.x * wv.x + ha.y * wv.y + ha.z * wv.z + ha.w * wv.w; partB[j] += hb.x * wv.x + hb.y * wv.y + hb.z * wv.z + hb.w * wv.w; }
            asm volatile("" ::: "memory"); }
#pragma unroll
        for (int i = 0; i < 4; ++i) { curA[i] = nxtA[i]; curB[i] = nxtB[i]; }
        const int jx = ((lane >> 5) & 1) * 8 + ((lane >> 4) & 1) * 4 + ((lane >> 3) & 1) * 2 + ((lane >> 2) & 1);
        float vA = reduce16_transpose(partA, lane), vB = reduce16_transpose(partB, lane);
        if (WHICH == 2) { const float mxA = wave_max(vA), mxB = wave_max(vB); const float eA = expf(vA - mxA), eB = expf(vB - mxB);
            const float sA = wave_sum(eA) * 0.25f, sB = wave_sum(eB) * 0.25f; vA = eA / sA; vB = eB / sB; }
        if ((lane & 3) == 0) { outv[(size_t)row0 * 16 + jx] = vA; outv[(size_t)rowB * 16 + jx] = vB; }
    }
    __syncthreads();
}

__device__ __forceinline__ void phase_prep(const Params& p, int l, unsigned char* smem) {
    unsigned char* ws = launder_ws(p.ws);
    const int tid = my_tid(), lane = tid & 63, wave = tid >> 6;
    float2* ropeA = (float2*)smem;
    float2* ropeD = ropeA + 64 * 16;
    for (int idx = tid; idx < 64 * 16; idx += NTHR) { const int pos = idx >> 4, f = idx & 15; const float inv = powf(10000.0f, -(float)f / 16.0f); float s, c; sincosf((float)pos * inv, &s, &c); ropeA[idx] = make_float2(c, s); }
    for (int idx = tid; idx < 64 * 8; idx += NTHR) { const int pos = idx >> 3, f = idx & 7; const float inv = powf(10000.0f, -(float)f / 8.0f); float s, c; sincosf((float)pos * inv, &s, &c); ropeD[idx] = make_float2(c, s); }
    __syncthreads();
    bf16_t* P = (bf16_t*)(ws + WS_P);
    const float* aqn = PIN(I_AQN) + l * 64; const float* akn = PIN(I_AKN) + l * 64;
    const float* dqn = PIN(I_DQN) + l * 32; const float* dkn = PIN(I_DKN) + l * 32;
    const int rstride = gridDim.x * 8;
    const int vecA = min(lane >> 3, 5), chA = lane & 7;
    u32x4 rawA;
    { const int row = blockIdx.x * 8 + wave; const bf16_t* pr = P + (size_t)row * PW; rawA = *(const u32x4*)(pr + vecA * 64 + chA * 8); }
    for (int row = blockIdx.x * 8 + wave; row < NROW; row += rstride) {
        const bool lat = row < NROWL; const int t = row & 4095; const int prow = t >> 6, pcol = t & 63;
        bf16_t* pr = P + (size_t)row * PW;
        u32x4 nxtA;
        { const int r2 = row + rstride < NROW ? row + rstride : row; const bf16_t* p2 = P + (size_t)r2 * PW; nxtA = *(const u32x4*)(p2 + vecA * 64 + chA * 8); }
        {
            const int vec = vecA, ch = chA; const bool act = lane < 48;
            bf16_t* ptr = pr + vec * 64 + ch * 8;
            const u32x4 raw = rawA;
            float x[8]; x[0] = bflo(raw.x); x[1] = bfhi(raw.x); x[2] = bflo(raw.y); x[3] = bfhi(raw.y); x[4] = bflo(raw.z); x[5] = bfhi(raw.z); x[6] = bflo(raw.w); x[7] = bfhi(raw.w);
            float ss = 0.f;
#pragma unroll
            for (int i = 0; i < 8; ++i) ss += x[i] * x[i];
            ss += __shfl_xor(ss, 1); ss += __shfl_xor(ss, 2); ss += __shfl_xor(ss, 4);
            const float inv = rsqrtf(ss * (1.0f / 64.0f) + EPSF);
            const float* gn = (vec < 4 ? aqn : akn) + ch * 8;
            const float qs = vec < 4 ? 0.125f * LOG2E : 1.0f;
            const int axis = ch >> 2, half = (ch >> 1) & 1; const int pos = axis == 0 ? prow : pcol;
            float o[8];
#pragma unroll
            for (int i = 0; i < 8; ++i) { const float y = x[i] * inv * gn[i]; const float pr2 = __shfl_xor(y, 2);
                if (lat) { const float2 cs = ropeA[pos * 16 + 8 * (ch & 1) + i]; o[i] = (half == 0 ? y * cs.x - pr2 * cs.y : y * cs.x + pr2 * cs.y) * qs; } else o[i] = y * qs; }
            if (act) { u32x4 w; w.x = pack_bf16(o[0], o[1]); w.y = pack_bf16(o[2], o[3]); w.z = pack_bf16(o[4], o[5]); w.w = pack_bf16(o[6], o[7]); *(u32x4*)ptr = w; }
        }
        rawA = nxtA;
    }
    __syncthreads();
}
__device__ __forceinline__ int block_excl_scan(int v, int* sbuf  , int& total) {
    const int tid = my_tid(), lane = tid & 63, wave = tid >> 6;
    int inc = v;
#pragma unroll
    for (int o = 1; o < 64; o <<= 1) { const int n = __shfl_up(inc, o); if (lane >= o) inc += n; }
    __syncthreads();
    if (lane == 63) sbuf[wave] = inc;
    __syncthreads();
    int pre = 0, tot = 0;
#pragma unroll
    for (int w = 0; w < 8; ++w) { const int s = sbuf[w]; if (w < wave) pre += s; tot += s; }
    total = tot;
    return pre + inc - v;
}

__device__ __forceinline__ void phase_topk(const Params& p, int l, unsigned char* smem) {
    unsigned char* ws = launder_ws(p.ws);
    const int tid = my_tid();
    unsigned* keys = (unsigned*)smem;
    int* hist = (int*)(keys + 4096);
    int* sb = hist + 256;
    int* ctl = sb + 16;
    const float* AFF = (const float*)(ws + WS_AFF);
    int* SROW = (int*)(ws + WS_SROW); float* SGATE = (float*)(ws + WS_SGATE); int* INV = (int*)(ws + WS_INV);
    const int nlists = (l == DEPTH - 1) ? 256 : 512;
    for (int it = blockIdx.x; it < nlists; it += gridDim.x) {
        const int kind = it >> 8, b = (it >> 4) & 15, e = it & 15;
        const int N = kind ? 256 : 4096, K = kind ? CAPC : CAPL;
        const int rowbase = kind ? NROWL + b * 256 : b * 4096;
        const int slotbase = e * SLOTS_E + (kind ? 8192 + b * CAPC : b * CAPL);
        for (int i = tid; i < N; i += NTHR) keys[i] = __float_as_uint(AFF[(size_t)(rowbase + i) * 16 + e]);
        unsigned prefix = 0, mask = 0; int need = K;
        for (int pass = 3; pass >= 0; --pass) {
            const int shift = 8 * pass;
            if (tid < 256) hist[tid] = 0;
            __syncthreads();
            for (int i = tid; i < N; i += NTHR) { const unsigned k = keys[i]; if ((k & mask) == prefix) atomicAdd(&hist[(k >> shift) & 255], 1); }
            __syncthreads();
            if (tid < 64) {
                const int b0 = 255 - 4 * tid; const int h0 = hist[b0], h1 = hist[b0 - 1], h2 = hist[b0 - 2], h3 = hist[b0 - 3];
                const int tot4 = h0 + h1 + h2 + h3; int inc = tot4;
#pragma unroll
                for (int o = 1; o < 64; o <<= 1) { const int n = __shfl_up(inc, o); if (tid >= o) inc += n; }
                const int exc = inc - tot4;
                const bool hit = (exc < need) && (inc >= need);
                if (hit) { int cum = exc, d = b0;
                    if (cum + h0 >= need) d = b0; else { cum += h0; if (cum + h1 >= need) d = b0 - 1; else { cum += h1; if (cum + h2 >= need) d = b0 - 2; else { cum += h2; d = b0 - 3; } } }
                    ctl[0] = d; ctl[1] = need - cum; } }
            __syncthreads();
            prefix |= (unsigned)ctl[0] << shift; mask |= 255u << shift; need = ctl[1];
            __syncthreads();
        }
        const unsigned T = prefix;
        int cg = 0, ce = 0; unsigned k8[8];
#pragma unroll
        for (int j = 0; j < 8; ++j) { const int i = tid * 8 + j; const unsigned k = (i < N) ? keys[i] : 0u; k8[j] = k; cg += (i < N && k > T) ? 1 : 0; ce += (i < N && k == T) ? 1 : 0; }
        int totg, tote;
        int pg = block_excl_scan(cg, sb, totg);
        int pe = block_excl_scan(ce, sb, tote);
#pragma unroll
        for (int j = 0; j < 8; ++j) { const int i = tid * 8 + j; if (i < N) { const unsigned k = k8[j]; int pos = -1;
                if (k > T) pos = pg++; else if (k == T) { if (pe < need) pos = totg + pe; ++pe; }
                if (pos >= 0) { const int s = slotbase + pos; const int row = rowbase + i; SROW[s] = row; SGATE[s] = __uint_as_float(k); INV[(size_t)row * 16 + e] = s; } } }
        __syncthreads();
    }
}

__device__ __forceinline__ void phase_gather(const Params& p) {
    unsigned char* ws = launder_ws(p.ws);
    const int lane = my_tid() & 63, wave = my_tid() >> 6;
    const int* SROW = (const int*)(ws + WS_SROW);
    const bf16_t* U = (const bf16_t*)(ws + WS_U); bf16_t* XE = (bf16_t*)(ws + WS_XE);
    for (int s = blockIdx.x * 8 + wave; s < NSLOT; s += gridDim.x * 8) {
        const int row = SROW[s];
        const u32x4* src = (const u32x4*)(U + (size_t)row * DM); u32x4* dst = (u32x4*)(XE + (size_t)s * DM);
        const u32x4 a = src[lane], b = src[64 + lane];
        dst[lane] = a; dst[64 + lane] = b;
    }
}

template <bool NEXT>
__device__ __forceinline__ void phase_combine(const Params& p, int l, unsigned char* smem) {
    unsigned char* ws = launder_ws(p.ws);
    const int tid = my_tid(), lane = tid & 63, wave = tid >> 6;
    int* INV = (int*)(ws + WS_INV);
    const bf16_t* YS = (const bf16_t*)(ws + WS_XE);
    const float* MODc = (const float*)(ws + WS_MOD + (size_t)(l & 1) * MOD_BYTES);
    const float* MODn = (const float*)(ws + WS_MOD + (size_t)((l + 1) & 1) * MOD_BYTES);
    float* Wg = (float*)smem;
    bf16_t* U = (bf16_t*)(ws + WS_U); float* GT = (float*)(ws + WS_GATES);
    const float* gain = PIN(I_N1G) + (size_t)(NEXT ? l + 1 : 0) * DM;
    if (NEXT) { for (int idx = tid; idx < 16384; idx += NTHR) { const int k = idx >> 4, j = idx & 15; Wg[j * 1024 + k] = PIN(I_WIN)[(size_t)(l + 1) * DM * INW + (size_t)k * INW + 2304 + j]; }
        __syncthreads(); }
    const int rstride = gridDim.x * 8;
    bf16_t* XB = (bf16_t*)(ws + WS_XB); float* outp = POUT();
    const int nrows = NEXT ? NROW : NROWL;
    const int rbase = 2 * (blockIdx.x * 8 + wave), rstep = 2 * rstride;
    int invA, invB; u32x2 xcA[4], xcB[4];
    { invA = INV[(size_t)rbase * 16 + (lane & 15)]; invB = INV[(size_t)(rbase + 1) * 16 + (lane & 15)];
#pragma unroll
      for (int i = 0; i < 4; ++i) { xcA[i] = *(const u32x2*)(XB + (size_t)rbase * DM + 256 * i + 4 * lane); xcB[i] = *(const u32x2*)(XB + (size_t)(rbase + 1) * DM + 256 * i + 4 * lane); } }
#pragma unroll 1
    for (int row0 = rbase; row0 < nrows; row0 += rstep) {
        const int rowB = row0 + 1;
        int ninvA, ninvB; u32x2 xnA[4], xnB[4];
        { const int r2 = row0 + rstep < nrows ? row0 + rstep : row0; ninvA = INV[(size_t)r2 * 16 + (lane & 15)]; ninvB = INV[(size_t)(r2 + 1) * 16 + (lane & 15)];
#pragma unroll
          for (int i = 0; i < 4; ++i) { xnA[i] = *(const u32x2*)(XB + (size_t)r2 * DM + 256 * i + 4 * lane); xnB[i] = *(const u32x2*)(XB + (size_t)(r2 + 1) * DM + 256 * i + 4 * lane); } }
        float accA[16], accB[16];
        unsigned mA = (unsigned)(__ballot(invA >= 0 && lane < 16)) & 0xffffu, mB = (unsigned)(__ballot(invB >= 0 && lane < 16)) & 0xffffu;
        int sA0 = 0, sA1 = 0, sB0 = 0, sB1 = 0; bool hA0 = false, hA1 = false, hB0 = false, hB1 = false;
        if (mA) { const int e0 = __ffs(mA) - 1; mA &= mA - 1; sA0 = __shfl(invA, e0); hA0 = true; if (mA) { const int e1 = __ffs(mA) - 1; mA &= mA - 1; sA1 = __shfl(invA, e1); hA1 = true; } }
        if (mB) { const int e0 = __ffs(mB) - 1; mB &= mB - 1; sB0 = __shfl(invB, e0); hB0 = true; if (mB) { const int e1 = __ffs(mB) - 1; mB &= mB - 1; sB1 = __shfl(invB, e1); hB1 = true; } }
        {   u32x2 wA0[4], wA1[4], wB0[4], wB1[4];
#pragma unroll
            for (int i = 0; i < 4; ++i) { wA0[i] = *(const u32x2*)(YS + (size_t)sA0 * DM + 256 * i + 4 * lane); wA1[i] = *(const u32x2*)(YS + (size_t)sA1 * DM + 256 * i + 4 * lane);
                wB0[i] = *(const u32x2*)(YS + (size_t)sB0 * DM + 256 * i + 4 * lane); wB1[i] = *(const u32x2*)(YS + (size_t)sB1 * DM + 256 * i + 4 * lane); }
#pragma unroll
            for (int i = 0; i < 4; ++i) {
                accA[4 * i + 0] = (hA0 ? bflo(wA0[i].x) : 0.f) + (hA1 ? bflo(wA1[i].x) : 0.f); accA[4 * i + 1] = (hA0 ? bfhi(wA0[i].x) : 0.f) + (hA1 ? bfhi(wA1[i].x) : 0.f);
                accA[4 * i + 2] = (hA0 ? bflo(wA0[i].y) : 0.f) + (hA1 ? bflo(wA1[i].y) : 0.f); accA[4 * i + 3] = (hA0 ? bfhi(wA0[i].y) : 0.f) + (hA1 ? bfhi(wA1[i].y) : 0.f);
                accB[4 * i + 0] = (hB0 ? bflo(wB0[i].x) : 0.f) + (hB1 ? bflo(wB1[i].x) : 0.f); accB[4 * i + 1] = (hB0 ? bfhi(wB0[i].x) : 0.f) + (hB1 ? bfhi(wB1[i].x) : 0.f);
                accB[4 * i + 2] = (hB0 ? bflo(wB0[i].y) : 0.f) + (hB1 ? bflo(wB1[i].y) : 0.f); accB[4 * i + 3] = (hB0 ? bfhi(wB0[i].y) : 0.f) + (hB1 ? bfhi(wB1[i].y) : 0.f); } }
        while (mA) { const int e = __ffs(mA) - 1; mA &= mA - 1; const int s2 = __shfl(invA, e);
#pragma unroll
            for (int i = 0; i < 4; ++i) { const u32x2 w = *(const u32x2*)(YS + (size_t)s2 * DM + 256 * i + 4 * lane);
                accA[4 * i + 0] += bflo(w.x); accA[4 * i + 1] += bfhi(w.x); accA[4 * i + 2] += bflo(w.y); accA[4 * i + 3] += bfhi(w.y); } }
        while (mB) { const int e = __ffs(mB) - 1; mB &= mB - 1; const int s2 = __shfl(invB, e);
#pragma unroll
            for (int i = 0; i < 4; ++i) { const u32x2 w = *(const u32x2*)(YS + (size_t)s2 * DM + 256 * i + 4 * lane);
                accB[4 * i + 0] += bflo(w.x); accB[4 * i + 1] += bfhi(w.x); accB[4 * i + 2] += bflo(w.y); accB[4 * i + 3] += bfhi(w.y); } }
        if (lane < 32) INV[(size_t)row0 * 16 + lane] = -1;
        const int mrow = row0 < NROWL ? (row0 >> 12) : 16;
        const float* gt = MODc + (size_t)mrow * 6144 + 5120;
        float ssA = 0.f, ssB = 0.f;
#pragma unroll
        for (int i = 0; i < 4; ++i) { const int k = 256 * i + 4 * lane;
            const float4 g = *(const float4*)(gt + k);
            float4 xa = make_float4(bflo(xcA[i].x), bfhi(xcA[i].x), bflo(xcA[i].y), bfhi(xcA[i].y)), xb = make_float4(bflo(xcB[i].x), bfhi(xcB[i].x), bflo(xcB[i].y), bfhi(xcB[i].y));
            xa.x += g.x * accA[4 * i + 0]; xa.y += g.y * accA[4 * i + 1]; xa.z += g.z * accA[4 * i + 2]; xa.w += g.w * accA[4 * i + 3];
            xb.x += g.x * accB[4 * i + 0]; xb.y += g.y * accB[4 * i + 1]; xb.z += g.z * accB[4 * i + 2]; xb.w += g.w * accB[4 * i + 3];
            if (NEXT) { u32x2 w; w.x = pack_bf16(xa.x, xa.y); w.y = pack_bf16(xa.z, xa.w); *(u32x2*)(XB + (size_t)row0 * DM + k) = w;
                        u32x2 w2; w2.x = pack_bf16(xb.x, xb.y); w2.y = pack_bf16(xb.z, xb.w); *(u32x2*)(XB + (size_t)rowB * DM + k) = w2; }
            else { *(float4*)(outp + (size_t)row0 * DM + k) = xa; *(float4*)(outp + (size_t)rowB * DM + k) = xb; }
            accA[4 * i + 0] = xa.x; accA[4 * i + 1] = xa.y; accA[4 * i + 2] = xa.z; accA[4 * i + 3] = xa.w;
            accB[4 * i + 0] = xb.x; accB[4 * i + 1] = xb.y; accB[4 * i + 2] = xb.z; accB[4 * i + 3] = xb.w;
            ssA += xa.x * xa.x + xa.y * xa.y + xa.z * xa.z + xa.w * xa.w; ssB += xb.x * xb.x + xb.y * xb.y + xb.z * xb.z + xb.w * xb.w; }
        invA = ninvA; invB = ninvB;
#pragma unroll
        for (int i = 0; i < 4; ++i) { xcA[i] = xnA[i]; xcB[i] = xnB[i]; }
        if (NEXT) {
            ssA = wave_sum(ssA); ssB = wave_sum(ssB);
            const float rA = rsqrtf(ssA * (1.0f / 1024.0f) + EPSF), rB = rsqrtf(ssB * (1.0f / 1024.0f) + EPSF);
            const float* mod = MODn + (size_t)mrow * 6144;
            float partA[16], partB[16];
#pragma unroll
            for (int j = 0; j < 16; ++j) { partA[j] = 0.f; partB[j] = 0.f; }
#pragma unroll
            for (int i = 0; i < 4; ++i) { const int k = 256 * i + 4 * lane;
                float4 g = *(const float4*)(gain + k); const float4 sh = *(const float4*)(mod + k), sc = *(const float4*)(mod + 1024 + k);
                g.x *= 1.f + sc.x; g.y *= 1.f + sc.y; g.z *= 1.f + sc.z; g.w *= 1.f + sc.w;
                float4 ha, hb;
                ha.x = accA[4 * i + 0] * rA * g.x + sh.x; ha.y = accA[4 * i + 1] * rA * g.y + sh.y; ha.z = accA[4 * i + 2] * rA * g.z + sh.z; ha.w = accA[4 * i + 3] * rA * g.w + sh.w;
                hb.x = accB[4 * i + 0] * rB * g.x + sh.x; hb.y = accB[4 * i + 1] * rB * g.y + sh.y; hb.z = accB[4 * i + 2] * rB * g.z + sh.z; hb.w = accB[4 * i + 3] * rB * g.w + sh.w;
                { u32x2 w; w.x = pack_bf16(ha.x, ha.y); w.y = pack_bf16(ha.z, ha.w); *(u32x2*)(U + (size_t)row0 * DM + k) = w; }
                { u32x2 w; w.x = pack_bf16(hb.x, hb.y); w.y = pack_bf16(hb.z, hb.w); *(u32x2*)(U + (size_t)rowB * DM + k) = w; }
#pragma unroll
                for (int j = 0; j < 8; ++j) { const float4 wv = *(const float4*)(Wg + j * 1024 + k);
                    partA[j] += ha.x * wv.x + ha.y * wv.y + ha.z * wv.z + ha.w * wv.w; partB[j] += hb.x * wv.x + hb.y * wv.y + hb.z * wv.z + hb.w * wv.w; }
                asm volatile("" ::: "memory");
#pragma unroll
                for (int j = 8; j < 16; ++j) { const float4 wv = *(const float4*)(Wg + j * 1024 + k);
                    partA[j] += ha.x * wv.x + ha.y * wv.y + ha.z * wv.z + ha.w * wv.w; partB[j] += hb.x * wv.x + hb.y * wv.y + hb.z * wv.z + hb.w * wv.w; }
                asm volatile("" ::: "memory"); }
            const float vA = reduce16_transpose(partA, lane), vB = reduce16_transpose(partB, lane);
            const int jx = ((lane >> 5) & 1) * 8 + ((lane >> 4) & 1) * 4 + ((lane >> 3) & 1) * 2 + ((lane >> 2) & 1);
            if ((lane & 3) == 0) { GT[(size_t)row0 * 16 + jx] = vA; GT[(size_t)rowB * 16 + jx] = vB; }
        }
    }
    __syncthreads();
}
struct AttnItem { int qrow0, qpos0, qcol, kcol, vcol, ycol; int nt0, krow0, kpos0, masked; int nt1, krow1; float M2, sink2, lam, postscale; const float* subgain; };
#define FA_LD 72

template <int NC>
__device__ __forceinline__ void fattn_item(const bf16_t* __restrict__ P, bf16_t* __restrict__ Y, const AttnItem& it, unsigned char* smem) {
    constexpr int KS = (NC == 2) ? 2 : 4;
    const int tid = my_tid(), lane = tid & 63, w = tid >> 6, h = lane >> 5, lq = lane & 31;
    bf16_t* Kb = (bf16_t*)smem;
    bf16_t* Vb = Kb + 2 * 64 * FA_LD;
    const LAS unsigned char* vlds = (const LAS unsigned char*)(smem) + 2 * 64 * FA_LD * 2;
    bf16x8 qf[NC][KS];
    { const bf16_t* qp = P + (size_t)(it.qrow0 + 32 * w + lq) * PW + it.qcol + 8 * h;
#pragma unroll
      for (int c = 0; c < NC; ++c)
#pragma unroll
          for (int s = 0; s < KS; ++s) qf[c][s] = *(const bf16x8*)(qp + 32 * c + 16 * s); }
    f32x16 O[NC][2]; float lsum[NC];
#pragma unroll
    for (int c = 0; c < NC; ++c) { lsum[c] = 0.f;
#pragma unroll
        for (int dt = 0; dt < 2; ++dt)
#pragma unroll
            for (int r = 0; r < 16; ++r) O[c][dt][r] = 0.f; }
    const int ntot = it.nt0 + it.nt1;
    const int ldkey = tid >> 3, ldch = tid & 7;
    const int vlane = ((4 * h + ((lane & 15) >> 2)) * FA_LD + 16 * ((lane >> 4) & 1) + 4 * (lane & 3)) * 2;
    u32x4 kreg, vreg;
    { const int krow = it.nt0 > 0 ? it.krow0 : it.krow1; const bf16_t* kp = P + (size_t)(krow + ldkey) * PW;
      kreg = *(const u32x4*)(kp + it.kcol + ldch * 8); vreg = *(const u32x4*)(kp + it.vcol + ldch * 8); }
    __syncthreads();
    *(u32x4*)(Kb + ldkey * FA_LD + ldch * 8) = kreg; *(u32x4*)(Vb + ldkey * FA_LD + ldch * 8) = vreg;
    __syncthreads();
    const int qpos = it.qpos0 + 32 * w + lq;
    for (int kt = 0; kt < ntot; ++kt) {
        const int buf = kt & 1;
        int kpos = 0; bool msk = false;
        if (kt < it.nt0) { kpos = it.kpos0 + 64 * kt; msk = it.masked != 0; }
        if (kt + 1 < ntot) { const int k2 = kt + 1; const int krow = k2 < it.nt0 ? it.krow0 + 64 * k2 : it.krow1 + 64 * (k2 - it.nt0);
            const bf16_t* kp = P + (size_t)(krow + ldkey) * PW; kreg = *(const u32x4*)(kp + it.kcol + ldch * 8); vreg = *(const u32x4*)(kp + it.vcol + ldch * 8); }
        bool skip = false;
        if (msk) { const int q0 = it.qpos0 + 32 * w; skip = (kpos > q0 + 31 + 128) || (kpos + 63 < q0 - 128); }
        if (!skip) {
            const bf16_t* kb = Kb + buf * 64 * FA_LD; const LAS unsigned char* vb = vlds + buf * 64 * FA_LD * 2 + vlane;
#pragma unroll
            for (int sub = 0; sub < 2; ++sub) {
                unsigned pk[NC][2][4];
#pragma unroll
                for (int c = 0; c < NC; ++c) {
                    f32x16 S;
#pragma unroll
                    for (int r = 0; r < 16; ++r) S[r] = -it.M2;
#pragma unroll
                    for (int s = 0; s < KS; ++s) { const bf16x8 a = *(const bf16x8*)(kb + (32 * sub + lq) * FA_LD + 32 * c + 16 * s + 8 * h);
                        S = __builtin_amdgcn_mfma_f32_32x32x16_bf16(a, qf[c][s], S, 0, 0, 0); }
                    float pv[16];
#pragma unroll
                    for (int r = 0; r < 16; ++r) { pv[r] = fast_exp2(S[r]);
                        if (NC == 1) { if (msk) { const int d = qpos - (kpos + 32 * sub + CROW(r, lane)); if (d > 128 || d < -128) pv[r] = 0.f; } } }
#pragma unroll
                    for (int r = 0; r < 16; ++r) lsum[c] += pv[r];
#pragma unroll
                    for (int s = 0; s < 2; ++s)
#pragma unroll
                        for (int jj = 0; jj < 4; ++jj) pk[c][s][jj] = pg8::cvt_pk_bf16(pv[8 * s + 2 * jj], pv[8 * s + 2 * jj + 1]);
                }
#pragma unroll
                for (int s = 0; s < 2; ++s)
#pragma unroll
                    for (int dt = 0; dt < 2; ++dt) {
                        const s16x4 lo = tr_read(vb + (32 * sub + 16 * s) * FA_LD * 2 + 64 * dt), hi = tr_read(vb + (32 * sub + 16 * s + 8) * FA_LD * 2 + 64 * dt);
                        const bf16x8 a = __builtin_shufflevector(lo, hi, 0, 1, 2, 3, 4, 5, 6, 7);
#pragma unroll
                        for (int c = 0; c < NC; ++c) { u32x4 bw; bw.x = pk[c][s][0]; bw.y = pk[c][s][1]; bw.z = pk[c][s][2]; bw.w = pk[c][s][3];
                            O[c][dt] = __builtin_amdgcn_mfma_f32_32x32x16_bf16(a, __builtin_bit_cast(bf16x8, bw), O[c][dt], 0, 0, 0); }
                    }
            }
        }
        if (kt + 1 < ntot) { bf16_t* kd = Kb + (buf ^ 1) * 64 * FA_LD; bf16_t* vd = Vb + (buf ^ 1) * 64 * FA_LD;
            *(u32x4*)(kd + ldkey * FA_LD + ldch * 8) = kreg; *(u32x4*)(vd + ldkey * FA_LD + ldch * 8) = vreg; }
        __syncthreads();
    }
    float linv[NC];
#pragma unroll
    for (int c = 0; c < NC; ++c) { const float l = lsum[c] + __shfl_xor(lsum[c], 32); linv[c] = (NC == 1) ? 1.0f / (l + fast_exp2(it.sink2 - it.M2)) : 1.0f / l; }
    bf16_t* yp = Y + (size_t)(it.qrow0 + 32 * w + lq) * DM + it.ycol + 4 * h;
    if (NC == 1) {
#pragma unroll
        for (int dt = 0; dt < 2; ++dt)
#pragma unroll
            for (int g = 0; g < 4; ++g) { u32x2 wv; wv.x = pg8::cvt_pk_bf16(O[0][dt][4 * g] * linv[0], O[0][dt][4 * g + 1] * linv[0]); wv.y = pg8::cvt_pk_bf16(O[0][dt][4 * g + 2] * linv[0], O[0][dt][4 * g + 3] * linv[0]);
                *(u32x2*)(yp + 32 * dt + 8 * g) = wv; }
    } else {
        const float a1 = it.lam * linv[NC - 1];
        float ss = 0.f;
#pragma unroll
        for (int dt = 0; dt < 2; ++dt)
#pragma unroll
            for (int r = 0; r < 16; ++r) { const float v = O[0][dt][r] * linv[0] - a1 * O[NC - 1][dt][r]; O[0][dt][r] = v; ss += v * v; }
        ss += __shfl_xor(ss, 32);
        const float rinv = rsqrtf(ss * (1.0f / 64.0f) + EPSF) * it.postscale;
        const float* sg = it.subgain + 4 * h;
#pragma unroll
        for (int dt = 0; dt < 2; ++dt)
#pragma unroll
            for (int g = 0; g < 4; ++g) { const float4 gg = *(const float4*)(sg + 32 * dt + 8 * g);
                u32x2 wv; wv.x = pg8::cvt_pk_bf16(O[0][dt][4 * g] * rinv * gg.x, O[0][dt][4 * g + 1] * rinv * gg.y); wv.y = pg8::cvt_pk_bf16(O[0][dt][4 * g + 2] * rinv * gg.z, O[0][dt][4 * g + 3] * rinv * gg.w);
                *(u32x2*)(yp + 32 * dt + 8 * g) = wv; }
    }
}


#define FD_RING 4
__device__ __forceinline__ void fattn_d_item(const bf16_t* __restrict__ P, bf16_t* __restrict__ Y, const AttnItem& it, unsigned char* smem) {
    const int tid = my_tid(), lane = tid & 63, w = tid >> 6, h = lane >> 5, lq = lane & 31;
    bf16_t* ring = (bf16_t*)smem;
    const LAS unsigned char* rlds = (const LAS unsigned char*)smem;
    constexpr int TB = 64 * FA_LD * 2;
    bf16x8 qf[2][2];
    { const bf16_t* qp = P + (size_t)(it.qrow0 + 32 * w + lq) * PW + it.qcol + 8 * h;
#pragma unroll
      for (int c = 0; c < 2; ++c)
#pragma unroll
          for (int s = 0; s < 2; ++s) qf[c][s] = *(const bf16x8*)(qp + 32 * c + 16 * s); }
    f32x16 O[2][2]; float lsum[2] = {0.f, 0.f};
#pragma unroll
    for (int c = 0; c < 2; ++c)
#pragma unroll
        for (int dt = 0; dt < 2; ++dt)
#pragma unroll
            for (int r = 0; r < 16; ++r) O[c][dt][r] = 0.f;
    const int ntot = it.nt0 + it.nt1;
    const int ldkey = tid >> 3, ldch = tid & 7;
    const int vlane = ((4 * h + ((lane & 15) >> 2)) * FA_LD + 16 * ((lane >> 4) & 1) + 4 * (lane & 3)) * 2;
    const int klane = (lq * FA_LD + 8 * h) * 2;
#define FD_TROW(k) ((k) < it.nt0 ? it.krow0 + 64 * (k) : it.krow1 + 64 * ((k) - it.nt0))
#define FD_GLOAD(k) do { const bf16_t* kp_ = P + (size_t)(FD_TROW(k) + ldkey) * PW; kreg = *(const u32x4*)(kp_ + it.kcol + ldch * 8); vreg = *(const u32x4*)(kp_ + it.vcol + ldch * 8); } while (0)
#define FD_LSTORE(k) do { bf16_t* d_ = ring + (size_t)((k) & (FD_RING - 1)) * 2 * 64 * FA_LD + ldkey * FA_LD + ldch * 8; *(u32x4*)d_ = kreg; *(u32x4*)(d_ + 64 * FA_LD) = vreg; } while (0)
    u32x4 kreg, vreg;
    __syncthreads();
    FD_GLOAD(0); FD_LSTORE(0);
    if (ntot > 1) { FD_GLOAD(1); FD_LSTORE(1); }
    __syncthreads();
    f32x16 zero16;
#pragma unroll
    for (int r = 0; r < 16; ++r) zero16[r] = 0.f;
    f32x16 SS[2];
    { const LAS unsigned char* kb = rlds + klane;
      SS[0] = __builtin_amdgcn_mfma_f32_32x32x16_bf16(*(const LAS bf16x8*)(kb), qf[0][0], zero16, 0, 0, 0);
      SS[0] = __builtin_amdgcn_mfma_f32_32x32x16_bf16(*(const LAS bf16x8*)(kb + 32), qf[0][1], SS[0], 0, 0, 0); }
    unsigned pkp[2][4];
#pragma unroll
    for (int s = 0; s < 2; ++s)
#pragma unroll
        for (int j = 0; j < 4; ++j) pkp[s][j] = 0u;
    for (int kt = 0; kt < ntot; ++kt) {
        if (kt + 2 < ntot) FD_GLOAD(kt + 2);
        const LAS unsigned char* cb = rlds + (size_t)(kt & (FD_RING - 1)) * 2 * TB;
        const LAS unsigned char* nb = rlds + (size_t)((kt + 1) & (FD_RING - 1)) * 2 * TB;
        const LAS unsigned char* pb = rlds + (size_t)((kt + FD_RING - 1) & (FD_RING - 1)) * 2 * TB;
#pragma unroll
        for (int u = 0; u < 4; ++u) {
            const int c = u & 1;
            const int nsub = ((u + 1) & 3) >> 1, nc = (u + 1) & 1;
            const int psub = ((u + 3) & 3) >> 1, pc = (u + 3) & 1;
            const LAS unsigned char* ka = ((u < 3) ? cb : nb) + klane + (32 * nsub) * FA_LD * 2 + 64 * nc;
            const LAS unsigned char* va = ((u > 0) ? cb : pb) + TB + vlane + (32 * psub) * FA_LD * 2;
            const bf16x8 kf0 = *(const LAS bf16x8*)(ka), kf1 = *(const LAS bf16x8*)(ka + 32);
            bf16x8 vf[2][2];
#pragma unroll
            for (int s = 0; s < 2; ++s)
#pragma unroll
                for (int dt = 0; dt < 2; ++dt) { const s16x4 lo = tr_read(va + (16 * s) * FA_LD * 2 + 64 * dt), hi = tr_read(va + (16 * s + 8) * FA_LD * 2 + 64 * dt);
                    vf[s][dt] = __builtin_shufflevector(lo, hi, 0, 1, 2, 3, 4, 5, 6, 7); }
            __builtin_amdgcn_sched_barrier(0);
            f32x16& Sc = SS[u & 1]; f32x16& Sn = SS[(u + 1) & 1];
            unsigned pkc[2][4];
#pragma unroll
            for (int s = 0; s < 2; ++s) {
                float pv[8];
#pragma unroll
                for (int j = 0; j < 8; ++j) pv[j] = fast_exp2(Sc[8 * s + j]);
                lsum[c] += ((pv[0] + pv[1]) + (pv[2] + pv[3])) + ((pv[4] + pv[5]) + (pv[6] + pv[7]));
#pragma unroll
                for (int jj = 0; jj < 4; ++jj) pkc[s][jj] = pg8::cvt_pk_bf16(pv[2 * jj], pv[2 * jj + 1]);
            }
            if ((u < 3) || (kt + 1 < ntot)) {
                Sn = __builtin_amdgcn_mfma_f32_32x32x16_bf16(kf0, qf[nc][0], zero16, 0, 0, 0);
                Sn = __builtin_amdgcn_mfma_f32_32x32x16_bf16(kf1, qf[nc][1], Sn, 0, 0, 0); }
            if ((u > 0) || (kt > 0)) {
#pragma unroll
                for (int s = 0; s < 2; ++s) { u32x4 bw; bw.x = pkp[s][0]; bw.y = pkp[s][1]; bw.z = pkp[s][2]; bw.w = pkp[s][3];
#pragma unroll
                    for (int dt = 0; dt < 2; ++dt) O[pc][dt] = __builtin_amdgcn_mfma_f32_32x32x16_bf16(vf[s][dt], __builtin_bit_cast(bf16x8, bw), O[pc][dt], 0, 0, 0); } }
            __builtin_amdgcn_sched_group_barrier(0x2, 5, 0);
#pragma unroll
            for (int g = 0; g < 6; ++g) { __builtin_amdgcn_sched_group_barrier(0x8, 1, 0); __builtin_amdgcn_sched_group_barrier(0x2, 5, 0); }
            __builtin_amdgcn_sched_barrier(0);
#pragma unroll
            for (int s = 0; s < 2; ++s)
#pragma unroll
                for (int j = 0; j < 4; ++j) pkp[s][j] = pkc[s][j];
        }
        if (kt + 2 < ntot) FD_LSTORE(kt + 2);
        __syncthreads();
    }
    { const LAS unsigned char* va = rlds + (size_t)((ntot - 1) & (FD_RING - 1)) * 2 * TB + TB + vlane + 32 * FA_LD * 2;
#pragma unroll
      for (int s = 0; s < 2; ++s) { u32x4 bw; bw.x = pkp[s][0]; bw.y = pkp[s][1]; bw.z = pkp[s][2]; bw.w = pkp[s][3];
#pragma unroll
          for (int dt = 0; dt < 2; ++dt) {
              const s16x4 lo = tr_read(va + (16 * s) * FA_LD * 2 + 64 * dt), hi = tr_read(va + (16 * s + 8) * FA_LD * 2 + 64 * dt);
              const bf16x8 a = __builtin_shufflevector(lo, hi, 0, 1, 2, 3, 4, 5, 6, 7);
              O[1][dt] = __builtin_amdgcn_mfma_f32_32x32x16_bf16(a, __builtin_bit_cast(bf16x8, bw), O[1][dt], 0, 0, 0); } } }
#undef FD_TROW
#undef FD_GLOAD
#undef FD_LSTORE
    float linv[2];
#pragma unroll
    for (int c = 0; c < 2; ++c) { const float l = lsum[c] + __shfl_xor(lsum[c], 32); linv[c] = 1.0f / l; }
    bf16_t* yp = Y + (size_t)(it.qrow0 + 32 * w + lq) * DM + it.ycol + 4 * h;
    const float a1 = it.lam * linv[1];
    float ss = 0.f;
#pragma unroll
    for (int dt = 0; dt < 2; ++dt)
#pragma unroll
        for (int r = 0; r < 16; ++r) { const float v = O[0][dt][r] * linv[0] - a1 * O[1][dt][r]; O[0][dt][r] = v; ss += v * v; }
    ss += __shfl_xor(ss, 32);
    const float rinv = rsqrtf(ss * (1.0f / 64.0f) + EPSF) * it.postscale;
    const float* sg = it.subgain + 4 * h;
#pragma unroll
    for (int dt = 0; dt < 2; ++dt)
#pragma unroll
        for (int g = 0; g < 4; ++g) { const float4 gg = *(const float4*)(sg + 32 * dt + 8 * g);
            u32x2 wv; wv.x = pg8::cvt_pk_bf16(O[0][dt][4 * g] * rinv * gg.x, O[0][dt][4 * g + 1] * rinv * gg.y); wv.y = pg8::cvt_pk_bf16(O[0][dt][4 * g + 2] * rinv * gg.z, O[0][dt][4 * g + 3] * rinv * gg.w);
            *(u32x2*)(yp + 32 * dt + 8 * g) = wv; }
}

__device__ __forceinline__ float max_abs_vec(const float* g, int n) { float m = 0.f; for (int i = 0; i < n; ++i) m = fmaxf(m, fabsf(g[i])); return m; }

__device__ __forceinline__ int attn_item_remap(int x0, int G) {
    if (G != 256 || x0 >= 1024) return x0;
    const int i = x0 >> 8, bid = x0 & 255, xcd = bid & 7, slot = bid >> 3;
    const int bh = i * 16 + xcd * 2 + (slot >> 4), n = slot & 15;
    return bh * 16 + n;
}
__device__ __forceinline__ void phase_attnA(const Params& p, int l, unsigned char* smem) {
    unsigned char* ws = launder_ws(p.ws);
    const bf16_t* P = (const bf16_t*)(ws + WS_P); bf16_t* Y = (bf16_t*)(ws + WS_U);
    const float bound = 8.0f * LOG2E * 1.02f * max_abs_vec(PIN(I_AQN) + l * 64, 64) * max_abs_vec(PIN(I_AKN) + l * 64, 64);
    const int nitems = (l == DEPTH - 1) ? 1024 : 1088;
    const int cshift = (gridDim.x == 256) ? 64 : 0;
    for (int x0 = blockIdx.x; x0 < nitems + cshift; x0 += gridDim.x) {
        if (x0 >= 1024 && x0 < 1024 + cshift) continue;
        const int x = attn_item_remap(x0 >= 1024 ? x0 - cshift : x0, gridDim.x);
        AttnItem it; it.subgain = nullptr; it.lam = 0.f; it.postscale = 1.f;
        int b, h, n;
        if (x < 1024) { b = x >> 6; h = (x >> 4) & 3; n = x & 15;
            const int lo = max(0, 256 * n - 128), hi = min(TL, 256 * n + 384);
            it.qrow0 = b * TL + 256 * n; it.qpos0 = 256 * n; it.nt0 = (hi - lo) >> 6; it.krow0 = b * TL + lo; it.kpos0 = lo; it.masked = 1; }
        else { const int y = x - 1024; b = y >> 2; h = y & 3;
            it.qrow0 = NROWL + b * TCX; it.qpos0 = 0; it.nt0 = 0; it.krow0 = 0; it.kpos0 = 0; it.masked = 0; }
        it.nt1 = 4; it.krow1 = NROWL + b * TCX;
        it.qcol = h * 64; it.kcol = 256 + (h >> 1) * 64; it.vcol = 384 + (h >> 1) * 64; it.ycol = h * 64;
        it.sink2 = PIN(I_ASINK)[l * 4 + h] * LOG2E; it.M2 = fmaxf(bound, it.sink2);
        fattn_item<1>(P, Y, it, smem);
    }
}
__device__ __forceinline__ void phase_attnD(const Params& p, int l, unsigned char* smem) {
    unsigned char* ws = launder_ws(p.ws);
    const bf16_t* P = (const bf16_t*)(ws + WS_P); bf16_t* Y = (bf16_t*)(ws + WS_U);
    const float bound = 5.656854249f * LOG2E * 1.02f * max_abs_vec(PIN(I_DQN) + l * 32, 32) * max_abs_vec(PIN(I_DKN) + l * 32, 32);
    float d1 = 0.f, d2 = 0.f;
    for (int i = 0; i < 32; ++i) { d1 += PIN(I_LQ1)[l * 32 + i] * PIN(I_LK1)[l * 32 + i]; d2 += PIN(I_LQ2)[l * 32 + i] * PIN(I_LK2)[l * 32 + i]; }
    const float lam_init = 0.8f - 0.6f * expf(-0.3f * (float)l);
    const float lam = expf(d1) - expf(d2) + lam_init;
    const int nitems = (l == DEPTH - 1) ? 1024 : 1088;
    for (int x0 = blockIdx.x; x0 < nitems; x0 += gridDim.x) {
        const int x = attn_item_remap(x0, gridDim.x);
        AttnItem it; it.subgain = PIN(I_DSUB) + l * 64; it.lam = lam; it.postscale = 1.0f - lam_init; it.sink2 = 0.f; it.M2 = bound;
        int b, h, n;
        if (x < 1024) { b = x >> 6; h = (x >> 4) & 3; n = x & 15;
            it.qrow0 = b * TL + 256 * n; it.qpos0 = 0; it.nt0 = 64; it.krow0 = b * TL; it.kpos0 = 0; it.masked = 0; }
        else { const int y = x - 1024; b = y >> 2; h = y & 3;
            it.qrow0 = NROWL + b * TCX; it.qpos0 = 0; it.nt0 = 0; it.krow0 = 0; it.kpos0 = 0; it.masked = 0; }
        it.nt1 = 4; it.krow1 = NROWL + b * TCX;
        it.qcol = 1536 + h * 64; it.kcol = 1792 + h * 64; it.vcol = 2048 + h * 64; it.ycol = 768 + h * 64;
        if (bound < 100.0f) fattn_d_item(P, Y, it, smem); else fattn_item<2>(P, Y, it, smem);
    }
}

#define HY_ZROWS 4160
#define HY_FLEN 8256
#define HY_OFF_F (HY_ZROWS * 32)
#define HY_OFF_MISC (HY_OFF_F + HY_FLEN * 2)

__device__ __forceinline__ void hy_kloop(const LAS unsigned char* zs, const LAS bf16_t* fs, int w, int lane, f32x4 (&acc)[4][8]) {
    const int i = lane & 15, q = lane >> 4, qq = (lane & 15) >> 2, pp = lane & 3;
    const LAS bf16_t* ap = fs + (4096 - 512 * w + 8 * q - 8 * i);
    const LAS unsigned char* bp = zs + (8 * q + qq) * 32 + pp * 8;
    bf16x8 an[4];
#pragma unroll
    for (int m = 0; m < 4; ++m) an[m] = *(const LAS bf16x8*)(ap - 128 * m);
#pragma unroll 1
    for (int ks = 0; ks < 129; ++ks) {
        bf16x8 a[4];
#pragma unroll
        for (int m = 0; m < 4; ++m) a[m] = an[m];
#pragma unroll
        for (int m = 0; m < 4; ++m) an[m] = *(const LAS bf16x8*)(ap + 32 * (ks + 1) - 128 * m);
#pragma unroll
        for (int r = 0; r < 8; ++r) {
            const s16x4 lo = tr_read(bp + (32 * ks + r) * 32), hi = tr_read(bp + (32 * ks + r) * 32 + 128);
            const bf16x8 b = __builtin_shufflevector(lo, hi, 0, 1, 2, 3, 4, 5, 6, 7);
#pragma unroll
            for (int m = 0; m < 4; ++m) acc[m][r] = __builtin_amdgcn_mfma_f32_16x16x32_bf16(a[m], b, acc[m][r], 0, 0, 0);
        }
    }
}
#define HYC_OFF_Z 4096
#define HYC_ZROWS 304
#define HYC_OFF_F (HYC_OFF_Z + HYC_ZROWS * 32)
#define HYC_FLEN 576
__device__ __forceinline__ void hy_ckloop(const LAS unsigned char* zs, const LAS bf16_t* fs, int r, int lane, f32x4 (&acc)[2]) {
    const int i = lane & 15, q = lane >> 4, qq = (lane & 15) >> 2, pp = lane & 3;
    const LAS bf16_t* ap = fs + (256 + 8 * q - 8 * i);
    const LAS unsigned char* bp = zs + (8 * q + qq + r) * 32 + pp * 8;
#pragma unroll
    for (int ks = 0; ks < 9; ++ks) {
        const s16x4 lo = tr_read(bp + (32 * ks) * 32), hi = tr_read(bp + (32 * ks) * 32 + 128);
        const bf16x8 b = __builtin_shufflevector(lo, hi, 0, 1, 2, 3, 4, 5, 6, 7);
#pragma unroll
        for (int m = 0; m < 2; ++m) { const bf16x8 a = *(const LAS bf16x8*)(ap + 32 * ks - 128 * m); acc[m] = __builtin_amdgcn_mfma_f32_16x16x32_bf16(a, b, acc[m], 0, 0, 0); }
    }
}
__device__ __forceinline__ float hy_sconv(const bf16_t* u, int t, int T, float c0, float c1, float c2) {
    const int tm = t > 0 ? t - 1 : 0, tp = t < T - 1 ? t + 1 : T - 1;
    const float um = bf2f(u[tm]), u0 = bf2f(u[t]), up = bf2f(u[tp]);
    return (t > 0 ? c0 : 0.f) * um + c1 * u0 + (t < T - 1 ? c2 : 0.f) * up;
}
__device__ __forceinline__ void hy_gate8(const bf16_t* ub  , int t0, float c0, float c1, float c2, float (&g)[8]) {
    const u32x4 raw = *(const u32x4*)ub; const float hl = bf2f(ub[-1]), hr = bf2f(ub[8]);
    float x[10];
    x[0] = t0 > 0 ? hl : 0.f; x[9] = t0 + 8 < 4096 ? hr : 0.f;
    x[1] = bflo(raw.x); x[2] = bfhi(raw.x); x[3] = bflo(raw.y); x[4] = bfhi(raw.y); x[5] = bflo(raw.z); x[6] = bfhi(raw.z); x[7] = bflo(raw.w); x[8] = bfhi(raw.w);
#pragma unroll
    for (int e = 0; e < 8; ++e) g[e] = c0 * x[e] + c1 * x[e + 1] + c2 * x[e + 2];
}
__device__ __forceinline__ float block_sum(float v, float* red  ) {
    v = wave_sum(v);
    __syncthreads();
    if ((my_tid() & 63) == 0) red[my_tid() >> 6] = v;
    __syncthreads();
    float s = 0.f;
#pragma unroll
    for (int w = 0; w < 8; ++w) s += red[w];
    return s;
}

#if defined(PROBE_KIND) && PROBE_KIND == 6
#define HY_STAMP(k) do { if (blockIdx.x == 0 && my_tid() == 0) { volatile unsigned* pw_ = (volatile unsigned*)(smem + LDS_BYTES - 48); const unsigned t_ = (unsigned)wall_clock64(); \
        if ((k) >= 0 && ((PROBE_MASK >> ((k) < 0 ? 0 : (k))) & 1)) pw_[2] += t_ - pw_[5]; pw_[5] = t_; } } while (0)
#else
#define HY_STAMP(k) do {} while (0)
#endif
__device__ __forceinline__ void phase_hyena(const Params& p, int l, unsigned char* smem) {
    unsigned char* ws = launder_ws(p.ws);
    LAS unsigned char* lds = (LAS unsigned char*)smem;
    bf16_t* Zs = (bf16_t*)smem; bf16_t* Fs = (bf16_t*)(smem + HY_OFF_F);
    float* fw3c = (float*)(smem + HY_OFF_MISC);
    float* red = fw3c + 256;
    float* HT = (float*)smem;
    const bf16_t* UT = (const bf16_t*)(ws + WS_UT);
    bf16_t* YT = (bf16_t*)(ws + WS_YT);
    const float* H2L = (const float*)(ws + WS_HID2L); const float* H2C = (const float*)(ws + WS_HID2C);
    const float* fw3 = PIN(I_FW3) + (size_t)l * 64 * 1024;
    const float* cw = PIN(I_HYCONV) + (size_t)l * 3 * 768;
    const float da = logf(1e-2f) / 1.5f, db = logf(1e-2f) / 0.3f;
    for (int c = blockIdx.x; c < 256; c += gridDim.x) {
        const int tid = my_tid(), lane = tid & 63, w = tid >> 6;
        bf16_t* FB = (bf16_t*)(ws + WS_FBUF) + (size_t)c * HY_FLEN;
        const float delta = fabsf(da + (float)c * ((db - da) / 255.0f));
        const float bias0 = PIN(I_HYBIAS)[l * 512 + c], bias1 = PIN(I_HYBIAS)[l * 512 + 256 + c];
        __syncthreads();
        if (tid < 256) fw3c[tid] = fw3[(size_t)(tid & 63) * 1024 + (tid >> 6) * 256 + c];
        __syncthreads();
        HY_STAMP(-1);
        float ss0 = 0.f, ss1 = 0.f;
#pragma unroll 1
        for (int lag = tid; lag < 4096; lag += NTHR) {
            float a0 = 0.f, a1 = 0.f, a2 = 0.f, a3 = 0.f;
            float hv[64];
#pragma unroll
            for (int k = 0; k < 64; ++k) hv[k] = H2L[(size_t)k * 4096 + lag];
#pragma unroll
            for (int k = 0; k < 64; ++k) { const float h = hv[k]; a0 += h * fw3c[k]; a1 += h * fw3c[64 + k]; a2 += h * fw3c[128 + k]; a3 += h * fw3c[192 + k]; }
            const float dec = expf(-((float)lag / 4095.0f) * delta);
            a0 *= dec; a1 *= dec; a2 *= dec; a3 *= dec;
            HT[lag] = a0; HT[4096 + lag] = a1; HT[8192 + lag] = a2; HT[12288 + lag] = a3;
            ss0 += a0 * a0 + (lag >= 1 ? a2 * a2 : 0.f); ss1 += a1 * a1 + (lag >= 1 ? a3 * a3 : 0.f);
        }
        ss0 = block_sum(ss0, red); ss1 = block_sum(ss1, red);
        const float n0 = rsqrtf(ss0 + EPSF), n1 = rsqrtf(ss1 + EPSF);
#pragma unroll 1
        for (int x = tid; x < HY_FLEN; x += NTHR) { const int d = 4128 - x; float f0 = 0.f, f1 = 0.f;
            if (d >= 0 && d <= 4095) { f0 = HT[d] * n0; f1 = HT[4096 + d] * n1; } else if (d < 0 && d >= -4095) { f0 = HT[8192 - d] * n0; f1 = HT[12288 - d] * n1; }
            Fs[x] = f2bf(f0); FB[x] = f2bf(f1); }
        __syncthreads();
        HY_STAMP(0);
        for (int idx = tid; idx < 1024; idx += NTHR) { const int rr = idx >> 4; Zs[(rr < 32 ? rr : 4096 + rr) * 16 + (idx & 15)] = 0; }
        { const bf16_t* u = UT + (size_t)c * NROW; const float v0 = cw[c], v1 = cw[768 + c], v2 = cw[1536 + c];
#pragma unroll 4
          for (int idx = tid; idx < 8192; idx += NTHR) { const int b = idx & 15, t0 = (idx >> 4) * 8;
              float g[8]; hy_gate8(u + b * 4096 + t0, t0, v0, v1, v2, g);
#pragma unroll
              for (int i = 0; i < 8; ++i) Zs[(t0 + i + 32) * 16 + b] = f2bf(g[i]); } }
        __syncthreads();
        HY_STAMP(1);
        f32x4 acc[4][8];
#pragma unroll
        for (int m = 0; m < 4; ++m)
#pragma unroll
            for (int r = 0; r < 8; ++r) acc[m][r] = (f32x4){0.f, 0.f, 0.f, 0.f};
        hy_kloop(lds, (const LAS bf16_t*)(lds + HY_OFF_F), w, lane, acc);
        HY_STAMP(2);
        { int lo = lane, wo = w; asm volatile("" : "+v"(lo), "+v"(wo));
          const float g0 = cw[256 + c], g1 = cw[768 + 256 + c], g2 = cw[1536 + 256 + c];
          const int tb0 = 512 * wo + 32 * (lo >> 4);
          const bf16_t* u1 = UT + (size_t)(256 + c) * NROW + (lo & 15) * 4096 + tb0;
          const bf16_t* zp = Zs + (tb0 + 32) * 16 + (lo & 15);
#pragma unroll
          for (int m = 0; m < 4; ++m)
#pragma unroll
              for (int j = 0; j < 4; ++j) { float g[8]; hy_gate8(u1 + 128 * m + 8 * j, tb0 + 128 * m + 8 * j, g0, g1, g2, g);
#pragma unroll
                  for (int r = 0; r < 8; ++r) { const float z = bf2f(zp[(128 * m + r + 8 * j) * 16]); acc[m][r][j] = g[r] * (acc[m][r][j] + bias0 * z); }
                  asm volatile("" ::: "memory"); } }
        __syncthreads();
        { int lo = lane, wo = w; asm volatile("" : "+v"(lo), "+v"(wo));
          bf16_t* zp = Zs + (512 * wo + 32 * (lo >> 4) + 32) * 16 + (lo & 15);
#pragma unroll
          for (int m = 0; m < 4; ++m)
#pragma unroll
              for (int r = 0; r < 8; ++r) {
#pragma unroll
                  for (int j = 0; j < 4; ++j) zp[(128 * m + r + 8 * j) * 16] = f2bf(acc[m][r][j]);
                  asm volatile("" ::: "memory"); } }
        for (int x = tid; x < HY_FLEN / 8; x += NTHR) ((u32x4*)Fs)[x] = ((const u32x4*)FB)[x];
        __syncthreads();
        HY_STAMP(3);
#pragma unroll
        for (int m = 0; m < 4; ++m)
#pragma unroll
            for (int r = 0; r < 8; ++r) acc[m][r] = (f32x4){0.f, 0.f, 0.f, 0.f};
        hy_kloop(lds, (const LAS bf16_t*)(lds + HY_OFF_F), w, lane, acc);
        HY_STAMP(4);
        { int lo = lane, wo = w; asm volatile("" : "+v"(lo), "+v"(wo));
          const float e0 = cw[512 + c], e1 = cw[768 + 512 + c], e2 = cw[1536 + 512 + c];
          const int tb0 = 512 * wo + 32 * (lo >> 4);
          const bf16_t* u2 = UT + (size_t)(512 + c) * NROW + (lo & 15) * 4096 + tb0;
          bf16_t* yo = YT + (size_t)c * NROW + (lo & 15) * 4096 + tb0;
          const bf16_t* zp = Zs + (tb0 + 32) * 16 + (lo & 15);
#pragma unroll
          for (int m = 0; m < 4; ++m)
#pragma unroll
              for (int j = 0; j < 4; ++j) { float g[8]; hy_gate8(u2 + 128 * m + 8 * j, tb0 + 128 * m + 8 * j, e0, e1, e2, g);
#pragma unroll
                  for (int r = 0; r < 8; ++r) { const float z1 = bf2f(zp[(128 * m + r + 8 * j) * 16]); g[r] = g[r] * (acc[m][r][j] + bias1 * z1); }
                  u32x4 o; o.x = pack_bf16(g[0], g[1]); o.y = pack_bf16(g[2], g[3]); o.z = pack_bf16(g[4], g[5]); o.w = pack_bf16(g[6], g[7]);
                  *(u32x4*)(yo + 128 * m + 8 * j) = o;
                  asm volatile("" ::: "memory"); } }
        __syncthreads();
        HY_STAMP(5);
        if (l < DEPTH - 1) {   float* HTc = (float*)smem;
            bf16_t* Zc = (bf16_t*)(smem + HYC_OFF_Z);
            bf16_t* Fc0 = (bf16_t*)(smem + HYC_OFF_F); bf16_t* Fc1 = Fc0 + HYC_FLEN;
            float* part = (float*)(smem + HYC_OFF_Z);
            float t0 = 0.f, t1 = 0.f;
            { const int lag = tid & 255, kh = tid >> 8; float a0 = 0.f, a1 = 0.f, a2 = 0.f, a3 = 0.f;
              float hv[32];
#pragma unroll
              for (int k = 0; k < 32; ++k) hv[k] = H2C[(size_t)(32 * kh + k) * 256 + lag];
#pragma unroll
              for (int k = 0; k < 32; ++k) { const float h = hv[k]; const int kk = 32 * kh + k; a0 += h * fw3c[kk]; a1 += h * fw3c[64 + kk]; a2 += h * fw3c[128 + kk]; a3 += h * fw3c[192 + kk]; }
              if (kh == 1) { part[lag] = a0; part[256 + lag] = a1; part[512 + lag] = a2; part[768 + lag] = a3; }
              __syncthreads();
              if (kh == 0) { a0 += part[lag]; a1 += part[256 + lag]; a2 += part[512 + lag]; a3 += part[768 + lag];
                const float dec = expf(-((float)lag / 255.0f) * delta);
                a0 *= dec; a1 *= dec; a2 *= dec; a3 *= dec;
                HTc[lag] = a0; HTc[256 + lag] = a1; HTc[512 + lag] = a2; HTc[768 + lag] = a3;
                t0 = a0 * a0 + (lag >= 1 ? a2 * a2 : 0.f); t1 = a1 * a1 + (lag >= 1 ? a3 * a3 : 0.f); } }
            t0 = block_sum(t0, red); t1 = block_sum(t1, red);
            const float m0 = rsqrtf(t0 + EPSF), m1 = rsqrtf(t1 + EPSF);
            for (int x = tid; x < 2 * HYC_FLEN; x += NTHR) { const int o = x >= HYC_FLEN ? 1 : 0, xx = x - o * HYC_FLEN, d = 288 - xx; float f = 0.f;
                if (d >= 0 && d <= 255) f = HTc[256 * o + d]; else if (d < 0 && d >= -255) f = HTc[512 + 256 * o - d];
                Fc0[x] = f2bf(f * (o ? m1 : m0)); }
            { const bf16_t* uc = UT + (size_t)c * NROW + NROWL; const float v0 = cw[c], v1 = cw[768 + c], v2 = cw[1536 + c];
              for (int idx = tid; idx < 768; idx += NTHR) { const int rr = idx >> 4; Zc[(rr < 32 ? rr : 256 + rr) * 16 + (idx & 15)] = 0; }
#pragma unroll 2
              for (int idx = tid; idx < 4096; idx += NTHR) { const int b = idx >> 8, t = idx & 255; Zc[(t + 32) * 16 + b] = f2bf(hy_sconv(uc + b * 256, t, 256, v0, v1, v2)); } }
            __syncthreads();
            f32x4 ca[2];
            ca[0] = (f32x4){0.f, 0.f, 0.f, 0.f}; ca[1] = ca[0];
            hy_ckloop(lds + HYC_OFF_Z, (const LAS bf16_t*)(lds + HYC_OFF_F), w, lane, ca);
            { const float g0 = cw[256 + c], g1 = cw[768 + 256 + c], g2 = cw[1536 + 256 + c];
              const bf16_t* u1c = UT + (size_t)(256 + c) * NROW + NROWL + (lane & 15) * 256;
#pragma unroll
              for (int m = 0; m < 2; ++m)
#pragma unroll
                  for (int j = 0; j < 4; ++j) { const int t = 128 * m + w + 32 * (lane >> 4) + 8 * j;
                      const float z = bf2f(Zc[(t + 32) * 16 + (lane & 15)]);
                      ca[m][j] = hy_sconv(u1c, t, 256, g0, g1, g2) * (ca[m][j] + bias0 * z); } }
            __syncthreads();
#pragma unroll
            for (int m = 0; m < 2; ++m)
#pragma unroll
                for (int j = 0; j < 4; ++j) { const int t = 128 * m + w + 32 * (lane >> 4) + 8 * j; Zc[(t + 32) * 16 + (lane & 15)] = f2bf(ca[m][j]); }
            __syncthreads();
            ca[0] = (f32x4){0.f, 0.f, 0.f, 0.f}; ca[1] = ca[0];
            hy_ckloop(lds + HYC_OFF_Z, (const LAS bf16_t*)(lds + HYC_OFF_F + 2 * HYC_FLEN), w, lane, ca);
            { const float e0 = cw[512 + c], e1 = cw[768 + 512 + c], e2 = cw[1536 + 512 + c];
              const bf16_t* u2c = UT + (size_t)(512 + c) * NROW + NROWL + (lane & 15) * 256;
              bf16_t* yo = YT + (size_t)c * NROW + NROWL + (lane & 15) * 256;
#pragma unroll
              for (int m = 0; m < 2; ++m)
#pragma unroll
                  for (int j = 0; j < 4; ++j) { const int t = 128 * m + w + 32 * (lane >> 4) + 8 * j;
                      const float z1 = bf2f(Zc[(t + 32) * 16 + (lane & 15)]);
                      yo[t] = f2bf(hy_sconv(u2c, t, 256, e0, e1, e2) * (ca[m][j] + bias1 * z1)); } }
            __syncthreads();
        }
        HY_STAMP(6);
    }
}

__device__ __forceinline__ void phase_hy_transpose(const Params& p, int l, unsigned char* smem) {
    unsigned char* ws = launder_ws(p.ws);
    const bf16_t* YT = (const bf16_t*)(ws + WS_YT); bf16_t* Y = (bf16_t*)(ws + WS_U);
    bf16_t* tile = (bf16_t*)smem;
    const int tid = my_tid();
    const int ntile = 4 * ((l == DEPTH - 1 ? NROWL : NROW) / 64);
    for (int it = blockIdx.x; it < ntile; it += gridDim.x) {
        const int ct = it & 3, rt = it >> 2;
        __syncthreads();
        { const int ch = tid >> 3, seg = tid & 7;
          const u32x4 v = *(const u32x4*)(YT + (size_t)(ct * 64 + ch) * NROW + rt * 64 + seg * 8);
          unsigned* d = (unsigned*)(tile + ch * 66 + seg * 8); d[0] = v.x; d[1] = v.y; d[2] = v.z; d[3] = v.w; }
        __syncthreads();
        { const int r = tid >> 3, seg = tid & 7;
          unsigned wv[4];
#pragma unroll
          for (int k = 0; k < 4; ++k) wv[k] = (unsigned)tile[(seg * 8 + 2 * k) * 66 + r] | ((unsigned)tile[(seg * 8 + 2 * k + 1) * 66 + r] << 16);
          u32x4 o; o.x = wv[0]; o.y = wv[1]; o.z = wv[2]; o.w = wv[3];
          *(u32x4*)(Y + (size_t)(rt * 64 + r) * DM + 256 + ct * 64 + seg * 8) = o; }
    }
    __syncthreads();
}
#define ML_ITEMS 4352
__device__ __forceinline__ void ml_decode(int it, int& b, int& head, int& tc, int& tok0, int& jf, int& jb) {
    b = it / 272; const int r = it - b * 272; head = r / 68; tc = r - head * 68;
    tok0 = tc < 4 ? NROWL + b * TCX + 64 * tc : b * TL + 64 * (tc - 4);
    jf = tc; jb = tc < 4 ? 3 - tc : 71 - tc;
}

__device__ __forceinline__ void phase_ml_local(const Params& p, int l, unsigned char* smem) {
    unsigned char* ws = launder_ws(p.ws);
    const int tid = my_tid(), lane = tid & 63, w = tid >> 6;
    bf16_t* Kt = (bf16_t*)smem;
    bf16_t* VwF = Kt + 64 * 72;
    bf16_t* VwB = VwF + 64 * 72;
    float* Vs = (float*)(VwB + 64 * 72);
    float* vec = Vs + 64 * 65;
    float* igf = vec, *igb = vec + 64, *lff = vec + 128, *lfb = vec + 192, *wf = vec + 256, *wb = vec + 320, *scal = vec + 384;
    const bf16_t* P = (const bf16_t*)(ws + WS_P);
    const float* GT = (const float*)(ws + WS_GATES);
    bf16_t* MLA = (bf16_t*)(ws + WS_MLA); float* MLN = (float*)(ws + WS_MLN); float* MLS = (float*)(ws + WS_MLS);
    const float* bg = PIN(I_BGATE) + l * 16;
    for (int it = blockIdx.x; it < ML_ITEMS; it += gridDim.x) {
        int b, head, tc, tok0, jf, jb; ml_decode(it, b, head, tc, tok0, jf, jb);
        __syncthreads();
        { const int s = tid >> 3, ch = tid & 7;
          const bf16_t* pr = P + (size_t)(tok0 + s) * PW + head * 64 + ch * 8;
          const u32x4 kv = *(const u32x4*)(pr + 768), vv = *(const u32x4*)(pr + 1024);
          const unsigned kw[4] = {kv.x, kv.y, kv.z, kv.w}, vw[4] = {vv.x, vv.y, vv.z, vv.w};
#pragma unroll
          for (int i = 0; i < 4; ++i) { Kt[(ch * 8 + 2 * i) * 72 + s] = f2bf(bflo(kw[i]) * 0.125f); Kt[(ch * 8 + 2 * i + 1) * 72 + s] = f2bf(bfhi(kw[i]) * 0.125f);
              Vs[s * 65 + ch * 8 + 2 * i] = bflo(vw[i]); Vs[s * 65 + ch * 8 + 2 * i + 1] = bfhi(vw[i]); } }
        if (tid < 64) { const float* g = GT + (size_t)(tok0 + tid) * 16;
            igf[tid] = g[head] + bg[head]; igb[tid] = g[4 + head] + bg[4 + head]; lff[tid] = log_sigmoid(g[8 + head] + bg[8 + head]); lfb[tid] = log_sigmoid(g[12 + head] + bg[12 + head]); }
        __syncthreads();
        if (tid < 128) {
            const int dirw = tid >> 6, tau = tid & 63, s = dirw ? 63 - tau : tau;
            const float lf = dirw ? lfb[s] : lff[s], ig = dirw ? igb[s] : igf[s];
            float cum = lf;
#pragma unroll
            for (int o = 1; o < 64; o <<= 1) { const float n = __shfl_up(cum, o); if (tau >= o) cum += n; }
            const float B = __shfl(cum, 63);
            const float ge = B - cum + ig;
            const float ml = wave_max(ge);
            (dirw ? wb : wf)[s] = expf(ge - ml);
            if (tau == 0) { scal[2 * dirw] = B; scal[2 * dirw + 1] = ml; } }
        __syncthreads();
        { const int e = tid >> 3, sc = (tid & 7) * 8; u32x4 a, c2; float x[8], y[8];
#pragma unroll
          for (int i = 0; i < 8; ++i) { const float v = Vs[(sc + i) * 65 + e]; x[i] = v * wf[sc + i]; y[i] = v * wb[sc + i]; }
          a.x = pack_bf16(x[0], x[1]); a.y = pack_bf16(x[2], x[3]); a.z = pack_bf16(x[4], x[5]); a.w = pack_bf16(x[6], x[7]);
          c2.x = pack_bf16(y[0], y[1]); c2.y = pack_bf16(y[2], y[3]); c2.z = pack_bf16(y[4], y[5]); c2.w = pack_bf16(y[6], y[7]);
          *(u32x4*)(VwF + e * 72 + sc) = a; *(u32x4*)(VwB + e * 72 + sc) = c2; }
        __syncthreads();
        const int dir = w >> 2, wl = w & 3, te = wl >> 1, tk = wl & 1;
        const int seq = (b * 4 + head) * 2 + dir, j = dir ? jb : jf;
        bf16_t* dst = MLA + ((size_t)seq * 68 + j) * 4096;
        { f32x16 C;
#pragma unroll
          for (int r = 0; r < 16; ++r) C[r] = 0.f;
          C = mma32((dir ? VwB : VwF) + 32 * te * 72, 72, Kt + 32 * tk * 72, 72, 64, C, lane);
#pragma unroll
          for (int r = 0; r < 16; ++r) dst[(32 * te + CROW(r, lane)) * 64 + 32 * tk + (lane & 31)] = f2bf(C[r]); }
        if (wl == 0) {
            const float* wv = dir ? wb : wf; float s = 0.f;
            for (int t = 0; t < 64; ++t) s += wv[t] * bf2f(Kt[lane * 72 + t]);
            MLN[((size_t)seq * 68 + j) * 64 + lane] = s;
            if (lane == 0) { MLS[((size_t)seq * 68 + j) * 4 + 0] = scal[2 * dir]; MLS[((size_t)seq * 68 + j) * 4 + 1] = scal[2 * dir + 1]; }
        }
    }
    __syncthreads();
}

__device__ __forceinline__ void phase_ml_scan(const Params& p) {
    unsigned char* ws = launder_ws(p.ws);
    const int tid = my_tid();
    unsigned* MLA = (unsigned*)(ws + WS_MLA); float* MLN = (float*)(ws + WS_MLN); float* MLS = (float*)(ws + WS_MLS);
    for (int it = blockIdx.x; it < 512; it += gridDim.x) {
        const int seq = it >> 2, part = it & 3;
        unsigned* base = MLA + (size_t)seq * 68 * 2048 + part * 512 + tid;
        float* nb = MLN + (size_t)seq * 68 * 64 + part * 16 + tid;
        float* sc = MLS + (size_t)seq * 68 * 4;
        const bool hasn = tid < 16;
        float m = 0.f, c0 = 0.f, c1 = 0.f, cn = 0.f;
#define ML_SCAN_BATCH(NBATCH, J0) do { unsigned a[NBATCH]; float an[NBATCH], B[NBATCH], ML[NBATCH]; \
            _Pragma("unroll") for (int u = 0; u < NBATCH; ++u) { a[u] = base[(size_t)((J0) + u) * 2048]; an[u] = hasn ? nb[((J0) + u) * 64] : 0.f; B[u] = sc[((J0) + u) * 4]; ML[u] = sc[((J0) + u) * 4 + 1]; } \
            _Pragma("unroll") for (int u = 0; u < NBATCH; ++u) { \
                const float mn = fmaxf(B[u] + m, ML[u]); const float wp = expf(B[u] + m - mn), wa = expf(ML[u] - mn); \
                if (part == 0 && tid == 0) sc[((J0) + u) * 4 + 2] = m; \
                base[(size_t)((J0) + u) * 2048] = pack_bf16(c0, c1); if (hasn) nb[((J0) + u) * 64] = cn; \
                c0 = wp * c0 + wa * bflo(a[u]); c1 = wp * c1 + wa * bfhi(a[u]); cn = wp * cn + wa * an[u]; m = mn; } } while (0)
        for (int j0 = 0; j0 < 64; j0 += 8) ML_SCAN_BATCH(8, j0);
        ML_SCAN_BATCH(4, 64);
#undef ML_SCAN_BATCH
    }
}

__device__ __forceinline__ void phase_ml_out(const Params& p, int l, unsigned char* smem) {
    unsigned char* ws = launder_ws(p.ws);
    const int tid = my_tid(), lane = tid & 63, w = tid >> 6;
    const int DSZ = 71680;
    const bf16_t* P = (const bf16_t*)(ws + WS_P);
    const float* GT = (const float*)(ws + WS_GATES);
    const bf16_t* MLA = (const bf16_t*)(ws + WS_MLA); const float* MLN = (const float*)(ws + WS_MLN); const float* MLS = (const float*)(ws + WS_MLS);
    bf16_t* Y = (bf16_t*)(ws + WS_U);
    const float* bg = PIN(I_BGATE) + l * 16; const float* mln = PIN(I_MLNORM) + l * 64;
    u32x4 pq, pk_, pv, po, pst[2]; float pn = 0.f, pg0 = 0.f, pg1 = 0.f, pm = 0.f;
#define ML_SKIP(it_) ({ int b_, h_, tc_, t0_, jf_, jb_; ml_decode((it_), b_, h_, tc_, t0_, jf_, jb_); (l == DEPTH - 1 && tc_ < 4); })
#define ML_FETCH(it_) do { int b_, h_, tc_, t0_, jf_, jb_; ml_decode((it_), b_, h_, tc_, t0_, jf_, jb_); \
        { const int s_ = tid >> 3, ch_ = tid & 7; const bf16_t* pr_ = P + (size_t)(t0_ + s_) * PW + h_ * 64 + ch_ * 8; \
          pq = *(const u32x4*)(pr_ + 512); pk_ = *(const u32x4*)(pr_ + 768); pv = *(const u32x4*)(pr_ + 1024); po = *(const u32x4*)(pr_ + 1280); } \
        _Pragma("unroll") for (int d_ = 0; d_ < 2; ++d_) { const int seq_ = (b_ * 4 + h_) * 2 + d_, j_ = d_ ? jb_ : jf_; \
          pst[d_] = *(const u32x4*)(MLA + ((size_t)seq_ * 68 + j_) * 4096 + (tid >> 3) * 64 + (tid & 7) * 8); } \
        if (tid < 128) { const int d_ = tid >> 6, tau_ = tid & 63, tk_ = d_ ? 63 - tau_ : tau_; const int seq_ = (b_ * 4 + h_) * 2 + d_, j_ = d_ ? jb_ : jf_; \
          pn = MLN[((size_t)seq_ * 68 + j_) * 64 + tau_]; const float* g_ = GT + (size_t)(t0_ + tk_) * 16; \
          pg0 = g_[4 * d_ + h_]; pg1 = g_[8 + 4 * d_ + h_]; pm = MLS[((size_t)seq_ * 68 + j_) * 4 + 2]; } } while (0)
    int it = blockIdx.x;
    while (it < ML_ITEMS && ML_SKIP(it)) it += gridDim.x;
    if (it < ML_ITEMS) ML_FETCH(it);
    while (it < ML_ITEMS) {
        int b, head, tc, tok0, jf, jb; ml_decode(it, b, head, tc, tok0, jf, jb);
        int nit = it + gridDim.x;
        while (nit < ML_ITEMS && ML_SKIP(nit)) nit += gridDim.x;
        __syncthreads();
        {   const int s = tid >> 3, ch = tid & 7;
            const u32x4 qv = pq, kv = pk_, vv = pv;
            u32x4 ks; ks.x = pack_bf16(bflo(kv.x) * 0.125f, bfhi(kv.x) * 0.125f); ks.y = pack_bf16(bflo(kv.y) * 0.125f, bfhi(kv.y) * 0.125f);
            ks.z = pack_bf16(bflo(kv.z) * 0.125f, bfhi(kv.z) * 0.125f); ks.w = pack_bf16(bflo(kv.w) * 0.125f, bfhi(kv.w) * 0.125f);
            const unsigned vw[4] = {vv.x, vv.y, vv.z, vv.w};
#pragma unroll
            for (int d = 0; d < 2; ++d) { unsigned char* D = smem + d * DSZ; const int tau = d ? 63 - s : s;
                bf16_t* Qd = (bf16_t*)D; bf16_t* Kd = Qd + 64 * 72; bf16_t* Bd = Kd + 64 * 72 + 64 * 136;
                *(u32x4*)(Qd + tau * 72 + ch * 8) = qv; *(u32x4*)(Kd + tau * 72 + ch * 8) = ks;
#pragma unroll
                for (int i = 0; i < 4; ++i) { Bd[(ch * 8 + 2 * i) * 136 + tau] = (bf16_t)(vw[i] & 0xffff); Bd[(ch * 8 + 2 * i + 1) * 136 + tau] = (bf16_t)(vw[i] >> 16); } }
#pragma unroll
            for (int d = 0; d < 2; ++d) { unsigned char* D = smem + d * DSZ; bf16_t* Bd = (bf16_t*)D + 2 * 64 * 72 + 64 * 136;
                const int e = tid >> 3, k0 = (tid & 7) * 8;
                *(u32x4*)(Bd + e * 136 + 64 + k0) = pst[d]; }
            if (tid < 128) { const int d = tid >> 6, tau = tid & 63;
                float* vecs = (float*)(smem + d * DSZ + 53248);
                vecs[3 * 64 + tau] = pn;
                vecs[4 * 64 + tau] = pg0 + bg[4 * d + head];
                vecs[5 * 64 + tau] = log_sigmoid(pg1 + bg[8 + 4 * d + head]); }
        }
        const float mcur = pm; const u32x4 ov = po;
        if (nit < ML_ITEMS) ML_FETCH(nit);
        __syncthreads();
        if (tid < 128) { const int d = tid >> 6, tau = tid & 63; float* vecs = (float*)(smem + d * DSZ + 53248);
            const int seq = (b * 4 + head) * 2 + d, j = d ? jb : jf;
            const float m = mcur;
            float cum = vecs[5 * 64 + tau];
#pragma unroll
            for (int o = 1; o < 64; o <<= 1) { const float n = __shfl_up(cum, o); if (tau >= o) cum += n; }
            float mm = vecs[4 * 64 + tau] - cum;
#pragma unroll
            for (int o = 1; o < 64; o <<= 1) { const float n = __shfl_up(mm, o); if (tau >= o) mm = fmaxf(mm, n); }
            const float mt = cum + fmaxf(m, mm);
            vecs[tau] = cum; vecs[64 + tau] = mt; vecs[128 + tau] = expf(cum + m - mt); }
        __syncthreads();
        const int d = w >> 2, wl = w & 3, tt = wl >> 1, tx = wl & 1;
        unsigned char* D = smem + d * DSZ;
        bf16_t* Qd = (bf16_t*)D; bf16_t* Kd = Qd + 64 * 72; bf16_t* Ad = Kd + 64 * 72; bf16_t* Bd = Ad + 64 * 136;
        float* vecs = (float*)(D + 53248); float* Hd = vecs + 7 * 64;
        {   f32x16 S;
#pragma unroll
            for (int r = 0; r < 16; ++r) S[r] = 0.f;
            S = mma32(Qd + 32 * tt * 72, 72, Kd + 32 * tx * 72, 72, 64, S, lane);
            const int s = 32 * tx + (lane & 31); const float bs = vecs[s], igs = vecs[4 * 64 + s];
#pragma unroll
            for (int r = 0; r < 16; ++r) { const int t = 32 * tt + CROW(r, lane);
                const float val = (s <= t) ? S[r] * fast_exp2((vecs[t] - bs + igs - vecs[64 + t]) * LOG2E) : 0.f;
                Ad[t * 136 + s] = f2bf(val); }
            const int tl = tid & 255, t = tl >> 2, qd = tl & 3; const float wi = vecs[128 + t];
#pragma unroll
            for (int v = 0; v < 2; ++v) { const u32x4 q = *(const u32x4*)(Qd + t * 72 + 16 * qd + 8 * v); u32x4 o;
                o.x = pack_bf16(bflo(q.x) * wi, bfhi(q.x) * wi); o.y = pack_bf16(bflo(q.y) * wi, bfhi(q.y) * wi); o.z = pack_bf16(bflo(q.z) * wi, bfhi(q.z) * wi); o.w = pack_bf16(bflo(q.w) * wi, bfhi(q.w) * wi);
                *(u32x4*)(Ad + t * 136 + 64 + 16 * qd + 8 * v) = o; }
        }
        __syncthreads();
        {   f32x16 N;
#pragma unroll
            for (int r = 0; r < 16; ++r) N[r] = 0.f;
            N = mma32(Ad + 32 * tt * 136, 136, Bd + 32 * tx * 136, 136, 128, N, lane);
#pragma unroll
            for (int r = 0; r < 16; ++r) Hd[(32 * tt + CROW(r, lane)) * 65 + 32 * tx + (lane & 31)] = N[r];
            const int tl = tid & 255;
            {
                const int t = tl >> 2, qd = tl & 3; float dn = 0.f;
                const u32x4 sa = *(const u32x4*)(Ad + t * 136 + 16 * qd), sb = *(const u32x4*)(Ad + t * 136 + 16 * qd + 8);
                const u32x4 qa = *(const u32x4*)(Ad + t * 136 + 64 + 16 * qd), qb = *(const u32x4*)(Ad + t * 136 + 64 + 16 * qd + 8);
                const float* nv = vecs + 3 * 64 + 16 * qd;
                dn += (bflo(sa.x) + bfhi(sa.x)) + (bflo(sa.y) + bfhi(sa.y)) + (bflo(sa.z) + bfhi(sa.z)) + (bflo(sa.w) + bfhi(sa.w));
                dn += (bflo(sb.x) + bfhi(sb.x)) + (bflo(sb.y) + bfhi(sb.y)) + (bflo(sb.z) + bfhi(sb.z)) + (bflo(sb.w) + bfhi(sb.w));
                dn += bflo(qa.x) * nv[0] + bfhi(qa.x) * nv[1] + bflo(qa.y) * nv[2] + bfhi(qa.y) * nv[3] + bflo(qa.z) * nv[4] + bfhi(qa.z) * nv[5] + bflo(qa.w) * nv[6] + bfhi(qa.w) * nv[7];
                dn += bflo(qb.x) * nv[8] + bfhi(qb.x) * nv[9] + bflo(qb.y) * nv[10] + bfhi(qb.y) * nv[11] + bflo(qb.z) * nv[12] + bfhi(qb.z) * nv[13] + bflo(qb.w) * nv[14] + bfhi(qb.w) * nv[15];
                dn += dpp_get<DPP_XOR1>(dn); dn += dpp_get<DPP_XOR2>(dn);
                if (qd == 0) vecs[6 * 64 + t] = dn; }
        }
        __syncthreads();
        {   const int s = tid >> 3, e0 = (tid & 7) * 8;
            const float* vF = (const float*)(smem + 53248); const float* HF = vF + 7 * 64;
            const float* vB = (const float*)(smem + DSZ + 53248); const float* HB = vB + 7 * 64;
            const int tb = 63 - s;
            const float rf = 1.0f / fmaxf(fabsf(vF[6 * 64 + s]), fast_exp2(-vF[64 + s] * LOG2E)), rb = 1.0f / fmaxf(fabsf(vB[6 * 64 + tb]), fast_exp2(-vB[64 + tb] * LOG2E));
            float y[8], ss = 0.f;
#pragma unroll
            for (int i = 0; i < 8; ++i) { y[i] = HF[s * 65 + e0 + i] * rf + HB[tb * 65 + e0 + i] * rb; ss += y[i] * y[i]; }
            ss += __shfl_xor(ss, 1); ss += __shfl_xor(ss, 2); ss += __shfl_xor(ss, 4);
            const float rinv = rsqrtf(ss * (1.0f / 64.0f) + EPSF);
            const float op[8] = {bflo(ov.x), bfhi(ov.x), bflo(ov.y), bfhi(ov.y), bflo(ov.z), bfhi(ov.z), bflo(ov.w), bfhi(ov.w)};
            float o[8];
#pragma unroll
            for (int i = 0; i < 8; ++i) o[i] = y[i] * rinv * mln[e0 + i] * __builtin_amdgcn_rcpf(1.0f + fast_exp2(-op[i] * LOG2E));
            u32x4 wv; wv.x = pack_bf16(o[0], o[1]); wv.y = pack_bf16(o[2], o[3]); wv.z = pack_bf16(o[4], o[5]); wv.w = pack_bf16(o[6], o[7]);
            *(u32x4*)(Y + (size_t)(tok0 + s) * DM + 512 + head * 64 + e0) = wv;
        }
        it = nit;
    }
#undef ML_SKIP
#undef ML_FETCH
    __syncthreads();
}
#ifndef DUPMASK
#define DUPMASK 0
#endif
#ifndef PROBE_KIND
#define PROBE_KIND 0
#endif
#ifndef PROBE_MASK
#define PROBE_MASK 0
#endif
#ifndef PROBE_MULT
#define PROBE_MULT 1
#endif
#ifndef PROBE_BLK
#define PROBE_BLK 0
#endif
#if PROBE_KIND
#define PROBE_PRE() do { if (blockIdx.x == PROBE_BLK && threadIdx.x == 0) pw[0] = (unsigned)wall_clock64(); } while (0)
#define PROBE_POST(id) do { if (blockIdx.x == PROBE_BLK && threadIdx.x == 0) { const unsigned t_ = (unsigned)wall_clock64(), c_ = (unsigned)clock64(); \
        if ((PROBE_MASK >> (id)) & 1) { if (PROBE_KIND == 1) pw[2] += t_ - pw[1]; if (PROBE_KIND == 2) pw[2] += t_ - pw[0]; if (PROBE_KIND == 3) { pw[2] += t_ - pw[1]; pw[3] += c_ - pw[4]; } } \
        pw[1] = t_; pw[4] = c_; } } while (0)
#else
#define PROBE_PRE() do {} while (0)
#define PROBE_POST(id) do {} while (0)
#endif
#if PROBE_KIND == 5
#define PROBE_SEC_BEGIN() do { if (blockIdx.x == PROBE_BLK && threadIdx.x == 0) pw[5] = (unsigned)wall_clock64(); } while (0)
#define PROBE_SEC_END(k) do { if (blockIdx.x == PROBE_BLK && threadIdx.x == 0) { const unsigned t_ = (unsigned)wall_clock64(); if ((PROBE_MASK >> (k)) & 1) pw[2] += t_ - pw[5]; pw[5] = t_; } } while (0)
#else
#define PROBE_SEC_BEGIN() do {} while (0)
#define PROBE_SEC_END(k) do {} while (0)
#endif
#define XBAR(id) do { PROBE_PRE(); XcdBarrier _b; _b.bar = (unsigned*)(launder_ws(p.ws) + WS_BAR); _b.x = xb_xcc_id(); _b.st = xbw; xcd_barrier(_b); if ((DUPMASK >> 13) & 1) xcd_barrier(_b); PROBE_POST(id); } while (0)
#define REP(k) for (int _rep = 0; _rep < 1 + ((DUPMASK >> (k)) & 1); ++_rep)
extern __shared__ __attribute__((aligned(16))) unsigned char smem_raw[];

__global__ void __launch_bounds__(NTHR, 2) trunk_fwd(Params p) {
    unsigned char* smem = smem_raw;
    volatile LAS unsigned* xbw = (volatile LAS unsigned*)(smem_raw + LDS_BYTES - 16);
    if (threadIdx.x == 0) { xbw[0] = 0u; xbw[1] = 0u; xbw[2] = 0u; xbw[3] = 0u; }
    __syncthreads();
    (void)xcd_barrier_post((unsigned*)(p.ws + WS_BAR), xbw);
#if PROBE_KIND
    volatile LAS unsigned* pw = (volatile LAS unsigned*)(smem_raw + LDS_BYTES - 48);
    if (blockIdx.x == PROBE_BLK && threadIdx.x == 0) { pw[1] = (unsigned)wall_clock64(); pw[4] = (unsigned)clock64(); pw[2] = 0u; pw[3] = 0u; }
#endif
    unsigned char* ws = p.ws;
    LAS unsigned char* lds = (LAS unsigned char*)smem_raw;
    const int G = gridDim.x, c = blockIdx.x;
    phase_W<0>(p, 0, smem);
    XBAR(0);
    phase_norm<1>(p, 0, smem);
    XBAR(1);
    for (int l = 0; l < DEPTH; ++l) {
        const bool last = (l == DEPTH - 1);
        REP(10) {   pg8::Gemm g; g.A = (const bf16_t*)(ws + WS_U); g.Bt = (const bf16_t*)(ws + WS_U); g.M = 0; g.N = 0; g.K = DM;
            { const int tid = my_tid();
              const float4* src = (const float4*)(ws + WS_ROPE); float4* dst = (float4*)(smem + EPI_TAB_OFF);
              for (int i = tid; i < 768; i += NTHR) dst[i] = src[i];
              float* gl = (float*)(smem + EPI_TAB_OFF + 12288);
              if (tid < 192) gl[tid] = tid < 64 ? PIN(I_AQN)[l * 64 + tid] : tid < 128 ? PIN(I_AKN)[l * 64 + tid - 64] : tid < 160 ? PIN(I_DQN)[l * 32 + tid - 128] : PIN(I_DKN)[l * 32 + tid - 160];
              __syncthreads(); }
            InProjOrder S{G, c}; EpiInProj E{(bf16_t*)(ws + WS_P), (bf16_t*)(ws + WS_UT), (const LAS unsigned char*)(lds + EPI_TAB_OFF)};
            pg8::gemm_phase(lds, g, S, E); }
        XBAR(2);
        PROBE_SEC_BEGIN();
        REP(0) phase_hyena(p, l, smem);
        PROBE_SEC_END(0);
        REP(1) phase_attnD(p, l, smem);
        PROBE_SEC_END(1);
        REP(2) phase_attnA(p, l, smem);
        PROBE_SEC_END(2);
        REP(3) phase_ml_local(p, l, smem);
        PROBE_SEC_END(3);
        XBAR(4);
        phase_ml_scan(p);
        REP(9) phase_hy_transpose(p, l, smem);
        XBAR(5);
        REP(4) phase_ml_out(p, l, smem);
        XBAR(6);
        {   pg8::Gemm g; g.A = (const bf16_t*)(ws + WS_U); g.Bt = (const bf16_t*)(ws + WS_WOUT); g.M = 0; g.N = 0; g.K = DM;
            OutProjOrder S{G, c, last ? 256 : 272};
            EpiOut E{PIN(I_X), PIN(I_CTX), (bf16_t*)(ws + WS_XB), (const float*)(ws + WS_MOD + (size_t)(l & 1) * MOD_BYTES), l == 0 ? 1 : 0};
            pg8::gemm_phase(lds, g, S, E); }
        REP(5) if (l + 1 < DEPTH) phase_W<2>(p, l + 1, smem);
        XBAR(7);
        REP(6) phase_norm<2>(p, l, smem);
        XBAR(8);
        REP(7) phase_topk(p, l, smem);
        XBAR(9);
        REP(11) {   pg8::Gemm g; g.A = (const bf16_t*)(ws + WS_U); g.Bt = (const bf16_t*)(ws + WS_WGU); g.M = 0; g.N = 0; g.K = DM;
            GateUpOrder S{G, c, last ? 32 : 34}; EpiGU E{(bf16_t*)(ws + WS_HID)};
            pg8::gemm_phase_gather(lds, g, S, E, (const int*)(ws + WS_SROW)); }
        XBAR(10);
        REP(12) {   pg8::Gemm g; g.A = (const bf16_t*)(ws + WS_HID); g.Bt = (const bf16_t*)(ws + WS_WD); g.M = 0; g.N = 0; g.K = DM;
            DownOrder S{G, c, last ? 32 : 34}; EpiDown E{(bf16_t*)(ws + WS_XE), (const float*)(ws + WS_SGATE)};
            pg8::gemm_phase(lds, g, S, E); }
        if (l + 1 < DEPTH) phase_W<3>(p, l + 1, smem);
        XBAR(11);
        if (l + 1 < DEPTH) { REP(14) phase_combine<true>(p, l, smem); REP(5) phase_W<1>(p, l + 1, smem); XBAR(12); }
        else phase_combine<false>(p, l, smem);
    }
#if PROBE_KIND
    PROBE_POST(12);
    if (blockIdx.x == PROBE_BLK && threadIdx.x == 0) {
        unsigned long long target = (unsigned long long)pw[2] * PROBE_MULT;
        if (PROBE_KIND == 3) target = pw[2] ? (unsigned long long)pw[3] * 10000ull / pw[2] : 0ull;
        const unsigned long long t0 = wall_clock64();
        while ((unsigned long long)wall_clock64() - t0 < target) __builtin_amdgcn_s_sleep(8);
    }
#endif
}

extern "C" void kernel_launch(void* const* d_in, const int* in_sizes, int n_in, void* d_out, int out_size, void* d_ws, size_t ws_size, hipStream_t stream) {
    static int grid = 0;
    if (grid == 0) {
        if (n_in != 34 || out_size != NROWL * DM || ws_size < WS_END) { fprintf(stderr, "kernel_launch: unexpected shapes (n_in %d out %d ws %zu need %zu)\n", n_in, out_size, ws_size, (size_t)WS_END); grid = -1; return; }
        int dev = 0, cus = 0;
        if (hipGetDevice(&dev) != hipSuccess || hipDeviceGetAttribute(&cus, hipDeviceAttributeMultiprocessorCount, dev) != hipSuccess) { grid = -1; return; }
        if (hipFuncSetAttribute((const void*)trunk_fwd, hipFuncAttributeMaxDynamicSharedMemorySize, LDS_BYTES) != hipSuccess) { fprintf(stderr, "kernel_launch: hipFuncSetAttribute failed\n"); grid = -1; return; }
        int per_cu = 0;
        if (hipOccupancyMaxActiveBlocksPerMultiprocessor(&per_cu, (const void*)trunk_fwd, NTHR, LDS_BYTES) != hipSuccess || per_cu < 1) { fprintf(stderr, "kernel_launch: occupancy query says %d\n", per_cu); }
        (void)hipGetLastError();
        grid = cus;
        if (grid > 256) grid = 256;
        grid &= ~7;
    }
    if (grid <= 0) return;
    (void)hipMemsetAsync((char*)d_ws + WS_BAR, 0, 16384, stream);
    Params p{};
    for (int i = 0; i < 34; ++i) p.in[i] = (const float*)d_in[i];
    p.out = (float*)d_out; p.ws = (unsigned char*)d_ws;
    hipLaunchKernelGGL(trunk_fwd, dim3(grid), dim3(NTHR), LDS_BYTES, stream, p);
}
```
